# Optimizing an MI355X kernel written in HIP

```python
import math
import jax, jax.numpy as jnp
from jax import lax
import numpy as np

D_MODEL = 2048
BATCH = 2
SEQ = 8192
DEPTH = 1

EPS = 1e-6
ROPE_THETA = 10000.0
Q_BLOCK = 128

MLA_HEADS = 8
MLA_Q_RANK = 768
MLA_KV_RANK = 512
MLA_NOPE = 128
MLA_ROPE = 64
MLA_V = 128
MLA_QK = MLA_NOPE + MLA_ROPE

DIFF_HEADS = 8
DIFF_HD = 64
DIFF_VD = 2 * DIFF_HD

PEER_HEADS = 8
PEER_NKEYS = 128
PEER_EXPERTS = PEER_NKEYS * PEER_NKEYS
PEER_QDIM = 256
PEER_HALF = PEER_QDIM // 2
PEER_TOPK = 16
PEER_CHUNK = 128

OFF_CQ = 0
OFF_CKV = OFF_CQ + MLA_Q_RANK
OFF_KR = OFF_CKV + MLA_KV_RANK
OFF_DQ = OFF_KR + MLA_ROPE
OFF_DK = OFF_DQ + DIFF_HEADS * 2 * DIFF_HD
OFF_DV = OFF_DK + DIFF_HEADS * 2 * DIFF_HD
OFF_GATE = OFF_DV + DIFF_HEADS * DIFF_VD
IN_COLS = OFF_GATE + 2 * D_MODEL

kernel_name = "hybrid_mla_diffattn_peer"


def rmsnorm(x, g):
    xf = x.astype(jnp.float32)
    y = xf * lax.rsqrt(jnp.mean(xf * xf, axis=-1, keepdims=True) + EPS)
    return (y * g.astype(jnp.float32)).astype(x.dtype)


def rope(x, pos):
    d = x.shape[-1]
    inv = ROPE_THETA ** (-jnp.arange(0, d, 2, dtype=jnp.float32) / d)
    ang = pos.astype(jnp.float32)[:, None] * inv[None, :]
    shape = (1, pos.shape[0]) + (1,) * (x.ndim - 3) + (d,)
    cos = jnp.concatenate([jnp.cos(ang), jnp.cos(ang)], -1).reshape(shape)
    sin = jnp.concatenate([jnp.sin(ang), jnp.sin(ang)], -1).reshape(shape)
    xf = x.astype(jnp.float32)
    x1, x2 = xf[..., : d // 2], xf[..., d // 2:]
    rot = jnp.concatenate([-x2, x1], -1)
    return (xf * cos + rot * sin).astype(x.dtype)


def _over_query_blocks(fn, qs):
    b, s = qs[0].shape[:2]
    nb = s // Q_BLOCK
    split = lambda a: a.reshape(b, nb, Q_BLOCK, *a.shape[2:]).swapaxes(0, 1)
    out = lax.map(lambda args: fn(args[0], *args[1:]),
                  (jnp.arange(nb), *[split(a) for a in qs]))
    return out.swapaxes(0, 1).reshape(b, s, *out.shape[3:])


def _causal_probs(q, k, blk, scale):
    qb, s = q.shape[1], k.shape[1]
    sc = jnp.einsum('bqhd,bkhd->bhqk', q, k).astype(jnp.float32) * scale
    qpos = blk * qb + jnp.arange(qb)
    mask = jnp.arange(s)[None, :] <= qpos[:, None]
    sc = jnp.where(mask, sc, -jnp.inf)
    return jax.nn.softmax(sc, axis=-1)


def mla_branch(proj, g_cq, w_uq, g_ckv, w_ukv, pos):
    b, s, _ = proj.shape
    c_q = rmsnorm(proj[..., OFF_CQ:OFF_CKV], g_cq)
    c_kv = rmsnorm(proj[..., OFF_CKV:OFF_KR], g_ckv)
    k_rope = rope(proj[..., OFF_KR:OFF_DQ][:, :, None, :], pos)
    q = (c_q @ w_uq).reshape(b, s, MLA_HEADS, MLA_QK)
    q = jnp.concatenate([q[..., :MLA_NOPE], rope(q[..., MLA_NOPE:], pos)], -1)
    kv = (c_kv @ w_ukv).reshape(b, s, MLA_HEADS, MLA_NOPE + MLA_V)
    k = jnp.concatenate([kv[..., :MLA_NOPE],
                         jnp.broadcast_to(k_rope, (b, s, MLA_HEADS, MLA_ROPE))], -1)
    v = kv[..., MLA_NOPE:]
    scale = MLA_QK ** -0.5

    def attend(blk, q_blk):
        p = _causal_probs(q_blk, k, blk, scale)
        return jnp.einsum('bhqk,bkhd->bqhd', p.astype(v.dtype), v)

    o = _over_query_blocks(attend, [q])
    return o.reshape(b, s, MLA_HEADS * MLA_V)


def diff_branch(proj, lambda_qk, g_subln, lambda_init, pos):
    b, s, _ = proj.shape
    q = rope(proj[..., OFF_DQ:OFF_DK].reshape(b, s, DIFF_HEADS, 2, DIFF_HD), pos)
    k = rope(proj[..., OFF_DK:OFF_DV].reshape(b, s, DIFF_HEADS, 2, DIFF_HD), pos)
    v = proj[..., OFF_DV:OFF_GATE].reshape(b, s, DIFF_HEADS, DIFF_VD)
    q1, q2 = q[..., 0, :], q[..., 1, :]
    k1, k2 = k[..., 0, :], k[..., 1, :]
    lq = lambda_qk.astype(jnp.float32)
    lam = (jnp.exp(jnp.sum(lq[0] * lq[1])) - jnp.exp(jnp.sum(lq[2] * lq[3]))
           + lambda_init)
    scale = DIFF_HD ** -0.5

    def attend(blk, q1b, q2b):
        p = _causal_probs(q1b, k1, blk, scale) - lam * _causal_probs(q2b, k2, blk, scale)
        return jnp.einsum('bhqk,bkhd->bqhd', p.astype(v.dtype), v)

    o = _over_query_blocks(attend, [q1, q2])
    o = rmsnorm(o, g_subln) * (1.0 - lambda_init)
    return o.reshape(b, s, DIFF_HEADS * DIFF_VD)


def peer_ffn(h, w_q, sub_keys, expert_u, expert_v):
    b, s, d = h.shape
    t = b * s
    hf = h.reshape(t, d)
    q = (hf @ w_q).reshape(t, PEER_HEADS, 2, PEER_HALF).astype(jnp.float32)
    sk = sub_keys.astype(jnp.float32)
    s1 = jnp.einsum('thd,nd->thn', q[:, :, 0], sk[0])
    s2 = jnp.einsum('thd,nd->thn', q[:, :, 1], sk[1])
    v1, i1 = lax.top_k(s1, PEER_TOPK)
    v2, i2 = lax.top_k(s2, PEER_TOPK)
    cand = (v1[..., :, None] + v2[..., None, :]).reshape(t, PEER_HEADS, PEER_TOPK * PEER_TOPK)
    cs, ci = lax.top_k(cand, PEER_TOPK)
    row = jnp.take_along_axis(i1, ci // PEER_TOPK, axis=-1)
    col = jnp.take_along_axis(i2, ci % PEER_TOPK, axis=-1)
    experts = row * PEER_NKEYS + col
    gates = jax.nn.softmax(cs, axis=-1)
    nc = t // PEER_CHUNK

    def mix(args):
        hc, ec, gc = args
        a = jax.nn.gelu(jnp.einsum('chkd,cd->chk', expert_u[ec], hc).astype(jnp.float32))
        w = (gc * a).astype(hc.dtype)
        return jnp.einsum('chk,chkd->cd', w, expert_v[ec])

    out = lax.map(mix, (hf.reshape(nc, PEER_CHUNK, d),
                        experts.reshape(nc, PEER_CHUNK, PEER_HEADS, PEER_TOPK),
                        gates.reshape(nc, PEER_CHUNK, PEER_HEADS, PEER_TOPK)))
    return out.reshape(b, s, d)


def setup_inputs(seed: int = 0) -> dict:
    key = jax.random.key(seed)
    ks = jax.random.split(key, 20)
    f32 = jnp.float32
    nrm = lambda k, shape, sc: jax.random.normal(k, shape, f32) * sc
    gain = lambda k, shape: 1.0 + 0.02 * jax.random.normal(k, shape, f32)
    return {
        "x": jax.random.normal(ks[0], (BATCH, SEQ, D_MODEL), f32),
        "w_in": nrm(ks[1], (DEPTH, D_MODEL, IN_COLS), D_MODEL ** -0.5),
        "b_gate": nrm(ks[2], (DEPTH, 2 * D_MODEL), 0.02),
        "g_norm1": gain(ks[3], (DEPTH, D_MODEL)),
        "g_cq": gain(ks[4], (DEPTH, MLA_Q_RANK)),
        "w_uq": nrm(ks[5], (DEPTH, MLA_Q_RANK, MLA_HEADS * MLA_QK), MLA_Q_RANK ** -0.5),
        "g_ckv": gain(ks[6], (DEPTH, MLA_KV_RANK)),
        "w_ukv": nrm(ks[7], (DEPTH, MLA_KV_RANK, MLA_HEADS * (MLA_NOPE + MLA_V)), MLA_KV_RANK ** -0.5),
        "w_o_mla": nrm(ks[8], (DEPTH, MLA_HEADS * MLA_V, D_MODEL), (MLA_HEADS * MLA_V) ** -0.5),
        "lambda_qk": nrm(ks[9], (DEPTH, 4, DIFF_HD), 0.1),
        "g_subln": gain(ks[10], (DEPTH, DIFF_VD)),
        "w_o_diff": nrm(ks[11], (DEPTH, DIFF_HEADS * DIFF_VD, D_MODEL), (DIFF_HEADS * DIFF_VD) ** -0.5),
        "w_out": nrm(ks[12], (DEPTH, D_MODEL, D_MODEL), D_MODEL ** -0.5),
        "g_norm2": gain(ks[13], (DEPTH, D_MODEL)),
        "w_q_peer": nrm(ks[14], (DEPTH, D_MODEL, PEER_HEADS * PEER_QDIM), D_MODEL ** -0.5),
        "sub_keys": nrm(ks[15], (DEPTH, 2, PEER_NKEYS, PEER_HALF), PEER_HALF ** -0.5),
        "expert_u": nrm(ks[16], (DEPTH, PEER_EXPERTS, D_MODEL), D_MODEL ** -0.5),
        "expert_v": nrm(ks[17], (DEPTH, PEER_EXPERTS, D_MODEL), PEER_HEADS ** -0.5),
        "g_final": gain(ks[18], (D_MODEL,)),
    }


def reference(x, w_in, b_gate, g_norm1, g_cq, w_uq, g_ckv, w_ukv, w_o_mla, lambda_qk,
              g_subln, w_o_diff, w_out, g_norm2, w_q_peer, sub_keys, expert_u, expert_v,
              g_final):
    pos = jnp.arange(x.shape[1], dtype=jnp.int32)
    for l in range(DEPTH):
        lambda_init = 0.8 - 0.6 * math.exp(-0.3 * l)
        h = rmsnorm(x, g_norm1[l])
        proj = h @ w_in[l]
        y_a = mla_branch(proj, g_cq[l], w_uq[l], g_ckv[l], w_ukv[l], pos) @ w_o_mla[l]
        y_b = diff_branch(proj, lambda_qk[l], g_subln[l], lambda_init, pos) @ w_o_diff[l]
        gates = jax.nn.sigmoid((proj[..., OFF_GATE:] + b_gate[l]).astype(jnp.float32)).astype(x.dtype)
        merged = gates[..., :D_MODEL] * y_a + gates[..., D_MODEL:] * y_b
        x = x + merged @ w_out[l]
        x = x + peer_ffn(rmsnorm(x, g_norm2[l]), w_q_peer[l], sub_keys[l], expert_u[l], expert_v[l])
    return rmsnorm(x, g_final)
```

```cpp
#include <hip/hip_runtime.h>
#include <cstdio>
#include <cstdint>
#include <cmath>

#ifndef MK_N_LAUNCHES
#define MK_N_LAUNCHES 0
#endif

constexpr int D_MODEL = 2048, BATCH = 2, SEQ = 8192, T = BATCH * SEQ;
constexpr int OFF_CQ = 0, OFF_CKV = 768, OFF_KR = 1280, OFF_DQ = 1344, OFF_DK = 2368, OFF_DV = 3392, OFF_GATE = 4416, IN_COLS = 8512;
constexpr int N1 = 8704;
constexpr int NEXP = 16384;
constexpr float EPS = 1e-6f;
constexpr float LOG2E = 1.4426950408889634f;
constexpr float C2_MLA = 0.07216878364870322f * LOG2E;
constexpr float C2_DIFF = 0.125f * LOG2E;
constexpr float LAMBDA_INIT = 0.2f;

namespace pg8 {
#define PG8_LAS __attribute__((address_space(3)))
typedef unsigned short bf16_t;
typedef short bf16x8 __attribute__((ext_vector_type(8)));
typedef float f32x4 __attribute__((ext_vector_type(4)));
typedef unsigned u32x4 __attribute__((ext_vector_type(4)));
typedef unsigned u32x2 __attribute__((ext_vector_type(2)));
constexpr int BM = 256, BK = 64, HALF = 128, HTB = HALF * BK * 2, STAGE_BYTES = 8 * HTB, NXCD = 8, WGM = 8;

__host__ __device__ __forceinline__ int lds_byte(int r, int c) { const int st = (r >> 4) * 2 + (c >> 5), rr = r & 15, cc = c & 31, ob = rr * 64 + cc * 2; return st * 1024 + (ob ^ (((ob >> 9) & 1) << 5)); }
__host__ __device__ __forceinline__ void stage_rc(int b, int& R, int& C) { const int st = b / 1024, sb = b % 1024, swz = sb ^ (((sb >> 9) & 1) << 5); R = (st >> 1) * 16 + swz / 64; C = (st & 1) * 32 + (swz % 64) / 2; }
__host__ __device__ __forceinline__ int perm32(int rho) { const int n = rho >> 4, i = rho & 15; return 8 * (i >> 2) + 4 * n + (i & 3); }

struct Unit { int pm, pn; };
struct Gemm { const bf16_t* A; const bf16_t* Bt; int M, N, K, lda; };

struct StaticOrder {
    int nM, nN, nwg, G, c;
    __host__ __device__ void init(int M, int N, int G_, int c_) { nM = M / BM; nN = N / BM; nwg = nM * nN; G = G_; c = c_; }
    __host__ __device__ bool next(int i, Unit& u) const {
        const long L = (long)i * G + c; if (L >= nwg) return false;
        int wgid = (int)L; { const int q = nwg / NXCD, r = nwg % NXCD, xcd = wgid % NXCD, off = wgid / NXCD; wgid = (xcd < r ? xcd * (q + 1) : r * (q + 1) + (xcd - r) * q) + off; }
        const int nig = WGM * nN, gid = wgid / nig, fm = gid * WGM, gsz = (nM - fm) < WGM ? (nM - fm) : WGM;
        u.pm = fm + ((wgid % nig) % gsz); u.pn = (wgid % nig) / gsz; return true;
    }
    __device__ __forceinline__ void a_ready(const Unit&) const {}
    __device__ __forceinline__ void done(const Unit&) const {}
};

typedef float f32x2_t __attribute__((ext_vector_type(2))); typedef __bf16 bf16x2_t __attribute__((ext_vector_type(2)));
__device__ __forceinline__ unsigned cvtpk(float lo, float hi) { f32x2_t v = {lo, hi}; bf16x2_t b = __builtin_convertvector(v, bf16x2_t); return __builtin_bit_cast(unsigned, b); }
__device__ __forceinline__ float bf2f(unsigned short h) { return __builtin_bit_cast(float, (unsigned)h << 16); }
__device__ __forceinline__ float bflo(unsigned w) { return __builtin_bit_cast(float, w << 16); }
__device__ __forceinline__ float bfhi(unsigned w) { return __builtin_bit_cast(float, w & 0xffff0000u); }

template <class Epi, class Sched, bool ALIGN_EPI = false, bool SP2 = false>
__device__ __forceinline__ void gemm_phase(PG8_LAS unsigned char* lds, const Gemm g, const Sched& S, const Epi& E) {
    const int tid = threadIdx.x, wid = __builtin_amdgcn_readfirstlane(tid >> 6), lane = tid & 63, wr = wid >> 2, wc = wid & 3, fr = lane & 15, fq = lane >> 4;
    const int K = g.K, nt = K / BK, lda = g.lda;
    unsigned voffA[2], voffB[2];
#pragma unroll
    for (int i = 0; i < 2; ++i) { int R, C; stage_rc(tid * 16 + i * 8192, R, C); const int Rb = Epi::PERM ? ((R & ~31) + perm32(R & 31)) : R;
        voffA[i] = (unsigned)(R * lda + C) * 2u; voffB[i] = (unsigned)(Rb * K + C) * 2u; }
    const size_t kstep = (size_t)(BK * 2);
    const size_t hstepA = (size_t)HALF * lda * 2, hstepB = (size_t)HALF * K * 2;
    const size_t tstepA = 2 * hstepA, tstepB = 2 * hstepB;
    const unsigned ldsw = (unsigned)wid * 1024u;
    const int aoff = lds_byte(wr * 64 + fr, fq * 8), boff = lds_byte(wc * 32 + fr, fq * 8);
#define PG8_SA(b, h) (((b) * 2 + (h)) * HTB)
#define PG8_SB(b, h) ((4 + (b) * 2 + (h)) * HTB)
#define PG8_STAGE(bufoff, gbase, voff) do { _Pragma("unroll") for (int _i = 0; _i < 2; ++_i) \
        __builtin_amdgcn_global_load_lds((const unsigned*)((const char*)(gbase) + (voff)[_i]), (PG8_LAS unsigned*)(lds + (bufoff) + ldsw + _i * 8192), 16, 0, 0); } while (0)
#define PG8_LDA(dst, b, h) do { _Pragma("unroll") for (int m = 0; m < 4; ++m) _Pragma("unroll") for (int k = 0; k < 2; ++k) dst[m][k] = *(const PG8_LAS bf16x8*)(lds + PG8_SA(b, h) + aoff + m * 2048 + k * 1024); } while (0)
#define PG8_LDB(dst, b, h) do { _Pragma("unroll") for (int n = 0; n < 2; ++n) _Pragma("unroll") for (int k = 0; k < 2; ++k) dst[n][k] = *(const PG8_LAS bf16x8*)(lds + PG8_SB(b, h) + boff + n * 2048 + k * 1024); } while (0)
#define PG8_MMA(ai, bj, At, Bt) do { __builtin_amdgcn_s_setprio(1); _Pragma("unroll") for (int m = 0; m < 4; ++m) _Pragma("unroll") for (int n = 0; n < 2; ++n) _Pragma("unroll") for (int k = 0; k < 2; ++k) \
        acc[ai][bj][m][n] = __builtin_amdgcn_mfma_f32_16x16x32_bf16(Bt[n][k], At[m][k], acc[ai][bj][m][n], 0, 0, 0); __builtin_amdgcn_s_setprio(0); } while (0)
#define PG8_WAIT_V(n) asm volatile("s_waitcnt vmcnt(" #n ")" ::: "memory")
#define PG8_WAIT_L(n) asm volatile("s_waitcnt lgkmcnt(" #n ")" ::: "memory")
#define PG8_BAR __builtin_amdgcn_s_barrier()
#define PG8_SCHED __builtin_amdgcn_sched_barrier(0)
    Unit cur, nxt; int ui = 0;
    if (!S.next(0, cur)) return;
    f32x4 acc[2][2][4][2];
#pragma unroll
    for (int a = 0; a < 2; ++a)
#pragma unroll
        for (int b = 0; b < 2; ++b)
#pragma unroll
            for (int m = 0; m < 4; ++m)
#pragma unroll
                for (int n = 0; n < 2; ++n) acc[a][b][m][n] = (f32x4){0.f, 0.f, 0.f, 0.f};
    bf16x8 At[4][2], B0[2][2], B1[2][2];
    const char* cA = (const char*)g.A + (size_t)cur.pm * tstepA; const char* cB = (const char*)g.Bt + (size_t)cur.pn * tstepB;
    S.a_ready(cur);
    if constexpr (SP2) {
        PG8_STAGE(PG8_SB(0, 0), cB, voffB); PG8_STAGE(PG8_SB(0, 1), cB + hstepB, voffB); PG8_STAGE(PG8_SA(0, 0), cA, voffA); PG8_STAGE(PG8_SA(0, 1), cA + hstepA, voffA);
        if (wr == 1) PG8_BAR;
        PG8_WAIT_V(2); PG8_BAR;
        PG8_STAGE(PG8_SB(1, 0), cB + kstep, voffB); PG8_STAGE(PG8_SA(1, 0), cA + kstep, voffA); PG8_STAGE(PG8_SB(1, 1), cB + hstepB + kstep, voffB);
        PG8_WAIT_V(6); PG8_BAR;
    } else {
        PG8_STAGE(PG8_SB(0, 0), cB, voffB); PG8_STAGE(PG8_SA(0, 0), cA, voffA); PG8_STAGE(PG8_SB(0, 1), cB + hstepB, voffB); PG8_STAGE(PG8_SA(0, 1), cA + hstepA, voffA);
        if (wr == 1) PG8_BAR;
        PG8_WAIT_V(4); PG8_BAR;
        PG8_STAGE(PG8_SB(1, 0), cB + kstep, voffB); PG8_STAGE(PG8_SA(1, 0), cA + kstep, voffA); PG8_STAGE(PG8_SB(1, 1), cB + hstepB + kstep, voffB);
        PG8_WAIT_V(6); PG8_BAR;
    }
    for (;;) {
        const bool has_next = S.next(ui + 1, nxt);
        const char* nA = has_next ? (const char*)g.A + (size_t)nxt.pm * tstepA : cA; const char* nB = has_next ? (const char*)g.Bt + (size_t)nxt.pn * tstepB : cB;
        for (int t = 0; t < nt; t += 2) {
            const bool last = (t == nt - 2);
            const char* a1 = cA + (size_t)(t + 1) * kstep;
            const char* a2 = last ? nA : cA + (size_t)(t + 2) * kstep; const char* b2 = last ? nB : cB + (size_t)(t + 2) * kstep;
            const char* a3 = a2 + kstep; const char* b3 = b2 + kstep;
            if (last && has_next) S.a_ready(nxt);
            if constexpr (SP2) {
            PG8_LDB(B0, 0, 0); PG8_LDB(B1, 0, 1); PG8_SCHED; PG8_LDA(At, 0, 0); PG8_STAGE(PG8_SA(1, 1), a1 + hstepA, voffA);
            PG8_WAIT_V(8); PG8_WAIT_L(0); PG8_BAR; PG8_MMA(0, 0, At, B0); PG8_MMA(0, 1, At, B1); PG8_BAR; PG8_SCHED;
            PG8_LDA(At, 0, 1); PG8_STAGE(PG8_SB(0, 0), b2, voffB); PG8_STAGE(PG8_SB(0, 1), b2 + hstepB, voffB); PG8_STAGE(PG8_SA(0, 0), a2, voffA);
            PG8_WAIT_V(8); PG8_WAIT_L(0); PG8_BAR; PG8_MMA(1, 0, At, B0); PG8_MMA(1, 1, At, B1); PG8_BAR; PG8_SCHED;
            PG8_LDB(B0, 1, 0); PG8_LDB(B1, 1, 1); PG8_SCHED; PG8_LDA(At, 1, 0); PG8_STAGE(PG8_SA(0, 1), a2 + hstepA, voffA);
            PG8_WAIT_V(8); PG8_WAIT_L(0); PG8_BAR; PG8_MMA(0, 0, At, B0); PG8_MMA(0, 1, At, B1); PG8_BAR; PG8_SCHED;
            PG8_LDA(At, 1, 1); PG8_STAGE(PG8_SB(1, 0), b3, voffB); PG8_STAGE(PG8_SB(1, 1), b3 + hstepB, voffB); PG8_STAGE(PG8_SA(1, 0), a3, voffA);
            PG8_WAIT_V(8); PG8_WAIT_L(0); PG8_BAR; PG8_MMA(1, 0, At, B0); PG8_MMA(1, 1, At, B1); PG8_BAR; PG8_SCHED;
            } else {
            PG8_LDB(B0, 0, 0); PG8_SCHED; PG8_LDA(At, 0, 0); PG8_STAGE(PG8_SA(1, 1), a1 + hstepA, voffA);
            PG8_WAIT_L(8); PG8_BAR; PG8_WAIT_L(0); PG8_MMA(0, 0, At, B0); PG8_BAR; PG8_SCHED;
            PG8_LDB(B1, 0, 1); PG8_STAGE(PG8_SB(0, 0), b2, voffB);
            PG8_BAR; PG8_WAIT_L(0); PG8_MMA(0, 1, At, B1); PG8_BAR;
            PG8_LDA(At, 0, 1); PG8_STAGE(PG8_SA(0, 0), a2, voffA);
            PG8_BAR; PG8_WAIT_L(0); PG8_MMA(1, 0, At, B0); PG8_BAR; PG8_SCHED;
            PG8_STAGE(PG8_SB(0, 1), b2 + hstepB, voffB);
            PG8_WAIT_V(6); PG8_BAR; PG8_MMA(1, 1, At, B1); PG8_BAR;
            PG8_LDB(B0, 1, 0); PG8_SCHED; PG8_LDA(At, 1, 0); PG8_STAGE(PG8_SA(0, 1), a2 + hstepA, voffA);
            PG8_WAIT_L(8); PG8_BAR; PG8_WAIT_L(0); PG8_MMA(0, 0, At, B0); PG8_BAR; PG8_SCHED;
            PG8_LDB(B1, 1, 1); PG8_STAGE(PG8_SB(1, 0), b3, voffB);
            PG8_BAR; PG8_WAIT_L(0); PG8_MMA(0, 1, At, B1); PG8_BAR;
            PG8_LDA(At, 1, 1); PG8_STAGE(PG8_SA(1, 0), a3, voffA);
            PG8_BAR; PG8_WAIT_L(0); PG8_MMA(1, 0, At, B0); PG8_BAR; PG8_SCHED;
            PG8_STAGE(PG8_SB(1, 1), b3 + hstepB, voffB);
            PG8_WAIT_V(6); PG8_BAR; PG8_MMA(1, 1, At, B1); PG8_BAR;
            }
        }
        if constexpr (ALIGN_EPI) { if (wr == 0) PG8_BAR; }
        E(acc, cur, wr, wc, fr, fq); S.done(cur);
        if (!has_next) break;
#pragma unroll
        for (int a = 0; a < 2; ++a)
#pragma unroll
            for (int b = 0; b < 2; ++b)
#pragma unroll
                for (int m = 0; m < 4; ++m)
#pragma unroll
                    for (int n = 0; n < 2; ++n) acc[a][b][m][n] = (f32x4){0.f, 0.f, 0.f, 0.f};
        cur = nxt; cA = nA; cB = nB; ++ui;
        if constexpr (ALIGN_EPI) { if (wr == 1) PG8_BAR; }
    }
    PG8_WAIT_V(0);
    if constexpr (!ALIGN_EPI) { if (wr == 0) PG8_BAR; }
    PG8_BAR;
#undef PG8_SA
#undef PG8_SB
#undef PG8_STAGE
#undef PG8_LDA
#undef PG8_LDB
#undef PG8_MMA
#undef PG8_WAIT_V
#undef PG8_WAIT_L
#undef PG8_BAR
#undef PG8_SCHED
}
}

#ifndef PG8_SP2
#define PG8_SP2 true
#endif
#ifndef PG8_ALIGN
#define PG8_ALIGN true
#endif

using pg8::bf16_t; using pg8::f32x4; using pg8::u32x4; using pg8::u32x2; using pg8::cvtpk; using pg8::bf2f; using pg8::bflo; using pg8::bfhi;

constexpr size_t MiB = 1u << 20;
constexpr size_t WS_CTL = 0, CTL_ZERO_BYTES = 1 * MiB;
constexpr size_t WS_ROPE = 1 * MiB;
constexpr size_t WS_WUQ = 3 * MiB, WS_WUKV = 6 * MiB, WS_WOM = 8 * MiB, WS_WOD = 12 * MiB, WS_WOUT = 16 * MiB, WS_WQP = 24 * MiB;
constexpr size_t WS_SKB = 5 * MiB + 512 * 1024;
constexpr size_t WS_W1 = 32 * MiB;
constexpr size_t WS_H = 66 * MiB;
constexpr size_t WS_CQ = 130 * MiB, WS_CKV = 154 * MiB;
constexpr size_t WS_KR = 170 * MiB, WS_DQ = 172 * MiB, WS_DK = 204 * MiB, WS_DV = 236 * MiB;
constexpr size_t WS_G = 268 * MiB;
constexpr size_t WS_QN = 32 * MiB, WS_QR = 64 * MiB, WS_KN = 80 * MiB, WS_V = 396 * MiB;
constexpr size_t WS_OM = 112 * MiB, WS_OD = 428 * MiB;
constexpr size_t WS_TMP = 32 * MiB;
constexpr size_t WS_MG = 172 * MiB;
constexpr size_t WS_X2 = 268 * MiB;
constexpr size_t WS_X2B = 396 * MiB;
constexpr size_t WS_EU = 32 * MiB, WS_EV = 96 * MiB;
constexpr size_t WS_QP = 172 * MiB;
constexpr size_t WS_IDX = 236 * MiB, WS_GT = 244 * MiB;
constexpr size_t WS_PSQ_Q = 460 * MiB, WS_PSQ_KV = 461 * MiB, WS_PSQ2 = 462 * MiB;
constexpr size_t WS_END = 464 * MiB;
constexpr int CW_TMO = 0, CW_CODE = 1, CW_LAMBDA = 8;
constexpr int CW_BAR = 4096;

constexpr int RING_OFF = 0, RING_BYTES = 131072;
constexpr int LDSCTL_OFF = RING_BYTES, MISC_OFF = LDSCTL_OFF + 320;
constexpr int LDS_BYTES = 147456;
constexpr int NWAVES = 8;

#define GAS __attribute__((address_space(1)))
#define LAS __attribute__((address_space(3)))
typedef unsigned short bf16;
typedef unsigned v4u __attribute__((ext_vector_type(4)));
typedef GAS unsigned gu32;
#define RLX_AGENT __ATOMIC_RELAXED, __HIP_MEMORY_SCOPE_AGENT
#define LDS_WAIT() asm volatile("s_waitcnt lgkmcnt(0)" ::: "memory")
#define VM_WAIT() asm volatile("s_waitcnt vmcnt(0)" ::: "memory")

#define XB_TMO      128
#define XB_XCNT(j)  (256  + 64 * (j))
#define XB_XSUB(j)  (1280 + 64 * (j))
#define XB_XGEN(j)  (2304 + 64 * (j))
#define XB_TOP      3328
#define XB_TOPGEN   3392
#define XCD_BAR_WORDS 3456
#define XB_SPIN_CAP (1u << 18)
__device__ __forceinline__ unsigned xb_ld(unsigned* p)              { return __hip_atomic_load(p, __ATOMIC_RELAXED, __HIP_MEMORY_SCOPE_AGENT); }
__device__ __forceinline__ unsigned xb_add(unsigned* p, unsigned v) { return __hip_atomic_fetch_add(p, v, __ATOMIC_RELAXED, __HIP_MEMORY_SCOPE_AGENT); }
__device__ __forceinline__ unsigned xb_xcc_id() { return (unsigned)__builtin_amdgcn_s_getreg((3 << 11) | 20) & 0xFu; }
#define XB_SPIN(cond, bar) do { unsigned _sp = 0; while (cond) { __builtin_amdgcn_s_sleep(1); \
    if ((++_sp & 255u) == 0u) { if (xb_ld(&(bar)[XB_TMO])) break; if (_sp > XB_SPIN_CAP) { atomicAdd(&(bar)[XB_TMO], 1u); break; } } } } while (0)
struct XcdBarrier { unsigned* bar; unsigned x; volatile LAS unsigned* st; };
__device__ __forceinline__ XcdBarrier xcd_barrier_post(unsigned* bar, volatile LAS unsigned* st) {
    XcdBarrier b; b.bar = bar; b.x = xb_xcc_id(); b.st = st;
    if (threadIdx.x == 0) (void)xb_add(&bar[XB_XCNT(b.x)], 1u);
    return b;
}
__device__ __forceinline__ void xcd_barrier_complete(unsigned* bar, unsigned x, unsigned& nloc, unsigned& nx) {
    const unsigned G = gridDim.x * gridDim.y * gridDim.z;
    unsigned sum, cnt, mine, sp = 0u;
    for (;;) {
        sum = 0u; cnt = 0u; mine = 0u;
#pragma unroll
        for (unsigned j = 0; j < 16; ++j) { const unsigned c = xb_ld(&bar[XB_XCNT(j)]); sum += c; cnt += (c > 0u) ? 1u : 0u; mine = (j == x) ? c : mine; }
        if (sum == G) break;
        __builtin_amdgcn_s_sleep(1);
        if ((++sp & 255u) == 0u) { if (xb_ld(&bar[XB_TMO])) break; if (sp > XB_SPIN_CAP) { atomicAdd(&bar[XB_TMO], 1u); break; } }
    }
    nloc = mine > 0u ? mine : 1u; nx = cnt > 0u ? cnt : 1u;
}
__device__ __forceinline__ void xcd_barrier(const XcdBarrier& b) {
    asm volatile("s_waitcnt vmcnt(0)" ::: "memory");
    __syncthreads();
    if (threadIdx.x == 0) {
        unsigned* bar = b.bar;
        __builtin_amdgcn_s_waitcnt(0);
        unsigned nloc = b.st[0], nx = b.st[1];
        if (nloc == 0u) { xcd_barrier_complete(bar, b.x, nloc, nx); b.st[0] = nloc; b.st[1] = nx; }
        const unsigned old = xb_add(&bar[XB_XSUB(b.x)], 1u);
        const unsigned gen = old / nloc;
        if (old + 1u == (gen + 1u) * nloc) {
            __builtin_amdgcn_fence(__ATOMIC_RELEASE, "agent");
            asm volatile("s_waitcnt vmcnt(0)" ::: "memory");
            const unsigned og = xb_add(&bar[XB_TOP], 1u);
            const unsigned tg = og / nx;
            if (og + 1u == (tg + 1u) * nx) xb_add(&bar[XB_TOPGEN], 1u);
            else XB_SPIN(xb_ld(&bar[XB_TOPGEN]) == tg, bar);
            __builtin_amdgcn_fence(__ATOMIC_ACQUIRE, "agent");
            xb_add(&bar[XB_XGEN(b.x)], 1u);
            asm volatile("s_waitcnt vmcnt(0)" ::: "memory");
        } else {
            XB_SPIN(xb_ld(&bar[XB_XGEN(b.x)]) == gen, bar);
            __builtin_amdgcn_fence(__ATOMIC_ACQUIRE, "agent");
            asm volatile("s_waitcnt vmcnt(0)" ::: "memory");
        }
    }
    __syncthreads();
}

struct Frame {
    LAS unsigned char* lds;
    volatile LAS unsigned* MISC;
    gu32* ctl;
    unsigned char* ws;
    int tid, lane, wave, vcu, G;
};

__device__ __forceinline__ float wave_sum(float v) {
#pragma unroll
    for (int o = 1; o < 64; o <<= 1) v += __shfl_xor(v, o);
    return v;
}
__device__ __forceinline__ float wave_max(float v) {
#pragma unroll
    for (int o = 1; o < 64; o <<= 1) v = fmaxf(v, __shfl_xor(v, o));
    return v;
}
__device__ __forceinline__ unsigned pk2(float lo, float hi) { return cvtpk(lo, hi); }

template <class Map>
__device__ __forceinline__ void tr_item(const float* W, int Nsrc, int K, const float* kscale, bf16* WT, LAS float* scr, int item, int nblk, int lane, Map map) {
    const int kb = item / nblk, nb = item % nblk, k0 = 64 * kb, n0 = 32 * nb;
    const int sc = map(n0 + (lane & 31));
#pragma unroll 8
    for (int i = 0; i < 32; ++i) { const int kk = 2 * i + (lane >> 5); float v = 0.f; if (sc >= 0) v = W[(size_t)(k0 + kk) * Nsrc + sc]; if (kscale) v *= kscale[k0 + kk]; scr[kk * 33 + (lane & 31)] = v; }
    LDS_WAIT(); asm volatile("" ::: "memory");
    const int c = lane & 7;
#pragma unroll
    for (int j = 0; j < 4; ++j) { const int n = (lane >> 3) + 8 * j; const LAS float* s = scr + (8 * c) * 33 + n;
        v4u o; o.x = pk2(s[0 * 33], s[1 * 33]); o.y = pk2(s[2 * 33], s[3 * 33]); o.z = pk2(s[4 * 33], s[5 * 33]); o.w = pk2(s[6 * 33], s[7 * 33]);
        *(GAS v4u*)(WT + (size_t)(n0 + n) * K + k0 + 8 * c) = o; }
    LDS_WAIT(); asm volatile("" ::: "memory");
}
__device__ __forceinline__ int rope_src(int jj) { return (jj & 1) * 32 + (jj >> 1); }
struct MapW1 { __device__ int operator()(int n) const {
    if (n < 1280) return n;
    if (n < 2304) { const int j = n - 1280; return OFF_DQ + (j & ~63) + rope_src(j & 63); }
    if (n < 3328) { const int j = n - 2304; return OFF_DK + (j & ~63) + rope_src(j & 63); }
    if (n < 4352) return OFF_DV + (n - 3328);
    if (n < 8448) return OFF_GATE + (n - 4352);
    if (n < 8512) return OFF_KR + rope_src(n - 8448);
    return -1; } };
struct MapUQ { __device__ int operator()(int n) const {
    if (n < 1024) return (n >> 7) * 192 + (n & 127);
    const int j = n - 1024; return (j >> 6) * 192 + 128 + rope_src(j & 63); } };
struct MapUKV { __device__ int operator()(int n) const {
    if (n < 1024) return (n >> 7) * 256 + (n & 127);
    const int j = n - 1024; return (j >> 7) * 256 + 128 + (j & 127); } };
struct MapId { __device__ int operator()(int n) const { return n; } };

struct Ins { const float *x, *w_in, *b_gate, *g_norm1, *g_cq, *w_uq, *g_ckv, *w_ukv, *w_o_mla, *lambda_qk, *g_subln, *w_o_diff, *w_out, *g_norm2, *w_q_peer, *sub_keys, *expert_u, *expert_v, *g_final; };

__device__ __forceinline__ void p0_prologue(Frame& F, const Ins& I, const double* inv_freq) {
    LAS float* scr = (LAS float*)(F.lds + RING_OFF + F.wave * 16384);
    const int gw = F.vcu * NWAVES + F.wave, NGW = F.G * NWAVES;
    unsigned char* ws = F.ws;
    constexpr int I_W1 = (2048 / 64) * (N1 / 32), I_UQ = (768 / 64) * (1536 / 32), I_UKV = (512 / 64) * (2048 / 32), I_OM = (1024 / 64) * (2048 / 32), I_OD = I_OM, I_OUT = (2048 / 64) * (2048 / 32), I_QP = I_OUT;
    constexpr int NITEMS = I_W1 + I_UQ + I_UKV + I_OM + I_OD + I_OUT + I_QP;
    for (int it = gw; it < NITEMS; it += NGW) {
        int r = it;
        if (r < I_W1) { tr_item(I.w_in, IN_COLS, 2048, nullptr, (bf16*)(ws + WS_W1), scr, r, N1 / 32, F.lane, MapW1()); continue; } r -= I_W1;
        if (r < I_UQ) { tr_item(I.w_uq, 1536, 768, I.g_cq, (bf16*)(ws + WS_WUQ), scr, r, 1536 / 32, F.lane, MapUQ()); continue; } r -= I_UQ;
        if (r < I_UKV) { tr_item(I.w_ukv, 2048, 512, I.g_ckv, (bf16*)(ws + WS_WUKV), scr, r, 2048 / 32, F.lane, MapUKV()); continue; } r -= I_UKV;
        if (r < I_OM) { tr_item(I.w_o_mla, 2048, 1024, nullptr, (bf16*)(ws + WS_WOM), scr, r, 2048 / 32, F.lane, MapId()); continue; } r -= I_OM;
        if (r < I_OD) { tr_item(I.w_o_diff, 2048, 1024, nullptr, (bf16*)(ws + WS_WOD), scr, r, 2048 / 32, F.lane, MapId()); continue; } r -= I_OD;
        if (r < I_OUT) { tr_item(I.w_out, 2048, 2048, nullptr, (bf16*)(ws + WS_WOUT), scr, r, 2048 / 32, F.lane, MapId()); continue; } r -= I_OUT;
        tr_item(I.w_q_peer, 2048, 2048, I.g_norm2, (bf16*)(ws + WS_WQP), scr, r, 2048 / 32, F.lane, MapId());
    }
    {
        bf16* skb = (bf16*)(ws + WS_SKB);
        for (int e = gw * 64 + F.lane; e < 256 * 256; e += NGW * 64) {
            const int n = e >> 8, k = e & 255; float v = 0.f;
            if (n < 128 && k < 128) v = I.sub_keys[n * 128 + k];
            else if (n >= 128 && k >= 128) v = I.sub_keys[128 * 128 + (n - 128) * 128 + (k - 128)];
            skb[e] = (bf16)(pk2(v, 0.f) & 0xffffu);
        }
    }
    {
        float* rope = (float*)(ws + WS_ROPE);
        for (int e = gw * 64 + F.lane; e < SEQ * 32; e += NGW * 64) {
            const int pos = e >> 5, i = e & 31;
            const double rev = (double)pos * inv_freq[i] * 0.15915494309189535;
            const float fr = (float)(rev - floor(rev));
            rope[2 * e] = __builtin_amdgcn_cosf(fr); rope[2 * e + 1] = __builtin_amdgcn_sinf(fr);
        }
    }
    if (blockIdx.x == 0 && F.tid == 0) {
        float a = 0.f, b = 0.f;
        for (int d = 0; d < 64; ++d) { a += I.lambda_qk[d] * I.lambda_qk[64 + d]; b += I.lambda_qk[128 + d] * I.lambda_qk[192 + d]; }
        const float lam = __expf(a) - __expf(b) + LAMBDA_INIT;
        ((float*)F.ctl)[CW_LAMBDA] = lam;
    }
    {
        bf16* H = (bf16*)(ws + WS_H);
        f32x4 g[8];
#pragma unroll
        for (int j = 0; j < 8; ++j) g[j] = *((const f32x4*)I.g_norm1 + F.lane + 64 * j);
        for (int m = gw; m < T; m += NGW) {
            const GAS f32x4* xr = (const GAS f32x4*)(I.x + (size_t)m * D_MODEL) + F.lane;
            f32x4 v[8]; float s = 0.f;
#pragma unroll
            for (int j = 0; j < 8; ++j) { v[j] = xr[64 * j]; s += (v[j].x * v[j].x + v[j].y * v[j].y) + (v[j].z * v[j].z + v[j].w * v[j].w); }
            const float rstd = 1.0f / sqrtf(wave_sum(s) * (1.f / D_MODEL) + EPS);
            GAS u32x2* o8 = (GAS u32x2*)(H + (size_t)m * D_MODEL) + F.lane;
#pragma unroll
            for (int j = 0; j < 8; ++j) { u32x2 w; w.x = pk2(v[j].x * rstd * g[j].x, v[j].y * rstd * g[j].y); w.y = pk2(v[j].z * rstd * g[j].z, v[j].w * rstd * g[j].w); o8[64 * j] = w; }
        }
    }
}

__device__ __forceinline__ void convert_experts(Frame& F, const Ins& I) {
    const size_t gt = (size_t)(F.vcu * NWAVES * 64) + F.tid, NT = (size_t)F.G * NWAVES * 64;
    const size_t nchunk = (size_t)NEXP * D_MODEL / 8;
    bf16* EU = (bf16*)(F.ws + WS_EU); bf16* EV = (bf16*)(F.ws + WS_EV);
    for (size_t c = gt; c < nchunk; c += NT) {
        const int d = (int)((c * 8) & (D_MODEL - 1));
        const f32x4 a0 = *(const GAS f32x4*)(I.expert_u + c * 8), a1 = *(const GAS f32x4*)(I.expert_u + c * 8 + 4);
        const f32x4 g0 = *(const f32x4*)(I.g_norm2 + d), g1 = *(const f32x4*)(I.g_norm2 + d + 4);
        v4u o; o.x = pk2(a0.x * g0.x, a0.y * g0.y); o.y = pk2(a0.z * g0.z, a0.w * g0.w); o.z = pk2(a1.x * g1.x, a1.y * g1.y); o.w = pk2(a1.z * g1.z, a1.w * g1.w);
        *(GAS v4u*)(EU + c * 8) = o;
        const f32x4 b0 = *(const GAS f32x4*)(I.expert_v + c * 8), b1 = *(const GAS f32x4*)(I.expert_v + c * 8 + 4);
        v4u p; p.x = pk2(b0.x, b0.y); p.y = pk2(b0.z, b0.w); p.z = pk2(b1.x, b1.y); p.w = pk2(b1.z, b1.w);
        *(GAS v4u*)(EV + c * 8) = p;
    }
}

__device__ __forceinline__ float sigmoidf_fast(float x) { return __builtin_amdgcn_rcpf(1.0f + __builtin_amdgcn_exp2f(-x * LOG2E)); }
__device__ __forceinline__ void rope8(f32x4& v0, f32x4& v1, const f32x4 cs0, const f32x4 cs1, float sc) {
    const float a0 = v0[0] * cs0[0] - v0[1] * cs0[1], b0 = v0[1] * cs0[0] + v0[0] * cs0[1];
    const float a1 = v0[2] * cs0[2] - v0[3] * cs0[3], b1 = v0[3] * cs0[2] + v0[2] * cs0[3];
    const float a2 = v1[0] * cs1[0] - v1[1] * cs1[1], b2 = v1[1] * cs1[0] + v1[0] * cs1[1];
    const float a3 = v1[2] * cs1[2] - v1[3] * cs1[3], b3 = v1[3] * cs1[2] + v1[2] * cs1[3];
    v0 = (f32x4){a0 * sc, b0 * sc, a1 * sc, b1 * sc}; v1 = (f32x4){a2 * sc, b2 * sc, a3 * sc, b3 * sc};
}
__device__ __forceinline__ u32x4 pack8(const f32x4 v0, const f32x4 v1) { u32x4 w; w.x = cvtpk(v0[0], v0[1]); w.y = cvtpk(v0[2], v0[3]); w.z = cvtpk(v1[0], v1[1]); w.w = cvtpk(v1[2], v1[3]); return w; }

struct EpiProj {
    static constexpr bool PERM = true;
    bf16_t *CQ, *CKV, *DQ, *DK, *DV, *G, *KR; float *ssq_q, *ssq_kv; const float* bgate; const float* rope;
    __device__ __forceinline__ void operator()(const f32x4 (&acc)[2][2][4][2], const pg8::Unit& u, int wr, int wc, int fr, int fq) const {
        const int row0 = u.pm * 256 + wr * 64 + fr, pn = u.pn, colw = wc * 32 + 8 * fq;
        if (pn < 5) {
            bf16_t* O; int ldc, ct, nsl, sl; float* ssq;
            if (pn < 3) { O = CQ; ldc = 768; ct = pn * 256; ssq = ssq_q; nsl = 12; sl = pn * 4 + wc; } else { O = CKV; ldc = 512; ct = (pn - 3) * 256; ssq = ssq_kv; nsl = 8; sl = (pn - 3) * 4 + wc; }
#pragma unroll
            for (int ai = 0; ai < 2; ++ai)
#pragma unroll
                for (int m = 0; m < 4; ++m) { const int row = row0 + ai * 128 + m * 16; float s = 0.f;
#pragma unroll
                    for (int bj = 0; bj < 2; ++bj) { const f32x4 v0 = acc[ai][bj][m][0], v1 = acc[ai][bj][m][1];
                        s += (v0[0] * v0[0] + v0[1] * v0[1]) + (v0[2] * v0[2] + v0[3] * v0[3]) + (v1[0] * v1[0] + v1[1] * v1[1]) + (v1[2] * v1[2] + v1[3] * v1[3]);
                        *(u32x4*)(O + (size_t)row * ldc + ct + bj * 128 + colw) = pack8(v0, v1); }
                    s += __shfl_xor(s, 16); s += __shfl_xor(s, 32);
                    if (fq == 0) ssq[(size_t)row * nsl + sl] = s; }
        } else if (pn < 13) {
            const bool isq = pn < 9; bf16_t* O = isq ? DQ : DK; const int ct = (pn - (isq ? 5 : 9)) * 256; const float sc = isq ? C2_DIFF : 1.0f;
            const int i0 = ((wc & 1) * 32 + 8 * fq) >> 1;
#pragma unroll
            for (int ai = 0; ai < 2; ++ai)
#pragma unroll
                for (int m = 0; m < 4; ++m) { const int row = row0 + ai * 128 + m * 16; const int pos = row & (SEQ - 1);
                    const f32x4 cs0 = *(const f32x4*)(rope + (size_t)(pos * 32 + i0) * 2), cs1 = *(const f32x4*)(rope + (size_t)(pos * 32 + i0 + 2) * 2);
#pragma unroll
                    for (int bj = 0; bj < 2; ++bj) { f32x4 v0 = acc[ai][bj][m][0], v1 = acc[ai][bj][m][1]; rope8(v0, v1, cs0, cs1, sc);
                        *(u32x4*)(O + (size_t)row * 1024 + ct + bj * 128 + colw) = pack8(v0, v1); } }
        } else if (pn < 17) {
            const int ct = (pn - 13) * 256;
#pragma unroll
            for (int ai = 0; ai < 2; ++ai)
#pragma unroll
                for (int m = 0; m < 4; ++m) { const int row = row0 + ai * 128 + m * 16;
#pragma unroll
                    for (int bj = 0; bj < 2; ++bj) *(u32x4*)(DV + (size_t)row * 1024 + ct + bj * 128 + colw) = pack8(acc[ai][bj][m][0], acc[ai][bj][m][1]); }
        } else if (pn < 33) {
            const int ct = (pn - 17) * 256;
            f32x4 bv[2][2];
#pragma unroll
            for (int bj = 0; bj < 2; ++bj) { bv[bj][0] = *(const f32x4*)(bgate + ct + bj * 128 + colw); bv[bj][1] = *(const f32x4*)(bgate + ct + bj * 128 + colw + 4); }
#pragma unroll
            for (int ai = 0; ai < 2; ++ai)
#pragma unroll
                for (int m = 0; m < 4; ++m) { const int row = row0 + ai * 128 + m * 16;
#pragma unroll
                    for (int bj = 0; bj < 2; ++bj) { f32x4 v0 = acc[ai][bj][m][0] + bv[bj][0], v1 = acc[ai][bj][m][1] + bv[bj][1];
#pragma unroll
                        for (int e = 0; e < 4; ++e) { v0[e] = sigmoidf_fast(v0[e]); v1[e] = sigmoidf_fast(v1[e]); }
                        *(u32x4*)(G + (size_t)row * 4096 + ct + bj * 128 + colw) = pack8(v0, v1); } }
        } else {
            if (wc < 2) {
                const int i0 = colw >> 1;
#pragma unroll
                for (int ai = 0; ai < 2; ++ai)
#pragma unroll
                    for (int m = 0; m < 4; ++m) { const int row = row0 + ai * 128 + m * 16; const int pos = row & (SEQ - 1);
                        const f32x4 cs0 = *(const f32x4*)(rope + (size_t)(pos * 32 + i0) * 2), cs1 = *(const f32x4*)(rope + (size_t)(pos * 32 + i0 + 2) * 2);
                        f32x4 v0 = acc[ai][0][m][0], v1 = acc[ai][0][m][1]; rope8(v0, v1, cs0, cs1, 1.0f);
                        *(u32x4*)(KR + (size_t)row * 64 + colw) = pack8(v0, v1); }
            }
        }
    }
};

struct EpiQup {
    static constexpr bool PERM = true;
    bf16_t *QN, *QR; const float* ssq; const float* rope;
    __device__ __forceinline__ void operator()(const f32x4 (&acc)[2][2][4][2], const pg8::Unit& u, int wr, int wc, int fr, int fq) const {
        const int row0 = u.pm * 256 + wr * 64 + fr, pn = u.pn, colw = wc * 32 + 8 * fq;
        const int i0 = ((wc & 1) * 32 + 8 * fq) >> 1;
#pragma unroll
        for (int ai = 0; ai < 2; ++ai)
#pragma unroll
            for (int m = 0; m < 4; ++m) { const int row = row0 + ai * 128 + m * 16; const int pos = row & (SEQ - 1);
                const f32x4 q0 = *(const f32x4*)(ssq + (size_t)row * 12), q1 = *(const f32x4*)(ssq + (size_t)row * 12 + 4), q2 = *(const f32x4*)(ssq + (size_t)row * 12 + 8);
                const float sq = (((q0[0] + q0[1]) + (q0[2] + q0[3])) + ((q1[0] + q1[1]) + (q1[2] + q1[3]))) + ((q2[0] + q2[1]) + (q2[2] + q2[3]));
                const float sc = C2_MLA / sqrtf(sq * (1.0f / 768.0f) + EPS);
                if (pn < 4) {
#pragma unroll
                    for (int bj = 0; bj < 2; ++bj) *(u32x4*)(QN + (size_t)row * 1024 + pn * 256 + bj * 128 + colw) = pack8(acc[ai][bj][m][0] * sc, acc[ai][bj][m][1] * sc);
                } else {
                    const f32x4 cs0 = *(const f32x4*)(rope + (size_t)(pos * 32 + i0) * 2), cs1 = *(const f32x4*)(rope + (size_t)(pos * 32 + i0 + 2) * 2);
#pragma unroll
                    for (int bj = 0; bj < 2; ++bj) { f32x4 v0 = acc[ai][bj][m][0], v1 = acc[ai][bj][m][1]; rope8(v0, v1, cs0, cs1, sc);
                        *(u32x4*)(QR + (size_t)row * 512 + (pn - 4) * 256 + bj * 128 + colw) = pack8(v0, v1); }
                } }
    }
};
struct EpiKVup {
    static constexpr bool PERM = true;
    bf16_t *KN, *V; const float* ssq;
    __device__ __forceinline__ void operator()(const f32x4 (&acc)[2][2][4][2], const pg8::Unit& u, int wr, int wc, int fr, int fq) const {
        const int row0 = u.pm * 256 + wr * 64 + fr, pn = u.pn, colw = wc * 32 + 8 * fq;
        bf16_t* O = pn < 4 ? KN : V; const int ct = (pn & 3) * 256;
#pragma unroll
        for (int ai = 0; ai < 2; ++ai)
#pragma unroll
            for (int m = 0; m < 4; ++m) { const int row = row0 + ai * 128 + m * 16;
                const f32x4 q0 = *(const f32x4*)(ssq + (size_t)row * 8), q1 = *(const f32x4*)(ssq + (size_t)row * 8 + 4);
                const float sq = ((q0[0] + q0[1]) + (q0[2] + q0[3])) + ((q1[0] + q1[1]) + (q1[2] + q1[3]));
                const float sc = 1.0f / sqrtf(sq * (1.0f / 512.0f) + EPS);
#pragma unroll
                for (int bj = 0; bj < 2; ++bj) *(u32x4*)(O + (size_t)row * 1024 + ct + bj * 128 + colw) = pack8(acc[ai][bj][m][0] * sc, acc[ai][bj][m][1] * sc); }
    }
};
struct EpiGate {
    static constexpr bool PERM = true;
    const bf16_t* G; bf16_t* TMP; bf16_t* MG; int second;
    __device__ __forceinline__ void operator()(const f32x4 (&acc)[2][2][4][2], const pg8::Unit& u, int wr, int wc, int fr, int fq) const {
        const int row0 = u.pm * 256 + wr * 64 + fr, colw = u.pn * 256 + wc * 32 + 8 * fq;
#pragma unroll
        for (int ai = 0; ai < 2; ++ai)
#pragma unroll
            for (int m = 0; m < 4; ++m) { const int row = row0 + ai * 128 + m * 16;
#pragma unroll
                for (int bj = 0; bj < 2; ++bj) { const int col = colw + bj * 128;
                    const u32x4 gw = *(const u32x4*)(G + (size_t)row * 4096 + (second ? 2048 : 0) + col);
                    f32x4 v0 = acc[ai][bj][m][0], v1 = acc[ai][bj][m][1];
                    v0 = (f32x4){v0[0] * bflo(gw.x), v0[1] * bfhi(gw.x), v0[2] * bflo(gw.y), v0[3] * bfhi(gw.y)};
                    v1 = (f32x4){v1[0] * bflo(gw.z), v1[1] * bfhi(gw.z), v1[2] * bflo(gw.w), v1[3] * bfhi(gw.w)};
                    if (second) { const u32x4 tw = *(const u32x4*)(TMP + (size_t)row * 2048 + col);
                        v0 += (f32x4){bflo(tw.x), bfhi(tw.x), bflo(tw.y), bfhi(tw.y)}; v1 += (f32x4){bflo(tw.z), bfhi(tw.z), bflo(tw.w), bfhi(tw.w)};
                        *(u32x4*)(MG + (size_t)row * 2048 + col) = pack8(v0, v1);
                    } else *(u32x4*)(TMP + (size_t)row * 2048 + col) = pack8(v0, v1); } }
    }
};
struct EpiRes {
    static constexpr bool PERM = false;
    const float* x; float* X2; bf16_t* X2B; float* ssq;
    __device__ __forceinline__ void operator()(const f32x4 (&acc)[2][2][4][2], const pg8::Unit& u, int wr, int wc, int fr, int fq) const {
        const int row0 = u.pm * 256 + wr * 64 + fr, col0 = u.pn * 256 + wc * 32 + 4 * fq;
#pragma unroll
        for (int ai = 0; ai < 2; ++ai)
#pragma unroll
            for (int m = 0; m < 4; ++m) { const int row = row0 + ai * 128 + m * 16; float s = 0.f;
#pragma unroll
                for (int bj = 0; bj < 2; ++bj)
#pragma unroll
                    for (int n = 0; n < 2; ++n) { const size_t off = (size_t)row * 2048 + col0 + bj * 128 + n * 16;
                        const f32x4 v = acc[ai][bj][m][n] + *(const f32x4*)(x + off);
                        s += (v[0] * v[0] + v[1] * v[1]) + (v[2] * v[2] + v[3] * v[3]);
                        *(f32x4*)(X2 + off) = v; u32x2 w; w.x = cvtpk(v[0], v[1]); w.y = cvtpk(v[2], v[3]); *(u32x2*)(X2B + off) = w; }
                s += __shfl_xor(s, 16); s += __shfl_xor(s, 32);
                if (fq == 0) ssq[(size_t)row * 32 + u.pn * 4 + wc] = s; }
    }
};
__device__ __forceinline__ float sum32(const float* p) { float t = 0.f;
#pragma unroll
    for (int i = 0; i < 8; ++i) { const f32x4 q = *(const f32x4*)(p + 4 * i); t += (q[0] + q[1]) + (q[2] + q[3]); } return t; }
struct EpiQP {
    static constexpr bool PERM = true;
    bf16_t* QP; const float* ssq;
    __device__ __forceinline__ void operator()(const f32x4 (&acc)[2][2][4][2], const pg8::Unit& u, int wr, int wc, int fr, int fq) const {
        const int row0 = u.pm * 256 + wr * 64 + fr, colw = u.pn * 256 + wc * 32 + 8 * fq;
#pragma unroll
        for (int ai = 0; ai < 2; ++ai)
#pragma unroll
            for (int m = 0; m < 4; ++m) { const int row = row0 + ai * 128 + m * 16;
                const float sc = 1.0f / sqrtf(sum32(ssq + (size_t)row * 32) * (1.0f / 2048.0f) + EPS);
#pragma unroll
                for (int bj = 0; bj < 2; ++bj) *(u32x4*)(QP + (size_t)row * 2048 + colw + bj * 128) = pack8(acc[ai][bj][m][0] * sc, acc[ai][bj][m][1] * sc); }
    }
};

__device__ __forceinline__ void naive_attn(LAS float* qs, const bf16* qa, int ldqa, int da, const bf16* qb, int ldqb, int db,
                                           const bf16* ka, int ldka, const bf16* kb, int ldkb, const bf16* v, int ldv,
                                           size_t rowbase, int p0, int lane, float (&o)[4][2], float (&linv)[4]) {
    const int dt = da + db;
    for (int idx = lane; idx < 4 * dt; idx += 64) { const int r = idx / dt, d = idx - r * dt;
        const bf16 h = d < da ? qa[(rowbase + p0 + r) * ldqa + d] : qb[(rowbase + p0 + r) * ldqb + (d - da)];
        qs[r * 192 + d] = bf2f(h); }
    LDS_WAIT(); asm volatile("" ::: "memory");
    float m[4], l[4];
#pragma unroll
    for (int r = 0; r < 4; ++r) { m[r] = -INFINITY; l[r] = 0.f; o[r][0] = 0.f; o[r][1] = 0.f; }
    const int pmax = p0 + 3, ntile = pmax / 64 + 1;
#pragma unroll 1
    for (int kt = 0; kt < ntile; ++kt) {
        const int key = kt * 64 + lane, kc = key < pmax ? key : pmax;
        float s[4] = {0.f, 0.f, 0.f, 0.f};
        const bf16* kra = ka + (rowbase + kc) * ldka;
#pragma unroll 2
        for (int d = 0; d < da; d += 8) { const u32x4 kw = *(const u32x4*)(kra + d);
            const float k0 = bflo(kw.x), k1 = bfhi(kw.x), k2 = bflo(kw.y), k3 = bfhi(kw.y), k4 = bflo(kw.z), k5 = bfhi(kw.z), k6 = bflo(kw.w), k7 = bfhi(kw.w);
#pragma unroll
            for (int r = 0; r < 4; ++r) { const f32x4 qa4 = *(const LAS f32x4*)(qs + r * 192 + d), qb4 = *(const LAS f32x4*)(qs + r * 192 + d + 4);
                s[r] += (qa4[0] * k0 + qa4[1] * k1) + (qa4[2] * k2 + qa4[3] * k3) + (qb4[0] * k4 + qb4[1] * k5) + (qb4[2] * k6 + qb4[3] * k7); } }
        if (db > 0) { const bf16* krb = kb + (rowbase + kc) * ldkb;
#pragma unroll 2
            for (int d = 0; d < db; d += 8) { const u32x4 kw = *(const u32x4*)(krb + d);
                const float k0 = bflo(kw.x), k1 = bfhi(kw.x), k2 = bflo(kw.y), k3 = bfhi(kw.y), k4 = bflo(kw.z), k5 = bfhi(kw.z), k6 = bflo(kw.w), k7 = bfhi(kw.w);
#pragma unroll
                for (int r = 0; r < 4; ++r) { const f32x4 qa4 = *(const LAS f32x4*)(qs + r * 192 + da + d), qb4 = *(const LAS f32x4*)(qs + r * 192 + da + d + 4);
                    s[r] += (qa4[0] * k0 + qa4[1] * k1) + (qa4[2] * k2 + qa4[3] * k3) + (qb4[0] * k4 + qb4[1] * k5) + (qb4[2] * k6 + qb4[3] * k7); } } }
        float p[4];
#pragma unroll
        for (int r = 0; r < 4; ++r) {
            const float sv = key > p0 + r ? -INFINITY : s[r];
            const float mn = fmaxf(m[r], wave_max(sv));
            const float al = __builtin_amdgcn_exp2f(m[r] - mn);
            p[r] = __builtin_amdgcn_exp2f(sv - mn);
            l[r] = l[r] * al + wave_sum(p[r]); o[r][0] *= al; o[r][1] *= al; m[r] = mn;
        }
        const int jn = (pmax - kt * 64) < 63 ? (pmax - kt * 64) : 63;
#pragma unroll 4
        for (int j = 0; j <= jn; ++j) {
            const bf16* vr = v + (rowbase + kt * 64 + j) * ldv;
            const float v0 = bf2f(vr[lane]), v1 = bf2f(vr[64 + lane]);
#pragma unroll
            for (int r = 0; r < 4; ++r) { const float pj = __builtin_bit_cast(float, __builtin_amdgcn_readlane(__builtin_bit_cast(int, p[r]), j)); o[r][0] += pj * v0; o[r][1] += pj * v1; }
        }
    }
#pragma unroll
    for (int r = 0; r < 4; ++r) linv[r] = 1.0f / l[r];
    LDS_WAIT(); asm volatile("" ::: "memory");
}
__device__ __forceinline__ void p3_attention_ref(Frame& F, const Ins& I) {
    unsigned char* ws = F.ws;
    const bf16 *QN = (const bf16*)(ws + WS_QN), *QR = (const bf16*)(ws + WS_QR), *KN = (const bf16*)(ws + WS_KN), *KR = (const bf16*)(ws + WS_KR), *V = (const bf16*)(ws + WS_V);
    const bf16 *DQ = (const bf16*)(ws + WS_DQ), *DK = (const bf16*)(ws + WS_DK), *DV = (const bf16*)(ws + WS_DV);
    bf16 *OM = (bf16*)(ws + WS_OM), *OD = (bf16*)(ws + WS_OD);
    LAS float* qs = (LAS float*)(F.lds + RING_OFF + F.wave * 4096);
    const int gw = F.vcu * NWAVES + F.wave, NGW = F.G * NWAVES, lane = F.lane;
    const float lam = ((const float*)F.ctl)[CW_LAMBDA];
    const float gs0 = I.g_subln[lane] * (1.0f - LAMBDA_INIT), gs1 = I.g_subln[64 + lane] * (1.0f - LAMBDA_INIT);
    for (int it = gw; it < 2 * 16 * (SEQ / 4); it += NGW) {
        const int type = it & 1, rest = it >> 1, bh = rest & 15, g = rest >> 4, b = bh >> 3, h = bh & 7, p0 = 4 * g;
        const size_t rowbase = (size_t)b * SEQ;
        float o[4][2], li[4];
        if (type == 0) {
            naive_attn(qs, QN + h * 128, 1024, 128, QR + h * 64, 512, 64, KN + h * 128, 1024, KR, 64, V + h * 128, 1024, rowbase, p0, lane, o, li);
#pragma unroll
            for (int r = 0; r < 4; ++r) { bf16* orow = OM + (rowbase + p0 + r) * 1024 + h * 128;
                orow[lane] = (bf16)(pk2(o[r][0] * li[r], 0.f) & 0xffffu); orow[64 + lane] = (bf16)(pk2(o[r][1] * li[r], 0.f) & 0xffffu); }
        } else {
            float o2[4][2], li2[4];
            naive_attn(qs, DQ + (h * 2) * 64, 1024, 64, DQ, 1024, 0, DK + (h * 2) * 64, 1024, DK, 1024, DV + h * 128, 1024, rowbase, p0, lane, o, li);
            naive_attn(qs, DQ + (h * 2 + 1) * 64, 1024, 64, DQ, 1024, 0, DK + (h * 2 + 1) * 64, 1024, DK, 1024, DV + h * 128, 1024, rowbase, p0, lane, o2, li2);
#pragma unroll
            for (int r = 0; r < 4; ++r) {
                const float d0 = o[r][0] * li[r] - lam * o2[r][0] * li2[r], d1 = o[r][1] * li[r] - lam * o2[r][1] * li2[r];
                const float rs = 1.0f / sqrtf(wave_sum(d0 * d0 + d1 * d1) * (1.0f / 128.0f) + EPS);
                bf16* orow = OD + (rowbase + p0 + r) * 1024 + h * 128;
                orow[lane] = (bf16)(pk2(d0 * rs * gs0, 0.f) & 0xffffu); orow[64 + lane] = (bf16)(pk2(d1 * rs * gs1, 0.f) & 0xffffu); }
        }
    }
}

__device__ __forceinline__ void wave_argmax(float v, int idx, float& mv, int& mi) {
#pragma unroll
    for (int o = 1; o < 64; o <<= 1) { const float ov = __shfl_xor(v, o); const int oi = __shfl_xor(idx, o); if (ov > v || (ov == v && oi < idx)) { v = ov; idx = oi; } }
    mv = v; mi = idx;
}
__device__ __forceinline__ void p7_routing_ref(Frame& F) {
    unsigned char* ws = F.ws;
    const bf16* QP = (const bf16*)(ws + WS_QP); const bf16* SKB = (const bf16*)(ws + WS_SKB);
    int* IDX = (int*)(ws + WS_IDX); float* GT = (float*)(ws + WS_GT);
    LAS float* wl = (LAS float*)(F.lds + RING_OFF + F.wave * 4096);
    LAS float* qs = wl; LAS float* v1s = wl + 256; LAS int* i1s = (LAS int*)(wl + 272); LAS float* v2s = wl + 288; LAS int* i2s = (LAS int*)(wl + 304);
    const int gw = F.vcu * NWAVES + F.wave, NGW = F.G * NWAVES, lane = F.lane;
    for (int it = gw; it < T * 8; it += NGW) {
        { const u32x2 w = *(const u32x2*)(QP + (size_t)it * 256 + lane * 4); qs[lane * 4 + 0] = bflo(w.x); qs[lane * 4 + 1] = bfhi(w.x); qs[lane * 4 + 2] = bflo(w.y); qs[lane * 4 + 3] = bfhi(w.y); }
        LDS_WAIT(); asm volatile("" ::: "memory");
        float sc[2][2];
#pragma unroll
        for (int hf = 0; hf < 2; ++hf)
#pragma unroll
            for (int kk = 0; kk < 2; ++kk) { const bf16* kr = SKB + (size_t)(hf * 128 + kk * 64 + lane) * 256 + hf * 128; float s = 0.f;
#pragma unroll 4
                for (int d = 0; d < 128; d += 8) { const u32x4 kw = *(const u32x4*)(kr + d);
                    const f32x4 qa4 = *(const LAS f32x4*)(qs + hf * 128 + d), qb4 = *(const LAS f32x4*)(qs + hf * 128 + d + 4);
                    s += (qa4[0] * bflo(kw.x) + qa4[1] * bfhi(kw.x)) + (qa4[2] * bflo(kw.y) + qa4[3] * bfhi(kw.y)) + (qb4[0] * bflo(kw.z) + qb4[1] * bfhi(kw.z)) + (qb4[2] * bflo(kw.w) + qb4[3] * bfhi(kw.w)); }
                sc[hf][kk] = s; }
#pragma unroll
        for (int hf = 0; hf < 2; ++hf) {
            float a = sc[hf][0], b = sc[hf][1];
            for (int r = 0; r < 16; ++r) {
                float lv; int li; if (b > a) { lv = b; li = lane + 64; } else { lv = a; li = lane; }
                float mv; int mi; wave_argmax(lv, li, mv, mi);
                if (mi == lane) a = -INFINITY; if (mi == lane + 64) b = -INFINITY;
                if (lane == 0) { if (hf == 0) { v1s[r] = mv; i1s[r] = mi; } else { v2s[r] = mv; i2s[r] = mi; } }
            }
        }
        LDS_WAIT(); asm volatile("" ::: "memory");
        float cv[4];
#pragma unroll
        for (int j = 0; j < 4; ++j) { const int c = lane * 4 + j; cv[j] = v1s[c >> 4] + v2s[c & 15]; }
        float mycs = 0.f; int myc = 0;
        for (int r = 0; r < 16; ++r) {
            float lv = cv[0]; int li = lane * 4;
#pragma unroll
            for (int j = 1; j < 4; ++j) if (cv[j] > lv) { lv = cv[j]; li = lane * 4 + j; }
            float mv; int mi; wave_argmax(lv, li, mv, mi);
#pragma unroll
            for (int j = 0; j < 4; ++j) if (mi == lane * 4 + j) cv[j] = -INFINITY;
            if (lane == r) { mycs = mv; myc = mi; }
        }
        float mx = mycs;
#pragma unroll
        for (int o = 1; o < 16; o <<= 1) mx = fmaxf(mx, __shfl_xor(mx, o));
        const float e = __expf(mycs - mx); float se = e;
#pragma unroll
        for (int o = 1; o < 16; o <<= 1) se += __shfl_xor(se, o);
        if (lane < 16) { const int ex = i1s[myc >> 4] * 128 + i2s[myc & 15];
            IDX[(size_t)it * 16 + lane] = ex; GT[(size_t)it * 16 + lane] = e / se; }
        LDS_WAIT(); asm volatile("" ::: "memory");
    }
}

__device__ __forceinline__ void unpack8(const u32x4 w, float (&f)[8]) { f[0] = bflo(w.x); f[1] = bfhi(w.x); f[2] = bflo(w.y); f[3] = bfhi(w.y); f[4] = bflo(w.z); f[5] = bfhi(w.z); f[6] = bflo(w.w); f[7] = bfhi(w.w); }
__device__ __forceinline__ void p8_gather(Frame& F, const Ins& I, float* out) {
    unsigned char* ws = F.ws;
    const float* X2 = (const float*)(ws + WS_X2); const bf16* EU = (const bf16*)(ws + WS_EU); const bf16* EV = (const bf16*)(ws + WS_EV);
    const int* IDX = (const int*)(ws + WS_IDX); const float* GT = (const float*)(ws + WS_GT);
    const float* ssq2 = (const float*)(ws + WS_PSQ2);
    const int gw = F.vcu * NWAVES + F.wave, NGW = F.G * NWAVES, lane = F.lane;
    for (int t = gw; t < T; t += NGW) {
        float xv[4][8], acc[4][8];
#pragma unroll
        for (int j = 0; j < 4; ++j) { const f32x4 a = *(const f32x4*)(X2 + (size_t)t * 2048 + 512 * j + 8 * lane), b = *(const f32x4*)(X2 + (size_t)t * 2048 + 512 * j + 8 * lane + 4);
            xv[j][0] = a[0]; xv[j][1] = a[1]; xv[j][2] = a[2]; xv[j][3] = a[3]; xv[j][4] = b[0]; xv[j][5] = b[1]; xv[j][6] = b[2]; xv[j][7] = b[3];
#pragma unroll
            for (int e = 0; e < 8; ++e) acc[j][e] = 0.f; }
        const float rstd2 = 1.0f / sqrtf(sum32(ssq2 + (size_t)t * 32) * (1.0f / 2048.0f) + EPS);
        const int id0 = IDX[(size_t)t * 128 + lane], id1 = IDX[(size_t)t * 128 + 64 + lane];
        const float g0 = GT[(size_t)t * 128 + lane], g1 = GT[(size_t)t * 128 + 64 + lane];
        for (int i = 0; i < 128; ++i) {
            const int ex = __builtin_amdgcn_readlane(i < 64 ? id0 : id1, i & 63);
            const float gate = __builtin_bit_cast(float, __builtin_amdgcn_readlane(__builtin_bit_cast(int, i < 64 ? g0 : g1), i & 63));
            const bf16* ur = EU + (size_t)ex * 2048 + 8 * lane; const bf16* vr = EV + (size_t)ex * 2048 + 8 * lane;
            u32x4 uw[4], vw[4];
#pragma unroll
            for (int j = 0; j < 4; ++j) { uw[j] = *(const u32x4*)(ur + 512 * j); vw[j] = *(const u32x4*)(vr + 512 * j); }
            float dot = 0.f;
#pragma unroll
            for (int j = 0; j < 4; ++j) { float f[8]; unpack8(uw[j], f);
#pragma unroll
                for (int e = 0; e < 8; ++e) dot += f[e] * xv[j][e]; }
            const float a = wave_sum(dot) * rstd2;
            const float z2 = 1.5957691216057308f * (a + 0.044715f * a * a * a);
            const float w = gate * a * __builtin_amdgcn_rcpf(1.0f + __builtin_amdgcn_exp2f(-z2 * LOG2E));
#pragma unroll
            for (int j = 0; j < 4; ++j) { float f[8]; unpack8(vw[j], f);
#pragma unroll
                for (int e = 0; e < 8; ++e) acc[j][e] += w * f[e]; }
        }
        float s = 0.f;
#pragma unroll
        for (int j = 0; j < 4; ++j)
#pragma unroll
            for (int e = 0; e < 8; ++e) { acc[j][e] += xv[j][e]; s += acc[j][e] * acc[j][e]; }
        const float rs = 1.0f / sqrtf(wave_sum(s) * (1.0f / 2048.0f) + EPS);
#pragma unroll
        for (int j = 0; j < 4; ++j) { const f32x4 ga = *(const f32x4*)(I.g_final + 512 * j + 8 * lane), gb = *(const f32x4*)(I.g_final + 512 * j + 8 * lane + 4);
            *(f32x4*)(out + (size_t)t * 2048 + 512 * j + 8 * lane) = (f32x4){acc[j][0] * rs * ga[0], acc[j][1] * rs * ga[1], acc[j][2] * rs * ga[2], acc[j][3] * rs * ga[3]};
            *(f32x4*)(out + (size_t)t * 2048 + 512 * j + 8 * lane + 4) = (f32x4){acc[j][4] * rs * gb[0], acc[j][5] * rs * gb[1], acc[j][6] * rs * gb[2], acc[j][7] * rs * gb[3]}; }
    }
}

constexpr int NPHASE = 10;
struct Args { Ins in; float* out; unsigned char* ws; double inv_freq[32]; int ph_lo, ph_hi; };
__global__ void __launch_bounds__(NWAVES * 64, 2) mega_fwd(Args args) {
    extern __shared__ __attribute__((aligned(16))) unsigned char lds[];
    Frame F;
    F.lds = (LAS unsigned char*)lds;
    F.MISC = (volatile LAS unsigned*)(F.lds + MISC_OFF);
    F.tid = threadIdx.x; F.lane = F.tid & 63; F.wave = __builtin_amdgcn_readfirstlane(F.tid >> 6);
    F.G = gridDim.x; { const int bx = blockIdx.x; F.vcu = (F.G % 8 == 0) ? (bx % 8) * (F.G / 8) + bx / 8 : bx; }
    unsigned char* ws = args.ws; F.ws = ws;
    F.ctl = (gu32*)(ws + WS_CTL);
    const Ins& I = args.in;
    for (int u = F.tid; u < (LDS_BYTES - LDSCTL_OFF) / 4; u += NWAVES * 64) ((LAS unsigned*)(F.lds + LDSCTL_OFF))[u] = 0u;
    __syncthreads();
    XcdBarrier bar; bar.bar = (unsigned*)(F.ctl + CW_BAR); bar.x = 0; bar.st = nullptr;
#if MK_N_LAUNCHES == 1
    bar = xcd_barrier_post((unsigned*)(F.ctl + CW_BAR), F.MISC + 8);
#define GRID_BAR() xcd_barrier(bar)
#else
#define GRID_BAR() do {} while (0)
#endif
    const int lo = args.ph_lo, hi = args.ph_hi;
#ifndef PH_MASK
#define PH_MASK 0xFFFF
#endif
#define IN(k) (((PH_MASK >> (k)) & 1) && lo <= (k) && (k) < hi)
#define BOTH(k) (IN(k) && IN((k) + 1))
    float* ssq_q = (float*)(ws + WS_PSQ_Q); float* ssq_kv = (float*)(ws + WS_PSQ_KV); float* ssq2 = (float*)(ws + WS_PSQ2);
    const float* rope = (const float*)(ws + WS_ROPE);

    if (IN(0)) { p0_prologue(F, I, args.inv_freq); if (BOTH(0)) GRID_BAR(); }

    if (IN(1)) {
        pg8::Gemm g{(const bf16_t*)(ws + WS_H), (const bf16_t*)(ws + WS_W1), T, N1, 2048, 2048}; pg8::StaticOrder S; S.init(T, N1, F.G, (int)blockIdx.x);
        EpiProj E{(bf16_t*)(ws + WS_CQ), (bf16_t*)(ws + WS_CKV), (bf16_t*)(ws + WS_DQ), (bf16_t*)(ws + WS_DK), (bf16_t*)(ws + WS_DV), (bf16_t*)(ws + WS_G), (bf16_t*)(ws + WS_KR), ssq_q, ssq_kv, I.b_gate, rope};
        pg8::gemm_phase<EpiProj, pg8::StaticOrder, PG8_ALIGN, PG8_SP2>(F.lds + RING_OFF, g, S, E);
        if (BOTH(1)) GRID_BAR();
    }
    if (IN(2)) {
        { pg8::Gemm g{(const bf16_t*)(ws + WS_CQ), (const bf16_t*)(ws + WS_WUQ), T, 1536, 768, 768}; pg8::StaticOrder S; S.init(T, 1536, F.G, (int)blockIdx.x);
          EpiQup E{(bf16_t*)(ws + WS_QN), (bf16_t*)(ws + WS_QR), ssq_q, rope};
          pg8::gemm_phase<EpiQup, pg8::StaticOrder, PG8_ALIGN, PG8_SP2>(F.lds + RING_OFF, g, S, E); }
        { pg8::Gemm g{(const bf16_t*)(ws + WS_CKV), (const bf16_t*)(ws + WS_WUKV), T, 2048, 512, 512}; pg8::StaticOrder S; S.init(T, 2048, F.G, (int)blockIdx.x);
          EpiKVup E{(bf16_t*)(ws + WS_KN), (bf16_t*)(ws + WS_V), ssq_kv};
          pg8::gemm_phase<EpiKVup, pg8::StaticOrder, PG8_ALIGN, PG8_SP2>(F.lds + RING_OFF, g, S, E); }
        if (BOTH(2)) GRID_BAR();
    }
    if (IN(3)) { p3_attention_ref(F, I); if (BOTH(3)) GRID_BAR(); }
    if (IN(4)) {
        pg8::Gemm g{(const bf16_t*)(ws + WS_OM), (const bf16_t*)(ws + WS_WOM), T, 2048, 1024, 1024}; pg8::StaticOrder S; S.init(T, 2048, F.G, (int)blockIdx.x);
        EpiGate E{(const bf16_t*)(ws + WS_G), (bf16_t*)(ws + WS_TMP), (bf16_t*)(ws + WS_MG), 0};
        pg8::gemm_phase<EpiGate, pg8::StaticOrder, PG8_ALIGN, PG8_SP2>(F.lds + RING_OFF, g, S, E);
        if (BOTH(4)) GRID_BAR();
    }
    if (IN(5)) {
        pg8::Gemm g{(const bf16_t*)(ws + WS_OD), (const bf16_t*)(ws + WS_WOD), T, 2048, 1024, 1024}; pg8::StaticOrder S; S.init(T, 2048, F.G, (int)blockIdx.x);
        EpiGate E{(const bf16_t*)(ws + WS_G), (bf16_t*)(ws + WS_TMP), (bf16_t*)(ws + WS_MG), 1};
        pg8::gemm_phase<EpiGate, pg8::StaticOrder, PG8_ALIGN, PG8_SP2>(F.lds + RING_OFF, g, S, E);
        if (BOTH(5)) GRID_BAR();
    }
    if (IN(6)) {
        convert_experts(F, I);
        pg8::Gemm g{(const bf16_t*)(ws + WS_MG), (const bf16_t*)(ws + WS_WOUT), T, 2048, 2048, 2048}; pg8::StaticOrder S; S.init(T, 2048, F.G, (int)blockIdx.x);
        EpiRes E{I.x, (float*)(ws + WS_X2), (bf16_t*)(ws + WS_X2B), ssq2};
        pg8::gemm_phase<EpiRes, pg8::StaticOrder, PG8_ALIGN, PG8_SP2>(F.lds + RING_OFF, g, S, E);
        if (BOTH(6)) GRID_BAR();
    }
    if (IN(7)) {
        pg8::Gemm g{(const bf16_t*)(ws + WS_X2B), (const bf16_t*)(ws + WS_WQP), T, 2048, 2048, 2048}; pg8::StaticOrder S; S.init(T, 2048, F.G, (int)blockIdx.x);
        EpiQP E{(bf16_t*)(ws + WS_QP), ssq2};
        pg8::gemm_phase<EpiQP, pg8::StaticOrder, PG8_ALIGN, PG8_SP2>(F.lds + RING_OFF, g, S, E);
        if (BOTH(7)) GRID_BAR();
    }
    if (IN(8)) { p7_routing_ref(F); if (BOTH(8)) GRID_BAR(); }
    if (IN(9)) { p8_gather(F, I, args.out); }
#undef IN
#undef BOTH
}

extern "C" void kernel_launch(void* const* d_in, const int* in_sizes, int n_in, void* d_out, int out_size, void* d_ws, size_t ws_size, hipStream_t stream) {
    static int grid = 0;
    if (grid == 0) {
        if (n_in != 19 || out_size != T * D_MODEL || ws_size < WS_END) { fprintf(stderr, "kernel_launch: unexpected shapes: n_in %d out %d ws %zu\n", n_in, out_size, ws_size); grid = -1; return; }
        int dev = 0, cus = 0, per_cu = 0;
        if (hipGetDevice(&dev) != hipSuccess || hipDeviceGetAttribute(&cus, hipDeviceAttributeMultiprocessorCount, dev) != hipSuccess) { grid = -1; return; }
        if (hipFuncSetAttribute((const void*)mega_fwd, hipFuncAttributeMaxDynamicSharedMemorySize, LDS_BYTES) != hipSuccess) { fprintf(stderr, "kernel_launch: hipFuncSetAttribute failed\n"); grid = -1; return; }
        if (hipOccupancyMaxActiveBlocksPerMultiprocessor(&per_cu, (const void*)mega_fwd, NWAVES * 64, LDS_BYTES) != hipSuccess || per_cu < 1)
            fprintf(stderr, "kernel_launch: occupancy query reports %d workgroups per CU\n", per_cu);
        (void)hipGetLastError();
        grid = cus;
    }
    if (grid < 0) return;
    if (hipMemsetAsync((char*)d_ws + WS_CTL, 0, CTL_ZERO_BYTES, stream) != hipSuccess) { fprintf(stderr, "kernel_launch: memset failed\n"); return; }
    Args a{};
    const float** ip = (const float**)&a.in;
    for (int i = 0; i < 19; ++i) ip[i] = (const float*)d_in[i];
    a.out = (float*)d_out; a.ws = (unsigned char*)d_ws;
    for (int i = 0; i < 32; ++i) a.inv_freq[i] = pow(10000.0, -(double)i / 32.0);
#if MK_N_LAUNCHES == 1
    a.ph_lo = 0; a.ph_hi = NPHASE;
    hipLaunchKernelGGL(mega_fwd, dim3(grid), dim3(NWAVES * 64), LDS_BYTES, stream, a);
#else
    for (int p = 0; p < NPHASE; ++p) { a.ph_lo = p; a.ph_hi = p + 1; hipLaunchKernelGGL(mega_fwd, dim3(grid), dim3(NWAVES * 64), LDS_BYTES, stream, a); }
#endif
    const hipError_t le = hipPeekAtLastError();
    if (le != hipSuccess) fprintf(stderr, "kernel_launch: launch failed: %s\n", hipGetErrorName(le));
}
```

```cpp
#include <hip/hip_runtime.h>
#include <cstdio>
#include <cstdint>
#include <cmath>

#ifndef MK_N_LAUNCHES
#define MK_N_LAUNCHES 1
#endif

constexpr int D_MODEL = 2048, BATCH = 2, SEQ = 8192, T = BATCH * SEQ;
constexpr int OFF_CQ = 0, OFF_CKV = 768, OFF_KR = 1280, OFF_DQ = 1344, OFF_DK = 2368, OFF_DV = 3392, OFF_GATE = 4416, IN_COLS = 8512;
constexpr int N1 = 8704;
constexpr int NEXP = 16384;
constexpr float EPS = 1e-6f;
constexpr float LOG2E = 1.4426950408889634f;
constexpr float C2_MLA = 0.07216878364870322f * LOG2E;
constexpr float C2_DIFF = 0.125f * LOG2E;
constexpr float LAMBDA_INIT = 0.2f;

namespace pg8 {
#define PG8_LAS __attribute__((address_space(3)))
typedef unsigned short bf16_t;
typedef short bf16x8 __attribute__((ext_vector_type(8)));
typedef float f32x4 __attribute__((ext_vector_type(4)));
typedef unsigned u32x4 __attribute__((ext_vector_type(4)));
typedef unsigned u32x2 __attribute__((ext_vector_type(2)));
constexpr int BM = 256, BK = 64, HALF = 128, HTB = HALF * BK * 2, STAGE_BYTES = 8 * HTB, NXCD = 8, WGM = 8;

__host__ __device__ __forceinline__ int lds_byte(int r, int c) { const int st = (r >> 4) * 2 + (c >> 5), rr = r & 15, cc = c & 31, ob = rr * 64 + cc * 2; return st * 1024 + (ob ^ (((ob >> 9) & 1) << 5)); }
__host__ __device__ __forceinline__ void stage_rc(int b, int& R, int& C) { const int st = b / 1024, sb = b % 1024, swz = sb ^ (((sb >> 9) & 1) << 5); R = (st >> 1) * 16 + swz / 64; C = (st & 1) * 32 + (swz % 64) / 2; }
__host__ __device__ __forceinline__ int perm32(int rho) { const int n = rho >> 4, i = rho & 15; return 8 * (i >> 2) + 4 * n + (i & 3); }

struct Unit { int pm, pn; };
struct Gemm { const bf16_t* A; const bf16_t* Bt; int M, N, K, lda; };

struct StaticOrder {
    int nM, nN, nwg, G, c;
    __host__ __device__ void init(int M, int N, int G_, int c_) { nM = M / BM; nN = N / BM; nwg = nM * nN; G = G_; c = c_; }
    __host__ __device__ bool next(int i, Unit& u) const {
        const long L = (long)i * G + c; if (L >= nwg) return false;
        int wgid = (int)L; { const int q = nwg / NXCD, r = nwg % NXCD, xcd = wgid % NXCD, off = wgid / NXCD; wgid = (xcd < r ? xcd * (q + 1) : r * (q + 1) + (xcd - r) * q) + off; }
        const int nig = WGM * nN, gid = wgid / nig, fm = gid * WGM, gsz = (nM - fm) < WGM ? (nM - fm) : WGM;
        u.pm = fm + ((wgid % nig) % gsz); u.pn = (wgid % nig) / gsz; return true;
    }
    __device__ __forceinline__ void a_ready(const Unit&) const {}
    __device__ __forceinline__ void done(const Unit&) const {}
};

typedef float f32x2_t __attribute__((ext_vector_type(2))); typedef __bf16 bf16x2_t __attribute__((ext_vector_type(2)));
__device__ __forceinline__ unsigned cvtpk(float lo, float hi) { f32x2_t v = {lo, hi}; bf16x2_t b = __builtin_convertvector(v, bf16x2_t); return __builtin_bit_cast(unsigned, b); }
__device__ __forceinline__ float bf2f(unsigned short h) { return __builtin_bit_cast(float, (unsigned)h << 16); }
__device__ __forceinline__ float bflo(unsigned w) { return __builtin_bit_cast(float, w << 16); }
__device__ __forceinline__ float bfhi(unsigned w) { return __builtin_bit_cast(float, w & 0xffff0000u); }

template <class Epi, class Sched, bool ALIGN_EPI = false, bool SP2 = false>
__device__ __forceinline__ void gemm_phase(PG8_LAS unsigned char* lds, const Gemm g, const Sched& S, const Epi& E) {
    const int tid = threadIdx.x, wid = __builtin_amdgcn_readfirstlane(tid >> 6), lane = tid & 63, wr = wid >> 2, wc = wid & 3, fr = lane & 15, fq = lane >> 4;
    const int K = g.K, nt = K / BK, lda = g.lda;
    unsigned voffA[2], voffB[2];
#pragma unroll
    for (int i = 0; i < 2; ++i) { int R, C; stage_rc(tid * 16 + i * 8192, R, C); const int Rb = Epi::PERM ? ((R & ~31) + perm32(R & 31)) : R;
        voffA[i] = (unsigned)(R * lda + C) * 2u; voffB[i] = (unsigned)(Rb * K + C) * 2u; }
    const size_t kstep = (size_t)(BK * 2);
    const size_t hstepA = (size_t)HALF * lda * 2, hstepB = (size_t)HALF * K * 2;
    const size_t tstepA = 2 * hstepA, tstepB = 2 * hstepB;
    const unsigned ldsw = (unsigned)wid * 1024u;
    const int aoff = lds_byte(wr * 64 + fr, fq * 8), boff = lds_byte(wc * 32 + fr, fq * 8);
#define PG8_SA(b, h) (((b) * 2 + (h)) * HTB)
#define PG8_SB(b, h) ((4 + (b) * 2 + (h)) * HTB)
#define PG8_STAGE(bufoff, gbase, voff) do { _Pragma("unroll") for (int _i = 0; _i < 2; ++_i) \
        __builtin_amdgcn_global_load_lds((const unsigned*)((const char*)(gbase) + (voff)[_i]), (PG8_LAS unsigned*)(lds + (bufoff) + ldsw + _i * 8192), 16, 0, 0); } while (0)
#define PG8_LDA(dst, b, h) do { _Pragma("unroll") for (int m = 0; m < 4; ++m) _Pragma("unroll") for (int k = 0; k < 2; ++k) dst[m][k] = *(const PG8_LAS bf16x8*)(lds + PG8_SA(b, h) + aoff + m * 2048 + k * 1024); } while (0)
#define PG8_LDB(dst, b, h) do { _Pragma("unroll") for (int n = 0; n < 2; ++n) _Pragma("unroll") for (int k = 0; k < 2; ++k) dst[n][k] = *(const PG8_LAS bf16x8*)(lds + PG8_SB(b, h) + boff + n * 2048 + k * 1024); } while (0)
#define PG8_MMA(ai, bj, At, Bt) do { __builtin_amdgcn_s_setprio(1); _Pragma("unroll") for (int m = 0; m < 4; ++m) _Pragma("unroll") for (int n = 0; n < 2; ++n) _Pragma("unroll") for (int k = 0; k < 2; ++k) \
        acc[ai][bj][m][n] = __builtin_amdgcn_mfma_f32_16x16x32_bf16(Bt[n][k], At[m][k], acc[ai][bj][m][n], 0, 0, 0); __builtin_amdgcn_s_setprio(0); } while (0)
#define PG8_WAIT_V(n) asm volatile("s_waitcnt vmcnt(" #n ")" ::: "memory")
#define PG8_WAIT_L(n) asm volatile("s_waitcnt lgkmcnt(" #n ")" ::: "memory")
#define PG8_BAR __builtin_amdgcn_s_barrier()
#define PG8_SCHED __builtin_amdgcn_sched_barrier(0)
    Unit cur, nxt; int ui = 0;
    if (!S.next(0, cur)) return;
    f32x4 acc[2][2][4][2];
#pragma unroll
    for (int a = 0; a < 2; ++a)
#pragma unroll
        for (int b = 0; b < 2; ++b)
#pragma unroll
            for (int m = 0; m < 4; ++m)
#pragma unroll
                for (int n = 0; n < 2; ++n) acc[a][b][m][n] = (f32x4){0.f, 0.f, 0.f, 0.f};
    bf16x8 At[4][2], B0[2][2], B1[2][2];
    const char* cA = (const char*)g.A + (size_t)cur.pm * tstepA; const char* cB = (const char*)g.Bt + (size_t)cur.pn * tstepB;
    S.a_ready(cur);
    if constexpr (SP2) {
        PG8_STAGE(PG8_SB(0, 0), cB, voffB); PG8_STAGE(PG8_SB(0, 1), cB + hstepB, voffB); PG8_STAGE(PG8_SA(0, 0), cA, voffA); PG8_STAGE(PG8_SA(0, 1), cA + hstepA, voffA);
        if (wr == 1) PG8_BAR;
        PG8_WAIT_V(2); PG8_BAR;
        PG8_STAGE(PG8_SB(1, 0), cB + kstep, voffB); PG8_STAGE(PG8_SA(1, 0), cA + kstep, voffA); PG8_STAGE(PG8_SB(1, 1), cB + hstepB + kstep, voffB);
        PG8_WAIT_V(6); PG8_BAR;
    } else {
        PG8_STAGE(PG8_SB(0, 0), cB, voffB); PG8_STAGE(PG8_SA(0, 0), cA, voffA); PG8_STAGE(PG8_SB(0, 1), cB + hstepB, voffB); PG8_STAGE(PG8_SA(0, 1), cA + hstepA, voffA);
        if (wr == 1) PG8_BAR;
        PG8_WAIT_V(4); PG8_BAR;
        PG8_STAGE(PG8_SB(1, 0), cB + kstep, voffB); PG8_STAGE(PG8_SA(1, 0), cA + kstep, voffA); PG8_STAGE(PG8_SB(1, 1), cB + hstepB + kstep, voffB);
        PG8_WAIT_V(6); PG8_BAR;
    }
    for (;;) {
        const bool has_next = S.next(ui + 1, nxt);
        const char* nA = has_next ? (const char*)g.A + (size_t)nxt.pm * tstepA : cA; const char* nB = has_next ? (const char*)g.Bt + (size_t)nxt.pn * tstepB : cB;
        for (int t = 0; t < nt; t += 2) {
            const bool last = (t == nt - 2);
            const char* a1 = cA + (size_t)(t + 1) * kstep;
            const char* a2 = last ? nA : cA + (size_t)(t + 2) * kstep; const char* b2 = last ? nB : cB + (size_t)(t + 2) * kstep;
            const char* a3 = a2 + kstep; const char* b3 = b2 + kstep;
            if (last && has_next) S.a_ready(nxt);
            if constexpr (SP2) {
            PG8_LDB(B0, 0, 0); PG8_LDB(B1, 0, 1); PG8_SCHED; PG8_LDA(At, 0, 0); PG8_STAGE(PG8_SA(1, 1), a1 + hstepA, voffA);
            PG8_WAIT_V(8); PG8_WAIT_L(0); PG8_BAR; PG8_MMA(0, 0, At, B0); PG8_MMA(0, 1, At, B1); PG8_BAR; PG8_SCHED;
            PG8_LDA(At, 0, 1); PG8_STAGE(PG8_SB(0, 0), b2, voffB); PG8_STAGE(PG8_SB(0, 1), b2 + hstepB, voffB); PG8_STAGE(PG8_SA(0, 0), a2, voffA);
            PG8_WAIT_V(8); PG8_WAIT_L(0); PG8_BAR; PG8_MMA(1, 0, At, B0); PG8_MMA(1, 1, At, B1); PG8_BAR; PG8_SCHED;
            PG8_LDB(B0, 1, 0); PG8_LDB(B1, 1, 1); PG8_SCHED; PG8_LDA(At, 1, 0); PG8_STAGE(PG8_SA(0, 1), a2 + hstepA, voffA);
            PG8_WAIT_V(8); PG8_WAIT_L(0); PG8_BAR; PG8_MMA(0, 0, At, B0); PG8_MMA(0, 1, At, B1); PG8_BAR; PG8_SCHED;
            PG8_LDA(At, 1, 1); PG8_STAGE(PG8_SB(1, 0), b3, voffB); PG8_STAGE(PG8_SB(1, 1), b3 + hstepB, voffB); PG8_STAGE(PG8_SA(1, 0), a3, voffA);
            PG8_WAIT_V(8); PG8_WAIT_L(0); PG8_BAR; PG8_MMA(1, 0, At, B0); PG8_MMA(1, 1, At, B1); PG8_BAR; PG8_SCHED;
            } else {
            PG8_LDB(B0, 0, 0); PG8_SCHED; PG8_LDA(At, 0, 0); PG8_STAGE(PG8_SA(1, 1), a1 + hstepA, voffA);
            PG8_WAIT_L(8); PG8_BAR; PG8_WAIT_L(0); PG8_MMA(0, 0, At, B0); PG8_BAR; PG8_SCHED;
            PG8_LDB(B1, 0, 1); PG8_STAGE(PG8_SB(0, 0), b2, voffB);
            PG8_BAR; PG8_WAIT_L(0); PG8_MMA(0, 1, At, B1); PG8_BAR;
            PG8_LDA(At, 0, 1); PG8_STAGE(PG8_SA(0, 0), a2, voffA);
            PG8_BAR; PG8_WAIT_L(0); PG8_MMA(1, 0, At, B0); PG8_BAR; PG8_SCHED;
            PG8_STAGE(PG8_SB(0, 1), b2 + hstepB, voffB);
            PG8_WAIT_V(6); PG8_BAR; PG8_MMA(1, 1, At, B1); PG8_BAR;
            PG8_LDB(B0, 1, 0); PG8_SCHED; PG8_LDA(At, 1, 0); PG8_STAGE(PG8_SA(0, 1), a2 + hstepA, voffA);
            PG8_WAIT_L(8); PG8_BAR; PG8_WAIT_L(0); PG8_MMA(0, 0, At, B0); PG8_BAR; PG8_SCHED;
            PG8_LDB(B1, 1, 1); PG8_STAGE(PG8_SB(1, 0), b3, voffB);
            PG8_BAR; PG8_WAIT_L(0); PG8_MMA(0, 1, At, B1); PG8_BAR;
            PG8_LDA(At, 1, 1); PG8_STAGE(PG8_SA(1, 0), a3, voffA);
            PG8_BAR; PG8_WAIT_L(0); PG8_MMA(1, 0, At, B0); PG8_BAR; PG8_SCHED;
            PG8_STAGE(PG8_SB(1, 1), b3 + hstepB, voffB);
            PG8_WAIT_V(6); PG8_BAR; PG8_MMA(1, 1, At, B1); PG8_BAR;
            }
        }
        if constexpr (ALIGN_EPI) { if (wr == 0) PG8_BAR; }
        E(acc, cur, wr, wc, fr, fq); S.done(cur);
        if (!has_next) break;
#pragma unroll
        for (int a = 0; a < 2; ++a)
#pragma unroll
            for (int b = 0; b < 2; ++b)
#pragma unroll
                for (int m = 0; m < 4; ++m)
#pragma unroll
                    for (int n = 0; n < 2; ++n) acc[a][b][m][n] = (f32x4){0.f, 0.f, 0.f, 0.f};
        cur = nxt; cA = nA; cB = nB; ++ui;
        if constexpr (ALIGN_EPI) { if (wr == 1) PG8_BAR; }
    }
    PG8_WAIT_V(0);
    if constexpr (!ALIGN_EPI) { if (wr == 0) PG8_BAR; }
    PG8_BAR;
#undef PG8_SA
#undef PG8_SB
#undef PG8_STAGE
#undef PG8_LDA
#undef PG8_LDB
#undef PG8_MMA
#undef PG8_WAIT_V
#undef PG8_WAIT_L
#undef PG8_BAR
#undef PG8_SCHED
}
}

#ifndef PG8_SP2
#define PG8_SP2 true
#endif
#ifndef PG8_ALIGN
#define PG8_ALIGN true
#endif

using pg8::bf16_t; using pg8::f32x4; using pg8::u32x4; using pg8::u32x2; using pg8::cvtpk; using pg8::bf2f; using pg8::bflo; using pg8::bfhi;

constexpr size_t MiB = 1u << 20;
constexpr size_t WS_CTL = 0, CTL_ZERO_BYTES = 1 * MiB;
constexpr size_t WS_ROPE = 1 * MiB;
constexpr size_t WS_WUQ = 3 * MiB, WS_WUKV = 6 * MiB, WS_WOM = 8 * MiB, WS_WOD = 12 * MiB, WS_WOUT = 16 * MiB, WS_WQP = 24 * MiB;
constexpr size_t WS_SKB = 5 * MiB + 512 * 1024;
constexpr size_t WS_W1 = 32 * MiB;
constexpr size_t WS_H = 66 * MiB;
constexpr size_t WS_CQ = 130 * MiB, WS_CKV = 154 * MiB;
constexpr size_t WS_KR = 170 * MiB, WS_DQ = 172 * MiB, WS_DK = 204 * MiB, WS_DV = 236 * MiB;
constexpr size_t WS_G = 268 * MiB;
constexpr size_t WS_QN = 32 * MiB, WS_QR = 64 * MiB, WS_KN = 80 * MiB, WS_V = 396 * MiB;
constexpr size_t WS_OM = 112 * MiB, WS_OD = 428 * MiB;
constexpr size_t WS_TMP = 32 * MiB;
constexpr size_t WS_MG = 172 * MiB;
constexpr size_t WS_X2 = 268 * MiB;
constexpr size_t WS_X2B = 396 * MiB;
constexpr size_t WS_EU = 32 * MiB, WS_EV = 96 * MiB;
constexpr size_t WS_QP = 172 * MiB;
constexpr size_t WS_IDX = 236 * MiB, WS_GT = 244 * MiB;
constexpr size_t WS_PSQ_Q = 460 * MiB, WS_PSQ_KV = 461 * MiB, WS_PSQ2 = 462 * MiB;
constexpr size_t WS_END = 464 * MiB;
constexpr int CW_TMO = 0, CW_CODE = 1, CW_LAMBDA = 8;
constexpr int CW_BAR = 4096;

constexpr int RING_OFF = 0, RING_BYTES = 131072;
constexpr int LDSCTL_OFF = RING_BYTES, MISC_OFF = LDSCTL_OFF + 320;
constexpr int LDS_BYTES = 147456;
constexpr int NWAVES = 8;

#define GAS __attribute__((address_space(1)))
#define LAS __attribute__((address_space(3)))
typedef unsigned short bf16;
typedef unsigned v4u __attribute__((ext_vector_type(4)));
typedef GAS unsigned gu32;
#define RLX_AGENT __ATOMIC_RELAXED, __HIP_MEMORY_SCOPE_AGENT
#define LDS_WAIT() asm volatile("s_waitcnt lgkmcnt(0)" ::: "memory")
#define VM_WAIT() asm volatile("s_waitcnt vmcnt(0)" ::: "memory")

#define XB_TMO      128
#define XB_XCNT(j)  (256  + 64 * (j))
#define XB_XSUB(j)  (1280 + 64 * (j))
#define XB_XGEN(j)  (2304 + 64 * (j))
#define XB_TOP      3328
#define XB_TOPGEN   3392
#define XCD_BAR_WORDS 3456
#define XB_SPIN_CAP (1u << 22)
__device__ __forceinline__ unsigned xb_ld(unsigned* p)              { return __hip_atomic_load(p, __ATOMIC_RELAXED, __HIP_MEMORY_SCOPE_AGENT); }
__device__ __forceinline__ unsigned xb_add(unsigned* p, unsigned v) { return __hip_atomic_fetch_add(p, v, __ATOMIC_RELAXED, __HIP_MEMORY_SCOPE_AGENT); }
__device__ __forceinline__ unsigned xb_xcc_id() { return (unsigned)__builtin_amdgcn_s_getreg((3 << 11) | 20) & 0xFu; }
#define XB_SPIN(cond, bar) do { unsigned _sp = 0; while (cond) { __builtin_amdgcn_s_sleep(1); \
    if ((++_sp & 255u) == 0u) { if (xb_ld(&(bar)[XB_TMO])) break; if (_sp > XB_SPIN_CAP) { atomicAdd(&(bar)[XB_TMO], 1u); break; } } } } while (0)
struct XcdBarrier { unsigned* bar; unsigned x; volatile LAS unsigned* st; };
__device__ __forceinline__ XcdBarrier xcd_barrier_post(unsigned* bar, volatile LAS unsigned* st) {
    XcdBarrier b; b.bar = bar; b.x = xb_xcc_id(); b.st = st;
    if (threadIdx.x == 0) (void)xb_add(&bar[XB_XCNT(b.x)], 1u);
    return b;
}
__device__ __forceinline__ void xcd_barrier_complete(unsigned* bar, unsigned x, unsigned& nloc, unsigned& nx) {
    const unsigned G = gridDim.x * gridDim.y * gridDim.z;
    unsigned sum, cnt, mine, sp = 0u;
    for (;;) {
        sum = 0u; cnt = 0u; mine = 0u;
#pragma unroll
        for (unsigned j = 0; j < 16; ++j) { const unsigned c = xb_ld(&bar[XB_XCNT(j)]); sum += c; cnt += (c > 0u) ? 1u : 0u; mine = (j == x) ? c : mine; }
        if (sum == G) break;
        __builtin_amdgcn_s_sleep(1);
        if ((++sp & 255u) == 0u) { if (xb_ld(&bar[XB_TMO])) break; if (sp > XB_SPIN_CAP) { atomicAdd(&bar[XB_TMO], 1u); break; } }
    }
    nloc = mine > 0u ? mine : 1u; nx = cnt > 0u ? cnt : 1u;
}
__device__ __forceinline__ void xcd_barrier(const XcdBarrier& b) {
    asm volatile("s_waitcnt vmcnt(0)" ::: "memory");
    __syncthreads();
    if (threadIdx.x == 0) {
        unsigned* bar = b.bar;
        __builtin_amdgcn_s_waitcnt(0);
        unsigned nloc = b.st[0], nx = b.st[1];
        if (nloc == 0u) { xcd_barrier_complete(bar, b.x, nloc, nx); b.st[0] = nloc; b.st[1] = nx; }
        const unsigned old = xb_add(&bar[XB_XSUB(b.x)], 1u);
        const unsigned gen = old / nloc;
        if (old + 1u == (gen + 1u) * nloc) {
            __builtin_amdgcn_fence(__ATOMIC_RELEASE, "agent");
            asm volatile("s_waitcnt vmcnt(0)" ::: "memory");
            const unsigned og = xb_add(&bar[XB_TOP], 1u);
            const unsigned tg = og / nx;
            if (og + 1u == (tg + 1u) * nx) xb_add(&bar[XB_TOPGEN], 1u);
            else XB_SPIN(xb_ld(&bar[XB_TOPGEN]) == tg, bar);
            __builtin_amdgcn_fence(__ATOMIC_ACQUIRE, "agent");
            xb_add(&bar[XB_XGEN(b.x)], 1u);
            asm volatile("s_waitcnt vmcnt(0)" ::: "memory");
        } else {
            XB_SPIN(xb_ld(&bar[XB_XGEN(b.x)]) == gen, bar);
            __builtin_amdgcn_fence(__ATOMIC_ACQUIRE, "agent");
            asm volatile("s_waitcnt vmcnt(0)" ::: "memory");
        }
    }
    __syncthreads();
}

struct Frame {
    LAS unsigned char* lds;
    volatile LAS unsigned* MISC;
    gu32* ctl;
    unsigned char* ws;
    int tid, lane, wave, vcu, G;
};

__device__ __forceinline__ float wave_sum(float v) {
#pragma unroll
    for (int o = 1; o < 64; o <<= 1) v += __shfl_xor(v, o);
    return v;
}
__device__ __forceinline__ float wave_max(float v) {
#pragma unroll
    for (int o = 1; o < 64; o <<= 1) v = fmaxf(v, __shfl_xor(v, o));
    return v;
}
__device__ __forceinline__ unsigned pk2(float lo, float hi) { return cvtpk(lo, hi); }

template <class Map>
__device__ __forceinline__ void tr_item(const float* W, int Nsrc, int K, const float* kscale, bf16* WT, LAS float* scr, int item, int nblk, int lane, Map map) {
    const int kb = item / nblk, nb = item % nblk, k0 = 64 * kb, n0 = 32 * nb;
    const int sc = map(n0 + (lane & 31));
#pragma unroll 8
    for (int i = 0; i < 32; ++i) { const int kk = 2 * i + (lane >> 5); float v = 0.f; if (sc >= 0) v = W[(size_t)(k0 + kk) * Nsrc + sc]; if (kscale) v *= kscale[k0 + kk]; scr[kk * 33 + (lane & 31)] = v; }
    LDS_WAIT(); asm volatile("" ::: "memory");
    const int c = lane & 7;
#pragma unroll
    for (int j = 0; j < 4; ++j) { const int n = (lane >> 3) + 8 * j; const LAS float* s = scr + (8 * c) * 33 + n;
        v4u o; o.x = pk2(s[0 * 33], s[1 * 33]); o.y = pk2(s[2 * 33], s[3 * 33]); o.z = pk2(s[4 * 33], s[5 * 33]); o.w = pk2(s[6 * 33], s[7 * 33]);
        *(GAS v4u*)(WT + (size_t)(n0 + n) * K + k0 + 8 * c) = o; }
    LDS_WAIT(); asm volatile("" ::: "memory");
}
__device__ __forceinline__ int rope_src(int jj) { return (jj & 1) * 32 + (jj >> 1); }
struct MapW1 { __device__ int operator()(int n) const {
    if (n < 1280) return n;
    if (n < 2304) { const int j = n - 1280; return OFF_DQ + (j & ~63) + rope_src(j & 63); }
    if (n < 3328) { const int j = n - 2304; return OFF_DK + (j & ~63) + rope_src(j & 63); }
    if (n < 4352) return OFF_DV + (n - 3328);
    if (n < 8448) return OFF_GATE + (n - 4352);
    if (n < 8512) return OFF_KR + rope_src(n - 8448);
    return -1; } };
struct MapUQ { __device__ int operator()(int n) const {
    if (n < 1024) return (n >> 7) * 192 + (n & 127);
    const int j = n - 1024; return (j >> 6) * 192 + 128 + rope_src(j & 63); } };
struct MapUKV { __device__ int operator()(int n) const {
    if (n < 1024) return (n >> 7) * 256 + (n & 127);
    const int j = n - 1024; return (j >> 7) * 256 + 128 + (j & 127); } };
struct MapId { __device__ int operator()(int n) const { return n; } };

struct Ins { const float *x, *w_in, *b_gate, *g_norm1, *g_cq, *w_uq, *g_ckv, *w_ukv, *w_o_mla, *lambda_qk, *g_subln, *w_o_diff, *w_out, *g_norm2, *w_q_peer, *sub_keys, *expert_u, *expert_v, *g_final; };

__device__ __forceinline__ void p0_prologue(Frame& F, const Ins& I, const double* inv_freq) {
    LAS float* scr = (LAS float*)(F.lds + RING_OFF + F.wave * 16384);
    const int gw = F.vcu * NWAVES + F.wave, NGW = F.G * NWAVES;
    unsigned char* ws = F.ws;
    constexpr int I_W1 = (2048 / 64) * (N1 / 32), I_UQ = (768 / 64) * (1536 / 32), I_UKV = (512 / 64) * (2048 / 32), I_OM = (1024 / 64) * (2048 / 32), I_OD = I_OM, I_OUT = (2048 / 64) * (2048 / 32), I_QP = I_OUT;
    constexpr int NITEMS = I_W1 + I_UQ + I_UKV + I_OM + I_OD + I_OUT + I_QP;
    for (int it = gw; it < NITEMS; it += NGW) {
        int r = it;
        if (r < I_W1) { tr_item(I.w_in, IN_COLS, 2048, nullptr, (bf16*)(ws + WS_W1), scr, r, N1 / 32, F.lane, MapW1()); continue; } r -= I_W1;
        if (r < I_UQ) { tr_item(I.w_uq, 1536, 768, I.g_cq, (bf16*)(ws + WS_WUQ), scr, r, 1536 / 32, F.lane, MapUQ()); continue; } r -= I_UQ;
        if (r < I_UKV) { tr_item(I.w_ukv, 2048, 512, I.g_ckv, (bf16*)(ws + WS_WUKV), scr, r, 2048 / 32, F.lane, MapUKV()); continue; } r -= I_UKV;
        if (r < I_OM) { tr_item(I.w_o_mla, 2048, 1024, nullptr, (bf16*)(ws + WS_WOM), scr, r, 2048 / 32, F.lane, MapId()); continue; } r -= I_OM;
        if (r < I_OD) { tr_item(I.w_o_diff, 2048, 1024, nullptr, (bf16*)(ws + WS_WOD), scr, r, 2048 / 32, F.lane, MapId()); continue; } r -= I_OD;
        if (r < I_OUT) { tr_item(I.w_out, 2048, 2048, nullptr, (bf16*)(ws + WS_WOUT), scr, r, 2048 / 32, F.lane, MapId()); continue; } r -= I_OUT;
        tr_item(I.w_q_peer, 2048, 2048, I.g_norm2, (bf16*)(ws + WS_WQP), scr, r, 2048 / 32, F.lane, MapId());
    }
    {
        bf16* skb = (bf16*)(ws + WS_SKB);
        for (int e = gw * 64 + F.lane; e < 256 * 256; e += NGW * 64) {
            const int n = e >> 8, k = e & 255; float v = 0.f;
            if (n < 128 && k < 128) v = I.sub_keys[n * 128 + k];
            else if (n >= 128 && k >= 128) v = I.sub_keys[128 * 128 + (n - 128) * 128 + (k - 128)];
            skb[e] = (bf16)(pk2(v, 0.f) & 0xffffu);
        }
    }
    {
        float* rope = (float*)(ws + WS_ROPE);
        for (int e = gw * 64 + F.lane; e < SEQ * 32; e += NGW * 64) {
            const int pos = e >> 5, i = e & 31;
            const double rev = (double)pos * inv_freq[i] * 0.15915494309189535;
            const float fr = (float)(rev - floor(rev));
            rope[2 * e] = __builtin_amdgcn_cosf(fr); rope[2 * e + 1] = __builtin_amdgcn_sinf(fr);
        }
    }
    if (blockIdx.x == 0 && F.tid == 0) {
        float a = 0.f, b = 0.f;
        for (int d = 0; d < 64; ++d) { a += I.lambda_qk[d] * I.lambda_qk[64 + d]; b += I.lambda_qk[128 + d] * I.lambda_qk[192 + d]; }
        const float lam = __expf(a) - __expf(b) + LAMBDA_INIT;
        ((float*)F.ctl)[CW_LAMBDA] = lam;
    }
    {
        bf16* H = (bf16*)(ws + WS_H);
        f32x4 g[8];
#pragma unroll
        for (int j = 0; j < 8; ++j) g[j] = *((const f32x4*)I.g_norm1 + F.lane + 64 * j);
        for (int m = gw; m < T; m += NGW) {
            const GAS f32x4* xr = (const GAS f32x4*)(I.x + (size_t)m * D_MODEL) + F.lane;
            f32x4 v[8]; float s = 0.f;
#pragma unroll
            for (int j = 0; j < 8; ++j) { v[j] = xr[64 * j]; s += (v[j].x * v[j].x + v[j].y * v[j].y) + (v[j].z * v[j].z + v[j].w * v[j].w); }
            const float rstd = 1.0f / sqrtf(wave_sum(s) * (1.f / D_MODEL) + EPS);
            GAS u32x2* o8 = (GAS u32x2*)(H + (size_t)m * D_MODEL) + F.lane;
#pragma unroll
            for (int j = 0; j < 8; ++j) { u32x2 w; w.x = pk2(v[j].x * rstd * g[j].x, v[j].y * rstd * g[j].y); w.y = pk2(v[j].z * rstd * g[j].z, v[j].w * rstd * g[j].w); o8[64 * j] = w; }
        }
    }
}

__device__ __forceinline__ void convert_experts(Frame& F, const Ins& I) {
    const size_t gt = (size_t)(F.vcu * NWAVES * 64) + F.tid, NT = (size_t)F.G * NWAVES * 64;
    const size_t nchunk = (size_t)NEXP * D_MODEL / 8;
    bf16* EU = (bf16*)(F.ws + WS_EU); bf16* EV = (bf16*)(F.ws + WS_EV);
    for (size_t c = gt; c < nchunk; c += NT) {
        const int d = (int)((c * 8) & (D_MODEL - 1));
        const f32x4 a0 = *(const GAS f32x4*)(I.expert_u + c * 8), a1 = *(const GAS f32x4*)(I.expert_u + c * 8 + 4);
        const f32x4 g0 = *(const f32x4*)(I.g_norm2 + d), g1 = *(const f32x4*)(I.g_norm2 + d + 4);
        v4u o; o.x = pk2(a0.x * g0.x, a0.y * g0.y); o.y = pk2(a0.z * g0.z, a0.w * g0.w); o.z = pk2(a1.x * g1.x, a1.y * g1.y); o.w = pk2(a1.z * g1.z, a1.w * g1.w);
        *(GAS v4u*)(EU + c * 8) = o;
        const f32x4 b0 = *(const GAS f32x4*)(I.expert_v + c * 8), b1 = *(const GAS f32x4*)(I.expert_v + c * 8 + 4);
        v4u p; p.x = pk2(b0.x, b0.y); p.y = pk2(b0.z, b0.w); p.z = pk2(b1.x, b1.y); p.w = pk2(b1.z, b1.w);
        *(GAS v4u*)(EV + c * 8) = p;
    }
}

__device__ __forceinline__ float sigmoidf_fast(float x) { return __builtin_amdgcn_rcpf(1.0f + __builtin_amdgcn_exp2f(-x * LOG2E)); }
__device__ __forceinline__ void rope8(f32x4& v0, f32x4& v1, const f32x4 cs0, const f32x4 cs1, float sc) {
    const float a0 = v0[0] * cs0[0] - v0[1] * cs0[1], b0 = v0[1] * cs0[0] + v0[0] * cs0[1];
    const float a1 = v0[2] * cs0[2] - v0[3] * cs0[3], b1 = v0[3] * cs0[2] + v0[2] * cs0[3];
    const float a2 = v1[0] * cs1[0] - v1[1] * cs1[1], b2 = v1[1] * cs1[0] + v1[0] * cs1[1];
    const float a3 = v1[2] * cs1[2] - v1[3] * cs1[3], b3 = v1[3] * cs1[2] + v1[2] * cs1[3];
    v0 = (f32x4){a0 * sc, b0 * sc, a1 * sc, b1 * sc}; v1 = (f32x4){a2 * sc, b2 * sc, a3 * sc, b3 * sc};
}
__device__ __forceinline__ u32x4 pack8(const f32x4 v0, const f32x4 v1) { u32x4 w; w.x = cvtpk(v0[0], v0[1]); w.y = cvtpk(v0[2], v0[3]); w.z = cvtpk(v1[0], v1[1]); w.w = cvtpk(v1[2], v1[3]); return w; }

struct EpiProj {
    static constexpr bool PERM = true;
    bf16_t *CQ, *CKV, *DQ, *DK, *DV, *G, *KR; float *ssq_q, *ssq_kv; const float* bgate; const float* rope;
    __device__ __forceinline__ void operator()(const f32x4 (&acc)[2][2][4][2], const pg8::Unit& u, int wr, int wc, int fr, int fq) const {
        const int row0 = u.pm * 256 + wr * 64 + fr, pn = u.pn, colw = wc * 32 + 8 * fq;
        if (pn < 5) {
            bf16_t* O; int ldc, ct, nsl, sl; float* ssq;
            if (pn < 3) { O = CQ; ldc = 768; ct = pn * 256; ssq = ssq_q; nsl = 12; sl = pn * 4 + wc; } else { O = CKV; ldc = 512; ct = (pn - 3) * 256; ssq = ssq_kv; nsl = 8; sl = (pn - 3) * 4 + wc; }
#pragma unroll
            for (int ai = 0; ai < 2; ++ai)
#pragma unroll
                for (int m = 0; m < 4; ++m) { const int row = row0 + ai * 128 + m * 16; float s = 0.f;
#pragma unroll
                    for (int bj = 0; bj < 2; ++bj) { const f32x4 v0 = acc[ai][bj][m][0], v1 = acc[ai][bj][m][1];
                        s += (v0[0] * v0[0] + v0[1] * v0[1]) + (v0[2] * v0[2] + v0[3] * v0[3]) + (v1[0] * v1[0] + v1[1] * v1[1]) + (v1[2] * v1[2] + v1[3] * v1[3]);
                        *(u32x4*)(O + (size_t)row * ldc + ct + bj * 128 + colw) = pack8(v0, v1); }
                    s += __shfl_xor(s, 16); s += __shfl_xor(s, 32);
                    if (fq == 0) ssq[(size_t)row * nsl + sl] = s; }
        } else if (pn < 13) {
            const bool isq = pn < 9; bf16_t* O = isq ? DQ : DK; const int ct = (pn - (isq ? 5 : 9)) * 256; const float sc = isq ? C2_DIFF : 1.0f;
            const int i0 = ((wc & 1) * 32 + 8 * fq) >> 1;
#pragma unroll
            for (int ai = 0; ai < 2; ++ai)
#pragma unroll
                for (int m = 0; m < 4; ++m) { const int row = row0 + ai * 128 + m * 16; const int pos = row & (SEQ - 1);
                    const f32x4 cs0 = *(const f32x4*)(rope + (size_t)(pos * 32 + i0) * 2), cs1 = *(const f32x4*)(rope + (size_t)(pos * 32 + i0 + 2) * 2);
#pragma unroll
                    for (int bj = 0; bj < 2; ++bj) { f32x4 v0 = acc[ai][bj][m][0], v1 = acc[ai][bj][m][1]; rope8(v0, v1, cs0, cs1, sc);
                        *(u32x4*)(O + (size_t)row * 1024 + ct + bj * 128 + colw) = pack8(v0, v1); } }
        } else if (pn < 17) {
            const int ct = (pn - 13) * 256;
#pragma unroll
            for (int ai = 0; ai < 2; ++ai)
#pragma unroll
                for (int m = 0; m < 4; ++m) { const int row = row0 + ai * 128 + m * 16;
#pragma unroll
                    for (int bj = 0; bj < 2; ++bj) *(u32x4*)(DV + (size_t)row * 1024 + ct + bj * 128 + colw) = pack8(acc[ai][bj][m][0], acc[ai][bj][m][1]); }
        } else if (pn < 33) {
            const int ct = (pn - 17) * 256;
            f32x4 bv[2][2];
#pragma unroll
            for (int bj = 0; bj < 2; ++bj) { bv[bj][0] = *(const f32x4*)(bgate + ct + bj * 128 + colw); bv[bj][1] = *(const f32x4*)(bgate + ct + bj * 128 + colw + 4); }
#pragma unroll
            for (int ai = 0; ai < 2; ++ai)
#pragma unroll
                for (int m = 0; m < 4; ++m) { const int row = row0 + ai * 128 + m * 16;
#pragma unroll
                    for (int bj = 0; bj < 2; ++bj) { f32x4 v0 = acc[ai][bj][m][0] + bv[bj][0], v1 = acc[ai][bj][m][1] + bv[bj][1];
#pragma unroll
                        for (int e = 0; e < 4; ++e) { v0[e] = sigmoidf_fast(v0[e]); v1[e] = sigmoidf_fast(v1[e]); }
                        *(u32x4*)(G + (size_t)row * 4096 + ct + bj * 128 + colw) = pack8(v0, v1); } }
        } else {
            if (wc < 2) {
                const int i0 = colw >> 1;
#pragma unroll
                for (int ai = 0; ai < 2; ++ai)
#pragma unroll
                    for (int m = 0; m < 4; ++m) { const int row = row0 + ai * 128 + m * 16; const int pos = row & (SEQ - 1);
                        const f32x4 cs0 = *(const f32x4*)(rope + (size_t)(pos * 32 + i0) * 2), cs1 = *(const f32x4*)(rope + (size_t)(pos * 32 + i0 + 2) * 2);
                        f32x4 v0 = acc[ai][0][m][0], v1 = acc[ai][0][m][1]; rope8(v0, v1, cs0, cs1, 1.0f);
                        *(u32x4*)(KR + (size_t)row * 64 + colw) = pack8(v0, v1); }
            }
        }
    }
};

struct EpiQup {
    static constexpr bool PERM = true;
    bf16_t *QN, *QR; const float* ssq; const float* rope;
    __device__ __forceinline__ void operator()(const f32x4 (&acc)[2][2][4][2], const pg8::Unit& u, int wr, int wc, int fr, int fq) const {
        const int row0 = u.pm * 256 + wr * 64 + fr, pn = u.pn, colw = wc * 32 + 8 * fq;
        const int i0 = ((wc & 1) * 32 + 8 * fq) >> 1;
#pragma unroll
        for (int ai = 0; ai < 2; ++ai)
#pragma unroll
            for (int m = 0; m < 4; ++m) { const int row = row0 + ai * 128 + m * 16; const int pos = row & (SEQ - 1);
                const f32x4 q0 = *(const f32x4*)(ssq + (size_t)row * 12), q1 = *(const f32x4*)(ssq + (size_t)row * 12 + 4), q2 = *(const f32x4*)(ssq + (size_t)row * 12 + 8);
                const float sq = (((q0[0] + q0[1]) + (q0[2] + q0[3])) + ((q1[0] + q1[1]) + (q1[2] + q1[3]))) + ((q2[0] + q2[1]) + (q2[2] + q2[3]));
                const float sc = C2_MLA / sqrtf(sq * (1.0f / 768.0f) + EPS);
                if (pn < 4) {
#pragma unroll
                    for (int bj = 0; bj < 2; ++bj) *(u32x4*)(QN + (size_t)row * 1024 + pn * 256 + bj * 128 + colw) = pack8(acc[ai][bj][m][0] * sc, acc[ai][bj][m][1] * sc);
                } else {
                    const f32x4 cs0 = *(const f32x4*)(rope + (size_t)(pos * 32 + i0) * 2), cs1 = *(const f32x4*)(rope + (size_t)(pos * 32 + i0 + 2) * 2);
#pragma unroll
                    for (int bj = 0; bj < 2; ++bj) { f32x4 v0 = acc[ai][bj][m][0], v1 = acc[ai][bj][m][1]; rope8(v0, v1, cs0, cs1, sc);
                        *(u32x4*)(QR + (size_t)row * 512 + (pn - 4) * 256 + bj * 128 + colw) = pack8(v0, v1); }
                } }
    }
};
struct EpiKVup {
    static constexpr bool PERM = true;
    bf16_t *KN, *V; const float* ssq;
    __device__ __forceinline__ void operator()(const f32x4 (&acc)[2][2][4][2], const pg8::Unit& u, int wr, int wc, int fr, int fq) const {
        const int row0 = u.pm * 256 + wr * 64 + fr, pn = u.pn, colw = wc * 32 + 8 * fq;
        bf16_t* O = pn < 4 ? KN : V; const int ct = (pn & 3) * 256;
#pragma unroll
        for (int ai = 0; ai < 2; ++ai)
#pragma unroll
            for (int m = 0; m < 4; ++m) { const int row = row0 + ai * 128 + m * 16;
                const f32x4 q0 = *(const f32x4*)(ssq + (size_t)row * 8), q1 = *(const f32x4*)(ssq + (size_t)row * 8 + 4);
                const float sq = ((q0[0] + q0[1]) + (q0[2] + q0[3])) + ((q1[0] + q1[1]) + (q1[2] + q1[3]));
                const float sc = 1.0f / sqrtf(sq * (1.0f / 512.0f) + EPS);
#pragma unroll
                for (int bj = 0; bj < 2; ++bj) *(u32x4*)(O + (size_t)row * 1024 + ct + bj * 128 + colw) = pack8(acc[ai][bj][m][0] * sc, acc[ai][bj][m][1] * sc); }
    }
};
struct EpiGate {
    static constexpr bool PERM = true;
    const bf16_t* G; bf16_t* TMP; bf16_t* MG; int second;
    __device__ __forceinline__ void operator()(const f32x4 (&acc)[2][2][4][2], const pg8::Unit& u, int wr, int wc, int fr, int fq) const {
        const int row0 = u.pm * 256 + wr * 64 + fr, colw = u.pn * 256 + wc * 32 + 8 * fq;
#pragma unroll
        for (int ai = 0; ai < 2; ++ai)
#pragma unroll
            for (int m = 0; m < 4; ++m) { const int row = row0 + ai * 128 + m * 16;
#pragma unroll
                for (int bj = 0; bj < 2; ++bj) { const int col = colw + bj * 128;
                    const u32x4 gw = *(const u32x4*)(G + (size_t)row * 4096 + (second ? 2048 : 0) + col);
                    f32x4 v0 = acc[ai][bj][m][0], v1 = acc[ai][bj][m][1];
                    v0 = (f32x4){v0[0] * bflo(gw.x), v0[1] * bfhi(gw.x), v0[2] * bflo(gw.y), v0[3] * bfhi(gw.y)};
                    v1 = (f32x4){v1[0] * bflo(gw.z), v1[1] * bfhi(gw.z), v1[2] * bflo(gw.w), v1[3] * bfhi(gw.w)};
                    if (second) { const u32x4 tw = *(const u32x4*)(TMP + (size_t)row * 2048 + col);
                        v0 += (f32x4){bflo(tw.x), bfhi(tw.x), bflo(tw.y), bfhi(tw.y)}; v1 += (f32x4){bflo(tw.z), bfhi(tw.z), bflo(tw.w), bfhi(tw.w)};
                        *(u32x4*)(MG + (size_t)row * 2048 + col) = pack8(v0, v1);
                    } else *(u32x4*)(TMP + (size_t)row * 2048 + col) = pack8(v0, v1); } }
    }
};
struct EpiRes {
    static constexpr bool PERM = false;
    const float* x; float* X2; bf16_t* X2B; float* ssq;
    __device__ __forceinline__ void operator()(const f32x4 (&acc)[2][2][4][2], const pg8::Unit& u, int wr, int wc, int fr, int fq) const {
        const int row0 = u.pm * 256 + wr * 64 + fr, col0 = u.pn * 256 + wc * 32 + 4 * fq;
#pragma unroll
        for (int ai = 0; ai < 2; ++ai)
#pragma unroll
            for (int m = 0; m < 4; ++m) { const int row = row0 + ai * 128 + m * 16; float s = 0.f;
#pragma unroll
                for (int bj = 0; bj < 2; ++bj)
#pragma unroll
                    for (int n = 0; n < 2; ++n) { const size_t off = (size_t)row * 2048 + col0 + bj * 128 + n * 16;
                        const f32x4 v = acc[ai][bj][m][n] + *(const f32x4*)(x + off);
                        s += (v[0] * v[0] + v[1] * v[1]) + (v[2] * v[2] + v[3] * v[3]);
                        *(f32x4*)(X2 + off) = v; u32x2 w; w.x = cvtpk(v[0], v[1]); w.y = cvtpk(v[2], v[3]); *(u32x2*)(X2B + off) = w; }
                s += __shfl_xor(s, 16); s += __shfl_xor(s, 32);
                if (fq == 0) ssq[(size_t)row * 32 + u.pn * 4 + wc] = s; }
    }
};
__device__ __forceinline__ float sum32(const float* p) { float t = 0.f;
#pragma unroll
    for (int i = 0; i < 8; ++i) { const f32x4 q = *(const f32x4*)(p + 4 * i); t += (q[0] + q[1]) + (q[2] + q[3]); } return t; }
struct EpiQP {
    static constexpr bool PERM = true;
    bf16_t* QP; const float* ssq;
    __device__ __forceinline__ void operator()(const f32x4 (&acc)[2][2][4][2], const pg8::Unit& u, int wr, int wc, int fr, int fq) const {
        const int row0 = u.pm * 256 + wr * 64 + fr, colw = u.pn * 256 + wc * 32 + 8 * fq;
#pragma unroll
        for (int ai = 0; ai < 2; ++ai)
#pragma unroll
            for (int m = 0; m < 4; ++m) { const int row = row0 + ai * 128 + m * 16;
                const float sc = 1.0f / sqrtf(sum32(ssq + (size_t)row * 32) * (1.0f / 2048.0f) + EPS);
#pragma unroll
                for (int bj = 0; bj < 2; ++bj) *(u32x4*)(QP + (size_t)row * 2048 + colw + bj * 128) = pack8(acc[ai][bj][m][0] * sc, acc[ai][bj][m][1] * sc); }
    }
};

__device__ __forceinline__ void naive_attn(LAS float* qs, const bf16* qa, int ldqa, int da, const bf16* qb, int ldqb, int db,
                                           const bf16* ka, int ldka, const bf16* kb, int ldkb, const bf16* v, int ldv,
                                           size_t rowbase, int p0, int lane, float (&o)[4][2], float (&linv)[4]) {
    const int dt = da + db;
    for (int idx = lane; idx < 4 * dt; idx += 64) { const int r = idx / dt, d = idx - r * dt;
        const bf16 h = d < da ? qa[(rowbase + p0 + r) * ldqa + d] : qb[(rowbase + p0 + r) * ldqb + (d - da)];
        qs[r * 192 + d] = bf2f(h); }
    LDS_WAIT(); asm volatile("" ::: "memory");
    float m[4], l[4];
#pragma unroll
    for (int r = 0; r < 4; ++r) { m[r] = -INFINITY; l[r] = 0.f; o[r][0] = 0.f; o[r][1] = 0.f; }
    const int pmax = p0 + 3, ntile = pmax / 64 + 1;
#pragma unroll 1
    for (int kt = 0; kt < ntile; ++kt) {
        const int key = kt * 64 + lane, kc = key < pmax ? key : pmax;
        float s[4] = {0.f, 0.f, 0.f, 0.f};
        const bf16* kra = ka + (rowbase + kc) * ldka;
#pragma unroll 2
        for (int d = 0; d < da; d += 8) { const u32x4 kw = *(const u32x4*)(kra + d);
            const float k0 = bflo(kw.x), k1 = bfhi(kw.x), k2 = bflo(kw.y), k3 = bfhi(kw.y), k4 = bflo(kw.z), k5 = bfhi(kw.z), k6 = bflo(kw.w), k7 = bfhi(kw.w);
#pragma unroll
            for (int r = 0; r < 4; ++r) { const f32x4 qa4 = *(const LAS f32x4*)(qs + r * 192 + d), qb4 = *(const LAS f32x4*)(qs + r * 192 + d + 4);
                s[r] += (qa4[0] * k0 + qa4[1] * k1) + (qa4[2] * k2 + qa4[3] * k3) + (qb4[0] * k4 + qb4[1] * k5) + (qb4[2] * k6 + qb4[3] * k7); } }
        if (db > 0) { const bf16* krb = kb + (rowbase + kc) * ldkb;
#pragma unroll 2
            for (int d = 0; d < db; d += 8) { const u32x4 kw = *(const u32x4*)(krb + d);
                const float k0 = bflo(kw.x), k1 = bfhi(kw.x), k2 = bflo(kw.y), k3 = bfhi(kw.y), k4 = bflo(kw.z), k5 = bfhi(kw.z), k6 = bflo(kw.w), k7 = bfhi(kw.w);
#pragma unroll
                for (int r = 0; r < 4; ++r) { const f32x4 qa4 = *(const LAS f32x4*)(qs + r * 192 + da + d), qb4 = *(const LAS f32x4*)(qs + r * 192 + da + d + 4);
                    s[r] += (qa4[0] * k0 + qa4[1] * k1) + (qa4[2] * k2 + qa4[3] * k3) + (qb4[0] * k4 + qb4[1] * k5) + (qb4[2] * k6 + qb4[3] * k7); } } }
        float p[4];
#pragma unroll
        for (int r = 0; r < 4; ++r) {
            const float sv = key > p0 + r ? -INFINITY : s[r];
            const float mn = fmaxf(m[r], wave_max(sv));
            const float al = __builtin_amdgcn_exp2f(m[r] - mn);
            p[r] = __builtin_amdgcn_exp2f(sv - mn);
            l[r] = l[r] * al + wave_sum(p[r]); o[r][0] *= al; o[r][1] *= al; m[r] = mn;
        }
        const int jn = (pmax - kt * 64) < 63 ? (pmax - kt * 64) : 63;
#pragma unroll 4
        for (int j = 0; j <= jn; ++j) {
            const bf16* vr = v + (rowbase + kt * 64 + j) * ldv;
            const float v0 = bf2f(vr[lane]), v1 = bf2f(vr[64 + lane]);
#pragma unroll
            for (int r = 0; r < 4; ++r) { const float pj = __builtin_bit_cast(float, __builtin_amdgcn_readlane(__builtin_bit_cast(int, p[r]), j)); o[r][0] += pj * v0; o[r][1] += pj * v1; }
        }
    }
#pragma unroll
    for (int r = 0; r < 4; ++r) linv[r] = 1.0f / l[r];
    LDS_WAIT(); asm volatile("" ::: "memory");
}
__device__ __forceinline__ void p3_attention_ref(Frame& F, const Ins& I) {
    unsigned char* ws = F.ws;
    const bf16 *QN = (const bf16*)(ws + WS_QN), *QR = (const bf16*)(ws + WS_QR), *KN = (const bf16*)(ws + WS_KN), *KR = (const bf16*)(ws + WS_KR), *V = (const bf16*)(ws + WS_V);
    const bf16 *DQ = (const bf16*)(ws + WS_DQ), *DK = (const bf16*)(ws + WS_DK), *DV = (const bf16*)(ws + WS_DV);
    bf16 *OM = (bf16*)(ws + WS_OM), *OD = (bf16*)(ws + WS_OD);
    LAS float* qs = (LAS float*)(F.lds + RING_OFF + F.wave * 4096);
    const int gw = F.vcu * NWAVES + F.wave, NGW = F.G * NWAVES, lane = F.lane;
    const float lam = ((const float*)F.ctl)[CW_LAMBDA];
    const float gs0 = I.g_subln[lane] * (1.0f - LAMBDA_INIT), gs1 = I.g_subln[64 + lane] * (1.0f - LAMBDA_INIT);
    for (int it = gw; it < 2 * 16 * (SEQ / 4); it += NGW) {
        const int type = it & 1, rest = it >> 1, bh = rest & 15, g = rest >> 4, b = bh >> 3, h = bh & 7, p0 = 4 * g;
        const size_t rowbase = (size_t)b * SEQ;
        float o[4][2], li[4];
        if (type == 0) {
            naive_attn(qs, QN + h * 128, 1024, 128, QR + h * 64, 512, 64, KN + h * 128, 1024, KR, 64, V + h * 128, 1024, rowbase, p0, lane, o, li);
#pragma unroll
            for (int r = 0; r < 4; ++r) { bf16* orow = OM + (rowbase + p0 + r) * 1024 + h * 128;
#ifdef ATT_CHECK
                { const float a0 = bf2f(orow[lane]), a1 = bf2f(orow[64 + lane]), b0 = o[r][0] * li[r], b1 = o[r][1] * li[r];
                  if (fabsf(a0 - b0) > ATT_TOL_A + ATT_TOL_R * fabsf(b0) || fabsf(a1 - b1) > ATT_TOL_A + ATT_TOL_R * fabsf(b1) || !(a0 == a0) || !(a1 == a1)) atomicAdd((unsigned*)F.ctl + 16, 1u); }
#else
                orow[lane] = (bf16)(pk2(o[r][0] * li[r], 0.f) & 0xffffu); orow[64 + lane] = (bf16)(pk2(o[r][1] * li[r], 0.f) & 0xffffu);
#endif
            }
        } else {
            float o2[4][2], li2[4];
            naive_attn(qs, DQ + (h * 2) * 64, 1024, 64, DQ, 1024, 0, DK + (h * 2) * 64, 1024, DK, 1024, DV + h * 128, 1024, rowbase, p0, lane, o, li);
            naive_attn(qs, DQ + (h * 2 + 1) * 64, 1024, 64, DQ, 1024, 0, DK + (h * 2 + 1) * 64, 1024, DK, 1024, DV + h * 128, 1024, rowbase, p0, lane, o2, li2);
#pragma unroll
            for (int r = 0; r < 4; ++r) {
                const float d0 = o[r][0] * li[r] - lam * o2[r][0] * li2[r], d1 = o[r][1] * li[r] - lam * o2[r][1] * li2[r];
                const float rs = 1.0f / sqrtf(wave_sum(d0 * d0 + d1 * d1) * (1.0f / 128.0f) + EPS);
                bf16* orow = OD + (rowbase + p0 + r) * 1024 + h * 128;
#ifdef ATT_CHECK
                { const float a0 = bf2f(orow[lane]), a1 = bf2f(orow[64 + lane]), b0 = d0 * rs * gs0, b1 = d1 * rs * gs1;
                  if (fabsf(a0 - b0) > ATT_TOL_A + ATT_TOL_R * fabsf(b0) || fabsf(a1 - b1) > ATT_TOL_A + ATT_TOL_R * fabsf(b1) || !(a0 == a0) || !(a1 == a1)) atomicAdd((unsigned*)F.ctl + 17, 1u); }
#else
                orow[lane] = (bf16)(pk2(d0 * rs * gs0, 0.f) & 0xffffu); orow[64 + lane] = (bf16)(pk2(d1 * rs * gs1, 0.f) & 0xffffu);
#endif
            }
        }
    }
}

namespace att {
typedef short bf16x8 __attribute__((ext_vector_type(8)));
typedef short s16x4 __attribute__((ext_vector_type(4)));
typedef float f32x16 __attribute__((ext_vector_type(16)));
typedef short v4i16_t __attribute__((ext_vector_type(4)));
constexpr int BUFB = 40960, WSF_OFF = 2 * BUFB;
__device__ __forceinline__ int crow(int r, int hi) { return (r & 3) + 8 * (r >> 2) + 4 * hi; }
__device__ __forceinline__ s16x4 vtr(const LAS unsigned char* p) { return __builtin_bit_cast(s16x4, __builtin_amdgcn_ds_read_tr16_b64_v4i16((LAS v4i16_t*)p)); }
__device__ __forceinline__ float swapmax(float m) { auto rr = __builtin_amdgcn_permlane32_swap(__float_as_uint(m), __float_as_uint(m), false, false);
    const unsigned a = rr[0], b = rr[1]; return fmaxf(__uint_as_float(a), __uint_as_float(b)); }
__device__ __forceinline__ float swapsum(float m) { auto rr = __builtin_amdgcn_permlane32_swap(__float_as_uint(m), __float_as_uint(m), false, false);
    const unsigned a = rr[0], b = rr[1]; return __uint_as_float(a) + __uint_as_float(b); }

template <bool DIFF>
__device__ __forceinline__ void attn_unit(LAS unsigned char* lds, int tid, size_t rowbase, int h, int q0,
                                          const bf16* Qa, const bf16* Qb, const bf16* Ka, const bf16* Kb, const bf16* Vp, bf16* Op, float lam, const float* gsub) {
    constexpr int NP = DIFF ? 4 : 5, NKS = DIFF ? 4 : 12, KPIECES = DIFF ? 16 : 24, R = DIFF ? 128 : 256;
    const int lane = tid & 63, r32 = lane & 31, hi = lane >> 5, wid = __builtin_amdgcn_readfirstlane(tid >> 6);
    const int mp = DIFF ? (wid >> 2) : 0, rows_w0 = q0 + 32 * (DIFF ? (wid & 3) : wid);
    const char* src[NP]; unsigned tstr[NP]; unsigned dsto[NP];
#pragma unroll
    for (int i = 0; i < NP; ++i) { const int pidx = wid * NP + i;
        if (!DIFF) {
            if (pidx < 16) { src[i] = (const char*)(Ka + (rowbase + lane) * 1024 + h * 128 + pidx * 8); tstr[i] = 64 * 2048; dsto[i] = pidx * 1024; }
            else if (pidx < 24) { src[i] = (const char*)(Kb + (rowbase + lane) * 64 + (pidx - 16) * 8); tstr[i] = 64 * 128; dsto[i] = pidx * 1024; }
            else { const int v = pidx - 24, dblk = v >> 2, kg = v & 3; src[i] = (const char*)(Vp + (rowbase + kg * 16 + (lane >> 2)) * 1024 + h * 128 + dblk * 32 + (lane & 3) * 8); tstr[i] = 64 * 2048; dsto[i] = (24 + v) * 1024; }
        } else {
            if (pidx < 16) { const int m2 = pidx >> 3, c = pidx & 7; src[i] = (const char*)(Ka + (rowbase + lane) * 1024 + (h * 2 + m2) * 64 + c * 8); tstr[i] = 64 * 2048; dsto[i] = pidx * 1024; }
            else { const int v = pidx - 16, dblk = v >> 2, kg = v & 3; src[i] = (const char*)(Vp + (rowbase + kg * 16 + (lane >> 2)) * 1024 + h * 128 + dblk * 32 + (lane & 3) * 8); tstr[i] = 64 * 2048; dsto[i] = (16 + v) * 1024; }
        } }
#define ATT_DMA(t, bb) do { _Pragma("unroll") for (int _i = 0; _i < NP; ++_i) \
        __builtin_amdgcn_global_load_lds((const unsigned*)(src[_i] + (size_t)(t) * tstr[_i]), (LAS unsigned*)(lds + (bb) * BUFB + dsto[_i]), 16, 0, 0); } while (0)
    bf16x8 qf[NKS];
    { const size_t qrow = rowbase + rows_w0 + r32;
#pragma unroll
      for (int ks = 0; ks < NKS; ++ks) {
          if (DIFF) qf[ks] = *(const bf16x8*)(Qa + qrow * 1024 + (h * 2 + mp) * 64 + ks * 16 + hi * 8);
          else if (ks < 8) qf[ks] = *(const bf16x8*)(Qa + qrow * 1024 + h * 128 + ks * 16 + hi * 8);
          else qf[ks] = *(const bf16x8*)(Qb + qrow * 512 + h * 64 + (ks - 8) * 16 + hi * 8);
      } }
    f32x16 o[4];
#pragma unroll
    for (int d0 = 0; d0 < 4; ++d0) o[d0] = f32x16{};
    float m = -1e30f, l = 0.f;
    const int NT = (q0 + R) / 64, t_last = (rows_w0 + 31) / 64;
    LAS float* wsf = (LAS float*)(lds + WSF_OFF) + wid * 32;
    const int koff = (DIFF ? mp * 8 * 1024 : 0) + hi * 1024 + r32 * 16;
    const int voff = KPIECES * 1024 + ((lane >> 4) & 1) * 32 + (lane & 3) * 8 + (4 * hi + ((lane & 15) >> 2)) * 64;
    const int qpos = rows_w0 + r32;
    ATT_DMA(0, 0);
    asm volatile("s_waitcnt vmcnt(0)" ::: "memory"); __syncthreads();
#pragma unroll 1
    for (int t = 0; t < NT; ++t) {
        const int bb = t & 1;
        if (t + 1 < NT) ATT_DMA(t + 1, bb ^ 1);
        if (t <= t_last) {
            const LAS unsigned char* kb = lds + bb * BUFB + koff;
            f32x16 p0 = f32x16{}, p1 = f32x16{};
#pragma unroll
            for (int ks = 0; ks < NKS; ++ks) {
                const bf16x8 ka = *(const LAS bf16x8*)(kb + ks * 2048), kc = *(const LAS bf16x8*)(kb + ks * 2048 + 512);
                p0 = __builtin_amdgcn_mfma_f32_32x32x16_bf16(ka, qf[ks], p0, 0, 0, 0);
                p1 = __builtin_amdgcn_mfma_f32_32x32x16_bf16(kc, qf[ks], p1, 0, 0, 0);
            }
            if (64 * t + 63 > rows_w0) {
                const int kb0 = 64 * t + 4 * hi;
#pragma unroll
                for (int r = 0; r < 16; ++r) { const int kv = kb0 + (r & 3) + 8 * (r >> 2); if (kv > qpos) p0[r] = -INFINITY; if (kv + 32 > qpos) p1[r] = -INFINITY; }
            }
            float rm = fmaxf(p0[0], p1[0]);
#pragma unroll
            for (int r = 1; r < 16; ++r) rm = fmaxf(rm, fmaxf(p0[r], p1[r]));
            rm = swapmax(rm);
            const float mn = fmaxf(m, rm);
            if (__any(mn > m)) {
                const float al = __builtin_amdgcn_exp2f(m - mn);
                l *= al;
                if (hi == 0) wsf[r32] = al;
                LDS_WAIT(); asm volatile("" ::: "memory");
#pragma unroll
                for (int r = 0; r < 16; ++r) { const float a = wsf[crow(r, hi)];
#pragma unroll
                    for (int d0 = 0; d0 < 4; ++d0) o[d0][r] *= a; }
                LDS_WAIT(); asm volatile("" ::: "memory");
            }
            m = mn;
            float ps = 0.f;
#pragma unroll
            for (int r = 0; r < 16; ++r) { p0[r] = __builtin_amdgcn_exp2f(p0[r] - mn); p1[r] = __builtin_amdgcn_exp2f(p1[r] - mn); ps += p0[r] + p1[r]; }
            l += ps;
            u32x4 pw[4];
            pw[0] = (u32x4){cvtpk(p0[0], p0[1]), cvtpk(p0[2], p0[3]), cvtpk(p0[4], p0[5]), cvtpk(p0[6], p0[7])};
            pw[1] = (u32x4){cvtpk(p0[8], p0[9]), cvtpk(p0[10], p0[11]), cvtpk(p0[12], p0[13]), cvtpk(p0[14], p0[15])};
            pw[2] = (u32x4){cvtpk(p1[0], p1[1]), cvtpk(p1[2], p1[3]), cvtpk(p1[4], p1[5]), cvtpk(p1[6], p1[7])};
            pw[3] = (u32x4){cvtpk(p1[8], p1[9]), cvtpk(p1[10], p1[11]), cvtpk(p1[12], p1[13]), cvtpk(p1[14], p1[15])};
            const LAS unsigned char* vb = lds + bb * BUFB + voff;
#pragma unroll
            for (int d0 = 0; d0 < 4; ++d0)
#pragma unroll
                for (int ks = 0; ks < 4; ++ks) {
                    const s16x4 lo = vtr(vb + (d0 * 4 + ks) * 1024), hh = vtr(vb + (d0 * 4 + ks) * 1024 + 512);
                    const bf16x8 vf = (bf16x8){lo[0], lo[1], lo[2], lo[3], hh[0], hh[1], hh[2], hh[3]};
                    o[d0] = __builtin_amdgcn_mfma_f32_32x32x16_bf16(__builtin_bit_cast(bf16x8, pw[ks]), vf, o[d0], 0, 0, 0);
                }
        }
        asm volatile("s_waitcnt vmcnt(0)" ::: "memory"); __syncthreads();
    }
#undef ATT_DMA
    l = swapsum(l);
    if (hi == 0) wsf[r32] = l;
    LDS_WAIT(); asm volatile("" ::: "memory");
    float rli[16];
#pragma unroll
    for (int r = 0; r < 16; ++r) rli[r] = 1.0f / wsf[crow(r, hi)];
    LDS_WAIT(); asm volatile("" ::: "memory");
    if (!DIFF) {
#pragma unroll
        for (int r = 0; r < 16; ++r) { bf16* orow = Op + (rowbase + rows_w0 + crow(r, hi)) * 1024 + h * 128 + r32;
#pragma unroll
            for (int d0 = 0; d0 < 4; ++d0) orow[d0 * 32] = (bf16)(cvtpk(o[d0][r] * rli[r], 0.f) & 0xffffu); }
    } else {
        LAS float* xch = (LAS float*)lds;
        if (wid >= 4) {
#pragma unroll
            for (int d0 = 0; d0 < 4; ++d0)
#pragma unroll
                for (int r = 0; r < 16; ++r) xch[((wid & 3) * 64 + d0 * 16 + r) * 64 + lane] = o[d0][r] * rli[r];
        }
        __syncthreads();
        if (wid < 4) {
            float ss[16];
#pragma unroll
            for (int r = 0; r < 16; ++r) ss[r] = 0.f;
#pragma unroll
            for (int d0 = 0; d0 < 4; ++d0)
#pragma unroll
                for (int r = 0; r < 16; ++r) { const float d = o[d0][r] * rli[r] - lam * xch[(wid * 64 + d0 * 16 + r) * 64 + lane]; o[d0][r] = d; ss[r] += d * d; }
#pragma unroll
            for (int r = 0; r < 16; ++r) {
#pragma unroll
                for (int of = 1; of < 32; of <<= 1) ss[r] += __shfl_xor(ss[r], of);
                ss[r] = 1.0f / sqrtf(ss[r] * (1.0f / 128.0f) + EPS); }
            float g4[4];
#pragma unroll
            for (int d0 = 0; d0 < 4; ++d0) g4[d0] = gsub[d0 * 32 + r32] * (1.0f - LAMBDA_INIT);
#pragma unroll
            for (int r = 0; r < 16; ++r) { bf16* orow = Op + (rowbase + rows_w0 + crow(r, hi)) * 1024 + h * 128 + r32;
#pragma unroll
                for (int d0 = 0; d0 < 4; ++d0) orow[d0 * 32] = (bf16)(cvtpk(o[d0][r] * ss[r] * g4[d0], 0.f) & 0xffffu); }
        }
        __syncthreads();
    }
}
}

__device__ __forceinline__ void p3_attention(Frame& F, const Ins& I) {
    unsigned char* ws = F.ws;
    const bf16 *QN = (const bf16*)(ws + WS_QN), *QR = (const bf16*)(ws + WS_QR), *KN = (const bf16*)(ws + WS_KN), *KR = (const bf16*)(ws + WS_KR), *V = (const bf16*)(ws + WS_V);
    const bf16 *DQ = (const bf16*)(ws + WS_DQ), *DK = (const bf16*)(ws + WS_DK), *DV = (const bf16*)(ws + WS_DV);
    bf16 *OM = (bf16*)(ws + WS_OM), *OD = (bf16*)(ws + WS_OD);
    const float lam = ((const float*)F.ctl)[CW_LAMBDA];
    LAS unsigned char* lds = F.lds + RING_OFF;
    for (int v = F.vcu; v < 256; v += F.G) {
        const int bh = v >> 4, c = v & 15, b = bh >> 3, h = bh & 7; const size_t rowbase = (size_t)b * SEQ;
        att::attn_unit<false>(lds, F.tid, rowbase, h, (31 - c) * 256, QN, QR, KN, KR, V, OM, lam, I.g_subln);
        att::attn_unit<true>(lds, F.tid, rowbase, h, (63 - c) * 128, DQ, nullptr, DK, nullptr, DV, OD, lam, I.g_subln);
        att::attn_unit<true>(lds, F.tid, rowbase, h, (47 - c) * 128, DQ, nullptr, DK, nullptr, DV, OD, lam, I.g_subln);
        att::attn_unit<true>(lds, F.tid, rowbase, h, (16 + c) * 128, DQ, nullptr, DK, nullptr, DV, OD, lam, I.g_subln);
        att::attn_unit<true>(lds, F.tid, rowbase, h, c * 128, DQ, nullptr, DK, nullptr, DV, OD, lam, I.g_subln);
        att::attn_unit<false>(lds, F.tid, rowbase, h, c * 256, QN, QR, KN, KR, V, OM, lam, I.g_subln);
    }
}

__device__ __forceinline__ void wave_argmax(float v, int idx, float& mv, int& mi) {
#pragma unroll
    for (int o = 1; o < 64; o <<= 1) { const float ov = __shfl_xor(v, o); const int oi = __shfl_xor(idx, o); if (ov > v || (ov == v && oi < idx)) { v = ov; idx = oi; } }
    mv = v; mi = idx;
}
__device__ __forceinline__ void p7_routing_ref(Frame& F) {
    unsigned char* ws = F.ws;
    const bf16* QP = (const bf16*)(ws + WS_QP); const bf16* SKB = (const bf16*)(ws + WS_SKB);
    int* IDX = (int*)(ws + WS_IDX); float* GT = (float*)(ws + WS_GT);
    LAS float* wl = (LAS float*)(F.lds + RING_OFF + F.wave * 4096);
    LAS float* qs = wl; LAS float* v1s = wl + 256; LAS int* i1s = (LAS int*)(wl + 272); LAS float* v2s = wl + 288; LAS int* i2s = (LAS int*)(wl + 304);
    const int gw = F.vcu * NWAVES + F.wave, NGW = F.G * NWAVES, lane = F.lane;
    for (int it = gw; it < T * 8; it += NGW) {
        { const u32x2 w = *(const u32x2*)(QP + (size_t)it * 256 + lane * 4); qs[lane * 4 + 0] = bflo(w.x); qs[lane * 4 + 1] = bfhi(w.x); qs[lane * 4 + 2] = bflo(w.y); qs[lane * 4 + 3] = bfhi(w.y); }
        LDS_WAIT(); asm volatile("" ::: "memory");
        float sc[2][2];
#pragma unroll
        for (int hf = 0; hf < 2; ++hf)
#pragma unroll
            for (int kk = 0; kk < 2; ++kk) { const bf16* kr = SKB + (size_t)(hf * 128 + kk * 64 + lane) * 256 + hf * 128; float s = 0.f;
#pragma unroll 4
                for (int d = 0; d < 128; d += 8) { const u32x4 kw = *(const u32x4*)(kr + d);
                    const f32x4 qa4 = *(const LAS f32x4*)(qs + hf * 128 + d), qb4 = *(const LAS f32x4*)(qs + hf * 128 + d + 4);
                    s += (qa4[0] * bflo(kw.x) + qa4[1] * bfhi(kw.x)) + (qa4[2] * bflo(kw.y) + qa4[3] * bfhi(kw.y)) + (qb4[0] * bflo(kw.z) + qb4[1] * bfhi(kw.z)) + (qb4[2] * bflo(kw.w) + qb4[3] * bfhi(kw.w)); }
                sc[hf][kk] = s; }
#pragma unroll
        for (int hf = 0; hf < 2; ++hf) {
            float a = sc[hf][0], b = sc[hf][1];
            for (int r = 0; r < 16; ++r) {
                float lv; int li; if (b > a) { lv = b; li = lane + 64; } else { lv = a; li = lane; }
                float mv; int mi; wave_argmax(lv, li, mv, mi);
                if (mi == lane) a = -INFINITY; if (mi == lane + 64) b = -INFINITY;
                if (lane == 0) { if (hf == 0) { v1s[r] = mv; i1s[r] = mi; } else { v2s[r] = mv; i2s[r] = mi; } }
            }
        }
        LDS_WAIT(); asm volatile("" ::: "memory");
        float cv[4];
#pragma unroll
        for (int j = 0; j < 4; ++j) { const int c = lane * 4 + j; cv[j] = v1s[c >> 4] + v2s[c & 15]; }
        float mycs = 0.f; int myc = 0;
        for (int r = 0; r < 16; ++r) {
            float lv = cv[0]; int li = lane * 4;
#pragma unroll
            for (int j = 1; j < 4; ++j) if (cv[j] > lv) { lv = cv[j]; li = lane * 4 + j; }
            float mv; int mi; wave_argmax(lv, li, mv, mi);
#pragma unroll
            for (int j = 0; j < 4; ++j) if (mi == lane * 4 + j) cv[j] = -INFINITY;
            if (lane == r) { mycs = mv; myc = mi; }
        }
        float mx = mycs;
#pragma unroll
        for (int o = 1; o < 16; o <<= 1) mx = fmaxf(mx, __shfl_xor(mx, o));
        const float e = __expf(mycs - mx); float se = e;
#pragma unroll
        for (int o = 1; o < 16; o <<= 1) se += __shfl_xor(se, o);
        if (lane < 16) { const int ex = i1s[myc >> 4] * 128 + i2s[myc & 15];
            IDX[(size_t)it * 16 + lane] = ex; GT[(size_t)it * 16 + lane] = e / se; }
        LDS_WAIT(); asm volatile("" ::: "memory");
    }
}

__device__ __forceinline__ void unpack8(const u32x4 w, float (&f)[8]) { f[0] = bflo(w.x); f[1] = bfhi(w.x); f[2] = bflo(w.y); f[3] = bfhi(w.y); f[4] = bflo(w.z); f[5] = bfhi(w.z); f[6] = bflo(w.w); f[7] = bfhi(w.w); }
__device__ __forceinline__ void p8_gather(Frame& F, const Ins& I, float* out) {
    unsigned char* ws = F.ws;
    const float* X2 = (const float*)(ws + WS_X2); const bf16* EU = (const bf16*)(ws + WS_EU); const bf16* EV = (const bf16*)(ws + WS_EV);
    const int* IDX = (const int*)(ws + WS_IDX); const float* GT = (const float*)(ws + WS_GT);
    const float* ssq2 = (const float*)(ws + WS_PSQ2);
    const int gw = F.vcu * NWAVES + F.wave, NGW = F.G * NWAVES, lane = F.lane;
    for (int t = gw; t < T; t += NGW) {
        float xv[4][8], acc[4][8];
#pragma unroll
        for (int j = 0; j < 4; ++j) { const f32x4 a = *(const f32x4*)(X2 + (size_t)t * 2048 + 512 * j + 8 * lane), b = *(const f32x4*)(X2 + (size_t)t * 2048 + 512 * j + 8 * lane + 4);
            xv[j][0] = a[0]; xv[j][1] = a[1]; xv[j][2] = a[2]; xv[j][3] = a[3]; xv[j][4] = b[0]; xv[j][5] = b[1]; xv[j][6] = b[2]; xv[j][7] = b[3];
#pragma unroll
            for (int e = 0; e < 8; ++e) acc[j][e] = 0.f; }
        const float rstd2 = 1.0f / sqrtf(sum32(ssq2 + (size_t)t * 32) * (1.0f / 2048.0f) + EPS);
        const int id0 = IDX[(size_t)t * 128 + lane], id1 = IDX[(size_t)t * 128 + 64 + lane];
        const float g0 = GT[(size_t)t * 128 + lane], g1 = GT[(size_t)t * 128 + 64 + lane];
        for (int i = 0; i < 128; ++i) {
            const int ex = __builtin_amdgcn_readlane(i < 64 ? id0 : id1, i & 63);
            const float gate = __builtin_bit_cast(float, __builtin_amdgcn_readlane(__builtin_bit_cast(int, i < 64 ? g0 : g1), i & 63));
            const bf16* ur = EU + (size_t)ex * 2048 + 8 * lane; const bf16* vr = EV + (size_t)ex * 2048 + 8 * lane;
            u32x4 uw[4], vw[4];
#pragma unroll
            for (int j = 0; j < 4; ++j) { uw[j] = *(const u32x4*)(ur + 512 * j); vw[j] = *(const u32x4*)(vr + 512 * j); }
            float dot = 0.f;
#pragma unroll
            for (int j = 0; j < 4; ++j) { float f[8]; unpack8(uw[j], f);
#pragma unroll
                for (int e = 0; e < 8; ++e) dot += f[e] * xv[j][e]; }
            const float a = wave_sum(dot) * rstd2;
            const float z2 = 1.5957691216057308f * (a + 0.044715f * a * a * a);
            const float w = gate * a * __builtin_amdgcn_rcpf(1.0f + __builtin_amdgcn_exp2f(-z2 * LOG2E));
#pragma unroll
            for (int j = 0; j < 4; ++j) { float f[8]; unpack8(vw[j], f);
#pragma unroll
                for (int e = 0; e < 8; ++e) acc[j][e] += w * f[e]; }
        }
        float s = 0.f;
#pragma unroll
        for (int j = 0; j < 4; ++j)
#pragma unroll
            for (int e = 0; e < 8; ++e) { acc[j][e] += xv[j][e]; s += acc[j][e] * acc[j][e]; }
        float rs = 1.0f / sqrtf(wave_sum(s) * (1.0f / 2048.0f) + EPS);
#ifdef ATT_CHECK
        if (((const unsigned*)F.ctl)[ATT_CHECK_WORD] > ATT_CHECK_MAX) rs = __builtin_nanf("");
#endif
#pragma unroll
        for (int j = 0; j < 4; ++j) { const f32x4 ga = *(const f32x4*)(I.g_final + 512 * j + 8 * lane), gb = *(const f32x4*)(I.g_final + 512 * j + 8 * lane + 4);
            *(f32x4*)(out + (size_t)t * 2048 + 512 * j + 8 * lane) = (f32x4){acc[j][0] * rs * ga[0], acc[j][1] * rs * ga[1], acc[j][2] * rs * ga[2], acc[j][3] * rs * ga[3]};
            *(f32x4*)(out + (size_t)t * 2048 + 512 * j + 8 * lane + 4) = (f32x4){acc[j][4] * rs * gb[0], acc[j][5] * rs * gb[1], acc[j][6] * rs * gb[2], acc[j][7] * rs * gb[3]}; }
    }
}

constexpr int NPHASE = 10;
struct Args { Ins in; float* out; unsigned char* ws; double inv_freq[32]; int ph_lo, ph_hi; };
__global__ void __launch_bounds__(NWAVES * 64, 2) mega_fwd(Args args) {
    extern __shared__ __attribute__((aligned(16))) unsigned char lds[];
    Frame F;
    F.lds = (LAS unsigned char*)lds;
    F.MISC = (volatile LAS unsigned*)(F.lds + MISC_OFF);
    F.tid = threadIdx.x; F.lane = F.tid & 63; F.wave = __builtin_amdgcn_readfirstlane(F.tid >> 6);
    F.G = gridDim.x; { const int bx = blockIdx.x; F.vcu = (F.G % 8 == 0) ? (bx % 8) * (F.G / 8) + bx / 8 : bx; }
    unsigned char* ws = args.ws; F.ws = ws;
    F.ctl = (gu32*)(ws + WS_CTL);
    const Ins& I = args.in;
    for (int u = F.tid; u < (LDS_BYTES - LDSCTL_OFF) / 4; u += NWAVES * 64) ((LAS unsigned*)(F.lds + LDSCTL_OFF))[u] = 0u;
    __syncthreads();
    XcdBarrier bar; bar.bar = (unsigned*)(F.ctl + CW_BAR); bar.x = 0; bar.st = nullptr;
#if MK_N_LAUNCHES == 1
    bar = xcd_barrier_post((unsigned*)(F.ctl + CW_BAR), F.MISC + 8);
#define GRID_BAR() xcd_barrier(bar)
#else
#define GRID_BAR() do {} while (0)
#endif
    const int lo = args.ph_lo, hi = args.ph_hi;
#ifndef PH_MASK
#define PH_MASK 0xFFFF
#endif
#define IN(k) (((PH_MASK >> (k)) & 1) && lo <= (k) && (k) < hi)
#define BOTH(k) (IN(k) && IN((k) + 1))
    float* ssq_q = (float*)(ws + WS_PSQ_Q); float* ssq_kv = (float*)(ws + WS_PSQ_KV); float* ssq2 = (float*)(ws + WS_PSQ2);
    const float* rope = (const float*)(ws + WS_ROPE);

    if (IN(0)) { p0_prologue(F, I, args.inv_freq); if (BOTH(0)) GRID_BAR(); }

    if (IN(1)) {
        pg8::Gemm g{(const bf16_t*)(ws + WS_H), (const bf16_t*)(ws + WS_W1), T, N1, 2048, 2048}; pg8::StaticOrder S; S.init(T, N1, F.G, (int)blockIdx.x);
        EpiProj E{(bf16_t*)(ws + WS_CQ), (bf16_t*)(ws + WS_CKV), (bf16_t*)(ws + WS_DQ), (bf16_t*)(ws + WS_DK), (bf16_t*)(ws + WS_DV), (bf16_t*)(ws + WS_G), (bf16_t*)(ws + WS_KR), ssq_q, ssq_kv, I.b_gate, rope};
        pg8::gemm_phase<EpiProj, pg8::StaticOrder, PG8_ALIGN, PG8_SP2>(F.lds + RING_OFF, g, S, E);
        if (BOTH(1)) GRID_BAR();
    }
    if (IN(2)) {
        { pg8::Gemm g{(const bf16_t*)(ws + WS_CQ), (const bf16_t*)(ws + WS_WUQ), T, 1536, 768, 768}; pg8::StaticOrder S; S.init(T, 1536, F.G, (int)blockIdx.x);
          EpiQup E{(bf16_t*)(ws + WS_QN), (bf16_t*)(ws + WS_QR), ssq_q, rope};
          pg8::gemm_phase<EpiQup, pg8::StaticOrder, PG8_ALIGN, PG8_SP2>(F.lds + RING_OFF, g, S, E); }
        { pg8::Gemm g{(const bf16_t*)(ws + WS_CKV), (const bf16_t*)(ws + WS_WUKV), T, 2048, 512, 512}; pg8::StaticOrder S; S.init(T, 2048, F.G, (int)blockIdx.x);
          EpiKVup E{(bf16_t*)(ws + WS_KN), (bf16_t*)(ws + WS_V), ssq_kv};
          pg8::gemm_phase<EpiKVup, pg8::StaticOrder, PG8_ALIGN, PG8_SP2>(F.lds + RING_OFF, g, S, E); }
        if (BOTH(2)) GRID_BAR();
    }
#ifdef ATT_REF
    if (IN(3)) { p3_attention_ref(F, I); if (BOTH(3)) GRID_BAR(); }
#else
    if (IN(3)) { p3_attention(F, I); if (BOTH(3)) GRID_BAR(); }
#ifdef ATT_CHECK
    if (IN(3)) { p3_attention_ref(F, I); GRID_BAR(); }
#endif
#endif
    if (IN(4)) {
        pg8::Gemm g{(const bf16_t*)(ws + WS_OM), (const bf16_t*)(ws + WS_WOM), T, 2048, 1024, 1024}; pg8::StaticOrder S; S.init(T, 2048, F.G, (int)blockIdx.x);
        EpiGate E{(const bf16_t*)(ws + WS_G), (bf16_t*)(ws + WS_TMP), (bf16_t*)(ws + WS_MG), 0};
        pg8::gemm_phase<EpiGate, pg8::StaticOrder, PG8_ALIGN, PG8_SP2>(F.lds + RING_OFF, g, S, E);
        if (BOTH(4)) GRID_BAR();
    }
    if (IN(5)) {
        pg8::Gemm g{(const bf16_t*)(ws + WS_OD), (const bf16_t*)(ws + WS_WOD), T, 2048, 1024, 1024}; pg8::StaticOrder S; S.init(T, 2048, F.G, (int)blockIdx.x);
        EpiGate E{(const bf16_t*)(ws + WS_G), (bf16_t*)(ws + WS_TMP), (bf16_t*)(ws + WS_MG), 1};
        pg8::gemm_phase<EpiGate, pg8::StaticOrder, PG8_ALIGN, PG8_SP2>(F.lds + RING_OFF, g, S, E);
        if (BOTH(5)) GRID_BAR();
    }
    if (IN(6)) {
        convert_experts(F, I);
        pg8::Gemm g{(const bf16_t*)(ws + WS_MG), (const bf16_t*)(ws + WS_WOUT), T, 2048, 2048, 2048}; pg8::StaticOrder S; S.init(T, 2048, F.G, (int)blockIdx.x);
        EpiRes E{I.x, (float*)(ws + WS_X2), (bf16_t*)(ws + WS_X2B), ssq2};
        pg8::gemm_phase<EpiRes, pg8::StaticOrder, PG8_ALIGN, PG8_SP2>(F.lds + RING_OFF, g, S, E);
        if (BOTH(6)) GRID_BAR();
    }
    if (IN(7)) {
        pg8::Gemm g{(const bf16_t*)(ws + WS_X2B), (const bf16_t*)(ws + WS_WQP), T, 2048, 2048, 2048}; pg8::StaticOrder S; S.init(T, 2048, F.G, (int)blockIdx.x);
        EpiQP E{(bf16_t*)(ws + WS_QP), ssq2};
        pg8::gemm_phase<EpiQP, pg8::StaticOrder, PG8_ALIGN, PG8_SP2>(F.lds + RING_OFF, g, S, E);
        if (BOTH(7)) GRID_BAR();
    }
    if (IN(8)) { p7_routing_ref(F); if (BOTH(8)) GRID_BAR(); }
    if (IN(9)) { p8_gather(F, I, args.out); }
#undef IN
#undef BOTH
}

extern "C" void kernel_launch(void* const* d_in, const int* in_sizes, int n_in, void* d_out, int out_size, void* d_ws, size_t ws_size, hipStream_t stream) {
    static int grid = 0;
    if (grid == 0) {
        if (n_in != 19 || out_size != T * D_MODEL || ws_size < WS_END) { fprintf(stderr, "kernel_launch: unexpected shapes: n_in %d out %d ws %zu\n", n_in, out_size, ws_size); grid = -1; return; }
        int dev = 0, cus = 0, per_cu = 0;
        if (hipGetDevice(&dev) != hipSuccess || hipDeviceGetAttribute(&cus, hipDeviceAttributeMultiprocessorCount, dev) != hipSuccess) { grid = -1; return; }
        if (hipFuncSetAttribute((const void*)mega_fwd, hipFuncAttributeMaxDynamicSharedMemorySize, LDS_BYTES) != hipSuccess) { fprintf(stderr, "kernel_launch: hipFuncSetAttribute failed\n"); grid = -1; return; }
        if (hipOccupancyMaxActiveBlocksPerMultiprocessor(&per_cu, (const void*)mega_fwd, NWAVES * 64, LDS_BYTES) != hipSuccess || per_cu < 1)
            fprintf(stderr, "kernel_launch: occupancy query reports %d workgroups per CU\n", per_cu);
        (void)hipGetLastError();
        grid = cus;
    }
    if (grid < 0) return;
    if (hipMemsetAsync((char*)d_ws + WS_CTL, 0, CTL_ZERO_BYTES, stream) != hipSuccess) { fprintf(stderr, "kernel_launch: memset failed\n"); return; }
    Args a{};
    const float** ip = (const float**)&a.in;
    for (int i = 0; i < 19; ++i) ip[i] = (const float*)d_in[i];
    a.out = (float*)d_out; a.ws = (unsigned char*)d_ws;
    for (int i = 0; i < 32; ++i) a.inv_freq[i] = pow(10000.0, -(double)i / 32.0);
#if MK_N_LAUNCHES == 1
    a.ph_lo = 0; a.ph_hi = NPHASE;
    hipLaunchKernelGGL(mega_fwd, dim3(grid), dim3(NWAVES * 64), LDS_BYTES, stream, a);
#else
    for (int p = 0; p < NPHASE; ++p) { a.ph_lo = p; a.ph_hi = p + 1; hipLaunchKernelGGL(mega_fwd, dim3(grid), dim3(NWAVES * 64), LDS_BYTES, stream, a); }
#endif
    const hipError_t le = hipPeekAtLastError();
    if (le != hipSuccess) fprintf(stderr, "kernel_launch: launch failed: %s\n", hipGetErrorName(le));
}
```

```cpp
#include <hip/hip_runtime.h>
#include <cstdio>
#include <cstdint>
#include <cmath>

#ifndef MK_N_LAUNCHES
#define MK_N_LAUNCHES 1
#endif

constexpr int D_MODEL = 2048, BATCH = 2, SEQ = 8192, T = BATCH * SEQ;
constexpr int OFF_CQ = 0, OFF_CKV = 768, OFF_KR = 1280, OFF_DQ = 1344, OFF_DK = 2368, OFF_DV = 3392, OFF_GATE = 4416, IN_COLS = 8512;
constexpr int N1 = 8704;
constexpr int NEXP = 16384;
constexpr float EPS = 1e-6f;
constexpr float LOG2E = 1.4426950408889634f;
constexpr float C2_MLA = 0.07216878364870322f * LOG2E;
constexpr float C2_DIFF = 0.125f * LOG2E;
constexpr float LAMBDA_INIT = 0.2f;

namespace pg8 {
#define PG8_LAS __attribute__((address_space(3)))
typedef unsigned short bf16_t;
typedef short bf16x8 __attribute__((ext_vector_type(8)));
typedef float f32x4 __attribute__((ext_vector_type(4)));
typedef unsigned u32x4 __attribute__((ext_vector_type(4)));
typedef unsigned u32x2 __attribute__((ext_vector_type(2)));
constexpr int BM = 256, BK = 64, HALF = 128, HTB = HALF * BK * 2, STAGE_BYTES = 8 * HTB, NXCD = 8, WGM = 8;

__host__ __device__ __forceinline__ int lds_byte(int r, int c) { const int st = (r >> 4) * 2 + (c >> 5), rr = r & 15, cc = c & 31, ob = rr * 64 + cc * 2; return st * 1024 + (ob ^ (((ob >> 9) & 1) << 5)); }
__host__ __device__ __forceinline__ void stage_rc(int b, int& R, int& C) { const int st = b / 1024, sb = b % 1024, swz = sb ^ (((sb >> 9) & 1) << 5); R = (st >> 1) * 16 + swz / 64; C = (st & 1) * 32 + (swz % 64) / 2; }
__host__ __device__ __forceinline__ int perm32(int rho) { const int n = rho >> 4, i = rho & 15; return 8 * (i >> 2) + 4 * n + (i & 3); }

struct Unit { int pm, pn; };
struct Gemm { const bf16_t* A; const bf16_t* Bt; int M, N, K, lda; };

struct StaticOrder {
    int nM, nN, nwg, G, c;
    __host__ __device__ void init(int M, int N, int G_, int c_) { nM = M / BM; nN = N / BM; nwg = nM * nN; G = G_; c = c_; }
    __host__ __device__ bool next(int i, Unit& u) const {
        const long L = (long)i * G + c; if (L >= nwg) return false;
        int wgid = (int)L; { const int q = nwg / NXCD, r = nwg % NXCD, xcd = wgid % NXCD, off = wgid / NXCD; wgid = (xcd < r ? xcd * (q + 1) : r * (q + 1) + (xcd - r) * q) + off; }
        const int nig = WGM * nN, gid = wgid / nig, fm = gid * WGM, gsz = (nM - fm) < WGM ? (nM - fm) : WGM;
        u.pm = fm + ((wgid % nig) % gsz); u.pn = (wgid % nig) / gsz; return true;
    }
    __device__ __forceinline__ void a_ready(const Unit&) const {}
    __device__ __forceinline__ void done(const Unit&) const {}
};

typedef float f32x2_t __attribute__((ext_vector_type(2))); typedef __bf16 bf16x2_t __attribute__((ext_vector_type(2)));
__device__ __forceinline__ unsigned cvtpk(float lo, float hi) { f32x2_t v = {lo, hi}; bf16x2_t b = __builtin_convertvector(v, bf16x2_t); return __builtin_bit_cast(unsigned, b); }
__device__ __forceinline__ float bf2f(unsigned short h) { return __builtin_bit_cast(float, (unsigned)h << 16); }
__device__ __forceinline__ float bflo(unsigned w) { return __builtin_bit_cast(float, w << 16); }
__device__ __forceinline__ float bfhi(unsigned w) { return __builtin_bit_cast(float, w & 0xffff0000u); }

template <class Epi, class Sched, bool ALIGN_EPI = false, bool SP2 = false>
__device__ __forceinline__ void gemm_phase(PG8_LAS unsigned char* lds, const Gemm g, const Sched& S, const Epi& E) {
    const int tid = threadIdx.x, wid = __builtin_amdgcn_readfirstlane(tid >> 6), lane = tid & 63, wr = wid >> 2, wc = wid & 3, fr = lane & 15, fq = lane >> 4;
    const int K = g.K, nt = K / BK, lda = g.lda;
    unsigned voffA[2], voffB[2];
#pragma unroll
    for (int i = 0; i < 2; ++i) { int R, C; stage_rc(tid * 16 + i * 8192, R, C); const int Rb = Epi::PERM ? ((R & ~31) + perm32(R & 31)) : R;
        voffA[i] = (unsigned)(R * lda + C) * 2u; voffB[i] = (unsigned)(Rb * K + C) * 2u; }
    const size_t kstep = (size_t)(BK * 2);
    const size_t hstepA = (size_t)HALF * lda * 2, hstepB = (size_t)HALF * K * 2;
    const size_t tstepA = 2 * hstepA, tstepB = 2 * hstepB;
    const unsigned ldsw = (unsigned)wid * 1024u;
    const int aoff = lds_byte(wr * 64 + fr, fq * 8), boff = lds_byte(wc * 32 + fr, fq * 8);
#define PG8_SA(b, h) (((b) * 2 + (h)) * HTB)
#define PG8_SB(b, h) ((4 + (b) * 2 + (h)) * HTB)
#define PG8_STAGE(bufoff, gbase, voff) do { _Pragma("unroll") for (int _i = 0; _i < 2; ++_i) \
        __builtin_amdgcn_global_load_lds((const unsigned*)((const char*)(gbase) + (voff)[_i]), (PG8_LAS unsigned*)(lds + (bufoff) + ldsw + _i * 8192), 16, 0, 0); } while (0)
#define PG8_LDA(dst, b, h) do { _Pragma("unroll") for (int m = 0; m < 4; ++m) _Pragma("unroll") for (int k = 0; k < 2; ++k) dst[m][k] = *(const PG8_LAS bf16x8*)(lds + PG8_SA(b, h) + aoff + m * 2048 + k * 1024); } while (0)
#define PG8_LDB(dst, b, h) do { _Pragma("unroll") for (int n = 0; n < 2; ++n) _Pragma("unroll") for (int k = 0; k < 2; ++k) dst[n][k] = *(const PG8_LAS bf16x8*)(lds + PG8_SB(b, h) + boff + n * 2048 + k * 1024); } while (0)
#define PG8_MMA(ai, bj, At, Bt) do { __builtin_amdgcn_s_setprio(1); _Pragma("unroll") for (int m = 0; m < 4; ++m) _Pragma("unroll") for (int n = 0; n < 2; ++n) _Pragma("unroll") for (int k = 0; k < 2; ++k) \
        acc[ai][bj][m][n] = __builtin_amdgcn_mfma_f32_16x16x32_bf16(Bt[n][k], At[m][k], acc[ai][bj][m][n], 0, 0, 0); __builtin_amdgcn_s_setprio(0); } while (0)
#define PG8_WAIT_V(n) asm volatile("s_waitcnt vmcnt(" #n ")" ::: "memory")
#define PG8_WAIT_L(n) asm volatile("s_waitcnt lgkmcnt(" #n ")" ::: "memory")
#define PG8_BAR __builtin_amdgcn_s_barrier()
#define PG8_SCHED __builtin_amdgcn_sched_barrier(0)
    Unit cur, nxt; int ui = 0;
    if (!S.next(0, cur)) return;
    f32x4 acc[2][2][4][2];
#pragma unroll
    for (int a = 0; a < 2; ++a)
#pragma unroll
        for (int b = 0; b < 2; ++b)
#pragma unroll
            for (int m = 0; m < 4; ++m)
#pragma unroll
                for (int n = 0; n < 2; ++n) acc[a][b][m][n] = (f32x4){0.f, 0.f, 0.f, 0.f};
    bf16x8 At[4][2], B0[2][2], B1[2][2];
    const char* cA = (const char*)g.A + (size_t)cur.pm * tstepA; const char* cB = (const char*)g.Bt + (size_t)cur.pn * tstepB;
    S.a_ready(cur);
    if constexpr (SP2) {
        PG8_STAGE(PG8_SB(0, 0), cB, voffB); PG8_STAGE(PG8_SB(0, 1), cB + hstepB, voffB); PG8_STAGE(PG8_SA(0, 0), cA, voffA); PG8_STAGE(PG8_SA(0, 1), cA + hstepA, voffA);
        if (wr == 1) PG8_BAR;
        PG8_WAIT_V(2); PG8_BAR;
        PG8_STAGE(PG8_SB(1, 0), cB + kstep, voffB); PG8_STAGE(PG8_SA(1, 0), cA + kstep, voffA); PG8_STAGE(PG8_SB(1, 1), cB + hstepB + kstep, voffB);
        PG8_WAIT_V(6); PG8_BAR;
    } else {
        PG8_STAGE(PG8_SB(0, 0), cB, voffB); PG8_STAGE(PG8_SA(0, 0), cA, voffA); PG8_STAGE(PG8_SB(0, 1), cB + hstepB, voffB); PG8_STAGE(PG8_SA(0, 1), cA + hstepA, voffA);
        if (wr == 1) PG8_BAR;
        PG8_WAIT_V(4); PG8_BAR;
        PG8_STAGE(PG8_SB(1, 0), cB + kstep, voffB); PG8_STAGE(PG8_SA(1, 0), cA + kstep, voffA); PG8_STAGE(PG8_SB(1, 1), cB + hstepB + kstep, voffB);
        PG8_WAIT_V(6); PG8_BAR;
    }
    for (;;) {
        const bool has_next = S.next(ui + 1, nxt);
        const char* nA = has_next ? (const char*)g.A + (size_t)nxt.pm * tstepA : cA; const char* nB = has_next ? (const char*)g.Bt + (size_t)nxt.pn * tstepB : cB;
        for (int t = 0; t < nt; t += 2) {
            const bool last = (t == nt - 2);
            const char* a1 = cA + (size_t)(t + 1) * kstep;
            const char* a2 = last ? nA : cA + (size_t)(t + 2) * kstep; const char* b2 = last ? nB : cB + (size_t)(t + 2) * kstep;
            const char* a3 = a2 + kstep; const char* b3 = b2 + kstep;
            if (last && has_next) S.a_ready(nxt);
            if constexpr (SP2) {
            PG8_LDB(B0, 0, 0); PG8_LDB(B1, 0, 1); PG8_SCHED; PG8_LDA(At, 0, 0); PG8_STAGE(PG8_SA(1, 1), a1 + hstepA, voffA);
            PG8_WAIT_V(8); PG8_WAIT_L(0); PG8_BAR; PG8_MMA(0, 0, At, B0); PG8_MMA(0, 1, At, B1); PG8_BAR; PG8_SCHED;
            PG8_LDA(At, 0, 1); PG8_STAGE(PG8_SB(0, 0), b2, voffB); PG8_STAGE(PG8_SB(0, 1), b2 + hstepB, voffB); PG8_STAGE(PG8_SA(0, 0), a2, voffA);
            PG8_WAIT_V(8); PG8_WAIT_L(0); PG8_BAR; PG8_MMA(1, 0, At, B0); PG8_MMA(1, 1, At, B1); PG8_BAR; PG8_SCHED;
            PG8_LDB(B0, 1, 0); PG8_LDB(B1, 1, 1); PG8_SCHED; PG8_LDA(At, 1, 0); PG8_STAGE(PG8_SA(0, 1), a2 + hstepA, voffA);
            PG8_WAIT_V(8); PG8_WAIT_L(0); PG8_BAR; PG8_MMA(0, 0, At, B0); PG8_MMA(0, 1, At, B1); PG8_BAR; PG8_SCHED;
            PG8_LDA(At, 1, 1); PG8_STAGE(PG8_SB(1, 0), b3, voffB); PG8_STAGE(PG8_SB(1, 1), b3 + hstepB, voffB); PG8_STAGE(PG8_SA(1, 0), a3, voffA);
            PG8_WAIT_V(8); PG8_WAIT_L(0); PG8_BAR; PG8_MMA(1, 0, At, B0); PG8_MMA(1, 1, At, B1); PG8_BAR; PG8_SCHED;
            } else {
            PG8_LDB(B0, 0, 0); PG8_SCHED; PG8_LDA(At, 0, 0); PG8_STAGE(PG8_SA(1, 1), a1 + hstepA, voffA);
            PG8_WAIT_L(8); PG8_BAR; PG8_WAIT_L(0); PG8_MMA(0, 0, At, B0); PG8_BAR; PG8_SCHED;
            PG8_LDB(B1, 0, 1); PG8_STAGE(PG8_SB(0, 0), b2, voffB);
            PG8_BAR; PG8_WAIT_L(0); PG8_MMA(0, 1, At, B1); PG8_BAR;
            PG8_LDA(At, 0, 1); PG8_STAGE(PG8_SA(0, 0), a2, voffA);
            PG8_BAR; PG8_WAIT_L(0); PG8_MMA(1, 0, At, B0); PG8_BAR; PG8_SCHED;
            PG8_STAGE(PG8_SB(0, 1), b2 + hstepB, voffB);
            PG8_WAIT_V(6); PG8_BAR; PG8_MMA(1, 1, At, B1); PG8_BAR;
            PG8_LDB(B0, 1, 0); PG8_SCHED; PG8_LDA(At, 1, 0); PG8_STAGE(PG8_SA(0, 1), a2 + hstepA, voffA);
            PG8_WAIT_L(8); PG8_BAR; PG8_WAIT_L(0); PG8_MMA(0, 0, At, B0); PG8_BAR; PG8_SCHED;
            PG8_LDB(B1, 1, 1); PG8_STAGE(PG8_SB(1, 0), b3, voffB);
            PG8_BAR; PG8_WAIT_L(0); PG8_MMA(0, 1, At, B1); PG8_BAR;
            PG8_LDA(At, 1, 1); PG8_STAGE(PG8_SA(1, 0), a3, voffA);
            PG8_BAR; PG8_WAIT_L(0); PG8_MMA(1, 0, At, B0); PG8_BAR; PG8_SCHED;
            PG8_STAGE(PG8_SB(1, 1), b3 + hstepB, voffB);
            PG8_WAIT_V(6); PG8_BAR; PG8_MMA(1, 1, At, B1); PG8_BAR;
            }
        }
        if constexpr (ALIGN_EPI) { if (wr == 0) PG8_BAR; }
        E(acc, cur, wr, wc, fr, fq); S.done(cur);
        if (!has_next) break;
#pragma unroll
        for (int a = 0; a < 2; ++a)
#pragma unroll
            for (int b = 0; b < 2; ++b)
#pragma unroll
                for (int m = 0; m < 4; ++m)
#pragma unroll
                    for (int n = 0; n < 2; ++n) acc[a][b][m][n] = (f32x4){0.f, 0.f, 0.f, 0.f};
        cur = nxt; cA = nA; cB = nB; ++ui;
        if constexpr (ALIGN_EPI) { if (wr == 1) PG8_BAR; }
    }
    PG8_WAIT_V(0);
    if constexpr (!ALIGN_EPI) { if (wr == 0) PG8_BAR; }
    PG8_BAR;
#undef PG8_SA
#undef PG8_SB
#undef PG8_STAGE
#undef PG8_LDA
#undef PG8_LDB
#undef PG8_MMA
#undef PG8_WAIT_V
#undef PG8_WAIT_L
#undef PG8_BAR
#undef PG8_SCHED
}
struct Gemm2 { const bf16_t *A1, *A2, *B1, *B2; int M, N, K1, lda; };
template <class Epi, class Sched, bool ALIGN_EPI = false, bool SP2 = false>
__device__ __forceinline__ void gemm_phase2(PG8_LAS unsigned char* lds, const Gemm2 g, const Sched& S, const Epi& E) {
    const int tid = threadIdx.x, wid = __builtin_amdgcn_readfirstlane(tid >> 6), lane = tid & 63, wr = wid >> 2, wc = wid & 3, fr = lane & 15, fq = lane >> 4;
    const int K = g.K1, nt = K / BK, lda = g.lda;
    unsigned voffA[2], voffB[2];
#pragma unroll
    for (int i = 0; i < 2; ++i) { int R, C; stage_rc(tid * 16 + i * 8192, R, C); const int Rb = Epi::PERM ? ((R & ~31) + perm32(R & 31)) : R;
        voffA[i] = (unsigned)(R * lda + C) * 2u; voffB[i] = (unsigned)(Rb * K + C) * 2u; }
    const size_t kstep = (size_t)(BK * 2);
    const size_t hstepA = (size_t)HALF * lda * 2, hstepB = (size_t)HALF * K * 2;
    const size_t tstepA = 2 * hstepA, tstepB = 2 * hstepB;
    const unsigned ldsw = (unsigned)wid * 1024u;
    const int aoff = lds_byte(wr * 64 + fr, fq * 8), boff = lds_byte(wc * 32 + fr, fq * 8);
#define PG8_SA(b, h) (((b) * 2 + (h)) * HTB)
#define PG8_SB(b, h) ((4 + (b) * 2 + (h)) * HTB)
#define PG8_STAGE(bufoff, gbase, voff) do { _Pragma("unroll") for (int _i = 0; _i < 2; ++_i) \
        __builtin_amdgcn_global_load_lds((const unsigned*)((const char*)(gbase) + (voff)[_i]), (PG8_LAS unsigned*)(lds + (bufoff) + ldsw + _i * 8192), 16, 0, 0); } while (0)
#define PG8_LDA(dst, b, h) do { _Pragma("unroll") for (int m = 0; m < 4; ++m) _Pragma("unroll") for (int k = 0; k < 2; ++k) dst[m][k] = *(const PG8_LAS bf16x8*)(lds + PG8_SA(b, h) + aoff + m * 2048 + k * 1024); } while (0)
#define PG8_LDB(dst, b, h) do { _Pragma("unroll") for (int n = 0; n < 2; ++n) _Pragma("unroll") for (int k = 0; k < 2; ++k) dst[n][k] = *(const PG8_LAS bf16x8*)(lds + PG8_SB(b, h) + boff + n * 2048 + k * 1024); } while (0)
#define PG8_MMA(ai, bj, At, Bt) do { __builtin_amdgcn_s_setprio(1); _Pragma("unroll") for (int m = 0; m < 4; ++m) _Pragma("unroll") for (int n = 0; n < 2; ++n) _Pragma("unroll") for (int k = 0; k < 2; ++k) \
        acc[ai][bj][m][n] = __builtin_amdgcn_mfma_f32_16x16x32_bf16(Bt[n][k], At[m][k], acc[ai][bj][m][n], 0, 0, 0); __builtin_amdgcn_s_setprio(0); } while (0)
#define PG8_WAIT_V(n) asm volatile("s_waitcnt vmcnt(" #n ")" ::: "memory")
#define PG8_WAIT_L(n) asm volatile("s_waitcnt lgkmcnt(" #n ")" ::: "memory")
#define PG8_BAR __builtin_amdgcn_s_barrier()
#define PG8_SCHED __builtin_amdgcn_sched_barrier(0)
    Unit cur, nxt; int ui = 0;
    if (!S.next(0, cur)) return;
    f32x4 acc[2][2][4][2];
#pragma unroll
    for (int a = 0; a < 2; ++a)
#pragma unroll
        for (int b = 0; b < 2; ++b)
#pragma unroll
            for (int m = 0; m < 4; ++m)
#pragma unroll
                for (int n = 0; n < 2; ++n) acc[a][b][m][n] = (f32x4){0.f, 0.f, 0.f, 0.f};
    bf16x8 At[4][2], B0[2][2], B1[2][2];
    const char* cA = (const char*)g.A1 + (size_t)cur.pm * tstepA; const char* cB = (const char*)g.B1 + (size_t)cur.pn * tstepB;
    S.a_ready(cur);
    if constexpr (SP2) {
        PG8_STAGE(PG8_SB(0, 0), cB, voffB); PG8_STAGE(PG8_SB(0, 1), cB + hstepB, voffB); PG8_STAGE(PG8_SA(0, 0), cA, voffA); PG8_STAGE(PG8_SA(0, 1), cA + hstepA, voffA);
        if (wr == 1) PG8_BAR;
        PG8_WAIT_V(2); PG8_BAR;
        PG8_STAGE(PG8_SB(1, 0), cB + kstep, voffB); PG8_STAGE(PG8_SA(1, 0), cA + kstep, voffA); PG8_STAGE(PG8_SB(1, 1), cB + hstepB + kstep, voffB);
        PG8_WAIT_V(6); PG8_BAR;
    } else {
        PG8_STAGE(PG8_SB(0, 0), cB, voffB); PG8_STAGE(PG8_SA(0, 0), cA, voffA); PG8_STAGE(PG8_SB(0, 1), cB + hstepB, voffB); PG8_STAGE(PG8_SA(0, 1), cA + hstepA, voffA);
        if (wr == 1) PG8_BAR;
        PG8_WAIT_V(4); PG8_BAR;
        PG8_STAGE(PG8_SB(1, 0), cB + kstep, voffB); PG8_STAGE(PG8_SA(1, 0), cA + kstep, voffA); PG8_STAGE(PG8_SB(1, 1), cB + hstepB + kstep, voffB);
        PG8_WAIT_V(6); PG8_BAR;
    }
    for (;;) {
        const int nhalf = (ui + 1) & 1;
        const bool has_next = S.next((ui + 1) >> 1, nxt);
        const char* nA = has_next ? (const char*)(nhalf ? g.A2 : g.A1) + (size_t)nxt.pm * tstepA : cA; const char* nB = has_next ? (const char*)(nhalf ? g.B2 : g.B1) + (size_t)nxt.pn * tstepB : cB;
        for (int t = 0; t < nt; t += 2) {
            const bool last = (t == nt - 2);
            const char* a1 = cA + (size_t)(t + 1) * kstep;
            const char* a2 = last ? nA : cA + (size_t)(t + 2) * kstep; const char* b2 = last ? nB : cB + (size_t)(t + 2) * kstep;
            const char* a3 = a2 + kstep; const char* b3 = b2 + kstep;
            if (last && has_next) S.a_ready(nxt);
            if constexpr (SP2) {
            PG8_LDB(B0, 0, 0); PG8_LDB(B1, 0, 1); PG8_SCHED; PG8_LDA(At, 0, 0); PG8_STAGE(PG8_SA(1, 1), a1 + hstepA, voffA);
            PG8_WAIT_V(8); PG8_WAIT_L(0); PG8_BAR; PG8_MMA(0, 0, At, B0); PG8_MMA(0, 1, At, B1); PG8_BAR; PG8_SCHED;
            PG8_LDA(At, 0, 1); PG8_STAGE(PG8_SB(0, 0), b2, voffB); PG8_STAGE(PG8_SB(0, 1), b2 + hstepB, voffB); PG8_STAGE(PG8_SA(0, 0), a2, voffA);
            PG8_WAIT_V(8); PG8_WAIT_L(0); PG8_BAR; PG8_MMA(1, 0, At, B0); PG8_MMA(1, 1, At, B1); PG8_BAR; PG8_SCHED;
            PG8_LDB(B0, 1, 0); PG8_LDB(B1, 1, 1); PG8_SCHED; PG8_LDA(At, 1, 0); PG8_STAGE(PG8_SA(0, 1), a2 + hstepA, voffA);
            PG8_WAIT_V(8); PG8_WAIT_L(0); PG8_BAR; PG8_MMA(0, 0, At, B0); PG8_MMA(0, 1, At, B1); PG8_BAR; PG8_SCHED;
            PG8_LDA(At, 1, 1); PG8_STAGE(PG8_SB(1, 0), b3, voffB); PG8_STAGE(PG8_SB(1, 1), b3 + hstepB, voffB); PG8_STAGE(PG8_SA(1, 0), a3, voffA);
            PG8_WAIT_V(8); PG8_WAIT_L(0); PG8_BAR; PG8_MMA(1, 0, At, B0); PG8_MMA(1, 1, At, B1); PG8_BAR; PG8_SCHED;
            } else {
            PG8_LDB(B0, 0, 0); PG8_SCHED; PG8_LDA(At, 0, 0); PG8_STAGE(PG8_SA(1, 1), a1 + hstepA, voffA);
            PG8_WAIT_L(8); PG8_BAR; PG8_WAIT_L(0); PG8_MMA(0, 0, At, B0); PG8_BAR; PG8_SCHED;
            PG8_LDB(B1, 0, 1); PG8_STAGE(PG8_SB(0, 0), b2, voffB);
            PG8_BAR; PG8_WAIT_L(0); PG8_MMA(0, 1, At, B1); PG8_BAR;
            PG8_LDA(At, 0, 1); PG8_STAGE(PG8_SA(0, 0), a2, voffA);
            PG8_BAR; PG8_WAIT_L(0); PG8_MMA(1, 0, At, B0); PG8_BAR; PG8_SCHED;
            PG8_STAGE(PG8_SB(0, 1), b2 + hstepB, voffB);
            PG8_WAIT_V(6); PG8_BAR; PG8_MMA(1, 1, At, B1); PG8_BAR;
            PG8_LDB(B0, 1, 0); PG8_SCHED; PG8_LDA(At, 1, 0); PG8_STAGE(PG8_SA(0, 1), a2 + hstepA, voffA);
            PG8_WAIT_L(8); PG8_BAR; PG8_WAIT_L(0); PG8_MMA(0, 0, At, B0); PG8_BAR; PG8_SCHED;
            PG8_LDB(B1, 1, 1); PG8_STAGE(PG8_SB(1, 0), b3, voffB);
            PG8_BAR; PG8_WAIT_L(0); PG8_MMA(0, 1, At, B1); PG8_BAR;
            PG8_LDA(At, 1, 1); PG8_STAGE(PG8_SA(1, 0), a3, voffA);
            PG8_BAR; PG8_WAIT_L(0); PG8_MMA(1, 0, At, B0); PG8_BAR; PG8_SCHED;
            PG8_STAGE(PG8_SB(1, 1), b3 + hstepB, voffB);
            PG8_WAIT_V(6); PG8_BAR; PG8_MMA(1, 1, At, B1); PG8_BAR;
            }
        }
        if constexpr (ALIGN_EPI) { if (wr == 0) PG8_BAR; }
        if ((ui & 1) == 0) E.mid(acc, cur, wr, wc, fr, fq); else { E(acc, cur, wr, wc, fr, fq); S.done(cur); }
        if (!has_next) break;
        if (ui & 1)
#pragma unroll
        for (int a = 0; a < 2; ++a)
#pragma unroll
            for (int b = 0; b < 2; ++b)
#pragma unroll
                for (int m = 0; m < 4; ++m)
#pragma unroll
                    for (int n = 0; n < 2; ++n) acc[a][b][m][n] = (f32x4){0.f, 0.f, 0.f, 0.f};
        cur = nxt; cA = nA; cB = nB; ++ui;
        if constexpr (ALIGN_EPI) { if (wr == 1) PG8_BAR; }
    }
    PG8_WAIT_V(0);
    if constexpr (!ALIGN_EPI) { if (wr == 0) PG8_BAR; }
    PG8_BAR;
#undef PG8_SA
#undef PG8_SB
#undef PG8_STAGE
#undef PG8_LDA
#undef PG8_LDB
#undef PG8_MMA
#undef PG8_WAIT_V
#undef PG8_WAIT_L
#undef PG8_BAR
#undef PG8_SCHED
}
}

#ifndef PG8_SP2
#define PG8_SP2 true
#endif
#ifndef PG8_ALIGN
#define PG8_ALIGN true
#endif

using pg8::bf16_t; using pg8::f32x4; using pg8::u32x4; using pg8::u32x2; using pg8::cvtpk; using pg8::bf2f; using pg8::bflo; using pg8::bfhi;

constexpr size_t MiB = 1u << 20;
constexpr size_t WS_CTL = 0, CTL_ZERO_BYTES = 32 * 1024;
constexpr size_t WS_ROPE = 1 * MiB;
constexpr size_t WS_WUQ = 3 * MiB, WS_WUKV = 6 * MiB, WS_WOM = 8 * MiB, WS_WOD = 12 * MiB, WS_WOUT = 16 * MiB, WS_WQP = 24 * MiB;
constexpr size_t WS_SKB = 5 * MiB + 512 * 1024;
constexpr size_t WS_W1 = 32 * MiB;
constexpr size_t WS_H = 66 * MiB;
constexpr size_t WS_CQ = 130 * MiB, WS_CKV = 154 * MiB;
constexpr size_t WS_KR = 170 * MiB, WS_DQ = 172 * MiB, WS_DK = 204 * MiB, WS_DV = 236 * MiB;
constexpr size_t WS_G = 268 * MiB;
constexpr size_t WS_QN = 32 * MiB, WS_QR = 64 * MiB, WS_KN = 80 * MiB, WS_V = 396 * MiB;
constexpr size_t WS_OM = 112 * MiB, WS_OD = 428 * MiB;
constexpr size_t WS_TMP = 32 * MiB;
constexpr size_t WS_MG = 172 * MiB;
constexpr size_t WS_X2 = 268 * MiB;
constexpr size_t WS_X2B = 396 * MiB;
constexpr size_t WS_EU = 32 * MiB, WS_EV = 96 * MiB;
constexpr size_t WS_QP = 172 * MiB;
constexpr size_t WS_IDX = 236 * MiB, WS_GT = 244 * MiB;
constexpr size_t WS_PSQ_Q = 460 * MiB, WS_PSQ_KV = 461 * MiB, WS_PSQ2 = 462 * MiB;
constexpr size_t WS_END = 464 * MiB;
constexpr int CW_TMO = 0, CW_CODE = 1, CW_LAMBDA = 8, CW_TOKCTR = 64;
constexpr int CW_BAR = 4096;

constexpr int RING_OFF = 0, RING_BYTES = 131072;
constexpr int LDSCTL_OFF = RING_BYTES, MISC_OFF = LDSCTL_OFF + 320;
constexpr int LDS_BYTES = 147456;
constexpr int NWAVES = 8;

#define GAS __attribute__((address_space(1)))
#define LAS __attribute__((address_space(3)))
typedef unsigned short bf16;
typedef unsigned v4u __attribute__((ext_vector_type(4)));
typedef GAS unsigned gu32;
#define RLX_AGENT __ATOMIC_RELAXED, __HIP_MEMORY_SCOPE_AGENT
#define LDS_WAIT() asm volatile("s_waitcnt lgkmcnt(0)" ::: "memory")
#define VM_WAIT() asm volatile("s_waitcnt vmcnt(0)" ::: "memory")

#define XB_TMO      128
#define XB_XCNT(j)  (256  + 64 * (j))
#define XB_XSUB(j)  (1280 + 64 * (j))
#define XB_XGEN(j)  (2304 + 64 * (j))
#define XB_TOP      3328
#define XB_TOPGEN   3392
#define XCD_BAR_WORDS 3456
#define XB_SPIN_CAP (1u << 22)
__device__ __forceinline__ unsigned xb_ld(unsigned* p)              { return __hip_atomic_load(p, __ATOMIC_RELAXED, __HIP_MEMORY_SCOPE_AGENT); }
__device__ __forceinline__ unsigned xb_add(unsigned* p, unsigned v) { return __hip_atomic_fetch_add(p, v, __ATOMIC_RELAXED, __HIP_MEMORY_SCOPE_AGENT); }
__device__ __forceinline__ unsigned xb_xcc_id() { return (unsigned)__builtin_amdgcn_s_getreg((3 << 11) | 20) & 0xFu; }
#define XB_SPIN(cond, bar) do { unsigned _sp = 0; while (cond) { __builtin_amdgcn_s_sleep(1); \
    if ((++_sp & 255u) == 0u) { if (xb_ld(&(bar)[XB_TMO])) break; if (_sp > XB_SPIN_CAP) { atomicAdd(&(bar)[XB_TMO], 1u); break; } } } } while (0)
struct XcdBarrier { unsigned* bar; unsigned x; volatile LAS unsigned* st; };
__device__ __forceinline__ XcdBarrier xcd_barrier_post(unsigned* bar, volatile LAS unsigned* st) {
    XcdBarrier b; b.bar = bar; b.x = xb_xcc_id(); b.st = st;
    if (threadIdx.x == 0) (void)xb_add(&bar[XB_XCNT(b.x)], 1u);
    return b;
}
__device__ __forceinline__ void xcd_barrier_complete(unsigned* bar, unsigned x, unsigned& nloc, unsigned& nx) {
    const unsigned G = gridDim.x * gridDim.y * gridDim.z;
    unsigned sum, cnt, mine, sp = 0u;
    for (;;) {
        sum = 0u; cnt = 0u; mine = 0u;
#pragma unroll
        for (unsigned j = 0; j < 16; ++j) { const unsigned c = xb_ld(&bar[XB_XCNT(j)]); sum += c; cnt += (c > 0u) ? 1u : 0u; mine = (j == x) ? c : mine; }
        if (sum == G) break;
        __builtin_amdgcn_s_sleep(1);
        if ((++sp & 255u) == 0u) { if (xb_ld(&bar[XB_TMO])) break; if (sp > XB_SPIN_CAP) { atomicAdd(&bar[XB_TMO], 1u); break; } }
    }
    nloc = mine > 0u ? mine : 1u; nx = cnt > 0u ? cnt : 1u;
}
__device__ __forceinline__ void xcd_barrier(const XcdBarrier& b) {
    asm volatile("s_waitcnt vmcnt(0)" ::: "memory");
    __syncthreads();
    if (threadIdx.x == 0) {
        unsigned* bar = b.bar;
        __builtin_amdgcn_s_waitcnt(0);
        unsigned nloc = b.st[0], nx = b.st[1];
        if (nloc == 0u) { xcd_barrier_complete(bar, b.x, nloc, nx); b.st[0] = nloc; b.st[1] = nx; }
        const unsigned old = xb_add(&bar[XB_XSUB(b.x)], 1u);
        const unsigned gen = old / nloc;
        if (old + 1u == (gen + 1u) * nloc) {
            __builtin_amdgcn_fence(__ATOMIC_RELEASE, "agent");
            asm volatile("s_waitcnt vmcnt(0)" ::: "memory");
            const unsigned og = xb_add(&bar[XB_TOP], 1u);
            const unsigned tg = og / nx;
            if (og + 1u == (tg + 1u) * nx) xb_add(&bar[XB_TOPGEN], 1u);
            else XB_SPIN(xb_ld(&bar[XB_TOPGEN]) == tg, bar);
            __builtin_amdgcn_fence(__ATOMIC_ACQUIRE, "agent");
            xb_add(&bar[XB_XGEN(b.x)], 1u);
            asm volatile("s_waitcnt vmcnt(0)" ::: "memory");
        } else {
            XB_SPIN(xb_ld(&bar[XB_XGEN(b.x)]) == gen, bar);
            __builtin_amdgcn_fence(__ATOMIC_ACQUIRE, "agent");
            asm volatile("s_waitcnt vmcnt(0)" ::: "memory");
        }
    }
    __syncthreads();
}

struct Frame {
    LAS unsigned char* lds;
    volatile LAS unsigned* MISC;
    gu32* ctl;
    unsigned char* ws;
    int tid, lane, wave, vcu, G;
};

__device__ __forceinline__ float wave_sum(float v) {
#pragma unroll
    for (int o = 1; o < 64; o <<= 1) v += __shfl_xor(v, o);
    return v;
}
__device__ __forceinline__ float wave_max(float v) {
#pragma unroll
    for (int o = 1; o < 64; o <<= 1) v = fmaxf(v, __shfl_xor(v, o));
    return v;
}
__device__ __forceinline__ unsigned pk2(float lo, float hi) { return cvtpk(lo, hi); }

template <class Map>
__device__ __forceinline__ void tr_item(const float* W, int Nsrc, int K, const float* kscale, bf16* WT, LAS float* scr, int item, int nblk, int lane, Map map) {
    const int kb = item / nblk, nb = item % nblk, k0 = 64 * kb, n0 = 32 * nb;
    const int sc = map(n0 + (lane & 31));
    float tv[32];
    const int scc = sc >= 0 ? sc : 0;
#pragma unroll
    for (int i = 0; i < 32; ++i) { const int kk = 2 * i + (lane >> 5); tv[i] = W[(size_t)(k0 + kk) * Nsrc + scc]; }
#pragma unroll
    for (int i = 0; i < 32; ++i) { const int kk = 2 * i + (lane >> 5); float v = sc >= 0 ? tv[i] : 0.f; if (kscale) v *= kscale[k0 + kk]; scr[kk * 33 + (lane & 31)] = v; }
    LDS_WAIT(); asm volatile("" ::: "memory");
    const int c = lane & 7;
#pragma unroll
    for (int j = 0; j < 4; ++j) { const int n = (lane >> 3) + 8 * j; const LAS float* s = scr + (8 * c) * 33 + n;
        v4u o; o.x = pk2(s[0 * 33], s[1 * 33]); o.y = pk2(s[2 * 33], s[3 * 33]); o.z = pk2(s[4 * 33], s[5 * 33]); o.w = pk2(s[6 * 33], s[7 * 33]);
        *(GAS v4u*)(WT + (size_t)(n0 + n) * K + k0 + 8 * c) = o; }
    LDS_WAIT(); asm volatile("" ::: "memory");
}
__device__ __forceinline__ int rope_src(int jj) { return (jj & 1) * 32 + (jj >> 1); }
struct MapW1 { __device__ int operator()(int n) const {
    if (n < 1280) return n;
    if (n < 2304) { const int j = n - 1280; return OFF_DQ + (j & ~63) + rope_src(j & 63); }
    if (n < 3328) { const int j = n - 2304; return OFF_DK + (j & ~63) + rope_src(j & 63); }
    if (n < 4352) return OFF_DV + (n - 3328);
    if (n < 8448) return OFF_GATE + (n - 4352);
    if (n < 8512) return OFF_KR + rope_src(n - 8448);
    return -1; } };
struct MapUQ { __device__ int operator()(int n) const {
    if (n < 1024) return (n >> 7) * 192 + (n & 127);
    const int j = n - 1024; return (j >> 6) * 192 + 128 + rope_src(j & 63); } };
struct MapUKV { __device__ int operator()(int n) const {
    if (n < 1024) return (n >> 7) * 256 + (n & 127);
    const int j = n - 1024; return (j >> 7) * 256 + 128 + (j & 127); } };
struct MapId { __device__ int operator()(int n) const { return n; } };

struct Ins { const float *x, *w_in, *b_gate, *g_norm1, *g_cq, *w_uq, *g_ckv, *w_ukv, *w_o_mla, *lambda_qk, *g_subln, *w_o_diff, *w_out, *g_norm2, *w_q_peer, *sub_keys, *expert_u, *expert_v, *g_final; };

__device__ __forceinline__ void p0_prologue(Frame& F, const Ins& I, const double* inv_freq) {
    LAS float* scr = (LAS float*)(F.lds + RING_OFF + F.wave * 16384);
    const int gw = F.vcu * NWAVES + F.wave, NGW = F.G * NWAVES;
    unsigned char* ws = F.ws;
    constexpr int I_W1 = (2048 / 64) * (N1 / 32), I_UQ = (768 / 64) * (1536 / 32), I_UKV = (512 / 64) * (2048 / 32), I_OM = (1024 / 64) * (2048 / 32), I_OD = I_OM, I_OUT = (2048 / 64) * (2048 / 32), I_QP = I_OUT;
    constexpr int NITEMS = I_W1 + I_UQ + I_UKV + I_OM + I_OD + I_OUT + I_QP;
    for (int it = gw; it < NITEMS; it += NGW) {
        int r = it;
        if (r < I_W1) { tr_item(I.w_in, IN_COLS, 2048, nullptr, (bf16*)(ws + WS_W1), scr, r, N1 / 32, F.lane, MapW1()); continue; } r -= I_W1;
        if (r < I_UQ) { tr_item(I.w_uq, 1536, 768, I.g_cq, (bf16*)(ws + WS_WUQ), scr, r, 1536 / 32, F.lane, MapUQ()); continue; } r -= I_UQ;
        if (r < I_UKV) { tr_item(I.w_ukv, 2048, 512, I.g_ckv, (bf16*)(ws + WS_WUKV), scr, r, 2048 / 32, F.lane, MapUKV()); continue; } r -= I_UKV;
        if (r < I_OM) { tr_item(I.w_o_mla, 2048, 1024, nullptr, (bf16*)(ws + WS_WOM), scr, r, 2048 / 32, F.lane, MapId()); continue; } r -= I_OM;
        if (r < I_OD) { tr_item(I.w_o_diff, 2048, 1024, nullptr, (bf16*)(ws + WS_WOD), scr, r, 2048 / 32, F.lane, MapId()); continue; } r -= I_OD;
        if (r < I_OUT) { tr_item(I.w_out, 2048, 2048, nullptr, (bf16*)(ws + WS_WOUT), scr, r, 2048 / 32, F.lane, MapId()); continue; } r -= I_OUT;
        tr_item(I.w_q_peer, 2048, 2048, I.g_norm2, (bf16*)(ws + WS_WQP), scr, r, 2048 / 32, F.lane, MapId());
    }
    {
        bf16* skb = (bf16*)(ws + WS_SKB);
        for (int e = gw * 64 + F.lane; e < 256 * 256; e += NGW * 64) {
            const int n = e >> 8, k = e & 255; float v = 0.f;
            if (n < 128 && k < 128) v = I.sub_keys[n * 128 + k];
            else if (n >= 128 && k >= 128) v = I.sub_keys[128 * 128 + (n - 128) * 128 + (k - 128)];
            skb[e] = (bf16)(pk2(v, 0.f) & 0xffffu);
        }
    }
    {
        float* rope = (float*)(ws + WS_ROPE);
        for (int e = gw * 64 + F.lane; e < SEQ * 32; e += NGW * 64) {
            const int pos = e >> 5, i = e & 31;
            const double rev = (double)pos * inv_freq[i] * 0.15915494309189535;
            const float fr = (float)(rev - floor(rev));
            rope[2 * e] = __builtin_amdgcn_cosf(fr); rope[2 * e + 1] = __builtin_amdgcn_sinf(fr);
        }
    }
    if (blockIdx.x == 0 && F.tid == 0) {
        float a = 0.f, b = 0.f;
        for (int d = 0; d < 64; ++d) { a += I.lambda_qk[d] * I.lambda_qk[64 + d]; b += I.lambda_qk[128 + d] * I.lambda_qk[192 + d]; }
        const float lam = __expf(a) - __expf(b) + LAMBDA_INIT;
        ((float*)F.ctl)[CW_LAMBDA] = lam;
    }
    {
        bf16* H = (bf16*)(ws + WS_H);
        f32x4 g[8];
#pragma unroll
        for (int j = 0; j < 8; ++j) g[j] = *((const f32x4*)I.g_norm1 + F.lane + 64 * j);
        for (int m = gw; m < T; m += NGW) {
            const GAS f32x4* xr = (const GAS f32x4*)(I.x + (size_t)m * D_MODEL) + F.lane;
            f32x4 v[8]; float s = 0.f;
#pragma unroll
            for (int j = 0; j < 8; ++j) { v[j] = xr[64 * j]; s += (v[j].x * v[j].x + v[j].y * v[j].y) + (v[j].z * v[j].z + v[j].w * v[j].w); }
            const float rstd = 1.0f / sqrtf(wave_sum(s) * (1.f / D_MODEL) + EPS);
            GAS u32x2* o8 = (GAS u32x2*)(H + (size_t)m * D_MODEL) + F.lane;
#pragma unroll
            for (int j = 0; j < 8; ++j) { u32x2 w; w.x = pk2(v[j].x * rstd * g[j].x, v[j].y * rstd * g[j].y); w.y = pk2(v[j].z * rstd * g[j].z, v[j].w * rstd * g[j].w); o8[64 * j] = w; }
        }
    }
}

__device__ __forceinline__ void convert_experts(Frame& F, const Ins& I) {
    const size_t gt = (size_t)(F.vcu * NWAVES * 64) + F.tid, NT = (size_t)F.G * NWAVES * 64;
    const size_t nchunk = (size_t)NEXP * D_MODEL / 8;
    bf16* EU = (bf16*)(F.ws + WS_EU); bf16* EV = (bf16*)(F.ws + WS_EV);
    for (size_t c = gt; c < nchunk; c += NT) {
        const int d = (int)((c * 8) & (D_MODEL - 1));
        const f32x4 a0 = *(const GAS f32x4*)(I.expert_u + c * 8), a1 = *(const GAS f32x4*)(I.expert_u + c * 8 + 4);
        const f32x4 g0 = *(const f32x4*)(I.g_norm2 + d), g1 = *(const f32x4*)(I.g_norm2 + d + 4);
        v4u o; o.x = pk2(a0.x * g0.x, a0.y * g0.y); o.y = pk2(a0.z * g0.z, a0.w * g0.w); o.z = pk2(a1.x * g1.x, a1.y * g1.y); o.w = pk2(a1.z * g1.z, a1.w * g1.w);
        *(GAS v4u*)(EU + c * 8) = o;
        const f32x4 b0 = *(const GAS f32x4*)(I.expert_v + c * 8), b1 = *(const GAS f32x4*)(I.expert_v + c * 8 + 4);
        v4u p; p.x = pk2(b0.x, b0.y); p.y = pk2(b0.z, b0.w); p.z = pk2(b1.x, b1.y); p.w = pk2(b1.z, b1.w);
        *(GAS v4u*)(EV + c * 8) = p;
    }
}

__device__ __forceinline__ float sigmoidf_fast(float x) { return __builtin_amdgcn_rcpf(1.0f + __builtin_amdgcn_exp2f(-x * LOG2E)); }
__device__ __forceinline__ void rope8(f32x4& v0, f32x4& v1, const f32x4 cs0, const f32x4 cs1, float sc) {
    const float a0 = v0[0] * cs0[0] - v0[1] * cs0[1], b0 = v0[1] * cs0[0] + v0[0] * cs0[1];
    const float a1 = v0[2] * cs0[2] - v0[3] * cs0[3], b1 = v0[3] * cs0[2] + v0[2] * cs0[3];
    const float a2 = v1[0] * cs1[0] - v1[1] * cs1[1], b2 = v1[1] * cs1[0] + v1[0] * cs1[1];
    const float a3 = v1[2] * cs1[2] - v1[3] * cs1[3], b3 = v1[3] * cs1[2] + v1[2] * cs1[3];
    v0 = (f32x4){a0 * sc, b0 * sc, a1 * sc, b1 * sc}; v1 = (f32x4){a2 * sc, b2 * sc, a3 * sc, b3 * sc};
}
__device__ __forceinline__ u32x4 pack8(const f32x4 v0, const f32x4 v1) { u32x4 w; w.x = cvtpk(v0[0], v0[1]); w.y = cvtpk(v0[2], v0[3]); w.z = cvtpk(v1[0], v1[1]); w.w = cvtpk(v1[2], v1[3]); return w; }

struct EpiProj {
    static constexpr bool PERM = true;
    bf16_t *CQ, *CKV, *DQ, *DK, *DV, *G, *KR; float *ssq_q, *ssq_kv; const float* bgate; const float* rope;
    __device__ __forceinline__ void operator()(const f32x4 (&acc)[2][2][4][2], const pg8::Unit& u, int wr, int wc, int fr, int fq) const {
        const int row0 = u.pm * 256 + wr * 64 + fr, pn = u.pn, colw = wc * 32 + 8 * fq;
        if (pn < 5) {
            bf16_t* O; int ldc, ct, nsl, sl; float* ssq;
            if (pn < 3) { O = CQ; ldc = 768; ct = pn * 256; ssq = ssq_q; nsl = 12; sl = pn * 4 + wc; } else { O = CKV; ldc = 512; ct = (pn - 3) * 256; ssq = ssq_kv; nsl = 8; sl = (pn - 3) * 4 + wc; }
#pragma unroll
            for (int ai = 0; ai < 2; ++ai)
#pragma unroll
                for (int m = 0; m < 4; ++m) { const int row = row0 + ai * 128 + m * 16; float s = 0.f;
#pragma unroll
                    for (int bj = 0; bj < 2; ++bj) { const f32x4 v0 = acc[ai][bj][m][0], v1 = acc[ai][bj][m][1];
                        s += (v0[0] * v0[0] + v0[1] * v0[1]) + (v0[2] * v0[2] + v0[3] * v0[3]) + (v1[0] * v1[0] + v1[1] * v1[1]) + (v1[2] * v1[2] + v1[3] * v1[3]);
                        *(u32x4*)(O + (size_t)row * ldc + ct + bj * 128 + colw) = pack8(v0, v1); }
                    s += __shfl_xor(s, 16); s += __shfl_xor(s, 32);
                    if (fq == 0) ssq[(size_t)row * nsl + sl] = s; }
        } else if (pn < 13) {
            const bool isq = pn < 9; bf16_t* O = isq ? DQ : DK; const int ct = (pn - (isq ? 5 : 9)) * 256; const float sc = isq ? C2_DIFF : 1.0f;
            const int i0 = ((wc & 1) * 32 + 8 * fq) >> 1;
#pragma unroll
            for (int ai = 0; ai < 2; ++ai)
#pragma unroll
                for (int m = 0; m < 4; ++m) { const int row = row0 + ai * 128 + m * 16; const int pos = row & (SEQ - 1);
                    const f32x4 cs0 = *(const f32x4*)(rope + (size_t)(pos * 32 + i0) * 2), cs1 = *(const f32x4*)(rope + (size_t)(pos * 32 + i0 + 2) * 2);
#pragma unroll
                    for (int bj = 0; bj < 2; ++bj) { f32x4 v0 = acc[ai][bj][m][0], v1 = acc[ai][bj][m][1]; rope8(v0, v1, cs0, cs1, sc);
                        *(u32x4*)(O + (size_t)row * 1024 + ct + bj * 128 + colw) = pack8(v0, v1); } }
        } else if (pn < 17) {
            const int ct = (pn - 13) * 256;
#pragma unroll
            for (int ai = 0; ai < 2; ++ai)
#pragma unroll
                for (int m = 0; m < 4; ++m) { const int row = row0 + ai * 128 + m * 16;
#pragma unroll
                    for (int bj = 0; bj < 2; ++bj) *(u32x4*)(DV + (size_t)row * 1024 + ct + bj * 128 + colw) = pack8(acc[ai][bj][m][0], acc[ai][bj][m][1]); }
        } else if (pn < 33) {
            const int ct = (pn - 17) * 256;
            f32x4 bv[2][2];
#pragma unroll
            for (int bj = 0; bj < 2; ++bj) { bv[bj][0] = *(const f32x4*)(bgate + ct + bj * 128 + colw); bv[bj][1] = *(const f32x4*)(bgate + ct + bj * 128 + colw + 4); }
#pragma unroll
            for (int ai = 0; ai < 2; ++ai)
#pragma unroll
                for (int m = 0; m < 4; ++m) { const int row = row0 + ai * 128 + m * 16;
#pragma unroll
                    for (int bj = 0; bj < 2; ++bj) { f32x4 v0 = acc[ai][bj][m][0] + bv[bj][0], v1 = acc[ai][bj][m][1] + bv[bj][1];
#pragma unroll
                        for (int e = 0; e < 4; ++e) { v0[e] = sigmoidf_fast(v0[e]); v1[e] = sigmoidf_fast(v1[e]); }
                        *(u32x4*)(G + (size_t)row * 4096 + ct + bj * 128 + colw) = pack8(v0, v1); } }
        } else {
            if (wc < 2) {
                const int i0 = colw >> 1;
#pragma unroll
                for (int ai = 0; ai < 2; ++ai)
#pragma unroll
                    for (int m = 0; m < 4; ++m) { const int row = row0 + ai * 128 + m * 16; const int pos = row & (SEQ - 1);
                        const f32x4 cs0 = *(const f32x4*)(rope + (size_t)(pos * 32 + i0) * 2), cs1 = *(const f32x4*)(rope + (size_t)(pos * 32 + i0 + 2) * 2);
                        f32x4 v0 = acc[ai][0][m][0], v1 = acc[ai][0][m][1]; rope8(v0, v1, cs0, cs1, 1.0f);
                        *(u32x4*)(KR + (size_t)row * 64 + colw) = pack8(v0, v1); }
            }
        }
    }
};

struct EpiQup {
    static constexpr bool PERM = true;
    bf16_t *QN, *QR; const float* ssq; const float* rope;
    __device__ __forceinline__ void operator()(const f32x4 (&acc)[2][2][4][2], const pg8::Unit& u, int wr, int wc, int fr, int fq) const {
        const int row0 = u.pm * 256 + wr * 64 + fr, pn = u.pn, colw = wc * 32 + 8 * fq;
        const int i0 = ((wc & 1) * 32 + 8 * fq) >> 1;
#pragma unroll
        for (int ai = 0; ai < 2; ++ai)
#pragma unroll
            for (int m = 0; m < 4; ++m) { const int row = row0 + ai * 128 + m * 16; const int pos = row & (SEQ - 1);
                const f32x4 q0 = *(const f32x4*)(ssq + (size_t)row * 12), q1 = *(const f32x4*)(ssq + (size_t)row * 12 + 4), q2 = *(const f32x4*)(ssq + (size_t)row * 12 + 8);
                const float sq = (((q0[0] + q0[1]) + (q0[2] + q0[3])) + ((q1[0] + q1[1]) + (q1[2] + q1[3]))) + ((q2[0] + q2[1]) + (q2[2] + q2[3]));
                const float sc = C2_MLA / sqrtf(sq * (1.0f / 768.0f) + EPS);
                if (pn < 4) {
#pragma unroll
                    for (int bj = 0; bj < 2; ++bj) *(u32x4*)(QN + (size_t)row * 1024 + pn * 256 + bj * 128 + colw) = pack8(acc[ai][bj][m][0] * sc, acc[ai][bj][m][1] * sc);
                } else {
                    const f32x4 cs0 = *(const f32x4*)(rope + (size_t)(pos * 32 + i0) * 2), cs1 = *(const f32x4*)(rope + (size_t)(pos * 32 + i0 + 2) * 2);
#pragma unroll
                    for (int bj = 0; bj < 2; ++bj) { f32x4 v0 = acc[ai][bj][m][0], v1 = acc[ai][bj][m][1]; rope8(v0, v1, cs0, cs1, sc);
                        *(u32x4*)(QR + (size_t)row * 512 + (pn - 4) * 256 + bj * 128 + colw) = pack8(v0, v1); }
                } }
    }
};
struct EpiKVup {
    static constexpr bool PERM = true;
    bf16_t *KN, *V; const float* ssq;
    __device__ __forceinline__ void operator()(const f32x4 (&acc)[2][2][4][2], const pg8::Unit& u, int wr, int wc, int fr, int fq) const {
        const int row0 = u.pm * 256 + wr * 64 + fr, pn = u.pn, colw = wc * 32 + 8 * fq;
        bf16_t* O = pn < 4 ? KN : V; const int ct = (pn & 3) * 256;
#pragma unroll
        for (int ai = 0; ai < 2; ++ai)
#pragma unroll
            for (int m = 0; m < 4; ++m) { const int row = row0 + ai * 128 + m * 16;
                const f32x4 q0 = *(const f32x4*)(ssq + (size_t)row * 8), q1 = *(const f32x4*)(ssq + (size_t)row * 8 + 4);
                const float sq = ((q0[0] + q0[1]) + (q0[2] + q0[3])) + ((q1[0] + q1[1]) + (q1[2] + q1[3]));
                const float sc = 1.0f / sqrtf(sq * (1.0f / 512.0f) + EPS);
#pragma unroll
                for (int bj = 0; bj < 2; ++bj) *(u32x4*)(O + (size_t)row * 1024 + ct + bj * 128 + colw) = pack8(acc[ai][bj][m][0] * sc, acc[ai][bj][m][1] * sc); }
    }
};
struct EpiGate {
    static constexpr bool PERM = true;
    const bf16_t* G; bf16_t* TMP; bf16_t* MG; int second;
    __device__ __forceinline__ void operator()(const f32x4 (&acc)[2][2][4][2], const pg8::Unit& u, int wr, int wc, int fr, int fq) const {
        const int row0 = u.pm * 256 + wr * 64 + fr, colw = u.pn * 256 + wc * 32 + 8 * fq;
#pragma unroll
        for (int ai = 0; ai < 2; ++ai)
#pragma unroll
            for (int m = 0; m < 4; ++m) { const int row = row0 + ai * 128 + m * 16;
#pragma unroll
                for (int bj = 0; bj < 2; ++bj) { const int col = colw + bj * 128;
                    const u32x4 gw = *(const u32x4*)(G + (size_t)row * 4096 + (second ? 2048 : 0) + col);
                    f32x4 v0 = acc[ai][bj][m][0], v1 = acc[ai][bj][m][1];
                    v0 = (f32x4){v0[0] * bflo(gw.x), v0[1] * bfhi(gw.x), v0[2] * bflo(gw.y), v0[3] * bfhi(gw.y)};
                    v1 = (f32x4){v1[0] * bflo(gw.z), v1[1] * bfhi(gw.z), v1[2] * bflo(gw.w), v1[3] * bfhi(gw.w)};
                    if (second) { const u32x4 tw = *(const u32x4*)(TMP + (size_t)row * 2048 + col);
                        v0 += (f32x4){bflo(tw.x), bfhi(tw.x), bflo(tw.y), bfhi(tw.y)}; v1 += (f32x4){bflo(tw.z), bfhi(tw.z), bflo(tw.w), bfhi(tw.w)};
                        *(u32x4*)(MG + (size_t)row * 2048 + col) = pack8(v0, v1);
                    } else *(u32x4*)(TMP + (size_t)row * 2048 + col) = pack8(v0, v1); } }
    }
};
struct EpiGate2 {
    static constexpr bool PERM = true;
    const bf16_t* G; bf16_t* MG;
    __device__ __forceinline__ void mid(f32x4 (&acc)[2][2][4][2], const pg8::Unit& u, int wr, int wc, int fr, int fq) const {
        const int row0 = u.pm * 256 + wr * 64 + fr, colw = u.pn * 256 + wc * 32 + 8 * fq;
#pragma unroll
        for (int ai = 0; ai < 2; ++ai)
#pragma unroll
            for (int m = 0; m < 4; ++m) { const int row = row0 + ai * 128 + m * 16;
#pragma unroll
                for (int bj = 0; bj < 2; ++bj) { const int col = colw + bj * 128;
                    const u32x4 ga = *(const u32x4*)(G + (size_t)row * 4096 + col), gb = *(const u32x4*)(G + (size_t)row * 4096 + 2048 + col);
                    f32x4 r0, r1;
                    r0[0] = bflo(ga.x) * __builtin_amdgcn_rcpf(bflo(gb.x)); r0[1] = bfhi(ga.x) * __builtin_amdgcn_rcpf(bfhi(gb.x)); r0[2] = bflo(ga.y) * __builtin_amdgcn_rcpf(bflo(gb.y)); r0[3] = bfhi(ga.y) * __builtin_amdgcn_rcpf(bfhi(gb.y));
                    r1[0] = bflo(ga.z) * __builtin_amdgcn_rcpf(bflo(gb.z)); r1[1] = bfhi(ga.z) * __builtin_amdgcn_rcpf(bfhi(gb.z)); r1[2] = bflo(ga.w) * __builtin_amdgcn_rcpf(bflo(gb.w)); r1[3] = bfhi(ga.w) * __builtin_amdgcn_rcpf(bfhi(gb.w));
                    acc[ai][bj][m][0] *= r0; acc[ai][bj][m][1] *= r1; }
                asm volatile("" ::: "memory"); }
    }
    __device__ __forceinline__ void operator()(const f32x4 (&acc)[2][2][4][2], const pg8::Unit& u, int wr, int wc, int fr, int fq) const {
        const int row0 = u.pm * 256 + wr * 64 + fr, colw = u.pn * 256 + wc * 32 + 8 * fq;
#pragma unroll
        for (int ai = 0; ai < 2; ++ai)
#pragma unroll
            for (int m = 0; m < 4; ++m) { const int row = row0 + ai * 128 + m * 16;
#pragma unroll
                for (int bj = 0; bj < 2; ++bj) { const int col = colw + bj * 128;
                    const u32x4 gb = *(const u32x4*)(G + (size_t)row * 4096 + 2048 + col);
                    f32x4 v0 = acc[ai][bj][m][0], v1 = acc[ai][bj][m][1];
                    v0 = (f32x4){v0[0] * bflo(gb.x), v0[1] * bfhi(gb.x), v0[2] * bflo(gb.y), v0[3] * bfhi(gb.y)};
                    v1 = (f32x4){v1[0] * bflo(gb.z), v1[1] * bfhi(gb.z), v1[2] * bflo(gb.w), v1[3] * bfhi(gb.w)};
                    *(u32x4*)(MG + (size_t)row * 2048 + col) = pack8(v0, v1); } }
    }
};
struct EpiRes {
    static constexpr bool PERM = false;
    const float* x; float* X2; bf16_t* X2B; float* ssq;
    __device__ __forceinline__ void operator()(const f32x4 (&acc)[2][2][4][2], const pg8::Unit& u, int wr, int wc, int fr, int fq) const {
        const int row0 = u.pm * 256 + wr * 64 + fr, col0 = u.pn * 256 + wc * 32 + 4 * fq;
#pragma unroll
        for (int ai = 0; ai < 2; ++ai)
#pragma unroll
            for (int m = 0; m < 4; ++m) { const int row = row0 + ai * 128 + m * 16; float s = 0.f;
#pragma unroll
                for (int bj = 0; bj < 2; ++bj)
#pragma unroll
                    for (int n = 0; n < 2; ++n) { const size_t off = (size_t)row * 2048 + col0 + bj * 128 + n * 16;
                        const f32x4 v = acc[ai][bj][m][n] + *(const f32x4*)(x + off);
                        s += (v[0] * v[0] + v[1] * v[1]) + (v[2] * v[2] + v[3] * v[3]);
#ifdef PEER_BF16
                        *(f32x4*)(X2 + off) = v;
#endif
                        u32x2 w; w.x = cvtpk(v[0], v[1]); w.y = cvtpk(v[2], v[3]); *(u32x2*)(X2B + off) = w; }
                s += __shfl_xor(s, 16); s += __shfl_xor(s, 32);
                if (fq == 0) ssq[(size_t)row * 32 + u.pn * 4 + wc] = s; }
    }
};
__device__ __forceinline__ float sum32(const float* p) { float t = 0.f;
#pragma unroll
    for (int i = 0; i < 8; ++i) { const f32x4 q = *(const f32x4*)(p + 4 * i); t += (q[0] + q[1]) + (q[2] + q[3]); } return t; }
struct EpiQP {
    static constexpr bool PERM = true;
    bf16_t* QP; const float* ssq;
    __device__ __forceinline__ void operator()(const f32x4 (&acc)[2][2][4][2], const pg8::Unit& u, int wr, int wc, int fr, int fq) const {
        const int row0 = u.pm * 256 + wr * 64 + fr, colw = u.pn * 256 + wc * 32 + 8 * fq;
#pragma unroll
        for (int ai = 0; ai < 2; ++ai)
#pragma unroll
            for (int m = 0; m < 4; ++m) { const int row = row0 + ai * 128 + m * 16;
                const float sc = 1.0f / sqrtf(sum32(ssq + (size_t)row * 32) * (1.0f / 2048.0f) + EPS);
#pragma unroll
                for (int bj = 0; bj < 2; ++bj) *(u32x4*)(QP + (size_t)row * 2048 + colw + bj * 128) = pack8(acc[ai][bj][m][0] * sc, acc[ai][bj][m][1] * sc); }
    }
};

__device__ __forceinline__ void naive_attn(LAS float* qs, const bf16* qa, int ldqa, int da, const bf16* qb, int ldqb, int db,
                                           const bf16* ka, int ldka, const bf16* kb, int ldkb, const bf16* v, int ldv,
                                           size_t rowbase, int p0, int lane, float (&o)[4][2], float (&linv)[4]) {
    const int dt = da + db;
    for (int idx = lane; idx < 4 * dt; idx += 64) { const int r = idx / dt, d = idx - r * dt;
        const bf16 h = d < da ? qa[(rowbase + p0 + r) * ldqa + d] : qb[(rowbase + p0 + r) * ldqb + (d - da)];
        qs[r * 192 + d] = bf2f(h); }
    LDS_WAIT(); asm volatile("" ::: "memory");
    float m[4], l[4];
#pragma unroll
    for (int r = 0; r < 4; ++r) { m[r] = -INFINITY; l[r] = 0.f; o[r][0] = 0.f; o[r][1] = 0.f; }
    const int pmax = p0 + 3, ntile = pmax / 64 + 1;
#pragma unroll 1
    for (int kt = 0; kt < ntile; ++kt) {
        const int key = kt * 64 + lane, kc = key < pmax ? key : pmax;
        float s[4] = {0.f, 0.f, 0.f, 0.f};
        const bf16* kra = ka + (rowbase + kc) * ldka;
#pragma unroll 2
        for (int d = 0; d < da; d += 8) { const u32x4 kw = *(const u32x4*)(kra + d);
            const float k0 = bflo(kw.x), k1 = bfhi(kw.x), k2 = bflo(kw.y), k3 = bfhi(kw.y), k4 = bflo(kw.z), k5 = bfhi(kw.z), k6 = bflo(kw.w), k7 = bfhi(kw.w);
#pragma unroll
            for (int r = 0; r < 4; ++r) { const f32x4 qa4 = *(const LAS f32x4*)(qs + r * 192 + d), qb4 = *(const LAS f32x4*)(qs + r * 192 + d + 4);
                s[r] += (qa4[0] * k0 + qa4[1] * k1) + (qa4[2] * k2 + qa4[3] * k3) + (qb4[0] * k4 + qb4[1] * k5) + (qb4[2] * k6 + qb4[3] * k7); } }
        if (db > 0) { const bf16* krb = kb + (rowbase + kc) * ldkb;
#pragma unroll 2
            for (int d = 0; d < db; d += 8) { const u32x4 kw = *(const u32x4*)(krb + d);
                const float k0 = bflo(kw.x), k1 = bfhi(kw.x), k2 = bflo(kw.y), k3 = bfhi(kw.y), k4 = bflo(kw.z), k5 = bfhi(kw.z), k6 = bflo(kw.w), k7 = bfhi(kw.w);
#pragma unroll
                for (int r = 0; r < 4; ++r) { const f32x4 qa4 = *(const LAS f32x4*)(qs + r * 192 + da + d), qb4 = *(const LAS f32x4*)(qs + r * 192 + da + d + 4);
                    s[r] += (qa4[0] * k0 + qa4[1] * k1) + (qa4[2] * k2 + qa4[3] * k3) + (qb4[0] * k4 + qb4[1] * k5) + (qb4[2] * k6 + qb4[3] * k7); } } }
        float p[4];
#pragma unroll
        for (int r = 0; r < 4; ++r) {
            const float sv = key > p0 + r ? -INFINITY : s[r];
            const float mn = fmaxf(m[r], wave_max(sv));
            const float al = __builtin_amdgcn_exp2f(m[r] - mn);
            p[r] = __builtin_amdgcn_exp2f(sv - mn);
            l[r] = l[r] * al + wave_sum(p[r]); o[r][0] *= al; o[r][1] *= al; m[r] = mn;
        }
        const int jn = (pmax - kt * 64) < 63 ? (pmax - kt * 64) : 63;
#pragma unroll 4
        for (int j = 0; j <= jn; ++j) {
            const bf16* vr = v + (rowbase + kt * 64 + j) * ldv;
            const float v0 = bf2f(vr[lane]), v1 = bf2f(vr[64 + lane]);
#pragma unroll
            for (int r = 0; r < 4; ++r) { const float pj = __builtin_bit_cast(float, __builtin_amdgcn_readlane(__builtin_bit_cast(int, p[r]), j)); o[r][0] += pj * v0; o[r][1] += pj * v1; }
        }
    }
#pragma unroll
    for (int r = 0; r < 4; ++r) linv[r] = 1.0f / l[r];
    LDS_WAIT(); asm volatile("" ::: "memory");
}
__device__ __forceinline__ void p3_attention_ref(Frame& F, const Ins& I) {
    unsigned char* ws = F.ws;
    const bf16 *QN = (const bf16*)(ws + WS_QN), *QR = (const bf16*)(ws + WS_QR), *KN = (const bf16*)(ws + WS_KN), *KR = (const bf16*)(ws + WS_KR), *V = (const bf16*)(ws + WS_V);
    const bf16 *DQ = (const bf16*)(ws + WS_DQ), *DK = (const bf16*)(ws + WS_DK), *DV = (const bf16*)(ws + WS_DV);
    bf16 *OM = (bf16*)(ws + WS_OM), *OD = (bf16*)(ws + WS_OD);
    LAS float* qs = (LAS float*)(F.lds + RING_OFF + F.wave * 4096);
    const int gw = F.vcu * NWAVES + F.wave, NGW = F.G * NWAVES, lane = F.lane;
    const float lam = ((const float*)F.ctl)[CW_LAMBDA];
    const float gs0 = I.g_subln[lane] * (1.0f - LAMBDA_INIT), gs1 = I.g_subln[64 + lane] * (1.0f - LAMBDA_INIT);
    for (int it = gw; it < 2 * 16 * (SEQ / 4); it += NGW) {
        const int type = it & 1, rest = it >> 1, bh = rest & 15, g = rest >> 4, b = bh >> 3, h = bh & 7, p0 = 4 * g;
        const size_t rowbase = (size_t)b * SEQ;
        float o[4][2], li[4];
        if (type == 0) {
            naive_attn(qs, QN + h * 128, 1024, 128, QR + h * 64, 512, 64, KN + h * 128, 1024, KR, 64, V + h * 128, 1024, rowbase, p0, lane, o, li);
#pragma unroll
            for (int r = 0; r < 4; ++r) { bf16* orow = OM + (rowbase + p0 + r) * 1024 + h * 128;
#ifdef ATT_CHECK
                { const float a0 = bf2f(orow[lane]), a1 = bf2f(orow[64 + lane]), b0 = o[r][0] * li[r], b1 = o[r][1] * li[r];
                  if (fabsf(a0 - b0) > ATT_TOL_A + ATT_TOL_R * fabsf(b0) || fabsf(a1 - b1) > ATT_TOL_A + ATT_TOL_R * fabsf(b1) || !(a0 == a0) || !(a1 == a1)) atomicAdd((unsigned*)F.ctl + 16, 1u); }
#else
                orow[lane] = (bf16)(pk2(o[r][0] * li[r], 0.f) & 0xffffu); orow[64 + lane] = (bf16)(pk2(o[r][1] * li[r], 0.f) & 0xffffu);
#endif
            }
        } else {
            float o2[4][2], li2[4];
            naive_attn(qs, DQ + (h * 2) * 64, 1024, 64, DQ, 1024, 0, DK + (h * 2) * 64, 1024, DK, 1024, DV + h * 128, 1024, rowbase, p0, lane, o, li);
            naive_attn(qs, DQ + (h * 2 + 1) * 64, 1024, 64, DQ, 1024, 0, DK + (h * 2 + 1) * 64, 1024, DK, 1024, DV + h * 128, 1024, rowbase, p0, lane, o2, li2);
#pragma unroll
            for (int r = 0; r < 4; ++r) {
                const float d0 = o[r][0] * li[r] - lam * o2[r][0] * li2[r], d1 = o[r][1] * li[r] - lam * o2[r][1] * li2[r];
                const float rs = 1.0f / sqrtf(wave_sum(d0 * d0 + d1 * d1) * (1.0f / 128.0f) + EPS);
                bf16* orow = OD + (rowbase + p0 + r) * 1024 + h * 128;
#ifdef ATT_CHECK
                { const float a0 = bf2f(orow[lane]), a1 = bf2f(orow[64 + lane]), b0 = d0 * rs * gs0, b1 = d1 * rs * gs1;
                  if (fabsf(a0 - b0) > ATT_TOL_A + ATT_TOL_R * fabsf(b0) || fabsf(a1 - b1) > ATT_TOL_A + ATT_TOL_R * fabsf(b1) || !(a0 == a0) || !(a1 == a1)) atomicAdd((unsigned*)F.ctl + 17, 1u); }
#else
                orow[lane] = (bf16)(pk2(d0 * rs * gs0, 0.f) & 0xffffu); orow[64 + lane] = (bf16)(pk2(d1 * rs * gs1, 0.f) & 0xffffu);
#endif
            }
        }
    }
}

namespace att {
typedef short bf16x8 __attribute__((ext_vector_type(8)));
typedef short s16x4 __attribute__((ext_vector_type(4)));
typedef float f32x16 __attribute__((ext_vector_type(16)));
typedef short v4i16_t __attribute__((ext_vector_type(4)));
constexpr int BUFB = 40960, WSF_OFF = 2 * BUFB;
#ifndef ATT_KD
#define ATT_KD 2
#endif
#ifndef ATT_VD
#define ATT_VD 2
#endif
__device__ __forceinline__ int crow(int r, int hi) { return (r & 3) + 8 * (r >> 2) + 4 * hi; }
__device__ __forceinline__ s16x4 vtr(const LAS unsigned char* p) { return __builtin_bit_cast(s16x4, __builtin_amdgcn_ds_read_tr16_b64_v4i16((LAS v4i16_t*)p)); }
__device__ __forceinline__ float swapmax(float m) { auto rr = __builtin_amdgcn_permlane32_swap(__float_as_uint(m), __float_as_uint(m), false, false);
    const unsigned a = rr[0], b = rr[1]; return fmaxf(__uint_as_float(a), __uint_as_float(b)); }
__device__ __forceinline__ float swapsum(float m) { auto rr = __builtin_amdgcn_permlane32_swap(__float_as_uint(m), __float_as_uint(m), false, false);
    const unsigned a = rr[0], b = rr[1]; return __uint_as_float(a) + __uint_as_float(b); }

template <bool DIFF>
__device__ __forceinline__ void attn_unit(LAS unsigned char* lds, int tid, size_t rowbase, int h, int q0,
                                          const bf16* Qa, const bf16* Qb, const bf16* Ka, const bf16* Kb, const bf16* Vp, bf16* Op, float lam, const float* gsub) {
    constexpr int NP = DIFF ? 4 : 5, NKS = DIFF ? 4 : 12, KPIECES = DIFF ? 16 : 24, R = DIFF ? 128 : 256;
    const int lane = tid & 63, r32 = lane & 31, hi = lane >> 5, wid = __builtin_amdgcn_readfirstlane(tid >> 6);
    const int mp = DIFF ? (wid >> 2) : 0, rows_w0 = q0 + 32 * (DIFF ? (wid & 3) : wid);
    const char* src[NP]; unsigned tstr[NP]; unsigned dsto[NP];
#pragma unroll
    for (int i = 0; i < NP; ++i) { const int pidx = wid * NP + i;
        if (!DIFF) {
            if (pidx < 16) { src[i] = (const char*)(Ka + (rowbase + lane) * 1024 + h * 128 + pidx * 8); tstr[i] = 64 * 2048; dsto[i] = pidx * 1024; }
            else if (pidx < 24) { src[i] = (const char*)(Kb + (rowbase + lane) * 64 + (pidx - 16) * 8); tstr[i] = 64 * 128; dsto[i] = pidx * 1024; }
            else { const int v = pidx - 24, dblk = v >> 2, kg = v & 3; src[i] = (const char*)(Vp + (rowbase + kg * 16 + (lane >> 2)) * 1024 + h * 128 + dblk * 32 + (lane & 3) * 8); tstr[i] = 64 * 2048; dsto[i] = (24 + v) * 1024; }
        } else {
            if (pidx < 16) { const int m2 = pidx >> 3, c = pidx & 7; src[i] = (const char*)(Ka + (rowbase + lane) * 1024 + (h * 2 + m2) * 64 + c * 8); tstr[i] = 64 * 2048; dsto[i] = pidx * 1024; }
            else { const int v = pidx - 16, dblk = v >> 2, kg = v & 3; src[i] = (const char*)(Vp + (rowbase + kg * 16 + (lane >> 2)) * 1024 + h * 128 + dblk * 32 + (lane & 3) * 8); tstr[i] = 64 * 2048; dsto[i] = (16 + v) * 1024; }
        } }
    const unsigned lds0 = (unsigned)(uintptr_t)lds;
#define ATT_DMA(t, bb) do { _Pragma("unroll") for (int _i = 0; _i < NP; ++_i) { unsigned _keep; const unsigned _dst = (unsigned)__builtin_amdgcn_readfirstlane((int)(lds0 + (unsigned)((bb) * BUFB) + dsto[_i])); \
        asm volatile("s_mov_b32 %0, m0\n\ts_mov_b32 m0, %2\n\ts_nop 0\n\tglobal_load_lds_dwordx4 %1, off\n\ts_mov_b32 m0, %0" : "=&s"(_keep) : "v"(src[_i] + (size_t)(t) * tstr[_i]), "s"(_dst) : "memory"); } } while (0)
    bf16x8 qf[NKS];
    { const size_t qrow = rowbase + rows_w0 + r32;
#pragma unroll
      for (int ks = 0; ks < NKS; ++ks) {
          if (DIFF) qf[ks] = *(const bf16x8*)(Qa + qrow * 1024 + (h * 2 + mp) * 64 + ks * 16 + hi * 8);
          else if (ks < 8) qf[ks] = *(const bf16x8*)(Qa + qrow * 1024 + h * 128 + ks * 16 + hi * 8);
          else qf[ks] = *(const bf16x8*)(Qb + qrow * 512 + h * 64 + (ks - 8) * 16 + hi * 8);
      } }
    f32x16 o[4];
#pragma unroll
    for (int d0 = 0; d0 < 4; ++d0) o[d0] = f32x16{};
    float m = -1e30f, l = 0.f;
    const int NT = (q0 + R) / 64, t_last = (rows_w0 + 31) / 64;
    LAS float* wsf = (LAS float*)(lds + WSF_OFF) + wid * 32;
    const int koff = (DIFF ? mp * 8 * 1024 : 0) + hi * 1024 + r32 * 16;
    const int voff = KPIECES * 1024 + ((lane >> 4) & 1) * 32 + (lane & 3) * 8 + (4 * hi + ((lane & 15) >> 2)) * 64;
    const int qpos = rows_w0 + r32;
    ATT_DMA(0, 0);
    __builtin_amdgcn_s_waitcnt(0x0F70);
    asm volatile("s_waitcnt vmcnt(0)" ::: "memory"); __syncthreads();
#pragma unroll 1
    for (int t = 0; t < NT; ++t) {
        const int bb = t & 1;
        if (t + 1 < NT) ATT_DMA(t + 1, bb ^ 1);
        if (t <= t_last) {
            const LAS unsigned char* kb = lds + bb * BUFB + koff;
            f32x16 p0 = f32x16{}, p1 = f32x16{};
            {
                bf16x8 kfa[NKS], kfc[NKS];
#pragma unroll
                for (int ks = 0; ks < ATT_KD; ++ks) { kfa[ks] = *(const LAS bf16x8*)(kb + ks * 2048); kfc[ks] = *(const LAS bf16x8*)(kb + ks * 2048 + 512); }
                __builtin_amdgcn_sched_barrier(0);
#pragma unroll
                for (int ks = 0; ks < NKS; ++ks) {
                    if (ks + ATT_KD < NKS) { kfa[ks + ATT_KD] = *(const LAS bf16x8*)(kb + (ks + ATT_KD) * 2048); kfc[ks + ATT_KD] = *(const LAS bf16x8*)(kb + (ks + ATT_KD) * 2048 + 512); }
                    __builtin_amdgcn_sched_barrier(0);
                    p0 = __builtin_amdgcn_mfma_f32_32x32x16_bf16(kfa[ks], qf[ks], p0, 0, 0, 0);
                    p1 = __builtin_amdgcn_mfma_f32_32x32x16_bf16(kfc[ks], qf[ks], p1, 0, 0, 0);
                    __builtin_amdgcn_sched_barrier(0);
                }
            }
            if (64 * t + 63 > rows_w0) {
                const int kb0 = 64 * t + 4 * hi;
#pragma unroll
                for (int r = 0; r < 16; ++r) { const int kv = kb0 + (r & 3) + 8 * (r >> 2); if (kv > qpos) p0[r] = -INFINITY; if (kv + 32 > qpos) p1[r] = -INFINITY; }
            }
            float rm = fmaxf(p0[0], p1[0]);
#pragma unroll
            for (int r = 1; r < 16; ++r) rm = fmaxf(rm, fmaxf(p0[r], p1[r]));
            rm = swapmax(rm);
            const float mn = fmaxf(m, rm);
            if (__any(mn > m)) {
                const float al = __builtin_amdgcn_exp2f(m - mn);
                l *= al;
                if (hi == 0) wsf[r32] = al;
                LDS_WAIT(); asm volatile("" ::: "memory");
#pragma unroll
                for (int r = 0; r < 16; ++r) { const float a = wsf[crow(r, hi)];
#pragma unroll
                    for (int d0 = 0; d0 < 4; ++d0) o[d0][r] *= a; }
                LDS_WAIT(); asm volatile("" ::: "memory");
            }
            m = mn;
            float ps = 0.f;
#pragma unroll
            for (int r = 0; r < 16; ++r) { p0[r] = __builtin_amdgcn_exp2f(p0[r] - mn); p1[r] = __builtin_amdgcn_exp2f(p1[r] - mn); ps += p0[r] + p1[r]; }
            l += ps;
            u32x4 pw[4];
            pw[0] = (u32x4){cvtpk(p0[0], p0[1]), cvtpk(p0[2], p0[3]), cvtpk(p0[4], p0[5]), cvtpk(p0[6], p0[7])};
            pw[1] = (u32x4){cvtpk(p0[8], p0[9]), cvtpk(p0[10], p0[11]), cvtpk(p0[12], p0[13]), cvtpk(p0[14], p0[15])};
            pw[2] = (u32x4){cvtpk(p1[0], p1[1]), cvtpk(p1[2], p1[3]), cvtpk(p1[4], p1[5]), cvtpk(p1[6], p1[7])};
            pw[3] = (u32x4){cvtpk(p1[8], p1[9]), cvtpk(p1[10], p1[11]), cvtpk(p1[12], p1[13]), cvtpk(p1[14], p1[15])};
            const LAS unsigned char* vb = lds + bb * BUFB + voff;
            {
                s16x4 vlo[16], vhh[16];
#pragma unroll
                for (int i = 0; i < ATT_VD; ++i) { vlo[i] = vtr(vb + i * 1024); vhh[i] = vtr(vb + i * 1024 + 512); }
                __builtin_amdgcn_sched_barrier(0);
#pragma unroll
                for (int i = 0; i < 16; ++i) {
                    if (i + ATT_VD < 16) { vlo[i + ATT_VD] = vtr(vb + (i + ATT_VD) * 1024); vhh[i + ATT_VD] = vtr(vb + (i + ATT_VD) * 1024 + 512); }
                    __builtin_amdgcn_sched_barrier(0);
                    const bf16x8 vf = (bf16x8){vlo[i][0], vlo[i][1], vlo[i][2], vlo[i][3], vhh[i][0], vhh[i][1], vhh[i][2], vhh[i][3]};
                    o[i >> 2] = __builtin_amdgcn_mfma_f32_32x32x16_bf16(__builtin_bit_cast(bf16x8, pw[i & 3]), vf, o[i >> 2], 0, 0, 0);
                    __builtin_amdgcn_sched_barrier(0);
                }
            }
        }
        asm volatile("s_waitcnt vmcnt(0)" ::: "memory"); __syncthreads();
    }
#undef ATT_DMA
    l = swapsum(l);
    if (hi == 0) wsf[r32] = l;
    LDS_WAIT(); asm volatile("" ::: "memory");
    float rli[16];
#pragma unroll
    for (int r = 0; r < 16; ++r) rli[r] = 1.0f / wsf[crow(r, hi)];
    LDS_WAIT(); asm volatile("" ::: "memory");
    if (!DIFF) {
#pragma unroll
        for (int r = 0; r < 16; ++r) { bf16* orow = Op + (rowbase + rows_w0 + crow(r, hi)) * 1024 + h * 128 + r32;
#pragma unroll
            for (int d0 = 0; d0 < 4; ++d0) orow[d0 * 32] = (bf16)(cvtpk(o[d0][r] * rli[r], 0.f) & 0xffffu); }
    } else {
        LAS float* xch = (LAS float*)lds;
        if (wid >= 4) {
#pragma unroll
            for (int d0 = 0; d0 < 4; ++d0)
#pragma unroll
                for (int r = 0; r < 16; ++r) xch[((wid & 3) * 64 + d0 * 16 + r) * 64 + lane] = o[d0][r] * rli[r];
        }
        __syncthreads();
        if (wid < 4) {
            float ss[16];
#pragma unroll
            for (int r = 0; r < 16; ++r) ss[r] = 0.f;
#pragma unroll
            for (int d0 = 0; d0 < 4; ++d0)
#pragma unroll
                for (int r = 0; r < 16; ++r) { const float d = o[d0][r] * rli[r] - lam * xch[(wid * 64 + d0 * 16 + r) * 64 + lane]; o[d0][r] = d; ss[r] += d * d; }
#pragma unroll
            for (int r = 0; r < 16; ++r) {
#pragma unroll
                for (int of = 1; of < 32; of <<= 1) ss[r] += __shfl_xor(ss[r], of);
                ss[r] = 1.0f / sqrtf(ss[r] * (1.0f / 128.0f) + EPS); }
            float g4[4];
#pragma unroll
            for (int d0 = 0; d0 < 4; ++d0) g4[d0] = gsub[d0 * 32 + r32] * (1.0f - LAMBDA_INIT);
#pragma unroll
            for (int r = 0; r < 16; ++r) { bf16* orow = Op + (rowbase + rows_w0 + crow(r, hi)) * 1024 + h * 128 + r32;
#pragma unroll
                for (int d0 = 0; d0 < 4; ++d0) orow[d0 * 32] = (bf16)(cvtpk(o[d0][r] * ss[r] * g4[d0], 0.f) & 0xffffu); }
        }
        __syncthreads();
    }
}
}

__device__ __forceinline__ void p3_attention(Frame& F, const Ins& I) {
    unsigned char* ws = F.ws;
    const bf16 *QN = (const bf16*)(ws + WS_QN), *QR = (const bf16*)(ws + WS_QR), *KN = (const bf16*)(ws + WS_KN), *KR = (const bf16*)(ws + WS_KR), *V = (const bf16*)(ws + WS_V);
    const bf16 *DQ = (const bf16*)(ws + WS_DQ), *DK = (const bf16*)(ws + WS_DK), *DV = (const bf16*)(ws + WS_DV);
    bf16 *OM = (bf16*)(ws + WS_OM), *OD = (bf16*)(ws + WS_OD);
    const float lam = ((const float*)F.ctl)[CW_LAMBDA];
    LAS unsigned char* lds = F.lds + RING_OFF;
    for (int v = F.vcu; v < 256; v += F.G) {
        const int bh = v >> 4, c = v & 15, b = bh >> 3, h = bh & 7; const size_t rowbase = (size_t)b * SEQ;
        att::attn_unit<false>(lds, F.tid, rowbase, h, (31 - c) * 256, QN, QR, KN, KR, V, OM, lam, I.g_subln);
        att::attn_unit<true>(lds, F.tid, rowbase, h, (63 - c) * 128, DQ, nullptr, DK, nullptr, DV, OD, lam, I.g_subln);
        att::attn_unit<true>(lds, F.tid, rowbase, h, (47 - c) * 128, DQ, nullptr, DK, nullptr, DV, OD, lam, I.g_subln);
        att::attn_unit<true>(lds, F.tid, rowbase, h, (16 + c) * 128, DQ, nullptr, DK, nullptr, DV, OD, lam, I.g_subln);
        att::attn_unit<true>(lds, F.tid, rowbase, h, c * 128, DQ, nullptr, DK, nullptr, DV, OD, lam, I.g_subln);
        att::attn_unit<false>(lds, F.tid, rowbase, h, c * 256, QN, QR, KN, KR, V, OM, lam, I.g_subln);
    }
}

__device__ __forceinline__ void wave_argmax(float v, int idx, float& mv, int& mi) {
#pragma unroll
    for (int o = 1; o < 64; o <<= 1) { const float ov = __shfl_xor(v, o); const int oi = __shfl_xor(idx, o); if (ov > v || (ov == v && oi < idx)) { v = ov; idx = oi; } }
    mv = v; mi = idx;
}
__device__ __forceinline__ void p7_routing_ref(Frame& F) {
    unsigned char* ws = F.ws;
    const bf16* QP = (const bf16*)(ws + WS_QP); const bf16* SKB = (const bf16*)(ws + WS_SKB);
    int* IDX = (int*)(ws + WS_IDX); float* GT = (float*)(ws + WS_GT);
    LAS float* wl = (LAS float*)(F.lds + RING_OFF + F.wave * 4096);
    LAS float* qs = wl; LAS float* v1s = wl + 256; LAS int* i1s = (LAS int*)(wl + 272); LAS float* v2s = wl + 288; LAS int* i2s = (LAS int*)(wl + 304);
    const int gw = F.vcu * NWAVES + F.wave, NGW = F.G * NWAVES, lane = F.lane;
    for (int it = gw; it < T * 8; it += NGW) {
        { const u32x2 w = *(const u32x2*)(QP + (size_t)it * 256 + lane * 4); qs[lane * 4 + 0] = bflo(w.x); qs[lane * 4 + 1] = bfhi(w.x); qs[lane * 4 + 2] = bflo(w.y); qs[lane * 4 + 3] = bfhi(w.y); }
        LDS_WAIT(); asm volatile("" ::: "memory");
        float sc[2][2];
#pragma unroll
        for (int hf = 0; hf < 2; ++hf)
#pragma unroll
            for (int kk = 0; kk < 2; ++kk) { const bf16* kr = SKB + (size_t)(hf * 128 + kk * 64 + lane) * 256 + hf * 128; float s = 0.f;
#pragma unroll 4
                for (int d = 0; d < 128; d += 8) { const u32x4 kw = *(const u32x4*)(kr + d);
                    const f32x4 qa4 = *(const LAS f32x4*)(qs + hf * 128 + d), qb4 = *(const LAS f32x4*)(qs + hf * 128 + d + 4);
                    s += (qa4[0] * bflo(kw.x) + qa4[1] * bfhi(kw.x)) + (qa4[2] * bflo(kw.y) + qa4[3] * bfhi(kw.y)) + (qb4[0] * bflo(kw.z) + qb4[1] * bfhi(kw.z)) + (qb4[2] * bflo(kw.w) + qb4[3] * bfhi(kw.w)); }
                sc[hf][kk] = s; }
#pragma unroll
        for (int hf = 0; hf < 2; ++hf) {
            float a = sc[hf][0], b = sc[hf][1];
            for (int r = 0; r < 16; ++r) {
                float lv; int li; if (b > a) { lv = b; li = lane + 64; } else { lv = a; li = lane; }
                float mv; int mi; wave_argmax(lv, li, mv, mi);
                if (mi == lane) a = -INFINITY; if (mi == lane + 64) b = -INFINITY;
                if (lane == 0) { if (hf == 0) { v1s[r] = mv; i1s[r] = mi; } else { v2s[r] = mv; i2s[r] = mi; } }
            }
        }
        LDS_WAIT(); asm volatile("" ::: "memory");
        float cv[4];
#pragma unroll
        for (int j = 0; j < 4; ++j) { const int c = lane * 4 + j; cv[j] = v1s[c >> 4] + v2s[c & 15]; }
        float mycs = 0.f; int myc = 0;
        for (int r = 0; r < 16; ++r) {
            float lv = cv[0]; int li = lane * 4;
#pragma unroll
            for (int j = 1; j < 4; ++j) if (cv[j] > lv) { lv = cv[j]; li = lane * 4 + j; }
            float mv; int mi; wave_argmax(lv, li, mv, mi);
#pragma unroll
            for (int j = 0; j < 4; ++j) if (mi == lane * 4 + j) cv[j] = -INFINITY;
            if (lane == r) { mycs = mv; myc = mi; }
        }
        float mx = mycs;
#pragma unroll
        for (int o = 1; o < 16; o <<= 1) mx = fmaxf(mx, __shfl_xor(mx, o));
        const float e = __expf(mycs - mx); float se = e;
#pragma unroll
        for (int o = 1; o < 16; o <<= 1) se += __shfl_xor(se, o);
        if (lane < 16) { const int ex = i1s[myc >> 4] * 128 + i2s[myc & 15];
            IDX[(size_t)it * 16 + lane] = ex; GT[(size_t)it * 16 + lane] = e / se; }
        LDS_WAIT(); asm volatile("" ::: "memory");
    }
}

__device__ __forceinline__ void unpack8(const u32x4 w, float (&f)[8]) { f[0] = bflo(w.x); f[1] = bfhi(w.x); f[2] = bflo(w.y); f[3] = bfhi(w.y); f[4] = bflo(w.z); f[5] = bfhi(w.z); f[6] = bflo(w.w); f[7] = bfhi(w.w); }
__device__ __forceinline__ void p8_gather(Frame& F, const Ins& I, float* out) {
    unsigned char* ws = F.ws;
    const float* X2 = (const float*)(ws + WS_X2); const bf16* EU = (const bf16*)(ws + WS_EU); const bf16* EV = (const bf16*)(ws + WS_EV);
    const int* IDX = (const int*)(ws + WS_IDX); const float* GT = (const float*)(ws + WS_GT);
    const float* ssq2 = (const float*)(ws + WS_PSQ2);
    const int gw = F.vcu * NWAVES + F.wave, NGW = F.G * NWAVES, lane = F.lane;
    for (int t = gw; t < T; t += NGW) {
        float xv[4][8], acc[4][8];
#pragma unroll
        for (int j = 0; j < 4; ++j) { const f32x4 a = *(const f32x4*)(X2 + (size_t)t * 2048 + 512 * j + 8 * lane), b = *(const f32x4*)(X2 + (size_t)t * 2048 + 512 * j + 8 * lane + 4);
            xv[j][0] = a[0]; xv[j][1] = a[1]; xv[j][2] = a[2]; xv[j][3] = a[3]; xv[j][4] = b[0]; xv[j][5] = b[1]; xv[j][6] = b[2]; xv[j][7] = b[3];
#pragma unroll
            for (int e = 0; e < 8; ++e) acc[j][e] = 0.f; }
        const float rstd2 = 1.0f / sqrtf(sum32(ssq2 + (size_t)t * 32) * (1.0f / 2048.0f) + EPS);
        const int id0 = IDX[(size_t)t * 128 + lane], id1 = IDX[(size_t)t * 128 + 64 + lane];
        const float g0 = GT[(size_t)t * 128 + lane], g1 = GT[(size_t)t * 128 + 64 + lane];
        for (int i = 0; i < 128; ++i) {
            const int ex = __builtin_amdgcn_readlane(i < 64 ? id0 : id1, i & 63);
            const float gate = __builtin_bit_cast(float, __builtin_amdgcn_readlane(__builtin_bit_cast(int, i < 64 ? g0 : g1), i & 63));
            const bf16* ur = EU + (size_t)ex * 2048 + 8 * lane; const bf16* vr = EV + (size_t)ex * 2048 + 8 * lane;
            u32x4 uw[4], vw[4];
#pragma unroll
            for (int j = 0; j < 4; ++j) { uw[j] = *(const u32x4*)(ur + 512 * j); vw[j] = *(const u32x4*)(vr + 512 * j); }
            float dot = 0.f;
#pragma unroll
            for (int j = 0; j < 4; ++j) { float f[8]; unpack8(uw[j], f);
#pragma unroll
                for (int e = 0; e < 8; ++e) dot += f[e] * xv[j][e]; }
            const float a = wave_sum(dot) * rstd2;
            const float z2 = 1.5957691216057308f * (a + 0.044715f * a * a * a);
            const float w = gate * a * __builtin_amdgcn_rcpf(1.0f + __builtin_amdgcn_exp2f(-z2 * LOG2E));
#pragma unroll
            for (int j = 0; j < 4; ++j) { float f[8]; unpack8(vw[j], f);
#pragma unroll
                for (int e = 0; e < 8; ++e) acc[j][e] += w * f[e]; }
        }
        float s = 0.f;
#pragma unroll
        for (int j = 0; j < 4; ++j)
#pragma unroll
            for (int e = 0; e < 8; ++e) { acc[j][e] += xv[j][e]; s += acc[j][e] * acc[j][e]; }
        float rs = 1.0f / sqrtf(wave_sum(s) * (1.0f / 2048.0f) + EPS);
#ifdef ATT_CHECK
        if (((const unsigned*)F.ctl)[ATT_CHECK_WORD] > ATT_CHECK_MAX) rs = __builtin_nanf("");
#endif
#pragma unroll
        for (int j = 0; j < 4; ++j) { const f32x4 ga = *(const f32x4*)(I.g_final + 512 * j + 8 * lane), gb = *(const f32x4*)(I.g_final + 512 * j + 8 * lane + 4);
            *(f32x4*)(out + (size_t)t * 2048 + 512 * j + 8 * lane) = (f32x4){acc[j][0] * rs * ga[0], acc[j][1] * rs * ga[1], acc[j][2] * rs * ga[2], acc[j][3] * rs * ga[3]};
            *(f32x4*)(out + (size_t)t * 2048 + 512 * j + 8 * lane + 4) = (f32x4){acc[j][4] * rs * gb[0], acc[j][5] * rs * gb[1], acc[j][6] * rs * gb[2], acc[j][7] * rs * gb[3]}; }
    }
}

namespace rt {
typedef short bf16x8 __attribute__((ext_vector_type(8)));
typedef float f32x16 __attribute__((ext_vector_type(16)));
__device__ __forceinline__ unsigned f2sort(float f) { const unsigned u = __float_as_uint(f); return u ^ ((unsigned)((int)u >> 31) | 0x80000000u); }
__device__ __forceinline__ float sort2f(unsigned s) { return __uint_as_float(s ^ ((s >> 31) ? 0x80000000u : 0xFFFFFFFFu)); }
__device__ __forceinline__ unsigned umax(unsigned a, unsigned b) { return a > b ? a : b; }
__device__ __forceinline__ unsigned pair_max(unsigned m) { auto rr = __builtin_amdgcn_permlane32_swap(m, m, false, false); const unsigned a = rr[0], b = rr[1]; return umax(a, b); }
constexpr int KEYS_BYTES = 65536, LIST_OFF = KEYS_BYTES, LIST_WAVE = 6144 + 512;
}
__device__ __forceinline__ void rt_load_keys(Frame& F, const Ins& I) {
    LAS unsigned char* lds = F.lds + RING_OFF;
    for (int it = F.tid; it < 2 * 128 * 16; it += NWAVES * 64) {
        const int c = it & 15, n = (it >> 4) & 127, hf = it >> 11;
        const float* sp = I.sub_keys + (size_t)hf * 16384 + n * 128 + c * 8;
        const f32x4 a = *(const f32x4*)sp, b = *(const f32x4*)(sp + 4);
        v4u o; o.x = pk2(a.x, a.y); o.y = pk2(a.z, a.w); o.z = pk2(b.x, b.y); o.w = pk2(b.z, b.w);
        *(LAS v4u*)(lds + hf * 32768 + c * 2048 + n * 16) = o;
    }
    __syncthreads();
}
template <bool TO_LDS>
__device__ __forceinline__ void rt_task(Frame& F, int task, LAS unsigned* lst) {
    using namespace rt;
    unsigned char* ws = F.ws;
    const bf16* QP = (const bf16*)(ws + WS_QP);
    int* IDX = (int*)(ws + WS_IDX); float* GT = (float*)(ws + WS_GT);
    LAS unsigned char* lds = F.lds + RING_OFF;
    const int lane = F.lane, r32 = lane & 31, hi = lane >> 5;
        const size_t row = (size_t)task * 32 + r32;
#pragma unroll 1
        for (int hf = 0; hf < 2; ++hf) {
            bf16x8 qf[8];
#pragma unroll
            for (int ks = 0; ks < 8; ++ks) qf[ks] = *(const bf16x8*)(QP + row * 256 + hf * 128 + ks * 16 + hi * 8);
            unsigned k[64];
            const LAS unsigned char* kb0 = lds + hf * 32768 + hi * 2048 + r32 * 16;
#pragma unroll
            for (int kb = 0; kb < 4; ++kb) {
                f32x16 acc = f32x16{};
#pragma unroll
                for (int ks = 0; ks < 8; ++ks) acc = __builtin_amdgcn_mfma_f32_32x32x16_bf16(*(const LAS bf16x8*)(kb0 + ks * 4096 + kb * 512), qf[ks], acc, 0, 0, 0);
#pragma unroll
                for (int r = 0; r < 16; ++r) { const int n = 32 * kb + (r & 3) + 8 * (r >> 2) + 4 * hi; k[16 * kb + r] = (f2sort(acc[r]) & ~0x7Fu) | (unsigned)(127 - n); }
            }
#pragma unroll 1
            for (int rd = 0; rd < 16; ++rd) {
                unsigned m = k[0];
#pragma unroll
                for (int i = 1; i < 64; ++i) m = umax(m, k[i]);
                const unsigned g = pair_max(m);
#pragma unroll
                for (int i = 0; i < 64; ++i) k[i] = (k[i] == g) ? 0u : k[i];
                if (hi == 0) lst[hf * 16 + rd] = g;
            }
        }
        LDS_WAIT(); asm volatile("" ::: "memory");
        float v1[16], v2[16];
#pragma unroll
        for (int q = 0; q < 4; ++q) { const v4u a = *(const LAS v4u*)(lst + 4 * q), b = *(const LAS v4u*)(lst + 16 + 4 * q);
#pragma unroll
            for (int e = 0; e < 4; ++e) { v1[4 * q + e] = sort2f(a[e] & ~0x7Fu); v2[4 * q + e] = sort2f(b[e] & ~0x7Fu); } }
        unsigned cand[50];
        { int ci = 0;
#pragma unroll
          for (int a = 0; a < 16; ++a)
#pragma unroll
              for (int b = 0; b < 16; ++b) if ((a + 1) * (b + 1) <= 16) { cand[ci] = (f2sort(v1[a] + v2[b]) & ~0xFFu) | (unsigned)(255 - (a * 16 + b)); ++ci; } }
#pragma unroll 1
        for (int rd = 0; rd < 16; ++rd) {
            unsigned m = cand[0];
#pragma unroll
            for (int i = 1; i < 50; ++i) m = umax(m, cand[i]);
#pragma unroll
            for (int i = 0; i < 50; ++i) cand[i] = (cand[i] == m) ? 0u : cand[i];
            if (hi == 0) lst[32 + rd] = m;
        }
        LDS_WAIT(); asm volatile("" ::: "memory");
        const float cmax = sort2f(lst[32] & ~0xFFu);
        float ev[8]; int ex[8]; float se = 0.f;
#pragma unroll
        for (int j = 0; j < 8; ++j) { const unsigned key = lst[32 + 8 * hi + j]; const int ab = 255 - (int)(key & 0xFFu);
            const int i1 = 127 - (int)(lst[ab >> 4] & 0x7Fu), i2 = 127 - (int)(lst[16 + (ab & 15)] & 0x7Fu);
            ex[j] = i1 * 128 + i2; ev[j] = __expf(sort2f(key & ~0xFFu) - cmax); se += ev[j]; }
        { auto rr = __builtin_amdgcn_permlane32_swap(__float_as_uint(se), __float_as_uint(se), false, false); const unsigned a = rr[0], b = rr[1]; se = __uint_as_float(a) + __uint_as_float(b); }
        const float inv = 1.0f / se;
        if (TO_LDS) {
#pragma unroll
            for (int j = 0; j < 8; ++j) { lst[8 * hi + j] = (unsigned)ex[j]; lst[16 + 8 * hi + j] = __float_as_uint(ev[j] * inv); }
        } else {
        int* ip = IDX + row * 16 + 8 * hi; float* gp = GT + row * 16 + 8 * hi;
        *(GAS v4u*)ip = (v4u){(unsigned)ex[0], (unsigned)ex[1], (unsigned)ex[2], (unsigned)ex[3]}; *(GAS v4u*)(ip + 4) = (v4u){(unsigned)ex[4], (unsigned)ex[5], (unsigned)ex[6], (unsigned)ex[7]};
        *(GAS f32x4*)gp = (f32x4){ev[0] * inv, ev[1] * inv, ev[2] * inv, ev[3] * inv}; *(GAS f32x4*)(gp + 4) = (f32x4){ev[4] * inv, ev[5] * inv, ev[6] * inv, ev[7] * inv};
        }
        LDS_WAIT(); asm volatile("" ::: "memory");
}
__device__ __forceinline__ void p8_routing(Frame& F, const Ins& I) {
    using namespace rt;
    rt_load_keys(F, I);
    LAS unsigned* lst = (LAS unsigned*)(F.lds + RING_OFF + LIST_OFF + F.wave * LIST_WAVE) + (F.lane & 31) * 48;
    const int gw = F.vcu * NWAVES + F.wave, NGW = F.G * NWAVES;
    for (int task = gw; task < T * 8 / 32; task += NGW) rt_task<false>(F, task, lst);
}
constexpr float EU_SCALE = 64.0f, EV_SCALE = 4.0f;
typedef float f32x2v __attribute__((ext_vector_type(2)));
__device__ __forceinline__ unsigned pk4_fp8(float a, float b, float c, float d) { int t = __builtin_amdgcn_cvt_pk_fp8_f32(a, b, 0, false); t = __builtin_amdgcn_cvt_pk_fp8_f32(c, d, t, true); return (unsigned)t; }
__device__ __forceinline__ void convert_experts_fp8(Frame& F, const Ins& I) {
    const size_t gt = (size_t)(F.vcu * NWAVES * 64) + F.tid, NT = (size_t)F.G * NWAVES * 64;
    const size_t nchunk = (size_t)NEXP * D_MODEL / 16;
    unsigned char* EU = F.ws + WS_EU; unsigned char* EV = F.ws + WS_EV;
    for (size_t c = gt; c < nchunk; c += NT) {
        const int d = (int)((c * 16) & (D_MODEL - 1));
        v4u o, p;
#pragma unroll
        for (int k = 0; k < 4; ++k) {
            const f32x4 a = *(const GAS f32x4*)(I.expert_u + c * 16 + 4 * k), g = *(const f32x4*)(I.g_norm2 + d + 4 * k), b = *(const GAS f32x4*)(I.expert_v + c * 16 + 4 * k);
            o[k] = pk4_fp8(a.x * g.x * EU_SCALE, a.y * g.y * EU_SCALE, a.z * g.z * EU_SCALE, a.w * g.w * EU_SCALE);
            p[k] = pk4_fp8(b.x * EV_SCALE, b.y * EV_SCALE, b.z * EV_SCALE, b.w * EV_SCALE);
        }
        *(GAS v4u*)(EU + c * 16) = o; *(GAS v4u*)(EV + c * 16) = p;
    }
}
#ifndef PEER_FP8
#define PEER_FP6 1
#endif
#ifdef PEER_FP6
typedef float v32f_t __attribute__((ext_vector_type(32)));
typedef float v16f_t __attribute__((ext_vector_type(16)));
typedef unsigned v6u_t __attribute__((ext_vector_type(6)));
constexpr int EROW = 1536;
__device__ __forceinline__ void convert_experts_fp6(Frame& F, const Ins& I) {
    const size_t gt = (size_t)(F.vcu * NWAVES * 64) + F.tid, NT = (size_t)F.G * NWAVES * 64;
    const size_t nblk = (size_t)NEXP * 64;
    unsigned char* EU = F.ws + WS_EU; unsigned char* EV = F.ws + WS_EV;
    LAS int* ptab = (LAS int*)(F.lds + RING_OFF + 65536);
#pragma unroll 1
    for (int j = 0; j < 32; ++j) {
        v16f_t a, b;
#pragma unroll
        for (int i = 0; i < 16; ++i) { a[i] = (i == j) ? 1.0f : 0.0f; b[i] = (i + 16 == j) ? 1.0f : 0.0f; }
        const v32f_t r = __builtin_amdgcn_cvt_scalef32_pk32_f32_fp6(__builtin_amdgcn_cvt_scalef32_2xpk16_fp6_f32(a, b, 1.0f), 1.0f);
        int pos = 0;
#pragma unroll
        for (int i = 0; i < 32; ++i) pos = (r[i] != 0.0f) ? i : pos;
        ptab[j] = pos;
    }
    LDS_WAIT(); asm volatile("" ::: "memory");
    bool inter = true;
#pragma unroll 1
    for (int j = 0; j < 32; ++j) inter = inter && (ptab[j] == ((j < 16) ? 2 * j : 2 * (j - 16) + 1));
    if (inter) {
        const int gw = F.vcu * NWAVES + F.wave, NGW = F.G * NWAVES, lane = F.lane;
        LAS unsigned char* img = F.lds + RING_OFF + F.wave * 9216;
        f32x4 gsc[8];
#pragma unroll
        for (int k = 0; k < 8; ++k) gsc[k] = *(const f32x4*)(I.g_norm2 + (64 * k + lane) * 4) * EU_SCALE;
        for (int e = gw; e < NEXP; e += NGW) {
            f32x4 ru[8], rv[8];
#pragma unroll
            for (int k = 0; k < 8; ++k) { ru[k] = *(const GAS f32x4*)(I.expert_u + (size_t)e * 2048 + (64 * k + lane) * 4); rv[k] = *(const GAS f32x4*)(I.expert_v + (size_t)e * 2048 + (64 * k + lane) * 4); }
#pragma unroll
            for (int tb = 0; tb < 2; ++tb) {
#pragma unroll
                for (int k = 0; k < 8; ++k) { const int i4 = 64 * k + lane;
                    *(LAS f32x4*)(img + (i4 >> 3) * 144 + (i4 & 7) * 16) = tb == 0 ? ru[k] * gsc[k] : rv[k] * EV_SCALE; }
                LDS_WAIT(); asm volatile("" ::: "memory");
                v16f_t ya, yb;
#pragma unroll
                for (int j = 0; j < 8; ++j) { const f32x4 x4 = *(const LAS f32x4*)(img + lane * 144 + 16 * j); ya[2 * j] = x4[0]; yb[2 * j] = x4[1]; ya[2 * j + 1] = x4[2]; yb[2 * j + 1] = x4[3]; }
                LDS_WAIT(); asm volatile("" ::: "memory");
                const v6u_t pk = __builtin_amdgcn_cvt_scalef32_2xpk16_fp6_f32(ya, yb, 1.0f);
                unsigned char* dst = (tb == 0 ? EU : EV) + (size_t)e * EROW;
                *(GAS v4u*)(dst + 16 * lane) = (v4u){pk[0], pk[1], pk[2], pk[3]}; *(GAS u32x2*)(dst + 1024 + 8 * lane) = (u32x2){pk[4], pk[5]};
            }
        }
    } else {
    LAS float* scr = (LAS float*)(F.lds + RING_OFF) + F.tid;
    for (size_t c = gt; c < nblk; c += NT) {
        const size_t e = c >> 6; const int l = (int)(c & 63), d = 32 * l;
        v16f_t ya, yb;
#pragma unroll
        for (int k = 0; k < 8; ++k) { const f32x4 a0 = *(const GAS f32x4*)(I.expert_u + c * 32 + 4 * k), g0 = *(const f32x4*)(I.g_norm2 + d + 4 * k);
#pragma unroll
            for (int j = 0; j < 4; ++j) scr[(4 * k + j) * 512] = a0[j] * g0[j] * EU_SCALE; }
#pragma unroll
        for (int j = 0; j < 16; ++j) { ya[j] = scr[ptab[j] * 512]; yb[j] = scr[ptab[16 + j] * 512]; }
        const v6u_t pu = __builtin_amdgcn_cvt_scalef32_2xpk16_fp6_f32(ya, yb, 1.0f);
        *(GAS v4u*)(EU + e * EROW + 16 * l) = (v4u){pu[0], pu[1], pu[2], pu[3]}; *(GAS u32x2*)(EU + e * EROW + 1024 + 8 * l) = (u32x2){pu[4], pu[5]};
#pragma unroll
        for (int k = 0; k < 8; ++k) { const f32x4 b0 = *(const GAS f32x4*)(I.expert_v + c * 32 + 4 * k);
#pragma unroll
            for (int j = 0; j < 4; ++j) scr[(4 * k + j) * 512] = b0[j] * EV_SCALE; }
#pragma unroll
        for (int j = 0; j < 16; ++j) { ya[j] = scr[ptab[j] * 512]; yb[j] = scr[ptab[16 + j] * 512]; }
        const v6u_t pv = __builtin_amdgcn_cvt_scalef32_2xpk16_fp6_f32(ya, yb, 1.0f);
        *(GAS v4u*)(EV + e * EROW + 16 * l) = (v4u){pv[0], pv[1], pv[2], pv[3]}; *(GAS u32x2*)(EV + e * EROW + 1024 + 8 * l) = (u32x2){pv[4], pv[5]};
    }
    }
    __syncthreads();
}
struct G9Row { u32x4 a; u32x2 b; };
#define G9_SETS G9Row A[4], B[4]
#define G9_XOFF(c) (32 * lane + 16 * (c))
#define G9_LOAD(SET, TAB, IDL, g) do { _Pragma("unroll") for (int k = 0; k < 4; ++k) { const int ex = __builtin_amdgcn_readlane(IDL, 4 * (4 * (g) + k)); \
        const unsigned char* rp = (TAB) + (size_t)ex * EROW; SET[k].a = *(const u32x4*)(rp + 16 * lane); SET[k].b = *(const u32x2*)(rp + 1024 + 8 * lane); } } while (0)
#define G9_CVT(SET, k) __builtin_amdgcn_cvt_scalef32_pk32_f32_fp6((v6u_t){SET[k].a.x, SET[k].a.y, SET[k].a.z, SET[k].a.w, SET[k].b.x, SET[k].b.y}, 1.0f)
#define G9_DOTS(SET, g) do { _Pragma("unroll") for (int k = 0; k < 4; ++k) { const v32f_t r = G9_CVT(SET, k); float s0 = 0.f, s1 = 0.f; \
        _Pragma("unroll") for (int e = 0; e < 16; ++e) { s0 += r[e] * xv[0][e]; s1 += r[16 + e] * xv[1][e]; } float s = s0 + s1; asm volatile("" : "+v"(s)); dots[4 * (g) + k] = s; } } while (0)
#define G9_FMAS(SET, g) do { _Pragma("unroll") for (int k = 0; k < 4; ++k) { const float wk = wq[g][k]; const v32f_t r = G9_CVT(SET, k); \
        _Pragma("unroll") for (int e = 0; e < 16; ++e) { acc[0][e] += wk * r[e]; acc[1][e] += wk * r[16 + e]; } } } while (0)
#else
constexpr int EROW = 2048;
#define G9_SETS u32x4 A[4][2], B[4][2]
#define G9_XOFF(c) (1024 * (c) + 16 * lane)
#define G9_LOAD(SET, TAB, IDL, g) do { _Pragma("unroll") for (int k = 0; k < 4; ++k) { const int ex = __builtin_amdgcn_readlane(IDL, 4 * (4 * (g) + k)); \
        const unsigned char* rp = (TAB) + (size_t)ex * 2048 + 16 * lane; SET[k][0] = *(const u32x4*)rp; SET[k][1] = *(const u32x4*)(rp + 1024); } } while (0)
#define G9_DOTS(SET, g) do { _Pragma("unroll") for (int k = 0; k < 4; ++k) { float s = 0.f; _Pragma("unroll") for (int c = 0; c < 2; ++c) _Pragma("unroll") for (int dw = 0; dw < 4; ++dw) { \
        const f32x2v lo = __builtin_amdgcn_cvt_pk_f32_fp8((int)SET[k][c][dw], false), hi2 = __builtin_amdgcn_cvt_pk_f32_fp8((int)SET[k][c][dw], true); \
        s += lo.x * xv[c][4 * dw] + lo.y * xv[c][4 * dw + 1] + hi2.x * xv[c][4 * dw + 2] + hi2.y * xv[c][4 * dw + 3]; } asm volatile("" : "+v"(s)); dots[4 * (g) + k] = s; } } while (0)
#define G9_FMAS(SET, g) do { _Pragma("unroll") for (int k = 0; k < 4; ++k) { const float wk = wq[g][k]; \
        _Pragma("unroll") for (int c = 0; c < 2; ++c) _Pragma("unroll") for (int dw = 0; dw < 4; ++dw) { \
        const f32x2v lo = __builtin_amdgcn_cvt_pk_f32_fp8((int)SET[k][c][dw], false), hi2 = __builtin_amdgcn_cvt_pk_f32_fp8((int)SET[k][c][dw], true); \
        acc[c][4 * dw] += wk * lo.x; acc[c][4 * dw + 1] += wk * lo.y; acc[c][4 * dw + 2] += wk * hi2.x; acc[c][4 * dw + 3] += wk * hi2.y; } } } while (0)
#endif
#define G9_PIN() do { _Pragma("unroll") for (int c = 0; c < 2; ++c) asm volatile("" : "+v"(acc[c][0]), "+v"(acc[c][1]), "+v"(acc[c][2]), "+v"(acc[c][3]), "+v"(acc[c][4]), "+v"(acc[c][5]), "+v"(acc[c][6]), "+v"(acc[c][7]), \
        "+v"(acc[c][8]), "+v"(acc[c][9]), "+v"(acc[c][10]), "+v"(acc[c][11]), "+v"(acc[c][12]), "+v"(acc[c][13]), "+v"(acc[c][14]), "+v"(acc[c][15])); } while (0)
template <class IdF, class GtF>
__device__ __forceinline__ void g9_token(Frame& F, const Ins& I, float* out, int t, LAS float* wl, IdF idf, GtF gtf) {
    unsigned char* ws = F.ws;
    const bf16* X2B = (const bf16*)(ws + WS_X2B); const unsigned char* EU = ws + WS_EU; const unsigned char* EV = ws + WS_EV;
    const float* ssq2 = (const float*)(ws + WS_PSQ2);
    const int lane = F.lane, sl = (lane >> 2) & 15;
    const bool bit3 = (lane & 8) != 0, bit2 = (lane & 4) != 0;
    {
        G9_SETS;
        {
            float xv[2][16];
#pragma unroll
            for (int c = 0; c < 2; ++c)
#pragma unroll
                for (int q = 0; q < 2; ++q) { const u32x4 a = *(const u32x4*)(X2B + (size_t)t * 2048 + G9_XOFF(c) + 8 * q);
                    xv[c][8 * q] = bflo(a.x); xv[c][8 * q + 1] = bfhi(a.x); xv[c][8 * q + 2] = bflo(a.y); xv[c][8 * q + 3] = bfhi(a.y); xv[c][8 * q + 4] = bflo(a.z); xv[c][8 * q + 5] = bfhi(a.z); xv[c][8 * q + 6] = bflo(a.w); xv[c][8 * q + 7] = bfhi(a.w); }
            const float rstd2 = (1.0f / EU_SCALE) / sqrtf(sum32(ssq2 + (size_t)t * 32) * (1.0f / 2048.0f) + EPS);
            int idl_cur = idf(0);
            G9_LOAD(A, EU, idl_cur, 0); __builtin_amdgcn_sched_barrier(0);
#pragma unroll 1
            for (int hd = 0; hd < 8; ++hd) {
                const int idl_nxt = idf(hd < 7 ? hd + 1 : 0); const float gtl = gtf(hd);
                float dots[16];
                G9_LOAD(B, EU, idl_cur, 1); __builtin_amdgcn_sched_barrier(0);
                G9_DOTS(A, 0); __builtin_amdgcn_sched_barrier(0);
                G9_LOAD(A, EU, idl_cur, 2); __builtin_amdgcn_sched_barrier(0);
                G9_DOTS(B, 1); __builtin_amdgcn_sched_barrier(0);
                G9_LOAD(B, EU, idl_cur, 3); __builtin_amdgcn_sched_barrier(0);
                G9_DOTS(A, 2); __builtin_amdgcn_sched_barrier(0);
                if (hd < 7) { G9_LOAD(A, EU, idl_nxt, 0); } else { G9_LOAD(A, EV, idl_nxt, 0); }
                __builtin_amdgcn_sched_barrier(0);
                G9_DOTS(B, 3); __builtin_amdgcn_sched_barrier(0);
                float d8[8], d4[4], d2[2], d1;
#pragma unroll
                for (int i = 0; i < 8; ++i) { auto rr = __builtin_amdgcn_permlane32_swap(__float_as_uint(dots[i]), __float_as_uint(dots[8 + i]), false, false); const unsigned r0 = rr[0], r1 = rr[1]; d8[i] = __uint_as_float(r0) + __uint_as_float(r1); }
#pragma unroll
                for (int i = 0; i < 4; ++i) { auto rr = __builtin_amdgcn_permlane16_swap(__float_as_uint(d8[i]), __float_as_uint(d8[4 + i]), false, false); const unsigned r0 = rr[0], r1 = rr[1]; d4[i] = __uint_as_float(r0) + __uint_as_float(r1); }
#pragma unroll
                for (int i = 0; i < 2; ++i) { const float keep = bit3 ? d4[2 + i] : d4[i], send = bit3 ? d4[i] : d4[2 + i]; d2[i] = keep + __shfl_xor(send, 8); }
                { const float keep = bit2 ? d2[1] : d2[0], send = bit2 ? d2[0] : d2[1]; d1 = keep + __shfl_xor(send, 4); }
                d1 += __shfl_xor(d1, 2); d1 += __shfl_xor(d1, 1);
                const float a = d1 * rstd2;
                const float z2 = 1.5957691216057308f * (a + 0.044715f * a * a * a);
                const float w = gtl * (1.0f / EV_SCALE) * a * __builtin_amdgcn_rcpf(1.0f + __builtin_amdgcn_exp2f(-z2 * LOG2E));
                if ((lane & 3) == 0) wl[hd * 16 + sl] = w;
                idl_cur = idl_nxt;
            }
        }
        LDS_WAIT(); asm volatile("" ::: "memory");
        float acc[2][16];
#pragma unroll
        for (int c = 0; c < 2; ++c)
#pragma unroll
            for (int e = 0; e < 16; ++e) acc[c][e] = 0.f;
        {
            int idl_cur = idf(0);
#pragma unroll 1
            for (int hd = 0; hd < 8; ++hd) {
                const int idl_nxt = idf(hd < 7 ? hd + 1 : 0);
                f32x4 wq[4];
#pragma unroll
                for (int g = 0; g < 4; ++g) wq[g] = *(const LAS f32x4*)(wl + hd * 16 + 4 * g);
                G9_LOAD(B, EV, idl_cur, 1); __builtin_amdgcn_sched_barrier(0);
                G9_FMAS(A, 0); G9_PIN(); __builtin_amdgcn_sched_barrier(0);
                G9_LOAD(A, EV, idl_cur, 2); __builtin_amdgcn_sched_barrier(0);
                G9_FMAS(B, 1); G9_PIN(); __builtin_amdgcn_sched_barrier(0);
                G9_LOAD(B, EV, idl_cur, 3); __builtin_amdgcn_sched_barrier(0);
                G9_FMAS(A, 2); G9_PIN(); __builtin_amdgcn_sched_barrier(0);
                if (hd < 7) { G9_LOAD(A, EV, idl_nxt, 0); } __builtin_amdgcn_sched_barrier(0);
                G9_FMAS(B, 3); G9_PIN(); __builtin_amdgcn_sched_barrier(0);
                idl_cur = idl_nxt;
            }
        }
        LDS_WAIT(); asm volatile("" ::: "memory");
        float s = 0.f;
#pragma unroll
        for (int c = 0; c < 2; ++c)
#pragma unroll
            for (int q = 0; q < 2; ++q) { const u32x4 a = *(const u32x4*)(X2B + (size_t)t * 2048 + G9_XOFF(c) + 8 * q);
                const float xr[8] = {bflo(a.x), bfhi(a.x), bflo(a.y), bfhi(a.y), bflo(a.z), bfhi(a.z), bflo(a.w), bfhi(a.w)};
#pragma unroll
                for (int e = 0; e < 8; ++e) { acc[c][8 * q + e] += xr[e]; s += acc[c][8 * q + e] * acc[c][8 * q + e]; } }
        float rs = 1.0f / sqrtf(wave_sum(s) * (1.0f / 2048.0f) + EPS);
#ifdef ATT_CHECK
        if (((const unsigned*)F.ctl)[16] + ((const unsigned*)F.ctl)[17] > 0u) rs = __builtin_nanf("");
#endif
#pragma unroll
        for (int c = 0; c < 2; ++c)
#pragma unroll
            for (int q = 0; q < 4; ++q) { const f32x4 g = *(const f32x4*)(I.g_final + G9_XOFF(c) + 4 * q);
                *(f32x4*)(out + (size_t)t * 2048 + G9_XOFF(c) + 4 * q) = (f32x4){acc[c][4 * q] * rs * g[0], acc[c][4 * q + 1] * rs * g[1], acc[c][4 * q + 2] * rs * g[2], acc[c][4 * q + 3] * rs * g[3]}; }
    }
}
#undef G9_LOAD
#undef G9_DOTS
#undef G9_FMAS
#undef G9_PIN
#undef G9_SETS
#undef G9_XOFF
__device__ __forceinline__ void p9_gather_fp8(Frame& F, const Ins& I, float* out) {
    const int* IDX = (const int*)(F.ws + WS_IDX); const float* GT = (const float*)(F.ws + WS_GT);
    const int lane = F.lane, sl = (lane >> 2) & 15;
    LAS float* wl = (LAS float*)(F.lds + RING_OFF + F.wave * 4096);
    unsigned* tokctr = (unsigned*)F.ctl + CW_TOKCTR;
    for (;;) {
        int t = 0; if (lane == 0) t = (int)__hip_atomic_fetch_add(tokctr, 1u, __ATOMIC_RELAXED, __HIP_MEMORY_SCOPE_AGENT);
        t = __builtin_amdgcn_readfirstlane(t);
        if (t >= T) break;
        const int* idx_t = IDX + (size_t)t * 128 + sl; const float* gt_t = GT + (size_t)t * 128 + sl;
        g9_token(F, I, out, t, wl, [=](int hd) { return idx_t[hd * 16]; }, [=](int hd) { return gt_t[hd * 16]; });
    }
}

__device__ __forceinline__ void p89_route_gather(Frame& F, const Ins& I, float* out) {
    using namespace rt;
    rt_load_keys(F, I);
    LAS unsigned* lstw = (LAS unsigned*)(F.lds + RING_OFF + LIST_OFF + F.wave * LIST_WAVE);
    LAS unsigned* lst = lstw + (F.lane & 31) * 48;
    LAS float* wl = (LAS float*)(lstw + 32 * 48);
    const int gw = F.vcu * NWAVES + F.wave, NGW = F.G * NWAVES, sl = (F.lane >> 2) & 15;
    for (int task = gw; task < T * 8 / 32; task += NGW) {
        rt_task<true>(F, task, lst);
        LDS_WAIT(); asm volatile("" ::: "memory");
#pragma unroll 1
        for (int tt = 0; tt < 4; ++tt) {
            LAS unsigned* lt = lstw + (tt * 8) * 48 + sl;
            g9_token(F, I, out, 4 * task + tt, wl, [=](int hd) { return (int)lt[hd * 48]; }, [=](int hd) { return __uint_as_float(lt[hd * 48 + 16]); });
        }
        LDS_WAIT(); asm volatile("" ::: "memory");
    }
}

constexpr int NPHASE = 10;
struct Args { Ins in; float* out; unsigned char* ws; double inv_freq[32]; int ph_lo, ph_hi; };
__global__ void __launch_bounds__(NWAVES * 64, 2) mega_fwd(Args args) {
    extern __shared__ __attribute__((aligned(16))) unsigned char lds[];
    Frame F;
    F.lds = (LAS unsigned char*)lds;
    F.MISC = (volatile LAS unsigned*)(F.lds + MISC_OFF);
    F.tid = threadIdx.x; F.lane = F.tid & 63; F.wave = __builtin_amdgcn_readfirstlane(F.tid >> 6);
    F.G = gridDim.x; { const int bx = blockIdx.x; F.vcu = (F.G % 8 == 0) ? (bx % 8) * (F.G / 8) + bx / 8 : bx; }
    unsigned char* ws = args.ws; F.ws = ws;
    F.ctl = (gu32*)(ws + WS_CTL);
    const Ins& I = args.in;
    for (int u = F.tid; u < (LDS_BYTES - LDSCTL_OFF) / 4; u += NWAVES * 64) ((LAS unsigned*)(F.lds + LDSCTL_OFF))[u] = 0u;
    __syncthreads();
    XcdBarrier bar; bar.bar = (unsigned*)(F.ctl + CW_BAR); bar.x = 0; bar.st = nullptr;
#if MK_N_LAUNCHES == 1
    bar = xcd_barrier_post((unsigned*)(F.ctl + CW_BAR), F.MISC + 8);
#define GRID_BAR() xcd_barrier(bar)
#else
#define GRID_BAR() do {} while (0)
#endif
    const int lo = args.ph_lo, hi = args.ph_hi;
#ifdef PROBE_PH
    unsigned long long pstamp[NPHASE + 1];
#define PSTAMP(k) do { if (blockIdx.x == 0 && F.tid == 0) pstamp[k] = __builtin_amdgcn_s_memrealtime(); } while (0)
#else
#define PSTAMP(k) do {} while (0)
#endif
#ifndef PH_MASK
#define PH_MASK 0xFFFF
#endif
#define IN(k) (((PH_MASK >> (k)) & 1) && lo <= (k) && (k) < hi)
#define BOTH(k) (IN(k) && IN((k) + 1))
    float* ssq_q = (float*)(ws + WS_PSQ_Q); float* ssq_kv = (float*)(ws + WS_PSQ_KV); float* ssq2 = (float*)(ws + WS_PSQ2);
    const float* rope = (const float*)(ws + WS_ROPE);

    PSTAMP(0);
    if (IN(0)) { p0_prologue(F, I, args.inv_freq); if (BOTH(0)) GRID_BAR(); }

    PSTAMP(1);
    if (IN(1)) {
        pg8::Gemm g{(const bf16_t*)(ws + WS_H), (const bf16_t*)(ws + WS_W1), T, N1, 2048, 2048}; pg8::StaticOrder S; S.init(T, N1, F.G, (int)blockIdx.x);
        EpiProj E{(bf16_t*)(ws + WS_CQ), (bf16_t*)(ws + WS_CKV), (bf16_t*)(ws + WS_DQ), (bf16_t*)(ws + WS_DK), (bf16_t*)(ws + WS_DV), (bf16_t*)(ws + WS_G), (bf16_t*)(ws + WS_KR), ssq_q, ssq_kv, I.b_gate, rope};
        pg8::gemm_phase<EpiProj, pg8::StaticOrder, PG8_ALIGN, PG8_SP2>(F.lds + RING_OFF, g, S, E);
        if (BOTH(1)) GRID_BAR();
    }
    PSTAMP(2);
    if (IN(2)) {
        { pg8::Gemm g{(const bf16_t*)(ws + WS_CQ), (const bf16_t*)(ws + WS_WUQ), T, 1536, 768, 768}; pg8::StaticOrder S; S.init(T, 1536, F.G, (int)blockIdx.x);
          EpiQup E{(bf16_t*)(ws + WS_QN), (bf16_t*)(ws + WS_QR), ssq_q, rope};
          pg8::gemm_phase<EpiQup, pg8::StaticOrder, PG8_ALIGN, PG8_SP2>(F.lds + RING_OFF, g, S, E); }
        { pg8::Gemm g{(const bf16_t*)(ws + WS_CKV), (const bf16_t*)(ws + WS_WUKV), T, 2048, 512, 512}; pg8::StaticOrder S; S.init(T, 2048, F.G, (int)blockIdx.x);
          EpiKVup E{(bf16_t*)(ws + WS_KN), (bf16_t*)(ws + WS_V), ssq_kv};
          pg8::gemm_phase<EpiKVup, pg8::StaticOrder, PG8_ALIGN, PG8_SP2>(F.lds + RING_OFF, g, S, E); }
        if (BOTH(2)) GRID_BAR();
    }
    PSTAMP(3);
#ifdef ATT_REF
    if (IN(3)) { p3_attention_ref(F, I); if (BOTH(3)) GRID_BAR(); }
#else
    if (IN(3)) { p3_attention(F, I); if (BOTH(3)) GRID_BAR(); }
#ifdef ATT_CHECK
    if (IN(3)) { p3_attention_ref(F, I); GRID_BAR(); }
#endif
#endif
    PSTAMP(4);
    if (IN(4)) {
        pg8::Gemm2 g{(const bf16_t*)(ws + WS_OM), (const bf16_t*)(ws + WS_OD), (const bf16_t*)(ws + WS_WOM), (const bf16_t*)(ws + WS_WOD), T, 2048, 1024, 1024};
        pg8::StaticOrder S; S.init(T, 2048, F.G, (int)blockIdx.x);
        EpiGate2 E{(const bf16_t*)(ws + WS_G), (bf16_t*)(ws + WS_MG)};
        pg8::gemm_phase2<EpiGate2, pg8::StaticOrder, PG8_ALIGN, PG8_SP2>(F.lds + RING_OFF, g, S, E);
        if (BOTH(4)) GRID_BAR();
    }
    PSTAMP(5);
    PSTAMP(6);
    if (IN(6)) {
#ifdef PEER_BF16
        convert_experts(F, I);
#else
#ifdef PEER_FP6
        convert_experts_fp6(F, I);
#else
        convert_experts_fp8(F, I);
#endif
#endif
        pg8::Gemm g{(const bf16_t*)(ws + WS_MG), (const bf16_t*)(ws + WS_WOUT), T, 2048, 2048, 2048}; pg8::StaticOrder S; S.init(T, 2048, F.G, (int)blockIdx.x);
        EpiRes E{I.x, (float*)(ws + WS_X2), (bf16_t*)(ws + WS_X2B), ssq2};
        pg8::gemm_phase<EpiRes, pg8::StaticOrder, PG8_ALIGN, PG8_SP2>(F.lds + RING_OFF, g, S, E);
        if (BOTH(6)) GRID_BAR();
    }
    PSTAMP(7);
    if (IN(7)) {
        pg8::Gemm g{(const bf16_t*)(ws + WS_X2B), (const bf16_t*)(ws + WS_WQP), T, 2048, 2048, 2048}; pg8::StaticOrder S; S.init(T, 2048, F.G, (int)blockIdx.x);
        EpiQP E{(bf16_t*)(ws + WS_QP), ssq2};
        pg8::gemm_phase<EpiQP, pg8::StaticOrder, PG8_ALIGN, PG8_SP2>(F.lds + RING_OFF, g, S, E);
        if (BOTH(7)) GRID_BAR();
    }
    PSTAMP(8);
#if defined(ROUTE_REF) || defined(PEER_BF16) || defined(NO_FUSE89)
#ifdef ROUTE_REF
    if (IN(8)) { p7_routing_ref(F); if (BOTH(8)) GRID_BAR(); }
#else
    if (IN(8)) { p8_routing(F, I); if (BOTH(8)) GRID_BAR(); }
#endif
    PSTAMP(9);
#ifdef PEER_BF16
    if (IN(9)) { p8_gather(F, I, args.out); }
#else
    if (IN(9)) { p9_gather_fp8(F, I, args.out); }
#endif
#else
    if (IN(8) && IN(9)) { p89_route_gather(F, I, args.out); }
    PSTAMP(9);
#endif
    PSTAMP(10);
#ifdef PROBE_PH
    if (blockIdx.x == 0 && F.tid == 0) {
        const unsigned long long span = (pstamp[PROBE_PH + 1] - pstamp[PROBE_PH]) * PROBE_MUL, t0 = __builtin_amdgcn_s_memrealtime();
        while (__builtin_amdgcn_s_memrealtime() - t0 < span) __builtin_amdgcn_s_sleep(32);
    }
#endif
#undef IN
#undef BOTH
}

extern "C" void kernel_launch(void* const* d_in, const int* in_sizes, int n_in, void* d_out, int out_size, void* d_ws, size_t ws_size, hipStream_t stream) {
    static int grid = 0;
    if (grid == 0) {
        if (n_in != 19 || out_size != T * D_MODEL || ws_size < WS_END) { fprintf(stderr, "kernel_launch: unexpected shapes: n_in %d out %d ws %zu\n", n_in, out_size, ws_size); grid = -1; return; }
        int dev = 0, cus = 0, per_cu = 0;
        if (hipGetDevice(&dev) != hipSuccess || hipDeviceGetAttribute(&cus, hipDeviceAttributeMultiprocessorCount, dev) != hipSuccess) { grid = -1; return; }
        if (hipFuncSetAttribute((const void*)mega_fwd, hipFuncAttributeMaxDynamicSharedMemorySize, LDS_BYTES) != hipSuccess) { fprintf(stderr, "kernel_launch: hipFuncSetAttribute failed\n"); grid = -1; return; }
        if (hipOccupancyMaxActiveBlocksPerMultiprocessor(&per_cu, (const void*)mega_fwd, NWAVES * 64, LDS_BYTES) != hipSuccess || per_cu < 1)
            fprintf(stderr, "kernel_launch: occupancy query reports %d workgroups per CU\n", per_cu);
        (void)hipGetLastError();
        grid = cus;
    }
    if (grid < 0) return;
    if (hipMemsetAsync((char*)d_ws + WS_CTL, 0, CTL_ZERO_BYTES, stream) != hipSuccess) { fprintf(stderr, "kernel_launch: memset failed\n"); return; }
    Args a{};
    const float** ip = (const float**)&a.in;
    for (int i = 0; i < 19; ++i) ip[i] = (const float*)d_in[i];
    a.out = (float*)d_out; a.ws = (unsigned char*)d_ws;
    for (int i = 0; i < 32; ++i) a.inv_freq[i] = pow(10000.0, -(double)i / 32.0);
#if MK_N_LAUNCHES == 1
    a.ph_lo = 0; a.ph_hi = NPHASE;
    hipLaunchKernelGGL(mega_fwd, dim3(grid), dim3(NWAVES * 64), LDS_BYTES, stream, a);
#else
    for (int p = 0; p < NPHASE; ++p) { a.ph_lo = p; a.ph_hi = p + 1; hipLaunchKernelGGL(mega_fwd, dim3(grid), dim3(NWAVES * 64), LDS_BYTES, stream, a); }
#endif
    const hipError_t le = hipPeekAtLastError();
    if (le != hipSuccess) fprintf(stderr, "kernel_launch: launch failed: %s\n", hipGetErrorName(le));
}
```

```cpp
#include <hip/hip_runtime.h>
#include <cstdio>
#include <cstdint>
#include <cmath>

#ifndef MK_N_LAUNCHES
#define MK_N_LAUNCHES 1
#endif

constexpr int D_MODEL = 2048, BATCH = 2, SEQ = 8192, T = BATCH * SEQ;
constexpr int OFF_CQ = 0, OFF_CKV = 768, OFF_KR = 1280, OFF_DQ = 1344, OFF_DK = 2368, OFF_DV = 3392, OFF_GATE = 4416, IN_COLS = 8512;
constexpr int N1 = 8704;
constexpr int NEXP = 16384;
constexpr float EPS = 1e-6f;
constexpr float LOG2E = 1.4426950408889634f;
constexpr float C2_MLA = 0.07216878364870322f * LOG2E;
constexpr float C2_DIFF = 0.125f * LOG2E;
constexpr float LAMBDA_INIT = 0.2f;

namespace pg8 {
#define PG8_LAS __attribute__((address_space(3)))
typedef unsigned short bf16_t;
typedef short bf16x8 __attribute__((ext_vector_type(8)));
typedef float f32x4 __attribute__((ext_vector_type(4)));
typedef unsigned u32x4 __attribute__((ext_vector_type(4)));
typedef unsigned u32x2 __attribute__((ext_vector_type(2)));
constexpr int BM = 256, BK = 64, HALF = 128, HTB = HALF * BK * 2, STAGE_BYTES = 8 * HTB, NXCD = 8, WGM = 8;

__host__ __device__ __forceinline__ int lds_byte(int r, int c) { const int st = (r >> 4) * 2 + (c >> 5), rr = r & 15, cc = c & 31, ob = rr * 64 + cc * 2; return st * 1024 + (ob ^ (((ob >> 9) & 1) << 5)); }
__host__ __device__ __forceinline__ void stage_rc(int b, int& R, int& C) { const int st = b / 1024, sb = b % 1024, swz = sb ^ (((sb >> 9) & 1) << 5); R = (st >> 1) * 16 + swz / 64; C = (st & 1) * 32 + (swz % 64) / 2; }
__host__ __device__ __forceinline__ int perm32(int rho) { const int n = rho >> 4, i = rho & 15; return 8 * (i >> 2) + 4 * n + (i & 3); }

struct Unit { int pm, pn; };
struct Gemm { const bf16_t* A; const bf16_t* Bt; int M, N, K, lda; };

struct StaticOrder {
    int nM, nN, nwg, G, c;
    __host__ __device__ void init(int M, int N, int G_, int c_) { nM = M / BM; nN = N / BM; nwg = nM * nN; G = G_; c = c_; }
    __host__ __device__ bool next(int i, Unit& u) const {
        const long L = (long)i * G + c; if (L >= nwg) return false;
        int wgid = (int)L; { const int q = nwg / NXCD, r = nwg % NXCD, xcd = wgid % NXCD, off = wgid / NXCD; wgid = (xcd < r ? xcd * (q + 1) : r * (q + 1) + (xcd - r) * q) + off; }
        const int nig = WGM * nN, gid = wgid / nig, fm = gid * WGM, gsz = (nM - fm) < WGM ? (nM - fm) : WGM;
        u.pm = fm + ((wgid % nig) % gsz); u.pn = (wgid % nig) / gsz; return true;
    }
    __device__ __forceinline__ void a_ready(const Unit&) const {}
    __device__ __forceinline__ void done(const Unit&) const {}
};

typedef float f32x2_t __attribute__((ext_vector_type(2))); typedef __bf16 bf16x2_t __attribute__((ext_vector_type(2)));
__device__ __forceinline__ unsigned cvtpk(float lo, float hi) { f32x2_t v = {lo, hi}; bf16x2_t b = __builtin_convertvector(v, bf16x2_t); return __builtin_bit_cast(unsigned, b); }
__device__ __forceinline__ float bf2f(unsigned short h) { return __builtin_bit_cast(float, (unsigned)h << 16); }
__device__ __forceinline__ float bflo(unsigned w) { return __builtin_bit_cast(float, w << 16); }
__device__ __forceinline__ float bfhi(unsigned w) { return __builtin_bit_cast(float, w & 0xffff0000u); }

template <class Epi, class Sched, bool ALIGN_EPI = false, bool SP2 = false>
__device__ __forceinline__ void gemm_phase(PG8_LAS unsigned char* lds, const Gemm g, const Sched& S, const Epi& E) {
    const int tid = threadIdx.x, wid = __builtin_amdgcn_readfirstlane(tid >> 6), lane = tid & 63, wr = wid >> 2, wc = wid & 3, fr = lane & 15, fq = lane >> 4;
    const int K = g.K, nt = K / BK, lda = g.lda;
    unsigned voffA[2], voffB[2];
#pragma unroll
    for (int i = 0; i < 2; ++i) { int R, C; stage_rc(tid * 16 + i * 8192, R, C); const int Rb = Epi::PERM ? ((R & ~31) + perm32(R & 31)) : R;
        voffA[i] = (unsigned)(R * lda + C) * 2u; voffB[i] = (unsigned)(Rb * K + C) * 2u; }
    const size_t kstep = (size_t)(BK * 2);
    const size_t hstepA = (size_t)HALF * lda * 2, hstepB = (size_t)HALF * K * 2;
    const size_t tstepA = 2 * hstepA, tstepB = 2 * hstepB;
    const unsigned ldsw = (unsigned)wid * 1024u;
    const int aoff = lds_byte(wr * 64 + fr, fq * 8), boff = lds_byte(wc * 32 + fr, fq * 8);
#define PG8_SA(b, h) (((b) * 2 + (h)) * HTB)
#define PG8_SB(b, h) ((4 + (b) * 2 + (h)) * HTB)
#define PG8_STAGE(bufoff, gbase, voff) do { _Pragma("unroll") for (int _i = 0; _i < 2; ++_i) \
        __builtin_amdgcn_global_load_lds((const unsigned*)((const char*)(gbase) + (voff)[_i]), (PG8_LAS unsigned*)(lds + (bufoff) + ldsw + _i * 8192), 16, 0, 0); } while (0)
#define PG8_LDA(dst, b, h) do { _Pragma("unroll") for (int m = 0; m < 4; ++m) _Pragma("unroll") for (int k = 0; k < 2; ++k) dst[m][k] = *(const PG8_LAS bf16x8*)(lds + PG8_SA(b, h) + aoff + m * 2048 + k * 1024); } while (0)
#define PG8_LDB(dst, b, h) do { _Pragma("unroll") for (int n = 0; n < 2; ++n) _Pragma("unroll") for (int k = 0; k < 2; ++k) dst[n][k] = *(const PG8_LAS bf16x8*)(lds + PG8_SB(b, h) + boff + n * 2048 + k * 1024); } while (0)
#define PG8_MMA(ai, bj, At, Bt) do { __builtin_amdgcn_s_setprio(1); _Pragma("unroll") for (int m = 0; m < 4; ++m) _Pragma("unroll") for (int n = 0; n < 2; ++n) _Pragma("unroll") for (int k = 0; k < 2; ++k) \
        acc[ai][bj][m][n] = __builtin_amdgcn_mfma_f32_16x16x32_bf16(Bt[n][k], At[m][k], acc[ai][bj][m][n], 0, 0, 0); __builtin_amdgcn_s_setprio(0); } while (0)
#define PG8_WAIT_V(n) asm volatile("s_waitcnt vmcnt(" #n ")" ::: "memory")
#define PG8_WAIT_L(n) asm volatile("s_waitcnt lgkmcnt(" #n ")" ::: "memory")
#define PG8_BAR __builtin_amdgcn_s_barrier()
#define PG8_SCHED __builtin_amdgcn_sched_barrier(0)
    Unit cur, nxt; int ui = 0;
    if (!S.next(0, cur)) return;
    f32x4 acc[2][2][4][2];
#pragma unroll
    for (int a = 0; a < 2; ++a)
#pragma unroll
        for (int b = 0; b < 2; ++b)
#pragma unroll
            for (int m = 0; m < 4; ++m)
#pragma unroll
                for (int n = 0; n < 2; ++n) acc[a][b][m][n] = (f32x4){0.f, 0.f, 0.f, 0.f};
    bf16x8 At[4][2], B0[2][2], B1[2][2];
    const char* cA = (const char*)g.A + (size_t)cur.pm * tstepA; const char* cB = (const char*)g.Bt + (size_t)cur.pn * tstepB;
    S.a_ready(cur);
    if constexpr (SP2) {
        PG8_STAGE(PG8_SB(0, 0), cB, voffB); PG8_STAGE(PG8_SB(0, 1), cB + hstepB, voffB); PG8_STAGE(PG8_SA(0, 0), cA, voffA); PG8_STAGE(PG8_SA(0, 1), cA + hstepA, voffA);
        if (wr == 1) PG8_BAR;
        PG8_WAIT_V(2); PG8_BAR;
        PG8_STAGE(PG8_SB(1, 0), cB + kstep, voffB); PG8_STAGE(PG8_SA(1, 0), cA + kstep, voffA); PG8_STAGE(PG8_SB(1, 1), cB + hstepB + kstep, voffB);
        PG8_WAIT_V(6); PG8_BAR;
    } else {
        PG8_STAGE(PG8_SB(0, 0), cB, voffB); PG8_STAGE(PG8_SA(0, 0), cA, voffA); PG8_STAGE(PG8_SB(0, 1), cB + hstepB, voffB); PG8_STAGE(PG8_SA(0, 1), cA + hstepA, voffA);
        if (wr == 1) PG8_BAR;
        PG8_WAIT_V(4); PG8_BAR;
        PG8_STAGE(PG8_SB(1, 0), cB + kstep, voffB); PG8_STAGE(PG8_SA(1, 0), cA + kstep, voffA); PG8_STAGE(PG8_SB(1, 1), cB + hstepB + kstep, voffB);
        PG8_WAIT_V(6); PG8_BAR;
    }
    for (;;) {
        const bool has_next = S.next(ui + 1, nxt);
        const char* nA = has_next ? (const char*)g.A + (size_t)nxt.pm * tstepA : cA; const char* nB = has_next ? (const char*)g.Bt + (size_t)nxt.pn * tstepB : cB;
        for (int t = 0; t < nt; t += 2) {
            const bool last = (t == nt - 2);
            const char* a1 = cA + (size_t)(t + 1) * kstep;
            const char* a2 = last ? nA : cA + (size_t)(t + 2) * kstep; const char* b2 = last ? nB : cB + (size_t)(t + 2) * kstep;
            const char* a3 = a2 + kstep; const char* b3 = b2 + kstep;
            if (last && has_next) S.a_ready(nxt);
            if constexpr (SP2) {
            PG8_LDB(B0, 0, 0); PG8_LDB(B1, 0, 1); PG8_SCHED; PG8_LDA(At, 0, 0); PG8_STAGE(PG8_SA(1, 1), a1 + hstepA, voffA);
            PG8_WAIT_V(8); PG8_WAIT_L(0); PG8_BAR; PG8_MMA(0, 0, At, B0); PG8_MMA(0, 1, At, B1); PG8_BAR; PG8_SCHED;
            PG8_LDA(At, 0, 1); PG8_STAGE(PG8_SB(0, 0), b2, voffB); PG8_STAGE(PG8_SB(0, 1), b2 + hstepB, voffB); PG8_STAGE(PG8_SA(0, 0), a2, voffA);
            PG8_WAIT_V(8); PG8_WAIT_L(0); PG8_BAR; PG8_MMA(1, 0, At, B0); PG8_MMA(1, 1, At, B1); PG8_BAR; PG8_SCHED;
            PG8_LDB(B0, 1, 0); PG8_LDB(B1, 1, 1); PG8_SCHED; PG8_LDA(At, 1, 0); PG8_STAGE(PG8_SA(0, 1), a2 + hstepA, voffA);
            PG8_WAIT_V(8); PG8_WAIT_L(0); PG8_BAR; PG8_MMA(0, 0, At, B0); PG8_MMA(0, 1, At, B1); PG8_BAR; PG8_SCHED;
            PG8_LDA(At, 1, 1); PG8_STAGE(PG8_SB(1, 0), b3, voffB); PG8_STAGE(PG8_SB(1, 1), b3 + hstepB, voffB); PG8_STAGE(PG8_SA(1, 0), a3, voffA);
            PG8_WAIT_V(8); PG8_WAIT_L(0); PG8_BAR; PG8_MMA(1, 0, At, B0); PG8_MMA(1, 1, At, B1); PG8_BAR; PG8_SCHED;
            } else {
            PG8_LDB(B0, 0, 0); PG8_SCHED; PG8_LDA(At, 0, 0); PG8_STAGE(PG8_SA(1, 1), a1 + hstepA, voffA);
            PG8_WAIT_L(8); PG8_BAR; PG8_WAIT_L(0); PG8_MMA(0, 0, At, B0); PG8_BAR; PG8_SCHED;
            PG8_LDB(B1, 0, 1); PG8_STAGE(PG8_SB(0, 0), b2, voffB);
            PG8_BAR; PG8_WAIT_L(0); PG8_MMA(0, 1, At, B1); PG8_BAR;
            PG8_LDA(At, 0, 1); PG8_STAGE(PG8_SA(0, 0), a2, voffA);
            PG8_BAR; PG8_WAIT_L(0); PG8_MMA(1, 0, At, B0); PG8_BAR; PG8_SCHED;
            PG8_STAGE(PG8_SB(0, 1), b2 + hstepB, voffB);
            PG8_WAIT_V(6); PG8_BAR; PG8_MMA(1, 1, At, B1); PG8_BAR;
            PG8_LDB(B0, 1, 0); PG8_SCHED; PG8_LDA(At, 1, 0); PG8_STAGE(PG8_SA(0, 1), a2 + hstepA, voffA);
            PG8_WAIT_L(8); PG8_BAR; PG8_WAIT_L(0); PG8_MMA(0, 0, At, B0); PG8_BAR; PG8_SCHED;
            PG8_LDB(B1, 1, 1); PG8_STAGE(PG8_SB(1, 0), b3, voffB);
            PG8_BAR; PG8_WAIT_L(0); PG8_MMA(0, 1, At, B1); PG8_BAR;
            PG8_LDA(At, 1, 1); PG8_STAGE(PG8_SA(1, 0), a3, voffA);
            PG8_BAR; PG8_WAIT_L(0); PG8_MMA(1, 0, At, B0); PG8_BAR; PG8_SCHED;
            PG8_STAGE(PG8_SB(1, 1), b3 + hstepB, voffB);
            PG8_WAIT_V(6); PG8_BAR; PG8_MMA(1, 1, At, B1); PG8_BAR;
            }
        }
        if constexpr (ALIGN_EPI) { if (wr == 0) PG8_BAR; }
        E(acc, cur, wr, wc, fr, fq); S.done(cur);
        if (!has_next) break;
#pragma unroll
        for (int a = 0; a < 2; ++a)
#pragma unroll
            for (int b = 0; b < 2; ++b)
#pragma unroll
                for (int m = 0; m < 4; ++m)
#pragma unroll
                    for (int n = 0; n < 2; ++n) acc[a][b][m][n] = (f32x4){0.f, 0.f, 0.f, 0.f};
        cur = nxt; cA = nA; cB = nB; ++ui;
        if constexpr (ALIGN_EPI) { if (wr == 1) PG8_BAR; }
    }
    PG8_WAIT_V(0);
    if constexpr (!ALIGN_EPI) { if (wr == 0) PG8_BAR; }
    PG8_BAR;
#undef PG8_SA
#undef PG8_SB
#undef PG8_STAGE
#undef PG8_LDA
#undef PG8_LDB
#undef PG8_MMA
#undef PG8_WAIT_V
#undef PG8_WAIT_L
#undef PG8_BAR
#undef PG8_SCHED
}
struct Gemm2 { const bf16_t *A1, *A2, *B1, *B2; int M, N, K1, lda; };
template <class Epi, class Sched, bool ALIGN_EPI = false, bool SP2 = false>
__device__ __forceinline__ void gemm_phase2(PG8_LAS unsigned char* lds, const Gemm2 g, const Sched& S, const Epi& E) {
    const int tid = threadIdx.x, wid = __builtin_amdgcn_readfirstlane(tid >> 6), lane = tid & 63, wr = wid >> 2, wc = wid & 3, fr = lane & 15, fq = lane >> 4;
    const int K = g.K1, nt = K / BK, lda = g.lda;
    unsigned voffA[2], voffB[2];
#pragma unroll
    for (int i = 0; i < 2; ++i) { int R, C; stage_rc(tid * 16 + i * 8192, R, C); const int Rb = Epi::PERM ? ((R & ~31) + perm32(R & 31)) : R;
        voffA[i] = (unsigned)(R * lda + C) * 2u; voffB[i] = (unsigned)(Rb * K + C) * 2u; }
    const size_t kstep = (size_t)(BK * 2);
    const size_t hstepA = (size_t)HALF * lda * 2, hstepB = (size_t)HALF * K * 2;
    const size_t tstepA = 2 * hstepA, tstepB = 2 * hstepB;
    const unsigned ldsw = (unsigned)wid * 1024u;
    const int aoff = lds_byte(wr * 64 + fr, fq * 8), boff = lds_byte(wc * 32 + fr, fq * 8);
#define PG8_SA(b, h) (((b) * 2 + (h)) * HTB)
#define PG8_SB(b, h) ((4 + (b) * 2 + (h)) * HTB)
#define PG8_STAGE(bufoff, gbase, voff) do { _Pragma("unroll") for (int _i = 0; _i < 2; ++_i) \
        __builtin_amdgcn_global_load_lds((const unsigned*)((const char*)(gbase) + (voff)[_i]), (PG8_LAS unsigned*)(lds + (bufoff) + ldsw + _i * 8192), 16, 0, 0); } while (0)
#define PG8_LDA(dst, b, h) do { _Pragma("unroll") for (int m = 0; m < 4; ++m) _Pragma("unroll") for (int k = 0; k < 2; ++k) dst[m][k] = *(const PG8_LAS bf16x8*)(lds + PG8_SA(b, h) + aoff + m * 2048 + k * 1024); } while (0)
#define PG8_LDB(dst, b, h) do { _Pragma("unroll") for (int n = 0; n < 2; ++n) _Pragma("unroll") for (int k = 0; k < 2; ++k) dst[n][k] = *(const PG8_LAS bf16x8*)(lds + PG8_SB(b, h) + boff + n * 2048 + k * 1024); } while (0)
#define PG8_MMA(ai, bj, At, Bt) do { __builtin_amdgcn_s_setprio(1); _Pragma("unroll") for (int m = 0; m < 4; ++m) _Pragma("unroll") for (int n = 0; n < 2; ++n) _Pragma("unroll") for (int k = 0; k < 2; ++k) \
        acc[ai][bj][m][n] = __builtin_amdgcn_mfma_f32_16x16x32_bf16(Bt[n][k], At[m][k], acc[ai][bj][m][n], 0, 0, 0); __builtin_amdgcn_s_setprio(0); } while (0)
#define PG8_WAIT_V(n) asm volatile("s_waitcnt vmcnt(" #n ")" ::: "memory")
#define PG8_WAIT_L(n) asm volatile("s_waitcnt lgkmcnt(" #n ")" ::: "memory")
#define PG8_BAR __builtin_amdgcn_s_barrier()
#define PG8_SCHED __builtin_amdgcn_sched_barrier(0)
    Unit cur, nxt; int ui = 0;
    if (!S.next(0, cur)) return;
    f32x4 acc[2][2][4][2];
#pragma unroll
    for (int a = 0; a < 2; ++a)
#pragma unroll
        for (int b = 0; b < 2; ++b)
#pragma unroll
            for (int m = 0; m < 4; ++m)
#pragma unroll
                for (int n = 0; n < 2; ++n) acc[a][b][m][n] = (f32x4){0.f, 0.f, 0.f, 0.f};
    bf16x8 At[4][2], B0[2][2], B1[2][2];
    const char* cA = (const char*)g.A1 + (size_t)cur.pm * tstepA; const char* cB = (const char*)g.B1 + (size_t)cur.pn * tstepB;
    S.a_ready(cur);
    if constexpr (SP2) {
        PG8_STAGE(PG8_SB(0, 0), cB, voffB); PG8_STAGE(PG8_SB(0, 1), cB + hstepB, voffB); PG8_STAGE(PG8_SA(0, 0), cA, voffA); PG8_STAGE(PG8_SA(0, 1), cA + hstepA, voffA);
        if (wr == 1) PG8_BAR;
        PG8_WAIT_V(2); PG8_BAR;
        PG8_STAGE(PG8_SB(1, 0), cB + kstep, voffB); PG8_STAGE(PG8_SA(1, 0), cA + kstep, voffA); PG8_STAGE(PG8_SB(1, 1), cB + hstepB + kstep, voffB);
        PG8_WAIT_V(6); PG8_BAR;
    } else {
        PG8_STAGE(PG8_SB(0, 0), cB, voffB); PG8_STAGE(PG8_SA(0, 0), cA, voffA); PG8_STAGE(PG8_SB(0, 1), cB + hstepB, voffB); PG8_STAGE(PG8_SA(0, 1), cA + hstepA, voffA);
        if (wr == 1) PG8_BAR;
        PG8_WAIT_V(4); PG8_BAR;
        PG8_STAGE(PG8_SB(1, 0), cB + kstep, voffB); PG8_STAGE(PG8_SA(1, 0), cA + kstep, voffA); PG8_STAGE(PG8_SB(1, 1), cB + hstepB + kstep, voffB);
        PG8_WAIT_V(6); PG8_BAR;
    }
    for (;;) {
        const int nhalf = (ui + 1) & 1;
        const bool has_next = S.next((ui + 1) >> 1, nxt);
        const char* nA = has_next ? (const char*)(nhalf ? g.A2 : g.A1) + (size_t)nxt.pm * tstepA : cA; const char* nB = has_next ? (const char*)(nhalf ? g.B2 : g.B1) + (size_t)nxt.pn * tstepB : cB;
        for (int t = 0; t < nt; t += 2) {
            const bool last = (t == nt - 2);
            const char* a1 = cA + (size_t)(t + 1) * kstep;
            const char* a2 = last ? nA : cA + (size_t)(t + 2) * kstep; const char* b2 = last ? nB : cB + (size_t)(t + 2) * kstep;
            const char* a3 = a2 + kstep; const char* b3 = b2 + kstep;
            if (last && has_next) S.a_ready(nxt);
            if constexpr (SP2) {
            PG8_LDB(B0, 0, 0); PG8_LDB(B1, 0, 1); PG8_SCHED; PG8_LDA(At, 0, 0); PG8_STAGE(PG8_SA(1, 1), a1 + hstepA, voffA);
            PG8_WAIT_V(8); PG8_WAIT_L(0); PG8_BAR; PG8_MMA(0, 0, At, B0); PG8_MMA(0, 1, At, B1); PG8_BAR; PG8_SCHED;
            PG8_LDA(At, 0, 1); PG8_STAGE(PG8_SB(0, 0), b2, voffB); PG8_STAGE(PG8_SB(0, 1), b2 + hstepB, voffB); PG8_STAGE(PG8_SA(0, 0), a2, voffA);
            PG8_WAIT_V(8); PG8_WAIT_L(0); PG8_BAR; PG8_MMA(1, 0, At, B0); PG8_MMA(1, 1, At, B1); PG8_BAR; PG8_SCHED;
            PG8_LDB(B0, 1, 0); PG8_LDB(B1, 1, 1); PG8_SCHED; PG8_LDA(At, 1, 0); PG8_STAGE(PG8_SA(0, 1), a2 + hstepA, voffA);
            PG8_WAIT_V(8); PG8_WAIT_L(0); PG8_BAR; PG8_MMA(0, 0, At, B0); PG8_MMA(0, 1, At, B1); PG8_BAR; PG8_SCHED;
            PG8_LDA(At, 1, 1); PG8_STAGE(PG8_SB(1, 0), b3, voffB); PG8_STAGE(PG8_SB(1, 1), b3 + hstepB, voffB); PG8_STAGE(PG8_SA(1, 0), a3, voffA);
            PG8_WAIT_V(8); PG8_WAIT_L(0); PG8_BAR; PG8_MMA(1, 0, At, B0); PG8_MMA(1, 1, At, B1); PG8_BAR; PG8_SCHED;
            } else {
            PG8_LDB(B0, 0, 0); PG8_SCHED; PG8_LDA(At, 0, 0); PG8_STAGE(PG8_SA(1, 1), a1 + hstepA, voffA);
            PG8_WAIT_L(8); PG8_BAR; PG8_WAIT_L(0); PG8_MMA(0, 0, At, B0); PG8_BAR; PG8_SCHED;
            PG8_LDB(B1, 0, 1); PG8_STAGE(PG8_SB(0, 0), b2, voffB);
            PG8_BAR; PG8_WAIT_L(0); PG8_MMA(0, 1, At, B1); PG8_BAR;
            PG8_LDA(At, 0, 1); PG8_STAGE(PG8_SA(0, 0), a2, voffA);
            PG8_BAR; PG8_WAIT_L(0); PG8_MMA(1, 0, At, B0); PG8_BAR; PG8_SCHED;
            PG8_STAGE(PG8_SB(0, 1), b2 + hstepB, voffB);
            PG8_WAIT_V(6); PG8_BAR; PG8_MMA(1, 1, At, B1); PG8_BAR;
            PG8_LDB(B0, 1, 0); PG8_SCHED; PG8_LDA(At, 1, 0); PG8_STAGE(PG8_SA(0, 1), a2 + hstepA, voffA);
            PG8_WAIT_L(8); PG8_BAR; PG8_WAIT_L(0); PG8_MMA(0, 0, At, B0); PG8_BAR; PG8_SCHED;
            PG8_LDB(B1, 1, 1); PG8_STAGE(PG8_SB(1, 0), b3, voffB);
            PG8_BAR; PG8_WAIT_L(0); PG8_MMA(0, 1, At, B1); PG8_BAR;
            PG8_LDA(At, 1, 1); PG8_STAGE(PG8_SA(1, 0), a3, voffA);
            PG8_BAR; PG8_WAIT_L(0); PG8_MMA(1, 0, At, B0); PG8_BAR; PG8_SCHED;
            PG8_STAGE(PG8_SB(1, 1), b3 + hstepB, voffB);
            PG8_WAIT_V(6); PG8_BAR; PG8_MMA(1, 1, At, B1); PG8_BAR;
            }
        }
        if constexpr (ALIGN_EPI) { if (wr == 0) PG8_BAR; }
        if ((ui & 1) == 0) E.mid(acc, cur, wr, wc, fr, fq); else { E(acc, cur, wr, wc, fr, fq); S.done(cur); }
        if (!has_next) break;
        if (ui & 1)
#pragma unroll
        for (int a = 0; a < 2; ++a)
#pragma unroll
            for (int b = 0; b < 2; ++b)
#pragma unroll
                for (int m = 0; m < 4; ++m)
#pragma unroll
                    for (int n = 0; n < 2; ++n) acc[a][b][m][n] = (f32x4){0.f, 0.f, 0.f, 0.f};
        cur = nxt; cA = nA; cB = nB; ++ui;
        if constexpr (ALIGN_EPI) { if (wr == 1) PG8_BAR; }
    }
    PG8_WAIT_V(0);
    if constexpr (!ALIGN_EPI) { if (wr == 0) PG8_BAR; }
    PG8_BAR;
#undef PG8_SA
#undef PG8_SB
#undef PG8_STAGE
#undef PG8_LDA
#undef PG8_LDB
#undef PG8_MMA
#undef PG8_WAIT_V
#undef PG8_WAIT_L
#undef PG8_BAR
#undef PG8_SCHED
}
}

#ifndef PG8_SP2
#define PG8_SP2 true
#endif
#ifndef PG8_ALIGN
#define PG8_ALIGN true
#endif

using pg8::bf16_t; using pg8::f32x4; using pg8::u32x4; using pg8::u32x2; using pg8::cvtpk; using pg8::bf2f; using pg8::bflo; using pg8::bfhi;

constexpr size_t MiB = 1u << 20;
constexpr size_t WS_CTL = 0, CTL_ZERO_BYTES = 32 * 1024;
constexpr size_t WS_ROPE = 1 * MiB;
constexpr size_t WS_WUQ = 3 * MiB, WS_WUKV = 6 * MiB, WS_WOM = 8 * MiB, WS_WOD = 12 * MiB, WS_WOUT = 16 * MiB, WS_WQP = 24 * MiB;
constexpr size_t WS_SKB = 5 * MiB + 512 * 1024;
constexpr size_t WS_W1 = 32 * MiB;
constexpr size_t WS_H = 66 * MiB;
constexpr size_t WS_CQ = 130 * MiB, WS_CKV = 154 * MiB;
constexpr size_t WS_KR = 170 * MiB, WS_DQ = 172 * MiB, WS_DK = 204 * MiB, WS_DV = 236 * MiB;
constexpr size_t WS_G = 268 * MiB;
constexpr size_t WS_QN = 32 * MiB, WS_QR = 64 * MiB, WS_KN = 80 * MiB, WS_V = 396 * MiB;
constexpr size_t WS_OM = 112 * MiB, WS_OD = 428 * MiB;
constexpr size_t WS_TMP = 32 * MiB;
constexpr size_t WS_MG = 172 * MiB;
constexpr size_t WS_X2 = 268 * MiB;
constexpr size_t WS_X2B = 396 * MiB;
constexpr size_t WS_EU = 32 * MiB, WS_EV = 96 * MiB;
constexpr size_t WS_QP = 172 * MiB;
constexpr size_t WS_IDX = 236 * MiB, WS_GT = 244 * MiB;
constexpr size_t WS_PSQ_Q = 460 * MiB, WS_PSQ_KV = 461 * MiB, WS_PSQ2 = 462 * MiB;
constexpr size_t WS_END = 464 * MiB;
constexpr int CW_TMO = 0, CW_CODE = 1, CW_LAMBDA = 8, CW_TOKCTR = 64;
constexpr int CW_BAR = 4096;

constexpr int RING_OFF = 0, RING_BYTES = 131072;
constexpr int LDSCTL_OFF = RING_BYTES, MISC_OFF = LDSCTL_OFF + 320;
constexpr int LDS_BYTES = 147456;
constexpr int NWAVES = 8;

#define GAS __attribute__((address_space(1)))
#define LAS __attribute__((address_space(3)))
typedef unsigned short bf16;
typedef unsigned v4u __attribute__((ext_vector_type(4)));
typedef GAS unsigned gu32;
#define RLX_AGENT __ATOMIC_RELAXED, __HIP_MEMORY_SCOPE_AGENT
#define LDS_WAIT() asm volatile("s_waitcnt lgkmcnt(0)" ::: "memory")
#define VM_WAIT() asm volatile("s_waitcnt vmcnt(0)" ::: "memory")

#define XB_TMO      128
#define XB_XCNT(j)  (256  + 64 * (j))
#define XB_XSUB(j)  (1280 + 64 * (j))
#define XB_XGEN(j)  (2304 + 64 * (j))
#define XB_TOP      3328
#define XB_TOPGEN   3392
#define XCD_BAR_WORDS 3456
#define XB_SPIN_CAP (1u << 22)
__device__ __forceinline__ unsigned xb_ld(unsigned* p)              { return __hip_atomic_load(p, __ATOMIC_RELAXED, __HIP_MEMORY_SCOPE_AGENT); }
__device__ __forceinline__ unsigned xb_add(unsigned* p, unsigned v) { return __hip_atomic_fetch_add(p, v, __ATOMIC_RELAXED, __HIP_MEMORY_SCOPE_AGENT); }
__device__ __forceinline__ unsigned xb_xcc_id() { return (unsigned)__builtin_amdgcn_s_getreg((3 << 11) | 20) & 0xFu; }
#define XB_SPIN(cond, bar) do { unsigned _sp = 0; while (cond) { __builtin_amdgcn_s_sleep(1); \
    if ((++_sp & 255u) == 0u) { if (xb_ld(&(bar)[XB_TMO])) break; if (_sp > XB_SPIN_CAP) { atomicAdd(&(bar)[XB_TMO], 1u); break; } } } } while (0)
struct XcdBarrier { unsigned* bar; unsigned x; volatile LAS unsigned* st; };
__device__ __forceinline__ XcdBarrier xcd_barrier_post(unsigned* bar, volatile LAS unsigned* st) {
    XcdBarrier b; b.bar = bar; b.x = xb_xcc_id(); b.st = st;
    if (threadIdx.x == 0) (void)xb_add(&bar[XB_XCNT(b.x)], 1u);
    return b;
}
__device__ __forceinline__ void xcd_barrier_complete(unsigned* bar, unsigned x, unsigned& nloc, unsigned& nx) {
    const unsigned G = gridDim.x * gridDim.y * gridDim.z;
    unsigned sum, cnt, mine, sp = 0u;
    for (;;) {
        sum = 0u; cnt = 0u; mine = 0u;
#pragma unroll
        for (unsigned j = 0; j < 16; ++j) { const unsigned c = xb_ld(&bar[XB_XCNT(j)]); sum += c; cnt += (c > 0u) ? 1u : 0u; mine = (j == x) ? c : mine; }
        if (sum == G) break;
        __builtin_amdgcn_s_sleep(1);
        if ((++sp & 255u) == 0u) { if (xb_ld(&bar[XB_TMO])) break; if (sp > XB_SPIN_CAP) { atomicAdd(&bar[XB_TMO], 1u); break; } }
    }
    nloc = mine > 0u ? mine : 1u; nx = cnt > 0u ? cnt : 1u;
}
__device__ __forceinline__ void xcd_barrier(const XcdBarrier& b) {
    asm volatile("s_waitcnt vmcnt(0)" ::: "memory");
    __syncthreads();
    if (threadIdx.x == 0) {
        unsigned* bar = b.bar;
        __builtin_amdgcn_s_waitcnt(0);
        unsigned nloc = b.st[0], nx = b.st[1];
        if (nloc == 0u) { xcd_barrier_complete(bar, b.x, nloc, nx); b.st[0] = nloc; b.st[1] = nx; }
        const unsigned old = xb_add(&bar[XB_XSUB(b.x)], 1u);
        const unsigned gen = old / nloc;
        if (old + 1u == (gen + 1u) * nloc) {
            __builtin_amdgcn_fence(__ATOMIC_RELEASE, "agent");
            asm volatile("s_waitcnt vmcnt(0)" ::: "memory");
            const unsigned og = xb_add(&bar[XB_TOP], 1u);
            const unsigned tg = og / nx;
            if (og + 1u == (tg + 1u) * nx) xb_add(&bar[XB_TOPGEN], 1u);
            else XB_SPIN(xb_ld(&bar[XB_TOPGEN]) == tg, bar);
            __builtin_amdgcn_fence(__ATOMIC_ACQUIRE, "agent");
            xb_add(&bar[XB_XGEN(b.x)], 1u);
            asm volatile("s_waitcnt vmcnt(0)" ::: "memory");
        } else {
            XB_SPIN(xb_ld(&bar[XB_XGEN(b.x)]) == gen, bar);
            __builtin_amdgcn_fence(__ATOMIC_ACQUIRE, "agent");
            asm volatile("s_waitcnt vmcnt(0)" ::: "memory");
        }
    }
    __syncthreads();
}

struct Frame {
    LAS unsigned char* lds;
    volatile LAS unsigned* MISC;
    gu32* ctl;
    unsigned char* ws;
    int tid, lane, wave, vcu, G;
};

__device__ __forceinline__ float wave_sum(float v) {
#pragma unroll
    for (int o = 1; o < 64; o <<= 1) v += __shfl_xor(v, o);
    return v;
}
__device__ __forceinline__ float wave_max(float v) {
#pragma unroll
    for (int o = 1; o < 64; o <<= 1) v = fmaxf(v, __shfl_xor(v, o));
    return v;
}
__device__ __forceinline__ unsigned pk2(float lo, float hi) { return cvtpk(lo, hi); }

template <class Map>
__device__ __forceinline__ void tr_item(const float* W, int Nsrc, int K, const float* kscale, bf16* WT, LAS float* scr, int item, int nblk, int lane, Map map) {
    const int kb = item / nblk, nb = item % nblk, k0 = 64 * kb, n0 = 32 * nb;
    const int sc = map(n0 + (lane & 31));
    float tv[32];
    const int scc = sc >= 0 ? sc : 0;
#pragma unroll
    for (int i = 0; i < 32; ++i) { const int kk = 2 * i + (lane >> 5); tv[i] = W[(size_t)(k0 + kk) * Nsrc + scc]; }
#pragma unroll
    for (int i = 0; i < 32; ++i) { const int kk = 2 * i + (lane >> 5); float v = sc >= 0 ? tv[i] : 0.f; if (kscale) v *= kscale[k0 + kk]; scr[kk * 33 + (lane & 31)] = v; }
    LDS_WAIT(); asm volatile("" ::: "memory");
    const int c = lane & 7;
#pragma unroll
    for (int j = 0; j < 4; ++j) { const int n = (lane >> 3) + 8 * j; const LAS float* s = scr + (8 * c) * 33 + n;
        v4u o; o.x = pk2(s[0 * 33], s[1 * 33]); o.y = pk2(s[2 * 33], s[3 * 33]); o.z = pk2(s[4 * 33], s[5 * 33]); o.w = pk2(s[6 * 33], s[7 * 33]);
        *(GAS v4u*)(WT + (size_t)(n0 + n) * K + k0 + 8 * c) = o; }
    LDS_WAIT(); asm volatile("" ::: "memory");
}
__device__ __forceinline__ int rope_src(int jj) { return (jj & 1) * 32 + (jj >> 1); }
struct MapW1 { __device__ int operator()(int n) const {
    if (n < 1280) return n;
    if (n < 2304) { const int j = n - 1280; return OFF_DQ + (j & ~63) + rope_src(j & 63); }
    if (n < 3328) { const int j = n - 2304; return OFF_DK + (j & ~63) + rope_src(j & 63); }
    if (n < 4352) return OFF_DV + (n - 3328);
    if (n < 8448) return OFF_GATE + (n - 4352);
    if (n < 8512) return OFF_KR + rope_src(n - 8448);
    return -1; } };
struct MapUQ { __device__ int operator()(int n) const {
    if (n < 1024) return (n >> 7) * 192 + (n & 127);
    const int j = n - 1024; return (j >> 6) * 192 + 128 + rope_src(j & 63); } };
struct MapUKV { __device__ int operator()(int n) const {
    if (n < 1024) return (n >> 7) * 256 + (n & 127);
    const int j = n - 1024; return (j >> 7) * 256 + 128 + (j & 127); } };
struct MapId { __device__ int operator()(int n) const { return n; } };

struct Ins { const float *x, *w_in, *b_gate, *g_norm1, *g_cq, *w_uq, *g_ckv, *w_ukv, *w_o_mla, *lambda_qk, *g_subln, *w_o_diff, *w_out, *g_norm2, *w_q_peer, *sub_keys, *expert_u, *expert_v, *g_final; };

__device__ __forceinline__ void p0_prologue(Frame& F, const Ins& I, const double* inv_freq) {
    LAS float* scr = (LAS float*)(F.lds + RING_OFF + F.wave * 16384);
    const int gw = F.vcu * NWAVES + F.wave, NGW = F.G * NWAVES;
    unsigned char* ws = F.ws;
    constexpr int I_W1 = (2048 / 64) * (N1 / 32), I_UQ = (768 / 64) * (1536 / 32), I_UKV = (512 / 64) * (2048 / 32), I_OM = (1024 / 64) * (2048 / 32), I_OD = I_OM, I_OUT = (2048 / 64) * (2048 / 32), I_QP = I_OUT;
    constexpr int NITEMS = I_W1 + I_UQ + I_UKV + I_OM + I_OD + I_OUT + I_QP;
    for (int it = gw; it < NITEMS; it += NGW) {
        int r = it;
        if (r < I_W1) { tr_item(I.w_in, IN_COLS, 2048, nullptr, (bf16*)(ws + WS_W1), scr, r, N1 / 32, F.lane, MapW1()); continue; } r -= I_W1;
        if (r < I_UQ) { tr_item(I.w_uq, 1536, 768, I.g_cq, (bf16*)(ws + WS_WUQ), scr, r, 1536 / 32, F.lane, MapUQ()); continue; } r -= I_UQ;
        if (r < I_UKV) { tr_item(I.w_ukv, 2048, 512, I.g_ckv, (bf16*)(ws + WS_WUKV), scr, r, 2048 / 32, F.lane, MapUKV()); continue; } r -= I_UKV;
        if (r < I_OM) { tr_item(I.w_o_mla, 2048, 1024, nullptr, (bf16*)(ws + WS_WOM), scr, r, 2048 / 32, F.lane, MapId()); continue; } r -= I_OM;
        if (r < I_OD) { tr_item(I.w_o_diff, 2048, 1024, nullptr, (bf16*)(ws + WS_WOD), scr, r, 2048 / 32, F.lane, MapId()); continue; } r -= I_OD;
        if (r < I_OUT) { tr_item(I.w_out, 2048, 2048, nullptr, (bf16*)(ws + WS_WOUT), scr, r, 2048 / 32, F.lane, MapId()); continue; } r -= I_OUT;
        tr_item(I.w_q_peer, 2048, 2048, I.g_norm2, (bf16*)(ws + WS_WQP), scr, r, 2048 / 32, F.lane, MapId());
    }
    {
        bf16* skb = (bf16*)(ws + WS_SKB);
        for (int e = gw * 64 + F.lane; e < 256 * 256; e += NGW * 64) {
            const int n = e >> 8, k = e & 255; float v = 0.f;
            if (n < 128 && k < 128) v = I.sub_keys[n * 128 + k];
            else if (n >= 128 && k >= 128) v = I.sub_keys[128 * 128 + (n - 128) * 128 + (k - 128)];
            skb[e] = (bf16)(pk2(v, 0.f) & 0xffffu);
        }
    }
    {
        float* rope = (float*)(ws + WS_ROPE);
        for (int e = gw * 64 + F.lane; e < SEQ * 32; e += NGW * 64) {
            const int pos = e >> 5, i = e & 31;
            const double rev = (double)pos * inv_freq[i] * 0.15915494309189535;
            const float fr = (float)(rev - floor(rev));
            rope[2 * e] = __builtin_amdgcn_cosf(fr); rope[2 * e + 1] = __builtin_amdgcn_sinf(fr);
        }
    }
    if (blockIdx.x == 0 && F.tid == 0) {
        float a = 0.f, b = 0.f;
        for (int d = 0; d < 64; ++d) { a += I.lambda_qk[d] * I.lambda_qk[64 + d]; b += I.lambda_qk[128 + d] * I.lambda_qk[192 + d]; }
        const float lam = __expf(a) - __expf(b) + LAMBDA_INIT;
        ((float*)F.ctl)[CW_LAMBDA] = lam;
    }
    {
        bf16* H = (bf16*)(ws + WS_H);
        f32x4 g[8];
#pragma unroll
        for (int j = 0; j < 8; ++j) g[j] = *((const f32x4*)I.g_norm1 + F.lane + 64 * j);
        for (int m = gw; m < T; m += NGW) {
            const GAS f32x4* xr = (const GAS f32x4*)(I.x + (size_t)m * D_MODEL) + F.lane;
            f32x4 v[8]; float s = 0.f;
#pragma unroll
            for (int j = 0; j < 8; ++j) { v[j] = xr[64 * j]; s += (v[j].x * v[j].x + v[j].y * v[j].y) + (v[j].z * v[j].z + v[j].w * v[j].w); }
            const float rstd = 1.0f / sqrtf(wave_sum(s) * (1.f / D_MODEL) + EPS);
            GAS u32x2* o8 = (GAS u32x2*)(H + (size_t)m * D_MODEL) + F.lane;
#pragma unroll
            for (int j = 0; j < 8; ++j) { u32x2 w; w.x = pk2(v[j].x * rstd * g[j].x, v[j].y * rstd * g[j].y); w.y = pk2(v[j].z * rstd * g[j].z, v[j].w * rstd * g[j].w); o8[64 * j] = w; }
        }
    }
}

__device__ __forceinline__ void convert_experts(Frame& F, const Ins& I) {
    const size_t gt = (size_t)(F.vcu * NWAVES * 64) + F.tid, NT = (size_t)F.G * NWAVES * 64;
    const size_t nchunk = (size_t)NEXP * D_MODEL / 8;
    bf16* EU = (bf16*)(F.ws + WS_EU); bf16* EV = (bf16*)(F.ws + WS_EV);
    for (size_t c = gt; c < nchunk; c += NT) {
        const int d = (int)((c * 8) & (D_MODEL - 1));
        const f32x4 a0 = *(const GAS f32x4*)(I.expert_u + c * 8), a1 = *(const GAS f32x4*)(I.expert_u + c * 8 + 4);
        const f32x4 g0 = *(const f32x4*)(I.g_norm2 + d), g1 = *(const f32x4*)(I.g_norm2 + d + 4);
        v4u o; o.x = pk2(a0.x * g0.x, a0.y * g0.y); o.y = pk2(a0.z * g0.z, a0.w * g0.w); o.z = pk2(a1.x * g1.x, a1.y * g1.y); o.w = pk2(a1.z * g1.z, a1.w * g1.w);
        *(GAS v4u*)(EU + c * 8) = o;
        const f32x4 b0 = *(const GAS f32x4*)(I.expert_v + c * 8), b1 = *(const GAS f32x4*)(I.expert_v + c * 8 + 4);
        v4u p; p.x = pk2(b0.x, b0.y); p.y = pk2(b0.z, b0.w); p.z = pk2(b1.x, b1.y); p.w = pk2(b1.z, b1.w);
        *(GAS v4u*)(EV + c * 8) = p;
    }
}

__device__ __forceinline__ float sigmoidf_fast(float x) { return __builtin_amdgcn_rcpf(1.0f + __builtin_amdgcn_exp2f(-x * LOG2E)); }
__device__ __forceinline__ void rope8(f32x4& v0, f32x4& v1, const f32x4 cs0, const f32x4 cs1, float sc) {
    const float a0 = v0[0] * cs0[0] - v0[1] * cs0[1], b0 = v0[1] * cs0[0] + v0[0] * cs0[1];
    const float a1 = v0[2] * cs0[2] - v0[3] * cs0[3], b1 = v0[3] * cs0[2] + v0[2] * cs0[3];
    const float a2 = v1[0] * cs1[0] - v1[1] * cs1[1], b2 = v1[1] * cs1[0] + v1[0] * cs1[1];
    const float a3 = v1[2] * cs1[2] - v1[3] * cs1[3], b3 = v1[3] * cs1[2] + v1[2] * cs1[3];
    v0 = (f32x4){a0 * sc, b0 * sc, a1 * sc, b1 * sc}; v1 = (f32x4){a2 * sc, b2 * sc, a3 * sc, b3 * sc};
}
__device__ __forceinline__ u32x4 pack8(const f32x4 v0, const f32x4 v1) { u32x4 w; w.x = cvtpk(v0[0], v0[1]); w.y = cvtpk(v0[2], v0[3]); w.z = cvtpk(v1[0], v1[1]); w.w = cvtpk(v1[2], v1[3]); return w; }

__device__ __forceinline__ size_t kt_off(size_t row, int col) { const size_t b = row >> 13; const int pos = (int)(row & 8191), tile = pos >> 6, key = pos & 63, h = col >> 7, piece = (col & 127) >> 3;
    return (((b * 8 + h) * 128 + tile) * 16 + piece) * 512 + key * 8 + (col & 7); }
__device__ __forceinline__ size_t vt_off(size_t row, int col) { const size_t b = row >> 13; const int pos = (int)(row & 8191), tile = pos >> 6, key = pos & 63, h = col >> 7, d = col & 127;
    return (((b * 8 + h) * 128 + tile) * 16 + (d >> 5) * 4 + (key >> 4)) * 512 + (key & 15) * 32 + (d & 31); }
__device__ __forceinline__ size_t krt_off(size_t row, int col) { const size_t b = row >> 13; const int pos = (int)(row & 8191), tile = pos >> 6, key = pos & 63;
    return ((b * 128 + tile) * 8 + (col >> 3)) * 512 + key * 8 + (col & 7); }
struct EpiProj {
    static constexpr bool PERM = true;
    bf16_t *CQ, *CKV, *DQ, *DK, *DV, *G, *KR; float *ssq_q, *ssq_kv; const float* bgate; const float* rope;
    __device__ __forceinline__ void operator()(const f32x4 (&acc)[2][2][4][2], const pg8::Unit& u, int wr, int wc, int fr, int fq) const {
        const int row0 = u.pm * 256 + wr * 64 + fr, pn = u.pn, colw = wc * 32 + 8 * fq;
        if (pn < 5) {
            bf16_t* O; int ldc, ct, nsl, sl; float* ssq;
            if (pn < 3) { O = CQ; ldc = 768; ct = pn * 256; ssq = ssq_q; nsl = 12; sl = pn * 4 + wc; } else { O = CKV; ldc = 512; ct = (pn - 3) * 256; ssq = ssq_kv; nsl = 8; sl = (pn - 3) * 4 + wc; }
#pragma unroll
            for (int ai = 0; ai < 2; ++ai)
#pragma unroll
                for (int m = 0; m < 4; ++m) { const int row = row0 + ai * 128 + m * 16; float s = 0.f;
#pragma unroll
                    for (int bj = 0; bj < 2; ++bj) { const f32x4 v0 = acc[ai][bj][m][0], v1 = acc[ai][bj][m][1];
                        s += (v0[0] * v0[0] + v0[1] * v0[1]) + (v0[2] * v0[2] + v0[3] * v0[3]) + (v1[0] * v1[0] + v1[1] * v1[1]) + (v1[2] * v1[2] + v1[3] * v1[3]);
                        *(u32x4*)(O + (size_t)row * ldc + ct + bj * 128 + colw) = pack8(v0, v1); }
                    s += __shfl_xor(s, 16); s += __shfl_xor(s, 32);
                    if (fq == 0) ssq[(size_t)row * nsl + sl] = s; }
        } else if (pn < 13) {
            const bool isq = pn < 9; bf16_t* O = isq ? DQ : DK; const int ct = (pn - (isq ? 5 : 9)) * 256; const float sc = isq ? C2_DIFF : 1.0f;
            const int i0 = ((wc & 1) * 32 + 8 * fq) >> 1;
#pragma unroll
            for (int ai = 0; ai < 2; ++ai)
#pragma unroll
                for (int m = 0; m < 4; ++m) { const int row = row0 + ai * 128 + m * 16; const int pos = row & (SEQ - 1);
                    const f32x4 cs0 = *(const f32x4*)(rope + (size_t)(pos * 32 + i0) * 2), cs1 = *(const f32x4*)(rope + (size_t)(pos * 32 + i0 + 2) * 2);
#pragma unroll
                    for (int bj = 0; bj < 2; ++bj) { f32x4 v0 = acc[ai][bj][m][0], v1 = acc[ai][bj][m][1]; rope8(v0, v1, cs0, cs1, sc);
                        const int col = ct + bj * 128 + colw;
                        *(u32x4*)(O + (isq ? (size_t)row * 1024 + col : kt_off(row, col))) = pack8(v0, v1); } }
        } else if (pn < 17) {
            const int ct = (pn - 13) * 256;
#pragma unroll
            for (int ai = 0; ai < 2; ++ai)
#pragma unroll
                for (int m = 0; m < 4; ++m) { const int row = row0 + ai * 128 + m * 16;
#pragma unroll
                    for (int bj = 0; bj < 2; ++bj) *(u32x4*)(DV + vt_off(row, ct + bj * 128 + colw)) = pack8(acc[ai][bj][m][0], acc[ai][bj][m][1]); }
        } else if (pn < 33) {
            const int ct = (pn - 17) * 256;
            f32x4 bv[2][2];
#pragma unroll
            for (int bj = 0; bj < 2; ++bj) { bv[bj][0] = *(const f32x4*)(bgate + ct + bj * 128 + colw); bv[bj][1] = *(const f32x4*)(bgate + ct + bj * 128 + colw + 4); }
#pragma unroll
            for (int ai = 0; ai < 2; ++ai)
#pragma unroll
                for (int m = 0; m < 4; ++m) { const int row = row0 + ai * 128 + m * 16;
#pragma unroll
                    for (int bj = 0; bj < 2; ++bj) { f32x4 v0 = acc[ai][bj][m][0] + bv[bj][0], v1 = acc[ai][bj][m][1] + bv[bj][1];
#pragma unroll
                        for (int e = 0; e < 4; ++e) { v0[e] = sigmoidf_fast(v0[e]); v1[e] = sigmoidf_fast(v1[e]); }
                        *(u32x4*)(G + (size_t)row * 4096 + ct + bj * 128 + colw) = pack8(v0, v1); } }
        } else {
            if (wc < 2) {
                const int i0 = colw >> 1;
#pragma unroll
                for (int ai = 0; ai < 2; ++ai)
#pragma unroll
                    for (int m = 0; m < 4; ++m) { const int row = row0 + ai * 128 + m * 16; const int pos = row & (SEQ - 1);
                        const f32x4 cs0 = *(const f32x4*)(rope + (size_t)(pos * 32 + i0) * 2), cs1 = *(const f32x4*)(rope + (size_t)(pos * 32 + i0 + 2) * 2);
                        f32x4 v0 = acc[ai][0][m][0], v1 = acc[ai][0][m][1]; rope8(v0, v1, cs0, cs1, 1.0f);
                        *(u32x4*)(KR + krt_off(row, colw)) = pack8(v0, v1); }
            }
        }
    }
};

struct EpiQup {
    static constexpr bool PERM = true;
    bf16_t *QN, *QR; const float* ssq; const float* rope;
    __device__ __forceinline__ void operator()(const f32x4 (&acc)[2][2][4][2], const pg8::Unit& u, int wr, int wc, int fr, int fq) const {
        const int row0 = u.pm * 256 + wr * 64 + fr, pn = u.pn, colw = wc * 32 + 8 * fq;
        const int i0 = ((wc & 1) * 32 + 8 * fq) >> 1;
#pragma unroll
        for (int ai = 0; ai < 2; ++ai)
#pragma unroll
            for (int m = 0; m < 4; ++m) { const int row = row0 + ai * 128 + m * 16; const int pos = row & (SEQ - 1);
                const f32x4 q0 = *(const f32x4*)(ssq + (size_t)row * 12), q1 = *(const f32x4*)(ssq + (size_t)row * 12 + 4), q2 = *(const f32x4*)(ssq + (size_t)row * 12 + 8);
                const float sq = (((q0[0] + q0[1]) + (q0[2] + q0[3])) + ((q1[0] + q1[1]) + (q1[2] + q1[3]))) + ((q2[0] + q2[1]) + (q2[2] + q2[3]));
                const float sc = C2_MLA / sqrtf(sq * (1.0f / 768.0f) + EPS);
                if (pn < 4) {
#pragma unroll
                    for (int bj = 0; bj < 2; ++bj) *(u32x4*)(QN + (size_t)row * 1024 + pn * 256 + bj * 128 + colw) = pack8(acc[ai][bj][m][0] * sc, acc[ai][bj][m][1] * sc);
                } else {
                    const f32x4 cs0 = *(const f32x4*)(rope + (size_t)(pos * 32 + i0) * 2), cs1 = *(const f32x4*)(rope + (size_t)(pos * 32 + i0 + 2) * 2);
#pragma unroll
                    for (int bj = 0; bj < 2; ++bj) { f32x4 v0 = acc[ai][bj][m][0], v1 = acc[ai][bj][m][1]; rope8(v0, v1, cs0, cs1, sc);
                        *(u32x4*)(QR + (size_t)row * 512 + (pn - 4) * 256 + bj * 128 + colw) = pack8(v0, v1); }
                } }
    }
};
struct EpiKVup {
    static constexpr bool PERM = true;
    bf16_t *KN, *V; const float* ssq;
    __device__ __forceinline__ void operator()(const f32x4 (&acc)[2][2][4][2], const pg8::Unit& u, int wr, int wc, int fr, int fq) const {
        const int row0 = u.pm * 256 + wr * 64 + fr, pn = u.pn, colw = wc * 32 + 8 * fq;
        bf16_t* O = pn < 4 ? KN : V; const int ct = (pn & 3) * 256;
#pragma unroll
        for (int ai = 0; ai < 2; ++ai)
#pragma unroll
            for (int m = 0; m < 4; ++m) { const int row = row0 + ai * 128 + m * 16;
                const f32x4 q0 = *(const f32x4*)(ssq + (size_t)row * 8), q1 = *(const f32x4*)(ssq + (size_t)row * 8 + 4);
                const float sq = ((q0[0] + q0[1]) + (q0[2] + q0[3])) + ((q1[0] + q1[1]) + (q1[2] + q1[3]));
                const float sc = 1.0f / sqrtf(sq * (1.0f / 512.0f) + EPS);
#pragma unroll
                for (int bj = 0; bj < 2; ++bj) { const int col = ct + bj * 128 + colw; *(u32x4*)(O + (pn < 4 ? kt_off(row, col) : vt_off(row, col))) = pack8(acc[ai][bj][m][0] * sc, acc[ai][bj][m][1] * sc); } }
    }
};
struct EpiGate {
    static constexpr bool PERM = true;
    const bf16_t* G; bf16_t* TMP; bf16_t* MG; int second;
    __device__ __forceinline__ void operator()(const f32x4 (&acc)[2][2][4][2], const pg8::Unit& u, int wr, int wc, int fr, int fq) const {
        const int row0 = u.pm * 256 + wr * 64 + fr, colw = u.pn * 256 + wc * 32 + 8 * fq;
#pragma unroll
        for (int ai = 0; ai < 2; ++ai)
#pragma unroll
            for (int m = 0; m < 4; ++m) { const int row = row0 + ai * 128 + m * 16;
#pragma unroll
                for (int bj = 0; bj < 2; ++bj) { const int col = colw + bj * 128;
                    const u32x4 gw = *(const u32x4*)(G + (size_t)row * 4096 + (second ? 2048 : 0) + col);
                    f32x4 v0 = acc[ai][bj][m][0], v1 = acc[ai][bj][m][1];
                    v0 = (f32x4){v0[0] * bflo(gw.x), v0[1] * bfhi(gw.x), v0[2] * bflo(gw.y), v0[3] * bfhi(gw.y)};
                    v1 = (f32x4){v1[0] * bflo(gw.z), v1[1] * bfhi(gw.z), v1[2] * bflo(gw.w), v1[3] * bfhi(gw.w)};
                    if (second) { const u32x4 tw = *(const u32x4*)(TMP + (size_t)row * 2048 + col);
                        v0 += (f32x4){bflo(tw.x), bfhi(tw.x), bflo(tw.y), bfhi(tw.y)}; v1 += (f32x4){bflo(tw.z), bfhi(tw.z), bflo(tw.w), bfhi(tw.w)};
                        *(u32x4*)(MG + (size_t)row * 2048 + col) = pack8(v0, v1);
                    } else *(u32x4*)(TMP + (size_t)row * 2048 + col) = pack8(v0, v1); } }
    }
};
struct EpiGate2 {
    static constexpr bool PERM = true;
    const bf16_t* G; bf16_t* MG;
    __device__ __forceinline__ void mid(f32x4 (&acc)[2][2][4][2], const pg8::Unit& u, int wr, int wc, int fr, int fq) const {
        const int row0 = u.pm * 256 + wr * 64 + fr, colw = u.pn * 256 + wc * 32 + 8 * fq;
#pragma unroll
        for (int ai = 0; ai < 2; ++ai)
#pragma unroll
            for (int m = 0; m < 4; ++m) { const int row = row0 + ai * 128 + m * 16;
#pragma unroll
                for (int bj = 0; bj < 2; ++bj) { const int col = colw + bj * 128;
                    const u32x4 ga = *(const u32x4*)(G + (size_t)row * 4096 + col), gb = *(const u32x4*)(G + (size_t)row * 4096 + 2048 + col);
                    f32x4 r0, r1;
                    r0[0] = bflo(ga.x) * __builtin_amdgcn_rcpf(bflo(gb.x)); r0[1] = bfhi(ga.x) * __builtin_amdgcn_rcpf(bfhi(gb.x)); r0[2] = bflo(ga.y) * __builtin_amdgcn_rcpf(bflo(gb.y)); r0[3] = bfhi(ga.y) * __builtin_amdgcn_rcpf(bfhi(gb.y));
                    r1[0] = bflo(ga.z) * __builtin_amdgcn_rcpf(bflo(gb.z)); r1[1] = bfhi(ga.z) * __builtin_amdgcn_rcpf(bfhi(gb.z)); r1[2] = bflo(ga.w) * __builtin_amdgcn_rcpf(bflo(gb.w)); r1[3] = bfhi(ga.w) * __builtin_amdgcn_rcpf(bfhi(gb.w));
                    acc[ai][bj][m][0] *= r0; acc[ai][bj][m][1] *= r1; }
                asm volatile("" ::: "memory"); }
    }
    __device__ __forceinline__ void operator()(const f32x4 (&acc)[2][2][4][2], const pg8::Unit& u, int wr, int wc, int fr, int fq) const {
        const int row0 = u.pm * 256 + wr * 64 + fr, colw = u.pn * 256 + wc * 32 + 8 * fq;
#pragma unroll
        for (int ai = 0; ai < 2; ++ai)
#pragma unroll
            for (int m = 0; m < 4; ++m) { const int row = row0 + ai * 128 + m * 16;
#pragma unroll
                for (int bj = 0; bj < 2; ++bj) { const int col = colw + bj * 128;
                    const u32x4 gb = *(const u32x4*)(G + (size_t)row * 4096 + 2048 + col);
                    f32x4 v0 = acc[ai][bj][m][0], v1 = acc[ai][bj][m][1];
                    v0 = (f32x4){v0[0] * bflo(gb.x), v0[1] * bfhi(gb.x), v0[2] * bflo(gb.y), v0[3] * bfhi(gb.y)};
                    v1 = (f32x4){v1[0] * bflo(gb.z), v1[1] * bfhi(gb.z), v1[2] * bflo(gb.w), v1[3] * bfhi(gb.w)};
                    *(u32x4*)(MG + (size_t)row * 2048 + col) = pack8(v0, v1); } }
    }
};
struct EpiRes {
    static constexpr bool PERM = false;
    const float* x; float* X2; bf16_t* X2B; float* ssq;
    __device__ __forceinline__ void operator()(const f32x4 (&acc)[2][2][4][2], const pg8::Unit& u, int wr, int wc, int fr, int fq) const {
        const int row0 = u.pm * 256 + wr * 64 + fr, col0 = u.pn * 256 + wc * 32 + 4 * fq;
#pragma unroll
        for (int ai = 0; ai < 2; ++ai)
#pragma unroll
            for (int m = 0; m < 4; ++m) { const int row = row0 + ai * 128 + m * 16; float s = 0.f;
#pragma unroll
                for (int bj = 0; bj < 2; ++bj)
#pragma unroll
                    for (int n = 0; n < 2; ++n) { const size_t off = (size_t)row * 2048 + col0 + bj * 128 + n * 16;
                        const f32x4 v = acc[ai][bj][m][n] + *(const f32x4*)(x + off);
                        s += (v[0] * v[0] + v[1] * v[1]) + (v[2] * v[2] + v[3] * v[3]);
#ifdef PEER_BF16
                        *(f32x4*)(X2 + off) = v;
#endif
                        u32x2 w; w.x = cvtpk(v[0], v[1]); w.y = cvtpk(v[2], v[3]); *(u32x2*)(X2B + off) = w; }
                s += __shfl_xor(s, 16); s += __shfl_xor(s, 32);
                if (fq == 0) ssq[(size_t)row * 32 + u.pn * 4 + wc] = s; }
    }
};
__device__ __forceinline__ float sum32(const float* p) { float t = 0.f;
#pragma unroll
    for (int i = 0; i < 8; ++i) { const f32x4 q = *(const f32x4*)(p + 4 * i); t += (q[0] + q[1]) + (q[2] + q[3]); } return t; }
struct EpiQP {
    static constexpr bool PERM = true;
    bf16_t* QP; const float* ssq;
    __device__ __forceinline__ void operator()(const f32x4 (&acc)[2][2][4][2], const pg8::Unit& u, int wr, int wc, int fr, int fq) const {
        const int row0 = u.pm * 256 + wr * 64 + fr, colw = u.pn * 256 + wc * 32 + 8 * fq;
#pragma unroll
        for (int ai = 0; ai < 2; ++ai)
#pragma unroll
            for (int m = 0; m < 4; ++m) { const int row = row0 + ai * 128 + m * 16;
                const float sc = 1.0f / sqrtf(sum32(ssq + (size_t)row * 32) * (1.0f / 2048.0f) + EPS);
#pragma unroll
                for (int bj = 0; bj < 2; ++bj) *(u32x4*)(QP + (size_t)row * 2048 + colw + bj * 128) = pack8(acc[ai][bj][m][0] * sc, acc[ai][bj][m][1] * sc); }
    }
};

template <class KaF, class KbF, class VF>
__device__ __forceinline__ void naive_attn(LAS float* qs, const bf16* qa, int ldqa, int da, const bf16* qb, int ldqb, int db,
                                           KaF ka_f, KbF kb_f, VF v_f,
                                           size_t rowbase, int p0, int lane, float (&o)[4][2], float (&linv)[4]) {
    const int dt = da + db;
    for (int idx = lane; idx < 4 * dt; idx += 64) { const int r = idx / dt, d = idx - r * dt;
        const bf16 h = d < da ? qa[(rowbase + p0 + r) * ldqa + d] : qb[(rowbase + p0 + r) * ldqb + (d - da)];
        qs[r * 192 + d] = bf2f(h); }
    LDS_WAIT(); asm volatile("" ::: "memory");
    float m[4], l[4];
#pragma unroll
    for (int r = 0; r < 4; ++r) { m[r] = -INFINITY; l[r] = 0.f; o[r][0] = 0.f; o[r][1] = 0.f; }
    const int pmax = p0 + 3, ntile = pmax / 64 + 1;
#pragma unroll 1
    for (int kt = 0; kt < ntile; ++kt) {
        const int key = kt * 64 + lane, kc = key < pmax ? key : pmax;
        float s[4] = {0.f, 0.f, 0.f, 0.f};
#pragma unroll 2
        for (int d = 0; d < da; d += 8) { const u32x4 kw = *(const u32x4*)ka_f(rowbase + kc, d);
            const float k0 = bflo(kw.x), k1 = bfhi(kw.x), k2 = bflo(kw.y), k3 = bfhi(kw.y), k4 = bflo(kw.z), k5 = bfhi(kw.z), k6 = bflo(kw.w), k7 = bfhi(kw.w);
#pragma unroll
            for (int r = 0; r < 4; ++r) { const f32x4 qa4 = *(const LAS f32x4*)(qs + r * 192 + d), qb4 = *(const LAS f32x4*)(qs + r * 192 + d + 4);
                s[r] += (qa4[0] * k0 + qa4[1] * k1) + (qa4[2] * k2 + qa4[3] * k3) + (qb4[0] * k4 + qb4[1] * k5) + (qb4[2] * k6 + qb4[3] * k7); } }
        if (db > 0) {
#pragma unroll 2
            for (int d = 0; d < db; d += 8) { const u32x4 kw = *(const u32x4*)kb_f(rowbase + kc, d);
                const float k0 = bflo(kw.x), k1 = bfhi(kw.x), k2 = bflo(kw.y), k3 = bfhi(kw.y), k4 = bflo(kw.z), k5 = bfhi(kw.z), k6 = bflo(kw.w), k7 = bfhi(kw.w);
#pragma unroll
                for (int r = 0; r < 4; ++r) { const f32x4 qa4 = *(const LAS f32x4*)(qs + r * 192 + da + d), qb4 = *(const LAS f32x4*)(qs + r * 192 + da + d + 4);
                    s[r] += (qa4[0] * k0 + qa4[1] * k1) + (qa4[2] * k2 + qa4[3] * k3) + (qb4[0] * k4 + qb4[1] * k5) + (qb4[2] * k6 + qb4[3] * k7); } } }
        float p[4];
#pragma unroll
        for (int r = 0; r < 4; ++r) {
            const float sv = key > p0 + r ? -INFINITY : s[r];
            const float mn = fmaxf(m[r], wave_max(sv));
            const float al = __builtin_amdgcn_exp2f(m[r] - mn);
            p[r] = __builtin_amdgcn_exp2f(sv - mn);
            l[r] = l[r] * al + wave_sum(p[r]); o[r][0] *= al; o[r][1] *= al; m[r] = mn;
        }
        const int jn = (pmax - kt * 64) < 63 ? (pmax - kt * 64) : 63;
#pragma unroll 4
        for (int j = 0; j <= jn; ++j) {
            const float v0 = bf2f(v_f(rowbase + kt * 64 + j, lane)), v1 = bf2f(v_f(rowbase + kt * 64 + j, 64 + lane));
#pragma unroll
            for (int r = 0; r < 4; ++r) { const float pj = __builtin_bit_cast(float, __builtin_amdgcn_readlane(__builtin_bit_cast(int, p[r]), j)); o[r][0] += pj * v0; o[r][1] += pj * v1; }
        }
    }
#pragma unroll
    for (int r = 0; r < 4; ++r) linv[r] = 1.0f / l[r];
    LDS_WAIT(); asm volatile("" ::: "memory");
}
__device__ __forceinline__ void p3_attention_ref(Frame& F, const Ins& I) {
    unsigned char* ws = F.ws;
    const bf16 *QN = (const bf16*)(ws + WS_QN), *QR = (const bf16*)(ws + WS_QR), *KN = (const bf16*)(ws + WS_KN), *KR = (const bf16*)(ws + WS_KR), *V = (const bf16*)(ws + WS_V);
    const bf16 *DQ = (const bf16*)(ws + WS_DQ), *DK = (const bf16*)(ws + WS_DK), *DV = (const bf16*)(ws + WS_DV);
    bf16 *OM = (bf16*)(ws + WS_OM), *OD = (bf16*)(ws + WS_OD);
    LAS float* qs = (LAS float*)(F.lds + RING_OFF + F.wave * 4096);
    const int gw = F.vcu * NWAVES + F.wave, NGW = F.G * NWAVES, lane = F.lane;
    const float lam = ((const float*)F.ctl)[CW_LAMBDA];
    const float gs0 = I.g_subln[lane] * (1.0f - LAMBDA_INIT), gs1 = I.g_subln[64 + lane] * (1.0f - LAMBDA_INIT);
    for (int it = gw; it < 2 * 16 * (SEQ / 4); it += NGW) {
        const int type = it & 1, rest = it >> 1, bh = rest & 15, g = rest >> 4, b = bh >> 3, h = bh & 7, p0 = 4 * g;
        const size_t rowbase = (size_t)b * SEQ;
        float o[4][2], li[4];
        if (type == 0) {
            naive_attn(qs, QN + h * 128, 1024, 128, QR + h * 64, 512, 64, [=](size_t row, int d) { return KN + kt_off(row, h * 128 + d); }, [=](size_t row, int d) { return KR + krt_off(row, d); },
                       [=](size_t row, int c) { return V[vt_off(row, h * 128 + c)]; }, rowbase, p0, lane, o, li);
#pragma unroll
            for (int r = 0; r < 4; ++r) { bf16* orow = OM + (rowbase + p0 + r) * 1024 + h * 128;
#ifdef ATT_CHECK
                { const float a0 = bf2f(orow[lane]), a1 = bf2f(orow[64 + lane]), b0 = o[r][0] * li[r], b1 = o[r][1] * li[r];
                  if (fabsf(a0 - b0) > ATT_TOL_A + ATT_TOL_R * fabsf(b0) || fabsf(a1 - b1) > ATT_TOL_A + ATT_TOL_R * fabsf(b1) || !(a0 == a0) || !(a1 == a1)) atomicAdd((unsigned*)F.ctl + 16, 1u); }
#else
                orow[lane] = (bf16)(pk2(o[r][0] * li[r], 0.f) & 0xffffu); orow[64 + lane] = (bf16)(pk2(o[r][1] * li[r], 0.f) & 0xffffu);
#endif
            }
        } else {
            float o2[4][2], li2[4];
            naive_attn(qs, DQ + (h * 2) * 64, 1024, 64, DQ, 1024, 0, [=](size_t row, int d) { return DK + kt_off(row, h * 128 + d); }, [=](size_t row, int d) { return DK; },
                       [=](size_t row, int c) { return DV[vt_off(row, h * 128 + c)]; }, rowbase, p0, lane, o, li);
            naive_attn(qs, DQ + (h * 2 + 1) * 64, 1024, 64, DQ, 1024, 0, [=](size_t row, int d) { return DK + kt_off(row, h * 128 + 64 + d); }, [=](size_t row, int d) { return DK; },
                       [=](size_t row, int c) { return DV[vt_off(row, h * 128 + c)]; }, rowbase, p0, lane, o2, li2);
#pragma unroll
            for (int r = 0; r < 4; ++r) {
                const float d0 = o[r][0] * li[r] - lam * o2[r][0] * li2[r], d1 = o[r][1] * li[r] - lam * o2[r][1] * li2[r];
                const float rs = 1.0f / sqrtf(wave_sum(d0 * d0 + d1 * d1) * (1.0f / 128.0f) + EPS);
                bf16* orow = OD + (rowbase + p0 + r) * 1024 + h * 128;
#ifdef ATT_CHECK
                { const float a0 = bf2f(orow[lane]), a1 = bf2f(orow[64 + lane]), b0 = d0 * rs * gs0, b1 = d1 * rs * gs1;
                  if (fabsf(a0 - b0) > ATT_TOL_A + ATT_TOL_R * fabsf(b0) || fabsf(a1 - b1) > ATT_TOL_A + ATT_TOL_R * fabsf(b1) || !(a0 == a0) || !(a1 == a1)) atomicAdd((unsigned*)F.ctl + 17, 1u); }
#else
                orow[lane] = (bf16)(pk2(d0 * rs * gs0, 0.f) & 0xffffu); orow[64 + lane] = (bf16)(pk2(d1 * rs * gs1, 0.f) & 0xffffu);
#endif
            }
        }
    }
}

namespace att {
typedef short bf16x8 __attribute__((ext_vector_type(8)));
typedef short s16x4 __attribute__((ext_vector_type(4)));
typedef float f32x16 __attribute__((ext_vector_type(16)));
typedef short v4i16_t __attribute__((ext_vector_type(4)));
#ifndef ATT_PF2
#define ATT_PF2 1
#endif
constexpr int BUFB = 40960, WSF_OFF = (ATT_PF2 ? 3 : 2) * BUFB;
#ifndef ATT_KD
#define ATT_KD 2
#endif
#ifndef ATT_VD
#define ATT_VD 2
#endif
__device__ __forceinline__ int crow(int r, int hi) { return (r & 3) + 8 * (r >> 2) + 4 * hi; }
__device__ __forceinline__ s16x4 vtr(const LAS unsigned char* p) { return __builtin_bit_cast(s16x4, __builtin_amdgcn_ds_read_tr16_b64_v4i16((LAS v4i16_t*)p)); }
__device__ __forceinline__ float max3f(float a, float b, float c) { float r; asm("v_max3_f32 %0, %1, %2, %3" : "=v"(r) : "v"(a), "v"(b), "v"(c)); return r; }
__device__ __forceinline__ float max2f(float a, float b) { float r; asm("v_max_f32_e32 %0, %1, %2" : "=v"(r) : "v"(a), "v"(b)); return r; }
__device__ __forceinline__ float swapmax(float m) { auto rr = __builtin_amdgcn_permlane32_swap(__float_as_uint(m), __float_as_uint(m), false, false);
    const unsigned a = rr[0], b = rr[1]; return fmaxf(__uint_as_float(a), __uint_as_float(b)); }
__device__ __forceinline__ float swapsum(float m) { auto rr = __builtin_amdgcn_permlane32_swap(__float_as_uint(m), __float_as_uint(m), false, false);
    const unsigned a = rr[0], b = rr[1]; return __uint_as_float(a) + __uint_as_float(b); }

template <bool DIFF>
__device__ __forceinline__ void attn_unit(LAS unsigned char* lds, int tid, size_t rowbase, int h, int q0,
                                          const bf16* Qa, const bf16* Qb, const bf16* Ka, const bf16* Kb, const bf16* Vp, bf16* Op, float lam, const float* gsub) {
    constexpr int NP = DIFF ? 4 : 5, NKS = DIFF ? 4 : 12, KPIECES = DIFF ? 16 : 24, R = DIFF ? 128 : 256;
    const int lane = tid & 63, r32 = lane & 31, hi = lane >> 5, wid = __builtin_amdgcn_readfirstlane(tid >> 6);
    const int mp = DIFF ? (wid >> 2) : 0, rows_w0 = q0 + 32 * (DIFF ? (wid & 3) : wid);
    const char* src[NP]; unsigned tstr[NP]; unsigned dsto[NP];
#pragma unroll
    for (int i = 0; i < NP; ++i) { const int pidx = wid * NP + i;
        const size_t bhb = ((size_t)(rowbase >> 13) * 8 + h) * 128 * 16384, krb = (size_t)(rowbase >> 13) * 128 * 8192;
        if (!DIFF) {
            if (pidx < 16) { src[i] = (const char*)Ka + bhb + pidx * 1024 + lane * 16; tstr[i] = 16384; dsto[i] = pidx * 1024; }
            else if (pidx < 24) { src[i] = (const char*)Kb + krb + (pidx - 16) * 1024 + lane * 16; tstr[i] = 8192; dsto[i] = pidx * 1024; }
            else { src[i] = (const char*)Vp + bhb + (pidx - 24) * 1024 + lane * 16; tstr[i] = 16384; dsto[i] = pidx * 1024; }
        } else {
            if (pidx < 16) { src[i] = (const char*)Ka + bhb + pidx * 1024 + lane * 16; tstr[i] = 16384; dsto[i] = pidx * 1024; }
            else { src[i] = (const char*)Vp + bhb + (pidx - 16) * 1024 + lane * 16; tstr[i] = 16384; dsto[i] = pidx * 1024; }
        } }
    const unsigned lds0 = (unsigned)(uintptr_t)lds;
#define ATT_DMA(t, bb) do { _Pragma("unroll") for (int _i = 0; _i < NP; ++_i) { unsigned _keep; const unsigned _dst = (unsigned)__builtin_amdgcn_readfirstlane((int)(lds0 + (unsigned)((bb) * BUFB) + dsto[_i])); \
        asm volatile("s_mov_b32 %0, m0\n\ts_mov_b32 m0, %2\n\ts_nop 0\n\tglobal_load_lds_dwordx4 %1, off\n\ts_mov_b32 m0, %0" : "=&s"(_keep) : "v"(src[_i] + (size_t)(t) * tstr[_i]), "s"(_dst) : "memory"); } } while (0)
    bf16x8 qf[NKS];
    { const size_t qrow = rowbase + rows_w0 + r32;
#pragma unroll
      for (int ks = 0; ks < NKS; ++ks) {
          if (DIFF) qf[ks] = *(const bf16x8*)(Qa + qrow * 1024 + (h * 2 + mp) * 64 + ks * 16 + hi * 8);
          else if (ks < 8) qf[ks] = *(const bf16x8*)(Qa + qrow * 1024 + h * 128 + ks * 16 + hi * 8);
          else qf[ks] = *(const bf16x8*)(Qb + qrow * 512 + h * 64 + (ks - 8) * 16 + hi * 8);
      } }
    f32x16 o[4];
#pragma unroll
    for (int d0 = 0; d0 < 4; ++d0) o[d0] = f32x16{};
    float m = -1e30f, l = 0.f;
    const int NT = (q0 + R) / 64, t_last = (rows_w0 + 31) / 64;
    LAS float* wsf = (LAS float*)(lds + WSF_OFF) + wid * 32;
    const int koff = (DIFF ? mp * 8 * 1024 : 0) + hi * 1024 + r32 * 16;
    const int voff = KPIECES * 1024 + ((lane >> 4) & 1) * 32 + (lane & 3) * 8 + (4 * hi + ((lane & 15) >> 2)) * 64;
    const int qpos = rows_w0 + r32;
    ATT_DMA(0, 0);
#if ATT_PF2
    ATT_DMA(1, 1);
#endif
    __builtin_amdgcn_s_waitcnt(0x0F70);
    asm volatile("s_waitcnt vmcnt(0)" ::: "memory"); __syncthreads();
#if ATT_PF2
    int bcur = 0;
#endif
#pragma unroll 1
    for (int t = 0; t < NT; ++t) {
#if ATT_PF2
        const int bb = bcur; const bool more = t + 2 < NT;
        if (more) ATT_DMA(t + 2, (bcur == 0) ? 2 : bcur - 1);
#else
        const int bb = t & 1;
        if (t + 1 < NT) ATT_DMA(t + 1, bb ^ 1);
#endif
        if (t <= t_last) {
            const LAS unsigned char* kb = lds + bb * BUFB + koff;
            f32x16 p0 = f32x16{}, p1 = f32x16{};
            {
                bf16x8 kfa[NKS], kfc[NKS];
#pragma unroll
                for (int ks = 0; ks < ATT_KD; ++ks) { kfa[ks] = *(const LAS bf16x8*)(kb + ks * 2048); kfc[ks] = *(const LAS bf16x8*)(kb + ks * 2048 + 512); }
                __builtin_amdgcn_sched_barrier(0);
#pragma unroll
                for (int ks = 0; ks < NKS; ++ks) {
                    if (ks + ATT_KD < NKS) { kfa[ks + ATT_KD] = *(const LAS bf16x8*)(kb + (ks + ATT_KD) * 2048); kfc[ks + ATT_KD] = *(const LAS bf16x8*)(kb + (ks + ATT_KD) * 2048 + 512); }
                    __builtin_amdgcn_sched_barrier(0);
                    p0 = __builtin_amdgcn_mfma_f32_32x32x16_bf16(kfa[ks], qf[ks], p0, 0, 0, 0);
                    p1 = __builtin_amdgcn_mfma_f32_32x32x16_bf16(kfc[ks], qf[ks], p1, 0, 0, 0);
                    __builtin_amdgcn_sched_barrier(0);
                }
            }
            if (64 * t + 63 > rows_w0) {
                const int kb0 = 64 * t + 4 * hi;
#pragma unroll
                for (int r = 0; r < 16; ++r) { const int kv = kb0 + (r & 3) + 8 * (r >> 2); if (kv > qpos) p0[r] = -INFINITY; if (kv + 32 > qpos) p1[r] = -INFINITY; }
            }
            asm volatile("s_nop 15\n\ts_nop 7" : "+v"(p0), "+v"(p1));
            float rm = max3f(p0[0], p0[1], p1[0]), rm2 = max3f(p0[2], p0[3], p1[1]); rm = max3f(rm, p1[2], p1[3]);
#pragma unroll
            for (int r = 4; r < 16; r += 4) { rm = max3f(rm, p0[r], p0[r + 1]); rm2 = max3f(rm2, p0[r + 2], p0[r + 3]); rm = max3f(rm, p1[r], p1[r + 1]); rm2 = max3f(rm2, p1[r + 2], p1[r + 3]); }
            rm = swapmax(max2f(rm, rm2));
            const float mn = fmaxf(m, rm);
            if (__any(mn > m)) {
                const float al = __builtin_amdgcn_exp2f(m - mn);
                l *= al;
                if (hi == 0) wsf[r32] = al;
                LDS_WAIT(); asm volatile("" ::: "memory");
#pragma unroll
                for (int r = 0; r < 16; ++r) { const float a = wsf[crow(r, hi)];
#pragma unroll
                    for (int d0 = 0; d0 < 4; ++d0) o[d0][r] *= a; }
                LDS_WAIT(); asm volatile("" ::: "memory");
            }
            m = mn;
            float ps = 0.f;
#pragma unroll
            for (int r = 0; r < 16; ++r) { p0[r] = __builtin_amdgcn_exp2f(p0[r] - mn); p1[r] = __builtin_amdgcn_exp2f(p1[r] - mn); ps += p0[r] + p1[r]; }
            l += ps;
            u32x4 pw[4];
            pw[0] = (u32x4){cvtpk(p0[0], p0[1]), cvtpk(p0[2], p0[3]), cvtpk(p0[4], p0[5]), cvtpk(p0[6], p0[7])};
            pw[1] = (u32x4){cvtpk(p0[8], p0[9]), cvtpk(p0[10], p0[11]), cvtpk(p0[12], p0[13]), cvtpk(p0[14], p0[15])};
            pw[2] = (u32x4){cvtpk(p1[0], p1[1]), cvtpk(p1[2], p1[3]), cvtpk(p1[4], p1[5]), cvtpk(p1[6], p1[7])};
            pw[3] = (u32x4){cvtpk(p1[8], p1[9]), cvtpk(p1[10], p1[11]), cvtpk(p1[12], p1[13]), cvtpk(p1[14], p1[15])};
            const LAS unsigned char* vb = lds + bb * BUFB + voff;
            {
                s16x4 vlo[16], vhh[16];
#pragma unroll
                for (int i = 0; i < ATT_VD; ++i) { vlo[i] = vtr(vb + i * 1024); vhh[i] = vtr(vb + i * 1024 + 512); }
                __builtin_amdgcn_sched_barrier(0);
#pragma unroll
                for (int i = 0; i < 16; ++i) {
                    if (i + ATT_VD < 16) { vlo[i + ATT_VD] = vtr(vb + (i + ATT_VD) * 1024); vhh[i + ATT_VD] = vtr(vb + (i + ATT_VD) * 1024 + 512); }
                    __builtin_amdgcn_sched_barrier(0);
                    const bf16x8 vf = (bf16x8){vlo[i][0], vlo[i][1], vlo[i][2], vlo[i][3], vhh[i][0], vhh[i][1], vhh[i][2], vhh[i][3]};
                    o[i >> 2] = __builtin_amdgcn_mfma_f32_32x32x16_bf16(__builtin_bit_cast(bf16x8, pw[i & 3]), vf, o[i >> 2], 0, 0, 0);
                    __builtin_amdgcn_sched_barrier(0);
                }
            }
        }
#if ATT_PF2
        if (more) asm volatile("s_waitcnt vmcnt(%0)" :: "n"(NP) : "memory"); else asm volatile("s_waitcnt vmcnt(0)" ::: "memory");
        __syncthreads();
        bcur = (bcur == 2) ? 0 : bcur + 1;
#else
        asm volatile("s_waitcnt vmcnt(0)" ::: "memory"); __syncthreads();
#endif
    }
#undef ATT_DMA
    l = swapsum(l);
    if (hi == 0) wsf[r32] = l;
    LDS_WAIT(); asm volatile("" ::: "memory");
    float rli[16];
#pragma unroll
    for (int r = 0; r < 16; ++r) rli[r] = 1.0f / wsf[crow(r, hi)];
    LDS_WAIT(); asm volatile("" ::: "memory");
    if (!DIFF) {
#pragma unroll
        for (int r = 0; r < 16; ++r) { bf16* orow = Op + (rowbase + rows_w0 + crow(r, hi)) * 1024 + h * 128 + r32;
#pragma unroll
            for (int d0 = 0; d0 < 4; ++d0) orow[d0 * 32] = (bf16)(cvtpk(o[d0][r] * rli[r], 0.f) & 0xffffu); }
    } else {
        LAS float* xch = (LAS float*)lds;
        if (wid >= 4) {
#pragma unroll
            for (int d0 = 0; d0 < 4; ++d0)
#pragma unroll
                for (int r = 0; r < 16; ++r) xch[((wid & 3) * 64 + d0 * 16 + r) * 64 + lane] = o[d0][r] * rli[r];
        }
        __syncthreads();
        if (wid < 4) {
            float ss[16];
#pragma unroll
            for (int r = 0; r < 16; ++r) ss[r] = 0.f;
#pragma unroll
            for (int d0 = 0; d0 < 4; ++d0)
#pragma unroll
                for (int r = 0; r < 16; ++r) { const float d = o[d0][r] * rli[r] - lam * xch[(wid * 64 + d0 * 16 + r) * 64 + lane]; o[d0][r] = d; ss[r] += d * d; }
#pragma unroll
            for (int r = 0; r < 16; ++r) {
#pragma unroll
                for (int of = 1; of < 32; of <<= 1) ss[r] += __shfl_xor(ss[r], of);
                ss[r] = 1.0f / sqrtf(ss[r] * (1.0f / 128.0f) + EPS); }
            float g4[4];
#pragma unroll
            for (int d0 = 0; d0 < 4; ++d0) g4[d0] = gsub[d0 * 32 + r32] * (1.0f - LAMBDA_INIT);
#pragma unroll
            for (int r = 0; r < 16; ++r) { bf16* orow = Op + (rowbase + rows_w0 + crow(r, hi)) * 1024 + h * 128 + r32;
#pragma unroll
                for (int d0 = 0; d0 < 4; ++d0) orow[d0 * 32] = (bf16)(cvtpk(o[d0][r] * ss[r] * g4[d0], 0.f) & 0xffffu); }
        }
        __syncthreads();
    }
}
}

__device__ __forceinline__ void p3_attention(Frame& F, const Ins& I) {
    unsigned char* ws = F.ws;
    const bf16 *QN = (const bf16*)(ws + WS_QN), *QR = (const bf16*)(ws + WS_QR), *KN = (const bf16*)(ws + WS_KN), *KR = (const bf16*)(ws + WS_KR), *V = (const bf16*)(ws + WS_V);
    const bf16 *DQ = (const bf16*)(ws + WS_DQ), *DK = (const bf16*)(ws + WS_DK), *DV = (const bf16*)(ws + WS_DV);
    bf16 *OM = (bf16*)(ws + WS_OM), *OD = (bf16*)(ws + WS_OD);
    const float lam = ((const float*)F.ctl)[CW_LAMBDA];
    LAS unsigned char* lds = F.lds + RING_OFF;
    for (int v = F.vcu; v < 256; v += F.G) {
        const int bh = v >> 4, c = v & 15, b = bh >> 3, h = bh & 7; const size_t rowbase = (size_t)b * SEQ;
        att::attn_unit<false>(lds, F.tid, rowbase, h, (31 - c) * 256, QN, QR, KN, KR, V, OM, lam, I.g_subln);
        att::attn_unit<true>(lds, F.tid, rowbase, h, (63 - c) * 128, DQ, nullptr, DK, nullptr, DV, OD, lam, I.g_subln);
        att::attn_unit<true>(lds, F.tid, rowbase, h, (47 - c) * 128, DQ, nullptr, DK, nullptr, DV, OD, lam, I.g_subln);
        att::attn_unit<true>(lds, F.tid, rowbase, h, (16 + c) * 128, DQ, nullptr, DK, nullptr, DV, OD, lam, I.g_subln);
        att::attn_unit<true>(lds, F.tid, rowbase, h, c * 128, DQ, nullptr, DK, nullptr, DV, OD, lam, I.g_subln);
        att::attn_unit<false>(lds, F.tid, rowbase, h, c * 256, QN, QR, KN, KR, V, OM, lam, I.g_subln);
    }
}

__device__ __forceinline__ void wave_argmax(float v, int idx, float& mv, int& mi) {
#pragma unroll
    for (int o = 1; o < 64; o <<= 1) { const float ov = __shfl_xor(v, o); const int oi = __shfl_xor(idx, o); if (ov > v || (ov == v && oi < idx)) { v = ov; idx = oi; } }
    mv = v; mi = idx;
}
__device__ __forceinline__ void p7_routing_ref(Frame& F) {
    unsigned char* ws = F.ws;
    const bf16* QP = (const bf16*)(ws + WS_QP); const bf16* SKB = (const bf16*)(ws + WS_SKB);
    int* IDX = (int*)(ws + WS_IDX); float* GT = (float*)(ws + WS_GT);
    LAS float* wl = (LAS float*)(F.lds + RING_OFF + F.wave * 4096);
    LAS float* qs = wl; LAS float* v1s = wl + 256; LAS int* i1s = (LAS int*)(wl + 272); LAS float* v2s = wl + 288; LAS int* i2s = (LAS int*)(wl + 304);
    const int gw = F.vcu * NWAVES + F.wave, NGW = F.G * NWAVES, lane = F.lane;
    for (int it = gw; it < T * 8; it += NGW) {
        { const u32x2 w = *(const u32x2*)(QP + (size_t)it * 256 + lane * 4); qs[lane * 4 + 0] = bflo(w.x); qs[lane * 4 + 1] = bfhi(w.x); qs[lane * 4 + 2] = bflo(w.y); qs[lane * 4 + 3] = bfhi(w.y); }
        LDS_WAIT(); asm volatile("" ::: "memory");
        float sc[2][2];
#pragma unroll
        for (int hf = 0; hf < 2; ++hf)
#pragma unroll
            for (int kk = 0; kk < 2; ++kk) { const bf16* kr = SKB + (size_t)(hf * 128 + kk * 64 + lane) * 256 + hf * 128; float s = 0.f;
#pragma unroll 4
                for (int d = 0; d < 128; d += 8) { const u32x4 kw = *(const u32x4*)(kr + d);
                    const f32x4 qa4 = *(const LAS f32x4*)(qs + hf * 128 + d), qb4 = *(const LAS f32x4*)(qs + hf * 128 + d + 4);
                    s += (qa4[0] * bflo(kw.x) + qa4[1] * bfhi(kw.x)) + (qa4[2] * bflo(kw.y) + qa4[3] * bfhi(kw.y)) + (qb4[0] * bflo(kw.z) + qb4[1] * bfhi(kw.z)) + (qb4[2] * bflo(kw.w) + qb4[3] * bfhi(kw.w)); }
                sc[hf][kk] = s; }
#pragma unroll
        for (int hf = 0; hf < 2; ++hf) {
            float a = sc[hf][0], b = sc[hf][1];
            for (int r = 0; r < 16; ++r) {
                float lv; int li; if (b > a) { lv = b; li = lane + 64; } else { lv = a; li = lane; }
                float mv; int mi; wave_argmax(lv, li, mv, mi);
                if (mi == lane) a = -INFINITY; if (mi == lane + 64) b = -INFINITY;
                if (lane == 0) { if (hf == 0) { v1s[r] = mv; i1s[r] = mi; } else { v2s[r] = mv; i2s[r] = mi; } }
            }
        }
        LDS_WAIT(); asm volatile("" ::: "memory");
        float cv[4];
#pragma unroll
        for (int j = 0; j < 4; ++j) { const int c = lane * 4 + j; cv[j] = v1s[c >> 4] + v2s[c & 15]; }
        float mycs = 0.f; int myc = 0;
        for (int r = 0; r < 16; ++r) {
            float lv = cv[0]; int li = lane * 4;
#pragma unroll
            for (int j = 1; j < 4; ++j) if (cv[j] > lv) { lv = cv[j]; li = lane * 4 + j; }
            float mv; int mi; wave_argmax(lv, li, mv, mi);
#pragma unroll
            for (int j = 0; j < 4; ++j) if (mi == lane * 4 + j) cv[j] = -INFINITY;
            if (lane == r) { mycs = mv; myc = mi; }
        }
        float mx = mycs;
#pragma unroll
        for (int o = 1; o < 16; o <<= 1) mx = fmaxf(mx, __shfl_xor(mx, o));
        const float e = __expf(mycs - mx); float se = e;
#pragma unroll
        for (int o = 1; o < 16; o <<= 1) se += __shfl_xor(se, o);
        if (lane < 16) { const int ex = i1s[myc >> 4] * 128 + i2s[myc & 15];
            IDX[(size_t)it * 16 + lane] = ex; GT[(size_t)it * 16 + lane] = e / se; }
        LDS_WAIT(); asm volatile("" ::: "memory");
    }
}

__device__ __forceinline__ void unpack8(const u32x4 w, float (&f)[8]) { f[0] = bflo(w.x); f[1] = bfhi(w.x); f[2] = bflo(w.y); f[3] = bfhi(w.y); f[4] = bflo(w.z); f[5] = bfhi(w.z); f[6] = bflo(w.w); f[7] = bfhi(w.w); }
__device__ __forceinline__ void p8_gather(Frame& F, const Ins& I, float* out) {
    unsigned char* ws = F.ws;
    const float* X2 = (const float*)(ws + WS_X2); const bf16* EU = (const bf16*)(ws + WS_EU); const bf16* EV = (const bf16*)(ws + WS_EV);
    const int* IDX = (const int*)(ws + WS_IDX); const float* GT = (const float*)(ws + WS_GT);
    const float* ssq2 = (const float*)(ws + WS_PSQ2);
    const int gw = F.vcu * NWAVES + F.wave, NGW = F.G * NWAVES, lane = F.lane;
    for (int t = gw; t < T; t += NGW) {
        float xv[4][8], acc[4][8];
#pragma unroll
        for (int j = 0; j < 4; ++j) { const f32x4 a = *(const f32x4*)(X2 + (size_t)t * 2048 + 512 * j + 8 * lane), b = *(const f32x4*)(X2 + (size_t)t * 2048 + 512 * j + 8 * lane + 4);
            xv[j][0] = a[0]; xv[j][1] = a[1]; xv[j][2] = a[2]; xv[j][3] = a[3]; xv[j][4] = b[0]; xv[j][5] = b[1]; xv[j][6] = b[2]; xv[j][7] = b[3];
#pragma unroll
            for (int e = 0; e < 8; ++e) acc[j][e] = 0.f; }
        const float rstd2 = 1.0f / sqrtf(sum32(ssq2 + (size_t)t * 32) * (1.0f / 2048.0f) + EPS);
        const int id0 = IDX[(size_t)t * 128 + lane], id1 = IDX[(size_t)t * 128 + 64 + lane];
        const float g0 = GT[(size_t)t * 128 + lane], g1 = GT[(size_t)t * 128 + 64 + lane];
        for (int i = 0; i < 128; ++i) {
            const int ex = __builtin_amdgcn_readlane(i < 64 ? id0 : id1, i & 63);
            const float gate = __builtin_bit_cast(float, __builtin_amdgcn_readlane(__builtin_bit_cast(int, i < 64 ? g0 : g1), i & 63));
            const bf16* ur = EU + (size_t)ex * 2048 + 8 * lane; const bf16* vr = EV + (size_t)ex * 2048 + 8 * lane;
            u32x4 uw[4], vw[4];
#pragma unroll
            for (int j = 0; j < 4; ++j) { uw[j] = *(const u32x4*)(ur + 512 * j); vw[j] = *(const u32x4*)(vr + 512 * j); }
            float dot = 0.f;
#pragma unroll
            for (int j = 0; j < 4; ++j) { float f[8]; unpack8(uw[j], f);
#pragma unroll
                for (int e = 0; e < 8; ++e) dot += f[e] * xv[j][e]; }
            const float a = wave_sum(dot) * rstd2;
            const float z2 = 1.5957691216057308f * (a + 0.044715f * a * a * a);
            const float w = gate * a * __builtin_amdgcn_rcpf(1.0f + __builtin_amdgcn_exp2f(-z2 * LOG2E));
#pragma unroll
            for (int j = 0; j < 4; ++j) { float f[8]; unpack8(vw[j], f);
#pragma unroll
                for (int e = 0; e < 8; ++e) acc[j][e] += w * f[e]; }
        }
        float s = 0.f;
#pragma unroll
        for (int j = 0; j < 4; ++j)
#pragma unroll
            for (int e = 0; e < 8; ++e) { acc[j][e] += xv[j][e]; s += acc[j][e] * acc[j][e]; }
        float rs = 1.0f / sqrtf(wave_sum(s) * (1.0f / 2048.0f) + EPS);
#ifdef ATT_CHECK
        if (((const unsigned*)F.ctl)[ATT_CHECK_WORD] > ATT_CHECK_MAX) rs = __builtin_nanf("");
#endif
#pragma unroll
        for (int j = 0; j < 4; ++j) { const f32x4 ga = *(const f32x4*)(I.g_final + 512 * j + 8 * lane), gb = *(const f32x4*)(I.g_final + 512 * j + 8 * lane + 4);
            *(f32x4*)(out + (size_t)t * 2048 + 512 * j + 8 * lane) = (f32x4){acc[j][0] * rs * ga[0], acc[j][1] * rs * ga[1], acc[j][2] * rs * ga[2], acc[j][3] * rs * ga[3]};
            *(f32x4*)(out + (size_t)t * 2048 + 512 * j + 8 * lane + 4) = (f32x4){acc[j][4] * rs * gb[0], acc[j][5] * rs * gb[1], acc[j][6] * rs * gb[2], acc[j][7] * rs * gb[3]}; }
    }
}

namespace rt {
typedef short bf16x8 __attribute__((ext_vector_type(8)));
typedef float f32x16 __attribute__((ext_vector_type(16)));
__device__ __forceinline__ unsigned f2sort(float f) { const unsigned u = __float_as_uint(f); return u ^ ((unsigned)((int)u >> 31) | 0x80000000u); }
__device__ __forceinline__ float sort2f(unsigned s) { return __uint_as_float(s ^ ((s >> 31) ? 0x80000000u : 0xFFFFFFFFu)); }
__device__ __forceinline__ unsigned umax(unsigned a, unsigned b) { return a > b ? a : b; }
__device__ __forceinline__ unsigned pair_max(unsigned m) { auto rr = __builtin_amdgcn_permlane32_swap(m, m, false, false); const unsigned a = rr[0], b = rr[1]; return umax(a, b); }
constexpr int KEYS_BYTES = 65536, LIST_OFF = KEYS_BYTES, LIST_WAVE = 6144 + 512;
}
__device__ __forceinline__ void rt_load_keys(Frame& F, const Ins& I) {
    LAS unsigned char* lds = F.lds + RING_OFF;
    for (int it = F.tid; it < 2 * 128 * 16; it += NWAVES * 64) {
        const int c = it & 15, n = (it >> 4) & 127, hf = it >> 11;
        const float* sp = I.sub_keys + (size_t)hf * 16384 + n * 128 + c * 8;
        const f32x4 a = *(const f32x4*)sp, b = *(const f32x4*)(sp + 4);
        v4u o; o.x = pk2(a.x, a.y); o.y = pk2(a.z, a.w); o.z = pk2(b.x, b.y); o.w = pk2(b.z, b.w);
        *(LAS v4u*)(lds + hf * 32768 + c * 2048 + n * 16) = o;
    }
    __syncthreads();
}
template <bool TO_LDS>
__device__ __forceinline__ void rt_task(Frame& F, int task, LAS unsigned* lst) {
    using namespace rt;
    unsigned char* ws = F.ws;
    const bf16* QP = (const bf16*)(ws + WS_QP);
    int* IDX = (int*)(ws + WS_IDX); float* GT = (float*)(ws + WS_GT);
    LAS unsigned char* lds = F.lds + RING_OFF;
    const int lane = F.lane, r32 = lane & 31, hi = lane >> 5;
        const size_t row = (size_t)task * 32 + r32;
#pragma unroll 1
        for (int hf = 0; hf < 2; ++hf) {
            bf16x8 qf[8];
#pragma unroll
            for (int ks = 0; ks < 8; ++ks) qf[ks] = *(const bf16x8*)(QP + row * 256 + hf * 128 + ks * 16 + hi * 8);
            unsigned k[64];
            const LAS unsigned char* kb0 = lds + hf * 32768 + hi * 2048 + r32 * 16;
#pragma unroll
            for (int kb = 0; kb < 4; ++kb) {
                f32x16 acc = f32x16{};
#pragma unroll
                for (int ks = 0; ks < 8; ++ks) acc = __builtin_amdgcn_mfma_f32_32x32x16_bf16(*(const LAS bf16x8*)(kb0 + ks * 4096 + kb * 512), qf[ks], acc, 0, 0, 0);
#pragma unroll
                for (int r = 0; r < 16; ++r) { const int n = 32 * kb + (r & 3) + 8 * (r >> 2) + 4 * hi; k[16 * kb + r] = (f2sort(acc[r]) & ~0x7Fu) | (unsigned)(127 - n); }
            }
#pragma unroll 1
            for (int rd = 0; rd < 16; ++rd) {
                unsigned m = k[0];
#pragma unroll
                for (int i = 1; i < 64; ++i) m = umax(m, k[i]);
                const unsigned g = pair_max(m);
#pragma unroll
                for (int i = 0; i < 64; ++i) k[i] = (k[i] == g) ? 0u : k[i];
                if (hi == 0) lst[hf * 16 + rd] = g;
            }
        }
        LDS_WAIT(); asm volatile("" ::: "memory");
        float v1[16], v2[16];
#pragma unroll
        for (int q = 0; q < 4; ++q) { const v4u a = *(const LAS v4u*)(lst + 4 * q), b = *(const LAS v4u*)(lst + 16 + 4 * q);
#pragma unroll
            for (int e = 0; e < 4; ++e) { v1[4 * q + e] = sort2f(a[e] & ~0x7Fu); v2[4 * q + e] = sort2f(b[e] & ~0x7Fu); } }
        unsigned cand[50];
        { int ci = 0;
#pragma unroll
          for (int a = 0; a < 16; ++a)
#pragma unroll
              for (int b = 0; b < 16; ++b) if ((a + 1) * (b + 1) <= 16) { cand[ci] = (f2sort(v1[a] + v2[b]) & ~0xFFu) | (unsigned)(255 - (a * 16 + b)); ++ci; } }
#pragma unroll 1
        for (int rd = 0; rd < 16; ++rd) {
            unsigned m = cand[0];
#pragma unroll
            for (int i = 1; i < 50; ++i) m = umax(m, cand[i]);
#pragma unroll
            for (int i = 0; i < 50; ++i) cand[i] = (cand[i] == m) ? 0u : cand[i];
            if (hi == 0) lst[32 + rd] = m;
        }
        LDS_WAIT(); asm volatile("" ::: "memory");
        const float cmax = sort2f(lst[32] & ~0xFFu);
        float ev[8]; int ex[8]; float se = 0.f;
#pragma unroll
        for (int j = 0; j < 8; ++j) { const unsigned key = lst[32 + 8 * hi + j]; const int ab = 255 - (int)(key & 0xFFu);
            const int i1 = 127 - (int)(lst[ab >> 4] & 0x7Fu), i2 = 127 - (int)(lst[16 + (ab & 15)] & 0x7Fu);
            ex[j] = i1 * 128 + i2; ev[j] = __expf(sort2f(key & ~0xFFu) - cmax); se += ev[j]; }
        { auto rr = __builtin_amdgcn_permlane32_swap(__float_as_uint(se), __float_as_uint(se), false, false); const unsigned a = rr[0], b = rr[1]; se = __uint_as_float(a) + __uint_as_float(b); }
        const float inv = 1.0f / se;
        if (TO_LDS) {
#pragma unroll
            for (int j = 0; j < 8; ++j) { lst[8 * hi + j] = (unsigned)ex[j]; lst[16 + 8 * hi + j] = __float_as_uint(ev[j] * inv); }
        } else {
        int* ip = IDX + row * 16 + 8 * hi; float* gp = GT + row * 16 + 8 * hi;
        *(GAS v4u*)ip = (v4u){(unsigned)ex[0], (unsigned)ex[1], (unsigned)ex[2], (unsigned)ex[3]}; *(GAS v4u*)(ip + 4) = (v4u){(unsigned)ex[4], (unsigned)ex[5], (unsigned)ex[6], (unsigned)ex[7]};
        *(GAS f32x4*)gp = (f32x4){ev[0] * inv, ev[1] * inv, ev[2] * inv, ev[3] * inv}; *(GAS f32x4*)(gp + 4) = (f32x4){ev[4] * inv, ev[5] * inv, ev[6] * inv, ev[7] * inv};
        }
        LDS_WAIT(); asm volatile("" ::: "memory");
}
__device__ __forceinline__ void p8_routing(Frame& F, const Ins& I) {
    using namespace rt;
    rt_load_keys(F, I);
    LAS unsigned* lst = (LAS unsigned*)(F.lds + RING_OFF + LIST_OFF + F.wave * LIST_WAVE) + (F.lane & 31) * 48;
    const int gw = F.vcu * NWAVES + F.wave, NGW = F.G * NWAVES;
    for (int task = gw; task < T * 8 / 32; task += NGW) rt_task<false>(F, task, lst);
}
constexpr float EU_SCALE = 64.0f, EV_SCALE = 4.0f;
typedef float f32x2v __attribute__((ext_vector_type(2)));
__device__ __forceinline__ unsigned pk4_fp8(float a, float b, float c, float d) { int t = __builtin_amdgcn_cvt_pk_fp8_f32(a, b, 0, false); t = __builtin_amdgcn_cvt_pk_fp8_f32(c, d, t, true); return (unsigned)t; }
__device__ __forceinline__ void convert_experts_fp8(Frame& F, const Ins& I) {
    const size_t gt = (size_t)(F.vcu * NWAVES * 64) + F.tid, NT = (size_t)F.G * NWAVES * 64;
    const size_t nchunk = (size_t)NEXP * D_MODEL / 16;
    unsigned char* EU = F.ws + WS_EU; unsigned char* EV = F.ws + WS_EV;
    for (size_t c = gt; c < nchunk; c += NT) {
        const int d = (int)((c * 16) & (D_MODEL - 1));
        v4u o, p;
#pragma unroll
        for (int k = 0; k < 4; ++k) {
            const f32x4 a = *(const GAS f32x4*)(I.expert_u + c * 16 + 4 * k), g = *(const f32x4*)(I.g_norm2 + d + 4 * k), b = *(const GAS f32x4*)(I.expert_v + c * 16 + 4 * k);
            o[k] = pk4_fp8(a.x * g.x * EU_SCALE, a.y * g.y * EU_SCALE, a.z * g.z * EU_SCALE, a.w * g.w * EU_SCALE);
            p[k] = pk4_fp8(b.x * EV_SCALE, b.y * EV_SCALE, b.z * EV_SCALE, b.w * EV_SCALE);
        }
        *(GAS v4u*)(EU + c * 16) = o; *(GAS v4u*)(EV + c * 16) = p;
    }
}
#ifndef PEER_FP8
#define PEER_FP6 1
#endif
#ifdef PEER_FP6
typedef float v32f_t __attribute__((ext_vector_type(32)));
typedef float v16f_t __attribute__((ext_vector_type(16)));
typedef unsigned v6u_t __attribute__((ext_vector_type(6)));
constexpr int EROW = 1536;
__device__ __forceinline__ void convert_experts_fp6(Frame& F, const Ins& I) {
    const size_t gt = (size_t)(F.vcu * NWAVES * 64) + F.tid, NT = (size_t)F.G * NWAVES * 64;
    const size_t nblk = (size_t)NEXP * 64;
    unsigned char* EU = F.ws + WS_EU; unsigned char* EV = F.ws + WS_EV;
    LAS int* ptab = (LAS int*)(F.lds + RING_OFF + 65536);
#pragma unroll 1
    for (int j = 0; j < 32; ++j) {
        v16f_t a, b;
#pragma unroll
        for (int i = 0; i < 16; ++i) { a[i] = (i == j) ? 1.0f : 0.0f; b[i] = (i + 16 == j) ? 1.0f : 0.0f; }
        const v32f_t r = __builtin_amdgcn_cvt_scalef32_pk32_f32_fp6(__builtin_amdgcn_cvt_scalef32_2xpk16_fp6_f32(a, b, 1.0f), 1.0f);
        int pos = 0;
#pragma unroll
        for (int i = 0; i < 32; ++i) pos = (r[i] != 0.0f) ? i : pos;
        ptab[j] = pos;
    }
    LDS_WAIT(); asm volatile("" ::: "memory");
    bool inter = true;
#pragma unroll 1
    for (int j = 0; j < 32; ++j) inter = inter && (ptab[j] == ((j < 16) ? 2 * j : 2 * (j - 16) + 1));
    if (inter) {
        const int gw = F.vcu * NWAVES + F.wave, NGW = F.G * NWAVES, lane = F.lane;
        LAS unsigned char* img = F.lds + RING_OFF + F.wave * 9216;
        f32x4 gsc[8];
#pragma unroll
        for (int k = 0; k < 8; ++k) gsc[k] = *(const f32x4*)(I.g_norm2 + (64 * k + lane) * 4) * EU_SCALE;
        for (int e = gw; e < NEXP; e += NGW) {
            f32x4 ru[8], rv[8];
#pragma unroll
            for (int k = 0; k < 8; ++k) { ru[k] = *(const GAS f32x4*)(I.expert_u + (size_t)e * 2048 + (64 * k + lane) * 4); rv[k] = *(const GAS f32x4*)(I.expert_v + (size_t)e * 2048 + (64 * k + lane) * 4); }
#pragma unroll
            for (int tb = 0; tb < 2; ++tb) {
#pragma unroll
                for (int k = 0; k < 8; ++k) { const int i4 = 64 * k + lane;
                    *(LAS f32x4*)(img + (i4 >> 3) * 144 + (i4 & 7) * 16) = tb == 0 ? ru[k] * gsc[k] : rv[k] * EV_SCALE; }
                LDS_WAIT(); asm volatile("" ::: "memory");
                v16f_t ya, yb;
#pragma unroll
                for (int j = 0; j < 8; ++j) { const f32x4 x4 = *(const LAS f32x4*)(img + lane * 144 + 16 * j); ya[2 * j] = x4[0]; yb[2 * j] = x4[1]; ya[2 * j + 1] = x4[2]; yb[2 * j + 1] = x4[3]; }
                LDS_WAIT(); asm volatile("" ::: "memory");
                const v6u_t pk = __builtin_amdgcn_cvt_scalef32_2xpk16_fp6_f32(ya, yb, 1.0f);
                unsigned char* dst = (tb == 0 ? EU : EV) + (size_t)e * EROW;
                *(GAS v4u*)(dst + 16 * lane) = (v4u){pk[0], pk[1], pk[2], pk[3]}; *(GAS u32x2*)(dst + 1024 + 8 * lane) = (u32x2){pk[4], pk[5]};
            }
        }
    } else {
    LAS float* scr = (LAS float*)(F.lds + RING_OFF) + F.tid;
    for (size_t c = gt; c < nblk; c += NT) {
        const size_t e = c >> 6; const int l = (int)(c & 63), d = 32 * l;
        v16f_t ya, yb;
#pragma unroll
        for (int k = 0; k < 8; ++k) { const f32x4 a0 = *(const GAS f32x4*)(I.expert_u + c * 32 + 4 * k), g0 = *(const f32x4*)(I.g_norm2 + d + 4 * k);
#pragma unroll
            for (int j = 0; j < 4; ++j) scr[(4 * k + j) * 512] = a0[j] * g0[j] * EU_SCALE; }
#pragma unroll
        for (int j = 0; j < 16; ++j) { ya[j] = scr[ptab[j] * 512]; yb[j] = scr[ptab[16 + j] * 512]; }
        const v6u_t pu = __builtin_amdgcn_cvt_scalef32_2xpk16_fp6_f32(ya, yb, 1.0f);
        *(GAS v4u*)(EU + e * EROW + 16 * l) = (v4u){pu[0], pu[1], pu[2], pu[3]}; *(GAS u32x2*)(EU + e * EROW + 1024 + 8 * l) = (u32x2){pu[4], pu[5]};
#pragma unroll
        for (int k = 0; k < 8; ++k) { const f32x4 b0 = *(const GAS f32x4*)(I.expert_v + c * 32 + 4 * k);
#pragma unroll
            for (int j = 0; j < 4; ++j) scr[(4 * k + j) * 512] = b0[j] * EV_SCALE; }
#pragma unroll
        for (int j = 0; j < 16; ++j) { ya[j] = scr[ptab[j] * 512]; yb[j] = scr[ptab[16 + j] * 512]; }
        const v6u_t pv = __builtin_amdgcn_cvt_scalef32_2xpk16_fp6_f32(ya, yb, 1.0f);
        *(GAS v4u*)(EV + e * EROW + 16 * l) = (v4u){pv[0], pv[1], pv[2], pv[3]}; *(GAS u32x2*)(EV + e * EROW + 1024 + 8 * l) = (u32x2){pv[4], pv[5]};
    }
    }
    __syncthreads();
}
struct G9Row { u32x4 a; u32x2 b; };
#define G9_SETS G9Row A[4], B[4]
#define G9_XOFF(c) (32 * lane + 16 * (c))
#define G9_LOAD(SET, TAB, IDL, g) do { _Pragma("unroll") for (int k = 0; k < 4; ++k) { const int ex = __builtin_amdgcn_readlane(IDL, 4 * (4 * (g) + k)); \
        const unsigned char* rp = (TAB) + (size_t)ex * EROW; SET[k].a = *(const u32x4*)(rp + 16 * lane); SET[k].b = *(const u32x2*)(rp + 1024 + 8 * lane); } } while (0)
#define G9_CVT(SET, k) __builtin_amdgcn_cvt_scalef32_pk32_f32_fp6((v6u_t){SET[k].a.x, SET[k].a.y, SET[k].a.z, SET[k].a.w, SET[k].b.x, SET[k].b.y}, 1.0f)
#define G9_DOTS(SET, g) do { _Pragma("unroll") for (int k = 0; k < 4; ++k) { const v32f_t r = G9_CVT(SET, k); float s0 = 0.f, s1 = 0.f; \
        _Pragma("unroll") for (int e = 0; e < 16; ++e) { s0 += r[e] * xv[0][e]; s1 += r[16 + e] * xv[1][e]; } float s = s0 + s1; asm volatile("" : "+v"(s)); dots[4 * (g) + k] = s; } } while (0)
#define G9_FMAS(SET, g) do { _Pragma("unroll") for (int k = 0; k < 4; ++k) { const float wk = wq[g][k]; const v32f_t r = G9_CVT(SET, k); \
        _Pragma("unroll") for (int e = 0; e < 16; ++e) { acc[0][e] += wk * r[e]; acc[1][e] += wk * r[16 + e]; } } } while (0)
#else
constexpr int EROW = 2048;
#define G9_SETS u32x4 A[4][2], B[4][2]
#define G9_XOFF(c) (1024 * (c) + 16 * lane)
#define G9_LOAD(SET, TAB, IDL, g) do { _Pragma("unroll") for (int k = 0; k < 4; ++k) { const int ex = __builtin_amdgcn_readlane(IDL, 4 * (4 * (g) + k)); \
        const unsigned char* rp = (TAB) + (size_t)ex * 2048 + 16 * lane; SET[k][0] = *(const u32x4*)rp; SET[k][1] = *(const u32x4*)(rp + 1024); } } while (0)
#define G9_DOTS(SET, g) do { _Pragma("unroll") for (int k = 0; k < 4; ++k) { float s = 0.f; _Pragma("unroll") for (int c = 0; c < 2; ++c) _Pragma("unroll") for (int dw = 0; dw < 4; ++dw) { \
        const f32x2v lo = __builtin_amdgcn_cvt_pk_f32_fp8((int)SET[k][c][dw], false), hi2 = __builtin_amdgcn_cvt_pk_f32_fp8((int)SET[k][c][dw], true); \
        s += lo.x * xv[c][4 * dw] + lo.y * xv[c][4 * dw + 1] + hi2.x * xv[c][4 * dw + 2] + hi2.y * xv[c][4 * dw + 3]; } asm volatile("" : "+v"(s)); dots[4 * (g) + k] = s; } } while (0)
#define G9_FMAS(SET, g) do { _Pragma("unroll") for (int k = 0; k < 4; ++k) { const float wk = wq[g][k]; \
        _Pragma("unroll") for (int c = 0; c < 2; ++c) _Pragma("unroll") for (int dw = 0; dw < 4; ++dw) { \
        const f32x2v lo = __builtin_amdgcn_cvt_pk_f32_fp8((int)SET[k][c][dw], false), hi2 = __builtin_amdgcn_cvt_pk_f32_fp8((int)SET[k][c][dw], true); \
        acc[c][4 * dw] += wk * lo.x; acc[c][4 * dw + 1] += wk * lo.y; acc[c][4 * dw + 2] += wk * hi2.x; acc[c][4 * dw + 3] += wk * hi2.y; } } } while (0)
#endif
#define G9_PIN() do { _Pragma("unroll") for (int c = 0; c < 2; ++c) asm volatile("" : "+v"(acc[c][0]), "+v"(acc[c][1]), "+v"(acc[c][2]), "+v"(acc[c][3]), "+v"(acc[c][4]), "+v"(acc[c][5]), "+v"(acc[c][6]), "+v"(acc[c][7]), \
        "+v"(acc[c][8]), "+v"(acc[c][9]), "+v"(acc[c][10]), "+v"(acc[c][11]), "+v"(acc[c][12]), "+v"(acc[c][13]), "+v"(acc[c][14]), "+v"(acc[c][15])); } while (0)
template <class IdF, class GtF>
__device__ __forceinline__ void g9_token(Frame& F, const Ins& I, float* out, int t, LAS float* wl, IdF idf, GtF gtf) {
    unsigned char* ws = F.ws;
    const bf16* X2B = (const bf16*)(ws + WS_X2B); const unsigned char* EU = ws + WS_EU; const unsigned char* EV = ws + WS_EV;
    const float* ssq2 = (const float*)(ws + WS_PSQ2);
    const int lane = F.lane, sl = (lane >> 2) & 15;
    const bool bit3 = (lane & 8) != 0, bit2 = (lane & 4) != 0;
    {
        G9_SETS;
        {
            float xv[2][16];
#pragma unroll
            for (int c = 0; c < 2; ++c)
#pragma unroll
                for (int q = 0; q < 2; ++q) { const u32x4 a = *(const u32x4*)(X2B + (size_t)t * 2048 + G9_XOFF(c) + 8 * q);
                    xv[c][8 * q] = bflo(a.x); xv[c][8 * q + 1] = bfhi(a.x); xv[c][8 * q + 2] = bflo(a.y); xv[c][8 * q + 3] = bfhi(a.y); xv[c][8 * q + 4] = bflo(a.z); xv[c][8 * q + 5] = bfhi(a.z); xv[c][8 * q + 6] = bflo(a.w); xv[c][8 * q + 7] = bfhi(a.w); }
            const float rstd2 = (1.0f / EU_SCALE) / sqrtf(sum32(ssq2 + (size_t)t * 32) * (1.0f / 2048.0f) + EPS);
            int idl_cur = idf(0);
            G9_LOAD(A, EU, idl_cur, 0); __builtin_amdgcn_sched_barrier(0);
#pragma unroll 1
            for (int hd = 0; hd < 8; ++hd) {
                const int idl_nxt = idf(hd < 7 ? hd + 1 : 0); const float gtl = gtf(hd);
                float dots[16];
                G9_LOAD(B, EU, idl_cur, 1); __builtin_amdgcn_sched_barrier(0);
                G9_DOTS(A, 0); __builtin_amdgcn_sched_barrier(0);
                G9_LOAD(A, EU, idl_cur, 2); __builtin_amdgcn_sched_barrier(0);
                G9_DOTS(B, 1); __builtin_amdgcn_sched_barrier(0);
                G9_LOAD(B, EU, idl_cur, 3); __builtin_amdgcn_sched_barrier(0);
                G9_DOTS(A, 2); __builtin_amdgcn_sched_barrier(0);
                if (hd < 7) { G9_LOAD(A, EU, idl_nxt, 0); } else { G9_LOAD(A, EV, idl_nxt, 0); }
                __builtin_amdgcn_sched_barrier(0);
                G9_DOTS(B, 3); __builtin_amdgcn_sched_barrier(0);
                float d8[8], d4[4], d2[2], d1;
#pragma unroll
                for (int i = 0; i < 8; ++i) { auto rr = __builtin_amdgcn_permlane32_swap(__float_as_uint(dots[i]), __float_as_uint(dots[8 + i]), false, false); const unsigned r0 = rr[0], r1 = rr[1]; d8[i] = __uint_as_float(r0) + __uint_as_float(r1); }
#pragma unroll
                for (int i = 0; i < 4; ++i) { auto rr = __builtin_amdgcn_permlane16_swap(__float_as_uint(d8[i]), __float_as_uint(d8[4 + i]), false, false); const unsigned r0 = rr[0], r1 = rr[1]; d4[i] = __uint_as_float(r0) + __uint_as_float(r1); }
#pragma unroll
                for (int i = 0; i < 2; ++i) { const float keep = bit3 ? d4[2 + i] : d4[i], send = bit3 ? d4[i] : d4[2 + i]; d2[i] = keep + __shfl_xor(send, 8); }
                { const float keep = bit2 ? d2[1] : d2[0], send = bit2 ? d2[0] : d2[1]; d1 = keep + __shfl_xor(send, 4); }
                d1 += __shfl_xor(d1, 2); d1 += __shfl_xor(d1, 1);
                const float a = d1 * rstd2;
                const float z2 = 1.5957691216057308f * (a + 0.044715f * a * a * a);
                const float w = gtl * (1.0f / EV_SCALE) * a * __builtin_amdgcn_rcpf(1.0f + __builtin_amdgcn_exp2f(-z2 * LOG2E));
                if ((lane & 3) == 0) wl[hd * 16 + sl] = w;
                idl_cur = idl_nxt;
            }
        }
        LDS_WAIT(); asm volatile("" ::: "memory");
        float acc[2][16];
#pragma unroll
        for (int c = 0; c < 2; ++c)
#pragma unroll
            for (int e = 0; e < 16; ++e) acc[c][e] = 0.f;
        {
            int idl_cur = idf(0);
#pragma unroll 1
            for (int hd = 0; hd < 8; ++hd) {
                const int idl_nxt = idf(hd < 7 ? hd + 1 : 0);
                f32x4 wq[4];
#pragma unroll
                for (int g = 0; g < 4; ++g) wq[g] = *(const LAS f32x4*)(wl + hd * 16 + 4 * g);
                G9_LOAD(B, EV, idl_cur, 1); __builtin_amdgcn_sched_barrier(0);
                G9_FMAS(A, 0); G9_PIN(); __builtin_amdgcn_sched_barrier(0);
                G9_LOAD(A, EV, idl_cur, 2); __builtin_amdgcn_sched_barrier(0);
                G9_FMAS(B, 1); G9_PIN(); __builtin_amdgcn_sched_barrier(0);
                G9_LOAD(B, EV, idl_cur, 3); __builtin_amdgcn_sched_barrier(0);
                G9_FMAS(A, 2); G9_PIN(); __builtin_amdgcn_sched_barrier(0);
                if (hd < 7) { G9_LOAD(A, EV, idl_nxt, 0); } __builtin_amdgcn_sched_barrier(0);
                G9_FMAS(B, 3); G9_PIN(); __builtin_amdgcn_sched_barrier(0);
                idl_cur = idl_nxt;
            }
        }
        LDS_WAIT(); asm volatile("" ::: "memory");
        float s = 0.f;
#pragma unroll
        for (int c = 0; c < 2; ++c)
#pragma unroll
            for (int q = 0; q < 2; ++q) { const u32x4 a = *(const u32x4*)(X2B + (size_t)t * 2048 + G9_XOFF(c) + 8 * q);
                const float xr[8] = {bflo(a.x), bfhi(a.x), bflo(a.y), bfhi(a.y), bflo(a.z), bfhi(a.z), bflo(a.w), bfhi(a.w)};
#pragma unroll
                for (int e = 0; e < 8; ++e) { acc[c][8 * q + e] += xr[e]; s += acc[c][8 * q + e] * acc[c][8 * q + e]; } }
        float rs = 1.0f / sqrtf(wave_sum(s) * (1.0f / 2048.0f) + EPS);
#ifdef ATT_CHECK
        if (((const unsigned*)F.ctl)[16] + ((const unsigned*)F.ctl)[17] > 0u) rs = __builtin_nanf("");
#endif
#pragma unroll
        for (int c = 0; c < 2; ++c)
#pragma unroll
            for (int q = 0; q < 4; ++q) { const f32x4 g = *(const f32x4*)(I.g_final + G9_XOFF(c) + 4 * q);
                *(f32x4*)(out + (size_t)t * 2048 + G9_XOFF(c) + 4 * q) = (f32x4){acc[c][4 * q] * rs * g[0], acc[c][4 * q + 1] * rs * g[1], acc[c][4 * q + 2] * rs * g[2], acc[c][4 * q + 3] * rs * g[3]}; }
    }
}
#undef G9_LOAD
#undef G9_DOTS
#undef G9_FMAS
#undef G9_PIN
#undef G9_SETS
#undef G9_XOFF
__device__ __forceinline__ void p9_gather_fp8(Frame& F, const Ins& I, float* out) {
    const int* IDX = (const int*)(F.ws + WS_IDX); const float* GT = (const float*)(F.ws + WS_GT);
    const int lane = F.lane, sl = (lane >> 2) & 15;
    LAS float* wl = (LAS float*)(F.lds + RING_OFF + F.wave * 4096);
    unsigned* tokctr = (unsigned*)F.ctl + CW_TOKCTR;
    for (;;) {
        int t = 0; if (lane == 0) t = (int)__hip_atomic_fetch_add(tokctr, 1u, __ATOMIC_RELAXED, __HIP_MEMORY_SCOPE_AGENT);
        t = __builtin_amdgcn_readfirstlane(t);
        if (t >= T) break;
        const int* idx_t = IDX + (size_t)t * 128 + sl; const float* gt_t = GT + (size_t)t * 128 + sl;
        g9_token(F, I, out, t, wl, [=](int hd) { return idx_t[hd * 16]; }, [=](int hd) { return gt_t[hd * 16]; });
    }
}

__device__ __forceinline__ void p89_route_gather(Frame& F, const Ins& I, float* out) {
    using namespace rt;
    rt_load_keys(F, I);
    LAS unsigned* lstw = (LAS unsigned*)(F.lds + RING_OFF + LIST_OFF + F.wave * LIST_WAVE);
    LAS unsigned* lst = lstw + (F.lane & 31) * 48;
    LAS float* wl = (LAS float*)(lstw + 32 * 48);
    const int gw = F.vcu * NWAVES + F.wave, NGW = F.G * NWAVES, sl = (F.lane >> 2) & 15;
    for (int task = gw; task < T * 8 / 32; task += NGW) {
        rt_task<true>(F, task, lst);
        LDS_WAIT(); asm volatile("" ::: "memory");
#pragma unroll 1
        for (int tt = 0; tt < 4; ++tt) {
            LAS unsigned* lt = lstw + (tt * 8) * 48 + sl;
            g9_token(F, I, out, 4 * task + tt, wl, [=](int hd) { return (int)lt[hd * 48]; }, [=](int hd) { return __uint_as_float(lt[hd * 48 + 16]); });
        }
        LDS_WAIT(); asm volatile("" ::: "memory");
    }
}

constexpr int NPHASE = 10;
struct Args { Ins in; float* out; unsigned char* ws; double inv_freq[32]; int ph_lo, ph_hi; };
__global__ void __launch_bounds__(NWAVES * 64, 2) mega_fwd(Args args) {
    extern __shared__ __attribute__((aligned(16))) unsigned char lds[];
    Frame F;
    F.lds = (LAS unsigned char*)lds;
    F.MISC = (volatile LAS unsigned*)(F.lds + MISC_OFF);
    F.tid = threadIdx.x; F.lane = F.tid & 63; F.wave = __builtin_amdgcn_readfirstlane(F.tid >> 6);
    F.G = gridDim.x; { const int bx = blockIdx.x; F.vcu = (F.G % 8 == 0) ? (bx % 8) * (F.G / 8) + bx / 8 : bx; }
    unsigned char* ws = args.ws; F.ws = ws;
    F.ctl = (gu32*)(ws + WS_CTL);
    const Ins& I = args.in;
    for (int u = F.tid; u < (LDS_BYTES - LDSCTL_OFF) / 4; u += NWAVES * 64) ((LAS unsigned*)(F.lds + LDSCTL_OFF))[u] = 0u;
    __syncthreads();
    XcdBarrier bar; bar.bar = (unsigned*)(F.ctl + CW_BAR); bar.x = 0; bar.st = nullptr;
#if MK_N_LAUNCHES == 1
    bar = xcd_barrier_post((unsigned*)(F.ctl + CW_BAR), F.MISC + 8);
#define GRID_BAR() xcd_barrier(bar)
#else
#define GRID_BAR() do {} while (0)
#endif
    const int lo = args.ph_lo, hi = args.ph_hi;
#ifdef PROBE_PH
    unsigned long long pstamp[NPHASE + 1];
#define PSTAMP(k) do { if (blockIdx.x == 0 && F.tid == 0) pstamp[k] = __builtin_amdgcn_s_memrealtime(); } while (0)
#else
#define PSTAMP(k) do {} while (0)
#endif
#ifndef PH_MASK
#define PH_MASK 0xFFFF
#endif
#define IN(k) (((PH_MASK >> (k)) & 1) && lo <= (k) && (k) < hi)
#define BOTH(k) (IN(k) && IN((k) + 1))
    float* ssq_q = (float*)(ws + WS_PSQ_Q); float* ssq_kv = (float*)(ws + WS_PSQ_KV); float* ssq2 = (float*)(ws + WS_PSQ2);
    const float* rope = (const float*)(ws + WS_ROPE);

    PSTAMP(0);
    if (IN(0)) { p0_prologue(F, I, args.inv_freq); if (BOTH(0)) GRID_BAR(); }

    PSTAMP(1);
    if (IN(1)) {
        pg8::Gemm g{(const bf16_t*)(ws + WS_H), (const bf16_t*)(ws + WS_W1), T, N1, 2048, 2048}; pg8::StaticOrder S; S.init(T, N1, F.G, (int)blockIdx.x);
        EpiProj E{(bf16_t*)(ws + WS_CQ), (bf16_t*)(ws + WS_CKV), (bf16_t*)(ws + WS_DQ), (bf16_t*)(ws + WS_DK), (bf16_t*)(ws + WS_DV), (bf16_t*)(ws + WS_G), (bf16_t*)(ws + WS_KR), ssq_q, ssq_kv, I.b_gate, rope};
        pg8::gemm_phase<EpiProj, pg8::StaticOrder, PG8_ALIGN, PG8_SP2>(F.lds + RING_OFF, g, S, E);
        if (BOTH(1)) GRID_BAR();
    }
    PSTAMP(2);
    if (IN(2)) {
        { pg8::Gemm g{(const bf16_t*)(ws + WS_CQ), (const bf16_t*)(ws + WS_WUQ), T, 1536, 768, 768}; pg8::StaticOrder S; S.init(T, 1536, F.G, (int)blockIdx.x);
          EpiQup E{(bf16_t*)(ws + WS_QN), (bf16_t*)(ws + WS_QR), ssq_q, rope};
          pg8::gemm_phase<EpiQup, pg8::StaticOrder, PG8_ALIGN, PG8_SP2>(F.lds + RING_OFF, g, S, E); }
        { pg8::Gemm g{(const bf16_t*)(ws + WS_CKV), (const bf16_t*)(ws + WS_WUKV), T, 2048, 512, 512}; pg8::StaticOrder S; S.init(T, 2048, F.G, (int)blockIdx.x);
          EpiKVup E{(bf16_t*)(ws + WS_KN), (bf16_t*)(ws + WS_V), ssq_kv};
          pg8::gemm_phase<EpiKVup, pg8::StaticOrder, PG8_ALIGN, PG8_SP2>(F.lds + RING_OFF, g, S, E); }
        if (BOTH(2)) GRID_BAR();
    }
    PSTAMP(3);
#ifdef ATT_REF
    if (IN(3)) { p3_attention_ref(F, I); if (BOTH(3)) GRID_BAR(); }
#else
    if (IN(3)) { p3_attention(F, I); if (BOTH(3)) GRID_BAR(); }
#ifdef ATT_CHECK
    if (IN(3)) { p3_attention_ref(F, I); GRID_BAR(); }
#endif
#endif
    PSTAMP(4);
    if (IN(4)) {
        pg8::Gemm2 g{(const bf16_t*)(ws + WS_OM), (const bf16_t*)(ws + WS_OD), (const bf16_t*)(ws + WS_WOM), (const bf16_t*)(ws + WS_WOD), T, 2048, 1024, 1024};
        pg8::StaticOrder S; S.init(T, 2048, F.G, (int)blockIdx.x);
        EpiGate2 E{(const bf16_t*)(ws + WS_G), (bf16_t*)(ws + WS_MG)};
        pg8::gemm_phase2<EpiGate2, pg8::StaticOrder, PG8_ALIGN, PG8_SP2>(F.lds + RING_OFF, g, S, E);
        if (BOTH(4)) GRID_BAR();
    }
    PSTAMP(5);
    PSTAMP(6);
    if (IN(6)) {
#ifdef PEER_BF16
        convert_experts(F, I);
#else
#ifdef PEER_FP6
        convert_experts_fp6(F, I);
#else
        convert_experts_fp8(F, I);
#endif
#endif
        pg8::Gemm g{(const bf16_t*)(ws + WS_MG), (const bf16_t*)(ws + WS_WOUT), T, 2048, 2048, 2048}; pg8::StaticOrder S; S.init(T, 2048, F.G, (int)blockIdx.x);
        EpiRes E{I.x, (float*)(ws + WS_X2), (bf16_t*)(ws + WS_X2B), ssq2};
        pg8::gemm_phase<EpiRes, pg8::StaticOrder, PG8_ALIGN, PG8_SP2>(F.lds + RING_OFF, g, S, E);
        if (BOTH(6)) GRID_BAR();
    }
    PSTAMP(7);
    if (IN(7)) {
        pg8::Gemm g{(const bf16_t*)(ws + WS_X2B), (const bf16_t*)(ws + WS_WQP), T, 2048, 2048, 2048}; pg8::StaticOrder S; S.init(T, 2048, F.G, (int)blockIdx.x);
        EpiQP E{(bf16_t*)(ws + WS_QP), ssq2};
        pg8::gemm_phase<EpiQP, pg8::StaticOrder, PG8_ALIGN, PG8_SP2>(F.lds + RING_OFF, g, S, E);
        if (BOTH(7)) GRID_BAR();
    }
    PSTAMP(8);
#if defined(ROUTE_REF) || defined(PEER_BF16) || defined(NO_FUSE89)
#ifdef ROUTE_REF
    if (IN(8)) { p7_routing_ref(F); if (BOTH(8)) GRID_BAR(); }
#else
    if (IN(8)) { p8_routing(F, I); if (BOTH(8)) GRID_BAR(); }
#endif
    PSTAMP(9);
#ifdef PEER_BF16
    if (IN(9)) { p8_gather(F, I, args.out); }
#else
    if (IN(9)) { p9_gather_fp8(F, I, args.out); }
#endif
#else
    if (IN(8) && IN(9)) { p89_route_gather(F, I, args.out); }
    PSTAMP(9);
#endif
    PSTAMP(10);
#ifdef PROBE_PH
    if (blockIdx.x == 0 && F.tid == 0) {
        const unsigned long long span = (pstamp[PROBE_PH + 1] - pstamp[PROBE_PH]) * PROBE_MUL, t0 = __builtin_amdgcn_s_memrealtime();
        while (__builtin_amdgcn_s_memrealtime() - t0 < span) __builtin_amdgcn_s_sleep(32);
    }
#endif
#undef IN
#undef BOTH
}

extern "C" void kernel_launch(void* const* d_in, const int* in_sizes, int n_in, void* d_out, int out_size, void* d_ws, size_t ws_size, hipStream_t stream) {
    static int grid = 0;
    if (grid == 0) {
        if (n_in != 19 || out_size != T * D_MODEL || ws_size < WS_END) { fprintf(stderr, "kernel_launch: unexpected shapes: n_in %d out %d ws %zu\n", n_in, out_size, ws_size); grid = -1; return; }
        int dev = 0, cus = 0, per_cu = 0;
        if (hipGetDevice(&dev) != hipSuccess || hipDeviceGetAttribute(&cus, hipDeviceAttributeMultiprocessorCount, dev) != hipSuccess) { grid = -1; return; }
        if (hipFuncSetAttribute((const void*)mega_fwd, hipFuncAttributeMaxDynamicSharedMemorySize, LDS_BYTES) != hipSuccess) { fprintf(stderr, "kernel_launch: hipFuncSetAttribute failed\n"); grid = -1; return; }
        if (hipOccupancyMaxActiveBlocksPerMultiprocessor(&per_cu, (const void*)mega_fwd, NWAVES * 64, LDS_BYTES) != hipSuccess || per_cu < 1)
            fprintf(stderr, "kernel_launch: occupancy query reports %d workgroups per CU\n", per_cu);
        (void)hipGetLastError();
        grid = cus;
    }
    if (grid < 0) return;
    if (hipMemsetAsync((char*)d_ws + WS_CTL, 0, CTL_ZERO_BYTES, stream) != hipSuccess) { fprintf(stderr, "kernel_launch: memset failed\n"); return; }
    Args a{};
    const float** ip = (const float**)&a.in;
    for (int i = 0; i < 19; ++i) ip[i] = (const float*)d_in[i];
    a.out = (float*)d_out; a.ws = (unsigned char*)d_ws;
    for (int i = 0; i < 32; ++i) a.inv_freq[i] = pow(10000.0, -(double)i / 32.0);
#if MK_N_LAUNCHES == 1
    a.ph_lo = 0; a.ph_hi = NPHASE;
    hipLaunchKernelGGL(mega_fwd, dim3(grid), dim3(NWAVES * 64), LDS_BYTES, stream, a);
#else
    for (int p = 0; p < NPHASE; ++p) { a.ph_lo = p; a.ph_hi = p + 1; hipLaunchKernelGGL(mega_fwd, dim3(grid), dim3(NWAVES * 64), LDS_BYTES, stream, a); }
#endif
    const hipError_t le = hipPeekAtLastError();
    if (le != hipSuccess) fprintf(stderr, "kernel_launch: launch failed: %s\n", hipGetErrorName(le));
}
```

```cpp
#include <hip/hip_runtime.h>
#include <cstdio>
#include <cstdint>
#include <cmath>

#ifndef MK_N_LAUNCHES
#define MK_N_LAUNCHES 1
#endif

constexpr int D_MODEL = 2048, BATCH = 2, SEQ = 8192, T = BATCH * SEQ;
constexpr int OFF_CQ = 0, OFF_CKV = 768, OFF_KR = 1280, OFF_DQ = 1344, OFF_DK = 2368, OFF_DV = 3392, OFF_GATE = 4416, IN_COLS = 8512;
constexpr int N1 = 8704;
constexpr int NEXP = 16384;
constexpr float EPS = 1e-6f;
constexpr float LOG2E = 1.4426950408889634f;
constexpr float C2_MLA = 0.07216878364870322f * LOG2E;
constexpr float C2_DIFF = 0.125f * LOG2E;
constexpr float LAMBDA_INIT = 0.2f;

namespace pg8 {
#define PG8_LAS __attribute__((address_space(3)))
typedef unsigned short bf16_t;
typedef short bf16x8 __attribute__((ext_vector_type(8)));
typedef float f32x4 __attribute__((ext_vector_type(4)));
typedef unsigned u32x4 __attribute__((ext_vector_type(4)));
typedef unsigned u32x2 __attribute__((ext_vector_type(2)));
constexpr int BM = 256, BK = 64, HALF = 128, HTB = HALF * BK * 2, STAGE_BYTES = 8 * HTB, NXCD = 8, WGM = 8;

__host__ __device__ __forceinline__ int lds_byte(int r, int c) { const int st = (r >> 4) * 2 + (c >> 5), rr = r & 15, cc = c & 31, ob = rr * 64 + cc * 2; return st * 1024 + (ob ^ (((ob >> 9) & 1) << 5)); }
__host__ __device__ __forceinline__ void stage_rc(int b, int& R, int& C) { const int st = b / 1024, sb = b % 1024, swz = sb ^ (((sb >> 9) & 1) << 5); R = (st >> 1) * 16 + swz / 64; C = (st & 1) * 32 + (swz % 64) / 2; }
__host__ __device__ __forceinline__ int perm32(int rho) { const int n = rho >> 4, i = rho & 15; return 8 * (i >> 2) + 4 * n + (i & 3); }

struct Unit { int pm, pn; };
struct Gemm { const bf16_t* A; const bf16_t* Bt; int M, N, K, lda; };

struct StaticOrder {
    int nM, nN, nwg, G, c;
    __host__ __device__ void init(int M, int N, int G_, int c_) { nM = M / BM; nN = N / BM; nwg = nM * nN; G = G_; c = c_; }
    __host__ __device__ bool next(int i, Unit& u) const {
        const long L = (long)i * G + c; if (L >= nwg) return false;
        int wgid = (int)L; { const int q = nwg / NXCD, r = nwg % NXCD, xcd = wgid % NXCD, off = wgid / NXCD; wgid = (xcd < r ? xcd * (q + 1) : r * (q + 1) + (xcd - r) * q) + off; }
        const int nig = WGM * nN, gid = wgid / nig, fm = gid * WGM, gsz = (nM - fm) < WGM ? (nM - fm) : WGM;
        u.pm = fm + ((wgid % nig) % gsz); u.pn = (wgid % nig) / gsz; return true;
    }
    __device__ __forceinline__ void a_ready(const Unit&) const {}
    __device__ __forceinline__ void done(const Unit&) const {}
};

typedef float f32x2_t __attribute__((ext_vector_type(2))); typedef __bf16 bf16x2_t __attribute__((ext_vector_type(2)));
__device__ __forceinline__ unsigned cvtpk(float lo, float hi) { f32x2_t v = {lo, hi}; bf16x2_t b = __builtin_convertvector(v, bf16x2_t); return __builtin_bit_cast(unsigned, b); }
__device__ __forceinline__ float bf2f(unsigned short h) { return __builtin_bit_cast(float, (unsigned)h << 16); }
__device__ __forceinline__ float bflo(unsigned w) { return __builtin_bit_cast(float, w << 16); }
__device__ __forceinline__ float bfhi(unsigned w) { return __builtin_bit_cast(float, w & 0xffff0000u); }

template <class Epi, class Sched, bool ALIGN_EPI = false, bool SP2 = false>
__device__ __forceinline__ void gemm_phase(PG8_LAS unsigned char* lds, const Gemm g, const Sched& S, const Epi& E) {
    const int tid = threadIdx.x, wid = __builtin_amdgcn_readfirstlane(tid >> 6), lane = tid & 63, wr = wid >> 2, wc = wid & 3, fr = lane & 15, fq = lane >> 4;
    const int K = g.K, nt = K / BK, lda = g.lda;
    unsigned voffA[2], voffB[2];
#pragma unroll
    for (int i = 0; i < 2; ++i) { int R, C; stage_rc(tid * 16 + i * 8192, R, C); const int Rb = Epi::PERM ? ((R & ~31) + perm32(R & 31)) : R;
        voffA[i] = (unsigned)(R * lda + C) * 2u; voffB[i] = (unsigned)(Rb * K + C) * 2u; }
    const size_t kstep = (size_t)(BK * 2);
    const size_t hstepA = (size_t)HALF * lda * 2, hstepB = (size_t)HALF * K * 2;
    const size_t tstepA = 2 * hstepA, tstepB = 2 * hstepB;
    const unsigned ldsw = (unsigned)wid * 1024u;
    const int aoff = lds_byte(wr * 64 + fr, fq * 8), boff = lds_byte(wc * 32 + fr, fq * 8);
#define PG8_SA(b, h) (((b) * 2 + (h)) * HTB)
#define PG8_SB(b, h) ((4 + (b) * 2 + (h)) * HTB)
#define PG8_STAGE(bufoff, gbase, voff) do { _Pragma("unroll") for (int _i = 0; _i < 2; ++_i) \
        __builtin_amdgcn_global_load_lds((const unsigned*)((const char*)(gbase) + (voff)[_i]), (PG8_LAS unsigned*)(lds + (bufoff) + ldsw + _i * 8192), 16, 0, 0); } while (0)
#define PG8_LDA(dst, b, h) do { _Pragma("unroll") for (int m = 0; m < 4; ++m) _Pragma("unroll") for (int k = 0; k < 2; ++k) dst[m][k] = *(const PG8_LAS bf16x8*)(lds + PG8_SA(b, h) + aoff + m * 2048 + k * 1024); } while (0)
#define PG8_LDB(dst, b, h) do { _Pragma("unroll") for (int n = 0; n < 2; ++n) _Pragma("unroll") for (int k = 0; k < 2; ++k) dst[n][k] = *(const PG8_LAS bf16x8*)(lds + PG8_SB(b, h) + boff + n * 2048 + k * 1024); } while (0)
#define PG8_MMA(ai, bj, At, Bt) do { __builtin_amdgcn_s_setprio(1); _Pragma("unroll") for (int m = 0; m < 4; ++m) _Pragma("unroll") for (int n = 0; n < 2; ++n) _Pragma("unroll") for (int k = 0; k < 2; ++k) \
        acc[ai][bj][m][n] = __builtin_amdgcn_mfma_f32_16x16x32_bf16(Bt[n][k], At[m][k], acc[ai][bj][m][n], 0, 0, 0); __builtin_amdgcn_s_setprio(0); } while (0)
#define PG8_WAIT_V(n) asm volatile("s_waitcnt vmcnt(" #n ")" ::: "memory")
#define PG8_WAIT_L(n) asm volatile("s_waitcnt lgkmcnt(" #n ")" ::: "memory")
#define PG8_BAR __builtin_amdgcn_s_barrier()
#define PG8_SCHED __builtin_amdgcn_sched_barrier(0)
    Unit cur, nxt; int ui = 0;
    if (!S.next(0, cur)) return;
    f32x4 acc[2][2][4][2];
#pragma unroll
    for (int a = 0; a < 2; ++a)
#pragma unroll
        for (int b = 0; b < 2; ++b)
#pragma unroll
            for (int m = 0; m < 4; ++m)
#pragma unroll
                for (int n = 0; n < 2; ++n) acc[a][b][m][n] = (f32x4){0.f, 0.f, 0.f, 0.f};
    bf16x8 At[4][2], B0[2][2], B1[2][2];
    const char* cA = (const char*)g.A + (size_t)cur.pm * tstepA; const char* cB = (const char*)g.Bt + (size_t)cur.pn * tstepB;
    S.a_ready(cur);
    if constexpr (SP2) {
        PG8_STAGE(PG8_SB(0, 0), cB, voffB); PG8_STAGE(PG8_SB(0, 1), cB + hstepB, voffB); PG8_STAGE(PG8_SA(0, 0), cA, voffA); PG8_STAGE(PG8_SA(0, 1), cA + hstepA, voffA);
        if (wr == 1) PG8_BAR;
        PG8_WAIT_V(2); PG8_BAR;
        PG8_STAGE(PG8_SB(1, 0), cB + kstep, voffB); PG8_STAGE(PG8_SA(1, 0), cA + kstep, voffA); PG8_STAGE(PG8_SB(1, 1), cB + hstepB + kstep, voffB);
        PG8_WAIT_V(6); PG8_BAR;
    } else {
        PG8_STAGE(PG8_SB(0, 0), cB, voffB); PG8_STAGE(PG8_SA(0, 0), cA, voffA); PG8_STAGE(PG8_SB(0, 1), cB + hstepB, voffB); PG8_STAGE(PG8_SA(0, 1), cA + hstepA, voffA);
        if (wr == 1) PG8_BAR;
        PG8_WAIT_V(4); PG8_BAR;
        PG8_STAGE(PG8_SB(1, 0), cB + kstep, voffB); PG8_STAGE(PG8_SA(1, 0), cA + kstep, voffA); PG8_STAGE(PG8_SB(1, 1), cB + hstepB + kstep, voffB);
        PG8_WAIT_V(6); PG8_BAR;
    }
    for (;;) {
        const bool has_next = S.next(ui + 1, nxt);
        const char* nA = has_next ? (const char*)g.A + (size_t)nxt.pm * tstepA : cA; const char* nB = has_next ? (const char*)g.Bt + (size_t)nxt.pn * tstepB : cB;
        for (int t = 0; t < nt; t += 2) {
            const bool last = (t == nt - 2);
            const char* a1 = cA + (size_t)(t + 1) * kstep;
            const char* a2 = last ? nA : cA + (size_t)(t + 2) * kstep; const char* b2 = last ? nB : cB + (size_t)(t + 2) * kstep;
            const char* a3 = a2 + kstep; const char* b3 = b2 + kstep;
            if (last && has_next) S.a_ready(nxt);
            if constexpr (SP2) {
            PG8_LDB(B0, 0, 0); PG8_LDB(B1, 0, 1); PG8_SCHED; PG8_LDA(At, 0, 0); PG8_STAGE(PG8_SA(1, 1), a1 + hstepA, voffA);
            PG8_WAIT_V(8); PG8_WAIT_L(0); PG8_BAR; PG8_MMA(0, 0, At, B0); PG8_MMA(0, 1, At, B1); PG8_BAR; PG8_SCHED;
            PG8_LDA(At, 0, 1); PG8_STAGE(PG8_SB(0, 0), b2, voffB); PG8_STAGE(PG8_SB(0, 1), b2 + hstepB, voffB); PG8_STAGE(PG8_SA(0, 0), a2, voffA);
            PG8_WAIT_V(8); PG8_WAIT_L(0); PG8_BAR; PG8_MMA(1, 0, At, B0); PG8_MMA(1, 1, At, B1); PG8_BAR; PG8_SCHED;
            PG8_LDB(B0, 1, 0); PG8_LDB(B1, 1, 1); PG8_SCHED; PG8_LDA(At, 1, 0); PG8_STAGE(PG8_SA(0, 1), a2 + hstepA, voffA);
            PG8_WAIT_V(8); PG8_WAIT_L(0); PG8_BAR; PG8_MMA(0, 0, At, B0); PG8_MMA(0, 1, At, B1); PG8_BAR; PG8_SCHED;
            PG8_LDA(At, 1, 1); PG8_STAGE(PG8_SB(1, 0), b3, voffB); PG8_STAGE(PG8_SB(1, 1), b3 + hstepB, voffB); PG8_STAGE(PG8_SA(1, 0), a3, voffA);
            PG8_WAIT_V(8); PG8_WAIT_L(0); PG8_BAR; PG8_MMA(1, 0, At, B0); PG8_MMA(1, 1, At, B1); PG8_BAR; PG8_SCHED;
            } else {
            PG8_LDB(B0, 0, 0); PG8_SCHED; PG8_LDA(At, 0, 0); PG8_STAGE(PG8_SA(1, 1), a1 + hstepA, voffA);
            PG8_WAIT_L(8); PG8_BAR; PG8_WAIT_L(0); PG8_MMA(0, 0, At, B0); PG8_BAR; PG8_SCHED;
            PG8_LDB(B1, 0, 1); PG8_STAGE(PG8_SB(0, 0), b2, voffB);
            PG8_BAR; PG8_WAIT_L(0); PG8_MMA(0, 1, At, B1); PG8_BAR;
            PG8_LDA(At, 0, 1); PG8_STAGE(PG8_SA(0, 0), a2, voffA);
            PG8_BAR; PG8_WAIT_L(0); PG8_MMA(1, 0, At, B0); PG8_BAR; PG8_SCHED;
            PG8_STAGE(PG8_SB(0, 1), b2 + hstepB, voffB);
            PG8_WAIT_V(6); PG8_BAR; PG8_MMA(1, 1, At, B1); PG8_BAR;
            PG8_LDB(B0, 1, 0); PG8_SCHED; PG8_LDA(At, 1, 0); PG8_STAGE(PG8_SA(0, 1), a2 + hstepA, voffA);
            PG8_WAIT_L(8); PG8_BAR; PG8_WAIT_L(0); PG8_MMA(0, 0, At, B0); PG8_BAR; PG8_SCHED;
            PG8_LDB(B1, 1, 1); PG8_STAGE(PG8_SB(1, 0), b3, voffB);
            PG8_BAR; PG8_WAIT_L(0); PG8_MMA(0, 1, At, B1); PG8_BAR;
            PG8_LDA(At, 1, 1); PG8_STAGE(PG8_SA(1, 0), a3, voffA);
            PG8_BAR; PG8_WAIT_L(0); PG8_MMA(1, 0, At, B0); PG8_BAR; PG8_SCHED;
            PG8_STAGE(PG8_SB(1, 1), b3 + hstepB, voffB);
            PG8_WAIT_V(6); PG8_BAR; PG8_MMA(1, 1, At, B1); PG8_BAR;
            }
        }
        if constexpr (ALIGN_EPI) { if (wr == 0) PG8_BAR; }
        E(acc, cur, wr, wc, fr, fq); S.done(cur);
        if (!has_next) break;
#pragma unroll
        for (int a = 0; a < 2; ++a)
#pragma unroll
            for (int b = 0; b < 2; ++b)
#pragma unroll
                for (int m = 0; m < 4; ++m)
#pragma unroll
                    for (int n = 0; n < 2; ++n) acc[a][b][m][n] = (f32x4){0.f, 0.f, 0.f, 0.f};
        cur = nxt; cA = nA; cB = nB; ++ui;
        if constexpr (ALIGN_EPI) { if (wr == 1) PG8_BAR; }
    }
    PG8_WAIT_V(0);
    if constexpr (!ALIGN_EPI) { if (wr == 0) PG8_BAR; }
    PG8_BAR;
#undef PG8_SA
#undef PG8_SB
#undef PG8_STAGE
#undef PG8_LDA
#undef PG8_LDB
#undef PG8_MMA
#undef PG8_WAIT_V
#undef PG8_WAIT_L
#undef PG8_BAR
#undef PG8_SCHED
}
struct Gemm2 { const bf16_t *A1, *A2, *B1, *B2; int M, N, K1, lda; };
template <class Epi, class Sched, bool ALIGN_EPI = false, bool SP2 = false>
__device__ __forceinline__ void gemm_phase2(PG8_LAS unsigned char* lds, const Gemm2 g, const Sched& S, const Epi& E) {
    const int tid = threadIdx.x, wid = __builtin_amdgcn_readfirstlane(tid >> 6), lane = tid & 63, wr = wid >> 2, wc = wid & 3, fr = lane & 15, fq = lane >> 4;
    const int K = g.K1, nt = K / BK, lda = g.lda;
    unsigned voffA[2], voffB[2];
#pragma unroll
    for (int i = 0; i < 2; ++i) { int R, C; stage_rc(tid * 16 + i * 8192, R, C); const int Rb = Epi::PERM ? ((R & ~31) + perm32(R & 31)) : R;
        voffA[i] = (unsigned)(R * lda + C) * 2u; voffB[i] = (unsigned)(Rb * K + C) * 2u; }
    const size_t kstep = (size_t)(BK * 2);
    const size_t hstepA = (size_t)HALF * lda * 2, hstepB = (size_t)HALF * K * 2;
    const size_t tstepA = 2 * hstepA, tstepB = 2 * hstepB;
    const unsigned ldsw = (unsigned)wid * 1024u;
    const int aoff = lds_byte(wr * 64 + fr, fq * 8), boff = lds_byte(wc * 32 + fr, fq * 8);
#define PG8_SA(b, h) (((b) * 2 + (h)) * HTB)
#define PG8_SB(b, h) ((4 + (b) * 2 + (h)) * HTB)
#define PG8_STAGE(bufoff, gbase, voff) do { _Pragma("unroll") for (int _i = 0; _i < 2; ++_i) \
        __builtin_amdgcn_global_load_lds((const unsigned*)((const char*)(gbase) + (voff)[_i]), (PG8_LAS unsigned*)(lds + (bufoff) + ldsw + _i * 8192), 16, 0, 0); } while (0)
#define PG8_LDA(dst, b, h) do { _Pragma("unroll") for (int m = 0; m < 4; ++m) _Pragma("unroll") for (int k = 0; k < 2; ++k) dst[m][k] = *(const PG8_LAS bf16x8*)(lds + PG8_SA(b, h) + aoff + m * 2048 + k * 1024); } while (0)
#define PG8_LDB(dst, b, h) do { _Pragma("unroll") for (int n = 0; n < 2; ++n) _Pragma("unroll") for (int k = 0; k < 2; ++k) dst[n][k] = *(const PG8_LAS bf16x8*)(lds + PG8_SB(b, h) + boff + n * 2048 + k * 1024); } while (0)
#define PG8_MMA(ai, bj, At, Bt) do { __builtin_amdgcn_s_setprio(1); _Pragma("unroll") for (int m = 0; m < 4; ++m) _Pragma("unroll") for (int n = 0; n < 2; ++n) _Pragma("unroll") for (int k = 0; k < 2; ++k) \
        acc[ai][bj][m][n] = __builtin_amdgcn_mfma_f32_16x16x32_bf16(Bt[n][k], At[m][k], acc[ai][bj][m][n], 0, 0, 0); __builtin_amdgcn_s_setprio(0); } while (0)
#define PG8_WAIT_V(n) asm volatile("s_waitcnt vmcnt(" #n ")" ::: "memory")
#define PG8_WAIT_L(n) asm volatile("s_waitcnt lgkmcnt(" #n ")" ::: "memory")
#define PG8_BAR __builtin_amdgcn_s_barrier()
#define PG8_SCHED __builtin_amdgcn_sched_barrier(0)
    Unit cur, nxt; int ui = 0;
    if (!S.next(0, cur)) return;
    f32x4 acc[2][2][4][2];
#pragma unroll
    for (int a = 0; a < 2; ++a)
#pragma unroll
        for (int b = 0; b < 2; ++b)
#pragma unroll
            for (int m = 0; m < 4; ++m)
#pragma unroll
                for (int n = 0; n < 2; ++n) acc[a][b][m][n] = (f32x4){0.f, 0.f, 0.f, 0.f};
    bf16x8 At[4][2], B0[2][2], B1[2][2];
    const char* cA = (const char*)g.A1 + (size_t)cur.pm * tstepA; const char* cB = (const char*)g.B1 + (size_t)cur.pn * tstepB;
    S.a_ready(cur);
    if constexpr (SP2) {
        PG8_STAGE(PG8_SB(0, 0), cB, voffB); PG8_STAGE(PG8_SB(0, 1), cB + hstepB, voffB); PG8_STAGE(PG8_SA(0, 0), cA, voffA); PG8_STAGE(PG8_SA(0, 1), cA + hstepA, voffA);
        if (wr == 1) PG8_BAR;
        PG8_WAIT_V(2); PG8_BAR;
        PG8_STAGE(PG8_SB(1, 0), cB + kstep, voffB); PG8_STAGE(PG8_SA(1, 0), cA + kstep, voffA); PG8_STAGE(PG8_SB(1, 1), cB + hstepB + kstep, voffB);
        PG8_WAIT_V(6); PG8_BAR;
    } else {
        PG8_STAGE(PG8_SB(0, 0), cB, voffB); PG8_STAGE(PG8_SA(0, 0), cA, voffA); PG8_STAGE(PG8_SB(0, 1), cB + hstepB, voffB); PG8_STAGE(PG8_SA(0, 1), cA + hstepA, voffA);
        if (wr == 1) PG8_BAR;
        PG8_WAIT_V(4); PG8_BAR;
        PG8_STAGE(PG8_SB(1, 0), cB + kstep, voffB); PG8_STAGE(PG8_SA(1, 0), cA + kstep, voffA); PG8_STAGE(PG8_SB(1, 1), cB + hstepB + kstep, voffB);
        PG8_WAIT_V(6); PG8_BAR;
    }
    for (;;) {
        const int nhalf = (ui + 1) & 1;
        const bool has_next = S.next((ui + 1) >> 1, nxt);
        const char* nA = has_next ? (const char*)(nhalf ? g.A2 : g.A1) + (size_t)nxt.pm * tstepA : cA; const char* nB = has_next ? (const char*)(nhalf ? g.B2 : g.B1) + (size_t)nxt.pn * tstepB : cB;
        for (int t = 0; t < nt; t += 2) {
            const bool last = (t == nt - 2);
            const char* a1 = cA + (size_t)(t + 1) * kstep;
            const char* a2 = last ? nA : cA + (size_t)(t + 2) * kstep; const char* b2 = last ? nB : cB + (size_t)(t + 2) * kstep;
            const char* a3 = a2 + kstep; const char* b3 = b2 + kstep;
            if (last && has_next) S.a_ready(nxt);
            if constexpr (SP2) {
            PG8_LDB(B0, 0, 0); PG8_LDB(B1, 0, 1); PG8_SCHED; PG8_LDA(At, 0, 0); PG8_STAGE(PG8_SA(1, 1), a1 + hstepA, voffA);
            PG8_WAIT_V(8); PG8_WAIT_L(0); PG8_BAR; PG8_MMA(0, 0, At, B0); PG8_MMA(0, 1, At, B1); PG8_BAR; PG8_SCHED;
            PG8_LDA(At, 0, 1); PG8_STAGE(PG8_SB(0, 0), b2, voffB); PG8_STAGE(PG8_SB(0, 1), b2 + hstepB, voffB); PG8_STAGE(PG8_SA(0, 0), a2, voffA);
            PG8_WAIT_V(8); PG8_WAIT_L(0); PG8_BAR; PG8_MMA(1, 0, At, B0); PG8_MMA(1, 1, At, B1); PG8_BAR; PG8_SCHED;
            PG8_LDB(B0, 1, 0); PG8_LDB(B1, 1, 1); PG8_SCHED; PG8_LDA(At, 1, 0); PG8_STAGE(PG8_SA(0, 1), a2 + hstepA, voffA);
            PG8_WAIT_V(8); PG8_WAIT_L(0); PG8_BAR; PG8_MMA(0, 0, At, B0); PG8_MMA(0, 1, At, B1); PG8_BAR; PG8_SCHED;
            PG8_LDA(At, 1, 1); PG8_STAGE(PG8_SB(1, 0), b3, voffB); PG8_STAGE(PG8_SB(1, 1), b3 + hstepB, voffB); PG8_STAGE(PG8_SA(1, 0), a3, voffA);
            PG8_WAIT_V(8); PG8_WAIT_L(0); PG8_BAR; PG8_MMA(1, 0, At, B0); PG8_MMA(1, 1, At, B1); PG8_BAR; PG8_SCHED;
            } else {
            PG8_LDB(B0, 0, 0); PG8_SCHED; PG8_LDA(At, 0, 0); PG8_STAGE(PG8_SA(1, 1), a1 + hstepA, voffA);
            PG8_WAIT_L(8); PG8_BAR; PG8_WAIT_L(0); PG8_MMA(0, 0, At, B0); PG8_BAR; PG8_SCHED;
            PG8_LDB(B1, 0, 1); PG8_STAGE(PG8_SB(0, 0), b2, voffB);
            PG8_BAR; PG8_WAIT_L(0); PG8_MMA(0, 1, At, B1); PG8_BAR;
            PG8_LDA(At, 0, 1); PG8_STAGE(PG8_SA(0, 0), a2, voffA);
            PG8_BAR; PG8_WAIT_L(0); PG8_MMA(1, 0, At, B0); PG8_BAR; PG8_SCHED;
            PG8_STAGE(PG8_SB(0, 1), b2 + hstepB, voffB);
            PG8_WAIT_V(6); PG8_BAR; PG8_MMA(1, 1, At, B1); PG8_BAR;
            PG8_LDB(B0, 1, 0); PG8_SCHED; PG8_LDA(At, 1, 0); PG8_STAGE(PG8_SA(0, 1), a2 + hstepA, voffA);
            PG8_WAIT_L(8); PG8_BAR; PG8_WAIT_L(0); PG8_MMA(0, 0, At, B0); PG8_BAR; PG8_SCHED;
            PG8_LDB(B1, 1, 1); PG8_STAGE(PG8_SB(1, 0), b3, voffB);
            PG8_BAR; PG8_WAIT_L(0); PG8_MMA(0, 1, At, B1); PG8_BAR;
            PG8_LDA(At, 1, 1); PG8_STAGE(PG8_SA(1, 0), a3, voffA);
            PG8_BAR; PG8_WAIT_L(0); PG8_MMA(1, 0, At, B0); PG8_BAR; PG8_SCHED;
            PG8_STAGE(PG8_SB(1, 1), b3 + hstepB, voffB);
            PG8_WAIT_V(6); PG8_BAR; PG8_MMA(1, 1, At, B1); PG8_BAR;
            }
        }
        if constexpr (ALIGN_EPI) { if (wr == 0) PG8_BAR; }
        if ((ui & 1) == 0) E.mid(acc, cur, wr, wc, fr, fq); else { E(acc, cur, wr, wc, fr, fq); S.done(cur); }
        if (!has_next) break;
        if (ui & 1)
#pragma unroll
        for (int a = 0; a < 2; ++a)
#pragma unroll
            for (int b = 0; b < 2; ++b)
#pragma unroll
                for (int m = 0; m < 4; ++m)
#pragma unroll
                    for (int n = 0; n < 2; ++n) acc[a][b][m][n] = (f32x4){0.f, 0.f, 0.f, 0.f};
        cur = nxt; cA = nA; cB = nB; ++ui;
        if constexpr (ALIGN_EPI) { if (wr == 1) PG8_BAR; }
    }
    PG8_WAIT_V(0);
    if constexpr (!ALIGN_EPI) { if (wr == 0) PG8_BAR; }
    PG8_BAR;
#undef PG8_SA
#undef PG8_SB
#undef PG8_STAGE
#undef PG8_LDA
#undef PG8_LDB
#undef PG8_MMA
#undef PG8_WAIT_V
#undef PG8_WAIT_L
#undef PG8_BAR
#undef PG8_SCHED
}
}

#ifndef PG8_SP2
#define PG8_SP2 true
#endif
#ifndef PG8_ALIGN
#define PG8_ALIGN true
#endif

using pg8::bf16_t; using pg8::f32x4; using pg8::u32x4; using pg8::u32x2; using pg8::cvtpk; using pg8::bf2f; using pg8::bflo; using pg8::bfhi;

constexpr size_t MiB = 1u << 20;
constexpr size_t WS_CTL = 0, CTL_ZERO_BYTES = 32 * 1024;
constexpr size_t WS_ROPE = 1 * MiB;
constexpr size_t WS_WUQ = 3 * MiB, WS_WUKV = 6 * MiB, WS_WOM = 8 * MiB, WS_WOD = 12 * MiB, WS_WOUT = 16 * MiB, WS_WQP = 24 * MiB;
constexpr size_t WS_SKB = 5 * MiB + 512 * 1024;
constexpr size_t WS_W1 = 32 * MiB;
constexpr size_t WS_H = 66 * MiB;
constexpr size_t WS_CQ = 130 * MiB, WS_CKV = 154 * MiB;
constexpr size_t WS_KR = 170 * MiB, WS_DQ = 172 * MiB, WS_DK = 204 * MiB, WS_DV = 236 * MiB;
constexpr size_t WS_G = 268 * MiB;
constexpr size_t WS_QN = 32 * MiB, WS_QR = 64 * MiB, WS_KN = 80 * MiB, WS_V = 396 * MiB;
constexpr size_t WS_OM = 112 * MiB, WS_OD = 428 * MiB;
constexpr size_t WS_TMP = 32 * MiB;
constexpr size_t WS_MG = 172 * MiB;
constexpr size_t WS_X2 = 268 * MiB;
constexpr size_t WS_X2B = 396 * MiB;
constexpr size_t WS_EU = 32 * MiB, WS_EV = 96 * MiB;
constexpr size_t WS_QP = 172 * MiB;
constexpr size_t WS_IDX = 236 * MiB, WS_GT = 244 * MiB;
constexpr size_t WS_PSQ_Q = 460 * MiB, WS_PSQ_KV = 461 * MiB, WS_PSQ2 = 462 * MiB;
constexpr size_t WS_END = 464 * MiB;
constexpr int CW_TMO = 0, CW_CODE = 1, CW_LAMBDA = 8, CW_TOKCTR = 64;
constexpr int CW_BAR = 4096;

constexpr int RING_OFF = 0, RING_BYTES = 131072;
constexpr int LDSCTL_OFF = RING_BYTES, MISC_OFF = LDSCTL_OFF + 320;
constexpr int LDS_BYTES = 147456;
constexpr int NWAVES = 8;

#define GAS __attribute__((address_space(1)))
#define LAS __attribute__((address_space(3)))
typedef unsigned short bf16;
typedef unsigned v4u __attribute__((ext_vector_type(4)));
typedef GAS unsigned gu32;
#define RLX_AGENT __ATOMIC_RELAXED, __HIP_MEMORY_SCOPE_AGENT
#define LDS_WAIT() asm volatile("s_waitcnt lgkmcnt(0)" ::: "memory")
#define VM_WAIT() asm volatile("s_waitcnt vmcnt(0)" ::: "memory")

#define XB_TMO      128
#define XB_XCNT(j)  (256  + 64 * (j))
#define XB_XSUB(j)  (1280 + 64 * (j))
#define XB_XGEN(j)  (2304 + 64 * (j))
#define XB_TOP      3328
#define XB_TOPGEN   3392
#define XCD_BAR_WORDS 3456
#define XB_SPIN_CAP (1u << 22)
__device__ __forceinline__ unsigned xb_ld(unsigned* p)              { return __hip_atomic_load(p, __ATOMIC_RELAXED, __HIP_MEMORY_SCOPE_AGENT); }
__device__ __forceinline__ unsigned xb_add(unsigned* p, unsigned v) { return __hip_atomic_fetch_add(p, v, __ATOMIC_RELAXED, __HIP_MEMORY_SCOPE_AGENT); }
__device__ __forceinline__ unsigned xb_xcc_id() { return (unsigned)__builtin_amdgcn_s_getreg((3 << 11) | 20) & 0xFu; }
#define XB_SPIN(cond, bar) do { unsigned _sp = 0; while (cond) { __builtin_amdgcn_s_sleep(1); \
    if ((++_sp & 255u) == 0u) { if (xb_ld(&(bar)[XB_TMO])) break; if (_sp > XB_SPIN_CAP) { atomicAdd(&(bar)[XB_TMO], 1u); break; } } } } while (0)
struct XcdBarrier { unsigned* bar; unsigned x; volatile LAS unsigned* st; };
__device__ __forceinline__ XcdBarrier xcd_barrier_post(unsigned* bar, volatile LAS unsigned* st) {
    XcdBarrier b; b.bar = bar; b.x = xb_xcc_id(); b.st = st;
    if (threadIdx.x == 0) (void)xb_add(&bar[XB_XCNT(b.x)], 1u);
    return b;
}
__device__ __forceinline__ void xcd_barrier_complete(unsigned* bar, unsigned x, unsigned& nloc, unsigned& nx) {
    const unsigned G = gridDim.x * gridDim.y * gridDim.z;
    unsigned sum, cnt, mine, sp = 0u;
    for (;;) {
        sum = 0u; cnt = 0u; mine = 0u;
#pragma unroll
        for (unsigned j = 0; j < 16; ++j) { const unsigned c = xb_ld(&bar[XB_XCNT(j)]); sum += c; cnt += (c > 0u) ? 1u : 0u; mine = (j == x) ? c : mine; }
        if (sum == G) break;
        __builtin_amdgcn_s_sleep(1);
        if ((++sp & 255u) == 0u) { if (xb_ld(&bar[XB_TMO])) break; if (sp > XB_SPIN_CAP) { atomicAdd(&bar[XB_TMO], 1u); break; } }
    }
    nloc = mine > 0u ? mine : 1u; nx = cnt > 0u ? cnt : 1u;
}
__device__ __forceinline__ void xcd_barrier(const XcdBarrier& b) {
    asm volatile("s_waitcnt vmcnt(0)" ::: "memory");
    __syncthreads();
    if (threadIdx.x == 0) {
        unsigned* bar = b.bar;
        __builtin_amdgcn_s_waitcnt(0);
        unsigned nloc = b.st[0], nx = b.st[1];
        if (nloc == 0u) { xcd_barrier_complete(bar, b.x, nloc, nx); b.st[0] = nloc; b.st[1] = nx; }
        const unsigned old = xb_add(&bar[XB_XSUB(b.x)], 1u);
        const unsigned gen = old / nloc;
        if (old + 1u == (gen + 1u) * nloc) {
            __builtin_amdgcn_fence(__ATOMIC_RELEASE, "agent");
            asm volatile("s_waitcnt vmcnt(0)" ::: "memory");
            const unsigned og = xb_add(&bar[XB_TOP], 1u);
            const unsigned tg = og / nx;
            if (og + 1u == (tg + 1u) * nx) xb_add(&bar[XB_TOPGEN], 1u);
            else XB_SPIN(xb_ld(&bar[XB_TOPGEN]) == tg, bar);
            __builtin_amdgcn_fence(__ATOMIC_ACQUIRE, "agent");
            xb_add(&bar[XB_XGEN(b.x)], 1u);
            asm volatile("s_waitcnt vmcnt(0)" ::: "memory");
        } else {
            XB_SPIN(xb_ld(&bar[XB_XGEN(b.x)]) == gen, bar);
            __builtin_amdgcn_fence(__ATOMIC_ACQUIRE, "agent");
            asm volatile("s_waitcnt vmcnt(0)" ::: "memory");
        }
    }
    __syncthreads();
}

struct Frame {
    LAS unsigned char* lds;
    volatile LAS unsigned* MISC;
    gu32* ctl;
    unsigned char* ws;
    int tid, lane, wave, vcu, G;
};

__device__ __forceinline__ float wave_sum(float v) {
#pragma unroll
    for (int o = 1; o < 64; o <<= 1) v += __shfl_xor(v, o);
    return v;
}
__device__ __forceinline__ float wave_max(float v) {
#pragma unroll
    for (int o = 1; o < 64; o <<= 1) v = fmaxf(v, __shfl_xor(v, o));
    return v;
}
__device__ __forceinline__ unsigned pk2(float lo, float hi) { return cvtpk(lo, hi); }

template <class Map>
__device__ __forceinline__ void tr_item(const float* W, int Nsrc, int K, const float* kscale, bf16* WT, LAS float* scr, int item, int nblk, int lane, Map map) {
    const int kb = item / nblk, nb = item % nblk, k0 = 64 * kb, n0 = 32 * nb;
    const int sc = map(n0 + (lane & 31));
    float tv[32];
    const int scc = sc >= 0 ? sc : 0;
#pragma unroll
    for (int i = 0; i < 32; ++i) { const int kk = 2 * i + (lane >> 5); tv[i] = W[(size_t)(k0 + kk) * Nsrc + scc]; }
#pragma unroll
    for (int i = 0; i < 32; ++i) { const int kk = 2 * i + (lane >> 5); float v = sc >= 0 ? tv[i] : 0.f; if (kscale) v *= kscale[k0 + kk]; scr[kk * 33 + (lane & 31)] = v; }
    LDS_WAIT(); asm volatile("" ::: "memory");
    const int c = lane & 7;
#pragma unroll
    for (int j = 0; j < 4; ++j) { const int n = (lane >> 3) + 8 * j; const LAS float* s = scr + (8 * c) * 33 + n;
        v4u o; o.x = pk2(s[0 * 33], s[1 * 33]); o.y = pk2(s[2 * 33], s[3 * 33]); o.z = pk2(s[4 * 33], s[5 * 33]); o.w = pk2(s[6 * 33], s[7 * 33]);
        *(GAS v4u*)(WT + (size_t)(n0 + n) * K + k0 + 8 * c) = o; }
    LDS_WAIT(); asm volatile("" ::: "memory");
}
__device__ __forceinline__ int rope_src(int jj) { return (jj & 1) * 32 + (jj >> 1); }
struct MapW1 { __device__ int operator()(int n) const {
    if (n < 1280) return n;
    if (n < 2304) { const int j = n - 1280; return OFF_DQ + (j & ~63) + rope_src(j & 63); }
    if (n < 3328) { const int j = n - 2304; return OFF_DK + (j & ~63) + rope_src(j & 63); }
    if (n < 4352) return OFF_DV + (n - 3328);
    if (n < 8448) return OFF_GATE + (n - 4352);
    if (n < 8512) return OFF_KR + rope_src(n - 8448);
    return -1; } };
struct MapUQ { __device__ int operator()(int n) const {
    if (n < 1024) return (n >> 7) * 192 + (n & 127);
    const int j = n - 1024; return (j >> 6) * 192 + 128 + rope_src(j & 63); } };
struct MapUKV { __device__ int operator()(int n) const {
    if (n < 1024) return (n >> 7) * 256 + (n & 127);
    const int j = n - 1024; return (j >> 7) * 256 + 128 + (j & 127); } };
struct MapId { __device__ int operator()(int n) const { return n; } };

struct Ins { const float *x, *w_in, *b_gate, *g_norm1, *g_cq, *w_uq, *g_ckv, *w_ukv, *w_o_mla, *lambda_qk, *g_subln, *w_o_diff, *w_out, *g_norm2, *w_q_peer, *sub_keys, *expert_u, *expert_v, *g_final; };

__device__ __forceinline__ void p0_prologue(Frame& F, const Ins& I, const double* inv_freq) {
    LAS float* scr = (LAS float*)(F.lds + RING_OFF + F.wave * 16384);
    const int gw = F.vcu * NWAVES + F.wave, NGW = F.G * NWAVES;
    unsigned char* ws = F.ws;
    constexpr int I_W1 = (2048 / 64) * (N1 / 32), I_UQ = (768 / 64) * (1536 / 32), I_UKV = (512 / 64) * (2048 / 32), I_OM = (1024 / 64) * (2048 / 32), I_OD = I_OM, I_OUT = (2048 / 64) * (2048 / 32), I_QP = I_OUT;
    constexpr int NITEMS = I_W1 + I_UQ + I_UKV + I_OM + I_OD + I_OUT + I_QP;
    for (int it = gw; it < NITEMS; it += NGW) {
        int r = it;
        if (r < I_W1) { tr_item(I.w_in, IN_COLS, 2048, nullptr, (bf16*)(ws + WS_W1), scr, r, N1 / 32, F.lane, MapW1()); continue; } r -= I_W1;
        if (r < I_UQ) { tr_item(I.w_uq, 1536, 768, I.g_cq, (bf16*)(ws + WS_WUQ), scr, r, 1536 / 32, F.lane, MapUQ()); continue; } r -= I_UQ;
        if (r < I_UKV) { tr_item(I.w_ukv, 2048, 512, I.g_ckv, (bf16*)(ws + WS_WUKV), scr, r, 2048 / 32, F.lane, MapUKV()); continue; } r -= I_UKV;
        if (r < I_OM) { tr_item(I.w_o_mla, 2048, 1024, nullptr, (bf16*)(ws + WS_WOM), scr, r, 2048 / 32, F.lane, MapId()); continue; } r -= I_OM;
        if (r < I_OD) { tr_item(I.w_o_diff, 2048, 1024, nullptr, (bf16*)(ws + WS_WOD), scr, r, 2048 / 32, F.lane, MapId()); continue; } r -= I_OD;
        if (r < I_OUT) { tr_item(I.w_out, 2048, 2048, nullptr, (bf16*)(ws + WS_WOUT), scr, r, 2048 / 32, F.lane, MapId()); continue; } r -= I_OUT;
        tr_item(I.w_q_peer, 2048, 2048, I.g_norm2, (bf16*)(ws + WS_WQP), scr, r, 2048 / 32, F.lane, MapId());
    }
    {
        bf16* skb = (bf16*)(ws + WS_SKB);
        for (int e = gw * 64 + F.lane; e < 256 * 256; e += NGW * 64) {
            const int n = e >> 8, k = e & 255; float v = 0.f;
            if (n < 128 && k < 128) v = I.sub_keys[n * 128 + k];
            else if (n >= 128 && k >= 128) v = I.sub_keys[128 * 128 + (n - 128) * 128 + (k - 128)];
            skb[e] = (bf16)(pk2(v, 0.f) & 0xffffu);
        }
    }
    {
        float* rope = (float*)(ws + WS_ROPE);
        for (int e = gw * 64 + F.lane; e < SEQ * 32; e += NGW * 64) {
            const int pos = e >> 5, i = e & 31;
            const double rev = (double)pos * inv_freq[i] * 0.15915494309189535;
            const float fr = (float)(rev - floor(rev));
            rope[2 * e] = __builtin_amdgcn_cosf(fr); rope[2 * e + 1] = __builtin_amdgcn_sinf(fr);
        }
    }
    if (blockIdx.x == 0 && F.tid == 0) {
        float a = 0.f, b = 0.f;
        for (int d = 0; d < 64; ++d) { a += I.lambda_qk[d] * I.lambda_qk[64 + d]; b += I.lambda_qk[128 + d] * I.lambda_qk[192 + d]; }
        const float lam = __expf(a) - __expf(b) + LAMBDA_INIT;
        ((float*)F.ctl)[CW_LAMBDA] = lam;
    }
    {
        bf16* H = (bf16*)(ws + WS_H);
        f32x4 g[8];
#pragma unroll
        for (int j = 0; j < 8; ++j) g[j] = *((const f32x4*)I.g_norm1 + F.lane + 64 * j);
        for (int m = gw; m < T; m += NGW) {
            const GAS f32x4* xr = (const GAS f32x4*)(I.x + (size_t)m * D_MODEL) + F.lane;
            f32x4 v[8]; float s = 0.f;
#pragma unroll
            for (int j = 0; j < 8; ++j) { v[j] = xr[64 * j]; s += (v[j].x * v[j].x + v[j].y * v[j].y) + (v[j].z * v[j].z + v[j].w * v[j].w); }
            const float rstd = 1.0f / sqrtf(wave_sum(s) * (1.f / D_MODEL) + EPS);
            GAS u32x2* o8 = (GAS u32x2*)(H + (size_t)m * D_MODEL) + F.lane;
#pragma unroll
            for (int j = 0; j < 8; ++j) { u32x2 w; w.x = pk2(v[j].x * rstd * g[j].x, v[j].y * rstd * g[j].y); w.y = pk2(v[j].z * rstd * g[j].z, v[j].w * rstd * g[j].w); o8[64 * j] = w; }
        }
    }
}

__device__ __forceinline__ void convert_experts(Frame& F, const Ins& I) {
    const size_t gt = (size_t)(F.vcu * NWAVES * 64) + F.tid, NT = (size_t)F.G * NWAVES * 64;
    const size_t nchunk = (size_t)NEXP * D_MODEL / 8;
    bf16* EU = (bf16*)(F.ws + WS_EU); bf16* EV = (bf16*)(F.ws + WS_EV);
    for (size_t c = gt; c < nchunk; c += NT) {
        const int d = (int)((c * 8) & (D_MODEL - 1));
        const f32x4 a0 = *(const GAS f32x4*)(I.expert_u + c * 8), a1 = *(const GAS f32x4*)(I.expert_u + c * 8 + 4);
        const f32x4 g0 = *(const f32x4*)(I.g_norm2 + d), g1 = *(const f32x4*)(I.g_norm2 + d + 4);
        v4u o; o.x = pk2(a0.x * g0.x, a0.y * g0.y); o.y = pk2(a0.z * g0.z, a0.w * g0.w); o.z = pk2(a1.x * g1.x, a1.y * g1.y); o.w = pk2(a1.z * g1.z, a1.w * g1.w);
        *(GAS v4u*)(EU + c * 8) = o;
        const f32x4 b0 = *(const GAS f32x4*)(I.expert_v + c * 8), b1 = *(const GAS f32x4*)(I.expert_v + c * 8 + 4);
        v4u p; p.x = pk2(b0.x, b0.y); p.y = pk2(b0.z, b0.w); p.z = pk2(b1.x, b1.y); p.w = pk2(b1.z, b1.w);
        *(GAS v4u*)(EV + c * 8) = p;
    }
}

__device__ __forceinline__ float sigmoidf_fast(float x) { return __builtin_amdgcn_rcpf(1.0f + __builtin_amdgcn_exp2f(-x * LOG2E)); }
__device__ __forceinline__ void rope8(f32x4& v0, f32x4& v1, const f32x4 cs0, const f32x4 cs1, float sc) {
    const float a0 = v0[0] * cs0[0] - v0[1] * cs0[1], b0 = v0[1] * cs0[0] + v0[0] * cs0[1];
    const float a1 = v0[2] * cs0[2] - v0[3] * cs0[3], b1 = v0[3] * cs0[2] + v0[2] * cs0[3];
    const float a2 = v1[0] * cs1[0] - v1[1] * cs1[1], b2 = v1[1] * cs1[0] + v1[0] * cs1[1];
    const float a3 = v1[2] * cs1[2] - v1[3] * cs1[3], b3 = v1[3] * cs1[2] + v1[2] * cs1[3];
    v0 = (f32x4){a0 * sc, b0 * sc, a1 * sc, b1 * sc}; v1 = (f32x4){a2 * sc, b2 * sc, a3 * sc, b3 * sc};
}
__device__ __forceinline__ u32x4 pack8(const f32x4 v0, const f32x4 v1) { u32x4 w; w.x = cvtpk(v0[0], v0[1]); w.y = cvtpk(v0[2], v0[3]); w.z = cvtpk(v1[0], v1[1]); w.w = cvtpk(v1[2], v1[3]); return w; }

__device__ __forceinline__ size_t kt_off(size_t row, int col) { const size_t b = row >> 13; const int pos = (int)(row & 8191), tile = pos >> 6, key = pos & 63, h = col >> 7, piece = (col & 127) >> 3;
    return (((b * 8 + h) * 128 + tile) * 16 + piece) * 512 + key * 8 + (col & 7); }
__device__ __forceinline__ size_t vt_off(size_t row, int col) { const size_t b = row >> 13; const int pos = (int)(row & 8191), tile = pos >> 6, key = pos & 63, h = col >> 7, d = col & 127;
    return (((b * 8 + h) * 128 + tile) * 16 + (d >> 5) * 4 + (key >> 4)) * 512 + (key & 15) * 32 + (d & 31); }
__device__ __forceinline__ size_t krt_off(size_t row, int col) { const size_t b = row >> 13; const int pos = (int)(row & 8191), tile = pos >> 6, key = pos & 63;
    return ((b * 128 + tile) * 8 + (col >> 3)) * 512 + key * 8 + (col & 7); }
struct EpiProj {
    static constexpr bool PERM = true;
    bf16_t *CQ, *CKV, *DQ, *DK, *DV, *G, *KR; float *ssq_q, *ssq_kv; const float* bgate; const float* rope;
    __device__ __forceinline__ void operator()(const f32x4 (&acc)[2][2][4][2], const pg8::Unit& u, int wr, int wc, int fr, int fq) const {
        const int row0 = u.pm * 256 + wr * 64 + fr, pn = u.pn, colw = wc * 32 + 8 * fq;
        if (pn < 5) {
            bf16_t* O; int ldc, ct, nsl, sl; float* ssq;
            if (pn < 3) { O = CQ; ldc = 768; ct = pn * 256; ssq = ssq_q; nsl = 12; sl = pn * 4 + wc; } else { O = CKV; ldc = 512; ct = (pn - 3) * 256; ssq = ssq_kv; nsl = 8; sl = (pn - 3) * 4 + wc; }
#pragma unroll
            for (int ai = 0; ai < 2; ++ai)
#pragma unroll
                for (int m = 0; m < 4; ++m) { const int row = row0 + ai * 128 + m * 16; float s = 0.f;
#pragma unroll
                    for (int bj = 0; bj < 2; ++bj) { const f32x4 v0 = acc[ai][bj][m][0], v1 = acc[ai][bj][m][1];
                        s += (v0[0] * v0[0] + v0[1] * v0[1]) + (v0[2] * v0[2] + v0[3] * v0[3]) + (v1[0] * v1[0] + v1[1] * v1[1]) + (v1[2] * v1[2] + v1[3] * v1[3]);
                        *(u32x4*)(O + (size_t)row * ldc + ct + bj * 128 + colw) = pack8(v0, v1); }
                    s += __shfl_xor(s, 16); s += __shfl_xor(s, 32);
                    if (fq == 0) ssq[(size_t)row * nsl + sl] = s; }
        } else if (pn < 13) {
            const bool isq = pn < 9; bf16_t* O = isq ? DQ : DK; const int ct = (pn - (isq ? 5 : 9)) * 256; const float sc = isq ? C2_DIFF : 1.0f;
            const int i0 = ((wc & 1) * 32 + 8 * fq) >> 1;
#pragma unroll
            for (int ai = 0; ai < 2; ++ai)
#pragma unroll
                for (int m = 0; m < 4; ++m) { const int row = row0 + ai * 128 + m * 16; const int pos = row & (SEQ - 1);
                    const f32x4 cs0 = *(const f32x4*)(rope + (size_t)(pos * 32 + i0) * 2), cs1 = *(const f32x4*)(rope + (size_t)(pos * 32 + i0 + 2) * 2);
#pragma unroll
                    for (int bj = 0; bj < 2; ++bj) { f32x4 v0 = acc[ai][bj][m][0], v1 = acc[ai][bj][m][1]; rope8(v0, v1, cs0, cs1, sc);
                        const int col = ct + bj * 128 + colw;
                        *(u32x4*)(O + (isq ? (size_t)row * 1024 + col : kt_off(row, col))) = pack8(v0, v1); } }
        } else if (pn < 17) {
            const int ct = (pn - 13) * 256;
#pragma unroll
            for (int ai = 0; ai < 2; ++ai)
#pragma unroll
                for (int m = 0; m < 4; ++m) { const int row = row0 + ai * 128 + m * 16;
#pragma unroll
                    for (int bj = 0; bj < 2; ++bj) *(u32x4*)(DV + vt_off(row, ct + bj * 128 + colw)) = pack8(acc[ai][bj][m][0], acc[ai][bj][m][1]); }
        } else if (pn < 33) {
            const int ct = (pn - 17) * 256;
            f32x4 bv[2][2];
#pragma unroll
            for (int bj = 0; bj < 2; ++bj) { bv[bj][0] = *(const f32x4*)(bgate + ct + bj * 128 + colw); bv[bj][1] = *(const f32x4*)(bgate + ct + bj * 128 + colw + 4); }
#pragma unroll
            for (int ai = 0; ai < 2; ++ai)
#pragma unroll
                for (int m = 0; m < 4; ++m) { const int row = row0 + ai * 128 + m * 16;
#pragma unroll
                    for (int bj = 0; bj < 2; ++bj) { f32x4 v0 = acc[ai][bj][m][0] + bv[bj][0], v1 = acc[ai][bj][m][1] + bv[bj][1];
#pragma unroll
                        for (int e = 0; e < 4; ++e) { v0[e] = sigmoidf_fast(v0[e]); v1[e] = sigmoidf_fast(v1[e]); }
                        *(u32x4*)(G + (size_t)row * 4096 + ct + bj * 128 + colw) = pack8(v0, v1); } }
        } else {
            if (wc < 2) {
                const int i0 = colw >> 1;
#pragma unroll
                for (int ai = 0; ai < 2; ++ai)
#pragma unroll
                    for (int m = 0; m < 4; ++m) { const int row = row0 + ai * 128 + m * 16; const int pos = row & (SEQ - 1);
                        const f32x4 cs0 = *(const f32x4*)(rope + (size_t)(pos * 32 + i0) * 2), cs1 = *(const f32x4*)(rope + (size_t)(pos * 32 + i0 + 2) * 2);
                        f32x4 v0 = acc[ai][0][m][0], v1 = acc[ai][0][m][1]; rope8(v0, v1, cs0, cs1, 1.0f);
                        *(u32x4*)(KR + krt_off(row, colw)) = pack8(v0, v1); }
            }
        }
    }
};

struct EpiQup {
    static constexpr bool PERM = true;
    bf16_t *QN, *QR; const float* ssq; const float* rope;
    __device__ __forceinline__ void operator()(const f32x4 (&acc)[2][2][4][2], const pg8::Unit& u, int wr, int wc, int fr, int fq) const {
        const int row0 = u.pm * 256 + wr * 64 + fr, pn = u.pn, colw = wc * 32 + 8 * fq;
        const int i0 = ((wc & 1) * 32 + 8 * fq) >> 1;
#pragma unroll
        for (int ai = 0; ai < 2; ++ai)
#pragma unroll
            for (int m = 0; m < 4; ++m) { const int row = row0 + ai * 128 + m * 16; const int pos = row & (SEQ - 1);
                const f32x4 q0 = *(const f32x4*)(ssq + (size_t)row * 12), q1 = *(const f32x4*)(ssq + (size_t)row * 12 + 4), q2 = *(const f32x4*)(ssq + (size_t)row * 12 + 8);
                const float sq = (((q0[0] + q0[1]) + (q0[2] + q0[3])) + ((q1[0] + q1[1]) + (q1[2] + q1[3]))) + ((q2[0] + q2[1]) + (q2[2] + q2[3]));
                const float sc = C2_MLA / sqrtf(sq * (1.0f / 768.0f) + EPS);
                if (pn < 4) {
#pragma unroll
                    for (int bj = 0; bj < 2; ++bj) *(u32x4*)(QN + (size_t)row * 1024 + pn * 256 + bj * 128 + colw) = pack8(acc[ai][bj][m][0] * sc, acc[ai][bj][m][1] * sc);
                } else {
                    const f32x4 cs0 = *(const f32x4*)(rope + (size_t)(pos * 32 + i0) * 2), cs1 = *(const f32x4*)(rope + (size_t)(pos * 32 + i0 + 2) * 2);
#pragma unroll
                    for (int bj = 0; bj < 2; ++bj) { f32x4 v0 = acc[ai][bj][m][0], v1 = acc[ai][bj][m][1]; rope8(v0, v1, cs0, cs1, sc);
                        *(u32x4*)(QR + (size_t)row * 512 + (pn - 4) * 256 + bj * 128 + colw) = pack8(v0, v1); }
                } }
    }
};
struct EpiKVup {
    static constexpr bool PERM = true;
    bf16_t *KN, *V; const float* ssq;
    __device__ __forceinline__ void operator()(const f32x4 (&acc)[2][2][4][2], const pg8::Unit& u, int wr, int wc, int fr, int fq) const {
        const int row0 = u.pm * 256 + wr * 64 + fr, pn = u.pn, colw = wc * 32 + 8 * fq;
        bf16_t* O = pn < 4 ? KN : V; const int ct = (pn & 3) * 256;
#pragma unroll
        for (int ai = 0; ai < 2; ++ai)
#pragma unroll
            for (int m = 0; m < 4; ++m) { const int row = row0 + ai * 128 + m * 16;
                const f32x4 q0 = *(const f32x4*)(ssq + (size_t)row * 8), q1 = *(const f32x4*)(ssq + (size_t)row * 8 + 4);
                const float sq = ((q0[0] + q0[1]) + (q0[2] + q0[3])) + ((q1[0] + q1[1]) + (q1[2] + q1[3]));
                const float sc = 1.0f / sqrtf(sq * (1.0f / 512.0f) + EPS);
#pragma unroll
                for (int bj = 0; bj < 2; ++bj) { const int col = ct + bj * 128 + colw; *(u32x4*)(O + (pn < 4 ? kt_off(row, col) : vt_off(row, col))) = pack8(acc[ai][bj][m][0] * sc, acc[ai][bj][m][1] * sc); } }
    }
};
struct EpiGate {
    static constexpr bool PERM = true;
    const bf16_t* G; bf16_t* TMP; bf16_t* MG; int second;
    __device__ __forceinline__ void operator()(const f32x4 (&acc)[2][2][4][2], const pg8::Unit& u, int wr, int wc, int fr, int fq) const {
        const int row0 = u.pm * 256 + wr * 64 + fr, colw = u.pn * 256 + wc * 32 + 8 * fq;
#pragma unroll
        for (int ai = 0; ai < 2; ++ai)
#pragma unroll
            for (int m = 0; m < 4; ++m) { const int row = row0 + ai * 128 + m * 16;
#pragma unroll
                for (int bj = 0; bj < 2; ++bj) { const int col = colw + bj * 128;
                    const u32x4 gw = *(const u32x4*)(G + (size_t)row * 4096 + (second ? 2048 : 0) + col);
                    f32x4 v0 = acc[ai][bj][m][0], v1 = acc[ai][bj][m][1];
                    v0 = (f32x4){v0[0] * bflo(gw.x), v0[1] * bfhi(gw.x), v0[2] * bflo(gw.y), v0[3] * bfhi(gw.y)};
                    v1 = (f32x4){v1[0] * bflo(gw.z), v1[1] * bfhi(gw.z), v1[2] * bflo(gw.w), v1[3] * bfhi(gw.w)};
                    if (second) { const u32x4 tw = *(const u32x4*)(TMP + (size_t)row * 2048 + col);
                        v0 += (f32x4){bflo(tw.x), bfhi(tw.x), bflo(tw.y), bfhi(tw.y)}; v1 += (f32x4){bflo(tw.z), bfhi(tw.z), bflo(tw.w), bfhi(tw.w)};
                        *(u32x4*)(MG + (size_t)row * 2048 + col) = pack8(v0, v1);
                    } else *(u32x4*)(TMP + (size_t)row * 2048 + col) = pack8(v0, v1); } }
    }
};
struct EpiGate2 {
    static constexpr bool PERM = true;
    const bf16_t* G; bf16_t* MG;
    __device__ __forceinline__ void mid(f32x4 (&acc)[2][2][4][2], const pg8::Unit& u, int wr, int wc, int fr, int fq) const {
        const int row0 = u.pm * 256 + wr * 64 + fr, colw = u.pn * 256 + wc * 32 + 8 * fq;
#pragma unroll
        for (int ai = 0; ai < 2; ++ai)
#pragma unroll
            for (int m = 0; m < 4; ++m) { const int row = row0 + ai * 128 + m * 16;
#pragma unroll
                for (int bj = 0; bj < 2; ++bj) { const int col = colw + bj * 128;
                    const u32x4 ga = *(const u32x4*)(G + (size_t)row * 4096 + col), gb = *(const u32x4*)(G + (size_t)row * 4096 + 2048 + col);
                    f32x4 r0, r1;
                    r0[0] = bflo(ga.x) * __builtin_amdgcn_rcpf(bflo(gb.x)); r0[1] = bfhi(ga.x) * __builtin_amdgcn_rcpf(bfhi(gb.x)); r0[2] = bflo(ga.y) * __builtin_amdgcn_rcpf(bflo(gb.y)); r0[3] = bfhi(ga.y) * __builtin_amdgcn_rcpf(bfhi(gb.y));
                    r1[0] = bflo(ga.z) * __builtin_amdgcn_rcpf(bflo(gb.z)); r1[1] = bfhi(ga.z) * __builtin_amdgcn_rcpf(bfhi(gb.z)); r1[2] = bflo(ga.w) * __builtin_amdgcn_rcpf(bflo(gb.w)); r1[3] = bfhi(ga.w) * __builtin_amdgcn_rcpf(bfhi(gb.w));
                    acc[ai][bj][m][0] *= r0; acc[ai][bj][m][1] *= r1; }
                asm volatile("" ::: "memory"); }
    }
    __device__ __forceinline__ void operator()(const f32x4 (&acc)[2][2][4][2], const pg8::Unit& u, int wr, int wc, int fr, int fq) const {
        const int row0 = u.pm * 256 + wr * 64 + fr, colw = u.pn * 256 + wc * 32 + 8 * fq;
#pragma unroll
        for (int ai = 0; ai < 2; ++ai)
#pragma unroll
            for (int m = 0; m < 4; ++m) { const int row = row0 + ai * 128 + m * 16;
#pragma unroll
                for (int bj = 0; bj < 2; ++bj) { const int col = colw + bj * 128;
                    const u32x4 gb = *(const u32x4*)(G + (size_t)row * 4096 + 2048 + col);
                    f32x4 v0 = acc[ai][bj][m][0], v1 = acc[ai][bj][m][1];
                    v0 = (f32x4){v0[0] * bflo(gb.x), v0[1] * bfhi(gb.x), v0[2] * bflo(gb.y), v0[3] * bfhi(gb.y)};
                    v1 = (f32x4){v1[0] * bflo(gb.z), v1[1] * bfhi(gb.z), v1[2] * bflo(gb.w), v1[3] * bfhi(gb.w)};
                    *(u32x4*)(MG + (size_t)row * 2048 + col) = pack8(v0, v1); } }
    }
};
struct EpiRes {
    static constexpr bool PERM = false;
    const float* x; float* X2; bf16_t* X2B; float* ssq;
    __device__ __forceinline__ void operator()(const f32x4 (&acc)[2][2][4][2], const pg8::Unit& u, int wr, int wc, int fr, int fq) const {
        const int row0 = u.pm * 256 + wr * 64 + fr, col0 = u.pn * 256 + wc * 32 + 4 * fq;
#pragma unroll
        for (int ai = 0; ai < 2; ++ai)
#pragma unroll
            for (int m = 0; m < 4; ++m) { const int row = row0 + ai * 128 + m * 16; float s = 0.f;
#pragma unroll
                for (int bj = 0; bj < 2; ++bj)
#pragma unroll
                    for (int n = 0; n < 2; ++n) { const size_t off = (size_t)row * 2048 + col0 + bj * 128 + n * 16;
                        const f32x4 v = acc[ai][bj][m][n] + *(const f32x4*)(x + off);
                        s += (v[0] * v[0] + v[1] * v[1]) + (v[2] * v[2] + v[3] * v[3]);
#ifdef PEER_BF16
                        *(f32x4*)(X2 + off) = v;
#endif
                        u32x2 w; w.x = cvtpk(v[0], v[1]); w.y = cvtpk(v[2], v[3]); *(u32x2*)(X2B + off) = w; }
                s += __shfl_xor(s, 16); s += __shfl_xor(s, 32);
                if (fq == 0) ssq[(size_t)row * 32 + u.pn * 4 + wc] = s; }
    }
};
__device__ __forceinline__ float sum32(const float* p) { float t = 0.f;
#pragma unroll
    for (int i = 0; i < 8; ++i) { const f32x4 q = *(const f32x4*)(p + 4 * i); t += (q[0] + q[1]) + (q[2] + q[3]); } return t; }
constexpr int RTAB_OFF = 132096, RTAB_SLOTS = 4;
struct EpiQP {
    static constexpr bool PERM = true;
    bf16_t* QP; const float* ssq; const LAS float* tab; int pms[RTAB_SLOTS];
    __device__ __forceinline__ void operator()(const f32x4 (&acc)[2][2][4][2], const pg8::Unit& u, int wr, int wc, int fr, int fq) const {
        const int row0 = u.pm * 256 + wr * 64 + fr, colw = u.pn * 256 + wc * 32 + 8 * fq;
        int slot = -1;
#pragma unroll
        for (int i = RTAB_SLOTS - 1; i >= 0; --i) if (pms[i] == u.pm) slot = i;
#pragma unroll
        for (int ai = 0; ai < 2; ++ai)
#pragma unroll
            for (int m = 0; m < 4; ++m) { const int row = row0 + ai * 128 + m * 16;
                const float sc = slot >= 0 ? tab[slot * 256 + wr * 64 + fr + ai * 128 + m * 16] : 1.0f / sqrtf(sum32(ssq + (size_t)row * 32) * (1.0f / 2048.0f) + EPS);
#pragma unroll
                for (int bj = 0; bj < 2; ++bj) *(u32x4*)(QP + (size_t)row * 2048 + colw + bj * 128) = pack8(acc[ai][bj][m][0] * sc, acc[ai][bj][m][1] * sc); }
    }
};

template <class KaF, class KbF, class VF>
__device__ __forceinline__ void naive_attn(LAS float* qs, const bf16* qa, int ldqa, int da, const bf16* qb, int ldqb, int db,
                                           KaF ka_f, KbF kb_f, VF v_f,
                                           size_t rowbase, int p0, int lane, float (&o)[4][2], float (&linv)[4]) {
    const int dt = da + db;
    for (int idx = lane; idx < 4 * dt; idx += 64) { const int r = idx / dt, d = idx - r * dt;
        const bf16 h = d < da ? qa[(rowbase + p0 + r) * ldqa + d] : qb[(rowbase + p0 + r) * ldqb + (d - da)];
        qs[r * 192 + d] = bf2f(h); }
    LDS_WAIT(); asm volatile("" ::: "memory");
    float m[4], l[4];
#pragma unroll
    for (int r = 0; r < 4; ++r) { m[r] = -INFINITY; l[r] = 0.f; o[r][0] = 0.f; o[r][1] = 0.f; }
    const int pmax = p0 + 3, ntile = pmax / 64 + 1;
#pragma unroll 1
    for (int kt = 0; kt < ntile; ++kt) {
        const int key = kt * 64 + lane, kc = key < pmax ? key : pmax;
        float s[4] = {0.f, 0.f, 0.f, 0.f};
#pragma unroll 2
        for (int d = 0; d < da; d += 8) { const u32x4 kw = *(const u32x4*)ka_f(rowbase + kc, d);
            const float k0 = bflo(kw.x), k1 = bfhi(kw.x), k2 = bflo(kw.y), k3 = bfhi(kw.y), k4 = bflo(kw.z), k5 = bfhi(kw.z), k6 = bflo(kw.w), k7 = bfhi(kw.w);
#pragma unroll
            for (int r = 0; r < 4; ++r) { const f32x4 qa4 = *(const LAS f32x4*)(qs + r * 192 + d), qb4 = *(const LAS f32x4*)(qs + r * 192 + d + 4);
                s[r] += (qa4[0] * k0 + qa4[1] * k1) + (qa4[2] * k2 + qa4[3] * k3) + (qb4[0] * k4 + qb4[1] * k5) + (qb4[2] * k6 + qb4[3] * k7); } }
        if (db > 0) {
#pragma unroll 2
            for (int d = 0; d < db; d += 8) { const u32x4 kw = *(const u32x4*)kb_f(rowbase + kc, d);
                const float k0 = bflo(kw.x), k1 = bfhi(kw.x), k2 = bflo(kw.y), k3 = bfhi(kw.y), k4 = bflo(kw.z), k5 = bfhi(kw.z), k6 = bflo(kw.w), k7 = bfhi(kw.w);
#pragma unroll
                for (int r = 0; r < 4; ++r) { const f32x4 qa4 = *(const LAS f32x4*)(qs + r * 192 + da + d), qb4 = *(const LAS f32x4*)(qs + r * 192 + da + d + 4);
                    s[r] += (qa4[0] * k0 + qa4[1] * k1) + (qa4[2] * k2 + qa4[3] * k3) + (qb4[0] * k4 + qb4[1] * k5) + (qb4[2] * k6 + qb4[3] * k7); } } }
        float p[4];
#pragma unroll
        for (int r = 0; r < 4; ++r) {
            const float sv = key > p0 + r ? -INFINITY : s[r];
            const float mn = fmaxf(m[r], wave_max(sv));
            const float al = __builtin_amdgcn_exp2f(m[r] - mn);
            p[r] = __builtin_amdgcn_exp2f(sv - mn);
            l[r] = l[r] * al + wave_sum(p[r]); o[r][0] *= al; o[r][1] *= al; m[r] = mn;
        }
        const int jn = (pmax - kt * 64) < 63 ? (pmax - kt * 64) : 63;
#pragma unroll 4
        for (int j = 0; j <= jn; ++j) {
            const float v0 = bf2f(v_f(rowbase + kt * 64 + j, lane)), v1 = bf2f(v_f(rowbase + kt * 64 + j, 64 + lane));
#pragma unroll
            for (int r = 0; r < 4; ++r) { const float pj = __builtin_bit_cast(float, __builtin_amdgcn_readlane(__builtin_bit_cast(int, p[r]), j)); o[r][0] += pj * v0; o[r][1] += pj * v1; }
        }
    }
#pragma unroll
    for (int r = 0; r < 4; ++r) linv[r] = 1.0f / l[r];
    LDS_WAIT(); asm volatile("" ::: "memory");
}
__device__ __forceinline__ void p3_attention_ref(Frame& F, const Ins& I) {
    unsigned char* ws = F.ws;
    const bf16 *QN = (const bf16*)(ws + WS_QN), *QR = (const bf16*)(ws + WS_QR), *KN = (const bf16*)(ws + WS_KN), *KR = (const bf16*)(ws + WS_KR), *V = (const bf16*)(ws + WS_V);
    const bf16 *DQ = (const bf16*)(ws + WS_DQ), *DK = (const bf16*)(ws + WS_DK), *DV = (const bf16*)(ws + WS_DV);
    bf16 *OM = (bf16*)(ws + WS_OM), *OD = (bf16*)(ws + WS_OD);
    LAS float* qs = (LAS float*)(F.lds + RING_OFF + F.wave * 4096);
    const int gw = F.vcu * NWAVES + F.wave, NGW = F.G * NWAVES, lane = F.lane;
    const float lam = ((const float*)F.ctl)[CW_LAMBDA];
    const float gs0 = I.g_subln[lane] * (1.0f - LAMBDA_INIT), gs1 = I.g_subln[64 + lane] * (1.0f - LAMBDA_INIT);
    for (int it = gw; it < 2 * 16 * (SEQ / 4); it += NGW) {
        const int type = it & 1, rest = it >> 1, bh = rest & 15, g = rest >> 4, b = bh >> 3, h = bh & 7, p0 = 4 * g;
        const size_t rowbase = (size_t)b * SEQ;
        float o[4][2], li[4];
        if (type == 0) {
            naive_attn(qs, QN + h * 128, 1024, 128, QR + h * 64, 512, 64, [=](size_t row, int d) { return KN + kt_off(row, h * 128 + d); }, [=](size_t row, int d) { return KR + krt_off(row, d); },
                       [=](size_t row, int c) { return V[vt_off(row, h * 128 + c)]; }, rowbase, p0, lane, o, li);
#pragma unroll
            for (int r = 0; r < 4; ++r) { bf16* orow = OM + (rowbase + p0 + r) * 1024 + h * 128;
#ifdef ATT_CHECK
                { const float a0 = bf2f(orow[lane]), a1 = bf2f(orow[64 + lane]), b0 = o[r][0] * li[r], b1 = o[r][1] * li[r];
                  if (fabsf(a0 - b0) > ATT_TOL_A + ATT_TOL_R * fabsf(b0) || fabsf(a1 - b1) > ATT_TOL_A + ATT_TOL_R * fabsf(b1) || !(a0 == a0) || !(a1 == a1)) atomicAdd((unsigned*)F.ctl + 16, 1u); }
#else
                orow[lane] = (bf16)(pk2(o[r][0] * li[r], 0.f) & 0xffffu); orow[64 + lane] = (bf16)(pk2(o[r][1] * li[r], 0.f) & 0xffffu);
#endif
            }
        } else {
            float o2[4][2], li2[4];
            naive_attn(qs, DQ + (h * 2) * 64, 1024, 64, DQ, 1024, 0, [=](size_t row, int d) { return DK + kt_off(row, h * 128 + d); }, [=](size_t row, int d) { return DK; },
                       [=](size_t row, int c) { return DV[vt_off(row, h * 128 + c)]; }, rowbase, p0, lane, o, li);
            naive_attn(qs, DQ + (h * 2 + 1) * 64, 1024, 64, DQ, 1024, 0, [=](size_t row, int d) { return DK + kt_off(row, h * 128 + 64 + d); }, [=](size_t row, int d) { return DK; },
                       [=](size_t row, int c) { return DV[vt_off(row, h * 128 + c)]; }, rowbase, p0, lane, o2, li2);
#pragma unroll
            for (int r = 0; r < 4; ++r) {
                const float d0 = o[r][0] * li[r] - lam * o2[r][0] * li2[r], d1 = o[r][1] * li[r] - lam * o2[r][1] * li2[r];
                const float rs = 1.0f / sqrtf(wave_sum(d0 * d0 + d1 * d1) * (1.0f / 128.0f) + EPS);
                bf16* orow = OD + (rowbase + p0 + r) * 1024 + h * 128;
#ifdef ATT_CHECK
                { const float a0 = bf2f(orow[lane]), a1 = bf2f(orow[64 + lane]), b0 = d0 * rs * gs0, b1 = d1 * rs * gs1;
                  if (fabsf(a0 - b0) > ATT_TOL_A + ATT_TOL_R * fabsf(b0) || fabsf(a1 - b1) > ATT_TOL_A + ATT_TOL_R * fabsf(b1) || !(a0 == a0) || !(a1 == a1)) atomicAdd((unsigned*)F.ctl + 17, 1u); }
#else
                orow[lane] = (bf16)(pk2(d0 * rs * gs0, 0.f) & 0xffffu); orow[64 + lane] = (bf16)(pk2(d1 * rs * gs1, 0.f) & 0xffffu);
#endif
            }
        }
    }
}

namespace att {
typedef short bf16x8 __attribute__((ext_vector_type(8)));
typedef short s16x4 __attribute__((ext_vector_type(4)));
typedef float f32x16 __attribute__((ext_vector_type(16)));
typedef short v4i16_t __attribute__((ext_vector_type(4)));
#ifndef ATT_PF2
#define ATT_PF2 1
#endif
constexpr int BUFB = 40960, WSF_OFF = (ATT_PF2 ? 3 : 2) * BUFB;
#ifndef ATT_KD
#define ATT_KD 2
#endif
#ifndef ATT_VD
#define ATT_VD 2
#endif
__device__ __forceinline__ int crow(int r, int hi) { return (r & 3) + 8 * (r >> 2) + 4 * hi; }
__device__ __forceinline__ s16x4 vtr(const LAS unsigned char* p) { return __builtin_bit_cast(s16x4, __builtin_amdgcn_ds_read_tr16_b64_v4i16((LAS v4i16_t*)p)); }
__device__ __forceinline__ float max3f(float a, float b, float c) { float r; asm("v_max3_f32 %0, %1, %2, %3" : "=v"(r) : "v"(a), "v"(b), "v"(c)); return r; }
__device__ __forceinline__ float max2f(float a, float b) { float r; asm("v_max_f32_e32 %0, %1, %2" : "=v"(r) : "v"(a), "v"(b)); return r; }
__device__ __forceinline__ float swapmax(float m) { auto rr = __builtin_amdgcn_permlane32_swap(__float_as_uint(m), __float_as_uint(m), false, false);
    const unsigned a = rr[0], b = rr[1]; return fmaxf(__uint_as_float(a), __uint_as_float(b)); }
__device__ __forceinline__ float swapsum(float m) { auto rr = __builtin_amdgcn_permlane32_swap(__float_as_uint(m), __float_as_uint(m), false, false);
    const unsigned a = rr[0], b = rr[1]; return __uint_as_float(a) + __uint_as_float(b); }

template <bool DIFF>
__device__ __forceinline__ void attn_unit(LAS unsigned char* lds, int tid, size_t rowbase, int h, int q0,
                                          const bf16* Qa, const bf16* Qb, const bf16* Ka, const bf16* Kb, const bf16* Vp, bf16* Op, float lam, const float* gsub) {
    constexpr int NP = DIFF ? 4 : 5, NKS = DIFF ? 4 : 12, KPIECES = DIFF ? 16 : 24, R = DIFF ? 128 : 256;
    const int lane = tid & 63, r32 = lane & 31, hi = lane >> 5, wid = __builtin_amdgcn_readfirstlane(tid >> 6);
    const int mp = DIFF ? (wid >> 2) : 0, rows_w0 = q0 + 32 * (DIFF ? (wid & 3) : wid);
    const char* src[NP]; unsigned tstr[NP]; unsigned dsto[NP];
#pragma unroll
    for (int i = 0; i < NP; ++i) { const int pidx = wid * NP + i;
        const size_t bhb = ((size_t)(rowbase >> 13) * 8 + h) * 128 * 16384, krb = (size_t)(rowbase >> 13) * 128 * 8192;
        if (!DIFF) {
            if (pidx < 16) { src[i] = (const char*)Ka + bhb + pidx * 1024 + lane * 16; tstr[i] = 16384; dsto[i] = pidx * 1024; }
            else if (pidx < 24) { src[i] = (const char*)Kb + krb + (pidx - 16) * 1024 + lane * 16; tstr[i] = 8192; dsto[i] = pidx * 1024; }
            else { src[i] = (const char*)Vp + bhb + (pidx - 24) * 1024 + lane * 16; tstr[i] = 16384; dsto[i] = pidx * 1024; }
        } else {
            if (pidx < 16) { src[i] = (const char*)Ka + bhb + pidx * 1024 + lane * 16; tstr[i] = 16384; dsto[i] = pidx * 1024; }
            else { src[i] = (const char*)Vp + bhb + (pidx - 16) * 1024 + lane * 16; tstr[i] = 16384; dsto[i] = pidx * 1024; }
        } }
    const unsigned lds0 = (unsigned)(uintptr_t)lds;
#define ATT_DMA(t, bb) do { _Pragma("unroll") for (int _i = 0; _i < NP; ++_i) { unsigned _keep; const unsigned _dst = (unsigned)__builtin_amdgcn_readfirstlane((int)(lds0 + (unsigned)((bb) * BUFB) + dsto[_i])); \
        asm volatile("s_mov_b32 %0, m0\n\ts_mov_b32 m0, %2\n\ts_nop 0\n\tglobal_load_lds_dwordx4 %1, off\n\ts_mov_b32 m0, %0" : "=&s"(_keep) : "v"(src[_i] + (size_t)(t) * tstr[_i]), "s"(_dst) : "memory"); } } while (0)
    bf16x8 qf[NKS];
    { const size_t qrow = rowbase + rows_w0 + r32;
#pragma unroll
      for (int ks = 0; ks < NKS; ++ks) {
          if (DIFF) qf[ks] = *(const bf16x8*)(Qa + qrow * 1024 + (h * 2 + mp) * 64 + ks * 16 + hi * 8);
          else if (ks < 8) qf[ks] = *(const bf16x8*)(Qa + qrow * 1024 + h * 128 + ks * 16 + hi * 8);
          else qf[ks] = *(const bf16x8*)(Qb + qrow * 512 + h * 64 + (ks - 8) * 16 + hi * 8);
      } }
    f32x16 o[4];
#pragma unroll
    for (int d0 = 0; d0 < 4; ++d0) o[d0] = f32x16{};
    float m = -1e30f, l = 0.f;
    const int NT = (q0 + R) / 64, t_last = (rows_w0 + 31) / 64;
    LAS float* wsf = (LAS float*)(lds + WSF_OFF) + wid * 32;
    const int koff = (DIFF ? mp * 8 * 1024 : 0) + hi * 1024 + r32 * 16;
    const int voff = KPIECES * 1024 + ((lane >> 4) & 1) * 32 + (lane & 3) * 8 + (4 * hi + ((lane & 15) >> 2)) * 64;
    const int qpos = rows_w0 + r32;
    ATT_DMA(0, 0);
#if ATT_PF2
    ATT_DMA(1, 1);
#endif
    __builtin_amdgcn_s_waitcnt(0x0F70);
    asm volatile("s_waitcnt vmcnt(0)" ::: "memory"); __syncthreads();
#if ATT_PF2
    int bcur = 0;
#endif
#pragma unroll 1
    for (int t = 0; t < NT; ++t) {
#if ATT_PF2
        const int bb = bcur; const bool more = t + 2 < NT;
        if (more) ATT_DMA(t + 2, (bcur == 0) ? 2 : bcur - 1);
#else
        const int bb = t & 1;
        if (t + 1 < NT) ATT_DMA(t + 1, bb ^ 1);
#endif
        if (t <= t_last) {
            const LAS unsigned char* kb = lds + bb * BUFB + koff;
            f32x16 p0 = f32x16{}, p1 = f32x16{};
            {
                bf16x8 kfa[NKS], kfc[NKS];
#pragma unroll
                for (int ks = 0; ks < ATT_KD; ++ks) { kfa[ks] = *(const LAS bf16x8*)(kb + ks * 2048); kfc[ks] = *(const LAS bf16x8*)(kb + ks * 2048 + 512); }
                __builtin_amdgcn_sched_barrier(0);
#pragma unroll
                for (int ks = 0; ks < NKS; ++ks) {
                    if (ks + ATT_KD < NKS) { kfa[ks + ATT_KD] = *(const LAS bf16x8*)(kb + (ks + ATT_KD) * 2048); kfc[ks + ATT_KD] = *(const LAS bf16x8*)(kb + (ks + ATT_KD) * 2048 + 512); }
                    __builtin_amdgcn_sched_barrier(0);
                    p0 = __builtin_amdgcn_mfma_f32_32x32x16_bf16(kfa[ks], qf[ks], p0, 0, 0, 0);
                    p1 = __builtin_amdgcn_mfma_f32_32x32x16_bf16(kfc[ks], qf[ks], p1, 0, 0, 0);
                    __builtin_amdgcn_sched_barrier(0);
                }
            }
            if (64 * t + 63 > rows_w0) {
                const int kb0 = 64 * t + 4 * hi;
#pragma unroll
                for (int r = 0; r < 16; ++r) { const int kv = kb0 + (r & 3) + 8 * (r >> 2); if (kv > qpos) p0[r] = -INFINITY; if (kv + 32 > qpos) p1[r] = -INFINITY; }
            }
            asm volatile("s_nop 15\n\ts_nop 7" : "+v"(p0), "+v"(p1));
            float rm = max3f(p0[0], p0[1], p1[0]), rm2 = max3f(p0[2], p0[3], p1[1]); rm = max3f(rm, p1[2], p1[3]);
#pragma unroll
            for (int r = 4; r < 16; r += 4) { rm = max3f(rm, p0[r], p0[r + 1]); rm2 = max3f(rm2, p0[r + 2], p0[r + 3]); rm = max3f(rm, p1[r], p1[r + 1]); rm2 = max3f(rm2, p1[r + 2], p1[r + 3]); }
            rm = swapmax(max2f(rm, rm2));
            const float mn = fmaxf(m, rm);
            if (__any(mn > m)) {
                const float al = __builtin_amdgcn_exp2f(m - mn);
                l *= al;
                if (hi == 0) wsf[r32] = al;
                LDS_WAIT(); asm volatile("" ::: "memory");
#pragma unroll
                for (int r = 0; r < 16; ++r) { const float a = wsf[crow(r, hi)];
#pragma unroll
                    for (int d0 = 0; d0 < 4; ++d0) o[d0][r] *= a; }
                LDS_WAIT(); asm volatile("" ::: "memory");
            }
            m = mn;
            float ps = 0.f;
#pragma unroll
            for (int r = 0; r < 16; ++r) { p0[r] = __builtin_amdgcn_exp2f(p0[r] - mn); p1[r] = __builtin_amdgcn_exp2f(p1[r] - mn); ps += p0[r] + p1[r]; }
            l += ps;
            u32x4 pw[4];
            pw[0] = (u32x4){cvtpk(p0[0], p0[1]), cvtpk(p0[2], p0[3]), cvtpk(p0[4], p0[5]), cvtpk(p0[6], p0[7])};
            pw[1] = (u32x4){cvtpk(p0[8], p0[9]), cvtpk(p0[10], p0[11]), cvtpk(p0[12], p0[13]), cvtpk(p0[14], p0[15])};
            pw[2] = (u32x4){cvtpk(p1[0], p1[1]), cvtpk(p1[2], p1[3]), cvtpk(p1[4], p1[5]), cvtpk(p1[6], p1[7])};
            pw[3] = (u32x4){cvtpk(p1[8], p1[9]), cvtpk(p1[10], p1[11]), cvtpk(p1[12], p1[13]), cvtpk(p1[14], p1[15])};
            const LAS unsigned char* vb = lds + bb * BUFB + voff;
            {
                s16x4 vlo[16], vhh[16];
#pragma unroll
                for (int i = 0; i < ATT_VD; ++i) { vlo[i] = vtr(vb + i * 1024); vhh[i] = vtr(vb + i * 1024 + 512); }
                __builtin_amdgcn_sched_barrier(0);
#pragma unroll
                for (int i = 0; i < 16; ++i) {
                    if (i + ATT_VD < 16) { vlo[i + ATT_VD] = vtr(vb + (i + ATT_VD) * 1024); vhh[i + ATT_VD] = vtr(vb + (i + ATT_VD) * 1024 + 512); }
                    __builtin_amdgcn_sched_barrier(0);
                    const bf16x8 vf = (bf16x8){vlo[i][0], vlo[i][1], vlo[i][2], vlo[i][3], vhh[i][0], vhh[i][1], vhh[i][2], vhh[i][3]};
                    o[i >> 2] = __builtin_amdgcn_mfma_f32_32x32x16_bf16(__builtin_bit_cast(bf16x8, pw[i & 3]), vf, o[i >> 2], 0, 0, 0);
                    __builtin_amdgcn_sched_barrier(0);
                }
            }
        }
#if ATT_PF2
        if (more) asm volatile("s_waitcnt vmcnt(%0)" :: "n"(NP) : "memory"); else asm volatile("s_waitcnt vmcnt(0)" ::: "memory");
        __syncthreads();
        bcur = (bcur == 2) ? 0 : bcur + 1;
#else
        asm volatile("s_waitcnt vmcnt(0)" ::: "memory"); __syncthreads();
#endif
    }
#undef ATT_DMA
    l = swapsum(l);
    if (hi == 0) wsf[r32] = l;
    LDS_WAIT(); asm volatile("" ::: "memory");
    float rli[16];
#pragma unroll
    for (int r = 0; r < 16; ++r) rli[r] = 1.0f / wsf[crow(r, hi)];
    LDS_WAIT(); asm volatile("" ::: "memory");
    if (!DIFF) {
#pragma unroll
        for (int r = 0; r < 16; ++r) { bf16* orow = Op + (rowbase + rows_w0 + crow(r, hi)) * 1024 + h * 128 + r32;
#pragma unroll
            for (int d0 = 0; d0 < 4; ++d0) orow[d0 * 32] = (bf16)(cvtpk(o[d0][r] * rli[r], 0.f) & 0xffffu); }
    } else {
        LAS float* xch = (LAS float*)lds;
        if (wid >= 4) {
#pragma unroll
            for (int d0 = 0; d0 < 4; ++d0)
#pragma unroll
                for (int r = 0; r < 16; ++r) xch[((wid & 3) * 64 + d0 * 16 + r) * 64 + lane] = o[d0][r] * rli[r];
        }
        __syncthreads();
        if (wid < 4) {
            float ss[16];
#pragma unroll
            for (int r = 0; r < 16; ++r) ss[r] = 0.f;
#pragma unroll
            for (int d0 = 0; d0 < 4; ++d0)
#pragma unroll
                for (int r = 0; r < 16; ++r) { const float d = o[d0][r] * rli[r] - lam * xch[(wid * 64 + d0 * 16 + r) * 64 + lane]; o[d0][r] = d; ss[r] += d * d; }
#pragma unroll
            for (int r = 0; r < 16; ++r) {
#pragma unroll
                for (int of = 1; of < 32; of <<= 1) ss[r] += __shfl_xor(ss[r], of);
                ss[r] = 1.0f / sqrtf(ss[r] * (1.0f / 128.0f) + EPS); }
            float g4[4];
#pragma unroll
            for (int d0 = 0; d0 < 4; ++d0) g4[d0] = gsub[d0 * 32 + r32] * (1.0f - LAMBDA_INIT);
#pragma unroll
            for (int r = 0; r < 16; ++r) { bf16* orow = Op + (rowbase + rows_w0 + crow(r, hi)) * 1024 + h * 128 + r32;
#pragma unroll
                for (int d0 = 0; d0 < 4; ++d0) orow[d0 * 32] = (bf16)(cvtpk(o[d0][r] * ss[r] * g4[d0], 0.f) & 0xffffu); }
        }
        __syncthreads();
    }
}
}

__device__ __forceinline__ void p3_attention(Frame& F, const Ins& I) {
    unsigned char* ws = F.ws;
    const bf16 *QN = (const bf16*)(ws + WS_QN), *QR = (const bf16*)(ws + WS_QR), *KN = (const bf16*)(ws + WS_KN), *KR = (const bf16*)(ws + WS_KR), *V = (const bf16*)(ws + WS_V);
    const bf16 *DQ = (const bf16*)(ws + WS_DQ), *DK = (const bf16*)(ws + WS_DK), *DV = (const bf16*)(ws + WS_DV);
    bf16 *OM = (bf16*)(ws + WS_OM), *OD = (bf16*)(ws + WS_OD);
    const float lam = ((const float*)F.ctl)[CW_LAMBDA];
    LAS unsigned char* lds = F.lds + RING_OFF;
    for (int v = F.vcu; v < 256; v += F.G) {
        const int bh = v >> 4, c = v & 15, b = bh >> 3, h = bh & 7; const size_t rowbase = (size_t)b * SEQ;
        att::attn_unit<false>(lds, F.tid, rowbase, h, (31 - c) * 256, QN, QR, KN, KR, V, OM, lam, I.g_subln);
        att::attn_unit<true>(lds, F.tid, rowbase, h, (63 - c) * 128, DQ, nullptr, DK, nullptr, DV, OD, lam, I.g_subln);
        att::attn_unit<true>(lds, F.tid, rowbase, h, (47 - c) * 128, DQ, nullptr, DK, nullptr, DV, OD, lam, I.g_subln);
        att::attn_unit<true>(lds, F.tid, rowbase, h, (16 + c) * 128, DQ, nullptr, DK, nullptr, DV, OD, lam, I.g_subln);
        att::attn_unit<true>(lds, F.tid, rowbase, h, c * 128, DQ, nullptr, DK, nullptr, DV, OD, lam, I.g_subln);
        att::attn_unit<false>(lds, F.tid, rowbase, h, c * 256, QN, QR, KN, KR, V, OM, lam, I.g_subln);
    }
}

__device__ __forceinline__ void wave_argmax(float v, int idx, float& mv, int& mi) {
#pragma unroll
    for (int o = 1; o < 64; o <<= 1) { const float ov = __shfl_xor(v, o); const int oi = __shfl_xor(idx, o); if (ov > v || (ov == v && oi < idx)) { v = ov; idx = oi; } }
    mv = v; mi = idx;
}
__device__ __forceinline__ void p7_routing_ref(Frame& F) {
    unsigned char* ws = F.ws;
    const bf16* QP = (const bf16*)(ws + WS_QP); const bf16* SKB = (const bf16*)(ws + WS_SKB);
    int* IDX = (int*)(ws + WS_IDX); float* GT = (float*)(ws + WS_GT);
    LAS float* wl = (LAS float*)(F.lds + RING_OFF + F.wave * 4096);
    LAS float* qs = wl; LAS float* v1s = wl + 256; LAS int* i1s = (LAS int*)(wl + 272); LAS float* v2s = wl + 288; LAS int* i2s = (LAS int*)(wl + 304);
    const int gw = F.vcu * NWAVES + F.wave, NGW = F.G * NWAVES, lane = F.lane;
    for (int it = gw; it < T * 8; it += NGW) {
        { const u32x2 w = *(const u32x2*)(QP + (size_t)it * 256 + lane * 4); qs[lane * 4 + 0] = bflo(w.x); qs[lane * 4 + 1] = bfhi(w.x); qs[lane * 4 + 2] = bflo(w.y); qs[lane * 4 + 3] = bfhi(w.y); }
        LDS_WAIT(); asm volatile("" ::: "memory");
        float sc[2][2];
#pragma unroll
        for (int hf = 0; hf < 2; ++hf)
#pragma unroll
            for (int kk = 0; kk < 2; ++kk) { const bf16* kr = SKB + (size_t)(hf * 128 + kk * 64 + lane) * 256 + hf * 128; float s = 0.f;
#pragma unroll 4
                for (int d = 0; d < 128; d += 8) { const u32x4 kw = *(const u32x4*)(kr + d);
                    const f32x4 qa4 = *(const LAS f32x4*)(qs + hf * 128 + d), qb4 = *(const LAS f32x4*)(qs + hf * 128 + d + 4);
                    s += (qa4[0] * bflo(kw.x) + qa4[1] * bfhi(kw.x)) + (qa4[2] * bflo(kw.y) + qa4[3] * bfhi(kw.y)) + (qb4[0] * bflo(kw.z) + qb4[1] * bfhi(kw.z)) + (qb4[2] * bflo(kw.w) + qb4[3] * bfhi(kw.w)); }
                sc[hf][kk] = s; }
#pragma unroll
        for (int hf = 0; hf < 2; ++hf) {
            float a = sc[hf][0], b = sc[hf][1];
            for (int r = 0; r < 16; ++r) {
                float lv; int li; if (b > a) { lv = b; li = lane + 64; } else { lv = a; li = lane; }
                float mv; int mi; wave_argmax(lv, li, mv, mi);
                if (mi == lane) a = -INFINITY; if (mi == lane + 64) b = -INFINITY;
                if (lane == 0) { if (hf == 0) { v1s[r] = mv; i1s[r] = mi; } else { v2s[r] = mv; i2s[r] = mi; } }
            }
        }
        LDS_WAIT(); asm volatile("" ::: "memory");
        float cv[4];
#pragma unroll
        for (int j = 0; j < 4; ++j) { const int c = lane * 4 + j; cv[j] = v1s[c >> 4] + v2s[c & 15]; }
        float mycs = 0.f; int myc = 0;
        for (int r = 0; r < 16; ++r) {
            float lv = cv[0]; int li = lane * 4;
#pragma unroll
            for (int j = 1; j < 4; ++j) if (cv[j] > lv) { lv = cv[j]; li = lane * 4 + j; }
            float mv; int mi; wave_argmax(lv, li, mv, mi);
#pragma unroll
            for (int j = 0; j < 4; ++j) if (mi == lane * 4 + j) cv[j] = -INFINITY;
            if (lane == r) { mycs = mv; myc = mi; }
        }
        float mx = mycs;
#pragma unroll
        for (int o = 1; o < 16; o <<= 1) mx = fmaxf(mx, __shfl_xor(mx, o));
        const float e = __expf(mycs - mx); float se = e;
#pragma unroll
        for (int o = 1; o < 16; o <<= 1) se += __shfl_xor(se, o);
        if (lane < 16) { const int ex = i1s[myc >> 4] * 128 + i2s[myc & 15];
            IDX[(size_t)it * 16 + lane] = ex; GT[(size_t)it * 16 + lane] = e / se; }
        LDS_WAIT(); asm volatile("" ::: "memory");
    }
}

__device__ __forceinline__ void unpack8(const u32x4 w, float (&f)[8]) { f[0] = bflo(w.x); f[1] = bfhi(w.x); f[2] = bflo(w.y); f[3] = bfhi(w.y); f[4] = bflo(w.z); f[5] = bfhi(w.z); f[6] = bflo(w.w); f[7] = bfhi(w.w); }
__device__ __forceinline__ void p8_gather(Frame& F, const Ins& I, float* out) {
    unsigned char* ws = F.ws;
    const float* X2 = (const float*)(ws + WS_X2); const bf16* EU = (const bf16*)(ws + WS_EU); const bf16* EV = (const bf16*)(ws + WS_EV);
    const int* IDX = (const int*)(ws + WS_IDX); const float* GT = (const float*)(ws + WS_GT);
    const float* ssq2 = (const float*)(ws + WS_PSQ2);
    const int gw = F.vcu * NWAVES + F.wave, NGW = F.G * NWAVES, lane = F.lane;
    for (int t = gw; t < T; t += NGW) {
        float xv[4][8], acc[4][8];
#pragma unroll
        for (int j = 0; j < 4; ++j) { const f32x4 a = *(const f32x4*)(X2 + (size_t)t * 2048 + 512 * j + 8 * lane), b = *(const f32x4*)(X2 + (size_t)t * 2048 + 512 * j + 8 * lane + 4);
            xv[j][0] = a[0]; xv[j][1] = a[1]; xv[j][2] = a[2]; xv[j][3] = a[3]; xv[j][4] = b[0]; xv[j][5] = b[1]; xv[j][6] = b[2]; xv[j][7] = b[3];
#pragma unroll
            for (int e = 0; e < 8; ++e) acc[j][e] = 0.f; }
        const float rstd2 = 1.0f / sqrtf(sum32(ssq2 + (size_t)t * 32) * (1.0f / 2048.0f) + EPS);
        const int id0 = IDX[(size_t)t * 128 + lane], id1 = IDX[(size_t)t * 128 + 64 + lane];
        const float g0 = GT[(size_t)t * 128 + lane], g1 = GT[(size_t)t * 128 + 64 + lane];
        for (int i = 0; i < 128; ++i) {
            const int ex = __builtin_amdgcn_readlane(i < 64 ? id0 : id1, i & 63);
            const float gate = __builtin_bit_cast(float, __builtin_amdgcn_readlane(__builtin_bit_cast(int, i < 64 ? g0 : g1), i & 63));
            const bf16* ur = EU + (size_t)ex * 2048 + 8 * lane; const bf16* vr = EV + (size_t)ex * 2048 + 8 * lane;
            u32x4 uw[4], vw[4];
#pragma unroll
            for (int j = 0; j < 4; ++j) { uw[j] = *(const u32x4*)(ur + 512 * j); vw[j] = *(const u32x4*)(vr + 512 * j); }
            float dot = 0.f;
#pragma unroll
            for (int j = 0; j < 4; ++j) { float f[8]; unpack8(uw[j], f);
#pragma unroll
                for (int e = 0; e < 8; ++e) dot += f[e] * xv[j][e]; }
            const float a = wave_sum(dot) * rstd2;
            const float z2 = 1.5957691216057308f * (a + 0.044715f * a * a * a);
            const float w = gate * a * __builtin_amdgcn_rcpf(1.0f + __builtin_amdgcn_exp2f(-z2 * LOG2E));
#pragma unroll
            for (int j = 0; j < 4; ++j) { float f[8]; unpack8(vw[j], f);
#pragma unroll
                for (int e = 0; e < 8; ++e) acc[j][e] += w * f[e]; }
        }
        float s = 0.f;
#pragma unroll
        for (int j = 0; j < 4; ++j)
#pragma unroll
            for (int e = 0; e < 8; ++e) { acc[j][e] += xv[j][e]; s += acc[j][e] * acc[j][e]; }
        float rs = 1.0f / sqrtf(wave_sum(s) * (1.0f / 2048.0f) + EPS);
#ifdef ATT_CHECK
        if (((const unsigned*)F.ctl)[ATT_CHECK_WORD] > ATT_CHECK_MAX) rs = __builtin_nanf("");
#endif
#pragma unroll
        for (int j = 0; j < 4; ++j) { const f32x4 ga = *(const f32x4*)(I.g_final + 512 * j + 8 * lane), gb = *(const f32x4*)(I.g_final + 512 * j + 8 * lane + 4);
            *(f32x4*)(out + (size_t)t * 2048 + 512 * j + 8 * lane) = (f32x4){acc[j][0] * rs * ga[0], acc[j][1] * rs * ga[1], acc[j][2] * rs * ga[2], acc[j][3] * rs * ga[3]};
            *(f32x4*)(out + (size_t)t * 2048 + 512 * j + 8 * lane + 4) = (f32x4){acc[j][4] * rs * gb[0], acc[j][5] * rs * gb[1], acc[j][6] * rs * gb[2], acc[j][7] * rs * gb[3]}; }
    }
}

namespace rt {
typedef short bf16x8 __attribute__((ext_vector_type(8)));
typedef float f32x16 __attribute__((ext_vector_type(16)));
__device__ __forceinline__ unsigned f2sort(float f) { const unsigned u = __float_as_uint(f); return u ^ ((unsigned)((int)u >> 31) | 0x80000000u); }
__device__ __forceinline__ float sort2f(unsigned s) { return __uint_as_float(s ^ ((s >> 31) ? 0x80000000u : 0xFFFFFFFFu)); }
__device__ __forceinline__ unsigned umax(unsigned a, unsigned b) { return a > b ? a : b; }
__device__ __forceinline__ unsigned pair_max(unsigned m) { auto rr = __builtin_amdgcn_permlane32_swap(m, m, false, false); const unsigned a = rr[0], b = rr[1]; return umax(a, b); }
constexpr int KEYS_BYTES = 65536, LIST_OFF = KEYS_BYTES, LIST_WAVE = 6144 + 512;
}
__device__ __forceinline__ void rt_load_keys(Frame& F, const Ins& I) {
    LAS unsigned char* lds = F.lds + RING_OFF;
    for (int it = F.tid; it < 2 * 128 * 16; it += NWAVES * 64) {
        const int c = it & 15, n = (it >> 4) & 127, hf = it >> 11;
        const float* sp = I.sub_keys + (size_t)hf * 16384 + n * 128 + c * 8;
        const f32x4 a = *(const f32x4*)sp, b = *(const f32x4*)(sp + 4);
        v4u o; o.x = pk2(a.x, a.y); o.y = pk2(a.z, a.w); o.z = pk2(b.x, b.y); o.w = pk2(b.z, b.w);
        *(LAS v4u*)(lds + hf * 32768 + c * 2048 + n * 16) = o;
    }
    __syncthreads();
}
template <bool TO_LDS>
__device__ __forceinline__ void rt_task(Frame& F, int task, LAS unsigned* lst) {
    using namespace rt;
    unsigned char* ws = F.ws;
    const bf16* QP = (const bf16*)(ws + WS_QP);
    int* IDX = (int*)(ws + WS_IDX); float* GT = (float*)(ws + WS_GT);
    LAS unsigned char* lds = F.lds + RING_OFF;
    const int lane = F.lane, r32 = lane & 31, hi = lane >> 5;
        const size_t row = (size_t)task * 32 + r32;
#pragma unroll 1
        for (int hf = 0; hf < 2; ++hf) {
            bf16x8 qf[8];
#pragma unroll
            for (int ks = 0; ks < 8; ++ks) qf[ks] = *(const bf16x8*)(QP + row * 256 + hf * 128 + ks * 16 + hi * 8);
            unsigned k[64];
            const LAS unsigned char* kb0 = lds + hf * 32768 + hi * 2048 + r32 * 16;
#pragma unroll
            for (int kb = 0; kb < 4; ++kb) {
                f32x16 acc = f32x16{};
#pragma unroll
                for (int ks = 0; ks < 8; ++ks) acc = __builtin_amdgcn_mfma_f32_32x32x16_bf16(*(const LAS bf16x8*)(kb0 + ks * 4096 + kb * 512), qf[ks], acc, 0, 0, 0);
#pragma unroll
                for (int r = 0; r < 16; ++r) { const int n = 32 * kb + (r & 3) + 8 * (r >> 2) + 4 * hi; k[16 * kb + r] = (f2sort(acc[r]) & ~0x7Fu) | (unsigned)(127 - n); }
            }
#pragma unroll 1
            for (int rd = 0; rd < 16; ++rd) {
                unsigned m = k[0];
#pragma unroll
                for (int i = 1; i < 64; ++i) m = umax(m, k[i]);
                const unsigned g = pair_max(m);
#pragma unroll
                for (int i = 0; i < 64; ++i) k[i] = (k[i] == g) ? 0u : k[i];
                if (hi == 0) lst[hf * 16 + rd] = g;
            }
        }
        LDS_WAIT(); asm volatile("" ::: "memory");
        float v1[16], v2[16];
#pragma unroll
        for (int q = 0; q < 4; ++q) { const v4u a = *(const LAS v4u*)(lst + 4 * q), b = *(const LAS v4u*)(lst + 16 + 4 * q);
#pragma unroll
            for (int e = 0; e < 4; ++e) { v1[4 * q + e] = sort2f(a[e] & ~0x7Fu); v2[4 * q + e] = sort2f(b[e] & ~0x7Fu); } }
        unsigned cand[50];
        { int ci = 0;
#pragma unroll
          for (int a = 0; a < 16; ++a)
#pragma unroll
              for (int b = 0; b < 16; ++b) if ((a + 1) * (b + 1) <= 16) { cand[ci] = (f2sort(v1[a] + v2[b]) & ~0xFFu) | (unsigned)(255 - (a * 16 + b)); ++ci; } }
#pragma unroll 1
        for (int rd = 0; rd < 16; ++rd) {
            unsigned m = cand[0];
#pragma unroll
            for (int i = 1; i < 50; ++i) m = umax(m, cand[i]);
#pragma unroll
            for (int i = 0; i < 50; ++i) cand[i] = (cand[i] == m) ? 0u : cand[i];
            if (hi == 0) lst[32 + rd] = m;
        }
        LDS_WAIT(); asm volatile("" ::: "memory");
        const float cmax = sort2f(lst[32] & ~0xFFu);
        float ev[8]; int ex[8]; float se = 0.f;
#pragma unroll
        for (int j = 0; j < 8; ++j) { const unsigned key = lst[32 + 8 * hi + j]; const int ab = 255 - (int)(key & 0xFFu);
            const int i1 = 127 - (int)(lst[ab >> 4] & 0x7Fu), i2 = 127 - (int)(lst[16 + (ab & 15)] & 0x7Fu);
            ex[j] = i1 * 128 + i2; ev[j] = __expf(sort2f(key & ~0xFFu) - cmax); se += ev[j]; }
        { auto rr = __builtin_amdgcn_permlane32_swap(__float_as_uint(se), __float_as_uint(se), false, false); const unsigned a = rr[0], b = rr[1]; se = __uint_as_float(a) + __uint_as_float(b); }
        const float inv = 1.0f / se;
        if (TO_LDS) {
#pragma unroll
            for (int j = 0; j < 8; ++j) { lst[8 * hi + j] = (unsigned)ex[j]; lst[16 + 8 * hi + j] = __float_as_uint(ev[j] * inv); }
        } else {
        int* ip = IDX + row * 16 + 8 * hi; float* gp = GT + row * 16 + 8 * hi;
        *(GAS v4u*)ip = (v4u){(unsigned)ex[0], (unsigned)ex[1], (unsigned)ex[2], (unsigned)ex[3]}; *(GAS v4u*)(ip + 4) = (v4u){(unsigned)ex[4], (unsigned)ex[5], (unsigned)ex[6], (unsigned)ex[7]};
        *(GAS f32x4*)gp = (f32x4){ev[0] * inv, ev[1] * inv, ev[2] * inv, ev[3] * inv}; *(GAS f32x4*)(gp + 4) = (f32x4){ev[4] * inv, ev[5] * inv, ev[6] * inv, ev[7] * inv};
        }
        LDS_WAIT(); asm volatile("" ::: "memory");
}
__device__ __forceinline__ void p8_routing(Frame& F, const Ins& I) {
    using namespace rt;
    rt_load_keys(F, I);
    LAS unsigned* lst = (LAS unsigned*)(F.lds + RING_OFF + LIST_OFF + F.wave * LIST_WAVE) + (F.lane & 31) * 48;
    const int gw = F.vcu * NWAVES + F.wave, NGW = F.G * NWAVES;
    for (int task = gw; task < T * 8 / 32; task += NGW) rt_task<false>(F, task, lst);
}
constexpr float EU_SCALE = 64.0f, EV_SCALE = 4.0f;
typedef float f32x2v __attribute__((ext_vector_type(2)));
__device__ __forceinline__ unsigned pk4_fp8(float a, float b, float c, float d) { int t = __builtin_amdgcn_cvt_pk_fp8_f32(a, b, 0, false); t = __builtin_amdgcn_cvt_pk_fp8_f32(c, d, t, true); return (unsigned)t; }
__device__ __forceinline__ void convert_experts_fp8(Frame& F, const Ins& I) {
    const size_t gt = (size_t)(F.vcu * NWAVES * 64) + F.tid, NT = (size_t)F.G * NWAVES * 64;
    const size_t nchunk = (size_t)NEXP * D_MODEL / 16;
    unsigned char* EU = F.ws + WS_EU; unsigned char* EV = F.ws + WS_EV;
    for (size_t c = gt; c < nchunk; c += NT) {
        const int d = (int)((c * 16) & (D_MODEL - 1));
        v4u o, p;
#pragma unroll
        for (int k = 0; k < 4; ++k) {
            const f32x4 a = *(const GAS f32x4*)(I.expert_u + c * 16 + 4 * k), g = *(const f32x4*)(I.g_norm2 + d + 4 * k), b = *(const GAS f32x4*)(I.expert_v + c * 16 + 4 * k);
            o[k] = pk4_fp8(a.x * g.x * EU_SCALE, a.y * g.y * EU_SCALE, a.z * g.z * EU_SCALE, a.w * g.w * EU_SCALE);
            p[k] = pk4_fp8(b.x * EV_SCALE, b.y * EV_SCALE, b.z * EV_SCALE, b.w * EV_SCALE);
        }
        *(GAS v4u*)(EU + c * 16) = o; *(GAS v4u*)(EV + c * 16) = p;
    }
}
#ifndef PEER_FP8
#define PEER_FP6 1
#endif
#ifdef PEER_FP6
typedef float v32f_t __attribute__((ext_vector_type(32)));
typedef float v16f_t __attribute__((ext_vector_type(16)));
typedef unsigned v6u_t __attribute__((ext_vector_type(6)));
constexpr int EROW = 1536;
__device__ __forceinline__ void convert_experts_fp6(Frame& F, const Ins& I) {
    const size_t gt = (size_t)(F.vcu * NWAVES * 64) + F.tid, NT = (size_t)F.G * NWAVES * 64;
    const size_t nblk = (size_t)NEXP * 64;
    unsigned char* EU = F.ws + WS_EU; unsigned char* EV = F.ws + WS_EV;
    LAS int* ptab = (LAS int*)(F.lds + RING_OFF + 65536);
#pragma unroll 1
    for (int j = 0; j < 32; ++j) {
        v16f_t a, b;
#pragma unroll
        for (int i = 0; i < 16; ++i) { a[i] = (i == j) ? 1.0f : 0.0f; b[i] = (i + 16 == j) ? 1.0f : 0.0f; }
        const v32f_t r = __builtin_amdgcn_cvt_scalef32_pk32_f32_fp6(__builtin_amdgcn_cvt_scalef32_2xpk16_fp6_f32(a, b, 1.0f), 1.0f);
        int pos = 0;
#pragma unroll
        for (int i = 0; i < 32; ++i) pos = (r[i] != 0.0f) ? i : pos;
        ptab[j] = pos;
    }
    LDS_WAIT(); asm volatile("" ::: "memory");
    bool inter = true;
#pragma unroll 1
    for (int j = 0; j < 32; ++j) inter = inter && (ptab[j] == ((j < 16) ? 2 * j : 2 * (j - 16) + 1));
    if (inter) {
        const int gw = F.vcu * NWAVES + F.wave, NGW = F.G * NWAVES, lane = F.lane;
        LAS unsigned char* img = F.lds + RING_OFF + F.wave * 9216;
        f32x4 gsc[8];
#pragma unroll
        for (int k = 0; k < 8; ++k) gsc[k] = *(const f32x4*)(I.g_norm2 + (64 * k + lane) * 4) * EU_SCALE;
        for (int e = gw; e < NEXP; e += NGW) {
            f32x4 ru[8], rv[8];
#pragma unroll
            for (int k = 0; k < 8; ++k) { ru[k] = *(const GAS f32x4*)(I.expert_u + (size_t)e * 2048 + (64 * k + lane) * 4); rv[k] = *(const GAS f32x4*)(I.expert_v + (size_t)e * 2048 + (64 * k + lane) * 4); }
#pragma unroll
            for (int tb = 0; tb < 2; ++tb) {
#pragma unroll
                for (int k = 0; k < 8; ++k) { const int i4 = 64 * k + lane;
                    *(LAS f32x4*)(img + (i4 >> 3) * 144 + (i4 & 7) * 16) = tb == 0 ? ru[k] * gsc[k] : rv[k] * EV_SCALE; }
                LDS_WAIT(); asm volatile("" ::: "memory");
                v16f_t ya, yb;
#pragma unroll
                for (int j = 0; j < 8; ++j) { const f32x4 x4 = *(const LAS f32x4*)(img + lane * 144 + 16 * j); ya[2 * j] = x4[0]; yb[2 * j] = x4[1]; ya[2 * j + 1] = x4[2]; yb[2 * j + 1] = x4[3]; }
                LDS_WAIT(); asm volatile("" ::: "memory");
                const v6u_t pk = __builtin_amdgcn_cvt_scalef32_2xpk16_fp6_f32(ya, yb, 1.0f);
                unsigned char* dst = (tb == 0 ? EU : EV) + (size_t)e * EROW;
                *(GAS v4u*)(dst + 16 * lane) = (v4u){pk[0], pk[1], pk[2], pk[3]}; *(GAS u32x2*)(dst + 1024 + 8 * lane) = (u32x2){pk[4], pk[5]};
            }
        }
    } else {
    LAS float* scr = (LAS float*)(F.lds + RING_OFF) + F.tid;
    for (size_t c = gt; c < nblk; c += NT) {
        const size_t e = c >> 6; const int l = (int)(c & 63), d = 32 * l;
        v16f_t ya, yb;
#pragma unroll
        for (int k = 0; k < 8; ++k) { const f32x4 a0 = *(const GAS f32x4*)(I.expert_u + c * 32 + 4 * k), g0 = *(const f32x4*)(I.g_norm2 + d + 4 * k);
#pragma unroll
            for (int j = 0; j < 4; ++j) scr[(4 * k + j) * 512] = a0[j] * g0[j] * EU_SCALE; }
#pragma unroll
        for (int j = 0; j < 16; ++j) { ya[j] = scr[ptab[j] * 512]; yb[j] = scr[ptab[16 + j] * 512]; }
        const v6u_t pu = __builtin_amdgcn_cvt_scalef32_2xpk16_fp6_f32(ya, yb, 1.0f);
        *(GAS v4u*)(EU + e * EROW + 16 * l) = (v4u){pu[0], pu[1], pu[2], pu[3]}; *(GAS u32x2*)(EU + e * EROW + 1024 + 8 * l) = (u32x2){pu[4], pu[5]};
#pragma unroll
        for (int k = 0; k < 8; ++k) { const f32x4 b0 = *(const GAS f32x4*)(I.expert_v + c * 32 + 4 * k);
#pragma unroll
            for (int j = 0; j < 4; ++j) scr[(4 * k + j) * 512] = b0[j] * EV_SCALE; }
#pragma unroll
        for (int j = 0; j < 16; ++j) { ya[j] = scr[ptab[j] * 512]; yb[j] = scr[ptab[16 + j] * 512]; }
        const v6u_t pv = __builtin_amdgcn_cvt_scalef32_2xpk16_fp6_f32(ya, yb, 1.0f);
        *(GAS v4u*)(EV + e * EROW + 16 * l) = (v4u){pv[0], pv[1], pv[2], pv[3]}; *(GAS u32x2*)(EV + e * EROW + 1024 + 8 * l) = (u32x2){pv[4], pv[5]};
    }
    }
    __syncthreads();
}
struct G9Row { u32x4 a; u32x2 b; };
#define G9_SETS G9Row A[4], B[4]
#define G9_XOFF(c) (32 * lane + 16 * (c))
#define G9_LOAD(SET, TAB, IDL, g) do { _Pragma("unroll") for (int k = 0; k < 4; ++k) { const int ex = __builtin_amdgcn_readlane(IDL, 4 * (4 * (g) + k)); \
        const unsigned char* rp = (TAB) + (size_t)ex * EROW; SET[k].a = *(const u32x4*)(rp + 16 * lane); SET[k].b = *(const u32x2*)(rp + 1024 + 8 * lane); } } while (0)
#define G9_CVT(SET, k) __builtin_amdgcn_cvt_scalef32_pk32_f32_fp6((v6u_t){SET[k].a.x, SET[k].a.y, SET[k].a.z, SET[k].a.w, SET[k].b.x, SET[k].b.y}, 1.0f)
#define G9_DOTS(SET, g) do { _Pragma("unroll") for (int k = 0; k < 4; ++k) { const v32f_t r = G9_CVT(SET, k); float s0 = 0.f, s1 = 0.f; \
        f32x2v q0 = {0.f, 0.f}, q1 = {0.f, 0.f}; (void)s0; (void)s1; \
        _Pragma("unroll") for (int e = 0; e < 16; e += 2) { q0 = (f32x2v){r[e], r[e + 1]} * (f32x2v){xv[0][e], xv[0][e + 1]} + q0; q1 = (f32x2v){r[16 + e], r[17 + e]} * (f32x2v){xv[1][e], xv[1][e + 1]} + q1; } \
        q0 += q1; float s = q0.x + q0.y; asm volatile("" : "+v"(s)); dots[4 * (g) + k] = s; } } while (0)
#define G9_FMAS(SET, g) do { _Pragma("unroll") for (int k = 0; k < 4; ++k) { const float wk = wq[g][k]; const v32f_t r = G9_CVT(SET, k); \
        const f32x2v wk2 = {wk, wk}; \
        _Pragma("unroll") for (int e = 0; e < 16; e += 2) { const f32x2v a0 = (f32x2v){r[e], r[e + 1]} * wk2 + (f32x2v){acc[0][e], acc[0][e + 1]}, a1 = (f32x2v){r[16 + e], r[17 + e]} * wk2 + (f32x2v){acc[1][e], acc[1][e + 1]}; \
            acc[0][e] = a0.x; acc[0][e + 1] = a0.y; acc[1][e] = a1.x; acc[1][e + 1] = a1.y; } } } while (0)
#else
constexpr int EROW = 2048;
#define G9_SETS u32x4 A[4][2], B[4][2]
#define G9_XOFF(c) (1024 * (c) + 16 * lane)
#define G9_LOAD(SET, TAB, IDL, g) do { _Pragma("unroll") for (int k = 0; k < 4; ++k) { const int ex = __builtin_amdgcn_readlane(IDL, 4 * (4 * (g) + k)); \
        const unsigned char* rp = (TAB) + (size_t)ex * 2048 + 16 * lane; SET[k][0] = *(const u32x4*)rp; SET[k][1] = *(const u32x4*)(rp + 1024); } } while (0)
#define G9_DOTS(SET, g) do { _Pragma("unroll") for (int k = 0; k < 4; ++k) { float s = 0.f; _Pragma("unroll") for (int c = 0; c < 2; ++c) _Pragma("unroll") for (int dw = 0; dw < 4; ++dw) { \
        const f32x2v lo = __builtin_amdgcn_cvt_pk_f32_fp8((int)SET[k][c][dw], false), hi2 = __builtin_amdgcn_cvt_pk_f32_fp8((int)SET[k][c][dw], true); \
        s += lo.x * xv[c][4 * dw] + lo.y * xv[c][4 * dw + 1] + hi2.x * xv[c][4 * dw + 2] + hi2.y * xv[c][4 * dw + 3]; } asm volatile("" : "+v"(s)); dots[4 * (g) + k] = s; } } while (0)
#define G9_FMAS(SET, g) do { _Pragma("unroll") for (int k = 0; k < 4; ++k) { const float wk = wq[g][k]; \
        _Pragma("unroll") for (int c = 0; c < 2; ++c) _Pragma("unroll") for (int dw = 0; dw < 4; ++dw) { \
        const f32x2v lo = __builtin_amdgcn_cvt_pk_f32_fp8((int)SET[k][c][dw], false), hi2 = __builtin_amdgcn_cvt_pk_f32_fp8((int)SET[k][c][dw], true); \
        acc[c][4 * dw] += wk * lo.x; acc[c][4 * dw + 1] += wk * lo.y; acc[c][4 * dw + 2] += wk * hi2.x; acc[c][4 * dw + 3] += wk * hi2.y; } } } while (0)
#endif
#define G9_PIN() do { _Pragma("unroll") for (int c = 0; c < 2; ++c) asm volatile("" : "+v"(acc[c][0]), "+v"(acc[c][1]), "+v"(acc[c][2]), "+v"(acc[c][3]), "+v"(acc[c][4]), "+v"(acc[c][5]), "+v"(acc[c][6]), "+v"(acc[c][7]), \
        "+v"(acc[c][8]), "+v"(acc[c][9]), "+v"(acc[c][10]), "+v"(acc[c][11]), "+v"(acc[c][12]), "+v"(acc[c][13]), "+v"(acc[c][14]), "+v"(acc[c][15])); } while (0)
template <class IdF, class GtF>
__device__ __forceinline__ void g9_token(Frame& F, const Ins& I, float* out, int t, LAS float* wl, IdF idf, GtF gtf) {
    unsigned char* ws = F.ws;
    const bf16* X2B = (const bf16*)(ws + WS_X2B); const unsigned char* EU = ws + WS_EU; const unsigned char* EV = ws + WS_EV;
    const float* ssq2 = (const float*)(ws + WS_PSQ2);
    const int lane = F.lane, sl = (lane >> 2) & 15;
    const bool bit3 = (lane & 8) != 0, bit2 = (lane & 4) != 0;
    {
        G9_SETS;
        {
            float xv[2][16];
#pragma unroll
            for (int c = 0; c < 2; ++c)
#pragma unroll
                for (int q = 0; q < 2; ++q) { const u32x4 a = *(const u32x4*)(X2B + (size_t)t * 2048 + G9_XOFF(c) + 8 * q);
                    xv[c][8 * q] = bflo(a.x); xv[c][8 * q + 1] = bfhi(a.x); xv[c][8 * q + 2] = bflo(a.y); xv[c][8 * q + 3] = bfhi(a.y); xv[c][8 * q + 4] = bflo(a.z); xv[c][8 * q + 5] = bfhi(a.z); xv[c][8 * q + 6] = bflo(a.w); xv[c][8 * q + 7] = bfhi(a.w); }
            const float rstd2 = (1.0f / EU_SCALE) / sqrtf(sum32(ssq2 + (size_t)t * 32) * (1.0f / 2048.0f) + EPS);
            int idl_cur = idf(0);
            G9_LOAD(A, EU, idl_cur, 0); __builtin_amdgcn_sched_barrier(0);
#pragma unroll 1
            for (int hd = 0; hd < 8; ++hd) {
                const int idl_nxt = idf(hd < 7 ? hd + 1 : 0); const float gtl = gtf(hd);
                float dots[16];
                G9_LOAD(B, EU, idl_cur, 1); __builtin_amdgcn_sched_barrier(0);
                G9_DOTS(A, 0); __builtin_amdgcn_sched_barrier(0);
                G9_LOAD(A, EU, idl_cur, 2); __builtin_amdgcn_sched_barrier(0);
                G9_DOTS(B, 1); __builtin_amdgcn_sched_barrier(0);
                G9_LOAD(B, EU, idl_cur, 3); __builtin_amdgcn_sched_barrier(0);
                G9_DOTS(A, 2); __builtin_amdgcn_sched_barrier(0);
                if (hd < 7) { G9_LOAD(A, EU, idl_nxt, 0); } else { G9_LOAD(A, EV, idl_nxt, 0); }
                __builtin_amdgcn_sched_barrier(0);
                G9_DOTS(B, 3); __builtin_amdgcn_sched_barrier(0);
                float d8[8], d4[4], d2[2], d1;
#pragma unroll
                for (int i = 0; i < 8; ++i) { auto rr = __builtin_amdgcn_permlane32_swap(__float_as_uint(dots[i]), __float_as_uint(dots[8 + i]), false, false); const unsigned r0 = rr[0], r1 = rr[1]; d8[i] = __uint_as_float(r0) + __uint_as_float(r1); }
#pragma unroll
                for (int i = 0; i < 4; ++i) { auto rr = __builtin_amdgcn_permlane16_swap(__float_as_uint(d8[i]), __float_as_uint(d8[4 + i]), false, false); const unsigned r0 = rr[0], r1 = rr[1]; d4[i] = __uint_as_float(r0) + __uint_as_float(r1); }
#pragma unroll
                for (int i = 0; i < 2; ++i) { const float keep = bit3 ? d4[2 + i] : d4[i], send = bit3 ? d4[i] : d4[2 + i]; d2[i] = keep + __shfl_xor(send, 8); }
                { const float keep = bit2 ? d2[1] : d2[0], send = bit2 ? d2[0] : d2[1]; d1 = keep + __shfl_xor(send, 4); }
                d1 += __shfl_xor(d1, 2); d1 += __shfl_xor(d1, 1);
                const float a = d1 * rstd2;
                const float z2 = 1.5957691216057308f * (a + 0.044715f * a * a * a);
                const float w = gtl * (1.0f / EV_SCALE) * a * __builtin_amdgcn_rcpf(1.0f + __builtin_amdgcn_exp2f(-z2 * LOG2E));
                if ((lane & 3) == 0) wl[hd * 16 + sl] = w;
                idl_cur = idl_nxt;
            }
        }
        LDS_WAIT(); asm volatile("" ::: "memory");
        float acc[2][16];
#pragma unroll
        for (int c = 0; c < 2; ++c)
#pragma unroll
            for (int e = 0; e < 16; ++e) acc[c][e] = 0.f;
        {
            int idl_cur = idf(0);
#pragma unroll 1
            for (int hd = 0; hd < 8; ++hd) {
                const int idl_nxt = idf(hd < 7 ? hd + 1 : 0);
                f32x4 wq[4];
#pragma unroll
                for (int g = 0; g < 4; ++g) wq[g] = *(const LAS f32x4*)(wl + hd * 16 + 4 * g);
                G9_LOAD(B, EV, idl_cur, 1); __builtin_amdgcn_sched_barrier(0);
                G9_FMAS(A, 0); G9_PIN(); __builtin_amdgcn_sched_barrier(0);
                G9_LOAD(A, EV, idl_cur, 2); __builtin_amdgcn_sched_barrier(0);
                G9_FMAS(B, 1); G9_PIN(); __builtin_amdgcn_sched_barrier(0);
                G9_LOAD(B, EV, idl_cur, 3); __builtin_amdgcn_sched_barrier(0);
                G9_FMAS(A, 2); G9_PIN(); __builtin_amdgcn_sched_barrier(0);
                if (hd < 7) { G9_LOAD(A, EV, idl_nxt, 0); } __builtin_amdgcn_sched_barrier(0);
                G9_FMAS(B, 3); G9_PIN(); __builtin_amdgcn_sched_barrier(0);
                idl_cur = idl_nxt;
            }
        }
        LDS_WAIT(); asm volatile("" ::: "memory");
        float s = 0.f;
#pragma unroll
        for (int c = 0; c < 2; ++c)
#pragma unroll
            for (int q = 0; q < 2; ++q) { const u32x4 a = *(const u32x4*)(X2B + (size_t)t * 2048 + G9_XOFF(c) + 8 * q);
                const float xr[8] = {bflo(a.x), bfhi(a.x), bflo(a.y), bfhi(a.y), bflo(a.z), bfhi(a.z), bflo(a.w), bfhi(a.w)};
#pragma unroll
                for (int e = 0; e < 8; ++e) { acc[c][8 * q + e] += xr[e]; s += acc[c][8 * q + e] * acc[c][8 * q + e]; } }
        float rs = 1.0f / sqrtf(wave_sum(s) * (1.0f / 2048.0f) + EPS);
#ifdef ATT_CHECK
        if (((const unsigned*)F.ctl)[16] + ((const unsigned*)F.ctl)[17] > 0u) rs = __builtin_nanf("");
#endif
#pragma unroll
        for (int c = 0; c < 2; ++c)
#pragma unroll
            for (int q = 0; q < 4; ++q) { const f32x4 g = *(const f32x4*)(I.g_final + G9_XOFF(c) + 4 * q);
                *(f32x4*)(out + (size_t)t * 2048 + G9_XOFF(c) + 4 * q) = (f32x4){acc[c][4 * q] * rs * g[0], acc[c][4 * q + 1] * rs * g[1], acc[c][4 * q + 2] * rs * g[2], acc[c][4 * q + 3] * rs * g[3]}; }
    }
}
#undef G9_LOAD
#undef G9_DOTS
#undef G9_FMAS
#undef G9_PIN
#undef G9_SETS
#undef G9_XOFF
__device__ __forceinline__ void p9_gather_fp8(Frame& F, const Ins& I, float* out) {
    const int* IDX = (const int*)(F.ws + WS_IDX); const float* GT = (const float*)(F.ws + WS_GT);
    const int lane = F.lane, sl = (lane >> 2) & 15;
    LAS float* wl = (LAS float*)(F.lds + RING_OFF + F.wave * 4096);
    unsigned* tokctr = (unsigned*)F.ctl + CW_TOKCTR;
    for (;;) {
        int t = 0; if (lane == 0) t = (int)__hip_atomic_fetch_add(tokctr, 1u, __ATOMIC_RELAXED, __HIP_MEMORY_SCOPE_AGENT);
        t = __builtin_amdgcn_readfirstlane(t);
        if (t >= T) break;
        const int* idx_t = IDX + (size_t)t * 128 + sl; const float* gt_t = GT + (size_t)t * 128 + sl;
        g9_token(F, I, out, t, wl, [=](int hd) { return idx_t[hd * 16]; }, [=](int hd) { return gt_t[hd * 16]; });
    }
}

__device__ __forceinline__ void p89_route_gather(Frame& F, const Ins& I, float* out) {
    using namespace rt;
    rt_load_keys(F, I);
    LAS unsigned* lstw = (LAS unsigned*)(F.lds + RING_OFF + LIST_OFF + F.wave * LIST_WAVE);
    LAS unsigned* lst = lstw + (F.lane & 31) * 48;
    LAS float* wl = (LAS float*)(lstw + 32 * 48);
    const int gw = F.vcu * NWAVES + F.wave, NGW = F.G * NWAVES, sl = (F.lane >> 2) & 15;
    for (int task = gw; task < T * 8 / 32; task += NGW) {
        rt_task<true>(F, task, lst);
        LDS_WAIT(); asm volatile("" ::: "memory");
#pragma unroll 1
        for (int tt = 0; tt < 4; ++tt) {
            LAS unsigned* lt = lstw + (tt * 8) * 48 + sl;
            g9_token(F, I, out, 4 * task + tt, wl, [=](int hd) { return (int)lt[hd * 48]; }, [=](int hd) { return __uint_as_float(lt[hd * 48 + 16]); });
        }
        LDS_WAIT(); asm volatile("" ::: "memory");
    }
}

constexpr int NPHASE = 10;
struct Args { Ins in; float* out; unsigned char* ws; double inv_freq[32]; int ph_lo, ph_hi; };
__global__ void __launch_bounds__(NWAVES * 64, 2) mega_fwd(Args args) {
    extern __shared__ __attribute__((aligned(16))) unsigned char lds[];
    Frame F;
    F.lds = (LAS unsigned char*)lds;
    F.MISC = (volatile LAS unsigned*)(F.lds + MISC_OFF);
    F.tid = threadIdx.x; F.lane = F.tid & 63; F.wave = __builtin_amdgcn_readfirstlane(F.tid >> 6);
    F.G = gridDim.x; { const int bx = blockIdx.x; F.vcu = (F.G % 8 == 0) ? (bx % 8) * (F.G / 8) + bx / 8 : bx; }
    unsigned char* ws = args.ws; F.ws = ws;
    F.ctl = (gu32*)(ws + WS_CTL);
    const Ins& I = args.in;
    for (int u = F.tid; u < (LDS_BYTES - LDSCTL_OFF) / 4; u += NWAVES * 64) ((LAS unsigned*)(F.lds + LDSCTL_OFF))[u] = 0u;
    __syncthreads();
    XcdBarrier bar; bar.bar = (unsigned*)(F.ctl + CW_BAR); bar.x = 0; bar.st = nullptr;
#if MK_N_LAUNCHES == 1
    bar = xcd_barrier_post((unsigned*)(F.ctl + CW_BAR), F.MISC + 8);
#define GRID_BAR() xcd_barrier(bar)
#else
#define GRID_BAR() do {} while (0)
#endif
    const int lo = args.ph_lo, hi = args.ph_hi;
#ifdef PROBE_PH
    unsigned long long pstamp[NPHASE + 1];
#define PSTAMP(k) do { if (blockIdx.x == 0 && F.tid == 0) pstamp[k] = __builtin_amdgcn_s_memrealtime(); } while (0)
#else
#define PSTAMP(k) do {} while (0)
#endif
#ifndef PH_MASK
#define PH_MASK 0xFFFF
#endif
#define IN(k) (((PH_MASK >> (k)) & 1) && lo <= (k) && (k) < hi)
#define BOTH(k) (IN(k) && IN((k) + 1))
    float* ssq_q = (float*)(ws + WS_PSQ_Q); float* ssq_kv = (float*)(ws + WS_PSQ_KV); float* ssq2 = (float*)(ws + WS_PSQ2);
    const float* rope = (const float*)(ws + WS_ROPE);

    PSTAMP(0);
    if (IN(0)) { p0_prologue(F, I, args.inv_freq); if (BOTH(0)) GRID_BAR(); }

    PSTAMP(1);
    if (IN(1)) {
        pg8::Gemm g{(const bf16_t*)(ws + WS_H), (const bf16_t*)(ws + WS_W1), T, N1, 2048, 2048}; pg8::StaticOrder S; S.init(T, N1, F.G, (int)blockIdx.x);
        EpiProj E{(bf16_t*)(ws + WS_CQ), (bf16_t*)(ws + WS_CKV), (bf16_t*)(ws + WS_DQ), (bf16_t*)(ws + WS_DK), (bf16_t*)(ws + WS_DV), (bf16_t*)(ws + WS_G), (bf16_t*)(ws + WS_KR), ssq_q, ssq_kv, I.b_gate, rope};
        pg8::gemm_phase<EpiProj, pg8::StaticOrder, PG8_ALIGN, PG8_SP2>(F.lds + RING_OFF, g, S, E);
        if (BOTH(1)) GRID_BAR();
    }
    PSTAMP(2);
    if (IN(2)) {
        { pg8::Gemm g{(const bf16_t*)(ws + WS_CQ), (const bf16_t*)(ws + WS_WUQ), T, 1536, 768, 768}; pg8::StaticOrder S; S.init(T, 1536, F.G, (int)blockIdx.x);
          EpiQup E{(bf16_t*)(ws + WS_QN), (bf16_t*)(ws + WS_QR), ssq_q, rope};
          pg8::gemm_phase<EpiQup, pg8::StaticOrder, PG8_ALIGN, PG8_SP2>(F.lds + RING_OFF, g, S, E); }
        { pg8::Gemm g{(const bf16_t*)(ws + WS_CKV), (const bf16_t*)(ws + WS_WUKV), T, 2048, 512, 512}; pg8::StaticOrder S; S.init(T, 2048, F.G, (int)blockIdx.x);
          EpiKVup E{(bf16_t*)(ws + WS_KN), (bf16_t*)(ws + WS_V), ssq_kv};
          pg8::gemm_phase<EpiKVup, pg8::StaticOrder, PG8_ALIGN, PG8_SP2>(F.lds + RING_OFF, g, S, E); }
        if (BOTH(2)) GRID_BAR();
    }
    PSTAMP(3);
#ifdef ATT_REF
    if (IN(3)) { p3_attention_ref(F, I); if (BOTH(3)) GRID_BAR(); }
#else
    if (IN(3)) { p3_attention(F, I); if (BOTH(3)) GRID_BAR(); }
#ifdef ATT_CHECK
    if (IN(3)) { p3_attention_ref(F, I); GRID_BAR(); }
#endif
#endif
    PSTAMP(4);
    if (IN(4)) {
        pg8::Gemm2 g{(const bf16_t*)(ws + WS_OM), (const bf16_t*)(ws + WS_OD), (const bf16_t*)(ws + WS_WOM), (const bf16_t*)(ws + WS_WOD), T, 2048, 1024, 1024};
        pg8::StaticOrder S; S.init(T, 2048, F.G, (int)blockIdx.x);
        EpiGate2 E{(const bf16_t*)(ws + WS_G), (bf16_t*)(ws + WS_MG)};
        pg8::gemm_phase2<EpiGate2, pg8::StaticOrder, PG8_ALIGN, PG8_SP2>(F.lds + RING_OFF, g, S, E);
        if (BOTH(4)) GRID_BAR();
    }
    PSTAMP(5);
    PSTAMP(6);
    if (IN(6)) {
#ifdef PEER_BF16
        convert_experts(F, I);
#else
#ifdef PEER_FP6
        convert_experts_fp6(F, I);
#else
        convert_experts_fp8(F, I);
#endif
#endif
        pg8::Gemm g{(const bf16_t*)(ws + WS_MG), (const bf16_t*)(ws + WS_WOUT), T, 2048, 2048, 2048}; pg8::StaticOrder S; S.init(T, 2048, F.G, (int)blockIdx.x);
        EpiRes E{I.x, (float*)(ws + WS_X2), (bf16_t*)(ws + WS_X2B), ssq2};
        pg8::gemm_phase<EpiRes, pg8::StaticOrder, PG8_ALIGN, PG8_SP2>(F.lds + RING_OFF, g, S, E);
        if (BOTH(6)) GRID_BAR();
    }
    PSTAMP(7);
    if (IN(7)) {
        pg8::Gemm g{(const bf16_t*)(ws + WS_X2B), (const bf16_t*)(ws + WS_WQP), T, 2048, 2048, 2048}; pg8::StaticOrder S; S.init(T, 2048, F.G, (int)blockIdx.x);
        EpiQP E{(bf16_t*)(ws + WS_QP), ssq2, (const LAS float*)(F.lds + RTAB_OFF), {-1, -1, -1, -1}};
        {
            LAS float* tab = (LAS float*)(F.lds + RTAB_OFF); pg8::Unit u;
#pragma unroll
            for (int i = 0; i < RTAB_SLOTS; ++i) {
                if (S.next(i, u)) {
                    E.pms[i] = u.pm;
                    const int r = F.tid >> 1, hf = F.tid & 1; const float* p = ssq2 + ((size_t)u.pm * 256 + r) * 32 + hf * 16;
                    const f32x4 q0 = *(const f32x4*)p, q1 = *(const f32x4*)(p + 4), q2 = *(const f32x4*)(p + 8), q3 = *(const f32x4*)(p + 12);
                    float t = (((q0[0] + q0[1]) + (q0[2] + q0[3])) + ((q1[0] + q1[1]) + (q1[2] + q1[3]))) + (((q2[0] + q2[1]) + (q2[2] + q2[3])) + ((q3[0] + q3[1]) + (q3[2] + q3[3])));
                    t += __shfl_xor(t, 1);
                    if (hf == 0) tab[i * 256 + r] = 1.0f / sqrtf(t * (1.0f / 2048.0f) + EPS);
                }
            }
            __syncthreads();
        }
        pg8::gemm_phase<EpiQP, pg8::StaticOrder, PG8_ALIGN, PG8_SP2>(F.lds + RING_OFF, g, S, E);
        if (BOTH(7)) GRID_BAR();
    }
    PSTAMP(8);
#if defined(ROUTE_REF) || defined(PEER_BF16) || defined(NO_FUSE89)
#ifdef ROUTE_REF
    if (IN(8)) { p7_routing_ref(F); if (BOTH(8)) GRID_BAR(); }
#else
    if (IN(8)) { p8_routing(F, I); if (BOTH(8)) GRID_BAR(); }
#endif
    PSTAMP(9);
#ifdef PEER_BF16
    if (IN(9)) { p8_gather(F, I, args.out); }
#else
    if (IN(9)) { p9_gather_fp8(F, I, args.out); }
#endif
#else
    if (IN(8) && IN(9)) { p89_route_gather(F, I, args.out); }
    PSTAMP(9);
#endif
    PSTAMP(10);
#ifdef PROBE_PH
    if (blockIdx.x == 0 && F.tid == 0) {
        const unsigned long long span = (pstamp[PROBE_PH + 1] - pstamp[PROBE_PH]) * PROBE_MUL, t0 = __builtin_amdgcn_s_memrealtime();
        while (__builtin_amdgcn_s_memrealtime() - t0 < span) __builtin_amdgcn_s_sleep(32);
    }
#endif
#undef IN
#undef BOTH
}

extern "C" void kernel_launch(void* const* d_in, const int* in_sizes, int n_in, void* d_out, int out_size, void* d_ws, size_t ws_size, hipStream_t stream) {
    static int grid = 0;
    if (grid == 0) {
        if (n_in != 19 || out_size != T * D_MODEL || ws_size < WS_END) { fprintf(stderr, "kernel_launch: unexpected shapes: n_in %d out %d ws %zu\n", n_in, out_size, ws_size); grid = -1; return; }
        int dev = 0, cus = 0, per_cu = 0;
        if (hipGetDevice(&dev) != hipSuccess || hipDeviceGetAttribute(&cus, hipDeviceAttributeMultiprocessorCount, dev) != hipSuccess) { grid = -1; return; }
        if (hipFuncSetAttribute((const void*)mega_fwd, hipFuncAttributeMaxDynamicSharedMemorySize, LDS_BYTES) != hipSuccess) { fprintf(stderr, "kernel_launch: hipFuncSetAttribute failed\n"); grid = -1; return; }
        if (hipOccupancyMaxActiveBlocksPerMultiprocessor(&per_cu, (const void*)mega_fwd, NWAVES * 64, LDS_BYTES) != hipSuccess || per_cu < 1)
            fprintf(stderr, "kernel_launch: occupancy query reports %d workgroups per CU\n", per_cu);
        (void)hipGetLastError();
        grid = cus;
    }
    if (grid < 0) return;
    if (hipMemsetAsync((char*)d_ws + WS_CTL, 0, CTL_ZERO_BYTES, stream) != hipSuccess) { fprintf(stderr, "kernel_launch: memset failed\n"); return; }
    Args a{};
    const float** ip = (const float**)&a.in;
    for (int i = 0; i < 19; ++i) ip[i] = (const float*)d_in[i];
    a.out = (float*)d_out; a.ws = (unsigned char*)d_ws;
    for (int i = 0; i < 32; ++i) a.inv_freq[i] = pow(10000.0, -(double)i / 32.0);
#if MK_N_LAUNCHES == 1
    a.ph_lo = 0; a.ph_hi = NPHASE;
    hipLaunchKernelGGL(mega_fwd, dim3(grid), dim3(NWAVES * 64), LDS_BYTES, stream, a);
#else
    for (int p = 0; p < NPHASE; ++p) { a.ph_lo = p; a.ph_hi = p + 1; hipLaunchKernelGGL(mega_fwd, dim3(grid), dim3(NWAVES * 64), LDS_BYTES, stream, a); }
#endif
    const hipError_t le = hipPeekAtLastError();
    if (le != hipSuccess) fprintf(stderr, "kernel_launch: launch failed: %s\n", hipGetErrorName(le));
}
```

```cpp
#include <hip/hip_runtime.h>
#include <cstdio>
#include <cstdint>
#include <cmath>

#ifndef MK_N_LAUNCHES
#define MK_N_LAUNCHES 1
#endif

constexpr int D_MODEL = 2048, BATCH = 2, SEQ = 8192, T = BATCH * SEQ;
constexpr int OFF_CQ = 0, OFF_CKV = 768, OFF_KR = 1280, OFF_DQ = 1344, OFF_DK = 2368, OFF_DV = 3392, OFF_GATE = 4416, IN_COLS = 8512;
constexpr int N1 = 4608;
constexpr int NG = 4096;
constexpr float W1_SCALE = 32.0f;
constexpr int NEXP = 16384;
constexpr float EPS = 1e-6f;
constexpr float LOG2E = 1.4426950408889634f;
constexpr float C2_MLA = 0.07216878364870322f * LOG2E;
constexpr float C2_DIFF = 0.125f * LOG2E;
constexpr float LAMBDA_INIT = 0.2f;

namespace pg8 {
#define PG8_LAS __attribute__((address_space(3)))
typedef unsigned short bf16_t;
typedef short bf16x8 __attribute__((ext_vector_type(8)));
typedef float f32x4 __attribute__((ext_vector_type(4)));
typedef unsigned u32x4 __attribute__((ext_vector_type(4)));
typedef unsigned u32x2 __attribute__((ext_vector_type(2)));
typedef int v8i32 __attribute__((ext_vector_type(8)));
constexpr int BM = 256, BK = 64, HALF = 128, HTB = HALF * BK * 2, STAGE_BYTES = 8 * HTB, NXCD = 8, WGM = 8;

__host__ __device__ __forceinline__ int lds_byte(int r, int c) { const int st = (r >> 4) * 2 + (c >> 5), rr = r & 15, cc = c & 31, ob = rr * 64 + cc * 2; return st * 1024 + (ob ^ (((ob >> 9) & 1) << 5)); }
__host__ __device__ __forceinline__ void stage_rc(int b, int& R, int& C) { const int st = b / 1024, sb = b % 1024, swz = sb ^ (((sb >> 9) & 1) << 5); R = (st >> 1) * 16 + swz / 64; C = (st & 1) * 32 + (swz % 64) / 2; }
__host__ __device__ __forceinline__ int perm32(int rho) { const int n = rho >> 4, i = rho & 15; return 8 * (i >> 2) + 4 * n + (i & 3); }

struct Unit { int pm, pn; };
struct Gemm { const bf16_t* A; const bf16_t* Bt; int M, N, K, lda; float oscale; };

struct StaticOrder {
    int nM, nN, nwg, G, c;
    __host__ __device__ void init(int M, int N, int G_, int c_) { nM = M / BM; nN = N / BM; nwg = nM * nN; G = G_; c = c_; }
    __host__ __device__ bool next(int i, Unit& u) const { return map((long)i * G + c, u); }
    __host__ __device__ bool map(long L, Unit& u) const {
        if (L >= nwg) return false;
        int wgid = (int)L; { const int q = nwg / NXCD, r = nwg % NXCD, xcd = wgid % NXCD, off = wgid / NXCD; wgid = (xcd < r ? xcd * (q + 1) : r * (q + 1) + (xcd - r) * q) + off; }
        const int nig = WGM * nN, gid = wgid / nig, fm = gid * WGM, gsz = (nM - fm) < WGM ? (nM - fm) : WGM;
        u.pm = fm + ((wgid % nig) % gsz); u.pn = (wgid % nig) / gsz; return true;
    }
    __device__ __forceinline__ void a_ready(const Unit&) const {}
    __device__ __forceinline__ void done(const Unit&) const {}
};

struct GateOrder : StaticOrder {
    __host__ __device__ bool next(int i, Unit& u) const {
        if (G != 256 || nwg != 1024) return StaticOrder::next(i, u);
        if (i < 3) return map((long)i * 256 + c, u);
        if (c >= 128 && i < 5) return map(768 + (long)(i - 3) * 128 + (c - 128), u);
        return false;
    }
};
typedef float f32x2_t __attribute__((ext_vector_type(2))); typedef __bf16 bf16x2_t __attribute__((ext_vector_type(2)));
__device__ __forceinline__ unsigned cvtpk(float lo, float hi) { f32x2_t v = {lo, hi}; bf16x2_t b = __builtin_convertvector(v, bf16x2_t); return __builtin_bit_cast(unsigned, b); }
__device__ __forceinline__ float bf2f(unsigned short h) { return __builtin_bit_cast(float, (unsigned)h << 16); }
__device__ __forceinline__ float bflo(unsigned w) { return __builtin_bit_cast(float, w << 16); }
__device__ __forceinline__ float bfhi(unsigned w) { return __builtin_bit_cast(float, w & 0xffff0000u); }

template <class Epi, class Sched, bool ALIGN_EPI = false, bool SP2 = false, bool FP8 = false>
__device__ __forceinline__ void gemm_phase(PG8_LAS unsigned char* lds, const Gemm g, const Sched& S, const Epi& E) {
    const int tid = threadIdx.x, wid = __builtin_amdgcn_readfirstlane(tid >> 6), lane = tid & 63, wr = wid >> 2, wc = wid & 3, fr = lane & 15, fq = lane >> 4;
    const int K = g.K, nt = K / BK, lda = g.lda;
    unsigned voffA[2], voffB[2];
#pragma unroll
    for (int i = 0; i < 2; ++i) { int R, C; stage_rc(tid * 16 + i * 8192, R, C); const int Rb = Epi::PERM ? ((R & ~31) + perm32(R & 31)) : R;
        voffA[i] = (unsigned)(R * lda + C) * 2u; voffB[i] = (unsigned)(Rb * K + C) * 2u; }
    const size_t kstep = (size_t)(BK * 2);
    const size_t hstepA = (size_t)HALF * lda * 2, hstepB = (size_t)HALF * K * 2;
    const size_t tstepA = 2 * hstepA, tstepB = 2 * hstepB;
    const unsigned ldsw = (unsigned)wid * 1024u;
    const int aoff = lds_byte(wr * 64 + fr, fq * 8), boff = lds_byte(wc * 32 + fr, fq * 8);
    const int aoff8 = lds_byte(wr * 64 + fr, 16 * fq) & ~31, boff8 = lds_byte(wc * 32 + fr, 16 * fq) & ~31;
#define PG8_SA(b, h) (((b) * 2 + (h)) * HTB)
#define PG8_SB(b, h) ((4 + (b) * 2 + (h)) * HTB)
#define PG8_STAGE(bufoff, gbase, voff) do { _Pragma("unroll") for (int _i = 0; _i < 2; ++_i) \
        __builtin_amdgcn_global_load_lds((const unsigned*)((const char*)(gbase) + (voff)[_i]), (PG8_LAS unsigned*)(lds + (bufoff) + ldsw + _i * 8192), 16, 0, 0); } while (0)
#define PG8_LDA(dst, b, h) do { _Pragma("unroll") for (int m = 0; m < 4; ++m) _Pragma("unroll") for (int k = 0; k < 2; ++k) { if constexpr (FP8) { if (k == 0) dst##8[m] = *(const PG8_LAS v8i32*)(lds + PG8_SA(b, h) + aoff8 + m * 2048); } else dst[m][k] = *(const PG8_LAS bf16x8*)(lds + PG8_SA(b, h) + aoff + m * 2048 + k * 1024); } } while (0)
#define PG8_LDB(dst, b, h) do { _Pragma("unroll") for (int n = 0; n < 2; ++n) _Pragma("unroll") for (int k = 0; k < 2; ++k) { if constexpr (FP8) { if (k == 0) dst##8[n] = *(const PG8_LAS v8i32*)(lds + PG8_SB(b, h) + boff8 + n * 2048); } else dst[n][k] = *(const PG8_LAS bf16x8*)(lds + PG8_SB(b, h) + boff + n * 2048 + k * 1024); } } while (0)
#define PG8_MMA(ai, bj, At, Bt) do { __builtin_amdgcn_s_setprio(1); _Pragma("unroll") for (int m = 0; m < 4; ++m) _Pragma("unroll") for (int n = 0; n < 2; ++n) { if constexpr (FP8) { \
        asm volatile("v_mfma_scale_f32_16x16x128_f8f6f4 %0, %1, %2, %0, %3, %3 op_sel_hi:[0,0,0]" : "+v"(acc[ai][bj][m][n]) : "v"(Bt##8[n]), "v"(At##8[m]), "v"(mxs));   \
        } else { _Pragma("unroll") for (int k = 0; k < 2; ++k) \
        acc[ai][bj][m][n] = __builtin_amdgcn_mfma_f32_16x16x32_bf16(Bt[n][k], At[m][k], acc[ai][bj][m][n], 0, 0, 0); } } __builtin_amdgcn_s_setprio(0); } while (0)
#define PG8_WAIT_V(n) asm volatile("s_waitcnt vmcnt(" #n ")" ::: "memory")
#define PG8_WAIT_L(n) asm volatile("s_waitcnt lgkmcnt(" #n ")" ::: "memory")
#define PG8_BAR __builtin_amdgcn_s_barrier()
#define PG8_SCHED __builtin_amdgcn_sched_barrier(0)
    Unit cur, nxt; int ui = 0;
    if (!S.next(0, cur)) return;
    f32x4 acc[2][2][4][2];
#pragma unroll
    for (int a = 0; a < 2; ++a)
#pragma unroll
        for (int b = 0; b < 2; ++b)
#pragma unroll
            for (int m = 0; m < 4; ++m)
#pragma unroll
                for (int n = 0; n < 2; ++n) acc[a][b][m][n] = (f32x4){0.f, 0.f, 0.f, 0.f};
    bf16x8 At[4][2], B0[2][2], B1[2][2];
    v8i32 At8[4], B08[2], B18[2];
    const int mxs = 0x7F7F7F7F;
    const char* cA = (const char*)g.A + (size_t)cur.pm * tstepA; const char* cB = (const char*)g.Bt + (size_t)cur.pn * tstepB;
    S.a_ready(cur);
    if constexpr (SP2) {
        PG8_STAGE(PG8_SB(0, 0), cB, voffB); PG8_STAGE(PG8_SB(0, 1), cB + hstepB, voffB); PG8_STAGE(PG8_SA(0, 0), cA, voffA); PG8_STAGE(PG8_SA(0, 1), cA + hstepA, voffA);
        if (wr == 1) PG8_BAR;
        PG8_WAIT_V(2); PG8_BAR;
        PG8_STAGE(PG8_SB(1, 0), cB + kstep, voffB); PG8_STAGE(PG8_SA(1, 0), cA + kstep, voffA); PG8_STAGE(PG8_SB(1, 1), cB + hstepB + kstep, voffB);
        PG8_WAIT_V(6); PG8_BAR;
    } else {
        PG8_STAGE(PG8_SB(0, 0), cB, voffB); PG8_STAGE(PG8_SA(0, 0), cA, voffA); PG8_STAGE(PG8_SB(0, 1), cB + hstepB, voffB); PG8_STAGE(PG8_SA(0, 1), cA + hstepA, voffA);
        if (wr == 1) PG8_BAR;
        PG8_WAIT_V(4); PG8_BAR;
        PG8_STAGE(PG8_SB(1, 0), cB + kstep, voffB); PG8_STAGE(PG8_SA(1, 0), cA + kstep, voffA); PG8_STAGE(PG8_SB(1, 1), cB + hstepB + kstep, voffB);
        PG8_WAIT_V(6); PG8_BAR;
    }
    for (;;) {
        const bool has_next = S.next(ui + 1, nxt);
        const char* nA = has_next ? (const char*)g.A + (size_t)nxt.pm * tstepA : cA; const char* nB = has_next ? (const char*)g.Bt + (size_t)nxt.pn * tstepB : cB;
        for (int t = 0; t < nt; t += 2) {
            const bool last = (t == nt - 2);
            const char* a1 = cA + (size_t)(t + 1) * kstep;
            const char* a2 = last ? nA : cA + (size_t)(t + 2) * kstep; const char* b2 = last ? nB : cB + (size_t)(t + 2) * kstep;
            const char* a3 = a2 + kstep; const char* b3 = b2 + kstep;
            if (last && has_next) S.a_ready(nxt);
            if constexpr (SP2) {
            PG8_LDB(B0, 0, 0); PG8_LDB(B1, 0, 1); PG8_SCHED; PG8_LDA(At, 0, 0); PG8_STAGE(PG8_SA(1, 1), a1 + hstepA, voffA);
            PG8_WAIT_V(8); PG8_WAIT_L(0); PG8_BAR; PG8_MMA(0, 0, At, B0); PG8_MMA(0, 1, At, B1); PG8_BAR; PG8_SCHED;
            PG8_LDA(At, 0, 1); PG8_STAGE(PG8_SB(0, 0), b2, voffB); PG8_STAGE(PG8_SB(0, 1), b2 + hstepB, voffB); PG8_STAGE(PG8_SA(0, 0), a2, voffA);
            PG8_WAIT_V(8); PG8_WAIT_L(0); PG8_BAR; PG8_MMA(1, 0, At, B0); PG8_MMA(1, 1, At, B1); PG8_BAR; PG8_SCHED;
            PG8_LDB(B0, 1, 0); PG8_LDB(B1, 1, 1); PG8_SCHED; PG8_LDA(At, 1, 0); PG8_STAGE(PG8_SA(0, 1), a2 + hstepA, voffA);
            PG8_WAIT_V(8); PG8_WAIT_L(0); PG8_BAR; PG8_MMA(0, 0, At, B0); PG8_MMA(0, 1, At, B1); PG8_BAR; PG8_SCHED;
            PG8_LDA(At, 1, 1); PG8_STAGE(PG8_SB(1, 0), b3, voffB); PG8_STAGE(PG8_SB(1, 1), b3 + hstepB, voffB); PG8_STAGE(PG8_SA(1, 0), a3, voffA);
            PG8_WAIT_V(8); PG8_WAIT_L(0); PG8_BAR; PG8_MMA(1, 0, At, B0); PG8_MMA(1, 1, At, B1); PG8_BAR; PG8_SCHED;
            } else {
            PG8_LDB(B0, 0, 0); PG8_SCHED; PG8_LDA(At, 0, 0); PG8_STAGE(PG8_SA(1, 1), a1 + hstepA, voffA);
            PG8_WAIT_L(8); PG8_BAR; PG8_WAIT_L(0); PG8_MMA(0, 0, At, B0); PG8_BAR; PG8_SCHED;
            PG8_LDB(B1, 0, 1); PG8_STAGE(PG8_SB(0, 0), b2, voffB);
            PG8_BAR; PG8_WAIT_L(0); PG8_MMA(0, 1, At, B1); PG8_BAR;
            PG8_LDA(At, 0, 1); PG8_STAGE(PG8_SA(0, 0), a2, voffA);
            PG8_BAR; PG8_WAIT_L(0); PG8_MMA(1, 0, At, B0); PG8_BAR; PG8_SCHED;
            PG8_STAGE(PG8_SB(0, 1), b2 + hstepB, voffB);
            PG8_WAIT_V(6); PG8_BAR; PG8_MMA(1, 1, At, B1); PG8_BAR;
            PG8_LDB(B0, 1, 0); PG8_SCHED; PG8_LDA(At, 1, 0); PG8_STAGE(PG8_SA(0, 1), a2 + hstepA, voffA);
            PG8_WAIT_L(8); PG8_BAR; PG8_WAIT_L(0); PG8_MMA(0, 0, At, B0); PG8_BAR; PG8_SCHED;
            PG8_LDB(B1, 1, 1); PG8_STAGE(PG8_SB(1, 0), b3, voffB);
            PG8_BAR; PG8_WAIT_L(0); PG8_MMA(0, 1, At, B1); PG8_BAR;
            PG8_LDA(At, 1, 1); PG8_STAGE(PG8_SA(1, 0), a3, voffA);
            PG8_BAR; PG8_WAIT_L(0); PG8_MMA(1, 0, At, B0); PG8_BAR; PG8_SCHED;
            PG8_STAGE(PG8_SB(1, 1), b3 + hstepB, voffB);
            PG8_WAIT_V(6); PG8_BAR; PG8_MMA(1, 1, At, B1); PG8_BAR;
            }
        }
        if constexpr (ALIGN_EPI) { if (wr == 0) PG8_BAR; }
        if constexpr (FP8) {
            asm volatile("s_nop 15\n\ts_nop 7" ::: "memory");
#pragma unroll
            for (int a = 0; a < 2; ++a)
#pragma unroll
                for (int b = 0; b < 2; ++b)
#pragma unroll
                    for (int m = 0; m < 4; ++m)
#pragma unroll
                        for (int n = 0; n < 2; ++n) acc[a][b][m][n] *= g.oscale; }
        E(acc, cur, wr, wc, fr, fq); S.done(cur);
        if (!has_next) break;
#pragma unroll
        for (int a = 0; a < 2; ++a)
#pragma unroll
            for (int b = 0; b < 2; ++b)
#pragma unroll
                for (int m = 0; m < 4; ++m)
#pragma unroll
                    for (int n = 0; n < 2; ++n) acc[a][b][m][n] = (f32x4){0.f, 0.f, 0.f, 0.f};
        cur = nxt; cA = nA; cB = nB; ++ui;
        if constexpr (ALIGN_EPI) { if (wr == 1) PG8_BAR; }
    }
    PG8_WAIT_V(0);
    if constexpr (!ALIGN_EPI) { if (wr == 0) PG8_BAR; }
    PG8_BAR;
#undef PG8_SA
#undef PG8_SB
#undef PG8_STAGE
#undef PG8_LDA
#undef PG8_LDB
#undef PG8_MMA
#undef PG8_WAIT_V
#undef PG8_WAIT_L
#undef PG8_BAR
#undef PG8_SCHED
}
struct Gemm2 { const bf16_t *A1, *A2, *B1, *B2; int M, N, K1, lda; };
template <class Epi, class Sched, bool ALIGN_EPI = false, bool SP2 = false>
__device__ __forceinline__ void gemm_phase2(PG8_LAS unsigned char* lds, const Gemm2 g, const Sched& S, const Epi& E) {
    const int tid = threadIdx.x, wid = __builtin_amdgcn_readfirstlane(tid >> 6), lane = tid & 63, wr = wid >> 2, wc = wid & 3, fr = lane & 15, fq = lane >> 4;
    const int K = g.K1, nt = K / BK, lda = g.lda;
    unsigned voffA[2], voffB[2];
#pragma unroll
    for (int i = 0; i < 2; ++i) { int R, C; stage_rc(tid * 16 + i * 8192, R, C); const int Rb = Epi::PERM ? ((R & ~31) + perm32(R & 31)) : R;
        voffA[i] = (unsigned)(R * lda + C) * 2u; voffB[i] = (unsigned)(Rb * K + C) * 2u; }
    const size_t kstep = (size_t)(BK * 2);
    const size_t hstepA = (size_t)HALF * lda * 2, hstepB = (size_t)HALF * K * 2;
    const size_t tstepA = 2 * hstepA, tstepB = 2 * hstepB;
    const unsigned ldsw = (unsigned)wid * 1024u;
    const int aoff = lds_byte(wr * 64 + fr, fq * 8), boff = lds_byte(wc * 32 + fr, fq * 8);
#define PG8_SA(b, h) (((b) * 2 + (h)) * HTB)
#define PG8_SB(b, h) ((4 + (b) * 2 + (h)) * HTB)
#define PG8_STAGE(bufoff, gbase, voff) do { _Pragma("unroll") for (int _i = 0; _i < 2; ++_i) \
        __builtin_amdgcn_global_load_lds((const unsigned*)((const char*)(gbase) + (voff)[_i]), (PG8_LAS unsigned*)(lds + (bufoff) + ldsw + _i * 8192), 16, 0, 0); } while (0)
#define PG8_LDA(dst, b, h) do { _Pragma("unroll") for (int m = 0; m < 4; ++m) _Pragma("unroll") for (int k = 0; k < 2; ++k) dst[m][k] = *(const PG8_LAS bf16x8*)(lds + PG8_SA(b, h) + aoff + m * 2048 + k * 1024); } while (0)
#define PG8_LDB(dst, b, h) do { _Pragma("unroll") for (int n = 0; n < 2; ++n) _Pragma("unroll") for (int k = 0; k < 2; ++k) dst[n][k] = *(const PG8_LAS bf16x8*)(lds + PG8_SB(b, h) + boff + n * 2048 + k * 1024); } while (0)
#define PG8_MMA(ai, bj, At, Bt) do { __builtin_amdgcn_s_setprio(1); _Pragma("unroll") for (int m = 0; m < 4; ++m) _Pragma("unroll") for (int n = 0; n < 2; ++n) _Pragma("unroll") for (int k = 0; k < 2; ++k) \
        acc[ai][bj][m][n] = __builtin_amdgcn_mfma_f32_16x16x32_bf16(Bt[n][k], At[m][k], acc[ai][bj][m][n], 0, 0, 0); __builtin_amdgcn_s_setprio(0); } while (0)
#define PG8_WAIT_V(n) asm volatile("s_waitcnt vmcnt(" #n ")" ::: "memory")
#define PG8_WAIT_L(n) asm volatile("s_waitcnt lgkmcnt(" #n ")" ::: "memory")
#define PG8_BAR __builtin_amdgcn_s_barrier()
#define PG8_SCHED __builtin_amdgcn_sched_barrier(0)
    Unit cur, nxt; int ui = 0;
    if (!S.next(0, cur)) return;
    f32x4 acc[2][2][4][2];
#pragma unroll
    for (int a = 0; a < 2; ++a)
#pragma unroll
        for (int b = 0; b < 2; ++b)
#pragma unroll
            for (int m = 0; m < 4; ++m)
#pragma unroll
                for (int n = 0; n < 2; ++n) acc[a][b][m][n] = (f32x4){0.f, 0.f, 0.f, 0.f};
    bf16x8 At[4][2], B0[2][2], B1[2][2];
    const char* cA = (const char*)g.A1 + (size_t)cur.pm * tstepA; const char* cB = (const char*)g.B1 + (size_t)cur.pn * tstepB;
    S.a_ready(cur);
    if constexpr (SP2) {
        PG8_STAGE(PG8_SB(0, 0), cB, voffB); PG8_STAGE(PG8_SB(0, 1), cB + hstepB, voffB); PG8_STAGE(PG8_SA(0, 0), cA, voffA); PG8_STAGE(PG8_SA(0, 1), cA + hstepA, voffA);
        if (wr == 1) PG8_BAR;
        PG8_WAIT_V(2); PG8_BAR;
        PG8_STAGE(PG8_SB(1, 0), cB + kstep, voffB); PG8_STAGE(PG8_SA(1, 0), cA + kstep, voffA); PG8_STAGE(PG8_SB(1, 1), cB + hstepB + kstep, voffB);
        PG8_WAIT_V(6); PG8_BAR;
    } else {
        PG8_STAGE(PG8_SB(0, 0), cB, voffB); PG8_STAGE(PG8_SA(0, 0), cA, voffA); PG8_STAGE(PG8_SB(0, 1), cB + hstepB, voffB); PG8_STAGE(PG8_SA(0, 1), cA + hstepA, voffA);
        if (wr == 1) PG8_BAR;
        PG8_WAIT_V(4); PG8_BAR;
        PG8_STAGE(PG8_SB(1, 0), cB + kstep, voffB); PG8_STAGE(PG8_SA(1, 0), cA + kstep, voffA); PG8_STAGE(PG8_SB(1, 1), cB + hstepB + kstep, voffB);
        PG8_WAIT_V(6); PG8_BAR;
    }
    for (;;) {
        const int nhalf = (ui + 1) & 1;
        const bool has_next = S.next((ui + 1) >> 1, nxt);
        const char* nA = has_next ? (const char*)(nhalf ? g.A2 : g.A1) + (size_t)nxt.pm * tstepA : cA; const char* nB = has_next ? (const char*)(nhalf ? g.B2 : g.B1) + (size_t)nxt.pn * tstepB : cB;
        for (int t = 0; t < nt; t += 2) {
            const bool last = (t == nt - 2);
            const char* a1 = cA + (size_t)(t + 1) * kstep;
            const char* a2 = last ? nA : cA + (size_t)(t + 2) * kstep; const char* b2 = last ? nB : cB + (size_t)(t + 2) * kstep;
            const char* a3 = a2 + kstep; const char* b3 = b2 + kstep;
            if (last && has_next) S.a_ready(nxt);
            if constexpr (SP2) {
            PG8_LDB(B0, 0, 0); PG8_LDB(B1, 0, 1); PG8_SCHED; PG8_LDA(At, 0, 0); PG8_STAGE(PG8_SA(1, 1), a1 + hstepA, voffA);
            PG8_WAIT_V(8); PG8_WAIT_L(0); PG8_BAR; PG8_MMA(0, 0, At, B0); PG8_MMA(0, 1, At, B1); PG8_BAR; PG8_SCHED;
            PG8_LDA(At, 0, 1); PG8_STAGE(PG8_SB(0, 0), b2, voffB); PG8_STAGE(PG8_SB(0, 1), b2 + hstepB, voffB); PG8_STAGE(PG8_SA(0, 0), a2, voffA);
            PG8_WAIT_V(8); PG8_WAIT_L(0); PG8_BAR; PG8_MMA(1, 0, At, B0); PG8_MMA(1, 1, At, B1); PG8_BAR; PG8_SCHED;
            PG8_LDB(B0, 1, 0); PG8_LDB(B1, 1, 1); PG8_SCHED; PG8_LDA(At, 1, 0); PG8_STAGE(PG8_SA(0, 1), a2 + hstepA, voffA);
            PG8_WAIT_V(8); PG8_WAIT_L(0); PG8_BAR; PG8_MMA(0, 0, At, B0); PG8_MMA(0, 1, At, B1); PG8_BAR; PG8_SCHED;
            PG8_LDA(At, 1, 1); PG8_STAGE(PG8_SB(1, 0), b3, voffB); PG8_STAGE(PG8_SB(1, 1), b3 + hstepB, voffB); PG8_STAGE(PG8_SA(1, 0), a3, voffA);
            PG8_WAIT_V(8); PG8_WAIT_L(0); PG8_BAR; PG8_MMA(1, 0, At, B0); PG8_MMA(1, 1, At, B1); PG8_BAR; PG8_SCHED;
            } else {
            PG8_LDB(B0, 0, 0); PG8_SCHED; PG8_LDA(At, 0, 0); PG8_STAGE(PG8_SA(1, 1), a1 + hstepA, voffA);
            PG8_WAIT_L(8); PG8_BAR; PG8_WAIT_L(0); PG8_MMA(0, 0, At, B0); PG8_BAR; PG8_SCHED;
            PG8_LDB(B1, 0, 1); PG8_STAGE(PG8_SB(0, 0), b2, voffB);
            PG8_BAR; PG8_WAIT_L(0); PG8_MMA(0, 1, At, B1); PG8_BAR;
            PG8_LDA(At, 0, 1); PG8_STAGE(PG8_SA(0, 0), a2, voffA);
            PG8_BAR; PG8_WAIT_L(0); PG8_MMA(1, 0, At, B0); PG8_BAR; PG8_SCHED;
            PG8_STAGE(PG8_SB(0, 1), b2 + hstepB, voffB);
            PG8_WAIT_V(6); PG8_BAR; PG8_MMA(1, 1, At, B1); PG8_BAR;
            PG8_LDB(B0, 1, 0); PG8_SCHED; PG8_LDA(At, 1, 0); PG8_STAGE(PG8_SA(0, 1), a2 + hstepA, voffA);
            PG8_WAIT_L(8); PG8_BAR; PG8_WAIT_L(0); PG8_MMA(0, 0, At, B0); PG8_BAR; PG8_SCHED;
            PG8_LDB(B1, 1, 1); PG8_STAGE(PG8_SB(1, 0), b3, voffB);
            PG8_BAR; PG8_WAIT_L(0); PG8_MMA(0, 1, At, B1); PG8_BAR;
            PG8_LDA(At, 1, 1); PG8_STAGE(PG8_SA(1, 0), a3, voffA);
            PG8_BAR; PG8_WAIT_L(0); PG8_MMA(1, 0, At, B0); PG8_BAR; PG8_SCHED;
            PG8_STAGE(PG8_SB(1, 1), b3 + hstepB, voffB);
            PG8_WAIT_V(6); PG8_BAR; PG8_MMA(1, 1, At, B1); PG8_BAR;
            }
        }
        if constexpr (ALIGN_EPI) { if (wr == 0) PG8_BAR; }
        if ((ui & 1) == 0) E.mid(acc, cur, wr, wc, fr, fq); else { E(acc, cur, wr, wc, fr, fq); S.done(cur); }
        if (!has_next) break;
        if (ui & 1)
#pragma unroll
        for (int a = 0; a < 2; ++a)
#pragma unroll
            for (int b = 0; b < 2; ++b)
#pragma unroll
                for (int m = 0; m < 4; ++m)
#pragma unroll
                    for (int n = 0; n < 2; ++n) acc[a][b][m][n] = (f32x4){0.f, 0.f, 0.f, 0.f};
        cur = nxt; cA = nA; cB = nB; ++ui;
        if constexpr (ALIGN_EPI) { if (wr == 1) PG8_BAR; }
    }
    PG8_WAIT_V(0);
    if constexpr (!ALIGN_EPI) { if (wr == 0) PG8_BAR; }
    PG8_BAR;
#undef PG8_SA
#undef PG8_SB
#undef PG8_STAGE
#undef PG8_LDA
#undef PG8_LDB
#undef PG8_MMA
#undef PG8_WAIT_V
#undef PG8_WAIT_L
#undef PG8_BAR
#undef PG8_SCHED
}
}

#ifndef PG8_SP2
#define PG8_SP2 true
#endif
#ifndef PG8_ALIGN
#define PG8_ALIGN true
#endif

using pg8::bf16_t; using pg8::f32x4; using pg8::u32x4; using pg8::u32x2; using pg8::cvtpk; using pg8::bf2f; using pg8::bflo; using pg8::bfhi;

constexpr size_t MiB = 1u << 20;
constexpr size_t WS_CTL = 0, CTL_ZERO_BYTES = 32 * 1024;
constexpr size_t WS_ROPE = 1 * MiB;
constexpr size_t WS_WUQ = 3 * MiB, WS_WUKV = 6 * MiB, WS_WOM = 8 * MiB, WS_WOD = 12 * MiB, WS_WOUT = 16 * MiB, WS_WQP = 24 * MiB;
constexpr size_t WS_SKB = 5 * MiB + 512 * 1024;
constexpr size_t WS_W1 = 32 * MiB;
constexpr size_t WS_W8 = 50 * MiB;
constexpr size_t WS_H8 = 396 * MiB;
constexpr size_t WS_H = 66 * MiB;
constexpr size_t WS_CQ = 130 * MiB, WS_CKV = 154 * MiB;
constexpr size_t WS_KR = 170 * MiB, WS_DQ = 172 * MiB, WS_DK = 204 * MiB, WS_DV = 236 * MiB;
constexpr size_t WS_G = 268 * MiB;
constexpr size_t WS_QN = 32 * MiB, WS_QR = 64 * MiB, WS_KN = 80 * MiB, WS_V = 396 * MiB;
constexpr size_t WS_OM = 112 * MiB, WS_OD = 428 * MiB;
constexpr size_t WS_TMP = 32 * MiB;
constexpr size_t WS_MG = 172 * MiB;
constexpr size_t WS_X2 = 268 * MiB;
constexpr size_t WS_X2B = 396 * MiB;
constexpr size_t WS_EU = 32 * MiB, WS_EV = 96 * MiB;
constexpr size_t WS_QP = 172 * MiB;
constexpr size_t WS_IDX = 236 * MiB, WS_GT = 244 * MiB;
constexpr size_t WS_PSQ_Q = 460 * MiB, WS_PSQ_KV = 461 * MiB, WS_PSQ2 = 462 * MiB;
constexpr size_t WS_END = 464 * MiB;
constexpr int CW_TMO = 0, CW_CODE = 1, CW_LAMBDA = 8, CW_TOKCTR = 64;
constexpr int CW_BAR = 4096;

constexpr int RING_OFF = 0, RING_BYTES = 131072;
constexpr int LDSCTL_OFF = RING_BYTES, MISC_OFF = LDSCTL_OFF + 320;
constexpr int LDS_BYTES = 147456;
constexpr int NWAVES = 8;

#define GAS __attribute__((address_space(1)))
#define LAS __attribute__((address_space(3)))
typedef unsigned short bf16;
typedef unsigned v4u __attribute__((ext_vector_type(4)));
typedef GAS unsigned gu32;
#define RLX_AGENT __ATOMIC_RELAXED, __HIP_MEMORY_SCOPE_AGENT
#define LDS_WAIT() asm volatile("s_waitcnt lgkmcnt(0)" ::: "memory")
#define VM_WAIT() asm volatile("s_waitcnt vmcnt(0)" ::: "memory")

#define XB_TMO      128
#define XB_XCNT(j)  (256  + 64 * (j))
#define XB_XSUB(j)  (1280 + 64 * (j))
#define XB_XGEN(j)  (2304 + 64 * (j))
#define XB_TOP      3328
#define XB_TOPGEN   3392
#define XCD_BAR_WORDS 3456
#define XB_SPIN_CAP (1u << 22)
__device__ __forceinline__ unsigned xb_ld(unsigned* p)              { return __hip_atomic_load(p, __ATOMIC_RELAXED, __HIP_MEMORY_SCOPE_AGENT); }
__device__ __forceinline__ unsigned xb_add(unsigned* p, unsigned v) { return __hip_atomic_fetch_add(p, v, __ATOMIC_RELAXED, __HIP_MEMORY_SCOPE_AGENT); }
__device__ __forceinline__ unsigned xb_xcc_id() { return (unsigned)__builtin_amdgcn_s_getreg((3 << 11) | 20) & 0xFu; }
#define XB_SPIN(cond, bar) do { unsigned _sp = 0; while (cond) { __builtin_amdgcn_s_sleep(1); \
    if ((++_sp & 255u) == 0u) { if (xb_ld(&(bar)[XB_TMO])) break; if (_sp > XB_SPIN_CAP) { atomicAdd(&(bar)[XB_TMO], 1u); break; } } } } while (0)
struct XcdBarrier { unsigned* bar; unsigned x; volatile LAS unsigned* st; };
__device__ __forceinline__ XcdBarrier xcd_barrier_post(unsigned* bar, volatile LAS unsigned* st) {
    XcdBarrier b; b.bar = bar; b.x = xb_xcc_id(); b.st = st;
    if (threadIdx.x == 0) (void)xb_add(&bar[XB_XCNT(b.x)], 1u);
    return b;
}
__device__ __forceinline__ void xcd_barrier_complete(unsigned* bar, unsigned x, unsigned& nloc, unsigned& nx) {
    const unsigned G = gridDim.x * gridDim.y * gridDim.z;
    unsigned sum, cnt, mine, sp = 0u;
    for (;;) {
        sum = 0u; cnt = 0u; mine = 0u;
#pragma unroll
        for (unsigned j = 0; j < 16; ++j) { const unsigned c = xb_ld(&bar[XB_XCNT(j)]); sum += c; cnt += (c > 0u) ? 1u : 0u; mine = (j == x) ? c : mine; }
        if (sum == G) break;
        __builtin_amdgcn_s_sleep(1);
        if ((++sp & 255u) == 0u) { if (xb_ld(&bar[XB_TMO])) break; if (sp > XB_SPIN_CAP) { atomicAdd(&bar[XB_TMO], 1u); break; } }
    }
    nloc = mine > 0u ? mine : 1u; nx = cnt > 0u ? cnt : 1u;
}
__device__ __forceinline__ void xcd_barrier(const XcdBarrier& b) {
    asm volatile("s_waitcnt vmcnt(0)" ::: "memory");
    __syncthreads();
    if (threadIdx.x == 0) {
        unsigned* bar = b.bar;
        __builtin_amdgcn_s_waitcnt(0);
        unsigned nloc = b.st[0], nx = b.st[1];
        if (nloc == 0u) { xcd_barrier_complete(bar, b.x, nloc, nx); b.st[0] = nloc; b.st[1] = nx; }
        const unsigned old = xb_add(&bar[XB_XSUB(b.x)], 1u);
        const unsigned gen = old / nloc;
        if (old + 1u == (gen + 1u) * nloc) {
            __builtin_amdgcn_fence(__ATOMIC_RELEASE, "agent");
            asm volatile("s_waitcnt vmcnt(0)" ::: "memory");
            const unsigned og = xb_add(&bar[XB_TOP], 1u);
            const unsigned tg = og / nx;
            if (og + 1u == (tg + 1u) * nx) xb_add(&bar[XB_TOPGEN], 1u);
            else XB_SPIN(xb_ld(&bar[XB_TOPGEN]) == tg, bar);
            __builtin_amdgcn_fence(__ATOMIC_ACQUIRE, "agent");
            xb_add(&bar[XB_XGEN(b.x)], 1u);
            asm volatile("s_waitcnt vmcnt(0)" ::: "memory");
        } else {
            XB_SPIN(xb_ld(&bar[XB_XGEN(b.x)]) == gen, bar);
            __builtin_amdgcn_fence(__ATOMIC_ACQUIRE, "agent");
            asm volatile("s_waitcnt vmcnt(0)" ::: "memory");
        }
    }
    __syncthreads();
}

struct Frame {
    LAS unsigned char* lds;
    volatile LAS unsigned* MISC;
    gu32* ctl;
    unsigned char* ws;
    int tid, lane, wave, vcu, G;
};

__device__ __forceinline__ float wave_sum(float v) {
#pragma unroll
    for (int o = 1; o < 64; o <<= 1) v += __shfl_xor(v, o);
    return v;
}
__device__ __forceinline__ float wave_max(float v) {
#pragma unroll
    for (int o = 1; o < 64; o <<= 1) v = fmaxf(v, __shfl_xor(v, o));
    return v;
}
__device__ __forceinline__ unsigned pk2(float lo, float hi) { return cvtpk(lo, hi); }

template <class Map>
__device__ __forceinline__ void tr_item(const float* W, int Nsrc, int K, const float* kscale, bf16* WT, LAS float* scr, int item, int nblk, int lane, Map map) {
    const int kb = item / nblk, nb = item % nblk, k0 = 64 * kb, n0 = 32 * nb;
    const int sc = map(n0 + (lane & 31));
    float tv[32];
    const int scc = sc >= 0 ? sc : 0;
#pragma unroll
    for (int i = 0; i < 32; ++i) { const int kk = 2 * i + (lane >> 5); tv[i] = W[(size_t)(k0 + kk) * Nsrc + scc]; }
#pragma unroll
    for (int i = 0; i < 32; ++i) { const int kk = 2 * i + (lane >> 5); float v = sc >= 0 ? tv[i] : 0.f; if (kscale) v *= kscale[k0 + kk]; scr[kk * 33 + (lane & 31)] = v; }
    LDS_WAIT(); asm volatile("" ::: "memory");
    const int c = lane & 7;
#pragma unroll
    for (int j = 0; j < 4; ++j) { const int n = (lane >> 3) + 8 * j; const LAS float* s = scr + (8 * c) * 33 + n;
        v4u o; o.x = pk2(s[0 * 33], s[1 * 33]); o.y = pk2(s[2 * 33], s[3 * 33]); o.z = pk2(s[4 * 33], s[5 * 33]); o.w = pk2(s[6 * 33], s[7 * 33]);
        *(GAS v4u*)(WT + (size_t)(n0 + n) * K + k0 + 8 * c) = o; }
    LDS_WAIT(); asm volatile("" ::: "memory");
}
template <class Map>
__device__ __forceinline__ void tr_item8(const float* W, int Nsrc, int K, float wscale, unsigned char* WT8, LAS float* scr, int item, int nblk, int lane, Map map) {
    const int kb = item / nblk, nb = item % nblk, k0 = 64 * kb, n0 = 32 * nb;
    const int sc = map(n0 + (lane & 31));
    float tv[32];
    const int scc = sc >= 0 ? sc : 0;
#pragma unroll
    for (int i = 0; i < 32; ++i) { const int kk = 2 * i + (lane >> 5); tv[i] = W[(size_t)(k0 + kk) * Nsrc + scc]; }
#pragma unroll
    for (int i = 0; i < 32; ++i) { const int kk = 2 * i + (lane >> 5); scr[kk * 33 + (lane & 31)] = sc >= 0 ? tv[i] * wscale : 0.f; }
    LDS_WAIT(); asm volatile("" ::: "memory");
    const int c = lane & 7;
#pragma unroll
    for (int j = 0; j < 4; ++j) { const int n = (lane >> 3) + 8 * j; const LAS float* s = scr + (8 * c) * 33 + n;
        u32x2 o; o.x = (unsigned)__builtin_amdgcn_cvt_pk_fp8_f32(s[2 * 33], s[3 * 33], __builtin_amdgcn_cvt_pk_fp8_f32(s[0 * 33], s[1 * 33], 0, false), true);
        o.y = (unsigned)__builtin_amdgcn_cvt_pk_fp8_f32(s[6 * 33], s[7 * 33], __builtin_amdgcn_cvt_pk_fp8_f32(s[4 * 33], s[5 * 33], 0, false), true);
        *(GAS u32x2*)(WT8 + (size_t)(n0 + n) * K + k0 + 8 * c) = o; }
    LDS_WAIT(); asm volatile("" ::: "memory");
}
__device__ __forceinline__ int rope_src(int jj) { return (jj & 1) * 32 + (jj >> 1); }
struct MapW1 { __device__ int operator()(int n) const {
    if (n < 1280) return n;
    if (n < 2304) { const int j = n - 1280; return OFF_DQ + (j & ~63) + rope_src(j & 63); }
    if (n < 3328) { const int j = n - 2304; return OFF_DK + (j & ~63) + rope_src(j & 63); }
    if (n < 4352) return OFF_DV + (n - 3328);
    if (n < 4416) return OFF_KR + rope_src(n - 4352);
    return -1; } };
struct MapGate { __device__ int operator()(int n) const { return OFF_GATE + n; } };
struct MapUQ { __device__ int operator()(int n) const {
    if (n < 1024) return (n >> 7) * 192 + (n & 127);
    const int j = n - 1024; return (j >> 6) * 192 + 128 + rope_src(j & 63); } };
struct MapUKV { __device__ int operator()(int n) const {
    if (n < 1024) return (n >> 7) * 256 + (n & 127);
    const int j = n - 1024; return (j >> 7) * 256 + 128 + (j & 127); } };
struct MapId { __device__ int operator()(int n) const { return n; } };

struct Ins { const float *x, *w_in, *b_gate, *g_norm1, *g_cq, *w_uq, *g_ckv, *w_ukv, *w_o_mla, *lambda_qk, *g_subln, *w_o_diff, *w_out, *g_norm2, *w_q_peer, *sub_keys, *expert_u, *expert_v, *g_final; };

__device__ __forceinline__ void p0_prologue(Frame& F, const Ins& I, const double* inv_freq) {
    LAS float* scr = (LAS float*)(F.lds + RING_OFF + F.wave * 16384);
    const int gw = F.vcu * NWAVES + F.wave, NGW = F.G * NWAVES;
    unsigned char* ws = F.ws;
    constexpr int I_W1 = (2048 / 64) * (N1 / 32), I_W8 = (2048 / 64) * (NG / 32), I_UQ = (768 / 64) * (1536 / 32), I_UKV = (512 / 64) * (2048 / 32), I_OM = (1024 / 64) * (2048 / 32), I_OD = I_OM, I_OUT = (2048 / 64) * (2048 / 32), I_QP = I_OUT;
    constexpr int NITEMS = I_W1 + I_W8 + I_UQ + I_UKV + I_OM + I_OD + I_OUT + I_QP;
    for (int it = gw; it < NITEMS; it += NGW) {
        int r = it;
        if (r < I_W1) { tr_item(I.w_in, IN_COLS, 2048, nullptr, (bf16*)(ws + WS_W1), scr, r, N1 / 32, F.lane, MapW1()); continue; } r -= I_W1;
        if (r < I_W8) { tr_item8(I.w_in, IN_COLS, 2048, W1_SCALE, ws + WS_W8, scr, r, NG / 32, F.lane, MapGate()); continue; } r -= I_W8;
        if (r < I_UQ) { tr_item(I.w_uq, 1536, 768, I.g_cq, (bf16*)(ws + WS_WUQ), scr, r, 1536 / 32, F.lane, MapUQ()); continue; } r -= I_UQ;
        if (r < I_UKV) { tr_item(I.w_ukv, 2048, 512, I.g_ckv, (bf16*)(ws + WS_WUKV), scr, r, 2048 / 32, F.lane, MapUKV()); continue; } r -= I_UKV;
        if (r < I_OM) { tr_item(I.w_o_mla, 2048, 1024, nullptr, (bf16*)(ws + WS_WOM), scr, r, 2048 / 32, F.lane, MapId()); continue; } r -= I_OM;
        if (r < I_OD) { tr_item(I.w_o_diff, 2048, 1024, nullptr, (bf16*)(ws + WS_WOD), scr, r, 2048 / 32, F.lane, MapId()); continue; } r -= I_OD;
        if (r < I_OUT) { tr_item(I.w_out, 2048, 2048, nullptr, (bf16*)(ws + WS_WOUT), scr, r, 2048 / 32, F.lane, MapId()); continue; } r -= I_OUT;
        tr_item(I.w_q_peer, 2048, 2048, I.g_norm2, (bf16*)(ws + WS_WQP), scr, r, 2048 / 32, F.lane, MapId());
    }
    {
        bf16* skb = (bf16*)(ws + WS_SKB);
        for (int e = gw * 64 + F.lane; e < 256 * 256; e += NGW * 64) {
            const int n = e >> 8, k = e & 255; float v = 0.f;
            if (n < 128 && k < 128) v = I.sub_keys[n * 128 + k];
            else if (n >= 128 && k >= 128) v = I.sub_keys[128 * 128 + (n - 128) * 128 + (k - 128)];
            skb[e] = (bf16)(pk2(v, 0.f) & 0xffffu);
        }
    }
    {
        float* rope = (float*)(ws + WS_ROPE);
        for (int e = gw * 64 + F.lane; e < SEQ * 32; e += NGW * 64) {
            const int pos = e >> 5, i = e & 31;
            const double rev = (double)pos * inv_freq[i] * 0.15915494309189535;
            const float fr = (float)(rev - floor(rev));
            rope[2 * e] = __builtin_amdgcn_cosf(fr); rope[2 * e + 1] = __builtin_amdgcn_sinf(fr);
        }
    }
    if (blockIdx.x == 0 && F.tid == 0) {
        float a = 0.f, b = 0.f;
        for (int d = 0; d < 64; ++d) { a += I.lambda_qk[d] * I.lambda_qk[64 + d]; b += I.lambda_qk[128 + d] * I.lambda_qk[192 + d]; }
        const float lam = __expf(a) - __expf(b) + LAMBDA_INIT;
        ((float*)F.ctl)[CW_LAMBDA] = lam;
    }
    {
        bf16* H = (bf16*)(ws + WS_H);
        f32x4 g[8];
#pragma unroll
        for (int j = 0; j < 8; ++j) g[j] = *((const f32x4*)I.g_norm1 + F.lane + 64 * j);
        for (int m = gw; m < T; m += NGW) {
            const GAS f32x4* xr = (const GAS f32x4*)(I.x + (size_t)m * D_MODEL) + F.lane;
            f32x4 v[8]; float s = 0.f;
#pragma unroll
            for (int j = 0; j < 8; ++j) { v[j] = xr[64 * j]; s += (v[j].x * v[j].x + v[j].y * v[j].y) + (v[j].z * v[j].z + v[j].w * v[j].w); }
            const float rstd = 1.0f / sqrtf(wave_sum(s) * (1.f / D_MODEL) + EPS);
            GAS u32x2* o8 = (GAS u32x2*)(H + (size_t)m * D_MODEL) + F.lane;
#pragma unroll
            for (int j = 0; j < 8; ++j) { u32x2 w; w.x = pk2(v[j].x * rstd * g[j].x, v[j].y * rstd * g[j].y); w.y = pk2(v[j].z * rstd * g[j].z, v[j].w * rstd * g[j].w); o8[64 * j] = w; }
            { GAS unsigned* h8 = (GAS unsigned*)(ws + WS_H8 + (size_t)m * D_MODEL) + F.lane;
#pragma unroll
              for (int j = 0; j < 8; ++j) h8[64 * j] = (unsigned)__builtin_amdgcn_cvt_pk_fp8_f32(v[j].z * rstd * g[j].z, v[j].w * rstd * g[j].w, __builtin_amdgcn_cvt_pk_fp8_f32(v[j].x * rstd * g[j].x, v[j].y * rstd * g[j].y, 0, false), true); }
        }
    }
}

__device__ __forceinline__ void convert_experts(Frame& F, const Ins& I) {
    const size_t gt = (size_t)(F.vcu * NWAVES * 64) + F.tid, NT = (size_t)F.G * NWAVES * 64;
    const size_t nchunk = (size_t)NEXP * D_MODEL / 8;
    bf16* EU = (bf16*)(F.ws + WS_EU); bf16* EV = (bf16*)(F.ws + WS_EV);
    for (size_t c = gt; c < nchunk; c += NT) {
        const int d = (int)((c * 8) & (D_MODEL - 1));
        const f32x4 a0 = *(const GAS f32x4*)(I.expert_u + c * 8), a1 = *(const GAS f32x4*)(I.expert_u + c * 8 + 4);
        const f32x4 g0 = *(const f32x4*)(I.g_norm2 + d), g1 = *(const f32x4*)(I.g_norm2 + d + 4);
        v4u o; o.x = pk2(a0.x * g0.x, a0.y * g0.y); o.y = pk2(a0.z * g0.z, a0.w * g0.w); o.z = pk2(a1.x * g1.x, a1.y * g1.y); o.w = pk2(a1.z * g1.z, a1.w * g1.w);
        *(GAS v4u*)(EU + c * 8) = o;
        const f32x4 b0 = *(const GAS f32x4*)(I.expert_v + c * 8), b1 = *(const GAS f32x4*)(I.expert_v + c * 8 + 4);
        v4u p; p.x = pk2(b0.x, b0.y); p.y = pk2(b0.z, b0.w); p.z = pk2(b1.x, b1.y); p.w = pk2(b1.z, b1.w);
        *(GAS v4u*)(EV + c * 8) = p;
    }
}

__device__ __forceinline__ float sigmoidf_fast(float x) { return __builtin_amdgcn_rcpf(1.0f + __builtin_amdgcn_exp2f(-x * LOG2E)); }
__device__ __forceinline__ void rope8(f32x4& v0, f32x4& v1, const f32x4 cs0, const f32x4 cs1, float sc) {
    const float a0 = v0[0] * cs0[0] - v0[1] * cs0[1], b0 = v0[1] * cs0[0] + v0[0] * cs0[1];
    const float a1 = v0[2] * cs0[2] - v0[3] * cs0[3], b1 = v0[3] * cs0[2] + v0[2] * cs0[3];
    const float a2 = v1[0] * cs1[0] - v1[1] * cs1[1], b2 = v1[1] * cs1[0] + v1[0] * cs1[1];
    const float a3 = v1[2] * cs1[2] - v1[3] * cs1[3], b3 = v1[3] * cs1[2] + v1[2] * cs1[3];
    v0 = (f32x4){a0 * sc, b0 * sc, a1 * sc, b1 * sc}; v1 = (f32x4){a2 * sc, b2 * sc, a3 * sc, b3 * sc};
}
__device__ __forceinline__ u32x4 pack8(const f32x4 v0, const f32x4 v1) { u32x4 w; w.x = cvtpk(v0[0], v0[1]); w.y = cvtpk(v0[2], v0[3]); w.z = cvtpk(v1[0], v1[1]); w.w = cvtpk(v1[2], v1[3]); return w; }

__device__ __forceinline__ size_t kt_off(size_t row, int col) { const size_t b = row >> 13; const int pos = (int)(row & 8191), tile = pos >> 6, key = pos & 63, h = col >> 7, piece = (col & 127) >> 3;
    return (((b * 8 + h) * 128 + tile) * 16 + piece) * 512 + key * 8 + (col & 7); }
__device__ __forceinline__ size_t vt_off(size_t row, int col) { const size_t b = row >> 13; const int pos = (int)(row & 8191), tile = pos >> 6, key = pos & 63, h = col >> 7, d = col & 127;
    return (((b * 8 + h) * 128 + tile) * 16 + (d >> 5) * 4 + (key >> 4)) * 512 + (key & 15) * 32 + (d & 31); }
__device__ __forceinline__ size_t krt_off(size_t row, int col) { const size_t b = row >> 13; const int pos = (int)(row & 8191), tile = pos >> 6, key = pos & 63;
    return ((b * 128 + tile) * 8 + (col >> 3)) * 512 + key * 8 + (col & 7); }
struct EpiProj {
    static constexpr bool PERM = true;
    bf16_t *CQ, *CKV, *DQ, *DK, *DV, *G, *KR; float *ssq_q, *ssq_kv; const float* bgate; const float* rope; int pn_off;
    __device__ __forceinline__ void operator()(const f32x4 (&acc)[2][2][4][2], const pg8::Unit& u, int wr, int wc, int fr, int fq) const {
        const int row0 = u.pm * 256 + wr * 64 + fr, pn = u.pn + pn_off, colw = wc * 32 + 8 * fq;
        if (pn < 5) {
            bf16_t* O; int ldc, ct, nsl, sl; float* ssq;
            if (pn < 3) { O = CQ; ldc = 768; ct = pn * 256; ssq = ssq_q; nsl = 12; sl = pn * 4 + wc; } else { O = CKV; ldc = 512; ct = (pn - 3) * 256; ssq = ssq_kv; nsl = 8; sl = (pn - 3) * 4 + wc; }
#pragma unroll
            for (int ai = 0; ai < 2; ++ai)
#pragma unroll
                for (int m = 0; m < 4; ++m) { const int row = row0 + ai * 128 + m * 16; float s = 0.f;
#pragma unroll
                    for (int bj = 0; bj < 2; ++bj) { const f32x4 v0 = acc[ai][bj][m][0], v1 = acc[ai][bj][m][1];
                        s += (v0[0] * v0[0] + v0[1] * v0[1]) + (v0[2] * v0[2] + v0[3] * v0[3]) + (v1[0] * v1[0] + v1[1] * v1[1]) + (v1[2] * v1[2] + v1[3] * v1[3]);
                        *(u32x4*)(O + (size_t)row * ldc + ct + bj * 128 + colw) = pack8(v0, v1); }
                    s += __shfl_xor(s, 16); s += __shfl_xor(s, 32);
                    if (fq == 0) ssq[(size_t)row * nsl + sl] = s; }
        } else if (pn < 13) {
            const bool isq = pn < 9; bf16_t* O = isq ? DQ : DK; const int ct = (pn - (isq ? 5 : 9)) * 256; const float sc = isq ? C2_DIFF : 1.0f;
            const int i0 = ((wc & 1) * 32 + 8 * fq) >> 1;
#pragma unroll
            for (int ai = 0; ai < 2; ++ai)
#pragma unroll
                for (int m = 0; m < 4; ++m) { const int row = row0 + ai * 128 + m * 16; const int pos = row & (SEQ - 1);
                    const f32x4 cs0 = *(const f32x4*)(rope + (size_t)(pos * 32 + i0) * 2), cs1 = *(const f32x4*)(rope + (size_t)(pos * 32 + i0 + 2) * 2);
#pragma unroll
                    for (int bj = 0; bj < 2; ++bj) { f32x4 v0 = acc[ai][bj][m][0], v1 = acc[ai][bj][m][1]; rope8(v0, v1, cs0, cs1, sc);
                        const int col = ct + bj * 128 + colw;
                        *(u32x4*)(O + (isq ? (size_t)row * 1024 + col : kt_off(row, col))) = pack8(v0, v1); } }
        } else if (pn < 17) {
            const int ct = (pn - 13) * 256;
#pragma unroll
            for (int ai = 0; ai < 2; ++ai)
#pragma unroll
                for (int m = 0; m < 4; ++m) { const int row = row0 + ai * 128 + m * 16;
#pragma unroll
                    for (int bj = 0; bj < 2; ++bj) *(u32x4*)(DV + vt_off(row, ct + bj * 128 + colw)) = pack8(acc[ai][bj][m][0], acc[ai][bj][m][1]); }
        } else if (pn >= 18) {
            const int ct = (pn - 18) * 256;
            f32x4 bv[2][2];
#pragma unroll
            for (int bj = 0; bj < 2; ++bj) { bv[bj][0] = *(const f32x4*)(bgate + ct + bj * 128 + colw); bv[bj][1] = *(const f32x4*)(bgate + ct + bj * 128 + colw + 4); }
#pragma unroll
            for (int ai = 0; ai < 2; ++ai)
#pragma unroll
                for (int m = 0; m < 4; ++m) { const int row = row0 + ai * 128 + m * 16;
#pragma unroll
                    for (int bj = 0; bj < 2; ++bj) { f32x4 v0 = acc[ai][bj][m][0] + bv[bj][0], v1 = acc[ai][bj][m][1] + bv[bj][1];
#pragma unroll
                        for (int e = 0; e < 4; ++e) { v0[e] = sigmoidf_fast(v0[e]); v1[e] = sigmoidf_fast(v1[e]); }
                        *(u32x4*)(G + (size_t)row * 4096 + ct + bj * 128 + colw) = pack8(v0, v1); } }
        } else {
            if (wc < 2) {
                const int i0 = colw >> 1;
#pragma unroll
                for (int ai = 0; ai < 2; ++ai)
#pragma unroll
                    for (int m = 0; m < 4; ++m) { const int row = row0 + ai * 128 + m * 16; const int pos = row & (SEQ - 1);
                        const f32x4 cs0 = *(const f32x4*)(rope + (size_t)(pos * 32 + i0) * 2), cs1 = *(const f32x4*)(rope + (size_t)(pos * 32 + i0 + 2) * 2);
                        f32x4 v0 = acc[ai][0][m][0], v1 = acc[ai][0][m][1]; rope8(v0, v1, cs0, cs1, 1.0f);
                        *(u32x4*)(KR + krt_off(row, colw)) = pack8(v0, v1); }
            }
        }
    }
};

struct EpiQup {
    static constexpr bool PERM = true;
    bf16_t *QN, *QR; const float* ssq; const float* rope;
    __device__ __forceinline__ void operator()(const f32x4 (&acc)[2][2][4][2], const pg8::Unit& u, int wr, int wc, int fr, int fq) const {
        const int row0 = u.pm * 256 + wr * 64 + fr, pn = u.pn, colw = wc * 32 + 8 * fq;
        const int i0 = ((wc & 1) * 32 + 8 * fq) >> 1;
#pragma unroll
        for (int ai = 0; ai < 2; ++ai)
#pragma unroll
            for (int m = 0; m < 4; ++m) { const int row = row0 + ai * 128 + m * 16; const int pos = row & (SEQ - 1);
                const f32x4 q0 = *(const f32x4*)(ssq + (size_t)row * 12), q1 = *(const f32x4*)(ssq + (size_t)row * 12 + 4), q2 = *(const f32x4*)(ssq + (size_t)row * 12 + 8);
                const float sq = (((q0[0] + q0[1]) + (q0[2] + q0[3])) + ((q1[0] + q1[1]) + (q1[2] + q1[3]))) + ((q2[0] + q2[1]) + (q2[2] + q2[3]));
                const float sc = C2_MLA / sqrtf(sq * (1.0f / 768.0f) + EPS);
                if (pn < 4) {
#pragma unroll
                    for (int bj = 0; bj < 2; ++bj) *(u32x4*)(QN + (size_t)row * 1024 + pn * 256 + bj * 128 + colw) = pack8(acc[ai][bj][m][0] * sc, acc[ai][bj][m][1] * sc);
                } else {
                    const f32x4 cs0 = *(const f32x4*)(rope + (size_t)(pos * 32 + i0) * 2), cs1 = *(const f32x4*)(rope + (size_t)(pos * 32 + i0 + 2) * 2);
#pragma unroll
                    for (int bj = 0; bj < 2; ++bj) { f32x4 v0 = acc[ai][bj][m][0], v1 = acc[ai][bj][m][1]; rope8(v0, v1, cs0, cs1, sc);
                        *(u32x4*)(QR + (size_t)row * 512 + (pn - 4) * 256 + bj * 128 + colw) = pack8(v0, v1); }
                } }
    }
};
struct EpiKVup {
    static constexpr bool PERM = true;
    bf16_t *KN, *V; const float* ssq;
    __device__ __forceinline__ void operator()(const f32x4 (&acc)[2][2][4][2], const pg8::Unit& u, int wr, int wc, int fr, int fq) const {
        const int row0 = u.pm * 256 + wr * 64 + fr, pn = u.pn, colw = wc * 32 + 8 * fq;
        bf16_t* O = pn < 4 ? KN : V; const int ct = (pn & 3) * 256;
#pragma unroll
        for (int ai = 0; ai < 2; ++ai)
#pragma unroll
            for (int m = 0; m < 4; ++m) { const int row = row0 + ai * 128 + m * 16;
                const f32x4 q0 = *(const f32x4*)(ssq + (size_t)row * 8), q1 = *(const f32x4*)(ssq + (size_t)row * 8 + 4);
                const float sq = ((q0[0] + q0[1]) + (q0[2] + q0[3])) + ((q1[0] + q1[1]) + (q1[2] + q1[3]));
                const float sc = 1.0f / sqrtf(sq * (1.0f / 512.0f) + EPS);
#pragma unroll
                for (int bj = 0; bj < 2; ++bj) { const int col = ct + bj * 128 + colw; *(u32x4*)(O + (pn < 4 ? kt_off(row, col) : vt_off(row, col))) = pack8(acc[ai][bj][m][0] * sc, acc[ai][bj][m][1] * sc); } }
    }
};
struct EpiGate {
    static constexpr bool PERM = true;
    const bf16_t* G; bf16_t* TMP; bf16_t* MG; int second;
    __device__ __forceinline__ void operator()(const f32x4 (&acc)[2][2][4][2], const pg8::Unit& u, int wr, int wc, int fr, int fq) const {
        const int row0 = u.pm * 256 + wr * 64 + fr, colw = u.pn * 256 + wc * 32 + 8 * fq;
#pragma unroll
        for (int ai = 0; ai < 2; ++ai)
#pragma unroll
            for (int m = 0; m < 4; ++m) { const int row = row0 + ai * 128 + m * 16;
#pragma unroll
                for (int bj = 0; bj < 2; ++bj) { const int col = colw + bj * 128;
                    const u32x4 gw = *(const u32x4*)(G + (size_t)row * 4096 + (second ? 2048 : 0) + col);
                    f32x4 v0 = acc[ai][bj][m][0], v1 = acc[ai][bj][m][1];
                    v0 = (f32x4){v0[0] * bflo(gw.x), v0[1] * bfhi(gw.x), v0[2] * bflo(gw.y), v0[3] * bfhi(gw.y)};
                    v1 = (f32x4){v1[0] * bflo(gw.z), v1[1] * bfhi(gw.z), v1[2] * bflo(gw.w), v1[3] * bfhi(gw.w)};
                    if (second) { const u32x4 tw = *(const u32x4*)(TMP + (size_t)row * 2048 + col);
                        v0 += (f32x4){bflo(tw.x), bfhi(tw.x), bflo(tw.y), bfhi(tw.y)}; v1 += (f32x4){bflo(tw.z), bfhi(tw.z), bflo(tw.w), bfhi(tw.w)};
                        *(u32x4*)(MG + (size_t)row * 2048 + col) = pack8(v0, v1);
                    } else *(u32x4*)(TMP + (size_t)row * 2048 + col) = pack8(v0, v1); } }
    }
};
struct EpiGate2 {
    static constexpr bool PERM = true;
    const bf16_t* G; bf16_t* MG;
    __device__ __forceinline__ void mid(f32x4 (&acc)[2][2][4][2], const pg8::Unit& u, int wr, int wc, int fr, int fq) const {
        const int row0 = u.pm * 256 + wr * 64 + fr, colw = u.pn * 256 + wc * 32 + 8 * fq;
#pragma unroll
        for (int ai = 0; ai < 2; ++ai)
#pragma unroll
            for (int m = 0; m < 4; ++m) { const int row = row0 + ai * 128 + m * 16;
#pragma unroll
                for (int bj = 0; bj < 2; ++bj) { const int col = colw + bj * 128;
                    const u32x4 ga = *(const u32x4*)(G + (size_t)row * 4096 + col), gb = *(const u32x4*)(G + (size_t)row * 4096 + 2048 + col);
                    f32x4 r0, r1;
                    r0[0] = bflo(ga.x) * __builtin_amdgcn_rcpf(bflo(gb.x)); r0[1] = bfhi(ga.x) * __builtin_amdgcn_rcpf(bfhi(gb.x)); r0[2] = bflo(ga.y) * __builtin_amdgcn_rcpf(bflo(gb.y)); r0[3] = bfhi(ga.y) * __builtin_amdgcn_rcpf(bfhi(gb.y));
                    r1[0] = bflo(ga.z) * __builtin_amdgcn_rcpf(bflo(gb.z)); r1[1] = bfhi(ga.z) * __builtin_amdgcn_rcpf(bfhi(gb.z)); r1[2] = bflo(ga.w) * __builtin_amdgcn_rcpf(bflo(gb.w)); r1[3] = bfhi(ga.w) * __builtin_amdgcn_rcpf(bfhi(gb.w));
                    acc[ai][bj][m][0] *= r0; acc[ai][bj][m][1] *= r1; }
                asm volatile("" ::: "memory"); }
    }
    __device__ __forceinline__ void operator()(const f32x4 (&acc)[2][2][4][2], const pg8::Unit& u, int wr, int wc, int fr, int fq) const {
        const int row0 = u.pm * 256 + wr * 64 + fr, colw = u.pn * 256 + wc * 32 + 8 * fq;
#pragma unroll
        for (int ai = 0; ai < 2; ++ai)
#pragma unroll
            for (int m = 0; m < 4; ++m) { const int row = row0 + ai * 128 + m * 16;
#pragma unroll
                for (int bj = 0; bj < 2; ++bj) { const int col = colw + bj * 128;
                    const u32x4 gb = *(const u32x4*)(G + (size_t)row * 4096 + 2048 + col);
                    f32x4 v0 = acc[ai][bj][m][0], v1 = acc[ai][bj][m][1];
                    v0 = (f32x4){v0[0] * bflo(gb.x), v0[1] * bfhi(gb.x), v0[2] * bflo(gb.y), v0[3] * bfhi(gb.y)};
                    v1 = (f32x4){v1[0] * bflo(gb.z), v1[1] * bfhi(gb.z), v1[2] * bflo(gb.w), v1[3] * bfhi(gb.w)};
                    *(u32x4*)(MG + (size_t)row * 2048 + col) = pack8(v0, v1); } }
    }
};
struct EpiRes {
    static constexpr bool PERM = false;
    const float* x; float* X2; bf16_t* X2B; float* ssq;
    __device__ __forceinline__ void operator()(const f32x4 (&acc)[2][2][4][2], const pg8::Unit& u, int wr, int wc, int fr, int fq) const {
        const int row0 = u.pm * 256 + wr * 64 + fr, col0 = u.pn * 256 + wc * 32 + 4 * fq;
#pragma unroll
        for (int ai = 0; ai < 2; ++ai)
#pragma unroll
            for (int m = 0; m < 4; ++m) { const int row = row0 + ai * 128 + m * 16; float s = 0.f;
#pragma unroll
                for (int bj = 0; bj < 2; ++bj)
#pragma unroll
                    for (int n = 0; n < 2; ++n) { const size_t off = (size_t)row * 2048 + col0 + bj * 128 + n * 16;
                        const f32x4 v = acc[ai][bj][m][n] + *(const f32x4*)(x + off);
                        s += (v[0] * v[0] + v[1] * v[1]) + (v[2] * v[2] + v[3] * v[3]);
#ifdef PEER_BF16
                        *(f32x4*)(X2 + off) = v;
#endif
                        u32x2 w; w.x = cvtpk(v[0], v[1]); w.y = cvtpk(v[2], v[3]); *(u32x2*)(X2B + off) = w; }
                s += __shfl_xor(s, 16); s += __shfl_xor(s, 32);
                if (fq == 0) ssq[(size_t)row * 32 + u.pn * 4 + wc] = s; }
    }
};
__device__ __forceinline__ float sum32(const float* p) { float t = 0.f;
#pragma unroll
    for (int i = 0; i < 8; ++i) { const f32x4 q = *(const f32x4*)(p + 4 * i); t += (q[0] + q[1]) + (q[2] + q[3]); } return t; }
constexpr int RTAB_OFF = 132096, RTAB_SLOTS = 4;
struct EpiQP {
    static constexpr bool PERM = true;
    bf16_t* QP; const float* ssq; const LAS float* tab; int pms[RTAB_SLOTS];
    __device__ __forceinline__ void operator()(const f32x4 (&acc)[2][2][4][2], const pg8::Unit& u, int wr, int wc, int fr, int fq) const {
        const int row0 = u.pm * 256 + wr * 64 + fr, colw = u.pn * 256 + wc * 32 + 8 * fq;
        int slot = -1;
#pragma unroll
        for (int i = RTAB_SLOTS - 1; i >= 0; --i) if (pms[i] == u.pm) slot = i;
#pragma unroll
        for (int ai = 0; ai < 2; ++ai)
#pragma unroll
            for (int m = 0; m < 4; ++m) { const int row = row0 + ai * 128 + m * 16;
                const float sc = slot >= 0 ? tab[slot * 256 + wr * 64 + fr + ai * 128 + m * 16] : 1.0f / sqrtf(sum32(ssq + (size_t)row * 32) * (1.0f / 2048.0f) + EPS);
#pragma unroll
                for (int bj = 0; bj < 2; ++bj) *(u32x4*)(QP + (size_t)row * 2048 + colw + bj * 128) = pack8(acc[ai][bj][m][0] * sc, acc[ai][bj][m][1] * sc); }
    }
};

template <class KaF, class KbF, class VF>
__device__ __forceinline__ void naive_attn(LAS float* qs, const bf16* qa, int ldqa, int da, const bf16* qb, int ldqb, int db,
                                           KaF ka_f, KbF kb_f, VF v_f,
                                           size_t rowbase, int p0, int lane, float (&o)[4][2], float (&linv)[4]) {
    const int dt = da + db;
    for (int idx = lane; idx < 4 * dt; idx += 64) { const int r = idx / dt, d = idx - r * dt;
        const bf16 h = d < da ? qa[(rowbase + p0 + r) * ldqa + d] : qb[(rowbase + p0 + r) * ldqb + (d - da)];
        qs[r * 192 + d] = bf2f(h); }
    LDS_WAIT(); asm volatile("" ::: "memory");
    float m[4], l[4];
#pragma unroll
    for (int r = 0; r < 4; ++r) { m[r] = -INFINITY; l[r] = 0.f; o[r][0] = 0.f; o[r][1] = 0.f; }
    const int pmax = p0 + 3, ntile = pmax / 64 + 1;
#pragma unroll 1
    for (int kt = 0; kt < ntile; ++kt) {
        const int key = kt * 64 + lane, kc = key < pmax ? key : pmax;
        float s[4] = {0.f, 0.f, 0.f, 0.f};
#pragma unroll 2
        for (int d = 0; d < da; d += 8) { const u32x4 kw = *(const u32x4*)ka_f(rowbase + kc, d);
            const float k0 = bflo(kw.x), k1 = bfhi(kw.x), k2 = bflo(kw.y), k3 = bfhi(kw.y), k4 = bflo(kw.z), k5 = bfhi(kw.z), k6 = bflo(kw.w), k7 = bfhi(kw.w);
#pragma unroll
            for (int r = 0; r < 4; ++r) { const f32x4 qa4 = *(const LAS f32x4*)(qs + r * 192 + d), qb4 = *(const LAS f32x4*)(qs + r * 192 + d + 4);
                s[r] += (qa4[0] * k0 + qa4[1] * k1) + (qa4[2] * k2 + qa4[3] * k3) + (qb4[0] * k4 + qb4[1] * k5) + (qb4[2] * k6 + qb4[3] * k7); } }
        if (db > 0) {
#pragma unroll 2
            for (int d = 0; d < db; d += 8) { const u32x4 kw = *(const u32x4*)kb_f(rowbase + kc, d);
                const float k0 = bflo(kw.x), k1 = bfhi(kw.x), k2 = bflo(kw.y), k3 = bfhi(kw.y), k4 = bflo(kw.z), k5 = bfhi(kw.z), k6 = bflo(kw.w), k7 = bfhi(kw.w);
#pragma unroll
                for (int r = 0; r < 4; ++r) { const f32x4 qa4 = *(const LAS f32x4*)(qs + r * 192 + da + d), qb4 = *(const LAS f32x4*)(qs + r * 192 + da + d + 4);
                    s[r] += (qa4[0] * k0 + qa4[1] * k1) + (qa4[2] * k2 + qa4[3] * k3) + (qb4[0] * k4 + qb4[1] * k5) + (qb4[2] * k6 + qb4[3] * k7); } } }
        float p[4];
#pragma unroll
        for (int r = 0; r < 4; ++r) {
            const float sv = key > p0 + r ? -INFINITY : s[r];
            const float mn = fmaxf(m[r], wave_max(sv));
            const float al = __builtin_amdgcn_exp2f(m[r] - mn);
            p[r] = __builtin_amdgcn_exp2f(sv - mn);
            l[r] = l[r] * al + wave_sum(p[r]); o[r][0] *= al; o[r][1] *= al; m[r] = mn;
        }
        const int jn = (pmax - kt * 64) < 63 ? (pmax - kt * 64) : 63;
#pragma unroll 4
        for (int j = 0; j <= jn; ++j) {
            const float v0 = bf2f(v_f(rowbase + kt * 64 + j, lane)), v1 = bf2f(v_f(rowbase + kt * 64 + j, 64 + lane));
#pragma unroll
            for (int r = 0; r < 4; ++r) { const float pj = __builtin_bit_cast(float, __builtin_amdgcn_readlane(__builtin_bit_cast(int, p[r]), j)); o[r][0] += pj * v0; o[r][1] += pj * v1; }
        }
    }
#pragma unroll
    for (int r = 0; r < 4; ++r) linv[r] = 1.0f / l[r];
    LDS_WAIT(); asm volatile("" ::: "memory");
}
__device__ __forceinline__ void p3_attention_ref(Frame& F, const Ins& I) {
    unsigned char* ws = F.ws;
    const bf16 *QN = (const bf16*)(ws + WS_QN), *QR = (const bf16*)(ws + WS_QR), *KN = (const bf16*)(ws + WS_KN), *KR = (const bf16*)(ws + WS_KR), *V = (const bf16*)(ws + WS_V);
    const bf16 *DQ = (const bf16*)(ws + WS_DQ), *DK = (const bf16*)(ws + WS_DK), *DV = (const bf16*)(ws + WS_DV);
    bf16 *OM = (bf16*)(ws + WS_OM), *OD = (bf16*)(ws + WS_OD);
    LAS float* qs = (LAS float*)(F.lds + RING_OFF + F.wave * 4096);
    const int gw = F.vcu * NWAVES + F.wave, NGW = F.G * NWAVES, lane = F.lane;
    const float lam = ((const float*)F.ctl)[CW_LAMBDA];
    const float gs0 = I.g_subln[lane] * (1.0f - LAMBDA_INIT), gs1 = I.g_subln[64 + lane] * (1.0f - LAMBDA_INIT);
    for (int it = gw; it < 2 * 16 * (SEQ / 4); it += NGW) {
        const int type = it & 1, rest = it >> 1, bh = rest & 15, g = rest >> 4, b = bh >> 3, h = bh & 7, p0 = 4 * g;
        const size_t rowbase = (size_t)b * SEQ;
        float o[4][2], li[4];
        if (type == 0) {
            naive_attn(qs, QN + h * 128, 1024, 128, QR + h * 64, 512, 64, [=](size_t row, int d) { return KN + kt_off(row, h * 128 + d); }, [=](size_t row, int d) { return KR + krt_off(row, d); },
                       [=](size_t row, int c) { return V[vt_off(row, h * 128 + c)]; }, rowbase, p0, lane, o, li);
#pragma unroll
            for (int r = 0; r < 4; ++r) { bf16* orow = OM + (rowbase + p0 + r) * 1024 + h * 128;
#ifdef ATT_CHECK
                { const float a0 = bf2f(orow[lane]), a1 = bf2f(orow[64 + lane]), b0 = o[r][0] * li[r], b1 = o[r][1] * li[r];
                  if (fabsf(a0 - b0) > ATT_TOL_A + ATT_TOL_R * fabsf(b0) || fabsf(a1 - b1) > ATT_TOL_A + ATT_TOL_R * fabsf(b1) || !(a0 == a0) || !(a1 == a1)) atomicAdd((unsigned*)F.ctl + 16, 1u); }
#else
                orow[lane] = (bf16)(pk2(o[r][0] * li[r], 0.f) & 0xffffu); orow[64 + lane] = (bf16)(pk2(o[r][1] * li[r], 0.f) & 0xffffu);
#endif
            }
        } else {
            float o2[4][2], li2[4];
            naive_attn(qs, DQ + (h * 2) * 64, 1024, 64, DQ, 1024, 0, [=](size_t row, int d) { return DK + kt_off(row, h * 128 + d); }, [=](size_t row, int d) { return DK; },
                       [=](size_t row, int c) { return DV[vt_off(row, h * 128 + c)]; }, rowbase, p0, lane, o, li);
            naive_attn(qs, DQ + (h * 2 + 1) * 64, 1024, 64, DQ, 1024, 0, [=](size_t row, int d) { return DK + kt_off(row, h * 128 + 64 + d); }, [=](size_t row, int d) { return DK; },
                       [=](size_t row, int c) { return DV[vt_off(row, h * 128 + c)]; }, rowbase, p0, lane, o2, li2);
#pragma unroll
            for (int r = 0; r < 4; ++r) {
                const float d0 = o[r][0] * li[r] - lam * o2[r][0] * li2[r], d1 = o[r][1] * li[r] - lam * o2[r][1] * li2[r];
                const float rs = 1.0f / sqrtf(wave_sum(d0 * d0 + d1 * d1) * (1.0f / 128.0f) + EPS);
                bf16* orow = OD + (rowbase + p0 + r) * 1024 + h * 128;
#ifdef ATT_CHECK
                { const float a0 = bf2f(orow[lane]), a1 = bf2f(orow[64 + lane]), b0 = d0 * rs * gs0, b1 = d1 * rs * gs1;
                  if (fabsf(a0 - b0) > ATT_TOL_A + ATT_TOL_R * fabsf(b0) || fabsf(a1 - b1) > ATT_TOL_A + ATT_TOL_R * fabsf(b1) || !(a0 == a0) || !(a1 == a1)) atomicAdd((unsigned*)F.ctl + 17, 1u); }
#else
                orow[lane] = (bf16)(pk2(d0 * rs * gs0, 0.f) & 0xffffu); orow[64 + lane] = (bf16)(pk2(d1 * rs * gs1, 0.f) & 0xffffu);
#endif
            }
        }
    }
}

namespace att {
typedef short bf16x8 __attribute__((ext_vector_type(8)));
typedef short s16x4 __attribute__((ext_vector_type(4)));
typedef float f32x16 __attribute__((ext_vector_type(16)));
typedef short v4i16_t __attribute__((ext_vector_type(4)));
#ifndef ATT_PF2
#define ATT_PF2 1
#endif
constexpr int BUFB = 40960, WSF_OFF = (ATT_PF2 ? 3 : 2) * BUFB;
#ifndef ATT_KD
#define ATT_KD 2
#endif
#ifndef ATT_VD
#define ATT_VD 2
#endif
__device__ __forceinline__ int crow(int r, int hi) { return (r & 3) + 8 * (r >> 2) + 4 * hi; }
__device__ __forceinline__ s16x4 vtr(const LAS unsigned char* p) { return __builtin_bit_cast(s16x4, __builtin_amdgcn_ds_read_tr16_b64_v4i16((LAS v4i16_t*)p)); }
__device__ __forceinline__ float max3f(float a, float b, float c) { float r; asm("v_max3_f32 %0, %1, %2, %3" : "=v"(r) : "v"(a), "v"(b), "v"(c)); return r; }
__device__ __forceinline__ float max2f(float a, float b) { float r; asm("v_max_f32_e32 %0, %1, %2" : "=v"(r) : "v"(a), "v"(b)); return r; }
__device__ __forceinline__ float swapmax(float m) { auto rr = __builtin_amdgcn_permlane32_swap(__float_as_uint(m), __float_as_uint(m), false, false);
    const unsigned a = rr[0], b = rr[1]; return fmaxf(__uint_as_float(a), __uint_as_float(b)); }
__device__ __forceinline__ float swapsum(float m) { auto rr = __builtin_amdgcn_permlane32_swap(__float_as_uint(m), __float_as_uint(m), false, false);
    const unsigned a = rr[0], b = rr[1]; return __uint_as_float(a) + __uint_as_float(b); }

template <bool DIFF>
__device__ __forceinline__ void attn_unit(LAS unsigned char* lds, int tid, size_t rowbase, int h, int q0,
                                          const bf16* Qa, const bf16* Qb, const bf16* Ka, const bf16* Kb, const bf16* Vp, bf16* Op, float lam, const float* gsub) {
    constexpr int NP = DIFF ? 4 : 5, NKS = DIFF ? 4 : 12, KPIECES = DIFF ? 16 : 24, R = DIFF ? 128 : 256;
    const int lane = tid & 63, r32 = lane & 31, hi = lane >> 5, wid = __builtin_amdgcn_readfirstlane(tid >> 6);
    const int mp = DIFF ? (wid >> 2) : 0, rows_w0 = q0 + 32 * (DIFF ? (wid & 3) : wid);
    const char* src[NP]; unsigned tstr[NP]; unsigned dsto[NP];
#pragma unroll
    for (int i = 0; i < NP; ++i) { const int pidx = wid * NP + i;
        const size_t bhb = ((size_t)(rowbase >> 13) * 8 + h) * 128 * 16384, krb = (size_t)(rowbase >> 13) * 128 * 8192;
        if (!DIFF) {
            if (pidx < 16) { src[i] = (const char*)Ka + bhb + pidx * 1024 + lane * 16; tstr[i] = 16384; dsto[i] = pidx * 1024; }
            else if (pidx < 24) { src[i] = (const char*)Kb + krb + (pidx - 16) * 1024 + lane * 16; tstr[i] = 8192; dsto[i] = pidx * 1024; }
            else { src[i] = (const char*)Vp + bhb + (pidx - 24) * 1024 + lane * 16; tstr[i] = 16384; dsto[i] = pidx * 1024; }
        } else {
            if (pidx < 16) { src[i] = (const char*)Ka + bhb + pidx * 1024 + lane * 16; tstr[i] = 16384; dsto[i] = pidx * 1024; }
            else { src[i] = (const char*)Vp + bhb + (pidx - 16) * 1024 + lane * 16; tstr[i] = 16384; dsto[i] = pidx * 1024; }
        } }
    const unsigned lds0 = (unsigned)(uintptr_t)lds;
#define ATT_DMA(t, bb) do { _Pragma("unroll") for (int _i = 0; _i < NP; ++_i) { unsigned _keep; const unsigned _dst = (unsigned)__builtin_amdgcn_readfirstlane((int)(lds0 + (unsigned)((bb) * BUFB) + dsto[_i])); \
        asm volatile("s_mov_b32 %0, m0\n\ts_mov_b32 m0, %2\n\ts_nop 0\n\tglobal_load_lds_dwordx4 %1, off\n\ts_mov_b32 m0, %0" : "=&s"(_keep) : "v"(src[_i] + (size_t)(t) * tstr[_i]), "s"(_dst) : "memory"); } } while (0)
    bf16x8 qf[NKS];
    { const size_t qrow = rowbase + rows_w0 + r32;
#pragma unroll
      for (int ks = 0; ks < NKS; ++ks) {
          if (DIFF) qf[ks] = *(const bf16x8*)(Qa + qrow * 1024 + (h * 2 + mp) * 64 + ks * 16 + hi * 8);
          else if (ks < 8) qf[ks] = *(const bf16x8*)(Qa + qrow * 1024 + h * 128 + ks * 16 + hi * 8);
          else qf[ks] = *(const bf16x8*)(Qb + qrow * 512 + h * 64 + (ks - 8) * 16 + hi * 8);
      } }
    f32x16 o[4];
#pragma unroll
    for (int d0 = 0; d0 < 4; ++d0) o[d0] = f32x16{};
    float m = -1e30f, l = 0.f;
    const int NT = (q0 + R) / 64, t_last = (rows_w0 + 31) / 64;
    LAS float* wsf = (LAS float*)(lds + WSF_OFF) + wid * 32;
    const int koff = (DIFF ? mp * 8 * 1024 : 0) + hi * 1024 + r32 * 16;
    const int voff = KPIECES * 1024 + ((lane >> 4) & 1) * 32 + (lane & 3) * 8 + (4 * hi + ((lane & 15) >> 2)) * 64;
    const int qpos = rows_w0 + r32;
    ATT_DMA(0, 0);
#if ATT_PF2
    ATT_DMA(1, 1);
#endif
    __builtin_amdgcn_s_waitcnt(0x0F70);
    asm volatile("s_waitcnt vmcnt(0)" ::: "memory"); __syncthreads();
#if ATT_PF2
    int bcur = 0;
#endif
#pragma unroll 1
    for (int t = 0; t < NT; ++t) {
#if ATT_PF2
        const int bb = bcur; const bool more = t + 2 < NT;
        if (more) ATT_DMA(t + 2, (bcur == 0) ? 2 : bcur - 1);
#else
        const int bb = t & 1;
        if (t + 1 < NT) ATT_DMA(t + 1, bb ^ 1);
#endif
        if (t <= t_last) {
            const LAS unsigned char* kb = lds + bb * BUFB + koff;
            f32x16 p0 = f32x16{}, p1 = f32x16{};
            {
                bf16x8 kfa[NKS], kfc[NKS];
#pragma unroll
                for (int ks = 0; ks < ATT_KD; ++ks) { kfa[ks] = *(const LAS bf16x8*)(kb + ks * 2048); kfc[ks] = *(const LAS bf16x8*)(kb + ks * 2048 + 512); }
                __builtin_amdgcn_sched_barrier(0);
#pragma unroll
                for (int ks = 0; ks < NKS; ++ks) {
                    if (ks + ATT_KD < NKS) { kfa[ks + ATT_KD] = *(const LAS bf16x8*)(kb + (ks + ATT_KD) * 2048); kfc[ks + ATT_KD] = *(const LAS bf16x8*)(kb + (ks + ATT_KD) * 2048 + 512); }
                    __builtin_amdgcn_sched_barrier(0);
                    p0 = __builtin_amdgcn_mfma_f32_32x32x16_bf16(kfa[ks], qf[ks], p0, 0, 0, 0);
                    p1 = __builtin_amdgcn_mfma_f32_32x32x16_bf16(kfc[ks], qf[ks], p1, 0, 0, 0);
                    __builtin_amdgcn_sched_barrier(0);
                }
            }
            if (64 * t + 63 > rows_w0) {
                const int kb0 = 64 * t + 4 * hi;
#pragma unroll
                for (int r = 0; r < 16; ++r) { const int kv = kb0 + (r & 3) + 8 * (r >> 2); if (kv > qpos) p0[r] = -INFINITY; if (kv + 32 > qpos) p1[r] = -INFINITY; }
            }
            asm volatile("s_nop 15\n\ts_nop 7" : "+v"(p0), "+v"(p1));
            float rm = max3f(p0[0], p0[1], p1[0]), rm2 = max3f(p0[2], p0[3], p1[1]); rm = max3f(rm, p1[2], p1[3]);
#pragma unroll
            for (int r = 4; r < 16; r += 4) { rm = max3f(rm, p0[r], p0[r + 1]); rm2 = max3f(rm2, p0[r + 2], p0[r + 3]); rm = max3f(rm, p1[r], p1[r + 1]); rm2 = max3f(rm2, p1[r + 2], p1[r + 3]); }
            rm = swapmax(max2f(rm, rm2));
            const float mn = fmaxf(m, rm);
            if (__any(mn > m)) {
                const float al = __builtin_amdgcn_exp2f(m - mn);
                l *= al;
                if (hi == 0) wsf[r32] = al;
                LDS_WAIT(); asm volatile("" ::: "memory");
#pragma unroll
                for (int r = 0; r < 16; ++r) { const float a = wsf[crow(r, hi)];
#pragma unroll
                    for (int d0 = 0; d0 < 4; ++d0) o[d0][r] *= a; }
                LDS_WAIT(); asm volatile("" ::: "memory");
            }
            m = mn;
            float ps = 0.f;
#pragma unroll
            for (int r = 0; r < 16; ++r) { p0[r] = __builtin_amdgcn_exp2f(p0[r] - mn); p1[r] = __builtin_amdgcn_exp2f(p1[r] - mn); ps += p0[r] + p1[r]; }
            l += ps;
            u32x4 pw[4];
            pw[0] = (u32x4){cvtpk(p0[0], p0[1]), cvtpk(p0[2], p0[3]), cvtpk(p0[4], p0[5]), cvtpk(p0[6], p0[7])};
            pw[1] = (u32x4){cvtpk(p0[8], p0[9]), cvtpk(p0[10], p0[11]), cvtpk(p0[12], p0[13]), cvtpk(p0[14], p0[15])};
            pw[2] = (u32x4){cvtpk(p1[0], p1[1]), cvtpk(p1[2], p1[3]), cvtpk(p1[4], p1[5]), cvtpk(p1[6], p1[7])};
            pw[3] = (u32x4){cvtpk(p1[8], p1[9]), cvtpk(p1[10], p1[11]), cvtpk(p1[12], p1[13]), cvtpk(p1[14], p1[15])};
            const LAS unsigned char* vb = lds + bb * BUFB + voff;
            {
                s16x4 vlo[16], vhh[16];
#pragma unroll
                for (int i = 0; i < ATT_VD; ++i) { vlo[i] = vtr(vb + i * 1024); vhh[i] = vtr(vb + i * 1024 + 512); }
                __builtin_amdgcn_sched_barrier(0);
#pragma unroll
                for (int i = 0; i < 16; ++i) {
                    if (i + ATT_VD < 16) { vlo[i + ATT_VD] = vtr(vb + (i + ATT_VD) * 1024); vhh[i + ATT_VD] = vtr(vb + (i + ATT_VD) * 1024 + 512); }
                    __builtin_amdgcn_sched_barrier(0);
                    const bf16x8 vf = (bf16x8){vlo[i][0], vlo[i][1], vlo[i][2], vlo[i][3], vhh[i][0], vhh[i][1], vhh[i][2], vhh[i][3]};
                    o[i >> 2] = __builtin_amdgcn_mfma_f32_32x32x16_bf16(__builtin_bit_cast(bf16x8, pw[i & 3]), vf, o[i >> 2], 0, 0, 0);
                    __builtin_amdgcn_sched_barrier(0);
                }
            }
        }
#if ATT_PF2
        if (more) asm volatile("s_waitcnt vmcnt(%0)" :: "n"(NP) : "memory"); else asm volatile("s_waitcnt vmcnt(0)" ::: "memory");
        __syncthreads();
        bcur = (bcur == 2) ? 0 : bcur + 1;
#else
        asm volatile("s_waitcnt vmcnt(0)" ::: "memory"); __syncthreads();
#endif
    }
#undef ATT_DMA
    l = swapsum(l);
    if (hi == 0) wsf[r32] = l;
    LDS_WAIT(); asm volatile("" ::: "memory");
    float rli[16];
#pragma unroll
    for (int r = 0; r < 16; ++r) rli[r] = 1.0f / wsf[crow(r, hi)];
    LDS_WAIT(); asm volatile("" ::: "memory");
    if (!DIFF) {
#pragma unroll
        for (int r = 0; r < 16; ++r) { bf16* orow = Op + (rowbase + rows_w0 + crow(r, hi)) * 1024 + h * 128 + r32;
#pragma unroll
            for (int d0 = 0; d0 < 4; ++d0) orow[d0 * 32] = (bf16)(cvtpk(o[d0][r] * rli[r], 0.f) & 0xffffu); }
    } else {
        LAS float* xch = (LAS float*)lds;
        if (wid >= 4) {
#pragma unroll
            for (int d0 = 0; d0 < 4; ++d0)
#pragma unroll
                for (int r = 0; r < 16; ++r) xch[((wid & 3) * 64 + d0 * 16 + r) * 64 + lane] = o[d0][r] * rli[r];
        }
        __syncthreads();
        if (wid < 4) {
            float ss[16];
#pragma unroll
            for (int r = 0; r < 16; ++r) ss[r] = 0.f;
#pragma unroll
            for (int d0 = 0; d0 < 4; ++d0)
#pragma unroll
                for (int r = 0; r < 16; ++r) { const float d = o[d0][r] * rli[r] - lam * xch[(wid * 64 + d0 * 16 + r) * 64 + lane]; o[d0][r] = d; ss[r] += d * d; }
#pragma unroll
            for (int r = 0; r < 16; ++r) {
#pragma unroll
                for (int of = 1; of < 32; of <<= 1) ss[r] += __shfl_xor(ss[r], of);
                ss[r] = 1.0f / sqrtf(ss[r] * (1.0f / 128.0f) + EPS); }
            float g4[4];
#pragma unroll
            for (int d0 = 0; d0 < 4; ++d0) g4[d0] = gsub[d0 * 32 + r32] * (1.0f - LAMBDA_INIT);
#pragma unroll
            for (int r = 0; r < 16; ++r) { bf16* orow = Op + (rowbase + rows_w0 + crow(r, hi)) * 1024 + h * 128 + r32;
#pragma unroll
                for (int d0 = 0; d0 < 4; ++d0) orow[d0 * 32] = (bf16)(cvtpk(o[d0][r] * ss[r] * g4[d0], 0.f) & 0xffffu); }
        }
        __syncthreads();
    }
}
}

__device__ __forceinline__ void p3_attention(Frame& F, const Ins& I) {
    unsigned char* ws = F.ws;
    const bf16 *QN = (const bf16*)(ws + WS_QN), *QR = (const bf16*)(ws + WS_QR), *KN = (const bf16*)(ws + WS_KN), *KR = (const bf16*)(ws + WS_KR), *V = (const bf16*)(ws + WS_V);
    const bf16 *DQ = (const bf16*)(ws + WS_DQ), *DK = (const bf16*)(ws + WS_DK), *DV = (const bf16*)(ws + WS_DV);
    bf16 *OM = (bf16*)(ws + WS_OM), *OD = (bf16*)(ws + WS_OD);
    const float lam = ((const float*)F.ctl)[CW_LAMBDA];
    LAS unsigned char* lds = F.lds + RING_OFF;
    for (int v = F.vcu; v < 256; v += F.G) {
        const int bh = v >> 4, c = v & 15, b = bh >> 3, h = bh & 7; const size_t rowbase = (size_t)b * SEQ;
        att::attn_unit<false>(lds, F.tid, rowbase, h, (31 - c) * 256, QN, QR, KN, KR, V, OM, lam, I.g_subln);
        att::attn_unit<true>(lds, F.tid, rowbase, h, (63 - c) * 128, DQ, nullptr, DK, nullptr, DV, OD, lam, I.g_subln);
        att::attn_unit<true>(lds, F.tid, rowbase, h, (47 - c) * 128, DQ, nullptr, DK, nullptr, DV, OD, lam, I.g_subln);
        att::attn_unit<true>(lds, F.tid, rowbase, h, (16 + c) * 128, DQ, nullptr, DK, nullptr, DV, OD, lam, I.g_subln);
        att::attn_unit<true>(lds, F.tid, rowbase, h, c * 128, DQ, nullptr, DK, nullptr, DV, OD, lam, I.g_subln);
        att::attn_unit<false>(lds, F.tid, rowbase, h, c * 256, QN, QR, KN, KR, V, OM, lam, I.g_subln);
    }
}

__device__ __forceinline__ void wave_argmax(float v, int idx, float& mv, int& mi) {
#pragma unroll
    for (int o = 1; o < 64; o <<= 1) { const float ov = __shfl_xor(v, o); const int oi = __shfl_xor(idx, o); if (ov > v || (ov == v && oi < idx)) { v = ov; idx = oi; } }
    mv = v; mi = idx;
}
__device__ __forceinline__ void p7_routing_ref(Frame& F) {
    unsigned char* ws = F.ws;
    const bf16* QP = (const bf16*)(ws + WS_QP); const bf16* SKB = (const bf16*)(ws + WS_SKB);
    int* IDX = (int*)(ws + WS_IDX); float* GT = (float*)(ws + WS_GT);
    LAS float* wl = (LAS float*)(F.lds + RING_OFF + F.wave * 4096);
    LAS float* qs = wl; LAS float* v1s = wl + 256; LAS int* i1s = (LAS int*)(wl + 272); LAS float* v2s = wl + 288; LAS int* i2s = (LAS int*)(wl + 304);
    const int gw = F.vcu * NWAVES + F.wave, NGW = F.G * NWAVES, lane = F.lane;
    for (int it = gw; it < T * 8; it += NGW) {
        { const u32x2 w = *(const u32x2*)(QP + (size_t)it * 256 + lane * 4); qs[lane * 4 + 0] = bflo(w.x); qs[lane * 4 + 1] = bfhi(w.x); qs[lane * 4 + 2] = bflo(w.y); qs[lane * 4 + 3] = bfhi(w.y); }
        LDS_WAIT(); asm volatile("" ::: "memory");
        float sc[2][2];
#pragma unroll
        for (int hf = 0; hf < 2; ++hf)
#pragma unroll
            for (int kk = 0; kk < 2; ++kk) { const bf16* kr = SKB + (size_t)(hf * 128 + kk * 64 + lane) * 256 + hf * 128; float s = 0.f;
#pragma unroll 4
                for (int d = 0; d < 128; d += 8) { const u32x4 kw = *(const u32x4*)(kr + d);
                    const f32x4 qa4 = *(const LAS f32x4*)(qs + hf * 128 + d), qb4 = *(const LAS f32x4*)(qs + hf * 128 + d + 4);
                    s += (qa4[0] * bflo(kw.x) + qa4[1] * bfhi(kw.x)) + (qa4[2] * bflo(kw.y) + qa4[3] * bfhi(kw.y)) + (qb4[0] * bflo(kw.z) + qb4[1] * bfhi(kw.z)) + (qb4[2] * bflo(kw.w) + qb4[3] * bfhi(kw.w)); }
                sc[hf][kk] = s; }
#pragma unroll
        for (int hf = 0; hf < 2; ++hf) {
            float a = sc[hf][0], b = sc[hf][1];
            for (int r = 0; r < 16; ++r) {
                float lv; int li; if (b > a) { lv = b; li = lane + 64; } else { lv = a; li = lane; }
                float mv; int mi; wave_argmax(lv, li, mv, mi);
                if (mi == lane) a = -INFINITY; if (mi == lane + 64) b = -INFINITY;
                if (lane == 0) { if (hf == 0) { v1s[r] = mv; i1s[r] = mi; } else { v2s[r] = mv; i2s[r] = mi; } }
            }
        }
        LDS_WAIT(); asm volatile("" ::: "memory");
        float cv[4];
#pragma unroll
        for (int j = 0; j < 4; ++j) { const int c = lane * 4 + j; cv[j] = v1s[c >> 4] + v2s[c & 15]; }
        float mycs = 0.f; int myc = 0;
        for (int r = 0; r < 16; ++r) {
            float lv = cv[0]; int li = lane * 4;
#pragma unroll
            for (int j = 1; j < 4; ++j) if (cv[j] > lv) { lv = cv[j]; li = lane * 4 + j; }
            float mv; int mi; wave_argmax(lv, li, mv, mi);
#pragma unroll
            for (int j = 0; j < 4; ++j) if (mi == lane * 4 + j) cv[j] = -INFINITY;
            if (lane == r) { mycs = mv; myc = mi; }
        }
        float mx = mycs;
#pragma unroll
        for (int o = 1; o < 16; o <<= 1) mx = fmaxf(mx, __shfl_xor(mx, o));
        const float e = __expf(mycs - mx); float se = e;
#pragma unroll
        for (int o = 1; o < 16; o <<= 1) se += __shfl_xor(se, o);
        if (lane < 16) { const int ex = i1s[myc >> 4] * 128 + i2s[myc & 15];
            IDX[(size_t)it * 16 + lane] = ex; GT[(size_t)it * 16 + lane] = e / se; }
        LDS_WAIT(); asm volatile("" ::: "memory");
    }
}

__device__ __forceinline__ void unpack8(const u32x4 w, float (&f)[8]) { f[0] = bflo(w.x); f[1] = bfhi(w.x); f[2] = bflo(w.y); f[3] = bfhi(w.y); f[4] = bflo(w.z); f[5] = bfhi(w.z); f[6] = bflo(w.w); f[7] = bfhi(w.w); }
__device__ __forceinline__ void p8_gather(Frame& F, const Ins& I, float* out) {
    unsigned char* ws = F.ws;
    const float* X2 = (const float*)(ws + WS_X2); const bf16* EU = (const bf16*)(ws + WS_EU); const bf16* EV = (const bf16*)(ws + WS_EV);
    const int* IDX = (const int*)(ws + WS_IDX); const float* GT = (const float*)(ws + WS_GT);
    const float* ssq2 = (const float*)(ws + WS_PSQ2);
    const int gw = F.vcu * NWAVES + F.wave, NGW = F.G * NWAVES, lane = F.lane;
    for (int t = gw; t < T; t += NGW) {
        float xv[4][8], acc[4][8];
#pragma unroll
        for (int j = 0; j < 4; ++j) { const f32x4 a = *(const f32x4*)(X2 + (size_t)t * 2048 + 512 * j + 8 * lane), b = *(const f32x4*)(X2 + (size_t)t * 2048 + 512 * j + 8 * lane + 4);
            xv[j][0] = a[0]; xv[j][1] = a[1]; xv[j][2] = a[2]; xv[j][3] = a[3]; xv[j][4] = b[0]; xv[j][5] = b[1]; xv[j][6] = b[2]; xv[j][7] = b[3];
#pragma unroll
            for (int e = 0; e < 8; ++e) acc[j][e] = 0.f; }
        const float rstd2 = 1.0f / sqrtf(sum32(ssq2 + (size_t)t * 32) * (1.0f / 2048.0f) + EPS);
        const int id0 = IDX[(size_t)t * 128 + lane], id1 = IDX[(size_t)t * 128 + 64 + lane];
        const float g0 = GT[(size_t)t * 128 + lane], g1 = GT[(size_t)t * 128 + 64 + lane];
        for (int i = 0; i < 128; ++i) {
            const int ex = __builtin_amdgcn_readlane(i < 64 ? id0 : id1, i & 63);
            const float gate = __builtin_bit_cast(float, __builtin_amdgcn_readlane(__builtin_bit_cast(int, i < 64 ? g0 : g1), i & 63));
            const bf16* ur = EU + (size_t)ex * 2048 + 8 * lane; const bf16* vr = EV + (size_t)ex * 2048 + 8 * lane;
            u32x4 uw[4], vw[4];
#pragma unroll
            for (int j = 0; j < 4; ++j) { uw[j] = *(const u32x4*)(ur + 512 * j); vw[j] = *(const u32x4*)(vr + 512 * j); }
            float dot = 0.f;
#pragma unroll
            for (int j = 0; j < 4; ++j) { float f[8]; unpack8(uw[j], f);
#pragma unroll
                for (int e = 0; e < 8; ++e) dot += f[e] * xv[j][e]; }
            const float a = wave_sum(dot) * rstd2;
            const float z2 = 1.5957691216057308f * (a + 0.044715f * a * a * a);
            const float w = gate * a * __builtin_amdgcn_rcpf(1.0f + __builtin_amdgcn_exp2f(-z2 * LOG2E));
#pragma unroll
            for (int j = 0; j < 4; ++j) { float f[8]; unpack8(vw[j], f);
#pragma unroll
                for (int e = 0; e < 8; ++e) acc[j][e] += w * f[e]; }
        }
        float s = 0.f;
#pragma unroll
        for (int j = 0; j < 4; ++j)
#pragma unroll
            for (int e = 0; e < 8; ++e) { acc[j][e] += xv[j][e]; s += acc[j][e] * acc[j][e]; }
        float rs = 1.0f / sqrtf(wave_sum(s) * (1.0f / 2048.0f) + EPS);
#ifdef ATT_CHECK
        if (((const unsigned*)F.ctl)[ATT_CHECK_WORD] > ATT_CHECK_MAX) rs = __builtin_nanf("");
#endif
#pragma unroll
        for (int j = 0; j < 4; ++j) { const f32x4 ga = *(const f32x4*)(I.g_final + 512 * j + 8 * lane), gb = *(const f32x4*)(I.g_final + 512 * j + 8 * lane + 4);
            *(f32x4*)(out + (size_t)t * 2048 + 512 * j + 8 * lane) = (f32x4){acc[j][0] * rs * ga[0], acc[j][1] * rs * ga[1], acc[j][2] * rs * ga[2], acc[j][3] * rs * ga[3]};
            *(f32x4*)(out + (size_t)t * 2048 + 512 * j + 8 * lane + 4) = (f32x4){acc[j][4] * rs * gb[0], acc[j][5] * rs * gb[1], acc[j][6] * rs * gb[2], acc[j][7] * rs * gb[3]}; }
    }
}

namespace rt {
typedef short bf16x8 __attribute__((ext_vector_type(8)));
typedef float f32x16 __attribute__((ext_vector_type(16)));
__device__ __forceinline__ unsigned f2sort(float f) { const unsigned u = __float_as_uint(f); return u ^ ((unsigned)((int)u >> 31) | 0x80000000u); }
__device__ __forceinline__ float sort2f(unsigned s) { return __uint_as_float(s ^ ((s >> 31) ? 0x80000000u : 0xFFFFFFFFu)); }
__device__ __forceinline__ unsigned umax(unsigned a, unsigned b) { return a > b ? a : b; }
__device__ __forceinline__ unsigned pair_max(unsigned m) { auto rr = __builtin_amdgcn_permlane32_swap(m, m, false, false); const unsigned a = rr[0], b = rr[1]; return umax(a, b); }
constexpr int KEYS_BYTES = 65536, LIST_OFF = KEYS_BYTES, LIST_WAVE = 6144 + 512;
}
__device__ __forceinline__ void rt_load_keys(Frame& F, const Ins& I) {
    LAS unsigned char* lds = F.lds + RING_OFF;
    for (int it = F.tid; it < 2 * 128 * 16; it += NWAVES * 64) {
        const int c = it & 15, n = (it >> 4) & 127, hf = it >> 11;
        const float* sp = I.sub_keys + (size_t)hf * 16384 + n * 128 + c * 8;
        const f32x4 a = *(const f32x4*)sp, b = *(const f32x4*)(sp + 4);
        v4u o; o.x = pk2(a.x, a.y); o.y = pk2(a.z, a.w); o.z = pk2(b.x, b.y); o.w = pk2(b.z, b.w);
        *(LAS v4u*)(lds + hf * 32768 + c * 2048 + n * 16) = o;
    }
    __syncthreads();
}
template <bool TO_LDS>
__device__ __forceinline__ void rt_task(Frame& F, int task, LAS unsigned* lst) {
    using namespace rt;
    unsigned char* ws = F.ws;
    const bf16* QP = (const bf16*)(ws + WS_QP);
    int* IDX = (int*)(ws + WS_IDX); float* GT = (float*)(ws + WS_GT);
    LAS unsigned char* lds = F.lds + RING_OFF;
    const int lane = F.lane, r32 = lane & 31, hi = lane >> 5;
        const size_t row = (size_t)task * 32 + r32;
#pragma unroll 1
        for (int hf = 0; hf < 2; ++hf) {
            bf16x8 qf[8];
#pragma unroll
            for (int ks = 0; ks < 8; ++ks) qf[ks] = *(const bf16x8*)(QP + row * 256 + hf * 128 + ks * 16 + hi * 8);
            unsigned k[64];
            const LAS unsigned char* kb0 = lds + hf * 32768 + hi * 2048 + r32 * 16;
#pragma unroll
            for (int kb = 0; kb < 4; ++kb) {
                f32x16 acc = f32x16{};
#pragma unroll
                for (int ks = 0; ks < 8; ++ks) acc = __builtin_amdgcn_mfma_f32_32x32x16_bf16(*(const LAS bf16x8*)(kb0 + ks * 4096 + kb * 512), qf[ks], acc, 0, 0, 0);
#pragma unroll
                for (int r = 0; r < 16; ++r) { const int n = 32 * kb + (r & 3) + 8 * (r >> 2) + 4 * hi; k[16 * kb + r] = (f2sort(acc[r]) & ~0x7Fu) | (unsigned)(127 - n); }
            }
#pragma unroll 1
            for (int rd = 0; rd < 16; ++rd) {
                unsigned m = k[0];
#pragma unroll
                for (int i = 1; i < 64; ++i) m = umax(m, k[i]);
                const unsigned g = pair_max(m);
#pragma unroll
                for (int i = 0; i < 64; ++i) k[i] = (k[i] == g) ? 0u : k[i];
                if (hi == 0) lst[hf * 16 + rd] = g;
            }
        }
        LDS_WAIT(); asm volatile("" ::: "memory");
        float v1[16], v2[16];
#pragma unroll
        for (int q = 0; q < 4; ++q) { const v4u a = *(const LAS v4u*)(lst + 4 * q), b = *(const LAS v4u*)(lst + 16 + 4 * q);
#pragma unroll
            for (int e = 0; e < 4; ++e) { v1[4 * q + e] = sort2f(a[e] & ~0x7Fu); v2[4 * q + e] = sort2f(b[e] & ~0x7Fu); } }
        unsigned cand[50];
        { int ci = 0;
#pragma unroll
          for (int a = 0; a < 16; ++a)
#pragma unroll
              for (int b = 0; b < 16; ++b) if ((a + 1) * (b + 1) <= 16) { cand[ci] = (f2sort(v1[a] + v2[b]) & ~0xFFu) | (unsigned)(255 - (a * 16 + b)); ++ci; } }
#pragma unroll 1
        for (int rd = 0; rd < 16; ++rd) {
            unsigned m = cand[0];
#pragma unroll
            for (int i = 1; i < 50; ++i) m = umax(m, cand[i]);
#pragma unroll
            for (int i = 0; i < 50; ++i) cand[i] = (cand[i] == m) ? 0u : cand[i];
            if (hi == 0) lst[32 + rd] = m;
        }
        LDS_WAIT(); asm volatile("" ::: "memory");
        const float cmax = sort2f(lst[32] & ~0xFFu);
        float ev[8]; int ex[8]; float se = 0.f;
#pragma unroll
        for (int j = 0; j < 8; ++j) { const unsigned key = lst[32 + 8 * hi + j]; const int ab = 255 - (int)(key & 0xFFu);
            const int i1 = 127 - (int)(lst[ab >> 4] & 0x7Fu), i2 = 127 - (int)(lst[16 + (ab & 15)] & 0x7Fu);
            ex[j] = i1 * 128 + i2; ev[j] = __expf(sort2f(key & ~0xFFu) - cmax); se += ev[j]; }
        { auto rr = __builtin_amdgcn_permlane32_swap(__float_as_uint(se), __float_as_uint(se), false, false); const unsigned a = rr[0], b = rr[1]; se = __uint_as_float(a) + __uint_as_float(b); }
        const float inv = 1.0f / se;
        if (TO_LDS) {
#pragma unroll
            for (int j = 0; j < 8; ++j) { lst[8 * hi + j] = (unsigned)ex[j]; lst[16 + 8 * hi + j] = __float_as_uint(ev[j] * inv); }
        } else {
        int* ip = IDX + row * 16 + 8 * hi; float* gp = GT + row * 16 + 8 * hi;
        *(GAS v4u*)ip = (v4u){(unsigned)ex[0], (unsigned)ex[1], (unsigned)ex[2], (unsigned)ex[3]}; *(GAS v4u*)(ip + 4) = (v4u){(unsigned)ex[4], (unsigned)ex[5], (unsigned)ex[6], (unsigned)ex[7]};
        *(GAS f32x4*)gp = (f32x4){ev[0] * inv, ev[1] * inv, ev[2] * inv, ev[3] * inv}; *(GAS f32x4*)(gp + 4) = (f32x4){ev[4] * inv, ev[5] * inv, ev[6] * inv, ev[7] * inv};
        }
        LDS_WAIT(); asm volatile("" ::: "memory");
}
__device__ __forceinline__ void p8_routing(Frame& F, const Ins& I) {
    using namespace rt;
    rt_load_keys(F, I);
    LAS unsigned* lst = (LAS unsigned*)(F.lds + RING_OFF + LIST_OFF + F.wave * LIST_WAVE) + (F.lane & 31) * 48;
    const int gw = F.vcu * NWAVES + F.wave, NGW = F.G * NWAVES;
    for (int task = gw; task < T * 8 / 32; task += NGW) rt_task<false>(F, task, lst);
}
constexpr float EU_SCALE = 64.0f, EV_SCALE = 4.0f;
typedef float f32x2v __attribute__((ext_vector_type(2)));
__device__ __forceinline__ unsigned pk4_fp8(float a, float b, float c, float d) { int t = __builtin_amdgcn_cvt_pk_fp8_f32(a, b, 0, false); t = __builtin_amdgcn_cvt_pk_fp8_f32(c, d, t, true); return (unsigned)t; }
__device__ __forceinline__ void convert_experts_fp8(Frame& F, const Ins& I) {
    const size_t gt = (size_t)(F.vcu * NWAVES * 64) + F.tid, NT = (size_t)F.G * NWAVES * 64;
    const size_t nchunk = (size_t)NEXP * D_MODEL / 16;
    unsigned char* EU = F.ws + WS_EU; unsigned char* EV = F.ws + WS_EV;
    for (size_t c = gt; c < nchunk; c += NT) {
        const int d = (int)((c * 16) & (D_MODEL - 1));
        v4u o, p;
#pragma unroll
        for (int k = 0; k < 4; ++k) {
            const f32x4 a = *(const GAS f32x4*)(I.expert_u + c * 16 + 4 * k), g = *(const f32x4*)(I.g_norm2 + d + 4 * k), b = *(const GAS f32x4*)(I.expert_v + c * 16 + 4 * k);
            o[k] = pk4_fp8(a.x * g.x * EU_SCALE, a.y * g.y * EU_SCALE, a.z * g.z * EU_SCALE, a.w * g.w * EU_SCALE);
            p[k] = pk4_fp8(b.x * EV_SCALE, b.y * EV_SCALE, b.z * EV_SCALE, b.w * EV_SCALE);
        }
        *(GAS v4u*)(EU + c * 16) = o; *(GAS v4u*)(EV + c * 16) = p;
    }
}
#ifndef PEER_FP8
#define PEER_FP6 1
#endif
#ifdef PEER_FP6
typedef float v32f_t __attribute__((ext_vector_type(32)));
typedef float v16f_t __attribute__((ext_vector_type(16)));
typedef unsigned v6u_t __attribute__((ext_vector_type(6)));
constexpr int EROW = 1536;
__device__ __forceinline__ void convert_experts_fp6(Frame& F, const Ins& I) {
    const size_t gt = (size_t)(F.vcu * NWAVES * 64) + F.tid, NT = (size_t)F.G * NWAVES * 64;
    const size_t nblk = (size_t)NEXP * 64;
    unsigned char* EU = F.ws + WS_EU; unsigned char* EV = F.ws + WS_EV;
    LAS int* ptab = (LAS int*)(F.lds + RING_OFF + 65536);
#pragma unroll 1
    for (int j = 0; j < 32; ++j) {
        v16f_t a, b;
#pragma unroll
        for (int i = 0; i < 16; ++i) { a[i] = (i == j) ? 1.0f : 0.0f; b[i] = (i + 16 == j) ? 1.0f : 0.0f; }
        const v32f_t r = __builtin_amdgcn_cvt_scalef32_pk32_f32_fp6(__builtin_amdgcn_cvt_scalef32_2xpk16_fp6_f32(a, b, 1.0f), 1.0f);
        int pos = 0;
#pragma unroll
        for (int i = 0; i < 32; ++i) pos = (r[i] != 0.0f) ? i : pos;
        ptab[j] = pos;
    }
    LDS_WAIT(); asm volatile("" ::: "memory");
    bool inter = true;
#pragma unroll 1
    for (int j = 0; j < 32; ++j) inter = inter && (ptab[j] == ((j < 16) ? 2 * j : 2 * (j - 16) + 1));
    if (inter) {
        const int gw = F.vcu * NWAVES + F.wave, NGW = F.G * NWAVES, lane = F.lane;
        LAS unsigned char* img = F.lds + RING_OFF + F.wave * 9216;
        f32x4 gsc[8];
#pragma unroll
        for (int k = 0; k < 8; ++k) gsc[k] = *(const f32x4*)(I.g_norm2 + (64 * k + lane) * 4) * EU_SCALE;
        for (int e = gw; e < NEXP; e += NGW) {
            f32x4 ru[8], rv[8];
#pragma unroll
            for (int k = 0; k < 8; ++k) { ru[k] = *(const GAS f32x4*)(I.expert_u + (size_t)e * 2048 + (64 * k + lane) * 4); rv[k] = *(const GAS f32x4*)(I.expert_v + (size_t)e * 2048 + (64 * k + lane) * 4); }
#pragma unroll
            for (int tb = 0; tb < 2; ++tb) {
#pragma unroll
                for (int k = 0; k < 8; ++k) { const int i4 = 64 * k + lane;
                    *(LAS f32x4*)(img + (i4 >> 3) * 144 + (i4 & 7) * 16) = tb == 0 ? ru[k] * gsc[k] : rv[k] * EV_SCALE; }
                LDS_WAIT(); asm volatile("" ::: "memory");
                v16f_t ya, yb;
#pragma unroll
                for (int j = 0; j < 8; ++j) { const f32x4 x4 = *(const LAS f32x4*)(img + lane * 144 + 16 * j); ya[2 * j] = x4[0]; yb[2 * j] = x4[1]; ya[2 * j + 1] = x4[2]; yb[2 * j + 1] = x4[3]; }
                LDS_WAIT(); asm volatile("" ::: "memory");
                const v6u_t pk = __builtin_amdgcn_cvt_scalef32_2xpk16_fp6_f32(ya, yb, 1.0f);
                unsigned char* dst = (tb == 0 ? EU : EV) + (size_t)e * EROW;
                *(GAS v4u*)(dst + 16 * lane) = (v4u){pk[0], pk[1], pk[2], pk[3]}; *(GAS u32x2*)(dst + 1024 + 8 * lane) = (u32x2){pk[4], pk[5]};
            }
        }
    } else {
    LAS float* scr = (LAS float*)(F.lds + RING_OFF) + F.tid;
    for (size_t c = gt; c < nblk; c += NT) {
        const size_t e = c >> 6; const int l = (int)(c & 63), d = 32 * l;
        v16f_t ya, yb;
#pragma unroll
        for (int k = 0; k < 8; ++k) { const f32x4 a0 = *(const GAS f32x4*)(I.expert_u + c * 32 + 4 * k), g0 = *(const f32x4*)(I.g_norm2 + d + 4 * k);
#pragma unroll
            for (int j = 0; j < 4; ++j) scr[(4 * k + j) * 512] = a0[j] * g0[j] * EU_SCALE; }
#pragma unroll
        for (int j = 0; j < 16; ++j) { ya[j] = scr[ptab[j] * 512]; yb[j] = scr[ptab[16 + j] * 512]; }
        const v6u_t pu = __builtin_amdgcn_cvt_scalef32_2xpk16_fp6_f32(ya, yb, 1.0f);
        *(GAS v4u*)(EU + e * EROW + 16 * l) = (v4u){pu[0], pu[1], pu[2], pu[3]}; *(GAS u32x2*)(EU + e * EROW + 1024 + 8 * l) = (u32x2){pu[4], pu[5]};
#pragma unroll
        for (int k = 0; k < 8; ++k) { const f32x4 b0 = *(const GAS f32x4*)(I.expert_v + c * 32 + 4 * k);
#pragma unroll
            for (int j = 0; j < 4; ++j) scr[(4 * k + j) * 512] = b0[j] * EV_SCALE; }
#pragma unroll
        for (int j = 0; j < 16; ++j) { ya[j] = scr[ptab[j] * 512]; yb[j] = scr[ptab[16 + j] * 512]; }
        const v6u_t pv = __builtin_amdgcn_cvt_scalef32_2xpk16_fp6_f32(ya, yb, 1.0f);
        *(GAS v4u*)(EV + e * EROW + 16 * l) = (v4u){pv[0], pv[1], pv[2], pv[3]}; *(GAS u32x2*)(EV + e * EROW + 1024 + 8 * l) = (u32x2){pv[4], pv[5]};
    }
    }
    __syncthreads();
}
struct G9Row { u32x4 a; u32x2 b; };
#define G9_SETS G9Row A[4], B[4]
#define G9_XOFF(c) (32 * lane + 16 * (c))
#define G9_LOAD(SET, TAB, IDL, g) do { _Pragma("unroll") for (int k = 0; k < 4; ++k) { const int ex = __builtin_amdgcn_readlane(IDL, 4 * (4 * (g) + k)); \
        const unsigned char* rp = (TAB) + (size_t)ex * EROW; SET[k].a = *(const u32x4*)(rp + 16 * lane); SET[k].b = *(const u32x2*)(rp + 1024 + 8 * lane); } } while (0)
#define G9_CVT(SET, k) __builtin_amdgcn_cvt_scalef32_pk32_f32_fp6((v6u_t){SET[k].a.x, SET[k].a.y, SET[k].a.z, SET[k].a.w, SET[k].b.x, SET[k].b.y}, 1.0f)
#define G9_DOTS(SET, g) do { _Pragma("unroll") for (int k = 0; k < 4; ++k) { const v32f_t r = G9_CVT(SET, k); float s0 = 0.f, s1 = 0.f; \
        f32x2v q0 = {0.f, 0.f}, q1 = {0.f, 0.f}; (void)s0; (void)s1; \
        _Pragma("unroll") for (int e = 0; e < 16; e += 2) { q0 = (f32x2v){r[e], r[e + 1]} * (f32x2v){xv[0][e], xv[0][e + 1]} + q0; q1 = (f32x2v){r[16 + e], r[17 + e]} * (f32x2v){xv[1][e], xv[1][e + 1]} + q1; } \
        q0 += q1; float s = q0.x + q0.y; asm volatile("" : "+v"(s)); dots[4 * (g) + k] = s; } } while (0)
#define G9_FMAS(SET, g) do { _Pragma("unroll") for (int k = 0; k < 4; ++k) { const float wk = wq[g][k]; const v32f_t r = G9_CVT(SET, k); \
        const f32x2v wk2 = {wk, wk}; \
        _Pragma("unroll") for (int e = 0; e < 16; e += 2) { const f32x2v a0 = (f32x2v){r[e], r[e + 1]} * wk2 + (f32x2v){acc[0][e], acc[0][e + 1]}, a1 = (f32x2v){r[16 + e], r[17 + e]} * wk2 + (f32x2v){acc[1][e], acc[1][e + 1]}; \
            acc[0][e] = a0.x; acc[0][e + 1] = a0.y; acc[1][e] = a1.x; acc[1][e + 1] = a1.y; } } } while (0)
#else
constexpr int EROW = 2048;
#define G9_SETS u32x4 A[4][2], B[4][2]
#define G9_XOFF(c) (1024 * (c) + 16 * lane)
#define G9_LOAD(SET, TAB, IDL, g) do { _Pragma("unroll") for (int k = 0; k < 4; ++k) { const int ex = __builtin_amdgcn_readlane(IDL, 4 * (4 * (g) + k)); \
        const unsigned char* rp = (TAB) + (size_t)ex * 2048 + 16 * lane; SET[k][0] = *(const u32x4*)rp; SET[k][1] = *(const u32x4*)(rp + 1024); } } while (0)
#define G9_DOTS(SET, g) do { _Pragma("unroll") for (int k = 0; k < 4; ++k) { float s = 0.f; _Pragma("unroll") for (int c = 0; c < 2; ++c) _Pragma("unroll") for (int dw = 0; dw < 4; ++dw) { \
        const f32x2v lo = __builtin_amdgcn_cvt_pk_f32_fp8((int)SET[k][c][dw], false), hi2 = __builtin_amdgcn_cvt_pk_f32_fp8((int)SET[k][c][dw], true); \
        s += lo.x * xv[c][4 * dw] + lo.y * xv[c][4 * dw + 1] + hi2.x * xv[c][4 * dw + 2] + hi2.y * xv[c][4 * dw + 3]; } asm volatile("" : "+v"(s)); dots[4 * (g) + k] = s; } } while (0)
#define G9_FMAS(SET, g) do { _Pragma("unroll") for (int k = 0; k < 4; ++k) { const float wk = wq[g][k]; \
        _Pragma("unroll") for (int c = 0; c < 2; ++c) _Pragma("unroll") for (int dw = 0; dw < 4; ++dw) { \
        const f32x2v lo = __builtin_amdgcn_cvt_pk_f32_fp8((int)SET[k][c][dw], false), hi2 = __builtin_amdgcn_cvt_pk_f32_fp8((int)SET[k][c][dw], true); \
        acc[c][4 * dw] += wk * lo.x; acc[c][4 * dw + 1] += wk * lo.y; acc[c][4 * dw + 2] += wk * hi2.x; acc[c][4 * dw + 3] += wk * hi2.y; } } } while (0)
#endif
#define G9_PIN() do { _Pragma("unroll") for (int c = 0; c < 2; ++c) asm volatile("" : "+v"(acc[c][0]), "+v"(acc[c][1]), "+v"(acc[c][2]), "+v"(acc[c][3]), "+v"(acc[c][4]), "+v"(acc[c][5]), "+v"(acc[c][6]), "+v"(acc[c][7]), \
        "+v"(acc[c][8]), "+v"(acc[c][9]), "+v"(acc[c][10]), "+v"(acc[c][11]), "+v"(acc[c][12]), "+v"(acc[c][13]), "+v"(acc[c][14]), "+v"(acc[c][15])); } while (0)
template <class IdF, class GtF>
__device__ __forceinline__ void g9_token(Frame& F, const Ins& I, float* out, int t, LAS float* wl, IdF idf, GtF gtf) {
    unsigned char* ws = F.ws;
    const bf16* X2B = (const bf16*)(ws + WS_X2B); const unsigned char* EU = ws + WS_EU; const unsigned char* EV = ws + WS_EV;
    const float* ssq2 = (const float*)(ws + WS_PSQ2);
    const int lane = F.lane, sl = (lane >> 2) & 15;
    const bool bit3 = (lane & 8) != 0, bit2 = (lane & 4) != 0;
    {
        G9_SETS;
        {
            float xv[2][16];
#pragma unroll
            for (int c = 0; c < 2; ++c)
#pragma unroll
                for (int q = 0; q < 2; ++q) { const u32x4 a = *(const u32x4*)(X2B + (size_t)t * 2048 + G9_XOFF(c) + 8 * q);
                    xv[c][8 * q] = bflo(a.x); xv[c][8 * q + 1] = bfhi(a.x); xv[c][8 * q + 2] = bflo(a.y); xv[c][8 * q + 3] = bfhi(a.y); xv[c][8 * q + 4] = bflo(a.z); xv[c][8 * q + 5] = bfhi(a.z); xv[c][8 * q + 6] = bflo(a.w); xv[c][8 * q + 7] = bfhi(a.w); }
            const float rstd2 = (1.0f / EU_SCALE) / sqrtf(sum32(ssq2 + (size_t)t * 32) * (1.0f / 2048.0f) + EPS);
            int idl_cur = idf(0);
            G9_LOAD(A, EU, idl_cur, 0); __builtin_amdgcn_sched_barrier(0);
#pragma unroll 1
            for (int hd = 0; hd < 8; ++hd) {
                const int idl_nxt = idf(hd < 7 ? hd + 1 : 0); const float gtl = gtf(hd);
                float dots[16];
                G9_LOAD(B, EU, idl_cur, 1); __builtin_amdgcn_sched_barrier(0);
                G9_DOTS(A, 0); __builtin_amdgcn_sched_barrier(0);
                G9_LOAD(A, EU, idl_cur, 2); __builtin_amdgcn_sched_barrier(0);
                G9_DOTS(B, 1); __builtin_amdgcn_sched_barrier(0);
                G9_LOAD(B, EU, idl_cur, 3); __builtin_amdgcn_sched_barrier(0);
                G9_DOTS(A, 2); __builtin_amdgcn_sched_barrier(0);
                if (hd < 7) { G9_LOAD(A, EU, idl_nxt, 0); } else { G9_LOAD(A, EV, idl_nxt, 0); }
                __builtin_amdgcn_sched_barrier(0);
                G9_DOTS(B, 3); __builtin_amdgcn_sched_barrier(0);
                float d8[8], d4[4], d2[2], d1;
#pragma unroll
                for (int i = 0; i < 8; ++i) { auto rr = __builtin_amdgcn_permlane32_swap(__float_as_uint(dots[i]), __float_as_uint(dots[8 + i]), false, false); const unsigned r0 = rr[0], r1 = rr[1]; d8[i] = __uint_as_float(r0) + __uint_as_float(r1); }
#pragma unroll
                for (int i = 0; i < 4; ++i) { auto rr = __builtin_amdgcn_permlane16_swap(__float_as_uint(d8[i]), __float_as_uint(d8[4 + i]), false, false); const unsigned r0 = rr[0], r1 = rr[1]; d4[i] = __uint_as_float(r0) + __uint_as_float(r1); }
#pragma unroll
                for (int i = 0; i < 2; ++i) { const float keep = bit3 ? d4[2 + i] : d4[i], send = bit3 ? d4[i] : d4[2 + i]; d2[i] = keep + __shfl_xor(send, 8); }
                { const float keep = bit2 ? d2[1] : d2[0], send = bit2 ? d2[0] : d2[1]; d1 = keep + __shfl_xor(send, 4); }
                d1 += __shfl_xor(d1, 2); d1 += __shfl_xor(d1, 1);
                const float a = d1 * rstd2;
                const float z2 = 1.5957691216057308f * (a + 0.044715f * a * a * a);
                const float w = gtl * (1.0f / EV_SCALE) * a * __builtin_amdgcn_rcpf(1.0f + __builtin_amdgcn_exp2f(-z2 * LOG2E));
                if ((lane & 3) == 0) wl[hd * 16 + sl] = w;
                idl_cur = idl_nxt;
            }
        }
        LDS_WAIT(); asm volatile("" ::: "memory");
        float acc[2][16];
#pragma unroll
        for (int c = 0; c < 2; ++c)
#pragma unroll
            for (int e = 0; e < 16; ++e) acc[c][e] = 0.f;
        {
            int idl_cur = idf(0);
#pragma unroll 1
            for (int hd = 0; hd < 8; ++hd) {
                const int idl_nxt = idf(hd < 7 ? hd + 1 : 0);
                f32x4 wq[4];
#pragma unroll
                for (int g = 0; g < 4; ++g) wq[g] = *(const LAS f32x4*)(wl + hd * 16 + 4 * g);
                G9_LOAD(B, EV, idl_cur, 1); __builtin_amdgcn_sched_barrier(0);
                G9_FMAS(A, 0); G9_PIN(); __builtin_amdgcn_sched_barrier(0);
                G9_LOAD(A, EV, idl_cur, 2); __builtin_amdgcn_sched_barrier(0);
                G9_FMAS(B, 1); G9_PIN(); __builtin_amdgcn_sched_barrier(0);
                G9_LOAD(B, EV, idl_cur, 3); __builtin_amdgcn_sched_barrier(0);
                G9_FMAS(A, 2); G9_PIN(); __builtin_amdgcn_sched_barrier(0);
                if (hd < 7) { G9_LOAD(A, EV, idl_nxt, 0); } __builtin_amdgcn_sched_barrier(0);
                G9_FMAS(B, 3); G9_PIN(); __builtin_amdgcn_sched_barrier(0);
                idl_cur = idl_nxt;
            }
        }
        LDS_WAIT(); asm volatile("" ::: "memory");
        float s = 0.f;
#pragma unroll
        for (int c = 0; c < 2; ++c)
#pragma unroll
            for (int q = 0; q < 2; ++q) { const u32x4 a = *(const u32x4*)(X2B + (size_t)t * 2048 + G9_XOFF(c) + 8 * q);
                const float xr[8] = {bflo(a.x), bfhi(a.x), bflo(a.y), bfhi(a.y), bflo(a.z), bfhi(a.z), bflo(a.w), bfhi(a.w)};
#pragma unroll
                for (int e = 0; e < 8; ++e) { acc[c][8 * q + e] += xr[e]; s += acc[c][8 * q + e] * acc[c][8 * q + e]; } }
        float rs = 1.0f / sqrtf(wave_sum(s) * (1.0f / 2048.0f) + EPS);
#ifdef ATT_CHECK
        if (((const unsigned*)F.ctl)[16] + ((const unsigned*)F.ctl)[17] > 0u) rs = __builtin_nanf("");
#endif
#pragma unroll
        for (int c = 0; c < 2; ++c)
#pragma unroll
            for (int q = 0; q < 4; ++q) { const f32x4 g = *(const f32x4*)(I.g_final + G9_XOFF(c) + 4 * q);
                *(f32x4*)(out + (size_t)t * 2048 + G9_XOFF(c) + 4 * q) = (f32x4){acc[c][4 * q] * rs * g[0], acc[c][4 * q + 1] * rs * g[1], acc[c][4 * q + 2] * rs * g[2], acc[c][4 * q + 3] * rs * g[3]}; }
    }
}
#undef G9_LOAD
#undef G9_DOTS
#undef G9_FMAS
#undef G9_PIN
#undef G9_SETS
#undef G9_XOFF
__device__ __forceinline__ void p9_gather_fp8(Frame& F, const Ins& I, float* out) {
    const int* IDX = (const int*)(F.ws + WS_IDX); const float* GT = (const float*)(F.ws + WS_GT);
    const int lane = F.lane, sl = (lane >> 2) & 15;
    LAS float* wl = (LAS float*)(F.lds + RING_OFF + F.wave * 4096);
    unsigned* tokctr = (unsigned*)F.ctl + CW_TOKCTR;
    for (;;) {
        int t = 0; if (lane == 0) t = (int)__hip_atomic_fetch_add(tokctr, 1u, __ATOMIC_RELAXED, __HIP_MEMORY_SCOPE_AGENT);
        t = __builtin_amdgcn_readfirstlane(t);
        if (t >= T) break;
        const int* idx_t = IDX + (size_t)t * 128 + sl; const float* gt_t = GT + (size_t)t * 128 + sl;
        g9_token(F, I, out, t, wl, [=](int hd) { return idx_t[hd * 16]; }, [=](int hd) { return gt_t[hd * 16]; });
    }
}

__device__ __forceinline__ void p89_route_gather(Frame& F, const Ins& I, float* out) {
    using namespace rt;
    rt_load_keys(F, I);
    LAS unsigned* lstw = (LAS unsigned*)(F.lds + RING_OFF + LIST_OFF + F.wave * LIST_WAVE);
    LAS unsigned* lst = lstw + (F.lane & 31) * 48;
    LAS float* wl = (LAS float*)(lstw + 32 * 48);
    const int gw = F.vcu * NWAVES + F.wave, NGW = F.G * NWAVES, sl = (F.lane >> 2) & 15;
    for (int task = gw; task < T * 8 / 32; task += NGW) {
        rt_task<true>(F, task, lst);
        LDS_WAIT(); asm volatile("" ::: "memory");
#pragma unroll 1
        for (int tt = 0; tt < 4; ++tt) {
            LAS unsigned* lt = lstw + (tt * 8) * 48 + sl;
            g9_token(F, I, out, 4 * task + tt, wl, [=](int hd) { return (int)lt[hd * 48]; }, [=](int hd) { return __uint_as_float(lt[hd * 48 + 16]); });
        }
        LDS_WAIT(); asm volatile("" ::: "memory");
    }
}

constexpr int NPHASE = 10;
struct Args { Ins in; float* out; unsigned char* ws; double inv_freq[32]; int ph_lo, ph_hi; };
__global__ void __launch_bounds__(NWAVES * 64, 2) mega_fwd(Args args) {
    extern __shared__ __attribute__((aligned(16))) unsigned char lds[];
    Frame F;
    F.lds = (LAS unsigned char*)lds;
    F.MISC = (volatile LAS unsigned*)(F.lds + MISC_OFF);
    F.tid = threadIdx.x; F.lane = F.tid & 63; F.wave = __builtin_amdgcn_readfirstlane(F.tid >> 6);
    F.G = gridDim.x; { const int bx = blockIdx.x; F.vcu = (F.G % 8 == 0) ? (bx % 8) * (F.G / 8) + bx / 8 : bx; }
    unsigned char* ws = args.ws; F.ws = ws;
    F.ctl = (gu32*)(ws + WS_CTL);
    const Ins& I = args.in;
    for (int u = F.tid; u < (LDS_BYTES - LDSCTL_OFF) / 4; u += NWAVES * 64) ((LAS unsigned*)(F.lds + LDSCTL_OFF))[u] = 0u;
    __syncthreads();
    XcdBarrier bar; bar.bar = (unsigned*)(F.ctl + CW_BAR); bar.x = 0; bar.st = nullptr;
#if MK_N_LAUNCHES == 1
    bar = xcd_barrier_post((unsigned*)(F.ctl + CW_BAR), F.MISC + 8);
#define GRID_BAR() xcd_barrier(bar)
#else
#define GRID_BAR() do {} while (0)
#endif
    const int lo = args.ph_lo, hi = args.ph_hi;
#ifdef PROBE_PH
    unsigned long long pstamp[NPHASE + 1];
#define PSTAMP(k) do { if (blockIdx.x == 0 && F.tid == 0) pstamp[k] = __builtin_amdgcn_s_memrealtime(); } while (0)
#else
#define PSTAMP(k) do {} while (0)
#endif
#ifndef PH_MASK
#define PH_MASK 0xFFFF
#endif
#define IN(k) (((PH_MASK >> (k)) & 1) && lo <= (k) && (k) < hi)
#define BOTH(k) (IN(k) && IN((k) + 1))
    float* ssq_q = (float*)(ws + WS_PSQ_Q); float* ssq_kv = (float*)(ws + WS_PSQ_KV); float* ssq2 = (float*)(ws + WS_PSQ2);
    const float* rope = (const float*)(ws + WS_ROPE);

    PSTAMP(0);
    if (IN(0)) { p0_prologue(F, I, args.inv_freq); if (BOTH(0)) GRID_BAR(); }

    PSTAMP(1);
    if (IN(1)) {
        EpiProj E{(bf16_t*)(ws + WS_CQ), (bf16_t*)(ws + WS_CKV), (bf16_t*)(ws + WS_DQ), (bf16_t*)(ws + WS_DK), (bf16_t*)(ws + WS_DV), (bf16_t*)(ws + WS_G), (bf16_t*)(ws + WS_KR), ssq_q, ssq_kv, I.b_gate, rope, 0};
        { pg8::Gemm g{(const bf16_t*)(ws + WS_H), (const bf16_t*)(ws + WS_W1), T, N1, 2048, 2048}; pg8::StaticOrder S; S.init(T, N1, F.G, (int)blockIdx.x);
          pg8::gemm_phase<EpiProj, pg8::StaticOrder, PG8_ALIGN, PG8_SP2>(F.lds + RING_OFF, g, S, E); }
        {
          pg8::Gemm g{(const bf16_t*)(ws + WS_H8), (const bf16_t*)(ws + WS_W8), T, NG, 1024, 1024, 1.0f / W1_SCALE}; pg8::GateOrder S; S.init(T, NG, F.G, (int)blockIdx.x);
          E.pn_off = 18;
          pg8::gemm_phase<EpiProj, pg8::GateOrder, PG8_ALIGN, PG8_SP2, true>(F.lds + RING_OFF, g, S, E); }
        if (BOTH(1)) GRID_BAR();
    }
    PSTAMP(2);
    if (IN(2)) {
        { pg8::Gemm g{(const bf16_t*)(ws + WS_CQ), (const bf16_t*)(ws + WS_WUQ), T, 1536, 768, 768}; pg8::StaticOrder S; S.init(T, 1536, F.G, (int)blockIdx.x);
          EpiQup E{(bf16_t*)(ws + WS_QN), (bf16_t*)(ws + WS_QR), ssq_q, rope};
          pg8::gemm_phase<EpiQup, pg8::StaticOrder, PG8_ALIGN, PG8_SP2>(F.lds + RING_OFF, g, S, E); }
        { pg8::Gemm g{(const bf16_t*)(ws + WS_CKV), (const bf16_t*)(ws + WS_WUKV), T, 2048, 512, 512}; pg8::StaticOrder S; S.init(T, 2048, F.G, (int)blockIdx.x);
          EpiKVup E{(bf16_t*)(ws + WS_KN), (bf16_t*)(ws + WS_V), ssq_kv};
          pg8::gemm_phase<EpiKVup, pg8::StaticOrder, PG8_ALIGN, PG8_SP2>(F.lds + RING_OFF, g, S, E); }
        if (BOTH(2)) GRID_BAR();
    }
    PSTAMP(3);
#ifdef ATT_REF
    if (IN(3)) { p3_attention_ref(F, I); if (BOTH(3)) GRID_BAR(); }
#else
    if (IN(3)) { p3_attention(F, I); if (BOTH(3)) GRID_BAR(); }
#ifdef ATT_CHECK
    if (IN(3)) { p3_attention_ref(F, I); GRID_BAR(); }
#endif
#endif
    PSTAMP(4);
    if (IN(4)) {
        pg8::Gemm2 g{(const bf16_t*)(ws + WS_OM), (const bf16_t*)(ws + WS_OD), (const bf16_t*)(ws + WS_WOM), (const bf16_t*)(ws + WS_WOD), T, 2048, 1024, 1024};
        pg8::StaticOrder S; S.init(T, 2048, F.G, (int)blockIdx.x);
        EpiGate2 E{(const bf16_t*)(ws + WS_G), (bf16_t*)(ws + WS_MG)};
        pg8::gemm_phase2<EpiGate2, pg8::StaticOrder, PG8_ALIGN, PG8_SP2>(F.lds + RING_OFF, g, S, E);
        if (BOTH(4)) GRID_BAR();
    }
    PSTAMP(5);
    PSTAMP(6);
    if (IN(6)) {
#ifdef PEER_BF16
        convert_experts(F, I);
#else
#ifdef PEER_FP6
        convert_experts_fp6(F, I);
#else
        convert_experts_fp8(F, I);
#endif
#endif
        pg8::Gemm g{(const bf16_t*)(ws + WS_MG), (const bf16_t*)(ws + WS_WOUT), T, 2048, 2048, 2048}; pg8::StaticOrder S; S.init(T, 2048, F.G, (int)blockIdx.x);
        EpiRes E{I.x, (float*)(ws + WS_X2), (bf16_t*)(ws + WS_X2B), ssq2};
        pg8::gemm_phase<EpiRes, pg8::StaticOrder, PG8_ALIGN, PG8_SP2>(F.lds + RING_OFF, g, S, E);
        if (BOTH(6)) GRID_BAR();
    }
    PSTAMP(7);
    if (IN(7)) {
        pg8::Gemm g{(const bf16_t*)(ws + WS_X2B), (const bf16_t*)(ws + WS_WQP), T, 2048, 2048, 2048}; pg8::StaticOrder S; S.init(T, 2048, F.G, (int)blockIdx.x);
        EpiQP E{(bf16_t*)(ws + WS_QP), ssq2, (const LAS float*)(F.lds + RTAB_OFF), {-1, -1, -1, -1}};
        {
            LAS float* tab = (LAS float*)(F.lds + RTAB_OFF); pg8::Unit u;
#pragma unroll
            for (int i = 0; i < RTAB_SLOTS; ++i) {
                if (S.next(i, u)) {
                    E.pms[i] = u.pm;
                    const int r = F.tid >> 1, hf = F.tid & 1; const float* p = ssq2 + ((size_t)u.pm * 256 + r) * 32 + hf * 16;
                    const f32x4 q0 = *(const f32x4*)p, q1 = *(const f32x4*)(p + 4), q2 = *(const f32x4*)(p + 8), q3 = *(const f32x4*)(p + 12);
                    float t = (((q0[0] + q0[1]) + (q0[2] + q0[3])) + ((q1[0] + q1[1]) + (q1[2] + q1[3]))) + (((q2[0] + q2[1]) + (q2[2] + q2[3])) + ((q3[0] + q3[1]) + (q3[2] + q3[3])));
                    t += __shfl_xor(t, 1);
                    if (hf == 0) tab[i * 256 + r] = 1.0f / sqrtf(t * (1.0f / 2048.0f) + EPS);
                }
            }
            __syncthreads();
        }
        pg8::gemm_phase<EpiQP, pg8::StaticOrder, PG8_ALIGN, PG8_SP2>(F.lds + RING_OFF, g, S, E);
        if (BOTH(7)) GRID_BAR();
    }
    PSTAMP(8);
#if defined(ROUTE_REF) || defined(PEER_BF16) || defined(NO_FUSE89)
#ifdef ROUTE_REF
    if (IN(8)) { p7_routing_ref(F); if (BOTH(8)) GRID_BAR(); }
#else
    if (IN(8)) { p8_routing(F, I); if (BOTH(8)) GRID_BAR(); }
#endif
    PSTAMP(9);
#ifdef PEER_BF16
    if (IN(9)) { p8_gather(F, I, args.out); }
#else
    if (IN(9)) { p9_gather_fp8(F, I, args.out); }
#endif
#else
    if (IN(8) && IN(9)) { p89_route_gather(F, I, args.out); }
    PSTAMP(9);
#endif
    PSTAMP(10);
#ifdef PROBE_PH
    if (blockIdx.x == 0 && F.tid == 0) {
        const unsigned long long span = (pstamp[PROBE_PH + 1] - pstamp[PROBE_PH]) * PROBE_MUL, t0 = __builtin_amdgcn_s_memrealtime();
        while (__builtin_amdgcn_s_memrealtime() - t0 < span) __builtin_amdgcn_s_sleep(32);
    }
#endif
#undef IN
#undef BOTH
}

extern "C" void kernel_launch(void* const* d_in, const int* in_sizes, int n_in, void* d_out, int out_size, void* d_ws, size_t ws_size, hipStream_t stream) {
    static int grid = 0;
    if (grid == 0) {
        if (n_in != 19 || out_size != T * D_MODEL || ws_size < WS_END) { fprintf(stderr, "kernel_launch: unexpected shapes: n_in %d out %d ws %zu\n", n_in, out_size, ws_size); grid = -1; return; }
        int dev = 0, cus = 0, per_cu = 0;
        if (hipGetDevice(&dev) != hipSuccess || hipDeviceGetAttribute(&cus, hipDeviceAttributeMultiprocessorCount, dev) != hipSuccess) { grid = -1; return; }
        if (hipFuncSetAttribute((const void*)mega_fwd, hipFuncAttributeMaxDynamicSharedMemorySize, LDS_BYTES) != hipSuccess) { fprintf(stderr, "kernel_launch: hipFuncSetAttribute failed\n"); grid = -1; return; }
        if (hipOccupancyMaxActiveBlocksPerMultiprocessor(&per_cu, (const void*)mega_fwd, NWAVES * 64, LDS_BYTES) != hipSuccess || per_cu < 1)
            fprintf(stderr, "kernel_launch: occupancy query reports %d workgroups per CU\n", per_cu);
        (void)hipGetLastError();
        grid = cus;
    }
    if (grid < 0) return;
    if (hipMemsetAsync((char*)d_ws + WS_CTL, 0, CTL_ZERO_BYTES, stream) != hipSuccess) { fprintf(stderr, "kernel_launch: memset failed\n"); return; }
    Args a{};
    const float** ip = (const float**)&a.in;
    for (int i = 0; i < 19; ++i) ip[i] = (const float*)d_in[i];
    a.out = (float*)d_out; a.ws = (unsigned char*)d_ws;
    for (int i = 0; i < 32; ++i) a.inv_freq[i] = pow(10000.0, -(double)i / 32.0);
#if MK_N_LAUNCHES == 1
    a.ph_lo = 0; a.ph_hi = NPHASE;
    hipLaunchKernelGGL(mega_fwd, dim3(grid), dim3(NWAVES * 64), LDS_BYTES, stream, a);
#else
    for (int p = 0; p < NPHASE; ++p) { a.ph_lo = p; a.ph_hi = p + 1; hipLaunchKernelGGL(mega_fwd, dim3(grid), dim3(NWAVES * 64), LDS_BYTES, stream, a); }
#endif
    const hipError_t le = hipPeekAtLastError();
    if (le != hipSuccess) fprintf(stderr, "kernel_launch: launch failed: %s\n", hipGetErrorName(le));
}
```

```cpp
#include <hip/hip_runtime.h>
#include <cstdio>
#include <cstdint>
#include <cmath>

#ifndef MK_N_LAUNCHES
#define MK_N_LAUNCHES 1
#endif

constexpr int D_MODEL = 2048, BATCH = 2, SEQ = 8192, T = BATCH * SEQ;
constexpr int OFF_CQ = 0, OFF_CKV = 768, OFF_KR = 1280, OFF_DQ = 1344, OFF_DK = 2368, OFF_DV = 3392, OFF_GATE = 4416, IN_COLS = 8512;
constexpr int N1 = 3072;
constexpr int NG = 5632;
constexpr float W1_SCALE = 32.0f;
constexpr int NEXP = 16384;
constexpr float EPS = 1e-6f;
constexpr float LOG2E = 1.4426950408889634f;
constexpr float C2_MLA = 0.07216878364870322f * LOG2E;
constexpr float C2_DIFF = 0.125f * LOG2E;
constexpr float LAMBDA_INIT = 0.2f;

namespace pg8 {
#define PG8_LAS __attribute__((address_space(3)))
typedef unsigned short bf16_t;
typedef short bf16x8 __attribute__((ext_vector_type(8)));
typedef float f32x4 __attribute__((ext_vector_type(4)));
typedef unsigned u32x4 __attribute__((ext_vector_type(4)));
typedef unsigned u32x2 __attribute__((ext_vector_type(2)));
typedef int v8i32 __attribute__((ext_vector_type(8)));
constexpr int BM = 256, BK = 64, HALF = 128, HTB = HALF * BK * 2, STAGE_BYTES = 8 * HTB, NXCD = 8, WGM = 8;

__host__ __device__ __forceinline__ int lds_byte(int r, int c) { const int st = (r >> 4) * 2 + (c >> 5), rr = r & 15, cc = c & 31, ob = rr * 64 + cc * 2; return st * 1024 + (ob ^ (((ob >> 9) & 1) << 5)); }
__host__ __device__ __forceinline__ void stage_rc(int b, int& R, int& C) { const int st = b / 1024, sb = b % 1024, swz = sb ^ (((sb >> 9) & 1) << 5); R = (st >> 1) * 16 + swz / 64; C = (st & 1) * 32 + (swz % 64) / 2; }
__host__ __device__ __forceinline__ int perm32(int rho) { const int n = rho >> 4, i = rho & 15; return 8 * (i >> 2) + 4 * n + (i & 3); }

struct Unit { int pm, pn; };
struct Gemm { const bf16_t* A; const bf16_t* Bt; int M, N, K, lda; float oscale; };

struct StaticOrder {
    int nM, nN, nwg, G, c;
    __host__ __device__ void init(int M, int N, int G_, int c_) { nM = M / BM; nN = N / BM; nwg = nM * nN; G = G_; c = c_; }
    __host__ __device__ bool next(int i, Unit& u) const { return map((long)i * G + c, u); }
    __host__ __device__ bool map(long L, Unit& u) const {
        if (L >= nwg) return false;
        int wgid = (int)L; { const int q = nwg / NXCD, r = nwg % NXCD, xcd = wgid % NXCD, off = wgid / NXCD; wgid = (xcd < r ? xcd * (q + 1) : r * (q + 1) + (xcd - r) * q) + off; }
        const int nig = WGM * nN, gid = wgid / nig, fm = gid * WGM, gsz = (nM - fm) < WGM ? (nM - fm) : WGM;
        u.pm = fm + ((wgid % nig) % gsz); u.pn = (wgid % nig) / gsz; return true;
    }
    __device__ __forceinline__ void a_ready(const Unit&) const {}
    __device__ __forceinline__ void done(const Unit&) const {}
};

struct GateOrder : StaticOrder {
    __host__ __device__ bool next(int i, Unit& u) const {
        if (G != 256 || nwg != 1024) return StaticOrder::next(i, u);
        if (i < 3) return map((long)i * 256 + c, u);
        if (c >= 128 && i < 5) return map(768 + (long)(i - 3) * 128 + (c - 128), u);
        return false;
    }
};
typedef float f32x2_t __attribute__((ext_vector_type(2))); typedef __bf16 bf16x2_t __attribute__((ext_vector_type(2)));
__device__ __forceinline__ unsigned cvtpk(float lo, float hi) { f32x2_t v = {lo, hi}; bf16x2_t b = __builtin_convertvector(v, bf16x2_t); return __builtin_bit_cast(unsigned, b); }
__device__ __forceinline__ float bf2f(unsigned short h) { return __builtin_bit_cast(float, (unsigned)h << 16); }
__device__ __forceinline__ float bflo(unsigned w) { return __builtin_bit_cast(float, w << 16); }
__device__ __forceinline__ float bfhi(unsigned w) { return __builtin_bit_cast(float, w & 0xffff0000u); }

template <class Epi, class Sched, bool ALIGN_EPI = false, bool SP2 = false, bool FP8 = false>
__device__ __forceinline__ void gemm_phase(PG8_LAS unsigned char* lds, const Gemm g, const Sched& S, const Epi& E) {
    const int tid = threadIdx.x, wid = __builtin_amdgcn_readfirstlane(tid >> 6), lane = tid & 63, wr = wid >> 2, wc = wid & 3, fr = lane & 15, fq = lane >> 4;
    const int K = g.K, nt = K / BK, lda = g.lda;
    unsigned voffA[2], voffB[2];
#pragma unroll
    for (int i = 0; i < 2; ++i) { int R, C; stage_rc(tid * 16 + i * 8192, R, C); const int Rb = Epi::PERM ? ((R & ~31) + perm32(R & 31)) : R;
        voffA[i] = (unsigned)(R * lda + C) * 2u; voffB[i] = (unsigned)(Rb * K + C) * 2u; }
    const size_t kstep = (size_t)(BK * 2);
    const size_t hstepA = (size_t)HALF * lda * 2, hstepB = (size_t)HALF * K * 2;
    const size_t tstepA = 2 * hstepA, tstepB = 2 * hstepB;
    const unsigned ldsw = (unsigned)wid * 1024u;
    const int aoff = lds_byte(wr * 64 + fr, fq * 8), boff = lds_byte(wc * 32 + fr, fq * 8);
    const int aoff8 = lds_byte(wr * 64 + fr, 16 * fq) & ~31, boff8 = lds_byte(wc * 32 + fr, 16 * fq) & ~31;
#define PG8_SA(b, h) (((b) * 2 + (h)) * HTB)
#define PG8_SB(b, h) ((4 + (b) * 2 + (h)) * HTB)
#define PG8_STAGE(bufoff, gbase, voff) do { _Pragma("unroll") for (int _i = 0; _i < 2; ++_i) \
        __builtin_amdgcn_global_load_lds((const unsigned*)((const char*)(gbase) + (voff)[_i]), (PG8_LAS unsigned*)(lds + (bufoff) + ldsw + _i * 8192), 16, 0, 0); } while (0)
#define PG8_LDA(dst, b, h) do { _Pragma("unroll") for (int m = 0; m < 4; ++m) _Pragma("unroll") for (int k = 0; k < 2; ++k) { if constexpr (FP8) { if (k == 0) dst##8[m] = *(const PG8_LAS v8i32*)(lds + PG8_SA(b, h) + aoff8 + m * 2048); } else dst[m][k] = *(const PG8_LAS bf16x8*)(lds + PG8_SA(b, h) + aoff + m * 2048 + k * 1024); } } while (0)
#define PG8_LDB(dst, b, h) do { _Pragma("unroll") for (int n = 0; n < 2; ++n) _Pragma("unroll") for (int k = 0; k < 2; ++k) { if constexpr (FP8) { if (k == 0) dst##8[n] = *(const PG8_LAS v8i32*)(lds + PG8_SB(b, h) + boff8 + n * 2048); } else dst[n][k] = *(const PG8_LAS bf16x8*)(lds + PG8_SB(b, h) + boff + n * 2048 + k * 1024); } } while (0)
#define PG8_MMA(ai, bj, At, Bt) do { __builtin_amdgcn_s_setprio(1); _Pragma("unroll") for (int m = 0; m < 4; ++m) _Pragma("unroll") for (int n = 0; n < 2; ++n) { if constexpr (FP8) { \
        asm volatile("v_mfma_scale_f32_16x16x128_f8f6f4 %0, %1, %2, %0, %3, %3 op_sel_hi:[0,0,0]" : "+v"(acc[ai][bj][m][n]) : "v"(Bt##8[n]), "v"(At##8[m]), "v"(mxs));   \
        } else { _Pragma("unroll") for (int k = 0; k < 2; ++k) \
        acc[ai][bj][m][n] = __builtin_amdgcn_mfma_f32_16x16x32_bf16(Bt[n][k], At[m][k], acc[ai][bj][m][n], 0, 0, 0); } } __builtin_amdgcn_s_setprio(0); } while (0)
#define PG8_WAIT_V(n) asm volatile("s_waitcnt vmcnt(" #n ")" ::: "memory")
#define PG8_WAIT_L(n) asm volatile("s_waitcnt lgkmcnt(" #n ")" ::: "memory")
#define PG8_BAR __builtin_amdgcn_s_barrier()
#define PG8_SCHED __builtin_amdgcn_sched_barrier(0)
    Unit cur, nxt; int ui = 0;
    if (!S.next(0, cur)) return;
    f32x4 acc[2][2][4][2];
#pragma unroll
    for (int a = 0; a < 2; ++a)
#pragma unroll
        for (int b = 0; b < 2; ++b)
#pragma unroll
            for (int m = 0; m < 4; ++m)
#pragma unroll
                for (int n = 0; n < 2; ++n) acc[a][b][m][n] = (f32x4){0.f, 0.f, 0.f, 0.f};
    bf16x8 At[4][2], B0[2][2], B1[2][2];
    v8i32 At8[4], B08[2], B18[2];
    const int mxs = 0x7F7F7F7F;
    const char* cA = (const char*)g.A + (size_t)cur.pm * tstepA; const char* cB = (const char*)g.Bt + (size_t)cur.pn * tstepB;
    S.a_ready(cur);
    if constexpr (SP2) {
        PG8_STAGE(PG8_SB(0, 0), cB, voffB); PG8_STAGE(PG8_SB(0, 1), cB + hstepB, voffB); PG8_STAGE(PG8_SA(0, 0), cA, voffA); PG8_STAGE(PG8_SA(0, 1), cA + hstepA, voffA);
        if (wr == 1) PG8_BAR;
        PG8_WAIT_V(2); PG8_BAR;
        PG8_STAGE(PG8_SB(1, 0), cB + kstep, voffB); PG8_STAGE(PG8_SA(1, 0), cA + kstep, voffA); PG8_STAGE(PG8_SB(1, 1), cB + hstepB + kstep, voffB);
        PG8_WAIT_V(6); PG8_BAR;
    } else {
        PG8_STAGE(PG8_SB(0, 0), cB, voffB); PG8_STAGE(PG8_SA(0, 0), cA, voffA); PG8_STAGE(PG8_SB(0, 1), cB + hstepB, voffB); PG8_STAGE(PG8_SA(0, 1), cA + hstepA, voffA);
        if (wr == 1) PG8_BAR;
        PG8_WAIT_V(4); PG8_BAR;
        PG8_STAGE(PG8_SB(1, 0), cB + kstep, voffB); PG8_STAGE(PG8_SA(1, 0), cA + kstep, voffA); PG8_STAGE(PG8_SB(1, 1), cB + hstepB + kstep, voffB);
        PG8_WAIT_V(6); PG8_BAR;
    }
    for (;;) {
        const bool has_next = S.next(ui + 1, nxt);
        const char* nA = has_next ? (const char*)g.A + (size_t)nxt.pm * tstepA : cA; const char* nB = has_next ? (const char*)g.Bt + (size_t)nxt.pn * tstepB : cB;
        for (int t = 0; t < nt; t += 2) {
            const bool last = (t == nt - 2);
            const char* a1 = cA + (size_t)(t + 1) * kstep;
            const char* a2 = last ? nA : cA + (size_t)(t + 2) * kstep; const char* b2 = last ? nB : cB + (size_t)(t + 2) * kstep;
            const char* a3 = a2 + kstep; const char* b3 = b2 + kstep;
            if (last && has_next) S.a_ready(nxt);
            if constexpr (SP2) {
            PG8_LDB(B0, 0, 0); PG8_LDB(B1, 0, 1); PG8_SCHED; PG8_LDA(At, 0, 0); PG8_STAGE(PG8_SA(1, 1), a1 + hstepA, voffA);
            PG8_WAIT_V(8); PG8_WAIT_L(0); PG8_BAR; PG8_MMA(0, 0, At, B0); PG8_MMA(0, 1, At, B1); PG8_BAR; PG8_SCHED;
            PG8_LDA(At, 0, 1); PG8_STAGE(PG8_SB(0, 0), b2, voffB); PG8_STAGE(PG8_SB(0, 1), b2 + hstepB, voffB); PG8_STAGE(PG8_SA(0, 0), a2, voffA);
            PG8_WAIT_V(8); PG8_WAIT_L(0); PG8_BAR; PG8_MMA(1, 0, At, B0); PG8_MMA(1, 1, At, B1); PG8_BAR; PG8_SCHED;
            PG8_LDB(B0, 1, 0); PG8_LDB(B1, 1, 1); PG8_SCHED; PG8_LDA(At, 1, 0); PG8_STAGE(PG8_SA(0, 1), a2 + hstepA, voffA);
            PG8_WAIT_V(8); PG8_WAIT_L(0); PG8_BAR; PG8_MMA(0, 0, At, B0); PG8_MMA(0, 1, At, B1); PG8_BAR; PG8_SCHED;
            PG8_LDA(At, 1, 1); PG8_STAGE(PG8_SB(1, 0), b3, voffB); PG8_STAGE(PG8_SB(1, 1), b3 + hstepB, voffB); PG8_STAGE(PG8_SA(1, 0), a3, voffA);
            PG8_WAIT_V(8); PG8_WAIT_L(0); PG8_BAR; PG8_MMA(1, 0, At, B0); PG8_MMA(1, 1, At, B1); PG8_BAR; PG8_SCHED;
            } else {
            PG8_LDB(B0, 0, 0); PG8_SCHED; PG8_LDA(At, 0, 0); PG8_STAGE(PG8_SA(1, 1), a1 + hstepA, voffA);
            PG8_WAIT_L(8); PG8_BAR; PG8_WAIT_L(0); PG8_MMA(0, 0, At, B0); PG8_BAR; PG8_SCHED;
            PG8_LDB(B1, 0, 1); PG8_STAGE(PG8_SB(0, 0), b2, voffB);
            PG8_BAR; PG8_WAIT_L(0); PG8_MMA(0, 1, At, B1); PG8_BAR;
            PG8_LDA(At, 0, 1); PG8_STAGE(PG8_SA(0, 0), a2, voffA);
            PG8_BAR; PG8_WAIT_L(0); PG8_MMA(1, 0, At, B0); PG8_BAR; PG8_SCHED;
            PG8_STAGE(PG8_SB(0, 1), b2 + hstepB, voffB);
            PG8_WAIT_V(6); PG8_BAR; PG8_MMA(1, 1, At, B1); PG8_BAR;
            PG8_LDB(B0, 1, 0); PG8_SCHED; PG8_LDA(At, 1, 0); PG8_STAGE(PG8_SA(0, 1), a2 + hstepA, voffA);
            PG8_WAIT_L(8); PG8_BAR; PG8_WAIT_L(0); PG8_MMA(0, 0, At, B0); PG8_BAR; PG8_SCHED;
            PG8_LDB(B1, 1, 1); PG8_STAGE(PG8_SB(1, 0), b3, voffB);
            PG8_BAR; PG8_WAIT_L(0); PG8_MMA(0, 1, At, B1); PG8_BAR;
            PG8_LDA(At, 1, 1); PG8_STAGE(PG8_SA(1, 0), a3, voffA);
            PG8_BAR; PG8_WAIT_L(0); PG8_MMA(1, 0, At, B0); PG8_BAR; PG8_SCHED;
            PG8_STAGE(PG8_SB(1, 1), b3 + hstepB, voffB);
            PG8_WAIT_V(6); PG8_BAR; PG8_MMA(1, 1, At, B1); PG8_BAR;
            }
        }
        if constexpr (ALIGN_EPI) { if (wr == 0) PG8_BAR; }
        if constexpr (FP8) {
            asm volatile("s_nop 15\n\ts_nop 7" ::: "memory");
#pragma unroll
            for (int a = 0; a < 2; ++a)
#pragma unroll
                for (int b = 0; b < 2; ++b)
#pragma unroll
                    for (int m = 0; m < 4; ++m)
#pragma unroll
                        for (int n = 0; n < 2; ++n) acc[a][b][m][n] *= g.oscale; }
        E(acc, cur, wr, wc, fr, fq); S.done(cur);
        if (!has_next) break;
#pragma unroll
        for (int a = 0; a < 2; ++a)
#pragma unroll
            for (int b = 0; b < 2; ++b)
#pragma unroll
                for (int m = 0; m < 4; ++m)
#pragma unroll
                    for (int n = 0; n < 2; ++n) acc[a][b][m][n] = (f32x4){0.f, 0.f, 0.f, 0.f};
        cur = nxt; cA = nA; cB = nB; ++ui;
        if constexpr (ALIGN_EPI) { if (wr == 1) PG8_BAR; }
    }
    PG8_WAIT_V(0);
    if constexpr (!ALIGN_EPI) { if (wr == 0) PG8_BAR; }
    PG8_BAR;
#undef PG8_SA
#undef PG8_SB
#undef PG8_STAGE
#undef PG8_LDA
#undef PG8_LDB
#undef PG8_MMA
#undef PG8_WAIT_V
#undef PG8_WAIT_L
#undef PG8_BAR
#undef PG8_SCHED
}
struct Gemm2 { const bf16_t *A1, *A2, *B1, *B2; int M, N, K1, lda; };
template <class Epi, class Sched, bool ALIGN_EPI = false, bool SP2 = false>
__device__ __forceinline__ void gemm_phase2(PG8_LAS unsigned char* lds, const Gemm2 g, const Sched& S, const Epi& E) {
    const int tid = threadIdx.x, wid = __builtin_amdgcn_readfirstlane(tid >> 6), lane = tid & 63, wr = wid >> 2, wc = wid & 3, fr = lane & 15, fq = lane >> 4;
    const int K = g.K1, nt = K / BK, lda = g.lda;
    unsigned voffA[2], voffB[2];
#pragma unroll
    for (int i = 0; i < 2; ++i) { int R, C; stage_rc(tid * 16 + i * 8192, R, C); const int Rb = Epi::PERM ? ((R & ~31) + perm32(R & 31)) : R;
        voffA[i] = (unsigned)(R * lda + C) * 2u; voffB[i] = (unsigned)(Rb * K + C) * 2u; }
    const size_t kstep = (size_t)(BK * 2);
    const size_t hstepA = (size_t)HALF * lda * 2, hstepB = (size_t)HALF * K * 2;
    const size_t tstepA = 2 * hstepA, tstepB = 2 * hstepB;
    const unsigned ldsw = (unsigned)wid * 1024u;
    const int aoff = lds_byte(wr * 64 + fr, fq * 8), boff = lds_byte(wc * 32 + fr, fq * 8);
#define PG8_SA(b, h) (((b) * 2 + (h)) * HTB)
#define PG8_SB(b, h) ((4 + (b) * 2 + (h)) * HTB)
#define PG8_STAGE(bufoff, gbase, voff) do { _Pragma("unroll") for (int _i = 0; _i < 2; ++_i) \
        __builtin_amdgcn_global_load_lds((const unsigned*)((const char*)(gbase) + (voff)[_i]), (PG8_LAS unsigned*)(lds + (bufoff) + ldsw + _i * 8192), 16, 0, 0); } while (0)
#define PG8_LDA(dst, b, h) do { _Pragma("unroll") for (int m = 0; m < 4; ++m) _Pragma("unroll") for (int k = 0; k < 2; ++k) dst[m][k] = *(const PG8_LAS bf16x8*)(lds + PG8_SA(b, h) + aoff + m * 2048 + k * 1024); } while (0)
#define PG8_LDB(dst, b, h) do { _Pragma("unroll") for (int n = 0; n < 2; ++n) _Pragma("unroll") for (int k = 0; k < 2; ++k) dst[n][k] = *(const PG8_LAS bf16x8*)(lds + PG8_SB(b, h) + boff + n * 2048 + k * 1024); } while (0)
#define PG8_MMA(ai, bj, At, Bt) do { __builtin_amdgcn_s_setprio(1); _Pragma("unroll") for (int m = 0; m < 4; ++m) _Pragma("unroll") for (int n = 0; n < 2; ++n) _Pragma("unroll") for (int k = 0; k < 2; ++k) \
        acc[ai][bj][m][n] = __builtin_amdgcn_mfma_f32_16x16x32_bf16(Bt[n][k], At[m][k], acc[ai][bj][m][n], 0, 0, 0); __builtin_amdgcn_s_setprio(0); } while (0)
#define PG8_WAIT_V(n) asm volatile("s_waitcnt vmcnt(" #n ")" ::: "memory")
#define PG8_WAIT_L(n) asm volatile("s_waitcnt lgkmcnt(" #n ")" ::: "memory")
#define PG8_BAR __builtin_amdgcn_s_barrier()
#define PG8_SCHED __builtin_amdgcn_sched_barrier(0)
    Unit cur, nxt; int ui = 0;
    if (!S.next(0, cur)) return;
    f32x4 acc[2][2][4][2];
#pragma unroll
    for (int a = 0; a < 2; ++a)
#pragma unroll
        for (int b = 0; b < 2; ++b)
#pragma unroll
            for (int m = 0; m < 4; ++m)
#pragma unroll
                for (int n = 0; n < 2; ++n) acc[a][b][m][n] = (f32x4){0.f, 0.f, 0.f, 0.f};
    bf16x8 At[4][2], B0[2][2], B1[2][2];
    const char* cA = (const char*)g.A1 + (size_t)cur.pm * tstepA; const char* cB = (const char*)g.B1 + (size_t)cur.pn * tstepB;
    S.a_ready(cur);
    if constexpr (SP2) {
        PG8_STAGE(PG8_SB(0, 0), cB, voffB); PG8_STAGE(PG8_SB(0, 1), cB + hstepB, voffB); PG8_STAGE(PG8_SA(0, 0), cA, voffA); PG8_STAGE(PG8_SA(0, 1), cA + hstepA, voffA);
        if (wr == 1) PG8_BAR;
        PG8_WAIT_V(2); PG8_BAR;
        PG8_STAGE(PG8_SB(1, 0), cB + kstep, voffB); PG8_STAGE(PG8_SA(1, 0), cA + kstep, voffA); PG8_STAGE(PG8_SB(1, 1), cB + hstepB + kstep, voffB);
        PG8_WAIT_V(6); PG8_BAR;
    } else {
        PG8_STAGE(PG8_SB(0, 0), cB, voffB); PG8_STAGE(PG8_SA(0, 0), cA, voffA); PG8_STAGE(PG8_SB(0, 1), cB + hstepB, voffB); PG8_STAGE(PG8_SA(0, 1), cA + hstepA, voffA);
        if (wr == 1) PG8_BAR;
        PG8_WAIT_V(4); PG8_BAR;
        PG8_STAGE(PG8_SB(1, 0), cB + kstep, voffB); PG8_STAGE(PG8_SA(1, 0), cA + kstep, voffA); PG8_STAGE(PG8_SB(1, 1), cB + hstepB + kstep, voffB);
        PG8_WAIT_V(6); PG8_BAR;
    }
    for (;;) {
        const int nhalf = (ui + 1) & 1;
        const bool has_next = S.next((ui + 1) >> 1, nxt);
        const char* nA = has_next ? (const char*)(nhalf ? g.A2 : g.A1) + (size_t)nxt.pm * tstepA : cA; const char* nB = has_next ? (const char*)(nhalf ? g.B2 : g.B1) + (size_t)nxt.pn * tstepB : cB;
        for (int t = 0; t < nt; t += 2) {
            const bool last = (t == nt - 2);
            const char* a1 = cA + (size_t)(t + 1) * kstep;
            const char* a2 = last ? nA : cA + (size_t)(t + 2) * kstep; const char* b2 = last ? nB : cB + (size_t)(t + 2) * kstep;
            const char* a3 = a2 + kstep; const char* b3 = b2 + kstep;
            if (last && has_next) S.a_ready(nxt);
            if constexpr (SP2) {
            PG8_LDB(B0, 0, 0); PG8_LDB(B1, 0, 1); PG8_SCHED; PG8_LDA(At, 0, 0); PG8_STAGE(PG8_SA(1, 1), a1 + hstepA, voffA);
            PG8_WAIT_V(8); PG8_WAIT_L(0); PG8_BAR; PG8_MMA(0, 0, At, B0); PG8_MMA(0, 1, At, B1); PG8_BAR; PG8_SCHED;
            PG8_LDA(At, 0, 1); PG8_STAGE(PG8_SB(0, 0), b2, voffB); PG8_STAGE(PG8_SB(0, 1), b2 + hstepB, voffB); PG8_STAGE(PG8_SA(0, 0), a2, voffA);
            PG8_WAIT_V(8); PG8_WAIT_L(0); PG8_BAR; PG8_MMA(1, 0, At, B0); PG8_MMA(1, 1, At, B1); PG8_BAR; PG8_SCHED;
            PG8_LDB(B0, 1, 0); PG8_LDB(B1, 1, 1); PG8_SCHED; PG8_LDA(At, 1, 0); PG8_STAGE(PG8_SA(0, 1), a2 + hstepA, voffA);
            PG8_WAIT_V(8); PG8_WAIT_L(0); PG8_BAR; PG8_MMA(0, 0, At, B0); PG8_MMA(0, 1, At, B1); PG8_BAR; PG8_SCHED;
            PG8_LDA(At, 1, 1); PG8_STAGE(PG8_SB(1, 0), b3, voffB); PG8_STAGE(PG8_SB(1, 1), b3 + hstepB, voffB); PG8_STAGE(PG8_SA(1, 0), a3, voffA);
            PG8_WAIT_V(8); PG8_WAIT_L(0); PG8_BAR; PG8_MMA(1, 0, At, B0); PG8_MMA(1, 1, At, B1); PG8_BAR; PG8_SCHED;
            } else {
            PG8_LDB(B0, 0, 0); PG8_SCHED; PG8_LDA(At, 0, 0); PG8_STAGE(PG8_SA(1, 1), a1 + hstepA, voffA);
            PG8_WAIT_L(8); PG8_BAR; PG8_WAIT_L(0); PG8_MMA(0, 0, At, B0); PG8_BAR; PG8_SCHED;
            PG8_LDB(B1, 0, 1); PG8_STAGE(PG8_SB(0, 0), b2, voffB);
            PG8_BAR; PG8_WAIT_L(0); PG8_MMA(0, 1, At, B1); PG8_BAR;
            PG8_LDA(At, 0, 1); PG8_STAGE(PG8_SA(0, 0), a2, voffA);
            PG8_BAR; PG8_WAIT_L(0); PG8_MMA(1, 0, At, B0); PG8_BAR; PG8_SCHED;
            PG8_STAGE(PG8_SB(0, 1), b2 + hstepB, voffB);
            PG8_WAIT_V(6); PG8_BAR; PG8_MMA(1, 1, At, B1); PG8_BAR;
            PG8_LDB(B0, 1, 0); PG8_SCHED; PG8_LDA(At, 1, 0); PG8_STAGE(PG8_SA(0, 1), a2 + hstepA, voffA);
            PG8_WAIT_L(8); PG8_BAR; PG8_WAIT_L(0); PG8_MMA(0, 0, At, B0); PG8_BAR; PG8_SCHED;
            PG8_LDB(B1, 1, 1); PG8_STAGE(PG8_SB(1, 0), b3, voffB);
            PG8_BAR; PG8_WAIT_L(0); PG8_MMA(0, 1, At, B1); PG8_BAR;
            PG8_LDA(At, 1, 1); PG8_STAGE(PG8_SA(1, 0), a3, voffA);
            PG8_BAR; PG8_WAIT_L(0); PG8_MMA(1, 0, At, B0); PG8_BAR; PG8_SCHED;
            PG8_STAGE(PG8_SB(1, 1), b3 + hstepB, voffB);
            PG8_WAIT_V(6); PG8_BAR; PG8_MMA(1, 1, At, B1); PG8_BAR;
            }
        }
        if constexpr (ALIGN_EPI) { if (wr == 0) PG8_BAR; }
        if ((ui & 1) == 0) E.mid(acc, cur, wr, wc, fr, fq); else { E(acc, cur, wr, wc, fr, fq); S.done(cur); }
        if (!has_next) break;
        if (ui & 1)
#pragma unroll
        for (int a = 0; a < 2; ++a)
#pragma unroll
            for (int b = 0; b < 2; ++b)
#pragma unroll
                for (int m = 0; m < 4; ++m)
#pragma unroll
                    for (int n = 0; n < 2; ++n) acc[a][b][m][n] = (f32x4){0.f, 0.f, 0.f, 0.f};
        cur = nxt; cA = nA; cB = nB; ++ui;
        if constexpr (ALIGN_EPI) { if (wr == 1) PG8_BAR; }
    }
    PG8_WAIT_V(0);
    if constexpr (!ALIGN_EPI) { if (wr == 0) PG8_BAR; }
    PG8_BAR;
#undef PG8_SA
#undef PG8_SB
#undef PG8_STAGE
#undef PG8_LDA
#undef PG8_LDB
#undef PG8_MMA
#undef PG8_WAIT_V
#undef PG8_WAIT_L
#undef PG8_BAR
#undef PG8_SCHED
}
}

#ifndef PG8_SP2
#define PG8_SP2 true
#endif
#ifndef PG8_ALIGN
#define PG8_ALIGN true
#endif

using pg8::bf16_t; using pg8::f32x4; using pg8::u32x4; using pg8::u32x2; using pg8::cvtpk; using pg8::bf2f; using pg8::bflo; using pg8::bfhi;

constexpr size_t MiB = 1u << 20;
constexpr size_t WS_CTL = 0, CTL_ZERO_BYTES = 32 * 1024;
constexpr size_t WS_ROPE = 1 * MiB;
constexpr size_t WS_WUQ = 3 * MiB, WS_WUKV = 6 * MiB, WS_WOM = 8 * MiB, WS_WOD = 12 * MiB, WS_WOUT = 16 * MiB, WS_WQP = 24 * MiB;
constexpr size_t WS_SKB = 5 * MiB + 512 * 1024;
constexpr size_t WS_W1 = 32 * MiB;
constexpr size_t WS_W8 = 44 * MiB;
constexpr size_t WS_H8 = 396 * MiB;
constexpr size_t WS_H = 66 * MiB;
constexpr size_t WS_CQ = 130 * MiB, WS_CKV = 154 * MiB;
constexpr size_t WS_KR = 170 * MiB, WS_DQ = 172 * MiB, WS_DK = 204 * MiB, WS_DV = 236 * MiB;
constexpr size_t WS_G = 268 * MiB;
constexpr size_t WS_QN = 32 * MiB, WS_QR = 64 * MiB, WS_KN = 80 * MiB, WS_V = 396 * MiB;
constexpr size_t WS_OM = 112 * MiB, WS_OD = 428 * MiB;
constexpr size_t WS_TMP = 32 * MiB;
constexpr size_t WS_MG = 172 * MiB;
constexpr size_t WS_X2 = 268 * MiB;
constexpr size_t WS_X2B = 396 * MiB;
constexpr size_t WS_EU = 32 * MiB, WS_EV = 96 * MiB;
constexpr size_t WS_QP = 172 * MiB;
constexpr size_t WS_IDX = 236 * MiB, WS_GT = 244 * MiB;
constexpr size_t WS_PSQ_Q = 460 * MiB, WS_PSQ_KV = 461 * MiB, WS_PSQ2 = 462 * MiB;
constexpr size_t WS_END = 464 * MiB;
constexpr int CW_TMO = 0, CW_CODE = 1, CW_LAMBDA = 8, CW_TOKCTR = 64;
constexpr int CW_BAR = 4096;

constexpr int RING_OFF = 0, RING_BYTES = 131072;
constexpr int LDSCTL_OFF = RING_BYTES, MISC_OFF = LDSCTL_OFF + 320;
constexpr int LDS_BYTES = 147456;
constexpr int NWAVES = 8;

#define GAS __attribute__((address_space(1)))
#define LAS __attribute__((address_space(3)))
typedef unsigned short bf16;
typedef unsigned v4u __attribute__((ext_vector_type(4)));
typedef GAS unsigned gu32;
#define RLX_AGENT __ATOMIC_RELAXED, __HIP_MEMORY_SCOPE_AGENT
#define LDS_WAIT() asm volatile("s_waitcnt lgkmcnt(0)" ::: "memory")
#define VM_WAIT() asm volatile("s_waitcnt vmcnt(0)" ::: "memory")

#define XB_TMO      128
#define XB_XCNT(j)  (256  + 64 * (j))
#define XB_XSUB(j)  (1280 + 64 * (j))
#define XB_XGEN(j)  (2304 + 64 * (j))
#define XB_TOP      3328
#define XB_TOPGEN   3392
#define XCD_BAR_WORDS 3456
#define XB_SPIN_CAP (1u << 22)
__device__ __forceinline__ unsigned xb_ld(unsigned* p)              { return __hip_atomic_load(p, __ATOMIC_RELAXED, __HIP_MEMORY_SCOPE_AGENT); }
__device__ __forceinline__ unsigned xb_add(unsigned* p, unsigned v) { return __hip_atomic_fetch_add(p, v, __ATOMIC_RELAXED, __HIP_MEMORY_SCOPE_AGENT); }
__device__ __forceinline__ unsigned xb_xcc_id() { return (unsigned)__builtin_amdgcn_s_getreg((3 << 11) | 20) & 0xFu; }
#define XB_SPIN(cond, bar) do { unsigned _sp = 0; while (cond) { __builtin_amdgcn_s_sleep(1); \
    if ((++_sp & 255u) == 0u) { if (xb_ld(&(bar)[XB_TMO])) break; if (_sp > XB_SPIN_CAP) { atomicAdd(&(bar)[XB_TMO], 1u); break; } } } } while (0)
struct XcdBarrier { unsigned* bar; unsigned x; volatile LAS unsigned* st; };
__device__ __forceinline__ XcdBarrier xcd_barrier_post(unsigned* bar, volatile LAS unsigned* st) {
    XcdBarrier b; b.bar = bar; b.x = xb_xcc_id(); b.st = st;
    if (threadIdx.x == 0) (void)xb_add(&bar[XB_XCNT(b.x)], 1u);
    return b;
}
__device__ __forceinline__ void xcd_barrier_complete(unsigned* bar, unsigned x, unsigned& nloc, unsigned& nx) {
    const unsigned G = gridDim.x * gridDim.y * gridDim.z;
    unsigned sum, cnt, mine, sp = 0u;
    for (;;) {
        sum = 0u; cnt = 0u; mine = 0u;
#pragma unroll
        for (unsigned j = 0; j < 16; ++j) { const unsigned c = xb_ld(&bar[XB_XCNT(j)]); sum += c; cnt += (c > 0u) ? 1u : 0u; mine = (j == x) ? c : mine; }
        if (sum == G) break;
        __builtin_amdgcn_s_sleep(1);
        if ((++sp & 255u) == 0u) { if (xb_ld(&bar[XB_TMO])) break; if (sp > XB_SPIN_CAP) { atomicAdd(&bar[XB_TMO], 1u); break; } }
    }
    nloc = mine > 0u ? mine : 1u; nx = cnt > 0u ? cnt : 1u;
}
__device__ __forceinline__ void xcd_barrier(const XcdBarrier& b) {
    asm volatile("s_waitcnt vmcnt(0)" ::: "memory");
    __syncthreads();
    if (threadIdx.x == 0) {
        unsigned* bar = b.bar;
        __builtin_amdgcn_s_waitcnt(0);
        unsigned nloc = b.st[0], nx = b.st[1];
        if (nloc == 0u) { xcd_barrier_complete(bar, b.x, nloc, nx); b.st[0] = nloc; b.st[1] = nx; }
        const unsigned old = xb_add(&bar[XB_XSUB(b.x)], 1u);
        const unsigned gen = old / nloc;
        if (old + 1u == (gen + 1u) * nloc) {
            __builtin_amdgcn_fence(__ATOMIC_RELEASE, "agent");
            asm volatile("s_waitcnt vmcnt(0)" ::: "memory");
            const unsigned og = xb_add(&bar[XB_TOP], 1u);
            const unsigned tg = og / nx;
            if (og + 1u == (tg + 1u) * nx) xb_add(&bar[XB_TOPGEN], 1u);
            else XB_SPIN(xb_ld(&bar[XB_TOPGEN]) == tg, bar);
            __builtin_amdgcn_fence(__ATOMIC_ACQUIRE, "agent");
            xb_add(&bar[XB_XGEN(b.x)], 1u);
            asm volatile("s_waitcnt vmcnt(0)" ::: "memory");
        } else {
            XB_SPIN(xb_ld(&bar[XB_XGEN(b.x)]) == gen, bar);
            __builtin_amdgcn_fence(__ATOMIC_ACQUIRE, "agent");
            asm volatile("s_waitcnt vmcnt(0)" ::: "memory");
        }
    }
    __syncthreads();
}

struct Frame {
    LAS unsigned char* lds;
    volatile LAS unsigned* MISC;
    gu32* ctl;
    unsigned char* ws;
    int tid, lane, wave, vcu, G;
};

__device__ __forceinline__ float wave_sum(float v) {
#pragma unroll
    for (int o = 1; o < 64; o <<= 1) v += __shfl_xor(v, o);
    return v;
}
__device__ __forceinline__ float wave_max(float v) {
#pragma unroll
    for (int o = 1; o < 64; o <<= 1) v = fmaxf(v, __shfl_xor(v, o));
    return v;
}
__device__ __forceinline__ unsigned pk2(float lo, float hi) { return cvtpk(lo, hi); }

template <class Map>
__device__ __forceinline__ void tr_item(const float* W, int Nsrc, int K, const float* kscale, bf16* WT, LAS float* scr, int item, int nblk, int lane, Map map) {
    const int kb = item / nblk, nb = item % nblk, k0 = 64 * kb, n0 = 32 * nb;
    const int sc = map(n0 + (lane & 31));
    float tv[32];
    const int scc = sc >= 0 ? sc : 0;
#pragma unroll
    for (int i = 0; i < 32; ++i) { const int kk = 2 * i + (lane >> 5); tv[i] = W[(size_t)(k0 + kk) * Nsrc + scc]; }
#pragma unroll
    for (int i = 0; i < 32; ++i) { const int kk = 2 * i + (lane >> 5); float v = sc >= 0 ? tv[i] : 0.f; if (kscale) v *= kscale[k0 + kk]; scr[kk * 33 + (lane & 31)] = v; }
    LDS_WAIT(); asm volatile("" ::: "memory");
    const int c = lane & 7;
#pragma unroll
    for (int j = 0; j < 4; ++j) { const int n = (lane >> 3) + 8 * j; const LAS float* s = scr + (8 * c) * 33 + n;
        v4u o; o.x = pk2(s[0 * 33], s[1 * 33]); o.y = pk2(s[2 * 33], s[3 * 33]); o.z = pk2(s[4 * 33], s[5 * 33]); o.w = pk2(s[6 * 33], s[7 * 33]);
        *(GAS v4u*)(WT + (size_t)(n0 + n) * K + k0 + 8 * c) = o; }
    LDS_WAIT(); asm volatile("" ::: "memory");
}
template <class Map>
__device__ __forceinline__ void tr_item8(const float* W, int Nsrc, int K, const float* kscale, float wscale, unsigned char* WT8, LAS float* scr, int item, int nblk, int lane, Map map) {
    const int kb = item / nblk, nb = item % nblk, k0 = 64 * kb, n0 = 32 * nb;
    const int sc = map(n0 + (lane & 31));
    float tv[32];
    const int scc = sc >= 0 ? sc : 0;
#pragma unroll
    for (int i = 0; i < 32; ++i) { const int kk = 2 * i + (lane >> 5); tv[i] = W[(size_t)(k0 + kk) * Nsrc + scc]; }
#pragma unroll
    for (int i = 0; i < 32; ++i) { const int kk = 2 * i + (lane >> 5); float v = sc >= 0 ? tv[i] * wscale : 0.f; if (kscale) v *= kscale[k0 + kk]; scr[kk * 33 + (lane & 31)] = v; }
    LDS_WAIT(); asm volatile("" ::: "memory");
    const int c = lane & 7;
#pragma unroll
    for (int j = 0; j < 4; ++j) { const int n = (lane >> 3) + 8 * j; const LAS float* s = scr + (8 * c) * 33 + n;
        u32x2 o; o.x = (unsigned)__builtin_amdgcn_cvt_pk_fp8_f32(s[2 * 33], s[3 * 33], __builtin_amdgcn_cvt_pk_fp8_f32(s[0 * 33], s[1 * 33], 0, false), true);
        o.y = (unsigned)__builtin_amdgcn_cvt_pk_fp8_f32(s[6 * 33], s[7 * 33], __builtin_amdgcn_cvt_pk_fp8_f32(s[4 * 33], s[5 * 33], 0, false), true);
        *(GAS u32x2*)(WT8 + (size_t)(n0 + n) * K + k0 + 8 * c) = o; }
    LDS_WAIT(); asm volatile("" ::: "memory");
}
__device__ __forceinline__ int rope_src(int jj) { return (jj & 1) * 32 + (jj >> 1); }
struct MapW1 { __device__ int operator()(int n) const {
    if (n < 1024) return OFF_DQ + (n & ~63) + rope_src(n & 63);
    if (n < 2048) { const int j = n - 1024; return OFF_DK + (j & ~63) + rope_src(j & 63); }
    return OFF_DV + (n - 2048); } };
struct MapGate { __device__ int operator()(int n) const {
    if (n < 4096) return OFF_GATE + n;
    if (n < 5376) return n - 4096;
    if (n < 5440) return OFF_KR + rope_src(n - 5376);
    return -1; } };
struct MapUQ { __device__ int operator()(int n) const {
    if (n < 1024) return (n >> 7) * 192 + (n & 127);
    const int j = n - 1024; return (j >> 6) * 192 + 128 + rope_src(j & 63); } };
struct MapUKV { __device__ int operator()(int n) const {
    if (n < 1024) return (n >> 7) * 256 + (n & 127);
    const int j = n - 1024; return (j >> 7) * 256 + 128 + (j & 127); } };
struct MapId { __device__ int operator()(int n) const { return n; } };

struct Ins { const float *x, *w_in, *b_gate, *g_norm1, *g_cq, *w_uq, *g_ckv, *w_ukv, *w_o_mla, *lambda_qk, *g_subln, *w_o_diff, *w_out, *g_norm2, *w_q_peer, *sub_keys, *expert_u, *expert_v, *g_final; };

__device__ __forceinline__ void p0_prologue(Frame& F, const Ins& I, const double* inv_freq) {
    LAS float* scr = (LAS float*)(F.lds + RING_OFF + F.wave * 16384);
    const int gw = F.vcu * NWAVES + F.wave, NGW = F.G * NWAVES;
    unsigned char* ws = F.ws;
    constexpr int I_W1 = (2048 / 64) * (N1 / 32), I_W8 = (2048 / 64) * (NG / 32), I_UQ = (768 / 64) * (1536 / 32), I_UKV = (512 / 64) * (2048 / 32), I_OM = (1024 / 64) * (2048 / 32), I_OD = I_OM, I_OUT = (2048 / 64) * (2048 / 32), I_QP = I_OUT;
    constexpr int NITEMS = I_W1 + I_W8 + I_UQ + I_UKV + I_OM + I_OD + I_OUT + I_QP;
    for (int it = gw; it < NITEMS; it += NGW) {
        int r = it;
        if (r < I_W1) { tr_item(I.w_in, IN_COLS, 2048, nullptr, (bf16*)(ws + WS_W1), scr, r, N1 / 32, F.lane, MapW1()); continue; } r -= I_W1;
        if (r < I_W8) { tr_item8(I.w_in, IN_COLS, 2048, nullptr, W1_SCALE, ws + WS_W8, scr, r, NG / 32, F.lane, MapGate()); continue; } r -= I_W8;
        if (r < I_UQ) { tr_item8(I.w_uq, 1536, 768, I.g_cq, W1_SCALE, ws + WS_WUQ, scr, r, 1536 / 32, F.lane, MapUQ()); continue; } r -= I_UQ;
        if (r < I_UKV) { tr_item8(I.w_ukv, 2048, 512, I.g_ckv, W1_SCALE, ws + WS_WUKV, scr, r, 2048 / 32, F.lane, MapUKV()); continue; } r -= I_UKV;
        if (r < I_OM) { tr_item(I.w_o_mla, 2048, 1024, nullptr, (bf16*)(ws + WS_WOM), scr, r, 2048 / 32, F.lane, MapId()); continue; } r -= I_OM;
        if (r < I_OD) { tr_item(I.w_o_diff, 2048, 1024, nullptr, (bf16*)(ws + WS_WOD), scr, r, 2048 / 32, F.lane, MapId()); continue; } r -= I_OD;
        if (r < I_OUT) { tr_item(I.w_out, 2048, 2048, nullptr, (bf16*)(ws + WS_WOUT), scr, r, 2048 / 32, F.lane, MapId()); continue; } r -= I_OUT;
        tr_item(I.w_q_peer, 2048, 2048, I.g_norm2, (bf16*)(ws + WS_WQP), scr, r, 2048 / 32, F.lane, MapId());
    }
    {
        bf16* skb = (bf16*)(ws + WS_SKB);
        for (int e = gw * 64 + F.lane; e < 256 * 256; e += NGW * 64) {
            const int n = e >> 8, k = e & 255; float v = 0.f;
            if (n < 128 && k < 128) v = I.sub_keys[n * 128 + k];
            else if (n >= 128 && k >= 128) v = I.sub_keys[128 * 128 + (n - 128) * 128 + (k - 128)];
            skb[e] = (bf16)(pk2(v, 0.f) & 0xffffu);
        }
    }
    {
        float* rope = (float*)(ws + WS_ROPE);
        for (int e = gw * 64 + F.lane; e < SEQ * 32; e += NGW * 64) {
            const int pos = e >> 5, i = e & 31;
            const double rev = (double)pos * inv_freq[i] * 0.15915494309189535;
            const float fr = (float)(rev - floor(rev));
            rope[2 * e] = __builtin_amdgcn_cosf(fr); rope[2 * e + 1] = __builtin_amdgcn_sinf(fr);
        }
    }
    if (blockIdx.x == 0 && F.tid == 0) {
        float a = 0.f, b = 0.f;
        for (int d = 0; d < 64; ++d) { a += I.lambda_qk[d] * I.lambda_qk[64 + d]; b += I.lambda_qk[128 + d] * I.lambda_qk[192 + d]; }
        const float lam = __expf(a) - __expf(b) + LAMBDA_INIT;
        ((float*)F.ctl)[CW_LAMBDA] = lam;
    }
    {
        bf16* H = (bf16*)(ws + WS_H);
        f32x4 g[8];
#pragma unroll
        for (int j = 0; j < 8; ++j) g[j] = *((const f32x4*)I.g_norm1 + F.lane + 64 * j);
        for (int m = gw; m < T; m += NGW) {
            const GAS f32x4* xr = (const GAS f32x4*)(I.x + (size_t)m * D_MODEL) + F.lane;
            f32x4 v[8]; float s = 0.f;
#pragma unroll
            for (int j = 0; j < 8; ++j) { v[j] = xr[64 * j]; s += (v[j].x * v[j].x + v[j].y * v[j].y) + (v[j].z * v[j].z + v[j].w * v[j].w); }
            const float rstd = 1.0f / sqrtf(wave_sum(s) * (1.f / D_MODEL) + EPS);
            GAS u32x2* o8 = (GAS u32x2*)(H + (size_t)m * D_MODEL) + F.lane;
#pragma unroll
            for (int j = 0; j < 8; ++j) { u32x2 w; w.x = pk2(v[j].x * rstd * g[j].x, v[j].y * rstd * g[j].y); w.y = pk2(v[j].z * rstd * g[j].z, v[j].w * rstd * g[j].w); o8[64 * j] = w; }
            { GAS unsigned* h8 = (GAS unsigned*)(ws + WS_H8 + (size_t)m * D_MODEL) + F.lane;
#pragma unroll
              for (int j = 0; j < 8; ++j) h8[64 * j] = (unsigned)__builtin_amdgcn_cvt_pk_fp8_f32(v[j].z * rstd * g[j].z, v[j].w * rstd * g[j].w, __builtin_amdgcn_cvt_pk_fp8_f32(v[j].x * rstd * g[j].x, v[j].y * rstd * g[j].y, 0, false), true); }
        }
    }
}

__device__ __forceinline__ void convert_experts(Frame& F, const Ins& I) {
    const size_t gt = (size_t)(F.vcu * NWAVES * 64) + F.tid, NT = (size_t)F.G * NWAVES * 64;
    const size_t nchunk = (size_t)NEXP * D_MODEL / 8;
    bf16* EU = (bf16*)(F.ws + WS_EU); bf16* EV = (bf16*)(F.ws + WS_EV);
    for (size_t c = gt; c < nchunk; c += NT) {
        const int d = (int)((c * 8) & (D_MODEL - 1));
        const f32x4 a0 = *(const GAS f32x4*)(I.expert_u + c * 8), a1 = *(const GAS f32x4*)(I.expert_u + c * 8 + 4);
        const f32x4 g0 = *(const f32x4*)(I.g_norm2 + d), g1 = *(const f32x4*)(I.g_norm2 + d + 4);
        v4u o; o.x = pk2(a0.x * g0.x, a0.y * g0.y); o.y = pk2(a0.z * g0.z, a0.w * g0.w); o.z = pk2(a1.x * g1.x, a1.y * g1.y); o.w = pk2(a1.z * g1.z, a1.w * g1.w);
        *(GAS v4u*)(EU + c * 8) = o;
        const f32x4 b0 = *(const GAS f32x4*)(I.expert_v + c * 8), b1 = *(const GAS f32x4*)(I.expert_v + c * 8 + 4);
        v4u p; p.x = pk2(b0.x, b0.y); p.y = pk2(b0.z, b0.w); p.z = pk2(b1.x, b1.y); p.w = pk2(b1.z, b1.w);
        *(GAS v4u*)(EV + c * 8) = p;
    }
}

__device__ __forceinline__ float sigmoidf_fast(float x) { return __builtin_amdgcn_rcpf(1.0f + __builtin_amdgcn_exp2f(-x * LOG2E)); }
__device__ __forceinline__ void rope8(f32x4& v0, f32x4& v1, const f32x4 cs0, const f32x4 cs1, float sc) {
    const float a0 = v0[0] * cs0[0] - v0[1] * cs0[1], b0 = v0[1] * cs0[0] + v0[0] * cs0[1];
    const float a1 = v0[2] * cs0[2] - v0[3] * cs0[3], b1 = v0[3] * cs0[2] + v0[2] * cs0[3];
    const float a2 = v1[0] * cs1[0] - v1[1] * cs1[1], b2 = v1[1] * cs1[0] + v1[0] * cs1[1];
    const float a3 = v1[2] * cs1[2] - v1[3] * cs1[3], b3 = v1[3] * cs1[2] + v1[2] * cs1[3];
    v0 = (f32x4){a0 * sc, b0 * sc, a1 * sc, b1 * sc}; v1 = (f32x4){a2 * sc, b2 * sc, a3 * sc, b3 * sc};
}
__device__ __forceinline__ u32x4 pack8(const f32x4 v0, const f32x4 v1) { u32x4 w; w.x = cvtpk(v0[0], v0[1]); w.y = cvtpk(v0[2], v0[3]); w.z = cvtpk(v1[0], v1[1]); w.w = cvtpk(v1[2], v1[3]); return w; }

__device__ __forceinline__ size_t kt_off(size_t row, int col) { const size_t b = row >> 13; const int pos = (int)(row & 8191), tile = pos >> 6, key = pos & 63, h = col >> 7, piece = (col & 127) >> 3;
    return (((b * 8 + h) * 128 + tile) * 16 + piece) * 512 + key * 8 + (col & 7); }
__device__ __forceinline__ size_t vt_off(size_t row, int col) { const size_t b = row >> 13; const int pos = (int)(row & 8191), tile = pos >> 6, key = pos & 63, h = col >> 7, d = col & 127;
    return (((b * 8 + h) * 128 + tile) * 16 + (d >> 5) * 4 + (key >> 4)) * 512 + (key & 15) * 32 + (d & 31); }
__device__ __forceinline__ size_t krt_off(size_t row, int col) { const size_t b = row >> 13; const int pos = (int)(row & 8191), tile = pos >> 6, key = pos & 63;
    return ((b * 128 + tile) * 8 + (col >> 3)) * 512 + key * 8 + (col & 7); }
template <int kind> struct EpiProj {
    static constexpr bool PERM = true;
    bf16_t *CQ, *CKV, *DQ, *DK, *DV, *G, *KR; float *ssq_q, *ssq_kv; const float* bgate; const float* rope;
    __device__ __forceinline__ void operator()(const f32x4 (&acc)[2][2][4][2], const pg8::Unit& u, int wr, int wc, int fr, int fq) const {
        const int row0 = u.pm * 256 + wr * 64 + fr, pn = kind == 0 ? 5 + u.pn : (u.pn < 16 ? 18 + u.pn : (u.pn < 21 ? u.pn - 16 : 17)), colw = wc * 32 + 8 * fq;
        if (kind == 1 && pn < 5) {
            unsigned char* O; int ldc, ct, nsl, sl; float* ssq;
            if (pn < 3) { O = (unsigned char*)CQ; ldc = 768; ct = pn * 256; ssq = ssq_q; nsl = 12; sl = pn * 4 + wc; } else { O = (unsigned char*)CKV; ldc = 512; ct = (pn - 3) * 256; ssq = ssq_kv; nsl = 8; sl = (pn - 3) * 4 + wc; }
#pragma unroll
            for (int ai = 0; ai < 2; ++ai)
#pragma unroll
                for (int m = 0; m < 4; ++m) { const int row = row0 + ai * 128 + m * 16; float s = 0.f;
#pragma unroll
                    for (int bj = 0; bj < 2; ++bj) { const f32x4 v0 = acc[ai][bj][m][0], v1 = acc[ai][bj][m][1];
                        s += (v0[0] * v0[0] + v0[1] * v0[1]) + (v0[2] * v0[2] + v0[3] * v0[3]) + (v1[0] * v1[0] + v1[1] * v1[1]) + (v1[2] * v1[2] + v1[3] * v1[3]);
                        u32x2 w8; w8.x = (unsigned)__builtin_amdgcn_cvt_pk_fp8_f32(v0[2], v0[3], __builtin_amdgcn_cvt_pk_fp8_f32(v0[0], v0[1], 0, false), true); w8.y = (unsigned)__builtin_amdgcn_cvt_pk_fp8_f32(v1[2], v1[3], __builtin_amdgcn_cvt_pk_fp8_f32(v1[0], v1[1], 0, false), true);
                        *(u32x2*)(O + (size_t)row * ldc + ct + bj * 128 + colw) = w8; }
                    s += __shfl_xor(s, 16); s += __shfl_xor(s, 32);
                    if (fq == 0) ssq[(size_t)row * nsl + sl] = s; }
        } else if (kind == 0 && pn < 13) {
            const bool isq = pn < 9; bf16_t* O = isq ? DQ : DK; const int ct = (pn - (isq ? 5 : 9)) * 256; const float sc = isq ? C2_DIFF : 1.0f;
            const int i0 = ((wc & 1) * 32 + 8 * fq) >> 1;
#pragma unroll
            for (int ai = 0; ai < 2; ++ai)
#pragma unroll
                for (int m = 0; m < 4; ++m) { const int row = row0 + ai * 128 + m * 16; const int pos = row & (SEQ - 1);
                    const f32x4 cs0 = *(const f32x4*)(rope + (size_t)(pos * 32 + i0) * 2), cs1 = *(const f32x4*)(rope + (size_t)(pos * 32 + i0 + 2) * 2);
#pragma unroll
                    for (int bj = 0; bj < 2; ++bj) { f32x4 v0 = acc[ai][bj][m][0], v1 = acc[ai][bj][m][1]; rope8(v0, v1, cs0, cs1, sc);
                        const int col = ct + bj * 128 + colw;
                        *(u32x4*)(O + (isq ? (size_t)row * 1024 + col : kt_off(row, col))) = pack8(v0, v1); } }
        } else if (kind == 0) {
            const int ct = (pn - 13) * 256;
#pragma unroll
            for (int ai = 0; ai < 2; ++ai)
#pragma unroll
                for (int m = 0; m < 4; ++m) { const int row = row0 + ai * 128 + m * 16;
#pragma unroll
                    for (int bj = 0; bj < 2; ++bj) *(u32x4*)(DV + vt_off(row, ct + bj * 128 + colw)) = pack8(acc[ai][bj][m][0], acc[ai][bj][m][1]); }
        } else if (kind == 1 && pn >= 18) {
            const int ct = (pn - 18) * 256;
            f32x4 bv[2][2];
#pragma unroll
            for (int bj = 0; bj < 2; ++bj) { bv[bj][0] = *(const f32x4*)(bgate + ct + bj * 128 + colw); bv[bj][1] = *(const f32x4*)(bgate + ct + bj * 128 + colw + 4); }
#pragma unroll
            for (int ai = 0; ai < 2; ++ai)
#pragma unroll
                for (int m = 0; m < 4; ++m) { const int row = row0 + ai * 128 + m * 16;
#pragma unroll
                    for (int bj = 0; bj < 2; ++bj) { f32x4 v0 = acc[ai][bj][m][0] + bv[bj][0], v1 = acc[ai][bj][m][1] + bv[bj][1];
#pragma unroll
                        for (int e = 0; e < 4; ++e) { v0[e] = sigmoidf_fast(v0[e]); v1[e] = sigmoidf_fast(v1[e]); }
                        *(u32x4*)(G + (size_t)row * 4096 + ct + bj * 128 + colw) = pack8(v0, v1); } }
        } else if (kind == 1) {
            if (wc < 2) {
                const int i0 = colw >> 1;
#pragma unroll
                for (int ai = 0; ai < 2; ++ai)
#pragma unroll
                    for (int m = 0; m < 4; ++m) { const int row = row0 + ai * 128 + m * 16; const int pos = row & (SEQ - 1);
                        const f32x4 cs0 = *(const f32x4*)(rope + (size_t)(pos * 32 + i0) * 2), cs1 = *(const f32x4*)(rope + (size_t)(pos * 32 + i0 + 2) * 2);
                        f32x4 v0 = acc[ai][0][m][0], v1 = acc[ai][0][m][1]; rope8(v0, v1, cs0, cs1, 1.0f);
                        *(u32x4*)(KR + krt_off(row, colw)) = pack8(v0, v1); }
            }
        }
    }
};

struct EpiQup {
    static constexpr bool PERM = true;
    bf16_t *QN, *QR; const float* ssq; const float* rope;
    __device__ __forceinline__ void operator()(const f32x4 (&acc)[2][2][4][2], const pg8::Unit& u, int wr, int wc, int fr, int fq) const {
        const int row0 = u.pm * 256 + wr * 64 + fr, pn = u.pn, colw = wc * 32 + 8 * fq;
        const int i0 = ((wc & 1) * 32 + 8 * fq) >> 1;
#pragma unroll
        for (int ai = 0; ai < 2; ++ai)
#pragma unroll
            for (int m = 0; m < 4; ++m) { const int row = row0 + ai * 128 + m * 16; const int pos = row & (SEQ - 1);
                const f32x4 q0 = *(const f32x4*)(ssq + (size_t)row * 12), q1 = *(const f32x4*)(ssq + (size_t)row * 12 + 4), q2 = *(const f32x4*)(ssq + (size_t)row * 12 + 8);
                const float sq = (((q0[0] + q0[1]) + (q0[2] + q0[3])) + ((q1[0] + q1[1]) + (q1[2] + q1[3]))) + ((q2[0] + q2[1]) + (q2[2] + q2[3]));
                const float sc = C2_MLA / sqrtf(sq * (1.0f / 768.0f) + EPS);
                if (pn < 4) {
#pragma unroll
                    for (int bj = 0; bj < 2; ++bj) *(u32x4*)(QN + (size_t)row * 1024 + pn * 256 + bj * 128 + colw) = pack8(acc[ai][bj][m][0] * sc, acc[ai][bj][m][1] * sc);
                } else {
                    const f32x4 cs0 = *(const f32x4*)(rope + (size_t)(pos * 32 + i0) * 2), cs1 = *(const f32x4*)(rope + (size_t)(pos * 32 + i0 + 2) * 2);
#pragma unroll
                    for (int bj = 0; bj < 2; ++bj) { f32x4 v0 = acc[ai][bj][m][0], v1 = acc[ai][bj][m][1]; rope8(v0, v1, cs0, cs1, sc);
                        *(u32x4*)(QR + (size_t)row * 512 + (pn - 4) * 256 + bj * 128 + colw) = pack8(v0, v1); }
                } }
    }
};
struct EpiKVup {
    static constexpr bool PERM = true;
    bf16_t *KN, *V; const float* ssq;
    __device__ __forceinline__ void operator()(const f32x4 (&acc)[2][2][4][2], const pg8::Unit& u, int wr, int wc, int fr, int fq) const {
        const int row0 = u.pm * 256 + wr * 64 + fr, pn = u.pn, colw = wc * 32 + 8 * fq;
        bf16_t* O = pn < 4 ? KN : V; const int ct = (pn & 3) * 256;
#pragma unroll
        for (int ai = 0; ai < 2; ++ai)
#pragma unroll
            for (int m = 0; m < 4; ++m) { const int row = row0 + ai * 128 + m * 16;
                const f32x4 q0 = *(const f32x4*)(ssq + (size_t)row * 8), q1 = *(const f32x4*)(ssq + (size_t)row * 8 + 4);
                const float sq = ((q0[0] + q0[1]) + (q0[2] + q0[3])) + ((q1[0] + q1[1]) + (q1[2] + q1[3]));
                const float sc = 1.0f / sqrtf(sq * (1.0f / 512.0f) + EPS);
#pragma unroll
                for (int bj = 0; bj < 2; ++bj) { const int col = ct + bj * 128 + colw; *(u32x4*)(O + (pn < 4 ? kt_off(row, col) : vt_off(row, col))) = pack8(acc[ai][bj][m][0] * sc, acc[ai][bj][m][1] * sc); } }
    }
};
struct EpiGate {
    static constexpr bool PERM = true;
    const bf16_t* G; bf16_t* TMP; bf16_t* MG; int second;
    __device__ __forceinline__ void operator()(const f32x4 (&acc)[2][2][4][2], const pg8::Unit& u, int wr, int wc, int fr, int fq) const {
        const int row0 = u.pm * 256 + wr * 64 + fr, colw = u.pn * 256 + wc * 32 + 8 * fq;
#pragma unroll
        for (int ai = 0; ai < 2; ++ai)
#pragma unroll
            for (int m = 0; m < 4; ++m) { const int row = row0 + ai * 128 + m * 16;
#pragma unroll
                for (int bj = 0; bj < 2; ++bj) { const int col = colw + bj * 128;
                    const u32x4 gw = *(const u32x4*)(G + (size_t)row * 4096 + (second ? 2048 : 0) + col);
                    f32x4 v0 = acc[ai][bj][m][0], v1 = acc[ai][bj][m][1];
                    v0 = (f32x4){v0[0] * bflo(gw.x), v0[1] * bfhi(gw.x), v0[2] * bflo(gw.y), v0[3] * bfhi(gw.y)};
                    v1 = (f32x4){v1[0] * bflo(gw.z), v1[1] * bfhi(gw.z), v1[2] * bflo(gw.w), v1[3] * bfhi(gw.w)};
                    if (second) { const u32x4 tw = *(const u32x4*)(TMP + (size_t)row * 2048 + col);
                        v0 += (f32x4){bflo(tw.x), bfhi(tw.x), bflo(tw.y), bfhi(tw.y)}; v1 += (f32x4){bflo(tw.z), bfhi(tw.z), bflo(tw.w), bfhi(tw.w)};
                        *(u32x4*)(MG + (size_t)row * 2048 + col) = pack8(v0, v1);
                    } else *(u32x4*)(TMP + (size_t)row * 2048 + col) = pack8(v0, v1); } }
    }
};
struct EpiGate2 {
    static constexpr bool PERM = true;
    const bf16_t* G; bf16_t* MG;
    __device__ __forceinline__ void mid(f32x4 (&acc)[2][2][4][2], const pg8::Unit& u, int wr, int wc, int fr, int fq) const {
        const int row0 = u.pm * 256 + wr * 64 + fr, colw = u.pn * 256 + wc * 32 + 8 * fq;
#pragma unroll
        for (int ai = 0; ai < 2; ++ai)
#pragma unroll
            for (int m = 0; m < 4; ++m) { const int row = row0 + ai * 128 + m * 16;
#pragma unroll
                for (int bj = 0; bj < 2; ++bj) { const int col = colw + bj * 128;
                    const u32x4 ga = *(const u32x4*)(G + (size_t)row * 4096 + col), gb = *(const u32x4*)(G + (size_t)row * 4096 + 2048 + col);
                    f32x4 r0, r1;
                    r0[0] = bflo(ga.x) * __builtin_amdgcn_rcpf(bflo(gb.x)); r0[1] = bfhi(ga.x) * __builtin_amdgcn_rcpf(bfhi(gb.x)); r0[2] = bflo(ga.y) * __builtin_amdgcn_rcpf(bflo(gb.y)); r0[3] = bfhi(ga.y) * __builtin_amdgcn_rcpf(bfhi(gb.y));
                    r1[0] = bflo(ga.z) * __builtin_amdgcn_rcpf(bflo(gb.z)); r1[1] = bfhi(ga.z) * __builtin_amdgcn_rcpf(bfhi(gb.z)); r1[2] = bflo(ga.w) * __builtin_amdgcn_rcpf(bflo(gb.w)); r1[3] = bfhi(ga.w) * __builtin_amdgcn_rcpf(bfhi(gb.w));
                    acc[ai][bj][m][0] *= r0; acc[ai][bj][m][1] *= r1; }
                asm volatile("" ::: "memory"); }
    }
    __device__ __forceinline__ void operator()(const f32x4 (&acc)[2][2][4][2], const pg8::Unit& u, int wr, int wc, int fr, int fq) const {
        const int row0 = u.pm * 256 + wr * 64 + fr, colw = u.pn * 256 + wc * 32 + 8 * fq;
#pragma unroll
        for (int ai = 0; ai < 2; ++ai)
#pragma unroll
            for (int m = 0; m < 4; ++m) { const int row = row0 + ai * 128 + m * 16;
#pragma unroll
                for (int bj = 0; bj < 2; ++bj) { const int col = colw + bj * 128;
                    const u32x4 gb = *(const u32x4*)(G + (size_t)row * 4096 + 2048 + col);
                    f32x4 v0 = acc[ai][bj][m][0], v1 = acc[ai][bj][m][1];
                    v0 = (f32x4){v0[0] * bflo(gb.x), v0[1] * bfhi(gb.x), v0[2] * bflo(gb.y), v0[3] * bfhi(gb.y)};
                    v1 = (f32x4){v1[0] * bflo(gb.z), v1[1] * bfhi(gb.z), v1[2] * bflo(gb.w), v1[3] * bfhi(gb.w)};
                    *(u32x4*)(MG + (size_t)row * 2048 + col) = pack8(v0, v1); } }
    }
};
struct EpiRes {
    static constexpr bool PERM = false;
    const float* x; float* X2; bf16_t* X2B; float* ssq;
    __device__ __forceinline__ void operator()(const f32x4 (&acc)[2][2][4][2], const pg8::Unit& u, int wr, int wc, int fr, int fq) const {
        const int row0 = u.pm * 256 + wr * 64 + fr, col0 = u.pn * 256 + wc * 32 + 4 * fq;
#pragma unroll
        for (int ai = 0; ai < 2; ++ai)
#pragma unroll
            for (int m = 0; m < 4; ++m) { const int row = row0 + ai * 128 + m * 16; float s = 0.f;
#pragma unroll
                for (int bj = 0; bj < 2; ++bj)
#pragma unroll
                    for (int n = 0; n < 2; ++n) { const size_t off = (size_t)row * 2048 + col0 + bj * 128 + n * 16;
                        const f32x4 v = acc[ai][bj][m][n] + *(const f32x4*)(x + off);
                        s += (v[0] * v[0] + v[1] * v[1]) + (v[2] * v[2] + v[3] * v[3]);
#ifdef PEER_BF16
                        *(f32x4*)(X2 + off) = v;
#endif
                        u32x2 w; w.x = cvtpk(v[0], v[1]); w.y = cvtpk(v[2], v[3]); *(u32x2*)(X2B + off) = w; }
                s += __shfl_xor(s, 16); s += __shfl_xor(s, 32);
                if (fq == 0) ssq[(size_t)row * 32 + u.pn * 4 + wc] = s; }
    }
};
__device__ __forceinline__ float sum32(const float* p) { float t = 0.f;
#pragma unroll
    for (int i = 0; i < 8; ++i) { const f32x4 q = *(const f32x4*)(p + 4 * i); t += (q[0] + q[1]) + (q[2] + q[3]); } return t; }
constexpr int RTAB_OFF = 132096, RTAB_SLOTS = 4;
struct EpiQP {
    static constexpr bool PERM = true;
    bf16_t* QP; const float* ssq; const LAS float* tab; int pms[RTAB_SLOTS];
    __device__ __forceinline__ void operator()(const f32x4 (&acc)[2][2][4][2], const pg8::Unit& u, int wr, int wc, int fr, int fq) const {
        const int row0 = u.pm * 256 + wr * 64 + fr, colw = u.pn * 256 + wc * 32 + 8 * fq;
        int slot = -1;
#pragma unroll
        for (int i = RTAB_SLOTS - 1; i >= 0; --i) if (pms[i] == u.pm) slot = i;
#pragma unroll
        for (int ai = 0; ai < 2; ++ai)
#pragma unroll
            for (int m = 0; m < 4; ++m) { const int row = row0 + ai * 128 + m * 16;
                const float sc = slot >= 0 ? tab[slot * 256 + wr * 64 + fr + ai * 128 + m * 16] : 1.0f / sqrtf(sum32(ssq + (size_t)row * 32) * (1.0f / 2048.0f) + EPS);
#pragma unroll
                for (int bj = 0; bj < 2; ++bj) *(u32x4*)(QP + (size_t)row * 2048 + colw + bj * 128) = pack8(acc[ai][bj][m][0] * sc, acc[ai][bj][m][1] * sc); }
    }
};

template <class KaF, class KbF, class VF>
__device__ __forceinline__ void naive_attn(LAS float* qs, const bf16* qa, int ldqa, int da, const bf16* qb, int ldqb, int db,
                                           KaF ka_f, KbF kb_f, VF v_f,
                                           size_t rowbase, int p0, int lane, float (&o)[4][2], float (&linv)[4]) {
    const int dt = da + db;
    for (int idx = lane; idx < 4 * dt; idx += 64) { const int r = idx / dt, d = idx - r * dt;
        const bf16 h = d < da ? qa[(rowbase + p0 + r) * ldqa + d] : qb[(rowbase + p0 + r) * ldqb + (d - da)];
        qs[r * 192 + d] = bf2f(h); }
    LDS_WAIT(); asm volatile("" ::: "memory");
    float m[4], l[4];
#pragma unroll
    for (int r = 0; r < 4; ++r) { m[r] = -INFINITY; l[r] = 0.f; o[r][0] = 0.f; o[r][1] = 0.f; }
    const int pmax = p0 + 3, ntile = pmax / 64 + 1;
#pragma unroll 1
    for (int kt = 0; kt < ntile; ++kt) {
        const int key = kt * 64 + lane, kc = key < pmax ? key : pmax;
        float s[4] = {0.f, 0.f, 0.f, 0.f};
#pragma unroll 2
        for (int d = 0; d < da; d += 8) { const u32x4 kw = *(const u32x4*)ka_f(rowbase + kc, d);
            const float k0 = bflo(kw.x), k1 = bfhi(kw.x), k2 = bflo(kw.y), k3 = bfhi(kw.y), k4 = bflo(kw.z), k5 = bfhi(kw.z), k6 = bflo(kw.w), k7 = bfhi(kw.w);
#pragma unroll
            for (int r = 0; r < 4; ++r) { const f32x4 qa4 = *(const LAS f32x4*)(qs + r * 192 + d), qb4 = *(const LAS f32x4*)(qs + r * 192 + d + 4);
                s[r] += (qa4[0] * k0 + qa4[1] * k1) + (qa4[2] * k2 + qa4[3] * k3) + (qb4[0] * k4 + qb4[1] * k5) + (qb4[2] * k6 + qb4[3] * k7); } }
        if (db > 0) {
#pragma unroll 2
            for (int d = 0; d < db; d += 8) { const u32x4 kw = *(const u32x4*)kb_f(rowbase + kc, d);
                const float k0 = bflo(kw.x), k1 = bfhi(kw.x), k2 = bflo(kw.y), k3 = bfhi(kw.y), k4 = bflo(kw.z), k5 = bfhi(kw.z), k6 = bflo(kw.w), k7 = bfhi(kw.w);
#pragma unroll
                for (int r = 0; r < 4; ++r) { const f32x4 qa4 = *(const LAS f32x4*)(qs + r * 192 + da + d), qb4 = *(const LAS f32x4*)(qs + r * 192 + da + d + 4);
                    s[r] += (qa4[0] * k0 + qa4[1] * k1) + (qa4[2] * k2 + qa4[3] * k3) + (qb4[0] * k4 + qb4[1] * k5) + (qb4[2] * k6 + qb4[3] * k7); } } }
        float p[4];
#pragma unroll
        for (int r = 0; r < 4; ++r) {
            const float sv = key > p0 + r ? -INFINITY : s[r];
            const float mn = fmaxf(m[r], wave_max(sv));
            const float al = __builtin_amdgcn_exp2f(m[r] - mn);
            p[r] = __builtin_amdgcn_exp2f(sv - mn);
            l[r] = l[r] * al + wave_sum(p[r]); o[r][0] *= al; o[r][1] *= al; m[r] = mn;
        }
        const int jn = (pmax - kt * 64) < 63 ? (pmax - kt * 64) : 63;
#pragma unroll 4
        for (int j = 0; j <= jn; ++j) {
            const float v0 = bf2f(v_f(rowbase + kt * 64 + j, lane)), v1 = bf2f(v_f(rowbase + kt * 64 + j, 64 + lane));
#pragma unroll
            for (int r = 0; r < 4; ++r) { const float pj = __builtin_bit_cast(float, __builtin_amdgcn_readlane(__builtin_bit_cast(int, p[r]), j)); o[r][0] += pj * v0; o[r][1] += pj * v1; }
        }
    }
#pragma unroll
    for (int r = 0; r < 4; ++r) linv[r] = 1.0f / l[r];
    LDS_WAIT(); asm volatile("" ::: "memory");
}
__device__ __forceinline__ void p3_attention_ref(Frame& F, const Ins& I) {
    unsigned char* ws = F.ws;
    const bf16 *QN = (const bf16*)(ws + WS_QN), *QR = (const bf16*)(ws + WS_QR), *KN = (const bf16*)(ws + WS_KN), *KR = (const bf16*)(ws + WS_KR), *V = (const bf16*)(ws + WS_V);
    const bf16 *DQ = (const bf16*)(ws + WS_DQ), *DK = (const bf16*)(ws + WS_DK), *DV = (const bf16*)(ws + WS_DV);
    bf16 *OM = (bf16*)(ws + WS_OM), *OD = (bf16*)(ws + WS_OD);
    LAS float* qs = (LAS float*)(F.lds + RING_OFF + F.wave * 4096);
    const int gw = F.vcu * NWAVES + F.wave, NGW = F.G * NWAVES, lane = F.lane;
    const float lam = ((const float*)F.ctl)[CW_LAMBDA];
    const float gs0 = I.g_subln[lane] * (1.0f - LAMBDA_INIT), gs1 = I.g_subln[64 + lane] * (1.0f - LAMBDA_INIT);
    for (int it = gw; it < 2 * 16 * (SEQ / 4); it += NGW) {
        const int type = it & 1, rest = it >> 1, bh = rest & 15, g = rest >> 4, b = bh >> 3, h = bh & 7, p0 = 4 * g;
        const size_t rowbase = (size_t)b * SEQ;
        float o[4][2], li[4];
        if (type == 0) {
            naive_attn(qs, QN + h * 128, 1024, 128, QR + h * 64, 512, 64, [=](size_t row, int d) { return KN + kt_off(row, h * 128 + d); }, [=](size_t row, int d) { return KR + krt_off(row, d); },
                       [=](size_t row, int c) { return V[vt_off(row, h * 128 + c)]; }, rowbase, p0, lane, o, li);
#pragma unroll
            for (int r = 0; r < 4; ++r) { bf16* orow = OM + (rowbase + p0 + r) * 1024 + h * 128;
#ifdef ATT_CHECK
                { const float a0 = bf2f(orow[lane]), a1 = bf2f(orow[64 + lane]), b0 = o[r][0] * li[r], b1 = o[r][1] * li[r];
                  if (fabsf(a0 - b0) > ATT_TOL_A + ATT_TOL_R * fabsf(b0) || fabsf(a1 - b1) > ATT_TOL_A + ATT_TOL_R * fabsf(b1) || !(a0 == a0) || !(a1 == a1)) atomicAdd((unsigned*)F.ctl + 16, 1u); }
#else
                orow[lane] = (bf16)(pk2(o[r][0] * li[r], 0.f) & 0xffffu); orow[64 + lane] = (bf16)(pk2(o[r][1] * li[r], 0.f) & 0xffffu);
#endif
            }
        } else {
            float o2[4][2], li2[4];
            naive_attn(qs, DQ + (h * 2) * 64, 1024, 64, DQ, 1024, 0, [=](size_t row, int d) { return DK + kt_off(row, h * 128 + d); }, [=](size_t row, int d) { return DK; },
                       [=](size_t row, int c) { return DV[vt_off(row, h * 128 + c)]; }, rowbase, p0, lane, o, li);
            naive_attn(qs, DQ + (h * 2 + 1) * 64, 1024, 64, DQ, 1024, 0, [=](size_t row, int d) { return DK + kt_off(row, h * 128 + 64 + d); }, [=](size_t row, int d) { return DK; },
                       [=](size_t row, int c) { return DV[vt_off(row, h * 128 + c)]; }, rowbase, p0, lane, o2, li2);
#pragma unroll
            for (int r = 0; r < 4; ++r) {
                const float d0 = o[r][0] * li[r] - lam * o2[r][0] * li2[r], d1 = o[r][1] * li[r] - lam * o2[r][1] * li2[r];
                const float rs = 1.0f / sqrtf(wave_sum(d0 * d0 + d1 * d1) * (1.0f / 128.0f) + EPS);
                bf16* orow = OD + (rowbase + p0 + r) * 1024 + h * 128;
#ifdef ATT_CHECK
                { const float a0 = bf2f(orow[lane]), a1 = bf2f(orow[64 + lane]), b0 = d0 * rs * gs0, b1 = d1 * rs * gs1;
                  if (fabsf(a0 - b0) > ATT_TOL_A + ATT_TOL_R * fabsf(b0) || fabsf(a1 - b1) > ATT_TOL_A + ATT_TOL_R * fabsf(b1) || !(a0 == a0) || !(a1 == a1)) atomicAdd((unsigned*)F.ctl + 17, 1u); }
#else
                orow[lane] = (bf16)(pk2(d0 * rs * gs0, 0.f) & 0xffffu); orow[64 + lane] = (bf16)(pk2(d1 * rs * gs1, 0.f) & 0xffffu);
#endif
            }
        }
    }
}

namespace att {
typedef short bf16x8 __attribute__((ext_vector_type(8)));
typedef short s16x4 __attribute__((ext_vector_type(4)));
typedef float f32x16 __attribute__((ext_vector_type(16)));
typedef short v4i16_t __attribute__((ext_vector_type(4)));
#ifndef ATT_PF2
#define ATT_PF2 1
#endif
constexpr int BUFB = 40960, WSF_OFF = (ATT_PF2 ? 3 : 2) * BUFB;
#ifndef ATT_KD
#define ATT_KD 2
#endif
#ifndef ATT_VD
#define ATT_VD 2
#endif
__device__ __forceinline__ int crow(int r, int hi) { return (r & 3) + 8 * (r >> 2) + 4 * hi; }
__device__ __forceinline__ s16x4 vtr(const LAS unsigned char* p) { return __builtin_bit_cast(s16x4, __builtin_amdgcn_ds_read_tr16_b64_v4i16((LAS v4i16_t*)p)); }
__device__ __forceinline__ float max3f(float a, float b, float c) { float r; asm("v_max3_f32 %0, %1, %2, %3" : "=v"(r) : "v"(a), "v"(b), "v"(c)); return r; }
__device__ __forceinline__ float max2f(float a, float b) { float r; asm("v_max_f32_e32 %0, %1, %2" : "=v"(r) : "v"(a), "v"(b)); return r; }
__device__ __forceinline__ float swapmax(float m) { auto rr = __builtin_amdgcn_permlane32_swap(__float_as_uint(m), __float_as_uint(m), false, false);
    const unsigned a = rr[0], b = rr[1]; return fmaxf(__uint_as_float(a), __uint_as_float(b)); }
__device__ __forceinline__ float swapsum(float m) { auto rr = __builtin_amdgcn_permlane32_swap(__float_as_uint(m), __float_as_uint(m), false, false);
    const unsigned a = rr[0], b = rr[1]; return __uint_as_float(a) + __uint_as_float(b); }

template <bool DIFF>
__device__ __forceinline__ void attn_unit(LAS unsigned char* lds, int tid, size_t rowbase, int h, int q0,
                                          const bf16* Qa, const bf16* Qb, const bf16* Ka, const bf16* Kb, const bf16* Vp, bf16* Op, float lam, const float* gsub) {
    constexpr int NP = DIFF ? 4 : 5, NKS = DIFF ? 4 : 12, KPIECES = DIFF ? 16 : 24, R = DIFF ? 128 : 256;
    const int lane = tid & 63, r32 = lane & 31, hi = lane >> 5, wid = __builtin_amdgcn_readfirstlane(tid >> 6);
    const int mp = DIFF ? (wid >> 2) : 0, rows_w0 = q0 + 32 * (DIFF ? (wid & 3) : wid);
    const char* src[NP]; unsigned tstr[NP]; unsigned dsto[NP];
#pragma unroll
    for (int i = 0; i < NP; ++i) { const int pidx = wid * NP + i;
        const size_t bhb = ((size_t)(rowbase >> 13) * 8 + h) * 128 * 16384, krb = (size_t)(rowbase >> 13) * 128 * 8192;
        if (!DIFF) {
            if (pidx < 16) { src[i] = (const char*)Ka + bhb + pidx * 1024 + lane * 16; tstr[i] = 16384; dsto[i] = pidx * 1024; }
            else if (pidx < 24) { src[i] = (const char*)Kb + krb + (pidx - 16) * 1024 + lane * 16; tstr[i] = 8192; dsto[i] = pidx * 1024; }
            else { src[i] = (const char*)Vp + bhb + (pidx - 24) * 1024 + lane * 16; tstr[i] = 16384; dsto[i] = pidx * 1024; }
        } else {
            if (pidx < 16) { src[i] = (const char*)Ka + bhb + pidx * 1024 + lane * 16; tstr[i] = 16384; dsto[i] = pidx * 1024; }
            else { src[i] = (const char*)Vp + bhb + (pidx - 16) * 1024 + lane * 16; tstr[i] = 16384; dsto[i] = pidx * 1024; }
        } }
    const unsigned lds0 = (unsigned)(uintptr_t)lds;
#define ATT_DMA(t, bb) do { _Pragma("unroll") for (int _i = 0; _i < NP; ++_i) { unsigned _keep; const unsigned _dst = (unsigned)__builtin_amdgcn_readfirstlane((int)(lds0 + (unsigned)((bb) * BUFB) + dsto[_i])); \
        asm volatile("s_mov_b32 %0, m0\n\ts_mov_b32 m0, %2\n\ts_nop 0\n\tglobal_load_lds_dwordx4 %1, off\n\ts_mov_b32 m0, %0" : "=&s"(_keep) : "v"(src[_i] + (size_t)(t) * tstr[_i]), "s"(_dst) : "memory"); } } while (0)
    bf16x8 qf[NKS];
    { const size_t qrow = rowbase + rows_w0 + r32;
#pragma unroll
      for (int ks = 0; ks < NKS; ++ks) {
          if (DIFF) qf[ks] = *(const bf16x8*)(Qa + qrow * 1024 + (h * 2 + mp) * 64 + ks * 16 + hi * 8);
          else if (ks < 8) qf[ks] = *(const bf16x8*)(Qa + qrow * 1024 + h * 128 + ks * 16 + hi * 8);
          else qf[ks] = *(const bf16x8*)(Qb + qrow * 512 + h * 64 + (ks - 8) * 16 + hi * 8);
      } }
    f32x16 o[4];
#pragma unroll
    for (int d0 = 0; d0 < 4; ++d0) o[d0] = f32x16{};
    float m = -1e30f, l = 0.f;
    const int NT = (q0 + R) / 64, t_last = (rows_w0 + 31) / 64;
    LAS float* wsf = (LAS float*)(lds + WSF_OFF) + wid * 32;
    const int koff = (DIFF ? mp * 8 * 1024 : 0) + hi * 1024 + r32 * 16;
    const int voff = KPIECES * 1024 + ((lane >> 4) & 1) * 32 + (lane & 3) * 8 + (4 * hi + ((lane & 15) >> 2)) * 64;
    const int qpos = rows_w0 + r32;
    ATT_DMA(0, 0);
#if ATT_PF2
    ATT_DMA(1, 1);
#endif
    __builtin_amdgcn_s_waitcnt(0x0F70);
    asm volatile("s_waitcnt vmcnt(0)" ::: "memory"); __syncthreads();
#if ATT_PF2
    int bcur = 0;
#endif
#pragma unroll 1
    for (int t = 0; t < NT; ++t) {
#if ATT_PF2
        const int bb = bcur; const bool more = t + 2 < NT;
        if (more) ATT_DMA(t + 2, (bcur == 0) ? 2 : bcur - 1);
#else
        const int bb = t & 1;
        if (t + 1 < NT) ATT_DMA(t + 1, bb ^ 1);
#endif
        if (t <= t_last) {
            const LAS unsigned char* kb = lds + bb * BUFB + koff;
            f32x16 p0 = f32x16{}, p1 = f32x16{};
            {
                bf16x8 kfa[NKS], kfc[NKS];
#pragma unroll
                for (int ks = 0; ks < ATT_KD; ++ks) { kfa[ks] = *(const LAS bf16x8*)(kb + ks * 2048); kfc[ks] = *(const LAS bf16x8*)(kb + ks * 2048 + 512); }
                __builtin_amdgcn_sched_barrier(0);
#pragma unroll
                for (int ks = 0; ks < NKS; ++ks) {
                    if (ks + ATT_KD < NKS) { kfa[ks + ATT_KD] = *(const LAS bf16x8*)(kb + (ks + ATT_KD) * 2048); kfc[ks + ATT_KD] = *(const LAS bf16x8*)(kb + (ks + ATT_KD) * 2048 + 512); }
                    __builtin_amdgcn_sched_barrier(0);
                    p0 = __builtin_amdgcn_mfma_f32_32x32x16_bf16(kfa[ks], qf[ks], p0, 0, 0, 0);
                    p1 = __builtin_amdgcn_mfma_f32_32x32x16_bf16(kfc[ks], qf[ks], p1, 0, 0, 0);
                    __builtin_amdgcn_sched_barrier(0);
                }
            }
            if (64 * t + 63 > rows_w0) {
                const int kb0 = 64 * t + 4 * hi;
#pragma unroll
                for (int r = 0; r < 16; ++r) { const int kv = kb0 + (r & 3) + 8 * (r >> 2); if (kv > qpos) p0[r] = -INFINITY; if (kv + 32 > qpos) p1[r] = -INFINITY; }
            }
            asm volatile("s_nop 15\n\ts_nop 7" : "+v"(p0), "+v"(p1));
            float rm = max3f(p0[0], p0[1], p1[0]), rm2 = max3f(p0[2], p0[3], p1[1]); rm = max3f(rm, p1[2], p1[3]);
#pragma unroll
            for (int r = 4; r < 16; r += 4) { rm = max3f(rm, p0[r], p0[r + 1]); rm2 = max3f(rm2, p0[r + 2], p0[r + 3]); rm = max3f(rm, p1[r], p1[r + 1]); rm2 = max3f(rm2, p1[r + 2], p1[r + 3]); }
            rm = swapmax(max2f(rm, rm2));
            const float mn = fmaxf(m, rm);
            if (__any(mn > m)) {
                const float al = __builtin_amdgcn_exp2f(m - mn);
                l *= al;
                if (hi == 0) wsf[r32] = al;
                LDS_WAIT(); asm volatile("" ::: "memory");
#pragma unroll
                for (int r = 0; r < 16; ++r) { const float a = wsf[crow(r, hi)];
#pragma unroll
                    for (int d0 = 0; d0 < 4; ++d0) o[d0][r] *= a; }
                LDS_WAIT(); asm volatile("" ::: "memory");
            }
            m = mn;
            float ps = 0.f;
#pragma unroll
            for (int r = 0; r < 16; ++r) { p0[r] = __builtin_amdgcn_exp2f(p0[r] - mn); p1[r] = __builtin_amdgcn_exp2f(p1[r] - mn); ps += p0[r] + p1[r]; }
            l += ps;
            u32x4 pw[4];
            pw[0] = (u32x4){cvtpk(p0[0], p0[1]), cvtpk(p0[2], p0[3]), cvtpk(p0[4], p0[5]), cvtpk(p0[6], p0[7])};
            pw[1] = (u32x4){cvtpk(p0[8], p0[9]), cvtpk(p0[10], p0[11]), cvtpk(p0[12], p0[13]), cvtpk(p0[14], p0[15])};
            pw[2] = (u32x4){cvtpk(p1[0], p1[1]), cvtpk(p1[2], p1[3]), cvtpk(p1[4], p1[5]), cvtpk(p1[6], p1[7])};
            pw[3] = (u32x4){cvtpk(p1[8], p1[9]), cvtpk(p1[10], p1[11]), cvtpk(p1[12], p1[13]), cvtpk(p1[14], p1[15])};
            const LAS unsigned char* vb = lds + bb * BUFB + voff;
            {
                s16x4 vlo[16], vhh[16];
#pragma unroll
                for (int i = 0; i < ATT_VD; ++i) { vlo[i] = vtr(vb + i * 1024); vhh[i] = vtr(vb + i * 1024 + 512); }
                __builtin_amdgcn_sched_barrier(0);
#pragma unroll
                for (int i = 0; i < 16; ++i) {
                    if (i + ATT_VD < 16) { vlo[i + ATT_VD] = vtr(vb + (i + ATT_VD) * 1024); vhh[i + ATT_VD] = vtr(vb + (i + ATT_VD) * 1024 + 512); }
                    __builtin_amdgcn_sched_barrier(0);
                    const bf16x8 vf = (bf16x8){vlo[i][0], vlo[i][1], vlo[i][2], vlo[i][3], vhh[i][0], vhh[i][1], vhh[i][2], vhh[i][3]};
                    o[i >> 2] = __builtin_amdgcn_mfma_f32_32x32x16_bf16(__builtin_bit_cast(bf16x8, pw[i & 3]), vf, o[i >> 2], 0, 0, 0);
                    __builtin_amdgcn_sched_barrier(0);
                }
            }
        }
#if ATT_PF2
        if (more) asm volatile("s_waitcnt vmcnt(%0)" :: "n"(NP) : "memory"); else asm volatile("s_waitcnt vmcnt(0)" ::: "memory");
        __syncthreads();
        bcur = (bcur == 2) ? 0 : bcur + 1;
#else
        asm volatile("s_waitcnt vmcnt(0)" ::: "memory"); __syncthreads();
#endif
    }
#undef ATT_DMA
    l = swapsum(l);
    if (hi == 0) wsf[r32] = l;
    LDS_WAIT(); asm volatile("" ::: "memory");
    float rli[16];
#pragma unroll
    for (int r = 0; r < 16; ++r) rli[r] = 1.0f / wsf[crow(r, hi)];
    LDS_WAIT(); asm volatile("" ::: "memory");
    if (!DIFF) {
#pragma unroll
        for (int r = 0; r < 16; ++r) { bf16* orow = Op + (rowbase + rows_w0 + crow(r, hi)) * 1024 + h * 128 + r32;
#pragma unroll
            for (int d0 = 0; d0 < 4; ++d0) orow[d0 * 32] = (bf16)(cvtpk(o[d0][r] * rli[r], 0.f) & 0xffffu); }
    } else {
        LAS float* xch = (LAS float*)lds;
        if (wid >= 4) {
#pragma unroll
            for (int d0 = 0; d0 < 4; ++d0)
#pragma unroll
                for (int r = 0; r < 16; ++r) xch[((wid & 3) * 64 + d0 * 16 + r) * 64 + lane] = o[d0][r] * rli[r];
        }
        __syncthreads();
        if (wid < 4) {
            float ss[16];
#pragma unroll
            for (int r = 0; r < 16; ++r) ss[r] = 0.f;
#pragma unroll
            for (int d0 = 0; d0 < 4; ++d0)
#pragma unroll
                for (int r = 0; r < 16; ++r) { const float d = o[d0][r] * rli[r] - lam * xch[(wid * 64 + d0 * 16 + r) * 64 + lane]; o[d0][r] = d; ss[r] += d * d; }
#pragma unroll
            for (int r = 0; r < 16; ++r) {
#pragma unroll
                for (int of = 1; of < 32; of <<= 1) ss[r] += __shfl_xor(ss[r], of);
                ss[r] = 1.0f / sqrtf(ss[r] * (1.0f / 128.0f) + EPS); }
            float g4[4];
#pragma unroll
            for (int d0 = 0; d0 < 4; ++d0) g4[d0] = gsub[d0 * 32 + r32] * (1.0f - LAMBDA_INIT);
#pragma unroll
            for (int r = 0; r < 16; ++r) { bf16* orow = Op + (rowbase + rows_w0 + crow(r, hi)) * 1024 + h * 128 + r32;
#pragma unroll
                for (int d0 = 0; d0 < 4; ++d0) orow[d0 * 32] = (bf16)(cvtpk(o[d0][r] * ss[r] * g4[d0], 0.f) & 0xffffu); }
        }
        __syncthreads();
    }
}
}

__device__ __forceinline__ void p3_attention(Frame& F, const Ins& I) {
    unsigned char* ws = F.ws;
    const bf16 *QN = (const bf16*)(ws + WS_QN), *QR = (const bf16*)(ws + WS_QR), *KN = (const bf16*)(ws + WS_KN), *KR = (const bf16*)(ws + WS_KR), *V = (const bf16*)(ws + WS_V);
    const bf16 *DQ = (const bf16*)(ws + WS_DQ), *DK = (const bf16*)(ws + WS_DK), *DV = (const bf16*)(ws + WS_DV);
    bf16 *OM = (bf16*)(ws + WS_OM), *OD = (bf16*)(ws + WS_OD);
    const float lam = ((const float*)F.ctl)[CW_LAMBDA];
    LAS unsigned char* lds = F.lds + RING_OFF;
    for (int v = F.vcu; v < 256; v += F.G) {
        const int bh = v >> 4, c = v & 15, b = bh >> 3, h = bh & 7; const size_t rowbase = (size_t)b * SEQ;
        att::attn_unit<false>(lds, F.tid, rowbase, h, (31 - c) * 256, QN, QR, KN, KR, V, OM, lam, I.g_subln);
        att::attn_unit<true>(lds, F.tid, rowbase, h, (63 - c) * 128, DQ, nullptr, DK, nullptr, DV, OD, lam, I.g_subln);
        att::attn_unit<true>(lds, F.tid, rowbase, h, (47 - c) * 128, DQ, nullptr, DK, nullptr, DV, OD, lam, I.g_subln);
        att::attn_unit<true>(lds, F.tid, rowbase, h, (16 + c) * 128, DQ, nullptr, DK, nullptr, DV, OD, lam, I.g_subln);
        att::attn_unit<true>(lds, F.tid, rowbase, h, c * 128, DQ, nullptr, DK, nullptr, DV, OD, lam, I.g_subln);
        att::attn_unit<false>(lds, F.tid, rowbase, h, c * 256, QN, QR, KN, KR, V, OM, lam, I.g_subln);
    }
}

__device__ __forceinline__ void wave_argmax(float v, int idx, float& mv, int& mi) {
#pragma unroll
    for (int o = 1; o < 64; o <<= 1) { const float ov = __shfl_xor(v, o); const int oi = __shfl_xor(idx, o); if (ov > v || (ov == v && oi < idx)) { v = ov; idx = oi; } }
    mv = v; mi = idx;
}
__device__ __forceinline__ void p7_routing_ref(Frame& F) {
    unsigned char* ws = F.ws;
    const bf16* QP = (const bf16*)(ws + WS_QP); const bf16* SKB = (const bf16*)(ws + WS_SKB);
    int* IDX = (int*)(ws + WS_IDX); float* GT = (float*)(ws + WS_GT);
    LAS float* wl = (LAS float*)(F.lds + RING_OFF + F.wave * 4096);
    LAS float* qs = wl; LAS float* v1s = wl + 256; LAS int* i1s = (LAS int*)(wl + 272); LAS float* v2s = wl + 288; LAS int* i2s = (LAS int*)(wl + 304);
    const int gw = F.vcu * NWAVES + F.wave, NGW = F.G * NWAVES, lane = F.lane;
    for (int it = gw; it < T * 8; it += NGW) {
        { const u32x2 w = *(const u32x2*)(QP + (size_t)it * 256 + lane * 4); qs[lane * 4 + 0] = bflo(w.x); qs[lane * 4 + 1] = bfhi(w.x); qs[lane * 4 + 2] = bflo(w.y); qs[lane * 4 + 3] = bfhi(w.y); }
        LDS_WAIT(); asm volatile("" ::: "memory");
        float sc[2][2];
#pragma unroll
        for (int hf = 0; hf < 2; ++hf)
#pragma unroll
            for (int kk = 0; kk < 2; ++kk) { const bf16* kr = SKB + (size_t)(hf * 128 + kk * 64 + lane) * 256 + hf * 128; float s = 0.f;
#pragma unroll 4
                for (int d = 0; d < 128; d += 8) { const u32x4 kw = *(const u32x4*)(kr + d);
                    const f32x4 qa4 = *(const LAS f32x4*)(qs + hf * 128 + d), qb4 = *(const LAS f32x4*)(qs + hf * 128 + d + 4);
                    s += (qa4[0] * bflo(kw.x) + qa4[1] * bfhi(kw.x)) + (qa4[2] * bflo(kw.y) + qa4[3] * bfhi(kw.y)) + (qb4[0] * bflo(kw.z) + qb4[1] * bfhi(kw.z)) + (qb4[2] * bflo(kw.w) + qb4[3] * bfhi(kw.w)); }
                sc[hf][kk] = s; }
#pragma unroll
        for (int hf = 0; hf < 2; ++hf) {
            float a = sc[hf][0], b = sc[hf][1];
            for (int r = 0; r < 16; ++r) {
                float lv; int li; if (b > a) { lv = b; li = lane + 64; } else { lv = a; li = lane; }
                float mv; int mi; wave_argmax(lv, li, mv, mi);
                if (mi == lane) a = -INFINITY; if (mi == lane + 64) b = -INFINITY;
                if (lane == 0) { if (hf == 0) { v1s[r] = mv; i1s[r] = mi; } else { v2s[r] = mv; i2s[r] = mi; } }
            }
        }
        LDS_WAIT(); asm volatile("" ::: "memory");
        float cv[4];
#pragma unroll
        for (int j = 0; j < 4; ++j) { const int c = lane * 4 + j; cv[j] = v1s[c >> 4] + v2s[c & 15]; }
        float mycs = 0.f; int myc = 0;
        for (int r = 0; r < 16; ++r) {
            float lv = cv[0]; int li = lane * 4;
#pragma unroll
            for (int j = 1; j < 4; ++j) if (cv[j] > lv) { lv = cv[j]; li = lane * 4 + j; }
            float mv; int mi; wave_argmax(lv, li, mv, mi);
#pragma unroll
            for (int j = 0; j < 4; ++j) if (mi == lane * 4 + j) cv[j] = -INFINITY;
            if (lane == r) { mycs = mv; myc = mi; }
        }
        float mx = mycs;
#pragma unroll
        for (int o = 1; o < 16; o <<= 1) mx = fmaxf(mx, __shfl_xor(mx, o));
        const float e = __expf(mycs - mx); float se = e;
#pragma unroll
        for (int o = 1; o < 16; o <<= 1) se += __shfl_xor(se, o);
        if (lane < 16) { const int ex = i1s[myc >> 4] * 128 + i2s[myc & 15];
            IDX[(size_t)it * 16 + lane] = ex; GT[(size_t)it * 16 + lane] = e / se; }
        LDS_WAIT(); asm volatile("" ::: "memory");
    }
}

__device__ __forceinline__ void unpack8(const u32x4 w, float (&f)[8]) { f[0] = bflo(w.x); f[1] = bfhi(w.x); f[2] = bflo(w.y); f[3] = bfhi(w.y); f[4] = bflo(w.z); f[5] = bfhi(w.z); f[6] = bflo(w.w); f[7] = bfhi(w.w); }
__device__ __forceinline__ void p8_gather(Frame& F, const Ins& I, float* out) {
    unsigned char* ws = F.ws;
    const float* X2 = (const float*)(ws + WS_X2); const bf16* EU = (const bf16*)(ws + WS_EU); const bf16* EV = (const bf16*)(ws + WS_EV);
    const int* IDX = (const int*)(ws + WS_IDX); const float* GT = (const float*)(ws + WS_GT);
    const float* ssq2 = (const float*)(ws + WS_PSQ2);
    const int gw = F.vcu * NWAVES + F.wave, NGW = F.G * NWAVES, lane = F.lane;
    for (int t = gw; t < T; t += NGW) {
        float xv[4][8], acc[4][8];
#pragma unroll
        for (int j = 0; j < 4; ++j) { const f32x4 a = *(const f32x4*)(X2 + (size_t)t * 2048 + 512 * j + 8 * lane), b = *(const f32x4*)(X2 + (size_t)t * 2048 + 512 * j + 8 * lane + 4);
            xv[j][0] = a[0]; xv[j][1] = a[1]; xv[j][2] = a[2]; xv[j][3] = a[3]; xv[j][4] = b[0]; xv[j][5] = b[1]; xv[j][6] = b[2]; xv[j][7] = b[3];
#pragma unroll
            for (int e = 0; e < 8; ++e) acc[j][e] = 0.f; }
        const float rstd2 = 1.0f / sqrtf(sum32(ssq2 + (size_t)t * 32) * (1.0f / 2048.0f) + EPS);
        const int id0 = IDX[(size_t)t * 128 + lane], id1 = IDX[(size_t)t * 128 + 64 + lane];
        const float g0 = GT[(size_t)t * 128 + lane], g1 = GT[(size_t)t * 128 + 64 + lane];
        for (int i = 0; i < 128; ++i) {
            const int ex = __builtin_amdgcn_readlane(i < 64 ? id0 : id1, i & 63);
            const float gate = __builtin_bit_cast(float, __builtin_amdgcn_readlane(__builtin_bit_cast(int, i < 64 ? g0 : g1), i & 63));
            const bf16* ur = EU + (size_t)ex * 2048 + 8 * lane; const bf16* vr = EV + (size_t)ex * 2048 + 8 * lane;
            u32x4 uw[4], vw[4];
#pragma unroll
            for (int j = 0; j < 4; ++j) { uw[j] = *(const u32x4*)(ur + 512 * j); vw[j] = *(const u32x4*)(vr + 512 * j); }
            float dot = 0.f;
#pragma unroll
            for (int j = 0; j < 4; ++j) { float f[8]; unpack8(uw[j], f);
#pragma unroll
                for (int e = 0; e < 8; ++e) dot += f[e] * xv[j][e]; }
            const float a = wave_sum(dot) * rstd2;
            const float z2 = 1.5957691216057308f * (a + 0.044715f * a * a * a);
            const float w = gate * a * __builtin_amdgcn_rcpf(1.0f + __builtin_amdgcn_exp2f(-z2 * LOG2E));
#pragma unroll
            for (int j = 0; j < 4; ++j) { float f[8]; unpack8(vw[j], f);
#pragma unroll
                for (int e = 0; e < 8; ++e) acc[j][e] += w * f[e]; }
        }
        float s = 0.f;
#pragma unroll
        for (int j = 0; j < 4; ++j)
#pragma unroll
            for (int e = 0; e < 8; ++e) { acc[j][e] += xv[j][e]; s += acc[j][e] * acc[j][e]; }
        float rs = 1.0f / sqrtf(wave_sum(s) * (1.0f / 2048.0f) + EPS);
#ifdef ATT_CHECK
        if (((const unsigned*)F.ctl)[ATT_CHECK_WORD] > ATT_CHECK_MAX) rs = __builtin_nanf("");
#endif
#pragma unroll
        for (int j = 0; j < 4; ++j) { const f32x4 ga = *(const f32x4*)(I.g_final + 512 * j + 8 * lane), gb = *(const f32x4*)(I.g_final + 512 * j + 8 * lane + 4);
            *(f32x4*)(out + (size_t)t * 2048 + 512 * j + 8 * lane) = (f32x4){acc[j][0] * rs * ga[0], acc[j][1] * rs * ga[1], acc[j][2] * rs * ga[2], acc[j][3] * rs * ga[3]};
            *(f32x4*)(out + (size_t)t * 2048 + 512 * j + 8 * lane + 4) = (f32x4){acc[j][4] * rs * gb[0], acc[j][5] * rs * gb[1], acc[j][6] * rs * gb[2], acc[j][7] * rs * gb[3]}; }
    }
}

namespace rt {
typedef short bf16x8 __attribute__((ext_vector_type(8)));
typedef float f32x16 __attribute__((ext_vector_type(16)));
__device__ __forceinline__ unsigned f2sort(float f) { const unsigned u = __float_as_uint(f); return u ^ ((unsigned)((int)u >> 31) | 0x80000000u); }
__device__ __forceinline__ float sort2f(unsigned s) { return __uint_as_float(s ^ ((s >> 31) ? 0x80000000u : 0xFFFFFFFFu)); }
__device__ __forceinline__ unsigned umax(unsigned a, unsigned b) { return a > b ? a : b; }
__device__ __forceinline__ unsigned pair_max(unsigned m) { auto rr = __builtin_amdgcn_permlane32_swap(m, m, false, false); const unsigned a = rr[0], b = rr[1]; return umax(a, b); }
constexpr int KEYS_BYTES = 65536, LIST_OFF = KEYS_BYTES, LIST_WAVE = 6144 + 512;
}
__device__ __forceinline__ void rt_load_keys(Frame& F, const Ins& I) {
    LAS unsigned char* lds = F.lds + RING_OFF;
    for (int it = F.tid; it < 2 * 128 * 16; it += NWAVES * 64) {
        const int c = it & 15, n = (it >> 4) & 127, hf = it >> 11;
        const float* sp = I.sub_keys + (size_t)hf * 16384 + n * 128 + c * 8;
        const f32x4 a = *(const f32x4*)sp, b = *(const f32x4*)(sp + 4);
        v4u o; o.x = pk2(a.x, a.y); o.y = pk2(a.z, a.w); o.z = pk2(b.x, b.y); o.w = pk2(b.z, b.w);
        *(LAS v4u*)(lds + hf * 32768 + c * 2048 + n * 16) = o;
    }
    __syncthreads();
}
template <bool TO_LDS>
__device__ __forceinline__ void rt_task(Frame& F, int task, LAS unsigned* lst) {
    using namespace rt;
    unsigned char* ws = F.ws;
    const bf16* QP = (const bf16*)(ws + WS_QP);
    int* IDX = (int*)(ws + WS_IDX); float* GT = (float*)(ws + WS_GT);
    LAS unsigned char* lds = F.lds + RING_OFF;
    const int lane = F.lane, r32 = lane & 31, hi = lane >> 5;
        const size_t row = (size_t)task * 32 + r32;
#pragma unroll 1
        for (int hf = 0; hf < 2; ++hf) {
            bf16x8 qf[8];
#pragma unroll
            for (int ks = 0; ks < 8; ++ks) qf[ks] = *(const bf16x8*)(QP + row * 256 + hf * 128 + ks * 16 + hi * 8);
            unsigned k[64];
            const LAS unsigned char* kb0 = lds + hf * 32768 + hi * 2048 + r32 * 16;
#pragma unroll
            for (int kb = 0; kb < 4; ++kb) {
                f32x16 acc = f32x16{};
#pragma unroll
                for (int ks = 0; ks < 8; ++ks) acc = __builtin_amdgcn_mfma_f32_32x32x16_bf16(*(const LAS bf16x8*)(kb0 + ks * 4096 + kb * 512), qf[ks], acc, 0, 0, 0);
#pragma unroll
                for (int r = 0; r < 16; ++r) { const int n = 32 * kb + (r & 3) + 8 * (r >> 2) + 4 * hi; k[16 * kb + r] = (f2sort(acc[r]) & ~0x7Fu) | (unsigned)(127 - n); }
            }
#pragma unroll 1
            for (int rd = 0; rd < 16; ++rd) {
                unsigned m = k[0];
#pragma unroll
                for (int i = 1; i < 64; ++i) m = umax(m, k[i]);
                const unsigned g = pair_max(m);
#pragma unroll
                for (int i = 0; i < 64; ++i) k[i] = (k[i] == g) ? 0u : k[i];
                if (hi == 0) lst[hf * 16 + rd] = g;
            }
        }
        LDS_WAIT(); asm volatile("" ::: "memory");
        float v1[16], v2[16];
#pragma unroll
        for (int q = 0; q < 4; ++q) { const v4u a = *(const LAS v4u*)(lst + 4 * q), b = *(const LAS v4u*)(lst + 16 + 4 * q);
#pragma unroll
            for (int e = 0; e < 4; ++e) { v1[4 * q + e] = sort2f(a[e] & ~0x7Fu); v2[4 * q + e] = sort2f(b[e] & ~0x7Fu); } }
        unsigned cand[50];
        { int ci = 0;
#pragma unroll
          for (int a = 0; a < 16; ++a)
#pragma unroll
              for (int b = 0; b < 16; ++b) if ((a + 1) * (b + 1) <= 16) { cand[ci] = (f2sort(v1[a] + v2[b]) & ~0xFFu) | (unsigned)(255 - (a * 16 + b)); ++ci; } }
#pragma unroll 1
        for (int rd = 0; rd < 16; ++rd) {
            unsigned m = cand[0];
#pragma unroll
            for (int i = 1; i < 50; ++i) m = umax(m, cand[i]);
#pragma unroll
            for (int i = 0; i < 50; ++i) cand[i] = (cand[i] == m) ? 0u : cand[i];
            if (hi == 0) lst[32 + rd] = m;
        }
        LDS_WAIT(); asm volatile("" ::: "memory");
        const float cmax = sort2f(lst[32] & ~0xFFu);
        float ev[8]; int ex[8]; float se = 0.f;
#pragma unroll
        for (int j = 0; j < 8; ++j) { const unsigned key = lst[32 + 8 * hi + j]; const int ab = 255 - (int)(key & 0xFFu);
            const int i1 = 127 - (int)(lst[ab >> 4] & 0x7Fu), i2 = 127 - (int)(lst[16 + (ab & 15)] & 0x7Fu);
            ex[j] = i1 * 128 + i2; ev[j] = __expf(sort2f(key & ~0xFFu) - cmax); se += ev[j]; }
        { auto rr = __builtin_amdgcn_permlane32_swap(__float_as_uint(se), __float_as_uint(se), false, false); const unsigned a = rr[0], b = rr[1]; se = __uint_as_float(a) + __uint_as_float(b); }
        const float inv = 1.0f / se;
        if (TO_LDS) {
#pragma unroll
            for (int j = 0; j < 8; ++j) { lst[8 * hi + j] = (unsigned)ex[j]; lst[16 + 8 * hi + j] = __float_as_uint(ev[j] * inv); }
        } else {
        int* ip = IDX + row * 16 + 8 * hi; float* gp = GT + row * 16 + 8 * hi;
        *(GAS v4u*)ip = (v4u){(unsigned)ex[0], (unsigned)ex[1], (unsigned)ex[2], (unsigned)ex[3]}; *(GAS v4u*)(ip + 4) = (v4u){(unsigned)ex[4], (unsigned)ex[5], (unsigned)ex[6], (unsigned)ex[7]};
        *(GAS f32x4*)gp = (f32x4){ev[0] * inv, ev[1] * inv, ev[2] * inv, ev[3] * inv}; *(GAS f32x4*)(gp + 4) = (f32x4){ev[4] * inv, ev[5] * inv, ev[6] * inv, ev[7] * inv};
        }
        LDS_WAIT(); asm volatile("" ::: "memory");
}
__device__ __forceinline__ void p8_routing(Frame& F, const Ins& I) {
    using namespace rt;
    rt_load_keys(F, I);
    LAS unsigned* lst = (LAS unsigned*)(F.lds + RING_OFF + LIST_OFF + F.wave * LIST_WAVE) + (F.lane & 31) * 48;
    const int gw = F.vcu * NWAVES + F.wave, NGW = F.G * NWAVES;
    for (int task = gw; task < T * 8 / 32; task += NGW) rt_task<false>(F, task, lst);
}
constexpr float EU_SCALE = 64.0f, EV_SCALE = 4.0f;
typedef float f32x2v __attribute__((ext_vector_type(2)));
__device__ __forceinline__ unsigned pk4_fp8(float a, float b, float c, float d) { int t = __builtin_amdgcn_cvt_pk_fp8_f32(a, b, 0, false); t = __builtin_amdgcn_cvt_pk_fp8_f32(c, d, t, true); return (unsigned)t; }
__device__ __forceinline__ void convert_experts_fp8(Frame& F, const Ins& I) {
    const size_t gt = (size_t)(F.vcu * NWAVES * 64) + F.tid, NT = (size_t)F.G * NWAVES * 64;
    const size_t nchunk = (size_t)NEXP * D_MODEL / 16;
    unsigned char* EU = F.ws + WS_EU; unsigned char* EV = F.ws + WS_EV;
    for (size_t c = gt; c < nchunk; c += NT) {
        const int d = (int)((c * 16) & (D_MODEL - 1));
        v4u o, p;
#pragma unroll
        for (int k = 0; k < 4; ++k) {
            const f32x4 a = *(const GAS f32x4*)(I.expert_u + c * 16 + 4 * k), g = *(const f32x4*)(I.g_norm2 + d + 4 * k), b = *(const GAS f32x4*)(I.expert_v + c * 16 + 4 * k);
            o[k] = pk4_fp8(a.x * g.x * EU_SCALE, a.y * g.y * EU_SCALE, a.z * g.z * EU_SCALE, a.w * g.w * EU_SCALE);
            p[k] = pk4_fp8(b.x * EV_SCALE, b.y * EV_SCALE, b.z * EV_SCALE, b.w * EV_SCALE);
        }
        *(GAS v4u*)(EU + c * 16) = o; *(GAS v4u*)(EV + c * 16) = p;
    }
}
#ifndef PEER_FP8
#define PEER_FP6 1
#endif
#ifdef PEER_FP6
typedef float v32f_t __attribute__((ext_vector_type(32)));
typedef float v16f_t __attribute__((ext_vector_type(16)));
typedef unsigned v6u_t __attribute__((ext_vector_type(6)));
constexpr int EROW = 1536;
__device__ __forceinline__ void convert_experts_fp6(Frame& F, const Ins& I) {
    const size_t gt = (size_t)(F.vcu * NWAVES * 64) + F.tid, NT = (size_t)F.G * NWAVES * 64;
    const size_t nblk = (size_t)NEXP * 64;
    unsigned char* EU = F.ws + WS_EU; unsigned char* EV = F.ws + WS_EV;
    LAS int* ptab = (LAS int*)(F.lds + RING_OFF + 65536);
#pragma unroll 1
    for (int j = 0; j < 32; ++j) {
        v16f_t a, b;
#pragma unroll
        for (int i = 0; i < 16; ++i) { a[i] = (i == j) ? 1.0f : 0.0f; b[i] = (i + 16 == j) ? 1.0f : 0.0f; }
        const v32f_t r = __builtin_amdgcn_cvt_scalef32_pk32_f32_fp6(__builtin_amdgcn_cvt_scalef32_2xpk16_fp6_f32(a, b, 1.0f), 1.0f);
        int pos = 0;
#pragma unroll
        for (int i = 0; i < 32; ++i) pos = (r[i] != 0.0f) ? i : pos;
        ptab[j] = pos;
    }
    LDS_WAIT(); asm volatile("" ::: "memory");
    bool inter = true;
#pragma unroll 1
    for (int j = 0; j < 32; ++j) inter = inter && (ptab[j] == ((j < 16) ? 2 * j : 2 * (j - 16) + 1));
    if (inter) {
        const int gw = F.vcu * NWAVES + F.wave, NGW = F.G * NWAVES, lane = F.lane;
        LAS unsigned char* img = F.lds + RING_OFF + F.wave * 9216;
        f32x4 gsc[8];
#pragma unroll
        for (int k = 0; k < 8; ++k) gsc[k] = *(const f32x4*)(I.g_norm2 + (64 * k + lane) * 4) * EU_SCALE;
        for (int e = gw; e < NEXP; e += NGW) {
            f32x4 ru[8], rv[8];
#pragma unroll
            for (int k = 0; k < 8; ++k) { ru[k] = *(const GAS f32x4*)(I.expert_u + (size_t)e * 2048 + (64 * k + lane) * 4); rv[k] = *(const GAS f32x4*)(I.expert_v + (size_t)e * 2048 + (64 * k + lane) * 4); }
#pragma unroll
            for (int tb = 0; tb < 2; ++tb) {
#pragma unroll
                for (int k = 0; k < 8; ++k) { const int i4 = 64 * k + lane;
                    *(LAS f32x4*)(img + (i4 >> 3) * 144 + (i4 & 7) * 16) = tb == 0 ? ru[k] * gsc[k] : rv[k] * EV_SCALE; }
                LDS_WAIT(); asm volatile("" ::: "memory");
                v16f_t ya, yb;
#pragma unroll
                for (int j = 0; j < 8; ++j) { const f32x4 x4 = *(const LAS f32x4*)(img + lane * 144 + 16 * j); ya[2 * j] = x4[0]; yb[2 * j] = x4[1]; ya[2 * j + 1] = x4[2]; yb[2 * j + 1] = x4[3]; }
                LDS_WAIT(); asm volatile("" ::: "memory");
                const v6u_t pk = __builtin_amdgcn_cvt_scalef32_2xpk16_fp6_f32(ya, yb, 1.0f);
                unsigned char* dst = (tb == 0 ? EU : EV) + (size_t)e * EROW;
                *(GAS v4u*)(dst + 16 * lane) = (v4u){pk[0], pk[1], pk[2], pk[3]}; *(GAS u32x2*)(dst + 1024 + 8 * lane) = (u32x2){pk[4], pk[5]};
            }
        }
    } else {
    LAS float* scr = (LAS float*)(F.lds + RING_OFF) + F.tid;
    for (size_t c = gt; c < nblk; c += NT) {
        const size_t e = c >> 6; const int l = (int)(c & 63), d = 32 * l;
        v16f_t ya, yb;
#pragma unroll
        for (int k = 0; k < 8; ++k) { const f32x4 a0 = *(const GAS f32x4*)(I.expert_u + c * 32 + 4 * k), g0 = *(const f32x4*)(I.g_norm2 + d + 4 * k);
#pragma unroll
            for (int j = 0; j < 4; ++j) scr[(4 * k + j) * 512] = a0[j] * g0[j] * EU_SCALE; }
#pragma unroll
        for (int j = 0; j < 16; ++j) { ya[j] = scr[ptab[j] * 512]; yb[j] = scr[ptab[16 + j] * 512]; }
        const v6u_t pu = __builtin_amdgcn_cvt_scalef32_2xpk16_fp6_f32(ya, yb, 1.0f);
        *(GAS v4u*)(EU + e * EROW + 16 * l) = (v4u){pu[0], pu[1], pu[2], pu[3]}; *(GAS u32x2*)(EU + e * EROW + 1024 + 8 * l) = (u32x2){pu[4], pu[5]};
#pragma unroll
        for (int k = 0; k < 8; ++k) { const f32x4 b0 = *(const GAS f32x4*)(I.expert_v + c * 32 + 4 * k);
#pragma unroll
            for (int j = 0; j < 4; ++j) scr[(4 * k + j) * 512] = b0[j] * EV_SCALE; }
#pragma unroll
        for (int j = 0; j < 16; ++j) { ya[j] = scr[ptab[j] * 512]; yb[j] = scr[ptab[16 + j] * 512]; }
        const v6u_t pv = __builtin_amdgcn_cvt_scalef32_2xpk16_fp6_f32(ya, yb, 1.0f);
        *(GAS v4u*)(EV + e * EROW + 16 * l) = (v4u){pv[0], pv[1], pv[2], pv[3]}; *(GAS u32x2*)(EV + e * EROW + 1024 + 8 * l) = (u32x2){pv[4], pv[5]};
    }
    }
    __syncthreads();
}
struct G9Row { u32x4 a; u32x2 b; };
#define G9_SETS G9Row A[4], B[4]
#define G9_XOFF(c) (32 * lane + 16 * (c))
#define G9_LOAD(SET, TAB, IDL, g) do { _Pragma("unroll") for (int k = 0; k < 4; ++k) { const int ex = __builtin_amdgcn_readlane(IDL, 4 * (4 * (g) + k)); \
        const unsigned char* rp = (TAB) + (size_t)ex * EROW; SET[k].a = *(const u32x4*)(rp + 16 * lane); SET[k].b = *(const u32x2*)(rp + 1024 + 8 * lane); } } while (0)
#define G9_CVT(SET, k) __builtin_amdgcn_cvt_scalef32_pk32_f32_fp6((v6u_t){SET[k].a.x, SET[k].a.y, SET[k].a.z, SET[k].a.w, SET[k].b.x, SET[k].b.y}, 1.0f)
#define G9_DOTS(SET, g) do { _Pragma("unroll") for (int k = 0; k < 4; ++k) { const v32f_t r = G9_CVT(SET, k); float s0 = 0.f, s1 = 0.f; \
        f32x2v q0 = {0.f, 0.f}, q1 = {0.f, 0.f}; (void)s0; (void)s1; \
        _Pragma("unroll") for (int e = 0; e < 16; e += 2) { q0 = (f32x2v){r[e], r[e + 1]} * (f32x2v){xv[0][e], xv[0][e + 1]} + q0; q1 = (f32x2v){r[16 + e], r[17 + e]} * (f32x2v){xv[1][e], xv[1][e + 1]} + q1; } \
        q0 += q1; float s = q0.x + q0.y; asm volatile("" : "+v"(s)); dots[4 * (g) + k] = s; } } while (0)
#define G9_FMAS(SET, g) do { _Pragma("unroll") for (int k = 0; k < 4; ++k) { const float wk = wq[g][k]; const v32f_t r = G9_CVT(SET, k); \
        const f32x2v wk2 = {wk, wk}; \
        _Pragma("unroll") for (int e = 0; e < 16; e += 2) { const f32x2v a0 = (f32x2v){r[e], r[e + 1]} * wk2 + (f32x2v){acc[0][e], acc[0][e + 1]}, a1 = (f32x2v){r[16 + e], r[17 + e]} * wk2 + (f32x2v){acc[1][e], acc[1][e + 1]}; \
            acc[0][e] = a0.x; acc[0][e + 1] = a0.y; acc[1][e] = a1.x; acc[1][e + 1] = a1.y; } } } while (0)
#else
constexpr int EROW = 2048;
#define G9_SETS u32x4 A[4][2], B[4][2]
#define G9_XOFF(c) (1024 * (c) + 16 * lane)
#define G9_LOAD(SET, TAB, IDL, g) do { _Pragma("unroll") for (int k = 0; k < 4; ++k) { const int ex = __builtin_amdgcn_readlane(IDL, 4 * (4 * (g) + k)); \
        const unsigned char* rp = (TAB) + (size_t)ex * 2048 + 16 * lane; SET[k][0] = *(const u32x4*)rp; SET[k][1] = *(const u32x4*)(rp + 1024); } } while (0)
#define G9_DOTS(SET, g) do { _Pragma("unroll") for (int k = 0; k < 4; ++k) { float s = 0.f; _Pragma("unroll") for (int c = 0; c < 2; ++c) _Pragma("unroll") for (int dw = 0; dw < 4; ++dw) { \
        const f32x2v lo = __builtin_amdgcn_cvt_pk_f32_fp8((int)SET[k][c][dw], false), hi2 = __builtin_amdgcn_cvt_pk_f32_fp8((int)SET[k][c][dw], true); \
        s += lo.x * xv[c][4 * dw] + lo.y * xv[c][4 * dw + 1] + hi2.x * xv[c][4 * dw + 2] + hi2.y * xv[c][4 * dw + 3]; } asm volatile("" : "+v"(s)); dots[4 * (g) + k] = s; } } while (0)
#define G9_FMAS(SET, g) do { _Pragma("unroll") for (int k = 0; k < 4; ++k) { const float wk = wq[g][k]; \
        _Pragma("unroll") for (int c = 0; c < 2; ++c) _Pragma("unroll") for (int dw = 0; dw < 4; ++dw) { \
        const f32x2v lo = __builtin_amdgcn_cvt_pk_f32_fp8((int)SET[k][c][dw], false), hi2 = __builtin_amdgcn_cvt_pk_f32_fp8((int)SET[k][c][dw], true); \
        acc[c][4 * dw] += wk * lo.x; acc[c][4 * dw + 1] += wk * lo.y; acc[c][4 * dw + 2] += wk * hi2.x; acc[c][4 * dw + 3] += wk * hi2.y; } } } while (0)
#endif
#define G9_PIN() do { _Pragma("unroll") for (int c = 0; c < 2; ++c) asm volatile("" : "+v"(acc[c][0]), "+v"(acc[c][1]), "+v"(acc[c][2]), "+v"(acc[c][3]), "+v"(acc[c][4]), "+v"(acc[c][5]), "+v"(acc[c][6]), "+v"(acc[c][7]), \
        "+v"(acc[c][8]), "+v"(acc[c][9]), "+v"(acc[c][10]), "+v"(acc[c][11]), "+v"(acc[c][12]), "+v"(acc[c][13]), "+v"(acc[c][14]), "+v"(acc[c][15])); } while (0)
template <class IdF, class GtF>
__device__ __forceinline__ void g9_token(Frame& F, const Ins& I, float* out, int t, LAS float* wl, IdF idf, GtF gtf) {
    unsigned char* ws = F.ws;
    const bf16* X2B = (const bf16*)(ws + WS_X2B); const unsigned char* EU = ws + WS_EU; const unsigned char* EV = ws + WS_EV;
    const float* ssq2 = (const float*)(ws + WS_PSQ2);
    const int lane = F.lane, sl = (lane >> 2) & 15;
    const bool bit3 = (lane & 8) != 0, bit2 = (lane & 4) != 0;
    {
        G9_SETS;
        {
            float xv[2][16];
#pragma unroll
            for (int c = 0; c < 2; ++c)
#pragma unroll
                for (int q = 0; q < 2; ++q) { const u32x4 a = *(const u32x4*)(X2B + (size_t)t * 2048 + G9_XOFF(c) + 8 * q);
                    xv[c][8 * q] = bflo(a.x); xv[c][8 * q + 1] = bfhi(a.x); xv[c][8 * q + 2] = bflo(a.y); xv[c][8 * q + 3] = bfhi(a.y); xv[c][8 * q + 4] = bflo(a.z); xv[c][8 * q + 5] = bfhi(a.z); xv[c][8 * q + 6] = bflo(a.w); xv[c][8 * q + 7] = bfhi(a.w); }
            const float rstd2 = (1.0f / EU_SCALE) / sqrtf(sum32(ssq2 + (size_t)t * 32) * (1.0f / 2048.0f) + EPS);
            int idl_cur = idf(0);
            G9_LOAD(A, EU, idl_cur, 0); __builtin_amdgcn_sched_barrier(0);
#pragma unroll 1
            for (int hd = 0; hd < 8; ++hd) {
                const int idl_nxt = idf(hd < 7 ? hd + 1 : 0); const float gtl = gtf(hd);
                float dots[16];
                G9_LOAD(B, EU, idl_cur, 1); __builtin_amdgcn_sched_barrier(0);
                G9_DOTS(A, 0); __builtin_amdgcn_sched_barrier(0);
                G9_LOAD(A, EU, idl_cur, 2); __builtin_amdgcn_sched_barrier(0);
                G9_DOTS(B, 1); __builtin_amdgcn_sched_barrier(0);
                G9_LOAD(B, EU, idl_cur, 3); __builtin_amdgcn_sched_barrier(0);
                G9_DOTS(A, 2); __builtin_amdgcn_sched_barrier(0);
                if (hd < 7) { G9_LOAD(A, EU, idl_nxt, 0); } else { G9_LOAD(A, EV, idl_nxt, 0); }
                __builtin_amdgcn_sched_barrier(0);
                G9_DOTS(B, 3); __builtin_amdgcn_sched_barrier(0);
                float d8[8], d4[4], d2[2], d1;
#pragma unroll
                for (int i = 0; i < 8; ++i) { auto rr = __builtin_amdgcn_permlane32_swap(__float_as_uint(dots[i]), __float_as_uint(dots[8 + i]), false, false); const unsigned r0 = rr[0], r1 = rr[1]; d8[i] = __uint_as_float(r0) + __uint_as_float(r1); }
#pragma unroll
                for (int i = 0; i < 4; ++i) { auto rr = __builtin_amdgcn_permlane16_swap(__float_as_uint(d8[i]), __float_as_uint(d8[4 + i]), false, false); const unsigned r0 = rr[0], r1 = rr[1]; d4[i] = __uint_as_float(r0) + __uint_as_float(r1); }
#pragma unroll
                for (int i = 0; i < 2; ++i) { const float keep = bit3 ? d4[2 + i] : d4[i], send = bit3 ? d4[i] : d4[2 + i]; d2[i] = keep + __shfl_xor(send, 8); }
                { const float keep = bit2 ? d2[1] : d2[0], send = bit2 ? d2[0] : d2[1]; d1 = keep + __shfl_xor(send, 4); }
                d1 += __shfl_xor(d1, 2); d1 += __shfl_xor(d1, 1);
                const float a = d1 * rstd2;
                const float z2 = 1.5957691216057308f * (a + 0.044715f * a * a * a);
                const float w = gtl * (1.0f / EV_SCALE) * a * __builtin_amdgcn_rcpf(1.0f + __builtin_amdgcn_exp2f(-z2 * LOG2E));
                if ((lane & 3) == 0) wl[hd * 16 + sl] = w;
                idl_cur = idl_nxt;
            }
        }
        LDS_WAIT(); asm volatile("" ::: "memory");
        float acc[2][16];
#pragma unroll
        for (int c = 0; c < 2; ++c)
#pragma unroll
            for (int e = 0; e < 16; ++e) acc[c][e] = 0.f;
        {
            int idl_cur = idf(0);
#pragma unroll 1
            for (int hd = 0; hd < 8; ++hd) {
                const int idl_nxt = idf(hd < 7 ? hd + 1 : 0);
                f32x4 wq[4];
#pragma unroll
                for (int g = 0; g < 4; ++g) wq[g] = *(const LAS f32x4*)(wl + hd * 16 + 4 * g);
                G9_LOAD(B, EV, idl_cur, 1); __builtin_amdgcn_sched_barrier(0);
                G9_FMAS(A, 0); G9_PIN(); __builtin_amdgcn_sched_barrier(0);
                G9_LOAD(A, EV, idl_cur, 2); __builtin_amdgcn_sched_barrier(0);
                G9_FMAS(B, 1); G9_PIN(); __builtin_amdgcn_sched_barrier(0);
                G9_LOAD(B, EV, idl_cur, 3); __builtin_amdgcn_sched_barrier(0);
                G9_FMAS(A, 2); G9_PIN(); __builtin_amdgcn_sched_barrier(0);
                if (hd < 7) { G9_LOAD(A, EV, idl_nxt, 0); } __builtin_amdgcn_sched_barrier(0);
                G9_FMAS(B, 3); G9_PIN(); __builtin_amdgcn_sched_barrier(0);
                idl_cur = idl_nxt;
            }
        }
        LDS_WAIT(); asm volatile("" ::: "memory");
        float s = 0.f;
#pragma unroll
        for (int c = 0; c < 2; ++c)
#pragma unroll
            for (int q = 0; q < 2; ++q) { const u32x4 a = *(const u32x4*)(X2B + (size_t)t * 2048 + G9_XOFF(c) + 8 * q);
                const float xr[8] = {bflo(a.x), bfhi(a.x), bflo(a.y), bfhi(a.y), bflo(a.z), bfhi(a.z), bflo(a.w), bfhi(a.w)};
#pragma unroll
                for (int e = 0; e < 8; ++e) { acc[c][8 * q + e] += xr[e]; s += acc[c][8 * q + e] * acc[c][8 * q + e]; } }
        float rs = 1.0f / sqrtf(wave_sum(s) * (1.0f / 2048.0f) + EPS);
#ifdef ATT_CHECK
        if (((const unsigned*)F.ctl)[16] + ((const unsigned*)F.ctl)[17] > 0u) rs = __builtin_nanf("");
#endif
#pragma unroll
        for (int c = 0; c < 2; ++c)
#pragma unroll
            for (int q = 0; q < 4; ++q) { const f32x4 g = *(const f32x4*)(I.g_final + G9_XOFF(c) + 4 * q);
                *(f32x4*)(out + (size_t)t * 2048 + G9_XOFF(c) + 4 * q) = (f32x4){acc[c][4 * q] * rs * g[0], acc[c][4 * q + 1] * rs * g[1], acc[c][4 * q + 2] * rs * g[2], acc[c][4 * q + 3] * rs * g[3]}; }
    }
}
#undef G9_LOAD
#undef G9_DOTS
#undef G9_FMAS
#undef G9_PIN
#undef G9_SETS
#undef G9_XOFF
__device__ __forceinline__ void p9_gather_fp8(Frame& F, const Ins& I, float* out) {
    const int* IDX = (const int*)(F.ws + WS_IDX); const float* GT = (const float*)(F.ws + WS_GT);
    const int lane = F.lane, sl = (lane >> 2) & 15;
    LAS float* wl = (LAS float*)(F.lds + RING_OFF + F.wave * 4096);
    unsigned* tokctr = (unsigned*)F.ctl + CW_TOKCTR;
    for (;;) {
        int t = 0; if (lane == 0) t = (int)__hip_atomic_fetch_add(tokctr, 1u, __ATOMIC_RELAXED, __HIP_MEMORY_SCOPE_AGENT);
        t = __builtin_amdgcn_readfirstlane(t);
        if (t >= T) break;
        const int* idx_t = IDX + (size_t)t * 128 + sl; const float* gt_t = GT + (size_t)t * 128 + sl;
        g9_token(F, I, out, t, wl, [=](int hd) { return idx_t[hd * 16]; }, [=](int hd) { return gt_t[hd * 16]; });
    }
}

__device__ __forceinline__ void p89_route_gather(Frame& F, const Ins& I, float* out) {
    using namespace rt;
    rt_load_keys(F, I);
    LAS unsigned* lstw = (LAS unsigned*)(F.lds + RING_OFF + LIST_OFF + F.wave * LIST_WAVE);
    LAS unsigned* lst = lstw + (F.lane & 31) * 48;
    LAS float* wl = (LAS float*)(lstw + 32 * 48);
    const int gw = F.vcu * NWAVES + F.wave, NGW = F.G * NWAVES, sl = (F.lane >> 2) & 15;
    for (int task = gw; task < T * 8 / 32; task += NGW) {
        rt_task<true>(F, task, lst);
        LDS_WAIT(); asm volatile("" ::: "memory");
#pragma unroll 1
        for (int tt = 0; tt < 4; ++tt) {
            LAS unsigned* lt = lstw + (tt * 8) * 48 + sl;
            g9_token(F, I, out, 4 * task + tt, wl, [=](int hd) { return (int)lt[hd * 48]; }, [=](int hd) { return __uint_as_float(lt[hd * 48 + 16]); });
        }
        LDS_WAIT(); asm volatile("" ::: "memory");
    }
}

constexpr int NPHASE = 10;
struct Args { Ins in; float* out; unsigned char* ws; double inv_freq[32]; int ph_lo, ph_hi; };
__global__ void __launch_bounds__(NWAVES * 64, 2) mega_fwd(Args args) {
    extern __shared__ __attribute__((aligned(16))) unsigned char lds[];
    Frame F;
    F.lds = (LAS unsigned char*)lds;
    F.MISC = (volatile LAS unsigned*)(F.lds + MISC_OFF);
    F.tid = threadIdx.x; F.lane = F.tid & 63; F.wave = __builtin_amdgcn_readfirstlane(F.tid >> 6);
    F.G = gridDim.x; { const int bx = blockIdx.x; F.vcu = (F.G % 8 == 0) ? (bx % 8) * (F.G / 8) + bx / 8 : bx; }
    unsigned char* ws = args.ws; F.ws = ws;
    F.ctl = (gu32*)(ws + WS_CTL);
    const Ins& I = args.in;
    for (int u = F.tid; u < (LDS_BYTES - LDSCTL_OFF) / 4; u += NWAVES * 64) ((LAS unsigned*)(F.lds + LDSCTL_OFF))[u] = 0u;
    __syncthreads();
    XcdBarrier bar; bar.bar = (unsigned*)(F.ctl + CW_BAR); bar.x = 0; bar.st = nullptr;
#if MK_N_LAUNCHES == 1
    bar = xcd_barrier_post((unsigned*)(F.ctl + CW_BAR), F.MISC + 8);
#define GRID_BAR() xcd_barrier(bar)
#else
#define GRID_BAR() do {} while (0)
#endif
    const int lo = args.ph_lo, hi = args.ph_hi;
#ifdef PROBE_PH
    unsigned long long pstamp[NPHASE + 1];
#define PSTAMP(k) do { if (blockIdx.x == 0 && F.tid == 0) pstamp[k] = __builtin_amdgcn_s_memrealtime(); } while (0)
#else
#define PSTAMP(k) do {} while (0)
#endif
#ifndef PH_MASK
#define PH_MASK 0xFFFF
#endif
#define IN(k) (((PH_MASK >> (k)) & 1) && lo <= (k) && (k) < hi)
#define BOTH(k) (IN(k) && IN((k) + 1))
    float* ssq_q = (float*)(ws + WS_PSQ_Q); float* ssq_kv = (float*)(ws + WS_PSQ_KV); float* ssq2 = (float*)(ws + WS_PSQ2);
    const float* rope = (const float*)(ws + WS_ROPE);

    PSTAMP(0);
    if (IN(0)) { p0_prologue(F, I, args.inv_freq); if (BOTH(0)) GRID_BAR(); }

    PSTAMP(1);
    if (IN(1)) {
        { pg8::Gemm g{(const bf16_t*)(ws + WS_H), (const bf16_t*)(ws + WS_W1), T, N1, 2048, 2048}; pg8::StaticOrder S; S.init(T, N1, F.G, (int)blockIdx.x);
          EpiProj<0> E{(bf16_t*)(ws + WS_CQ), (bf16_t*)(ws + WS_CKV), (bf16_t*)(ws + WS_DQ), (bf16_t*)(ws + WS_DK), (bf16_t*)(ws + WS_DV), (bf16_t*)(ws + WS_G), (bf16_t*)(ws + WS_KR), ssq_q, ssq_kv, I.b_gate, rope};
          pg8::gemm_phase<EpiProj<0>, pg8::StaticOrder, PG8_ALIGN, PG8_SP2>(F.lds + RING_OFF, g, S, E); }
        {
          pg8::Gemm g{(const bf16_t*)(ws + WS_H8), (const bf16_t*)(ws + WS_W8), T, NG, 1024, 1024, 1.0f / W1_SCALE}; pg8::GateOrder S; S.init(T, NG, F.G, (int)blockIdx.x);
          EpiProj<1> E{(bf16_t*)(ws + WS_CQ), (bf16_t*)(ws + WS_CKV), (bf16_t*)(ws + WS_DQ), (bf16_t*)(ws + WS_DK), (bf16_t*)(ws + WS_DV), (bf16_t*)(ws + WS_G), (bf16_t*)(ws + WS_KR), ssq_q, ssq_kv, I.b_gate, rope};
          pg8::gemm_phase<EpiProj<1>, pg8::GateOrder, PG8_ALIGN, PG8_SP2, true>(F.lds + RING_OFF, g, S, E); }
        if (BOTH(1)) GRID_BAR();
    }
    PSTAMP(2);
    if (IN(2)) {
        { pg8::Gemm g{(const bf16_t*)(ws + WS_CQ), (const bf16_t*)(ws + WS_WUQ), T, 1536, 384, 384, 1.0f / W1_SCALE}; pg8::StaticOrder S; S.init(T, 1536, F.G, (int)blockIdx.x);
          EpiQup E{(bf16_t*)(ws + WS_QN), (bf16_t*)(ws + WS_QR), ssq_q, rope};
          pg8::gemm_phase<EpiQup, pg8::StaticOrder, PG8_ALIGN, PG8_SP2, true>(F.lds + RING_OFF, g, S, E); }
        { pg8::Gemm g{(const bf16_t*)(ws + WS_CKV), (const bf16_t*)(ws + WS_WUKV), T, 2048, 256, 256, 1.0f / W1_SCALE}; pg8::StaticOrder S; S.init(T, 2048, F.G, (int)blockIdx.x);
          EpiKVup E{(bf16_t*)(ws + WS_KN), (bf16_t*)(ws + WS_V), ssq_kv};
          pg8::gemm_phase<EpiKVup, pg8::StaticOrder, PG8_ALIGN, PG8_SP2, true>(F.lds + RING_OFF, g, S, E); }
        if (BOTH(2)) GRID_BAR();
    }
    PSTAMP(3);
#ifdef ATT_REF
    if (IN(3)) { p3_attention_ref(F, I); if (BOTH(3)) GRID_BAR(); }
#else
    if (IN(3)) { p3_attention(F, I); if (BOTH(3)) GRID_BAR(); }
#ifdef ATT_CHECK
    if (IN(3)) { p3_attention_ref(F, I); GRID_BAR(); }
#endif
#endif
    PSTAMP(4);
    if (IN(4)) {
        pg8::Gemm2 g{(const bf16_t*)(ws + WS_OM), (const bf16_t*)(ws + WS_OD), (const bf16_t*)(ws + WS_WOM), (const bf16_t*)(ws + WS_WOD), T, 2048, 1024, 1024};
        pg8::StaticOrder S; S.init(T, 2048, F.G, (int)blockIdx.x);
        EpiGate2 E{(const bf16_t*)(ws + WS_G), (bf16_t*)(ws + WS_MG)};
        pg8::gemm_phase2<EpiGate2, pg8::StaticOrder, PG8_ALIGN, PG8_SP2>(F.lds + RING_OFF, g, S, E);
        if (BOTH(4)) GRID_BAR();
    }
    PSTAMP(5);
    PSTAMP(6);
    if (IN(6)) {
#ifdef PEER_BF16
        convert_experts(F, I);
#else
#ifdef PEER_FP6
        convert_experts_fp6(F, I);
#else
        convert_experts_fp8(F, I);
#endif
#endif
        pg8::Gemm g{(const bf16_t*)(ws + WS_MG), (const bf16_t*)(ws + WS_WOUT), T, 2048, 2048, 2048}; pg8::StaticOrder S; S.init(T, 2048, F.G, (int)blockIdx.x);
        EpiRes E{I.x, (float*)(ws + WS_X2), (bf16_t*)(ws + WS_X2B), ssq2};
        pg8::gemm_phase<EpiRes, pg8::StaticOrder, PG8_ALIGN, PG8_SP2>(F.lds + RING_OFF, g, S, E);
        if (BOTH(6)) GRID_BAR();
    }
    PSTAMP(7);
    if (IN(7)) {
        pg8::Gemm g{(const bf16_t*)(ws + WS_X2B), (const bf16_t*)(ws + WS_WQP), T, 2048, 2048, 2048}; pg8::StaticOrder S; S.init(T, 2048, F.G, (int)blockIdx.x);
        EpiQP E{(bf16_t*)(ws + WS_QP), ssq2, (const LAS float*)(F.lds + RTAB_OFF), {-1, -1, -1, -1}};
        {
            LAS float* tab = (LAS float*)(F.lds + RTAB_OFF); pg8::Unit u;
#pragma unroll
            for (int i = 0; i < RTAB_SLOTS; ++i) {
                if (S.next(i, u)) {
                    E.pms[i] = u.pm;
                    const int r = F.tid >> 1, hf = F.tid & 1; const float* p = ssq2 + ((size_t)u.pm * 256 + r) * 32 + hf * 16;
                    const f32x4 q0 = *(const f32x4*)p, q1 = *(const f32x4*)(p + 4), q2 = *(const f32x4*)(p + 8), q3 = *(const f32x4*)(p + 12);
                    float t = (((q0[0] + q0[1]) + (q0[2] + q0[3])) + ((q1[0] + q1[1]) + (q1[2] + q1[3]))) + (((q2[0] + q2[1]) + (q2[2] + q2[3])) + ((q3[0] + q3[1]) + (q3[2] + q3[3])));
                    t += __shfl_xor(t, 1);
                    if (hf == 0) tab[i * 256 + r] = 1.0f / sqrtf(t * (1.0f / 2048.0f) + EPS);
                }
            }
            __syncthreads();
        }
        pg8::gemm_phase<EpiQP, pg8::StaticOrder, PG8_ALIGN, PG8_SP2>(F.lds + RING_OFF, g, S, E);
        if (BOTH(7)) GRID_BAR();
    }
    PSTAMP(8);
#if defined(ROUTE_REF) || defined(PEER_BF16) || defined(NO_FUSE89)
#ifdef ROUTE_REF
    if (IN(8)) { p7_routing_ref(F); if (BOTH(8)) GRID_BAR(); }
#else
    if (IN(8)) { p8_routing(F, I); if (BOTH(8)) GRID_BAR(); }
#endif
    PSTAMP(9);
#ifdef PEER_BF16
    if (IN(9)) { p8_gather(F, I, args.out); }
#else
    if (IN(9)) { p9_gather_fp8(F, I, args.out); }
#endif
#else
    if (IN(8) && IN(9)) { p89_route_gather(F, I, args.out); }
    PSTAMP(9);
#endif
    PSTAMP(10);
#ifdef PROBE_PH
    if (blockIdx.x == 0 && F.tid == 0) {
        const unsigned long long span = (pstamp[PROBE_PH + 1] - pstamp[PROBE_PH]) * PROBE_MUL, t0 = __builtin_amdgcn_s_memrealtime();
        while (__builtin_amdgcn_s_memrealtime() - t0 < span) __builtin_amdgcn_s_sleep(32);
    }
#endif
#undef IN
#undef BOTH
}

extern "C" void kernel_launch(void* const* d_in, const int* in_sizes, int n_in, void* d_out, int out_size, void* d_ws, size_t ws_size, hipStream_t stream) {
    static int grid = 0;
    if (grid == 0) {
        if (n_in != 19 || out_size != T * D_MODEL || ws_size < WS_END) { fprintf(stderr, "kernel_launch: unexpected shapes: n_in %d out %d ws %zu\n", n_in, out_size, ws_size); grid = -1; return; }
        int dev = 0, cus = 0, per_cu = 0;
        if (hipGetDevice(&dev) != hipSuccess || hipDeviceGetAttribute(&cus, hipDeviceAttributeMultiprocessorCount, dev) != hipSuccess) { grid = -1; return; }
        if (hipFuncSetAttribute((const void*)mega_fwd, hipFuncAttributeMaxDynamicSharedMemorySize, LDS_BYTES) != hipSuccess) { fprintf(stderr, "kernel_launch: hipFuncSetAttribute failed\n"); grid = -1; return; }
        if (hipOccupancyMaxActiveBlocksPerMultiprocessor(&per_cu, (const void*)mega_fwd, NWAVES * 64, LDS_BYTES) != hipSuccess || per_cu < 1)
            fprintf(stderr, "kernel_launch: occupancy query reports %d workgroups per CU\n", per_cu);
        (void)hipGetLastError();
        grid = cus;
    }
    if (grid < 0) return;
    if (hipMemsetAsync((char*)d_ws + WS_CTL, 0, CTL_ZERO_BYTES, stream) != hipSuccess) { fprintf(stderr, "kernel_launch: memset failed\n"); return; }
    Args a{};
    const float** ip = (const float**)&a.in;
    for (int i = 0; i < 19; ++i) ip[i] = (const float*)d_in[i];
    a.out = (float*)d_out; a.ws = (unsigned char*)d_ws;
    for (int i = 0; i < 32; ++i) a.inv_freq[i] = pow(10000.0, -(double)i / 32.0);
#if MK_N_LAUNCHES == 1
    a.ph_lo = 0; a.ph_hi = NPHASE;
    hipLaunchKernelGGL(mega_fwd, dim3(grid), dim3(NWAVES * 64), LDS_BYTES, stream, a);
#else
    for (int p = 0; p < NPHASE; ++p) { a.ph_lo = p; a.ph_hi = p + 1; hipLaunchKernelGGL(mega_fwd, dim3(grid), dim3(NWAVES * 64), LDS_BYTES, stream, a); }
#endif
    const hipError_t le = hipPeekAtLastError();
    if (le != hipSuccess) fprintf(stderr, "kernel_launch: launch failed: %s\n", hipGetErrorName(le));
}
```

```cpp
#include <hip/hip_runtime.h>
#include <cstdio>
#include <cstdint>
#include <cmath>

#ifndef MK_N_LAUNCHES
#define MK_N_LAUNCHES 1
#endif

constexpr int D_MODEL = 2048, BATCH = 2, SEQ = 8192, T = BATCH * SEQ;
constexpr int OFF_CQ = 0, OFF_CKV = 768, OFF_KR = 1280, OFF_DQ = 1344, OFF_DK = 2368, OFF_DV = 3392, OFF_GATE = 4416, IN_COLS = 8512;
constexpr int N1 = 3072;
constexpr int NG = 5632;
constexpr float W1_SCALE = 32.0f;
constexpr int NEXP = 16384;
constexpr float EPS = 1e-6f;
constexpr float LOG2E = 1.4426950408889634f;
constexpr float C2_MLA = 0.07216878364870322f * LOG2E;
constexpr float C2_DIFF = 0.125f * LOG2E;
constexpr float LAMBDA_INIT = 0.2f;

namespace pg8 {
#define PG8_LAS __attribute__((address_space(3)))
typedef unsigned short bf16_t;
typedef short bf16x8 __attribute__((ext_vector_type(8)));
typedef float f32x4 __attribute__((ext_vector_type(4)));
typedef unsigned u32x4 __attribute__((ext_vector_type(4)));
typedef unsigned u32x2 __attribute__((ext_vector_type(2)));
typedef int v8i32 __attribute__((ext_vector_type(8)));
constexpr int BM = 256, BK = 64, HALF = 128, HTB = HALF * BK * 2, STAGE_BYTES = 8 * HTB, NXCD = 8, WGM = 8;

__host__ __device__ __forceinline__ int lds_byte(int r, int c) { const int st = (r >> 4) * 2 + (c >> 5), rr = r & 15, cc = c & 31, ob = rr * 64 + cc * 2; return st * 1024 + (ob ^ (((ob >> 9) & 1) << 5)); }
__host__ __device__ __forceinline__ void stage_rc(int b, int& R, int& C) { const int st = b / 1024, sb = b % 1024, swz = sb ^ (((sb >> 9) & 1) << 5); R = (st >> 1) * 16 + swz / 64; C = (st & 1) * 32 + (swz % 64) / 2; }
__host__ __device__ __forceinline__ int perm32(int rho) { const int n = rho >> 4, i = rho & 15; return 8 * (i >> 2) + 4 * n + (i & 3); }

struct Unit { int pm, pn; };
struct Gemm { const bf16_t* A; const bf16_t* Bt; int M, N, K, lda; float oscale; };

struct StaticOrder {
    int nM, nN, nwg, G, c;
    __host__ __device__ __forceinline__ void init(int M, int N, int G_, int c_) { nM = M / BM; nN = N / BM; nwg = nM * nN; G = G_; c = c_; }
    __host__ __device__ __forceinline__ bool next(int i, Unit& u) const { return map((long)i * G + c, u); }
    __host__ __device__ __forceinline__ bool map(long L, Unit& u) const {
        if (L >= nwg) return false;
        int wgid = (int)L; { const int q = nwg / NXCD, r = nwg % NXCD, xcd = wgid % NXCD, off = wgid / NXCD; wgid = (xcd < r ? xcd * (q + 1) : r * (q + 1) + (xcd - r) * q) + off; }
        const int nig = WGM * nN, gid = wgid / nig, fm = gid * WGM, gsz = (nM - fm) < WGM ? (nM - fm) : WGM;
        u.pm = fm + ((wgid % nig) % gsz); u.pn = (wgid % nig) / gsz; return true;
    }
    __device__ __forceinline__ void a_ready(const Unit&) const {}
    __device__ __forceinline__ void done(const Unit&) const {}
};

struct GateOrder : StaticOrder {
    __host__ __device__ __forceinline__ bool next(int i, Unit& u) const {
        if (G != 256 || nwg != 1024) return StaticOrder::next(i, u);
        if (i < 3) return map((long)i * 256 + c, u);
        if (c >= 128 && i < 5) return map(768 + (long)(i - 3) * 128 + (c - 128), u);
        return false;
    }
};
typedef float f32x2_t __attribute__((ext_vector_type(2))); typedef __bf16 bf16x2_t __attribute__((ext_vector_type(2)));
__device__ __forceinline__ unsigned cvtpk(float lo, float hi) { f32x2_t v = {lo, hi}; bf16x2_t b = __builtin_convertvector(v, bf16x2_t); return __builtin_bit_cast(unsigned, b); }
__device__ __forceinline__ float bf2f(unsigned short h) { return __builtin_bit_cast(float, (unsigned)h << 16); }
__device__ __forceinline__ float bflo(unsigned w) { return __builtin_bit_cast(float, w << 16); }
__device__ __forceinline__ float bfhi(unsigned w) { return __builtin_bit_cast(float, w & 0xffff0000u); }

template <class Epi, class Sched, bool ALIGN_EPI = false, bool SP2 = false, bool FP8 = false>
__device__ __forceinline__ void gemm_phase(PG8_LAS unsigned char* lds, const Gemm g, const Sched& S, const Epi& E) {
    const int tid = threadIdx.x, wid = __builtin_amdgcn_readfirstlane(tid >> 6), lane = tid & 63, wr = wid >> 2, wc = wid & 3, fr = lane & 15, fq = lane >> 4;
    const int K = g.K, nt = K / BK, lda = g.lda;
    unsigned voffA[2], voffB[2];
#pragma unroll
    for (int i = 0; i < 2; ++i) { int R, C; stage_rc(tid * 16 + i * 8192, R, C); const int Rb = Epi::PERM ? ((R & ~31) + perm32(R & 31)) : R;
        voffA[i] = (unsigned)(R * lda + C) * 2u; voffB[i] = (unsigned)(Rb * K + C) * 2u; }
    const size_t kstep = (size_t)(BK * 2);
    const size_t hstepA = (size_t)HALF * lda * 2, hstepB = (size_t)HALF * K * 2;
    const size_t tstepA = 2 * hstepA, tstepB = 2 * hstepB;
    const unsigned ldsw = (unsigned)wid * 1024u;
    const int aoff = lds_byte(wr * 64 + fr, fq * 8), boff = lds_byte(wc * 32 + fr, fq * 8);
    const int aoff8 = lds_byte(wr * 64 + fr, 16 * fq) & ~31, boff8 = lds_byte(wc * 32 + fr, 16 * fq) & ~31;
#define PG8_SA(b, h) (((b) * 2 + (h)) * HTB)
#define PG8_SB(b, h) ((4 + (b) * 2 + (h)) * HTB)
#define PG8_STAGE(bufoff, gbase, voff) do { _Pragma("unroll") for (int _i = 0; _i < 2; ++_i) \
        __builtin_amdgcn_global_load_lds((const unsigned*)((const char*)(gbase) + (voff)[_i]), (PG8_LAS unsigned*)(lds + (bufoff) + ldsw + _i * 8192), 16, 0, 0); } while (0)
#define PG8_LDA(dst, b, h) do { _Pragma("unroll") for (int m = 0; m < 4; ++m) _Pragma("unroll") for (int k = 0; k < 2; ++k) { if constexpr (FP8) { if (k == 0) dst##8[m] = *(const PG8_LAS v8i32*)(lds + PG8_SA(b, h) + aoff8 + m * 2048); } else dst[m][k] = *(const PG8_LAS bf16x8*)(lds + PG8_SA(b, h) + aoff + m * 2048 + k * 1024); } } while (0)
#define PG8_LDB(dst, b, h) do { _Pragma("unroll") for (int n = 0; n < 2; ++n) _Pragma("unroll") for (int k = 0; k < 2; ++k) { if constexpr (FP8) { if (k == 0) dst##8[n] = *(const PG8_LAS v8i32*)(lds + PG8_SB(b, h) + boff8 + n * 2048); } else dst[n][k] = *(const PG8_LAS bf16x8*)(lds + PG8_SB(b, h) + boff + n * 2048 + k * 1024); } } while (0)
#define PG8_MMA(ai, bj, At, Bt) do { __builtin_amdgcn_s_setprio(1); _Pragma("unroll") for (int m = 0; m < 4; ++m) _Pragma("unroll") for (int n = 0; n < 2; ++n) { if constexpr (FP8) { \
        asm volatile("v_mfma_scale_f32_16x16x128_f8f6f4 %0, %1, %2, %0, %3, %3 op_sel_hi:[0,0,0]" : "+v"(acc[ai][bj][m][n]) : "v"(Bt##8[n]), "v"(At##8[m]), "v"(mxs));   \
        } else { _Pragma("unroll") for (int k = 0; k < 2; ++k) \
        acc[ai][bj][m][n] = __builtin_amdgcn_mfma_f32_16x16x32_bf16(Bt[n][k], At[m][k], acc[ai][bj][m][n], 0, 0, 0); } } __builtin_amdgcn_s_setprio(0); } while (0)
#define PG8_WAIT_V(n) asm volatile("s_waitcnt vmcnt(" #n ")" ::: "memory")
#define PG8_WAIT_L(n) asm volatile("s_waitcnt lgkmcnt(" #n ")" ::: "memory")
#define PG8_BAR __builtin_amdgcn_s_barrier()
#define PG8_SCHED __builtin_amdgcn_sched_barrier(0)
    Unit cur, nxt; int ui = 0;
    if (!S.next(0, cur)) return;
    f32x4 acc[2][2][4][2];
#pragma unroll
    for (int a = 0; a < 2; ++a)
#pragma unroll
        for (int b = 0; b < 2; ++b)
#pragma unroll
            for (int m = 0; m < 4; ++m)
#pragma unroll
                for (int n = 0; n < 2; ++n) acc[a][b][m][n] = (f32x4){0.f, 0.f, 0.f, 0.f};
    bf16x8 At[4][2], B0[2][2], B1[2][2];
    v8i32 At8[4], B08[2], B18[2];
    const int mxs = 0x7F7F7F7F;
    const char* cA = (const char*)g.A + (size_t)cur.pm * tstepA; const char* cB = (const char*)g.Bt + (size_t)cur.pn * tstepB;
    S.a_ready(cur);
    if constexpr (SP2) {
        PG8_STAGE(PG8_SB(0, 0), cB, voffB); PG8_STAGE(PG8_SB(0, 1), cB + hstepB, voffB); PG8_STAGE(PG8_SA(0, 0), cA, voffA); PG8_STAGE(PG8_SA(0, 1), cA + hstepA, voffA);
        if (wr == 1) PG8_BAR;
        PG8_WAIT_V(2); PG8_BAR;
        PG8_STAGE(PG8_SB(1, 0), cB + kstep, voffB); PG8_STAGE(PG8_SA(1, 0), cA + kstep, voffA); PG8_STAGE(PG8_SB(1, 1), cB + hstepB + kstep, voffB);
        PG8_WAIT_V(6); PG8_BAR;
    } else {
        PG8_STAGE(PG8_SB(0, 0), cB, voffB); PG8_STAGE(PG8_SA(0, 0), cA, voffA); PG8_STAGE(PG8_SB(0, 1), cB + hstepB, voffB); PG8_STAGE(PG8_SA(0, 1), cA + hstepA, voffA);
        if (wr == 1) PG8_BAR;
        PG8_WAIT_V(4); PG8_BAR;
        PG8_STAGE(PG8_SB(1, 0), cB + kstep, voffB); PG8_STAGE(PG8_SA(1, 0), cA + kstep, voffA); PG8_STAGE(PG8_SB(1, 1), cB + hstepB + kstep, voffB);
        PG8_WAIT_V(6); PG8_BAR;
    }
    for (;;) {
        const bool has_next = S.next(ui + 1, nxt);
        const char* nA = has_next ? (const char*)g.A + (size_t)nxt.pm * tstepA : cA; const char* nB = has_next ? (const char*)g.Bt + (size_t)nxt.pn * tstepB : cB;
        for (int t = 0; t < nt; t += 2) {
            const bool last = (t == nt - 2);
            const char* a1 = cA + (size_t)(t + 1) * kstep;
            const char* a2 = last ? nA : cA + (size_t)(t + 2) * kstep; const char* b2 = last ? nB : cB + (size_t)(t + 2) * kstep;
            const char* a3 = a2 + kstep; const char* b3 = b2 + kstep;
            if (last && has_next) S.a_ready(nxt);
            if constexpr (SP2) {
            PG8_LDB(B0, 0, 0); PG8_LDB(B1, 0, 1); PG8_SCHED; PG8_LDA(At, 0, 0); PG8_STAGE(PG8_SA(1, 1), a1 + hstepA, voffA);
            PG8_WAIT_V(8); PG8_WAIT_L(0); PG8_BAR; PG8_MMA(0, 0, At, B0); PG8_MMA(0, 1, At, B1); PG8_BAR; PG8_SCHED;
            PG8_LDA(At, 0, 1); PG8_STAGE(PG8_SB(0, 0), b2, voffB); PG8_STAGE(PG8_SB(0, 1), b2 + hstepB, voffB); PG8_STAGE(PG8_SA(0, 0), a2, voffA);
            PG8_WAIT_V(8); PG8_WAIT_L(0); PG8_BAR; PG8_MMA(1, 0, At, B0); PG8_MMA(1, 1, At, B1); PG8_BAR; PG8_SCHED;
            PG8_LDB(B0, 1, 0); PG8_LDB(B1, 1, 1); PG8_SCHED; PG8_LDA(At, 1, 0); PG8_STAGE(PG8_SA(0, 1), a2 + hstepA, voffA);
            PG8_WAIT_V(8); PG8_WAIT_L(0); PG8_BAR; PG8_MMA(0, 0, At, B0); PG8_MMA(0, 1, At, B1); PG8_BAR; PG8_SCHED;
            PG8_LDA(At, 1, 1); PG8_STAGE(PG8_SB(1, 0), b3, voffB); PG8_STAGE(PG8_SB(1, 1), b3 + hstepB, voffB); PG8_STAGE(PG8_SA(1, 0), a3, voffA);
            PG8_WAIT_V(8); PG8_WAIT_L(0); PG8_BAR; PG8_MMA(1, 0, At, B0); PG8_MMA(1, 1, At, B1); PG8_BAR; PG8_SCHED;
            } else {
            PG8_LDB(B0, 0, 0); PG8_SCHED; PG8_LDA(At, 0, 0); PG8_STAGE(PG8_SA(1, 1), a1 + hstepA, voffA);
            PG8_WAIT_L(8); PG8_BAR; PG8_WAIT_L(0); PG8_MMA(0, 0, At, B0); PG8_BAR; PG8_SCHED;
            PG8_LDB(B1, 0, 1); PG8_STAGE(PG8_SB(0, 0), b2, voffB);
            PG8_BAR; PG8_WAIT_L(0); PG8_MMA(0, 1, At, B1); PG8_BAR;
            PG8_LDA(At, 0, 1); PG8_STAGE(PG8_SA(0, 0), a2, voffA);
            PG8_BAR; PG8_WAIT_L(0); PG8_MMA(1, 0, At, B0); PG8_BAR; PG8_SCHED;
            PG8_STAGE(PG8_SB(0, 1), b2 + hstepB, voffB);
            PG8_WAIT_V(6); PG8_BAR; PG8_MMA(1, 1, At, B1); PG8_BAR;
            PG8_LDB(B0, 1, 0); PG8_SCHED; PG8_LDA(At, 1, 0); PG8_STAGE(PG8_SA(0, 1), a2 + hstepA, voffA);
            PG8_WAIT_L(8); PG8_BAR; PG8_WAIT_L(0); PG8_MMA(0, 0, At, B0); PG8_BAR; PG8_SCHED;
            PG8_LDB(B1, 1, 1); PG8_STAGE(PG8_SB(1, 0), b3, voffB);
            PG8_BAR; PG8_WAIT_L(0); PG8_MMA(0, 1, At, B1); PG8_BAR;
            PG8_LDA(At, 1, 1); PG8_STAGE(PG8_SA(1, 0), a3, voffA);
            PG8_BAR; PG8_WAIT_L(0); PG8_MMA(1, 0, At, B0); PG8_BAR; PG8_SCHED;
            PG8_STAGE(PG8_SB(1, 1), b3 + hstepB, voffB);
            PG8_WAIT_V(6); PG8_BAR; PG8_MMA(1, 1, At, B1); PG8_BAR;
            }
        }
        if constexpr (ALIGN_EPI) { if (wr == 0) PG8_BAR; }
        if constexpr (FP8) {
            asm volatile("s_nop 15\n\ts_nop 7" ::: "memory");
#pragma unroll
            for (int a = 0; a < 2; ++a)
#pragma unroll
                for (int b = 0; b < 2; ++b)
#pragma unroll
                    for (int m = 0; m < 4; ++m)
#pragma unroll
                        for (int n = 0; n < 2; ++n) acc[a][b][m][n] *= g.oscale; }
        E(acc, cur, wr, wc, fr, fq); S.done(cur);
        if (!has_next) break;
#pragma unroll
        for (int a = 0; a < 2; ++a)
#pragma unroll
            for (int b = 0; b < 2; ++b)
#pragma unroll
                for (int m = 0; m < 4; ++m)
#pragma unroll
                    for (int n = 0; n < 2; ++n) acc[a][b][m][n] = (f32x4){0.f, 0.f, 0.f, 0.f};
        cur = nxt; cA = nA; cB = nB; ++ui;
        if constexpr (ALIGN_EPI) { if (wr == 1) PG8_BAR; }
    }
    PG8_WAIT_V(0);
    if constexpr (!ALIGN_EPI) { if (wr == 0) PG8_BAR; }
    PG8_BAR;
#undef PG8_SA
#undef PG8_SB
#undef PG8_STAGE
#undef PG8_LDA
#undef PG8_LDB
#undef PG8_MMA
#undef PG8_WAIT_V
#undef PG8_WAIT_L
#undef PG8_BAR
#undef PG8_SCHED
}
struct Gemm2 { const bf16_t *A1, *A2, *B1, *B2; int M, N, K1, lda; };
template <class Epi, class Sched, bool ALIGN_EPI = false, bool SP2 = false>
__device__ __forceinline__ void gemm_phase2(PG8_LAS unsigned char* lds, const Gemm2 g, const Sched& S, const Epi& E) {
    const int tid = threadIdx.x, wid = __builtin_amdgcn_readfirstlane(tid >> 6), lane = tid & 63, wr = wid >> 2, wc = wid & 3, fr = lane & 15, fq = lane >> 4;
    const int K = g.K1, nt = K / BK, lda = g.lda;
    unsigned voffA[2], voffB[2];
#pragma unroll
    for (int i = 0; i < 2; ++i) { int R, C; stage_rc(tid * 16 + i * 8192, R, C); const int Rb = Epi::PERM ? ((R & ~31) + perm32(R & 31)) : R;
        voffA[i] = (unsigned)(R * lda + C) * 2u; voffB[i] = (unsigned)(Rb * K + C) * 2u; }
    const size_t kstep = (size_t)(BK * 2);
    const size_t hstepA = (size_t)HALF * lda * 2, hstepB = (size_t)HALF * K * 2;
    const size_t tstepA = 2 * hstepA, tstepB = 2 * hstepB;
    const unsigned ldsw = (unsigned)wid * 1024u;
    const int aoff = lds_byte(wr * 64 + fr, fq * 8), boff = lds_byte(wc * 32 + fr, fq * 8);
#define PG8_SA(b, h) (((b) * 2 + (h)) * HTB)
#define PG8_SB(b, h) ((4 + (b) * 2 + (h)) * HTB)
#define PG8_STAGE(bufoff, gbase, voff) do { _Pragma("unroll") for (int _i = 0; _i < 2; ++_i) \
        __builtin_amdgcn_global_load_lds((const unsigned*)((const char*)(gbase) + (voff)[_i]), (PG8_LAS unsigned*)(lds + (bufoff) + ldsw + _i * 8192), 16, 0, 0); } while (0)
#define PG8_LDA(dst, b, h) do { _Pragma("unroll") for (int m = 0; m < 4; ++m) _Pragma("unroll") for (int k = 0; k < 2; ++k) dst[m][k] = *(const PG8_LAS bf16x8*)(lds + PG8_SA(b, h) + aoff + m * 2048 + k * 1024); } while (0)
#define PG8_LDB(dst, b, h) do { _Pragma("unroll") for (int n = 0; n < 2; ++n) _Pragma("unroll") for (int k = 0; k < 2; ++k) dst[n][k] = *(const PG8_LAS bf16x8*)(lds + PG8_SB(b, h) + boff + n * 2048 + k * 1024); } while (0)
#define PG8_MMA(ai, bj, At, Bt) do { __builtin_amdgcn_s_setprio(1); _Pragma("unroll") for (int m = 0; m < 4; ++m) _Pragma("unroll") for (int n = 0; n < 2; ++n) _Pragma("unroll") for (int k = 0; k < 2; ++k) \
        acc[ai][bj][m][n] = __builtin_amdgcn_mfma_f32_16x16x32_bf16(Bt[n][k], At[m][k], acc[ai][bj][m][n], 0, 0, 0); __builtin_amdgcn_s_setprio(0); } while (0)
#define PG8_WAIT_V(n) asm volatile("s_waitcnt vmcnt(" #n ")" ::: "memory")
#define PG8_WAIT_L(n) asm volatile("s_waitcnt lgkmcnt(" #n ")" ::: "memory")
#define PG8_BAR __builtin_amdgcn_s_barrier()
#define PG8_SCHED __builtin_amdgcn_sched_barrier(0)
    Unit cur, nxt; int ui = 0;
    if (!S.next(0, cur)) return;
    f32x4 acc[2][2][4][2];
#pragma unroll
    for (int a = 0; a < 2; ++a)
#pragma unroll
        for (int b = 0; b < 2; ++b)
#pragma unroll
            for (int m = 0; m < 4; ++m)
#pragma unroll
                for (int n = 0; n < 2; ++n) acc[a][b][m][n] = (f32x4){0.f, 0.f, 0.f, 0.f};
    bf16x8 At[4][2], B0[2][2], B1[2][2];
    const char* cA = (const char*)g.A1 + (size_t)cur.pm * tstepA; const char* cB = (const char*)g.B1 + (size_t)cur.pn * tstepB;
    S.a_ready(cur);
    if constexpr (SP2) {
        PG8_STAGE(PG8_SB(0, 0), cB, voffB); PG8_STAGE(PG8_SB(0, 1), cB + hstepB, voffB); PG8_STAGE(PG8_SA(0, 0), cA, voffA); PG8_STAGE(PG8_SA(0, 1), cA + hstepA, voffA);
        if (wr == 1) PG8_BAR;
        PG8_WAIT_V(2); PG8_BAR;
        PG8_STAGE(PG8_SB(1, 0), cB + kstep, voffB); PG8_STAGE(PG8_SA(1, 0), cA + kstep, voffA); PG8_STAGE(PG8_SB(1, 1), cB + hstepB + kstep, voffB);
        PG8_WAIT_V(6); PG8_BAR;
    } else {
        PG8_STAGE(PG8_SB(0, 0), cB, voffB); PG8_STAGE(PG8_SA(0, 0), cA, voffA); PG8_STAGE(PG8_SB(0, 1), cB + hstepB, voffB); PG8_STAGE(PG8_SA(0, 1), cA + hstepA, voffA);
        if (wr == 1) PG8_BAR;
        PG8_WAIT_V(4); PG8_BAR;
        PG8_STAGE(PG8_SB(1, 0), cB + kstep, voffB); PG8_STAGE(PG8_SA(1, 0), cA + kstep, voffA); PG8_STAGE(PG8_SB(1, 1), cB + hstepB + kstep, voffB);
        PG8_WAIT_V(6); PG8_BAR;
    }
    for (;;) {
        const int nhalf = (ui + 1) & 1;
        const bool has_next = S.next((ui + 1) >> 1, nxt);
        const char* nA = has_next ? (const char*)(nhalf ? g.A2 : g.A1) + (size_t)nxt.pm * tstepA : cA; const char* nB = has_next ? (const char*)(nhalf ? g.B2 : g.B1) + (size_t)nxt.pn * tstepB : cB;
        for (int t = 0; t < nt; t += 2) {
            const bool last = (t == nt - 2);
            const char* a1 = cA + (size_t)(t + 1) * kstep;
            const char* a2 = last ? nA : cA + (size_t)(t + 2) * kstep; const char* b2 = last ? nB : cB + (size_t)(t + 2) * kstep;
            const char* a3 = a2 + kstep; const char* b3 = b2 + kstep;
            if (last && has_next) S.a_ready(nxt);
            if constexpr (SP2) {
            PG8_LDB(B0, 0, 0); PG8_LDB(B1, 0, 1); PG8_SCHED; PG8_LDA(At, 0, 0); PG8_STAGE(PG8_SA(1, 1), a1 + hstepA, voffA);
            PG8_WAIT_V(8); PG8_WAIT_L(0); PG8_BAR; PG8_MMA(0, 0, At, B0); PG8_MMA(0, 1, At, B1); PG8_BAR; PG8_SCHED;
            PG8_LDA(At, 0, 1); PG8_STAGE(PG8_SB(0, 0), b2, voffB); PG8_STAGE(PG8_SB(0, 1), b2 + hstepB, voffB); PG8_STAGE(PG8_SA(0, 0), a2, voffA);
            PG8_WAIT_V(8); PG8_WAIT_L(0); PG8_BAR; PG8_MMA(1, 0, At, B0); PG8_MMA(1, 1, At, B1); PG8_BAR; PG8_SCHED;
            PG8_LDB(B0, 1, 0); PG8_LDB(B1, 1, 1); PG8_SCHED; PG8_LDA(At, 1, 0); PG8_STAGE(PG8_SA(0, 1), a2 + hstepA, voffA);
            PG8_WAIT_V(8); PG8_WAIT_L(0); PG8_BAR; PG8_MMA(0, 0, At, B0); PG8_MMA(0, 1, At, B1); PG8_BAR; PG8_SCHED;
            PG8_LDA(At, 1, 1); PG8_STAGE(PG8_SB(1, 0), b3, voffB); PG8_STAGE(PG8_SB(1, 1), b3 + hstepB, voffB); PG8_STAGE(PG8_SA(1, 0), a3, voffA);
            PG8_WAIT_V(8); PG8_WAIT_L(0); PG8_BAR; PG8_MMA(1, 0, At, B0); PG8_MMA(1, 1, At, B1); PG8_BAR; PG8_SCHED;
            } else {
            PG8_LDB(B0, 0, 0); PG8_SCHED; PG8_LDA(At, 0, 0); PG8_STAGE(PG8_SA(1, 1), a1 + hstepA, voffA);
            PG8_WAIT_L(8); PG8_BAR; PG8_WAIT_L(0); PG8_MMA(0, 0, At, B0); PG8_BAR; PG8_SCHED;
            PG8_LDB(B1, 0, 1); PG8_STAGE(PG8_SB(0, 0), b2, voffB);
            PG8_BAR; PG8_WAIT_L(0); PG8_MMA(0, 1, At, B1); PG8_BAR;
            PG8_LDA(At, 0, 1); PG8_STAGE(PG8_SA(0, 0), a2, voffA);
            PG8_BAR; PG8_WAIT_L(0); PG8_MMA(1, 0, At, B0); PG8_BAR; PG8_SCHED;
            PG8_STAGE(PG8_SB(0, 1), b2 + hstepB, voffB);
            PG8_WAIT_V(6); PG8_BAR; PG8_MMA(1, 1, At, B1); PG8_BAR;
            PG8_LDB(B0, 1, 0); PG8_SCHED; PG8_LDA(At, 1, 0); PG8_STAGE(PG8_SA(0, 1), a2 + hstepA, voffA);
            PG8_WAIT_L(8); PG8_BAR; PG8_WAIT_L(0); PG8_MMA(0, 0, At, B0); PG8_BAR; PG8_SCHED;
            PG8_LDB(B1, 1, 1); PG8_STAGE(PG8_SB(1, 0), b3, voffB);
            PG8_BAR; PG8_WAIT_L(0); PG8_MMA(0, 1, At, B1); PG8_BAR;
            PG8_LDA(At, 1, 1); PG8_STAGE(PG8_SA(1, 0), a3, voffA);
            PG8_BAR; PG8_WAIT_L(0); PG8_MMA(1, 0, At, B0); PG8_BAR; PG8_SCHED;
            PG8_STAGE(PG8_SB(1, 1), b3 + hstepB, voffB);
            PG8_WAIT_V(6); PG8_BAR; PG8_MMA(1, 1, At, B1); PG8_BAR;
            }
        }
        if constexpr (ALIGN_EPI) { if (wr == 0) PG8_BAR; }
        if ((ui & 1) == 0) E.mid(acc, cur, wr, wc, fr, fq); else { E(acc, cur, wr, wc, fr, fq); S.done(cur); }
        if (!has_next) break;
        if (ui & 1)
#pragma unroll
        for (int a = 0; a < 2; ++a)
#pragma unroll
            for (int b = 0; b < 2; ++b)
#pragma unroll
                for (int m = 0; m < 4; ++m)
#pragma unroll
                    for (int n = 0; n < 2; ++n) acc[a][b][m][n] = (f32x4){0.f, 0.f, 0.f, 0.f};
        cur = nxt; cA = nA; cB = nB; ++ui;
        if constexpr (ALIGN_EPI) { if (wr == 1) PG8_BAR; }
    }
    PG8_WAIT_V(0);
    if constexpr (!ALIGN_EPI) { if (wr == 0) PG8_BAR; }
    PG8_BAR;
#undef PG8_SA
#undef PG8_SB
#undef PG8_STAGE
#undef PG8_LDA
#undef PG8_LDB
#undef PG8_MMA
#undef PG8_WAIT_V
#undef PG8_WAIT_L
#undef PG8_BAR
#undef PG8_SCHED
}
}

#ifndef PG8_SP2
#define PG8_SP2 true
#endif
#ifndef PG8_ALIGN
#define PG8_ALIGN true
#endif

using pg8::bf16_t; using pg8::f32x4; using pg8::u32x4; using pg8::u32x2; using pg8::cvtpk; using pg8::bf2f; using pg8::bflo; using pg8::bfhi;

constexpr size_t MiB = 1u << 20;
constexpr size_t WS_CTL = 0, CTL_ZERO_BYTES = 32 * 1024;
constexpr size_t WS_ROPE = 1 * MiB;
constexpr size_t WS_WUQ = 3 * MiB, WS_WUKV = 6 * MiB, WS_WOM = 8 * MiB, WS_WOD = 12 * MiB, WS_WOUT = 16 * MiB, WS_WQP = 24 * MiB;
constexpr size_t WS_SKB = 5 * MiB + 512 * 1024;
constexpr size_t WS_W1 = 32 * MiB;
constexpr size_t WS_W8 = 44 * MiB;
constexpr size_t WS_H8 = 396 * MiB;
constexpr size_t WS_H = 66 * MiB;
constexpr size_t WS_CQ = 130 * MiB, WS_CKV = 154 * MiB;
constexpr size_t WS_KR = 170 * MiB, WS_DQ = 172 * MiB, WS_DK = 204 * MiB, WS_DV = 236 * MiB;
constexpr size_t WS_G = 268 * MiB;
constexpr size_t WS_QN = 32 * MiB, WS_QR = 64 * MiB, WS_KN = 80 * MiB, WS_V = 396 * MiB;
constexpr size_t WS_OM = 112 * MiB, WS_OD = 428 * MiB;
constexpr size_t WS_TMP = 32 * MiB;
constexpr size_t WS_MG = 172 * MiB;
constexpr size_t WS_X2 = 268 * MiB;
constexpr size_t WS_X2B = 396 * MiB;
constexpr size_t WS_EU = 32 * MiB, WS_EV = 96 * MiB;
constexpr size_t WS_QP = 172 * MiB;
constexpr size_t WS_IDX = 236 * MiB, WS_GT = 244 * MiB;
constexpr size_t WS_PSQ_Q = 460 * MiB, WS_PSQ_KV = 461 * MiB, WS_PSQ2 = 462 * MiB;
constexpr size_t WS_END = 464 * MiB;
constexpr int CW_TMO = 0, CW_CODE = 1, CW_LAMBDA = 8, CW_TOKCTR = 64;
constexpr int CW_BAR = 4096;

constexpr int RING_OFF = 0, RING_BYTES = 131072;
constexpr int LDSCTL_OFF = RING_BYTES, MISC_OFF = LDSCTL_OFF + 320;
constexpr int LDS_BYTES = 147456;
constexpr int NWAVES = 8;

#define GAS __attribute__((address_space(1)))
#define LAS __attribute__((address_space(3)))
typedef unsigned short bf16;
typedef unsigned v4u __attribute__((ext_vector_type(4)));
typedef GAS unsigned gu32;
#define RLX_AGENT __ATOMIC_RELAXED, __HIP_MEMORY_SCOPE_AGENT
#define LDS_WAIT() asm volatile("s_waitcnt lgkmcnt(0)" ::: "memory")
#define VM_WAIT() asm volatile("s_waitcnt vmcnt(0)" ::: "memory")

#define XB_TMO      128
#define XB_XCNT(j)  (256  + 64 * (j))
#define XB_XSUB(j)  (1280 + 64 * (j))
#define XB_XGEN(j)  (2304 + 64 * (j))
#define XB_TOP      3328
#define XB_TOPGEN   3392
#define XCD_BAR_WORDS 3456
#define XB_SPIN_CAP (1u << 22)
__device__ __forceinline__ unsigned xb_ld(unsigned* p)              { return __hip_atomic_load(p, __ATOMIC_RELAXED, __HIP_MEMORY_SCOPE_AGENT); }
__device__ __forceinline__ unsigned xb_add(unsigned* p, unsigned v) { return __hip_atomic_fetch_add(p, v, __ATOMIC_RELAXED, __HIP_MEMORY_SCOPE_AGENT); }
__device__ __forceinline__ unsigned xb_xcc_id() { return (unsigned)__builtin_amdgcn_s_getreg((3 << 11) | 20) & 0xFu; }
#define XB_SPIN(cond, bar) do { unsigned _sp = 0; while (cond) { __builtin_amdgcn_s_sleep(1); \
    if ((++_sp & 255u) == 0u) { if (xb_ld(&(bar)[XB_TMO])) break; if (_sp > XB_SPIN_CAP) { atomicAdd(&(bar)[XB_TMO], 1u); break; } } } } while (0)
struct XcdBarrier { unsigned* bar; unsigned x; volatile LAS unsigned* st; };
__device__ __forceinline__ XcdBarrier xcd_barrier_post(unsigned* bar, volatile LAS unsigned* st) {
    XcdBarrier b; b.bar = bar; b.x = xb_xcc_id(); b.st = st;
    if (threadIdx.x == 0) (void)xb_add(&bar[XB_XCNT(b.x)], 1u);
    return b;
}
__device__ __forceinline__ void xcd_barrier_complete(unsigned* bar, unsigned x, unsigned& nloc, unsigned& nx) {
    const unsigned G = gridDim.x * gridDim.y * gridDim.z;
    unsigned sum, cnt, mine, sp = 0u;
    for (;;) {
        sum = 0u; cnt = 0u; mine = 0u;
#pragma unroll
        for (unsigned j = 0; j < 16; ++j) { const unsigned c = xb_ld(&bar[XB_XCNT(j)]); sum += c; cnt += (c > 0u) ? 1u : 0u; mine = (j == x) ? c : mine; }
        if (sum == G) break;
        __builtin_amdgcn_s_sleep(1);
        if ((++sp & 255u) == 0u) { if (xb_ld(&bar[XB_TMO])) break; if (sp > XB_SPIN_CAP) { atomicAdd(&bar[XB_TMO], 1u); break; } }
    }
    nloc = mine > 0u ? mine : 1u; nx = cnt > 0u ? cnt : 1u;
}
__device__ __forceinline__ void xcd_barrier(const XcdBarrier& b) {
    asm volatile("s_waitcnt vmcnt(0)" ::: "memory");
    __syncthreads();
    if (threadIdx.x == 0) {
        unsigned* bar = b.bar;
        __builtin_amdgcn_s_waitcnt(0);
        unsigned nloc = b.st[0], nx = b.st[1];
        if (nloc == 0u) { xcd_barrier_complete(bar, b.x, nloc, nx); b.st[0] = nloc; b.st[1] = nx; }
        const unsigned old = xb_add(&bar[XB_XSUB(b.x)], 1u);
        const unsigned gen = old / nloc;
        if (old + 1u == (gen + 1u) * nloc) {
            __builtin_amdgcn_fence(__ATOMIC_RELEASE, "agent");
            asm volatile("s_waitcnt vmcnt(0)" ::: "memory");
            const unsigned og = xb_add(&bar[XB_TOP], 1u);
            const unsigned tg = og / nx;
            if (og + 1u == (tg + 1u) * nx) xb_add(&bar[XB_TOPGEN], 1u);
            else XB_SPIN(xb_ld(&bar[XB_TOPGEN]) == tg, bar);
            __builtin_amdgcn_fence(__ATOMIC_ACQUIRE, "agent");
            xb_add(&bar[XB_XGEN(b.x)], 1u);
            asm volatile("s_waitcnt vmcnt(0)" ::: "memory");
        } else {
            XB_SPIN(xb_ld(&bar[XB_XGEN(b.x)]) == gen, bar);
            __builtin_amdgcn_fence(__ATOMIC_ACQUIRE, "agent");
            asm volatile("s_waitcnt vmcnt(0)" ::: "memory");
        }
    }
    __syncthreads();
}

struct Frame {
    LAS unsigned char* lds;
    volatile LAS unsigned* MISC;
    gu32* ctl;
    unsigned char* ws;
    int tid, lane, wave, vcu, G;
};

__device__ __forceinline__ float wave_sum(float v) {
#pragma unroll
    for (int o = 1; o < 64; o <<= 1) v += __shfl_xor(v, o);
    return v;
}
__device__ __forceinline__ float wave_max(float v) {
#pragma unroll
    for (int o = 1; o < 64; o <<= 1) v = fmaxf(v, __shfl_xor(v, o));
    return v;
}
__device__ __forceinline__ unsigned pk2(float lo, float hi) { return cvtpk(lo, hi); }

template <class Map>
__device__ __forceinline__ void tr_item(const float* W, int Nsrc, int K, const float* kscale, bf16* WT, LAS float* scr, int item, int nblk, int lane, Map map) {
    const int kb = item / nblk, nb = item % nblk, k0 = 64 * kb, n0 = 32 * nb;
    const int sc = map(n0 + (lane & 31));
    float tv[32];
    const int scc = sc >= 0 ? sc : 0;
#pragma unroll
    for (int i = 0; i < 32; ++i) { const int kk = 2 * i + (lane >> 5); tv[i] = W[(size_t)(k0 + kk) * Nsrc + scc]; }
#pragma unroll
    for (int i = 0; i < 32; ++i) { const int kk = 2 * i + (lane >> 5); float v = sc >= 0 ? tv[i] : 0.f; if (kscale) v *= kscale[k0 + kk]; scr[kk * 33 + (lane & 31)] = v; }
    LDS_WAIT(); asm volatile("" ::: "memory");
    const int c = lane & 7;
#pragma unroll
    for (int j = 0; j < 4; ++j) { const int n = (lane >> 3) + 8 * j; const LAS float* s = scr + (8 * c) * 33 + n;
        v4u o; o.x = pk2(s[0 * 33], s[1 * 33]); o.y = pk2(s[2 * 33], s[3 * 33]); o.z = pk2(s[4 * 33], s[5 * 33]); o.w = pk2(s[6 * 33], s[7 * 33]);
        *(GAS v4u*)(WT + (size_t)(n0 + n) * K + k0 + 8 * c) = o; }
    LDS_WAIT(); asm volatile("" ::: "memory");
}
template <class Map>
__device__ __forceinline__ void tr_item8(const float* W, int Nsrc, int K, const float* kscale, float wscale, unsigned char* WT8, LAS float* scr, int item, int nblk, int lane, Map map) {
    const int kb = item / nblk, nb = item % nblk, k0 = 64 * kb, n0 = 32 * nb;
    const int sc = map(n0 + (lane & 31));
    float tv[32];
    const int scc = sc >= 0 ? sc : 0;
#pragma unroll
    for (int i = 0; i < 32; ++i) { const int kk = 2 * i + (lane >> 5); tv[i] = W[(size_t)(k0 + kk) * Nsrc + scc]; }
#pragma unroll
    for (int i = 0; i < 32; ++i) { const int kk = 2 * i + (lane >> 5); float v = sc >= 0 ? tv[i] * wscale : 0.f; if (kscale) v *= kscale[k0 + kk]; scr[kk * 33 + (lane & 31)] = v; }
    LDS_WAIT(); asm volatile("" ::: "memory");
    const int c = lane & 7;
#pragma unroll
    for (int j = 0; j < 4; ++j) { const int n = (lane >> 3) + 8 * j; const LAS float* s = scr + (8 * c) * 33 + n;
        u32x2 o; o.x = (unsigned)__builtin_amdgcn_cvt_pk_fp8_f32(s[2 * 33], s[3 * 33], __builtin_amdgcn_cvt_pk_fp8_f32(s[0 * 33], s[1 * 33], 0, false), true);
        o.y = (unsigned)__builtin_amdgcn_cvt_pk_fp8_f32(s[6 * 33], s[7 * 33], __builtin_amdgcn_cvt_pk_fp8_f32(s[4 * 33], s[5 * 33], 0, false), true);
        *(GAS u32x2*)(WT8 + (size_t)(n0 + n) * K + k0 + 8 * c) = o; }
    LDS_WAIT(); asm volatile("" ::: "memory");
}
__device__ __forceinline__ int rope_src(int jj) { return (jj & 1) * 32 + (jj >> 1); }
struct MapW1 { __device__ int operator()(int n) const {
    if (n < 1024) return OFF_DQ + (n & ~63) + rope_src(n & 63);
    if (n < 2048) { const int j = n - 1024; return OFF_DK + (j & ~63) + rope_src(j & 63); }
    return OFF_DV + (n - 2048); } };
struct MapGate { __device__ int operator()(int n) const {
    if (n < 4096) return OFF_GATE + n;
    if (n < 5376) return n - 4096;
    if (n < 5440) return OFF_KR + rope_src(n - 5376);
    return -1; } };
struct MapUQ { __device__ int operator()(int n) const {
    if (n < 1024) return (n >> 7) * 192 + (n & 127);
    const int j = n - 1024; return (j >> 6) * 192 + 128 + rope_src(j & 63); } };
struct MapUKV { __device__ int operator()(int n) const {
    if (n < 1024) return (n >> 7) * 256 + (n & 127);
    const int j = n - 1024; return (j >> 7) * 256 + 128 + (j & 127); } };
struct MapId { __device__ int operator()(int n) const { return n; } };

struct Ins { const float *x, *w_in, *b_gate, *g_norm1, *g_cq, *w_uq, *g_ckv, *w_ukv, *w_o_mla, *lambda_qk, *g_subln, *w_o_diff, *w_out, *g_norm2, *w_q_peer, *sub_keys, *expert_u, *expert_v, *g_final; };

__device__ __forceinline__ void p0_prologue(Frame& F, const Ins& I, const double* inv_freq) {
    LAS float* scr = (LAS float*)(F.lds + RING_OFF + F.wave * 16384);
    const int gw = F.vcu * NWAVES + F.wave, NGW = F.G * NWAVES;
    unsigned char* ws = F.ws;
    constexpr int I_W1 = (2048 / 64) * (N1 / 32), I_W8 = (2048 / 64) * (NG / 32), I_UQ = (768 / 64) * (1536 / 32), I_UKV = (512 / 64) * (2048 / 32), I_OM = (1024 / 64) * (2048 / 32), I_OD = I_OM, I_OUT = (2048 / 64) * (2048 / 32), I_QP = I_OUT;
    constexpr int NITEMS = I_W1 + I_W8 + I_UQ + I_UKV + I_OM + I_OD + I_OUT + I_QP;
    for (int it = gw; it < NITEMS; it += NGW) {
        int r = it;
        if (r < I_W1) { tr_item(I.w_in, IN_COLS, 2048, nullptr, (bf16*)(ws + WS_W1), scr, r, N1 / 32, F.lane, MapW1()); continue; } r -= I_W1;
        if (r < I_W8) { tr_item8(I.w_in, IN_COLS, 2048, nullptr, W1_SCALE, ws + WS_W8, scr, r, NG / 32, F.lane, MapGate()); continue; } r -= I_W8;
        if (r < I_UQ) { tr_item8(I.w_uq, 1536, 768, I.g_cq, W1_SCALE, ws + WS_WUQ, scr, r, 1536 / 32, F.lane, MapUQ()); continue; } r -= I_UQ;
        if (r < I_UKV) { tr_item8(I.w_ukv, 2048, 512, I.g_ckv, W1_SCALE, ws + WS_WUKV, scr, r, 2048 / 32, F.lane, MapUKV()); continue; } r -= I_UKV;
        if (r < I_OM) { tr_item(I.w_o_mla, 2048, 1024, nullptr, (bf16*)(ws + WS_WOM), scr, r, 2048 / 32, F.lane, MapId()); continue; } r -= I_OM;
        if (r < I_OD) { tr_item(I.w_o_diff, 2048, 1024, nullptr, (bf16*)(ws + WS_WOD), scr, r, 2048 / 32, F.lane, MapId()); continue; } r -= I_OD;
        if (r < I_OUT) { tr_item(I.w_out, 2048, 2048, nullptr, (bf16*)(ws + WS_WOUT), scr, r, 2048 / 32, F.lane, MapId()); continue; } r -= I_OUT;
        tr_item(I.w_q_peer, 2048, 2048, I.g_norm2, (bf16*)(ws + WS_WQP), scr, r, 2048 / 32, F.lane, MapId());
    }
    {
        bf16* skb = (bf16*)(ws + WS_SKB);
        for (int e = gw * 64 + F.lane; e < 256 * 256; e += NGW * 64) {
            const int n = e >> 8, k = e & 255; float v = 0.f;
            if (n < 128 && k < 128) v = I.sub_keys[n * 128 + k];
            else if (n >= 128 && k >= 128) v = I.sub_keys[128 * 128 + (n - 128) * 128 + (k - 128)];
            skb[e] = (bf16)(pk2(v, 0.f) & 0xffffu);
        }
    }
    {
        float* rope = (float*)(ws + WS_ROPE);
        for (int e = gw * 64 + F.lane; e < SEQ * 32; e += NGW * 64) {
            const int pos = e >> 5, i = e & 31;
            const double rev = (double)pos * inv_freq[i] * 0.15915494309189535;
            const float fr = (float)(rev - floor(rev));
            rope[2 * e] = __builtin_amdgcn_cosf(fr); rope[2 * e + 1] = __builtin_amdgcn_sinf(fr);
        }
    }
    if (blockIdx.x == 0 && F.tid == 0) {
        float a = 0.f, b = 0.f;
        for (int d = 0; d < 64; ++d) { a += I.lambda_qk[d] * I.lambda_qk[64 + d]; b += I.lambda_qk[128 + d] * I.lambda_qk[192 + d]; }
        const float lam = __expf(a) - __expf(b) + LAMBDA_INIT;
        ((float*)F.ctl)[CW_LAMBDA] = lam;
    }
    {
        bf16* H = (bf16*)(ws + WS_H);
        f32x4 g[8];
#pragma unroll
        for (int j = 0; j < 8; ++j) g[j] = *((const f32x4*)I.g_norm1 + F.lane + 64 * j);
        for (int m = gw; m < T; m += NGW) {
            const GAS f32x4* xr = (const GAS f32x4*)(I.x + (size_t)m * D_MODEL) + F.lane;
            f32x4 v[8]; float s = 0.f;
#pragma unroll
            for (int j = 0; j < 8; ++j) { v[j] = xr[64 * j]; s += (v[j].x * v[j].x + v[j].y * v[j].y) + (v[j].z * v[j].z + v[j].w * v[j].w); }
            const float rstd = 1.0f / sqrtf(wave_sum(s) * (1.f / D_MODEL) + EPS);
            GAS u32x2* o8 = (GAS u32x2*)(H + (size_t)m * D_MODEL) + F.lane;
#pragma unroll
            for (int j = 0; j < 8; ++j) { u32x2 w; w.x = pk2(v[j].x * rstd * g[j].x, v[j].y * rstd * g[j].y); w.y = pk2(v[j].z * rstd * g[j].z, v[j].w * rstd * g[j].w); o8[64 * j] = w; }
            { GAS unsigned* h8 = (GAS unsigned*)(ws + WS_H8 + (size_t)m * D_MODEL) + F.lane;
#pragma unroll
              for (int j = 0; j < 8; ++j) h8[64 * j] = (unsigned)__builtin_amdgcn_cvt_pk_fp8_f32(v[j].z * rstd * g[j].z, v[j].w * rstd * g[j].w, __builtin_amdgcn_cvt_pk_fp8_f32(v[j].x * rstd * g[j].x, v[j].y * rstd * g[j].y, 0, false), true); }
        }
    }
}

__device__ __forceinline__ void convert_experts(Frame& F, const Ins& I) {
    const size_t gt = (size_t)(F.vcu * NWAVES * 64) + F.tid, NT = (size_t)F.G * NWAVES * 64;
    const size_t nchunk = (size_t)NEXP * D_MODEL / 8;
    bf16* EU = (bf16*)(F.ws + WS_EU); bf16* EV = (bf16*)(F.ws + WS_EV);
    for (size_t c = gt; c < nchunk; c += NT) {
        const int d = (int)((c * 8) & (D_MODEL - 1));
        const f32x4 a0 = *(const GAS f32x4*)(I.expert_u + c * 8), a1 = *(const GAS f32x4*)(I.expert_u + c * 8 + 4);
        const f32x4 g0 = *(const f32x4*)(I.g_norm2 + d), g1 = *(const f32x4*)(I.g_norm2 + d + 4);
        v4u o; o.x = pk2(a0.x * g0.x, a0.y * g0.y); o.y = pk2(a0.z * g0.z, a0.w * g0.w); o.z = pk2(a1.x * g1.x, a1.y * g1.y); o.w = pk2(a1.z * g1.z, a1.w * g1.w);
        *(GAS v4u*)(EU + c * 8) = o;
        const f32x4 b0 = *(const GAS f32x4*)(I.expert_v + c * 8), b1 = *(const GAS f32x4*)(I.expert_v + c * 8 + 4);
        v4u p; p.x = pk2(b0.x, b0.y); p.y = pk2(b0.z, b0.w); p.z = pk2(b1.x, b1.y); p.w = pk2(b1.z, b1.w);
        *(GAS v4u*)(EV + c * 8) = p;
    }
}

__device__ __forceinline__ float sigmoidf_fast(float x) { return __builtin_amdgcn_rcpf(1.0f + __builtin_amdgcn_exp2f(-x * LOG2E)); }
__device__ __forceinline__ void rope8(f32x4& v0, f32x4& v1, const f32x4 cs0, const f32x4 cs1, float sc) {
    const float a0 = v0[0] * cs0[0] - v0[1] * cs0[1], b0 = v0[1] * cs0[0] + v0[0] * cs0[1];
    const float a1 = v0[2] * cs0[2] - v0[3] * cs0[3], b1 = v0[3] * cs0[2] + v0[2] * cs0[3];
    const float a2 = v1[0] * cs1[0] - v1[1] * cs1[1], b2 = v1[1] * cs1[0] + v1[0] * cs1[1];
    const float a3 = v1[2] * cs1[2] - v1[3] * cs1[3], b3 = v1[3] * cs1[2] + v1[2] * cs1[3];
    v0 = (f32x4){a0 * sc, b0 * sc, a1 * sc, b1 * sc}; v1 = (f32x4){a2 * sc, b2 * sc, a3 * sc, b3 * sc};
}
__device__ __forceinline__ u32x4 pack8(const f32x4 v0, const f32x4 v1) { u32x4 w; w.x = cvtpk(v0[0], v0[1]); w.y = cvtpk(v0[2], v0[3]); w.z = cvtpk(v1[0], v1[1]); w.w = cvtpk(v1[2], v1[3]); return w; }

__device__ __forceinline__ size_t kt_off(size_t row, int col) { const size_t b = row >> 13; const int pos = (int)(row & 8191), tile = pos >> 6, key = pos & 63, h = col >> 7, piece = (col & 127) >> 3;
    return (((b * 8 + h) * 128 + tile) * 16 + piece) * 512 + key * 8 + (col & 7); }
__device__ __forceinline__ size_t vt_off(size_t row, int col) { const size_t b = row >> 13; const int pos = (int)(row & 8191), tile = pos >> 6, key = pos & 63, h = col >> 7, d = col & 127;
    return (((b * 8 + h) * 128 + tile) * 16 + (d >> 5) * 4 + (key >> 4)) * 512 + (key & 15) * 32 + (d & 31); }
__device__ __forceinline__ size_t krt_off(size_t row, int col) { const size_t b = row >> 13; const int pos = (int)(row & 8191), tile = pos >> 6, key = pos & 63;
    return ((b * 128 + tile) * 8 + (col >> 3)) * 512 + key * 8 + (col & 7); }
__device__ __forceinline__ size_t k8_off(size_t row, int col) { const size_t b = row >> 13; const int pos = (int)(row & 8191), tile = pos >> 6, key = pos & 63, h = col >> 7, d = col & 127;
    return (((b * 8 + h) * 128 + tile) * 4 + (d >> 5)) * 2048 + key * 32 + (d & 31); }
__device__ __forceinline__ size_t kr8_off(size_t row, int c) { const size_t b = row >> 13; const int pos = (int)(row & 8191), tile = pos >> 6, key = pos & 63;
    return ((b * 128 + tile) * 2 + (c >> 5)) * 2048 + key * 32 + (c & 31); }
constexpr float MLA_QSCALE = 8.0f;
__device__ __forceinline__ u32x2 pack8_fp8(const f32x4 v0, const f32x4 v1) { u32x2 w; w.x = (unsigned)__builtin_amdgcn_cvt_pk_fp8_f32(v0[2], v0[3], __builtin_amdgcn_cvt_pk_fp8_f32(v0[0], v0[1], 0, false), true);
    w.y = (unsigned)__builtin_amdgcn_cvt_pk_fp8_f32(v1[2], v1[3], __builtin_amdgcn_cvt_pk_fp8_f32(v1[0], v1[1], 0, false), true); return w; }
template <int kind> struct EpiProj {
    static constexpr bool PERM = true;
    bf16_t *CQ, *CKV, *DQ, *DK, *DV, *G, *KR; float *ssq_q, *ssq_kv; const float* bgate; const float* rope;
    __device__ __forceinline__ void operator()(const f32x4 (&acc)[2][2][4][2], const pg8::Unit& u, int wr, int wc, int fr, int fq) const {
        const int row0 = u.pm * 256 + wr * 64 + fr, pn = kind == 0 ? 5 + u.pn : (u.pn < 16 ? 18 + u.pn : (u.pn < 21 ? u.pn - 16 : 17)), colw = wc * 32 + 8 * fq;
        if (kind == 1 && pn < 5) {
            unsigned char* O; int ldc, ct, nsl, sl; float* ssq;
            if (pn < 3) { O = (unsigned char*)CQ; ldc = 768; ct = pn * 256; ssq = ssq_q; nsl = 12; sl = pn * 4 + wc; } else { O = (unsigned char*)CKV; ldc = 512; ct = (pn - 3) * 256; ssq = ssq_kv; nsl = 8; sl = (pn - 3) * 4 + wc; }
#pragma unroll
            for (int ai = 0; ai < 2; ++ai)
#pragma unroll
                for (int m = 0; m < 4; ++m) { const int row = row0 + ai * 128 + m * 16; float s = 0.f;
#pragma unroll
                    for (int bj = 0; bj < 2; ++bj) { const f32x4 v0 = acc[ai][bj][m][0], v1 = acc[ai][bj][m][1];
                        s += (v0[0] * v0[0] + v0[1] * v0[1]) + (v0[2] * v0[2] + v0[3] * v0[3]) + (v1[0] * v1[0] + v1[1] * v1[1]) + (v1[2] * v1[2] + v1[3] * v1[3]);
                        u32x2 w8; w8.x = (unsigned)__builtin_amdgcn_cvt_pk_fp8_f32(v0[2], v0[3], __builtin_amdgcn_cvt_pk_fp8_f32(v0[0], v0[1], 0, false), true); w8.y = (unsigned)__builtin_amdgcn_cvt_pk_fp8_f32(v1[2], v1[3], __builtin_amdgcn_cvt_pk_fp8_f32(v1[0], v1[1], 0, false), true);
                        *(u32x2*)(O + (size_t)row * ldc + ct + bj * 128 + colw) = w8; }
                    s += __shfl_xor(s, 16); s += __shfl_xor(s, 32);
                    if (fq == 0) ssq[(size_t)row * nsl + sl] = s; }
        } else if (kind == 0 && pn < 13) {
            const bool isq = pn < 9; bf16_t* O = isq ? DQ : DK; const int ct = (pn - (isq ? 5 : 9)) * 256; const float sc = isq ? C2_DIFF : 1.0f;
            const int i0 = ((wc & 1) * 32 + 8 * fq) >> 1;
#pragma unroll
            for (int ai = 0; ai < 2; ++ai)
#pragma unroll
                for (int m = 0; m < 4; ++m) { const int row = row0 + ai * 128 + m * 16; const int pos = row & (SEQ - 1);
                    const f32x4 cs0 = *(const f32x4*)(rope + (size_t)(pos * 32 + i0) * 2), cs1 = *(const f32x4*)(rope + (size_t)(pos * 32 + i0 + 2) * 2);
#pragma unroll
                    for (int bj = 0; bj < 2; ++bj) { f32x4 v0 = acc[ai][bj][m][0], v1 = acc[ai][bj][m][1]; rope8(v0, v1, cs0, cs1, sc);
                        const int col = ct + bj * 128 + colw;
                        *(u32x4*)(O + (isq ? (size_t)row * 1024 + col : kt_off(row, col))) = pack8(v0, v1); } }
        } else if (kind == 0) {
            const int ct = (pn - 13) * 256;
#pragma unroll
            for (int ai = 0; ai < 2; ++ai)
#pragma unroll
                for (int m = 0; m < 4; ++m) { const int row = row0 + ai * 128 + m * 16;
#pragma unroll
                    for (int bj = 0; bj < 2; ++bj) *(u32x4*)(DV + vt_off(row, ct + bj * 128 + colw)) = pack8(acc[ai][bj][m][0], acc[ai][bj][m][1]); }
        } else if (kind == 1 && pn >= 18) {
            const int ct = (pn - 18) * 256;
            f32x4 bv[2][2];
#pragma unroll
            for (int bj = 0; bj < 2; ++bj) { bv[bj][0] = *(const f32x4*)(bgate + ct + bj * 128 + colw); bv[bj][1] = *(const f32x4*)(bgate + ct + bj * 128 + colw + 4); }
#pragma unroll
            for (int ai = 0; ai < 2; ++ai)
#pragma unroll
                for (int m = 0; m < 4; ++m) { const int row = row0 + ai * 128 + m * 16;
#pragma unroll
                    for (int bj = 0; bj < 2; ++bj) { f32x4 v0 = acc[ai][bj][m][0] + bv[bj][0], v1 = acc[ai][bj][m][1] + bv[bj][1];
#pragma unroll
                        for (int e = 0; e < 4; ++e) { v0[e] = sigmoidf_fast(v0[e]); v1[e] = sigmoidf_fast(v1[e]); }
                        *(u32x4*)(G + (size_t)row * 4096 + ct + bj * 128 + colw) = pack8(v0, v1); } }
        } else if (kind == 1) {
            if (wc < 2) {
                const int i0 = colw >> 1;
#pragma unroll
                for (int ai = 0; ai < 2; ++ai)
#pragma unroll
                    for (int m = 0; m < 4; ++m) { const int row = row0 + ai * 128 + m * 16; const int pos = row & (SEQ - 1);
                        const f32x4 cs0 = *(const f32x4*)(rope + (size_t)(pos * 32 + i0) * 2), cs1 = *(const f32x4*)(rope + (size_t)(pos * 32 + i0 + 2) * 2);
                        f32x4 v0 = acc[ai][0][m][0], v1 = acc[ai][0][m][1]; rope8(v0, v1, cs0, cs1, 1.0f);
                        *(u32x2*)((unsigned char*)KR + kr8_off(row, colw)) = pack8_fp8(v0, v1); }
            }
        }
    }
};

struct EpiQup {
    static constexpr bool PERM = true;
    bf16_t *QN, *QR; const float* ssq; const float* rope;
    __device__ __forceinline__ void operator()(const f32x4 (&acc)[2][2][4][2], const pg8::Unit& u, int wr, int wc, int fr, int fq) const {
        const int row0 = u.pm * 256 + wr * 64 + fr, pn = u.pn, colw = wc * 32 + 8 * fq;
        const int i0 = ((wc & 1) * 32 + 8 * fq) >> 1;
#pragma unroll
        for (int ai = 0; ai < 2; ++ai)
#pragma unroll
            for (int m = 0; m < 4; ++m) { const int row = row0 + ai * 128 + m * 16; const int pos = row & (SEQ - 1);
                const f32x4 q0 = *(const f32x4*)(ssq + (size_t)row * 12), q1 = *(const f32x4*)(ssq + (size_t)row * 12 + 4), q2 = *(const f32x4*)(ssq + (size_t)row * 12 + 8);
                const float sq = (((q0[0] + q0[1]) + (q0[2] + q0[3])) + ((q1[0] + q1[1]) + (q1[2] + q1[3]))) + ((q2[0] + q2[1]) + (q2[2] + q2[3]));
                const float sc = (C2_MLA * MLA_QSCALE) / sqrtf(sq * (1.0f / 768.0f) + EPS);
                if (pn < 4) {
#pragma unroll
                    for (int bj = 0; bj < 2; ++bj) *(u32x2*)((unsigned char*)QN + (size_t)row * 1024 + pn * 256 + bj * 128 + colw) = pack8_fp8(acc[ai][bj][m][0] * sc, acc[ai][bj][m][1] * sc);
                } else {
                    const f32x4 cs0 = *(const f32x4*)(rope + (size_t)(pos * 32 + i0) * 2), cs1 = *(const f32x4*)(rope + (size_t)(pos * 32 + i0 + 2) * 2);
#pragma unroll
                    for (int bj = 0; bj < 2; ++bj) { f32x4 v0 = acc[ai][bj][m][0], v1 = acc[ai][bj][m][1]; rope8(v0, v1, cs0, cs1, sc);
                        *(u32x2*)((unsigned char*)QR + (size_t)row * 512 + (pn - 4) * 256 + bj * 128 + colw) = pack8_fp8(v0, v1); }
                } }
    }
};
struct EpiKVup {
    static constexpr bool PERM = true;
    bf16_t *KN, *V; const float* ssq;
    __device__ __forceinline__ void operator()(const f32x4 (&acc)[2][2][4][2], const pg8::Unit& u, int wr, int wc, int fr, int fq) const {
        const int row0 = u.pm * 256 + wr * 64 + fr, pn = u.pn, colw = wc * 32 + 8 * fq;
        bf16_t* O = pn < 4 ? KN : V; const int ct = (pn & 3) * 256;
#pragma unroll
        for (int ai = 0; ai < 2; ++ai)
#pragma unroll
            for (int m = 0; m < 4; ++m) { const int row = row0 + ai * 128 + m * 16;
                const f32x4 q0 = *(const f32x4*)(ssq + (size_t)row * 8), q1 = *(const f32x4*)(ssq + (size_t)row * 8 + 4);
                const float sq = ((q0[0] + q0[1]) + (q0[2] + q0[3])) + ((q1[0] + q1[1]) + (q1[2] + q1[3]));
                const float sc = 1.0f / sqrtf(sq * (1.0f / 512.0f) + EPS);
#pragma unroll
                for (int bj = 0; bj < 2; ++bj) { const int col = ct + bj * 128 + colw;
                    if (pn < 4) *(u32x2*)((unsigned char*)KN + k8_off(row, col)) = pack8_fp8(acc[ai][bj][m][0] * sc, acc[ai][bj][m][1] * sc);
                    else *(u32x4*)(V + vt_off(row, col)) = pack8(acc[ai][bj][m][0] * sc, acc[ai][bj][m][1] * sc); } }
    }
};
struct EpiGate {
    static constexpr bool PERM = true;
    const bf16_t* G; bf16_t* TMP; bf16_t* MG; int second;
    __device__ __forceinline__ void operator()(const f32x4 (&acc)[2][2][4][2], const pg8::Unit& u, int wr, int wc, int fr, int fq) const {
        const int row0 = u.pm * 256 + wr * 64 + fr, colw = u.pn * 256 + wc * 32 + 8 * fq;
#pragma unroll
        for (int ai = 0; ai < 2; ++ai)
#pragma unroll
            for (int m = 0; m < 4; ++m) { const int row = row0 + ai * 128 + m * 16;
#pragma unroll
                for (int bj = 0; bj < 2; ++bj) { const int col = colw + bj * 128;
                    const u32x4 gw = *(const u32x4*)(G + (size_t)row * 4096 + (second ? 2048 : 0) + col);
                    f32x4 v0 = acc[ai][bj][m][0], v1 = acc[ai][bj][m][1];
                    v0 = (f32x4){v0[0] * bflo(gw.x), v0[1] * bfhi(gw.x), v0[2] * bflo(gw.y), v0[3] * bfhi(gw.y)};
                    v1 = (f32x4){v1[0] * bflo(gw.z), v1[1] * bfhi(gw.z), v1[2] * bflo(gw.w), v1[3] * bfhi(gw.w)};
                    if (second) { const u32x4 tw = *(const u32x4*)(TMP + (size_t)row * 2048 + col);
                        v0 += (f32x4){bflo(tw.x), bfhi(tw.x), bflo(tw.y), bfhi(tw.y)}; v1 += (f32x4){bflo(tw.z), bfhi(tw.z), bflo(tw.w), bfhi(tw.w)};
                        *(u32x4*)(MG + (size_t)row * 2048 + col) = pack8(v0, v1);
                    } else *(u32x4*)(TMP + (size_t)row * 2048 + col) = pack8(v0, v1); } }
    }
};
struct EpiGate2 {
    static constexpr bool PERM = true;
    const bf16_t* G; bf16_t* MG;
    __device__ __forceinline__ void mid(f32x4 (&acc)[2][2][4][2], const pg8::Unit& u, int wr, int wc, int fr, int fq) const {
        const int row0 = u.pm * 256 + wr * 64 + fr, colw = u.pn * 256 + wc * 32 + 8 * fq;
#pragma unroll
        for (int ai = 0; ai < 2; ++ai)
#pragma unroll
            for (int m = 0; m < 4; ++m) { const int row = row0 + ai * 128 + m * 16;
#pragma unroll
                for (int bj = 0; bj < 2; ++bj) { const int col = colw + bj * 128;
                    const u32x4 ga = *(const u32x4*)(G + (size_t)row * 4096 + col), gb = *(const u32x4*)(G + (size_t)row * 4096 + 2048 + col);
                    f32x4 r0, r1;
                    r0[0] = bflo(ga.x) * __builtin_amdgcn_rcpf(bflo(gb.x)); r0[1] = bfhi(ga.x) * __builtin_amdgcn_rcpf(bfhi(gb.x)); r0[2] = bflo(ga.y) * __builtin_amdgcn_rcpf(bflo(gb.y)); r0[3] = bfhi(ga.y) * __builtin_amdgcn_rcpf(bfhi(gb.y));
                    r1[0] = bflo(ga.z) * __builtin_amdgcn_rcpf(bflo(gb.z)); r1[1] = bfhi(ga.z) * __builtin_amdgcn_rcpf(bfhi(gb.z)); r1[2] = bflo(ga.w) * __builtin_amdgcn_rcpf(bflo(gb.w)); r1[3] = bfhi(ga.w) * __builtin_amdgcn_rcpf(bfhi(gb.w));
                    acc[ai][bj][m][0] *= r0; acc[ai][bj][m][1] *= r1; }
                asm volatile("" ::: "memory"); }
    }
    __device__ __forceinline__ void operator()(const f32x4 (&acc)[2][2][4][2], const pg8::Unit& u, int wr, int wc, int fr, int fq) const {
        const int row0 = u.pm * 256 + wr * 64 + fr, colw = u.pn * 256 + wc * 32 + 8 * fq;
#pragma unroll
        for (int ai = 0; ai < 2; ++ai)
#pragma unroll
            for (int m = 0; m < 4; ++m) { const int row = row0 + ai * 128 + m * 16;
#pragma unroll
                for (int bj = 0; bj < 2; ++bj) { const int col = colw + bj * 128;
                    const u32x4 gb = *(const u32x4*)(G + (size_t)row * 4096 + 2048 + col);
                    f32x4 v0 = acc[ai][bj][m][0], v1 = acc[ai][bj][m][1];
                    v0 = (f32x4){v0[0] * bflo(gb.x), v0[1] * bfhi(gb.x), v0[2] * bflo(gb.y), v0[3] * bfhi(gb.y)};
                    v1 = (f32x4){v1[0] * bflo(gb.z), v1[1] * bfhi(gb.z), v1[2] * bflo(gb.w), v1[3] * bfhi(gb.w)};
                    *(u32x4*)(MG + (size_t)row * 2048 + col) = pack8(v0, v1); } }
    }
};
struct EpiRes {
    static constexpr bool PERM = false;
    const float* x; float* X2; bf16_t* X2B; float* ssq;
    __device__ __forceinline__ void operator()(const f32x4 (&acc)[2][2][4][2], const pg8::Unit& u, int wr, int wc, int fr, int fq) const {
        const int row0 = u.pm * 256 + wr * 64 + fr, col0 = u.pn * 256 + wc * 32 + 4 * fq;
#pragma unroll
        for (int ai = 0; ai < 2; ++ai)
#pragma unroll
            for (int m = 0; m < 4; ++m) { const int row = row0 + ai * 128 + m * 16; float s = 0.f;
#pragma unroll
                for (int bj = 0; bj < 2; ++bj)
#pragma unroll
                    for (int n = 0; n < 2; ++n) { const size_t off = (size_t)row * 2048 + col0 + bj * 128 + n * 16;
                        const f32x4 v = acc[ai][bj][m][n] + *(const f32x4*)(x + off);
                        s += (v[0] * v[0] + v[1] * v[1]) + (v[2] * v[2] + v[3] * v[3]);
#ifdef PEER_BF16
                        *(f32x4*)(X2 + off) = v;
#endif
                        u32x2 w; w.x = cvtpk(v[0], v[1]); w.y = cvtpk(v[2], v[3]); *(u32x2*)(X2B + off) = w; }
                s += __shfl_xor(s, 16); s += __shfl_xor(s, 32);
                if (fq == 0) ssq[(size_t)row * 32 + u.pn * 4 + wc] = s; }
    }
};
__device__ __forceinline__ float sum32(const float* p) { float t = 0.f;
#pragma unroll
    for (int i = 0; i < 8; ++i) { const f32x4 q = *(const f32x4*)(p + 4 * i); t += (q[0] + q[1]) + (q[2] + q[3]); } return t; }
constexpr int RTAB_OFF = 132096, RTAB_SLOTS = 4;
struct EpiQP {
    static constexpr bool PERM = true;
    bf16_t* QP; const float* ssq; const LAS float* tab; int pms[RTAB_SLOTS];
    __device__ __forceinline__ void operator()(const f32x4 (&acc)[2][2][4][2], const pg8::Unit& u, int wr, int wc, int fr, int fq) const {
        const int row0 = u.pm * 256 + wr * 64 + fr, colw = u.pn * 256 + wc * 32 + 8 * fq;
        int slot = -1;
#pragma unroll
        for (int i = RTAB_SLOTS - 1; i >= 0; --i) if (pms[i] == u.pm) slot = i;
#pragma unroll
        for (int ai = 0; ai < 2; ++ai)
#pragma unroll
            for (int m = 0; m < 4; ++m) { const int row = row0 + ai * 128 + m * 16;
                const float sc = slot >= 0 ? tab[slot * 256 + wr * 64 + fr + ai * 128 + m * 16] : 1.0f / sqrtf(sum32(ssq + (size_t)row * 32) * (1.0f / 2048.0f) + EPS);
#pragma unroll
                for (int bj = 0; bj < 2; ++bj) *(u32x4*)(QP + (size_t)row * 2048 + colw + bj * 128) = pack8(acc[ai][bj][m][0] * sc, acc[ai][bj][m][1] * sc); }
    }
};

template <class QF, class KF, class VF>
__device__ __forceinline__ void naive_attn(LAS float* qs, QF q_f, int dt, KF k_f, VF v_f, float sscale,
                                           size_t rowbase, int p0, int lane, float (&o)[4][2], float (&linv)[4]) {
    for (int idx = lane; idx < 4 * dt; idx += 64) { const int r = idx / dt, d = idx - r * dt; qs[r * 192 + d] = q_f(rowbase + p0 + r, d); }
    LDS_WAIT(); asm volatile("" ::: "memory");
    float m[4], l[4];
#pragma unroll
    for (int r = 0; r < 4; ++r) { m[r] = -INFINITY; l[r] = 0.f; o[r][0] = 0.f; o[r][1] = 0.f; }
    const int pmax = p0 + 3, ntile = pmax / 64 + 1;
#pragma unroll 1
    for (int kt = 0; kt < ntile; ++kt) {
        const int key = kt * 64 + lane, kc = key < pmax ? key : pmax;
        float s[4] = {0.f, 0.f, 0.f, 0.f};
#pragma unroll 2
        for (int d = 0; d < dt; d += 8) { float k[8]; k_f(rowbase + kc, d, k);
#pragma unroll
            for (int r = 0; r < 4; ++r) { const f32x4 qa4 = *(const LAS f32x4*)(qs + r * 192 + d), qb4 = *(const LAS f32x4*)(qs + r * 192 + d + 4);
                s[r] += (qa4[0] * k[0] + qa4[1] * k[1]) + (qa4[2] * k[2] + qa4[3] * k[3]) + (qb4[0] * k[4] + qb4[1] * k[5]) + (qb4[2] * k[6] + qb4[3] * k[7]); } }
        float p[4];
#pragma unroll
        for (int r = 0; r < 4; ++r) {
            const float sv = key > p0 + r ? -INFINITY : s[r] * sscale;
            const float mn = fmaxf(m[r], wave_max(sv));
            const float al = __builtin_amdgcn_exp2f(m[r] - mn);
            p[r] = __builtin_amdgcn_exp2f(sv - mn);
            l[r] = l[r] * al + wave_sum(p[r]); o[r][0] *= al; o[r][1] *= al; m[r] = mn;
        }
        const int jn = (pmax - kt * 64) < 63 ? (pmax - kt * 64) : 63;
#pragma unroll 4
        for (int j = 0; j <= jn; ++j) {
            const float v0 = bf2f(v_f(rowbase + kt * 64 + j, lane)), v1 = bf2f(v_f(rowbase + kt * 64 + j, 64 + lane));
#pragma unroll
            for (int r = 0; r < 4; ++r) { const float pj = __builtin_bit_cast(float, __builtin_amdgcn_readlane(__builtin_bit_cast(int, p[r]), j)); o[r][0] += pj * v0; o[r][1] += pj * v1; }
        }
    }
#pragma unroll
    for (int r = 0; r < 4; ++r) linv[r] = 1.0f / l[r];
    LDS_WAIT(); asm volatile("" ::: "memory");
}
__device__ __forceinline__ float fp8_at(const unsigned char* p) { typedef float f2 __attribute__((ext_vector_type(2))); const f2 v = __builtin_amdgcn_cvt_pk_f32_fp8((int)*p, false); return v.x; }
__device__ __forceinline__ void fp8x8(const unsigned char* p, float (&k)[8]) { typedef float f2 __attribute__((ext_vector_type(2))); const u32x2 w = *(const u32x2*)p;
    const f2 a = __builtin_amdgcn_cvt_pk_f32_fp8((int)w.x, false), b = __builtin_amdgcn_cvt_pk_f32_fp8((int)w.x, true), c = __builtin_amdgcn_cvt_pk_f32_fp8((int)w.y, false), d = __builtin_amdgcn_cvt_pk_f32_fp8((int)w.y, true);
    k[0] = a.x; k[1] = a.y; k[2] = b.x; k[3] = b.y; k[4] = c.x; k[5] = c.y; k[6] = d.x; k[7] = d.y; }
__device__ __forceinline__ void bf16x8f(const bf16* p, float (&k)[8]) { const u32x4 kw = *(const u32x4*)p; k[0] = bflo(kw.x); k[1] = bfhi(kw.x); k[2] = bflo(kw.y); k[3] = bfhi(kw.y); k[4] = bflo(kw.z); k[5] = bfhi(kw.z); k[6] = bflo(kw.w); k[7] = bfhi(kw.w); }
__device__ __forceinline__ void p3_attention_ref(Frame& F, const Ins& I) {
    unsigned char* ws = F.ws;
    const bf16 *QN = (const bf16*)(ws + WS_QN), *QR = (const bf16*)(ws + WS_QR), *KN = (const bf16*)(ws + WS_KN), *KR = (const bf16*)(ws + WS_KR), *V = (const bf16*)(ws + WS_V);
    const bf16 *DQ = (const bf16*)(ws + WS_DQ), *DK = (const bf16*)(ws + WS_DK), *DV = (const bf16*)(ws + WS_DV);
    bf16 *OM = (bf16*)(ws + WS_OM), *OD = (bf16*)(ws + WS_OD);
    LAS float* qs = (LAS float*)(F.lds + RING_OFF + F.wave * 4096);
    const int gw = F.vcu * NWAVES + F.wave, NGW = F.G * NWAVES, lane = F.lane;
    const float lam = ((const float*)F.ctl)[CW_LAMBDA];
    const float gs0 = I.g_subln[lane] * (1.0f - LAMBDA_INIT), gs1 = I.g_subln[64 + lane] * (1.0f - LAMBDA_INIT);
    for (int it = gw; it < 2 * 16 * (SEQ / 4); it += NGW) {
        const int type = it & 1, rest = it >> 1, bh = rest & 15, g = rest >> 4, b = bh >> 3, h = bh & 7, p0 = 4 * g;
        const size_t rowbase = (size_t)b * SEQ;
        float o[4][2], li[4];
        if (type == 0) {
            {
                const unsigned char *QN8 = (const unsigned char*)QN, *QR8 = (const unsigned char*)QR, *KN8 = (const unsigned char*)KN, *KR8 = (const unsigned char*)KR;
                naive_attn(qs, [=](size_t row, int d) { return d < 128 ? fp8_at(QN8 + row * 1024 + h * 128 + d) : fp8_at(QR8 + row * 512 + h * 64 + (d - 128)); }, 192,
                           [=](size_t row, int d, float (&k)[8]) { if (d < 128) fp8x8(KN8 + k8_off(row, h * 128 + d), k); else fp8x8(KR8 + kr8_off(row, d - 128), k); },
                           [=](size_t row, int c) { return V[vt_off(row, h * 128 + c)]; }, 1.0f / MLA_QSCALE, rowbase, p0, lane, o, li); }
#pragma unroll
            for (int r = 0; r < 4; ++r) { bf16* orow = OM + (rowbase + p0 + r) * 1024 + h * 128;
#ifdef ATT_CHECK
                { const float a0 = bf2f(orow[lane]), a1 = bf2f(orow[64 + lane]), b0 = o[r][0] * li[r], b1 = o[r][1] * li[r];
                  if (fabsf(a0 - b0) > ATT_TOL_A + ATT_TOL_R * fabsf(b0) || fabsf(a1 - b1) > ATT_TOL_A + ATT_TOL_R * fabsf(b1) || !(a0 == a0) || !(a1 == a1)) atomicAdd((unsigned*)F.ctl + 16, 1u); }
#else
                orow[lane] = (bf16)(pk2(o[r][0] * li[r], 0.f) & 0xffffu); orow[64 + lane] = (bf16)(pk2(o[r][1] * li[r], 0.f) & 0xffffu);
#endif
            }
        } else {
            float o2[4][2], li2[4];
            naive_attn(qs, [=](size_t row, int d) { return bf2f(DQ[row * 1024 + (h * 2) * 64 + d]); }, 64, [=](size_t row, int d, float (&k)[8]) { bf16x8f(DK + kt_off(row, h * 128 + d), k); },
                       [=](size_t row, int c) { return DV[vt_off(row, h * 128 + c)]; }, 1.0f, rowbase, p0, lane, o, li);
            naive_attn(qs, [=](size_t row, int d) { return bf2f(DQ[row * 1024 + (h * 2 + 1) * 64 + d]); }, 64, [=](size_t row, int d, float (&k)[8]) { bf16x8f(DK + kt_off(row, h * 128 + 64 + d), k); },
                       [=](size_t row, int c) { return DV[vt_off(row, h * 128 + c)]; }, 1.0f, rowbase, p0, lane, o2, li2);
#pragma unroll
            for (int r = 0; r < 4; ++r) {
                const float d0 = o[r][0] * li[r] - lam * o2[r][0] * li2[r], d1 = o[r][1] * li[r] - lam * o2[r][1] * li2[r];
                const float rs = 1.0f / sqrtf(wave_sum(d0 * d0 + d1 * d1) * (1.0f / 128.0f) + EPS);
                bf16* orow = OD + (rowbase + p0 + r) * 1024 + h * 128;
#ifdef ATT_CHECK
                { const float a0 = bf2f(orow[lane]), a1 = bf2f(orow[64 + lane]), b0 = d0 * rs * gs0, b1 = d1 * rs * gs1;
                  if (fabsf(a0 - b0) > ATT_TOL_A + ATT_TOL_R * fabsf(b0) || fabsf(a1 - b1) > ATT_TOL_A + ATT_TOL_R * fabsf(b1) || !(a0 == a0) || !(a1 == a1)) atomicAdd((unsigned*)F.ctl + 17, 1u); }
#else
                orow[lane] = (bf16)(pk2(d0 * rs * gs0, 0.f) & 0xffffu); orow[64 + lane] = (bf16)(pk2(d1 * rs * gs1, 0.f) & 0xffffu);
#endif
            }
        }
    }
}

namespace att {
typedef short bf16x8 __attribute__((ext_vector_type(8)));
typedef short s16x4 __attribute__((ext_vector_type(4)));
typedef float f32x16 __attribute__((ext_vector_type(16)));
typedef short v4i16_t __attribute__((ext_vector_type(4)));
#ifndef ATT_PF2
#define ATT_PF2 1
#endif
constexpr int BUFB = 40960, WSF_OFF = (ATT_PF2 ? 3 : 2) * BUFB;
#ifndef ATT_KD
#define ATT_KD 2
#endif
#ifndef ATT_VD
#define ATT_VD 2
#endif
__device__ __forceinline__ int crow(int r, int hi) { return (r & 3) + 8 * (r >> 2) + 4 * hi; }
__device__ __forceinline__ s16x4 vtr(const LAS unsigned char* p) { return __builtin_bit_cast(s16x4, __builtin_amdgcn_ds_read_tr16_b64_v4i16((LAS v4i16_t*)p)); }
__device__ __forceinline__ float max3f(float a, float b, float c) { float r; asm("v_max3_f32 %0, %1, %2, %3" : "=v"(r) : "v"(a), "v"(b), "v"(c)); return r; }
__device__ __forceinline__ float max2f(float a, float b) { float r; asm("v_max_f32_e32 %0, %1, %2" : "=v"(r) : "v"(a), "v"(b)); return r; }
__device__ __forceinline__ float swapmax(float m) { auto rr = __builtin_amdgcn_permlane32_swap(__float_as_uint(m), __float_as_uint(m), false, false);
    const unsigned a = rr[0], b = rr[1]; return fmaxf(__uint_as_float(a), __uint_as_float(b)); }
__device__ __forceinline__ float swapsum(float m) { auto rr = __builtin_amdgcn_permlane32_swap(__float_as_uint(m), __float_as_uint(m), false, false);
    const unsigned a = rr[0], b = rr[1]; return __uint_as_float(a) + __uint_as_float(b); }

template <bool DIFF>
__device__ __forceinline__ void attn_unit(LAS unsigned char* lds, int tid, size_t rowbase, int h, int q0,
                                          const bf16* Qa, const bf16* Qb, const bf16* Ka, const bf16* Kb, const bf16* Vp, bf16* Op, float lam, const float* gsub) {
    constexpr bool QK8 = !DIFF;
    constexpr int NP = 4, NKS = DIFF ? 4 : 12, KPIECES = 24, R = DIFF ? 128 : 256;
    typedef int v8i32 __attribute__((ext_vector_type(8)));
    const int lane = tid & 63, r32 = lane & 31, hi = lane >> 5, wid = __builtin_amdgcn_readfirstlane(tid >> 6);
    const int mp = DIFF ? (wid >> 2) : 0, rows_w0 = q0 + 32 * (DIFF ? (wid & 3) : wid);
    const char* src[NP]; unsigned tstr[NP]; unsigned dsto[NP];
#pragma unroll
    for (int i = 0; i < NP; ++i) { const int pidx = wid * NP + i;
        const size_t bhb = ((size_t)(rowbase >> 13) * 8 + h) * 128 * 16384, krb = (size_t)(rowbase >> 13) * 128 * 8192;
        if (!DIFF) {
            const size_t b8 = ((size_t)(rowbase >> 13) * 8 + h) * 128 * 8192, kr8 = (size_t)(rowbase >> 13) * 128 * 4096;
            if (pidx < 8) { src[i] = (const char*)Ka + b8 + pidx * 1024 + lane * 16; tstr[i] = 8192; dsto[i] = pidx * 1024; }
            else if (pidx < 12) { src[i] = (const char*)Kb + kr8 + (pidx - 8) * 1024 + lane * 16; tstr[i] = 4096; dsto[i] = pidx * 1024; }
            else if (pidx < 28) { src[i] = (const char*)Vp + bhb + (pidx - 12) * 1024 + lane * 16; tstr[i] = 16384; dsto[i] = KPIECES * 1024 + (pidx - 12) * 1024; }
            else { src[i] = nullptr; tstr[i] = 0; dsto[i] = 0; }
        } else {
            if (pidx < 16) { src[i] = (const char*)Ka + bhb + pidx * 1024 + lane * 16; tstr[i] = 16384; dsto[i] = pidx * 1024; }
            else { src[i] = (const char*)Vp + bhb + (pidx - 16) * 1024 + lane * 16; tstr[i] = 16384; dsto[i] = KPIECES * 1024 + (pidx - 16) * 1024; }
        } }
    const int npw = DIFF ? NP : (wid == 7 ? 0 : NP);
    const unsigned lds0 = (unsigned)(uintptr_t)lds;
#define ATT_DMA(t, bb) do { if (npw) _Pragma("unroll") for (int _i = 0; _i < NP; ++_i) { unsigned _keep; const unsigned _dst = (unsigned)__builtin_amdgcn_readfirstlane((int)(lds0 + (unsigned)((bb) * BUFB) + dsto[_i])); \
        asm volatile("s_mov_b32 %0, m0\n\ts_mov_b32 m0, %2\n\ts_nop 0\n\tglobal_load_lds_dwordx4 %1, off\n\ts_mov_b32 m0, %0" : "=&s"(_keep) : "v"(src[_i] + (size_t)(t) * tstr[_i]), "s"(_dst) : "memory"); } } while (0)
    bf16x8 qf[QK8 ? 1 : NKS]; v8i32 qf8[3];
    { const size_t qrow = rowbase + rows_w0 + r32;
      if constexpr (QK8) {
#pragma unroll
          for (int ks = 0; ks < 3; ++ks) qf8[ks] = ks < 2 ? *(const v8i32*)((const unsigned char*)Qa + qrow * 1024 + h * 128 + ks * 64 + hi * 32) : *(const v8i32*)((const unsigned char*)Qb + qrow * 512 + h * 64 + hi * 32);
      } else {
#pragma unroll
      for (int ks = 0; ks < NKS; ++ks) {
          if (DIFF) qf[ks] = *(const bf16x8*)(Qa + qrow * 1024 + (h * 2 + mp) * 64 + ks * 16 + hi * 8);
          else if (ks < 8) qf[ks] = *(const bf16x8*)(Qa + qrow * 1024 + h * 128 + ks * 16 + hi * 8);
          else qf[ks] = *(const bf16x8*)(Qb + qrow * 512 + h * 64 + (ks - 8) * 16 + hi * 8);
      } } }
    f32x16 o[4];
#pragma unroll
    for (int d0 = 0; d0 < 4; ++d0) o[d0] = f32x16{};
    float m = -1e30f, l = 0.f;
    const int NT = (q0 + R) / 64, t_last = (rows_w0 + 31) / 64;
    LAS float* wsf = (LAS float*)(lds + WSF_OFF) + wid * 32;
    const int koff = QK8 ? hi * 2048 + r32 * 32 : (DIFF ? mp * 8 * 1024 : 0) + hi * 1024 + r32 * 16;
    const int voff = KPIECES * 1024 + ((lane >> 4) & 1) * 32 + (lane & 3) * 8 + (4 * hi + ((lane & 15) >> 2)) * 64;
    const int qpos = rows_w0 + r32;
    ATT_DMA(0, 0);
#if ATT_PF2
    ATT_DMA(1, 1);
#endif
    __builtin_amdgcn_s_waitcnt(0x0F70);
    asm volatile("s_waitcnt vmcnt(0)" ::: "memory"); __syncthreads();
#if ATT_PF2
    int bcur = 0;
#endif
#pragma unroll 1
    for (int t = 0; t < NT; ++t) {
#if ATT_PF2
        const int bb = bcur; const bool more = t + 2 < NT;
        if (more) ATT_DMA(t + 2, (bcur == 0) ? 2 : bcur - 1);
#else
        const int bb = t & 1;
        if (t + 1 < NT) ATT_DMA(t + 1, bb ^ 1);
#endif
        if (t <= t_last) {
            const LAS unsigned char* kb = lds + bb * BUFB + koff;
            f32x16 p0 = f32x16{}, p1 = f32x16{};
            if constexpr (QK8) {
                v8i32 k8a[3], k8c[3];
#pragma unroll
                for (int ks = 0; ks < 3; ++ks) { k8a[ks] = *(const LAS v8i32*)(kb + ks * 4096); k8c[ks] = *(const LAS v8i32*)(kb + ks * 4096 + 1024); }
#pragma unroll
                for (int ks = 0; ks < 3; ++ks) {
                    p0 = __builtin_amdgcn_mfma_scale_f32_32x32x64_f8f6f4(k8a[ks], qf8[ks], p0, 0, 0, 0, 0x7F7F7F7F, 0, 0x7F7F7F7F);
                    p1 = __builtin_amdgcn_mfma_scale_f32_32x32x64_f8f6f4(k8c[ks], qf8[ks], p1, 0, 0, 0, 0x7F7F7F7F, 0, 0x7F7F7F7F);
                }
            } else
            {
                bf16x8 kfa[NKS], kfc[NKS];
#pragma unroll
                for (int ks = 0; ks < ATT_KD; ++ks) { kfa[ks] = *(const LAS bf16x8*)(kb + ks * 2048); kfc[ks] = *(const LAS bf16x8*)(kb + ks * 2048 + 512); }
                __builtin_amdgcn_sched_barrier(0);
#pragma unroll
                for (int ks = 0; ks < NKS; ++ks) {
                    if (ks + ATT_KD < NKS) { kfa[ks + ATT_KD] = *(const LAS bf16x8*)(kb + (ks + ATT_KD) * 2048); kfc[ks + ATT_KD] = *(const LAS bf16x8*)(kb + (ks + ATT_KD) * 2048 + 512); }
                    __builtin_amdgcn_sched_barrier(0);
                    p0 = __builtin_amdgcn_mfma_f32_32x32x16_bf16(kfa[ks], qf[ks], p0, 0, 0, 0);
                    p1 = __builtin_amdgcn_mfma_f32_32x32x16_bf16(kfc[ks], qf[ks], p1, 0, 0, 0);
                    __builtin_amdgcn_sched_barrier(0);
                }
            }
            if (64 * t + 63 > rows_w0) {
                const int kb0 = 64 * t + 4 * hi;
#pragma unroll
                for (int r = 0; r < 16; ++r) { const int kv = kb0 + (r & 3) + 8 * (r >> 2); if (kv > qpos) p0[r] = -INFINITY; if (kv + 32 > qpos) p1[r] = -INFINITY; }
            }
            asm volatile("s_nop 15\n\ts_nop 7" : "+v"(p0), "+v"(p1));
            float rm = max3f(p0[0], p0[1], p1[0]), rm2 = max3f(p0[2], p0[3], p1[1]); rm = max3f(rm, p1[2], p1[3]);
#pragma unroll
            for (int r = 4; r < 16; r += 4) { rm = max3f(rm, p0[r], p0[r + 1]); rm2 = max3f(rm2, p0[r + 2], p0[r + 3]); rm = max3f(rm, p1[r], p1[r + 1]); rm2 = max3f(rm2, p1[r + 2], p1[r + 3]); }
            rm = swapmax(max2f(rm, rm2)) * (QK8 ? 1.0f / MLA_QSCALE : 1.0f);
            const float mn = fmaxf(m, rm);
            if (__any(mn > m)) {
                const float al = __builtin_amdgcn_exp2f(m - mn);
                l *= al;
                if (hi == 0) wsf[r32] = al;
                LDS_WAIT(); asm volatile("" ::: "memory");
#pragma unroll
                for (int r = 0; r < 16; ++r) { const float a = wsf[crow(r, hi)];
#pragma unroll
                    for (int d0 = 0; d0 < 4; ++d0) o[d0][r] *= a; }
                LDS_WAIT(); asm volatile("" ::: "memory");
            }
            m = mn;
            float ps = 0.f;
#pragma unroll
            for (int r = 0; r < 16; ++r) { p0[r] = __builtin_amdgcn_exp2f(QK8 ? fmaf(p0[r], 1.0f / MLA_QSCALE, -mn) : p0[r] - mn); p1[r] = __builtin_amdgcn_exp2f(QK8 ? fmaf(p1[r], 1.0f / MLA_QSCALE, -mn) : p1[r] - mn); ps += p0[r] + p1[r]; }
            l += ps;
            u32x4 pw[4];
            pw[0] = (u32x4){cvtpk(p0[0], p0[1]), cvtpk(p0[2], p0[3]), cvtpk(p0[4], p0[5]), cvtpk(p0[6], p0[7])};
            pw[1] = (u32x4){cvtpk(p0[8], p0[9]), cvtpk(p0[10], p0[11]), cvtpk(p0[12], p0[13]), cvtpk(p0[14], p0[15])};
            pw[2] = (u32x4){cvtpk(p1[0], p1[1]), cvtpk(p1[2], p1[3]), cvtpk(p1[4], p1[5]), cvtpk(p1[6], p1[7])};
            pw[3] = (u32x4){cvtpk(p1[8], p1[9]), cvtpk(p1[10], p1[11]), cvtpk(p1[12], p1[13]), cvtpk(p1[14], p1[15])};
            const LAS unsigned char* vb = lds + bb * BUFB + voff;
            {
                s16x4 vlo[16], vhh[16];
#pragma unroll
                for (int i = 0; i < ATT_VD; ++i) { vlo[i] = vtr(vb + i * 1024); vhh[i] = vtr(vb + i * 1024 + 512); }
                __builtin_amdgcn_sched_barrier(0);
#pragma unroll
                for (int i = 0; i < 16; ++i) {
                    if (i + ATT_VD < 16) { vlo[i + ATT_VD] = vtr(vb + (i + ATT_VD) * 1024); vhh[i + ATT_VD] = vtr(vb + (i + ATT_VD) * 1024 + 512); }
                    __builtin_amdgcn_sched_barrier(0);
                    const bf16x8 vf = (bf16x8){vlo[i][0], vlo[i][1], vlo[i][2], vlo[i][3], vhh[i][0], vhh[i][1], vhh[i][2], vhh[i][3]};
                    o[i >> 2] = __builtin_amdgcn_mfma_f32_32x32x16_bf16(__builtin_bit_cast(bf16x8, pw[i & 3]), vf, o[i >> 2], 0, 0, 0);
                    __builtin_amdgcn_sched_barrier(0);
                }
            }
        }
#if ATT_PF2
        if (more) asm volatile("s_waitcnt vmcnt(%0)" :: "n"(NP) : "memory"); else asm volatile("s_waitcnt vmcnt(0)" ::: "memory");
        __syncthreads();
        bcur = (bcur == 2) ? 0 : bcur + 1;
#else
        asm volatile("s_waitcnt vmcnt(0)" ::: "memory"); __syncthreads();
#endif
    }
#undef ATT_DMA
    l = swapsum(l);
    if (hi == 0) wsf[r32] = l;
    LDS_WAIT(); asm volatile("" ::: "memory");
    float rli[16];
#pragma unroll
    for (int r = 0; r < 16; ++r) rli[r] = 1.0f / wsf[crow(r, hi)];
    LDS_WAIT(); asm volatile("" ::: "memory");
    if (!DIFF) {
#pragma unroll
        for (int r = 0; r < 16; ++r) { bf16* orow = Op + (rowbase + rows_w0 + crow(r, hi)) * 1024 + h * 128 + r32;
#pragma unroll
            for (int d0 = 0; d0 < 4; ++d0) orow[d0 * 32] = (bf16)(cvtpk(o[d0][r] * rli[r], 0.f) & 0xffffu); }
    } else {
        LAS float* xch = (LAS float*)lds;
        if (wid >= 4) {
#pragma unroll
            for (int d0 = 0; d0 < 4; ++d0)
#pragma unroll
                for (int r = 0; r < 16; ++r) xch[((wid & 3) * 64 + d0 * 16 + r) * 64 + lane] = o[d0][r] * rli[r];
        }
        __syncthreads();
        if (wid < 4) {
            float ss[16];
#pragma unroll
            for (int r = 0; r < 16; ++r) ss[r] = 0.f;
#pragma unroll
            for (int d0 = 0; d0 < 4; ++d0)
#pragma unroll
                for (int r = 0; r < 16; ++r) { const float d = o[d0][r] * rli[r] - lam * xch[(wid * 64 + d0 * 16 + r) * 64 + lane]; o[d0][r] = d; ss[r] += d * d; }
#pragma unroll
            for (int r = 0; r < 16; ++r) {
#pragma unroll
                for (int of = 1; of < 32; of <<= 1) ss[r] += __shfl_xor(ss[r], of);
                ss[r] = 1.0f / sqrtf(ss[r] * (1.0f / 128.0f) + EPS); }
            float g4[4];
#pragma unroll
            for (int d0 = 0; d0 < 4; ++d0) g4[d0] = gsub[d0 * 32 + r32] * (1.0f - LAMBDA_INIT);
#pragma unroll
            for (int r = 0; r < 16; ++r) { bf16* orow = Op + (rowbase + rows_w0 + crow(r, hi)) * 1024 + h * 128 + r32;
#pragma unroll
                for (int d0 = 0; d0 < 4; ++d0) orow[d0 * 32] = (bf16)(cvtpk(o[d0][r] * ss[r] * g4[d0], 0.f) & 0xffffu); }
        }
        __syncthreads();
    }
}
}

__device__ __forceinline__ void p3_attention(Frame& F, const Ins& I) {
    unsigned char* ws = F.ws;
    const bf16 *QN = (const bf16*)(ws + WS_QN), *QR = (const bf16*)(ws + WS_QR), *KN = (const bf16*)(ws + WS_KN), *KR = (const bf16*)(ws + WS_KR), *V = (const bf16*)(ws + WS_V);
    const bf16 *DQ = (const bf16*)(ws + WS_DQ), *DK = (const bf16*)(ws + WS_DK), *DV = (const bf16*)(ws + WS_DV);
    bf16 *OM = (bf16*)(ws + WS_OM), *OD = (bf16*)(ws + WS_OD);
    const float lam = ((const float*)F.ctl)[CW_LAMBDA];
    LAS unsigned char* lds = F.lds + RING_OFF;
    for (int v = F.vcu; v < 256; v += F.G) {
        const int bh = v >> 4, c = v & 15, b = bh >> 3, h = bh & 7; const size_t rowbase = (size_t)b * SEQ;
        att::attn_unit<false>(lds, F.tid, rowbase, h, (31 - c) * 256, QN, QR, KN, KR, V, OM, lam, I.g_subln);
        att::attn_unit<true>(lds, F.tid, rowbase, h, (63 - c) * 128, DQ, nullptr, DK, nullptr, DV, OD, lam, I.g_subln);
        att::attn_unit<true>(lds, F.tid, rowbase, h, (47 - c) * 128, DQ, nullptr, DK, nullptr, DV, OD, lam, I.g_subln);
        att::attn_unit<true>(lds, F.tid, rowbase, h, (16 + c) * 128, DQ, nullptr, DK, nullptr, DV, OD, lam, I.g_subln);
        att::attn_unit<true>(lds, F.tid, rowbase, h, c * 128, DQ, nullptr, DK, nullptr, DV, OD, lam, I.g_subln);
        att::attn_unit<false>(lds, F.tid, rowbase, h, c * 256, QN, QR, KN, KR, V, OM, lam, I.g_subln);
    }
}

__device__ __forceinline__ void wave_argmax(float v, int idx, float& mv, int& mi) {
#pragma unroll
    for (int o = 1; o < 64; o <<= 1) { const float ov = __shfl_xor(v, o); const int oi = __shfl_xor(idx, o); if (ov > v || (ov == v && oi < idx)) { v = ov; idx = oi; } }
    mv = v; mi = idx;
}
__device__ __forceinline__ void p7_routing_ref(Frame& F) {
    unsigned char* ws = F.ws;
    const bf16* QP = (const bf16*)(ws + WS_QP); const bf16* SKB = (const bf16*)(ws + WS_SKB);
    int* IDX = (int*)(ws + WS_IDX); float* GT = (float*)(ws + WS_GT);
    LAS float* wl = (LAS float*)(F.lds + RING_OFF + F.wave * 4096);
    LAS float* qs = wl; LAS float* v1s = wl + 256; LAS int* i1s = (LAS int*)(wl + 272); LAS float* v2s = wl + 288; LAS int* i2s = (LAS int*)(wl + 304);
    const int gw = F.vcu * NWAVES + F.wave, NGW = F.G * NWAVES, lane = F.lane;
    for (int it = gw; it < T * 8; it += NGW) {
        { const u32x2 w = *(const u32x2*)(QP + (size_t)it * 256 + lane * 4); qs[lane * 4 + 0] = bflo(w.x); qs[lane * 4 + 1] = bfhi(w.x); qs[lane * 4 + 2] = bflo(w.y); qs[lane * 4 + 3] = bfhi(w.y); }
        LDS_WAIT(); asm volatile("" ::: "memory");
        float sc[2][2];
#pragma unroll
        for (int hf = 0; hf < 2; ++hf)
#pragma unroll
            for (int kk = 0; kk < 2; ++kk) { const bf16* kr = SKB + (size_t)(hf * 128 + kk * 64 + lane) * 256 + hf * 128; float s = 0.f;
#pragma unroll 4
                for (int d = 0; d < 128; d += 8) { const u32x4 kw = *(const u32x4*)(kr + d);
                    const f32x4 qa4 = *(const LAS f32x4*)(qs + hf * 128 + d), qb4 = *(const LAS f32x4*)(qs + hf * 128 + d + 4);
                    s += (qa4[0] * bflo(kw.x) + qa4[1] * bfhi(kw.x)) + (qa4[2] * bflo(kw.y) + qa4[3] * bfhi(kw.y)) + (qb4[0] * bflo(kw.z) + qb4[1] * bfhi(kw.z)) + (qb4[2] * bflo(kw.w) + qb4[3] * bfhi(kw.w)); }
                sc[hf][kk] = s; }
#pragma unroll
        for (int hf = 0; hf < 2; ++hf) {
            float a = sc[hf][0], b = sc[hf][1];
            for (int r = 0; r < 16; ++r) {
                float lv; int li; if (b > a) { lv = b; li = lane + 64; } else { lv = a; li = lane; }
                float mv; int mi; wave_argmax(lv, li, mv, mi);
                if (mi == lane) a = -INFINITY; if (mi == lane + 64) b = -INFINITY;
                if (lane == 0) { if (hf == 0) { v1s[r] = mv; i1s[r] = mi; } else { v2s[r] = mv; i2s[r] = mi; } }
            }
        }
        LDS_WAIT(); asm volatile("" ::: "memory");
        float cv[4];
#pragma unroll
        for (int j = 0; j < 4; ++j) { const int c = lane * 4 + j; cv[j] = v1s[c >> 4] + v2s[c & 15]; }
        float mycs = 0.f; int myc = 0;
        for (int r = 0; r < 16; ++r) {
            float lv = cv[0]; int li = lane * 4;
#pragma unroll
            for (int j = 1; j < 4; ++j) if (cv[j] > lv) { lv = cv[j]; li = lane * 4 + j; }
            float mv; int mi; wave_argmax(lv, li, mv, mi);
#pragma unroll
            for (int j = 0; j < 4; ++j) if (mi == lane * 4 + j) cv[j] = -INFINITY;
            if (lane == r) { mycs = mv; myc = mi; }
        }
        float mx = mycs;
#pragma unroll
        for (int o = 1; o < 16; o <<= 1) mx = fmaxf(mx, __shfl_xor(mx, o));
        const float e = __expf(mycs - mx); float se = e;
#pragma unroll
        for (int o = 1; o < 16; o <<= 1) se += __shfl_xor(se, o);
        if (lane < 16) { const int ex = i1s[myc >> 4] * 128 + i2s[myc & 15];
            IDX[(size_t)it * 16 + lane] = ex; GT[(size_t)it * 16 + lane] = e / se; }
        LDS_WAIT(); asm volatile("" ::: "memory");
    }
}

__device__ __forceinline__ void unpack8(const u32x4 w, float (&f)[8]) { f[0] = bflo(w.x); f[1] = bfhi(w.x); f[2] = bflo(w.y); f[3] = bfhi(w.y); f[4] = bflo(w.z); f[5] = bfhi(w.z); f[6] = bflo(w.w); f[7] = bfhi(w.w); }
__device__ __forceinline__ void p8_gather(Frame& F, const Ins& I, float* out) {
    unsigned char* ws = F.ws;
    const float* X2 = (const float*)(ws + WS_X2); const bf16* EU = (const bf16*)(ws + WS_EU); const bf16* EV = (const bf16*)(ws + WS_EV);
    const int* IDX = (const int*)(ws + WS_IDX); const float* GT = (const float*)(ws + WS_GT);
    const float* ssq2 = (const float*)(ws + WS_PSQ2);
    const int gw = F.vcu * NWAVES + F.wave, NGW = F.G * NWAVES, lane = F.lane;
    for (int t = gw; t < T; t += NGW) {
        float xv[4][8], acc[4][8];
#pragma unroll
        for (int j = 0; j < 4; ++j) { const f32x4 a = *(const f32x4*)(X2 + (size_t)t * 2048 + 512 * j + 8 * lane), b = *(const f32x4*)(X2 + (size_t)t * 2048 + 512 * j + 8 * lane + 4);
            xv[j][0] = a[0]; xv[j][1] = a[1]; xv[j][2] = a[2]; xv[j][3] = a[3]; xv[j][4] = b[0]; xv[j][5] = b[1]; xv[j][6] = b[2]; xv[j][7] = b[3];
#pragma unroll
            for (int e = 0; e < 8; ++e) acc[j][e] = 0.f; }
        const float rstd2 = 1.0f / sqrtf(sum32(ssq2 + (size_t)t * 32) * (1.0f / 2048.0f) + EPS);
        const int id0 = IDX[(size_t)t * 128 + lane], id1 = IDX[(size_t)t * 128 + 64 + lane];
        const float g0 = GT[(size_t)t * 128 + lane], g1 = GT[(size_t)t * 128 + 64 + lane];
        for (int i = 0; i < 128; ++i) {
            const int ex = __builtin_amdgcn_readlane(i < 64 ? id0 : id1, i & 63);
            const float gate = __builtin_bit_cast(float, __builtin_amdgcn_readlane(__builtin_bit_cast(int, i < 64 ? g0 : g1), i & 63));
            const bf16* ur = EU + (size_t)ex * 2048 + 8 * lane; const bf16* vr = EV + (size_t)ex * 2048 + 8 * lane;
            u32x4 uw[4], vw[4];
#pragma unroll
            for (int j = 0; j < 4; ++j) { uw[j] = *(const u32x4*)(ur + 512 * j); vw[j] = *(const u32x4*)(vr + 512 * j); }
            float dot = 0.f;
#pragma unroll
            for (int j = 0; j < 4; ++j) { float f[8]; unpack8(uw[j], f);
#pragma unroll
                for (int e = 0; e < 8; ++e) dot += f[e] * xv[j][e]; }
            const float a = wave_sum(dot) * rstd2;
            const float z2 = 1.5957691216057308f * (a + 0.044715f * a * a * a);
            const float w = gate * a * __builtin_amdgcn_rcpf(1.0f + __builtin_amdgcn_exp2f(-z2 * LOG2E));
#pragma unroll
            for (int j = 0; j < 4; ++j) { float f[8]; unpack8(vw[j], f);
#pragma unroll
                for (int e = 0; e < 8; ++e) acc[j][e] += w * f[e]; }
        }
        float s = 0.f;
#pragma unroll
        for (int j = 0; j < 4; ++j)
#pragma unroll
            for (int e = 0; e < 8; ++e) { acc[j][e] += xv[j][e]; s += acc[j][e] * acc[j][e]; }
        float rs = 1.0f / sqrtf(wave_sum(s) * (1.0f / 2048.0f) + EPS);
#ifdef ATT_CHECK
        if (((const unsigned*)F.ctl)[ATT_CHECK_WORD] > ATT_CHECK_MAX) rs = __builtin_nanf("");
#endif
#pragma unroll
        for (int j = 0; j < 4; ++j) { const f32x4 ga = *(const f32x4*)(I.g_final + 512 * j + 8 * lane), gb = *(const f32x4*)(I.g_final + 512 * j + 8 * lane + 4);
            *(f32x4*)(out + (size_t)t * 2048 + 512 * j + 8 * lane) = (f32x4){acc[j][0] * rs * ga[0], acc[j][1] * rs * ga[1], acc[j][2] * rs * ga[2], acc[j][3] * rs * ga[3]};
            *(f32x4*)(out + (size_t)t * 2048 + 512 * j + 8 * lane + 4) = (f32x4){acc[j][4] * rs * gb[0], acc[j][5] * rs * gb[1], acc[j][6] * rs * gb[2], acc[j][7] * rs * gb[3]}; }
    }
}

namespace rt {
typedef short bf16x8 __attribute__((ext_vector_type(8)));
typedef float f32x16 __attribute__((ext_vector_type(16)));
__device__ __forceinline__ unsigned f2sort(float f) { const unsigned u = __float_as_uint(f); return u ^ ((unsigned)((int)u >> 31) | 0x80000000u); }
__device__ __forceinline__ float sort2f(unsigned s) { return __uint_as_float(s ^ ((s >> 31) ? 0x80000000u : 0xFFFFFFFFu)); }
__device__ __forceinline__ unsigned umax(unsigned a, unsigned b) { return a > b ? a : b; }
__device__ __forceinline__ unsigned pair_max(unsigned m) { auto rr = __builtin_amdgcn_permlane32_swap(m, m, false, false); const unsigned a = rr[0], b = rr[1]; return umax(a, b); }
constexpr int KEYS_BYTES = 65536, LIST_OFF = KEYS_BYTES, LIST_WAVE = 6144 + 512;
}
__device__ __forceinline__ void rt_load_keys(Frame& F, const Ins& I) {
    LAS unsigned char* lds = F.lds + RING_OFF;
    for (int it = F.tid; it < 2 * 128 * 16; it += NWAVES * 64) {
        const int c = it & 15, n = (it >> 4) & 127, hf = it >> 11;
        const float* sp = I.sub_keys + (size_t)hf * 16384 + n * 128 + c * 8;
        const f32x4 a = *(const f32x4*)sp, b = *(const f32x4*)(sp + 4);
        v4u o; o.x = pk2(a.x, a.y); o.y = pk2(a.z, a.w); o.z = pk2(b.x, b.y); o.w = pk2(b.z, b.w);
        *(LAS v4u*)(lds + hf * 32768 + c * 2048 + n * 16) = o;
    }
    __syncthreads();
}
template <bool TO_LDS>
__device__ __forceinline__ void rt_task(Frame& F, int task, LAS unsigned* lst) {
    using namespace rt;
    unsigned char* ws = F.ws;
    const bf16* QP = (const bf16*)(ws + WS_QP);
    int* IDX = (int*)(ws + WS_IDX); float* GT = (float*)(ws + WS_GT);
    LAS unsigned char* lds = F.lds + RING_OFF;
    const int lane = F.lane, r32 = lane & 31, hi = lane >> 5;
        const size_t row = (size_t)task * 32 + r32;
#pragma unroll 1
        for (int hf = 0; hf < 2; ++hf) {
            bf16x8 qf[8];
#pragma unroll
            for (int ks = 0; ks < 8; ++ks) qf[ks] = *(const bf16x8*)(QP + row * 256 + hf * 128 + ks * 16 + hi * 8);
            unsigned k[64];
            const LAS unsigned char* kb0 = lds + hf * 32768 + hi * 2048 + r32 * 16;
#pragma unroll
            for (int kb = 0; kb < 4; ++kb) {
                f32x16 acc = f32x16{};
#pragma unroll
                for (int ks = 0; ks < 8; ++ks) acc = __builtin_amdgcn_mfma_f32_32x32x16_bf16(*(const LAS bf16x8*)(kb0 + ks * 4096 + kb * 512), qf[ks], acc, 0, 0, 0);
#pragma unroll
                for (int r = 0; r < 16; ++r) { const int n = 32 * kb + (r & 3) + 8 * (r >> 2) + 4 * hi; k[16 * kb + r] = (f2sort(acc[r]) & ~0x7Fu) | (unsigned)(127 - n); }
            }
#pragma unroll 1
            for (int rd = 0; rd < 16; ++rd) {
                unsigned m = k[0];
#pragma unroll
                for (int i = 1; i < 64; ++i) m = umax(m, k[i]);
                const unsigned g = pair_max(m);
#pragma unroll
                for (int i = 0; i < 64; ++i) k[i] = (k[i] == g) ? 0u : k[i];
                if (hi == 0) lst[hf * 16 + rd] = g;
            }
        }
        LDS_WAIT(); asm volatile("" ::: "memory");
        float v1[16], v2[16];
#pragma unroll
        for (int q = 0; q < 4; ++q) { const v4u a = *(const LAS v4u*)(lst + 4 * q), b = *(const LAS v4u*)(lst + 16 + 4 * q);
#pragma unroll
            for (int e = 0; e < 4; ++e) { v1[4 * q + e] = sort2f(a[e] & ~0x7Fu); v2[4 * q + e] = sort2f(b[e] & ~0x7Fu); } }
        unsigned cand[50];
        { int ci = 0;
#pragma unroll
          for (int a = 0; a < 16; ++a)
#pragma unroll
              for (int b = 0; b < 16; ++b) if ((a + 1) * (b + 1) <= 16) { cand[ci] = (f2sort(v1[a] + v2[b]) & ~0xFFu) | (unsigned)(255 - (a * 16 + b)); ++ci; } }
#pragma unroll 1
        for (int rd = 0; rd < 16; ++rd) {
            unsigned m = cand[0];
#pragma unroll
            for (int i = 1; i < 50; ++i) m = umax(m, cand[i]);
#pragma unroll
            for (int i = 0; i < 50; ++i) cand[i] = (cand[i] == m) ? 0u : cand[i];
            if (hi == 0) lst[32 + rd] = m;
        }
        LDS_WAIT(); asm volatile("" ::: "memory");
        const float cmax = sort2f(lst[32] & ~0xFFu);
        float ev[8]; int ex[8]; float se = 0.f;
#pragma unroll
        for (int j = 0; j < 8; ++j) { const unsigned key = lst[32 + 8 * hi + j]; const int ab = 255 - (int)(key & 0xFFu);
            const int i1 = 127 - (int)(lst[ab >> 4] & 0x7Fu), i2 = 127 - (int)(lst[16 + (ab & 15)] & 0x7Fu);
            ex[j] = i1 * 128 + i2; ev[j] = __expf(sort2f(key & ~0xFFu) - cmax); se += ev[j]; }
        { auto rr = __builtin_amdgcn_permlane32_swap(__float_as_uint(se), __float_as_uint(se), false, false); const unsigned a = rr[0], b = rr[1]; se = __uint_as_float(a) + __uint_as_float(b); }
        const float inv = 1.0f / se;
        if (TO_LDS) {
#pragma unroll
            for (int j = 0; j < 8; ++j) { lst[8 * hi + j] = (unsigned)ex[j]; lst[16 + 8 * hi + j] = __float_as_uint(ev[j] * inv); }
        } else {
        int* ip = IDX + row * 16 + 8 * hi; float* gp = GT + row * 16 + 8 * hi;
        *(GAS v4u*)ip = (v4u){(unsigned)ex[0], (unsigned)ex[1], (unsigned)ex[2], (unsigned)ex[3]}; *(GAS v4u*)(ip + 4) = (v4u){(unsigned)ex[4], (unsigned)ex[5], (unsigned)ex[6], (unsigned)ex[7]};
        *(GAS f32x4*)gp = (f32x4){ev[0] * inv, ev[1] * inv, ev[2] * inv, ev[3] * inv}; *(GAS f32x4*)(gp + 4) = (f32x4){ev[4] * inv, ev[5] * inv, ev[6] * inv, ev[7] * inv};
        }
        LDS_WAIT(); asm volatile("" ::: "memory");
}
__device__ __forceinline__ void p8_routing(Frame& F, const Ins& I) {
    using namespace rt;
    rt_load_keys(F, I);
    LAS unsigned* lst = (LAS unsigned*)(F.lds + RING_OFF + LIST_OFF + F.wave * LIST_WAVE) + (F.lane & 31) * 48;
    const int gw = F.vcu * NWAVES + F.wave, NGW = F.G * NWAVES;
    for (int task = gw; task < T * 8 / 32; task += NGW) rt_task<false>(F, task, lst);
}
constexpr float EU_SCALE = 64.0f, EV_SCALE = 4.0f;
typedef float f32x2v __attribute__((ext_vector_type(2)));
__device__ __forceinline__ unsigned pk4_fp8(float a, float b, float c, float d) { int t = __builtin_amdgcn_cvt_pk_fp8_f32(a, b, 0, false); t = __builtin_amdgcn_cvt_pk_fp8_f32(c, d, t, true); return (unsigned)t; }
__device__ __forceinline__ void convert_experts_fp8(Frame& F, const Ins& I) {
    const size_t gt = (size_t)(F.vcu * NWAVES * 64) + F.tid, NT = (size_t)F.G * NWAVES * 64;
    const size_t nchunk = (size_t)NEXP * D_MODEL / 16;
    unsigned char* EU = F.ws + WS_EU; unsigned char* EV = F.ws + WS_EV;
    for (size_t c = gt; c < nchunk; c += NT) {
        const int d = (int)((c * 16) & (D_MODEL - 1));
        v4u o, p;
#pragma unroll
        for (int k = 0; k < 4; ++k) {
            const f32x4 a = *(const GAS f32x4*)(I.expert_u + c * 16 + 4 * k), g = *(const f32x4*)(I.g_norm2 + d + 4 * k), b = *(const GAS f32x4*)(I.expert_v + c * 16 + 4 * k);
            o[k] = pk4_fp8(a.x * g.x * EU_SCALE, a.y * g.y * EU_SCALE, a.z * g.z * EU_SCALE, a.w * g.w * EU_SCALE);
            p[k] = pk4_fp8(b.x * EV_SCALE, b.y * EV_SCALE, b.z * EV_SCALE, b.w * EV_SCALE);
        }
        *(GAS v4u*)(EU + c * 16) = o; *(GAS v4u*)(EV + c * 16) = p;
    }
}
#ifndef PEER_FP8
#define PEER_FP6 1
#endif
#ifdef PEER_FP6
typedef float v32f_t __attribute__((ext_vector_type(32)));
typedef float v16f_t __attribute__((ext_vector_type(16)));
typedef unsigned v6u_t __attribute__((ext_vector_type(6)));
constexpr int EROW = 1536;
__device__ __forceinline__ void convert_experts_fp6(Frame& F, const Ins& I) {
    const size_t gt = (size_t)(F.vcu * NWAVES * 64) + F.tid, NT = (size_t)F.G * NWAVES * 64;
    const size_t nblk = (size_t)NEXP * 64;
    unsigned char* EU = F.ws + WS_EU; unsigned char* EV = F.ws + WS_EV;
    LAS int* ptab = (LAS int*)(F.lds + RING_OFF + 65536);
#pragma unroll 1
    for (int j = 0; j < 32; ++j) {
        v16f_t a, b;
#pragma unroll
        for (int i = 0; i < 16; ++i) { a[i] = (i == j) ? 1.0f : 0.0f; b[i] = (i + 16 == j) ? 1.0f : 0.0f; }
        const v32f_t r = __builtin_amdgcn_cvt_scalef32_pk32_f32_fp6(__builtin_amdgcn_cvt_scalef32_2xpk16_fp6_f32(a, b, 1.0f), 1.0f);
        int pos = 0;
#pragma unroll
        for (int i = 0; i < 32; ++i) pos = (r[i] != 0.0f) ? i : pos;
        ptab[j] = pos;
    }
    LDS_WAIT(); asm volatile("" ::: "memory");
    bool inter = true;
#pragma unroll 1
    for (int j = 0; j < 32; ++j) inter = inter && (ptab[j] == ((j < 16) ? 2 * j : 2 * (j - 16) + 1));
    if (inter) {
        const int gw = F.vcu * NWAVES + F.wave, NGW = F.G * NWAVES, lane = F.lane;
        LAS unsigned char* img = F.lds + RING_OFF + F.wave * 9216;
        f32x4 gsc[8];
#pragma unroll
        for (int k = 0; k < 8; ++k) gsc[k] = *(const f32x4*)(I.g_norm2 + (64 * k + lane) * 4) * EU_SCALE;
        for (int e = gw; e < NEXP; e += NGW) {
            f32x4 ru[8], rv[8];
#pragma unroll
            for (int k = 0; k < 8; ++k) { ru[k] = *(const GAS f32x4*)(I.expert_u + (size_t)e * 2048 + (64 * k + lane) * 4); rv[k] = *(const GAS f32x4*)(I.expert_v + (size_t)e * 2048 + (64 * k + lane) * 4); }
#pragma unroll
            for (int tb = 0; tb < 2; ++tb) {
#pragma unroll
                for (int k = 0; k < 8; ++k) { const int i4 = 64 * k + lane;
                    *(LAS f32x4*)(img + (i4 >> 3) * 144 + (i4 & 7) * 16) = tb == 0 ? ru[k] * gsc[k] : rv[k] * EV_SCALE; }
                LDS_WAIT(); asm volatile("" ::: "memory");
                v16f_t ya, yb;
#pragma unroll
                for (int j = 0; j < 8; ++j) { const f32x4 x4 = *(const LAS f32x4*)(img + lane * 144 + 16 * j); ya[2 * j] = x4[0]; yb[2 * j] = x4[1]; ya[2 * j + 1] = x4[2]; yb[2 * j + 1] = x4[3]; }
                LDS_WAIT(); asm volatile("" ::: "memory");
                const v6u_t pk = __builtin_amdgcn_cvt_scalef32_2xpk16_fp6_f32(ya, yb, 1.0f);
                unsigned char* dst = (tb == 0 ? EU : EV) + (size_t)e * EROW;
                *(GAS v4u*)(dst + 16 * lane) = (v4u){pk[0], pk[1], pk[2], pk[3]}; *(GAS u32x2*)(dst + 1024 + 8 * lane) = (u32x2){pk[4], pk[5]};
            }
        }
    } else {
    LAS float* scr = (LAS float*)(F.lds + RING_OFF) + F.tid;
    for (size_t c = gt; c < nblk; c += NT) {
        const size_t e = c >> 6; const int l = (int)(c & 63), d = 32 * l;
        v16f_t ya, yb;
#pragma unroll
        for (int k = 0; k < 8; ++k) { const f32x4 a0 = *(const GAS f32x4*)(I.expert_u + c * 32 + 4 * k), g0 = *(const f32x4*)(I.g_norm2 + d + 4 * k);
#pragma unroll
            for (int j = 0; j < 4; ++j) scr[(4 * k + j) * 512] = a0[j] * g0[j] * EU_SCALE; }
#pragma unroll
        for (int j = 0; j < 16; ++j) { ya[j] = scr[ptab[j] * 512]; yb[j] = scr[ptab[16 + j] * 512]; }
        const v6u_t pu = __builtin_amdgcn_cvt_scalef32_2xpk16_fp6_f32(ya, yb, 1.0f);
        *(GAS v4u*)(EU + e * EROW + 16 * l) = (v4u){pu[0], pu[1], pu[2], pu[3]}; *(GAS u32x2*)(EU + e * EROW + 1024 + 8 * l) = (u32x2){pu[4], pu[5]};
#pragma unroll
        for (int k = 0; k < 8; ++k) { const f32x4 b0 = *(const GAS f32x4*)(I.expert_v + c * 32 + 4 * k);
#pragma unroll
            for (int j = 0; j < 4; ++j) scr[(4 * k + j) * 512] = b0[j] * EV_SCALE; }
#pragma unroll
        for (int j = 0; j < 16; ++j) { ya[j] = scr[ptab[j] * 512]; yb[j] = scr[ptab[16 + j] * 512]; }
        const v6u_t pv = __builtin_amdgcn_cvt_scalef32_2xpk16_fp6_f32(ya, yb, 1.0f);
        *(GAS v4u*)(EV + e * EROW + 16 * l) = (v4u){pv[0], pv[1], pv[2], pv[3]}; *(GAS u32x2*)(EV + e * EROW + 1024 + 8 * l) = (u32x2){pv[4], pv[5]};
    }
    }
    __syncthreads();
}
struct G9Row { u32x4 a; u32x2 b; };
#define G9_SETS G9Row A[4], B[4]
#define G9_XOFF(c) (32 * lane + 16 * (c))
#define G9_LOAD(SET, TAB, IDL, g) do { _Pragma("unroll") for (int k = 0; k < 4; ++k) { const int ex = __builtin_amdgcn_readlane(IDL, 4 * (4 * (g) + k)); \
        const unsigned char* rp = (TAB) + (size_t)ex * EROW; SET[k].a = *(const u32x4*)(rp + 16 * lane); SET[k].b = *(const u32x2*)(rp + 1024 + 8 * lane); } } while (0)
#define G9_CVT(SET, k) __builtin_amdgcn_cvt_scalef32_pk32_f32_fp6((v6u_t){SET[k].a.x, SET[k].a.y, SET[k].a.z, SET[k].a.w, SET[k].b.x, SET[k].b.y}, 1.0f)
#define G9_DOTS(SET, g) do { _Pragma("unroll") for (int k = 0; k < 4; ++k) { const v32f_t r = G9_CVT(SET, k); float s0 = 0.f, s1 = 0.f; \
        f32x2v q0 = {0.f, 0.f}, q1 = {0.f, 0.f}; (void)s0; (void)s1; \
        _Pragma("unroll") for (int e = 0; e < 16; e += 2) { q0 = (f32x2v){r[e], r[e + 1]} * (f32x2v){xv[0][e], xv[0][e + 1]} + q0; q1 = (f32x2v){r[16 + e], r[17 + e]} * (f32x2v){xv[1][e], xv[1][e + 1]} + q1; } \
        q0 += q1; float s = q0.x + q0.y; asm volatile("" : "+v"(s)); dots[4 * (g) + k] = s; } } while (0)
#define G9_FMAS(SET, g) do { _Pragma("unroll") for (int k = 0; k < 4; ++k) { const float wk = wq[g][k]; const v32f_t r = G9_CVT(SET, k); \
        const f32x2v wk2 = {wk, wk}; \
        _Pragma("unroll") for (int e = 0; e < 16; e += 2) { const f32x2v a0 = (f32x2v){r[e], r[e + 1]} * wk2 + (f32x2v){acc[0][e], acc[0][e + 1]}, a1 = (f32x2v){r[16 + e], r[17 + e]} * wk2 + (f32x2v){acc[1][e], acc[1][e + 1]}; \
            acc[0][e] = a0.x; acc[0][e + 1] = a0.y; acc[1][e] = a1.x; acc[1][e + 1] = a1.y; } } } while (0)
#else
constexpr int EROW = 2048;
#define G9_SETS u32x4 A[4][2], B[4][2]
#define G9_XOFF(c) (1024 * (c) + 16 * lane)
#define G9_LOAD(SET, TAB, IDL, g) do { _Pragma("unroll") for (int k = 0; k < 4; ++k) { const int ex = __builtin_amdgcn_readlane(IDL, 4 * (4 * (g) + k)); \
        const unsigned char* rp = (TAB) + (size_t)ex * 2048 + 16 * lane; SET[k][0] = *(const u32x4*)rp; SET[k][1] = *(const u32x4*)(rp + 1024); } } while (0)
#define G9_DOTS(SET, g) do { _Pragma("unroll") for (int k = 0; k < 4; ++k) { float s = 0.f; _Pragma("unroll") for (int c = 0; c < 2; ++c) _Pragma("unroll") for (int dw = 0; dw < 4; ++dw) { \
        const f32x2v lo = __builtin_amdgcn_cvt_pk_f32_fp8((int)SET[k][c][dw], false), hi2 = __builtin_amdgcn_cvt_pk_f32_fp8((int)SET[k][c][dw], true); \
        s += lo.x * xv[c][4 * dw] + lo.y * xv[c][4 * dw + 1] + hi2.x * xv[c][4 * dw + 2] + hi2.y * xv[c][4 * dw + 3]; } asm volatile("" : "+v"(s)); dots[4 * (g) + k] = s; } } while (0)
#define G9_FMAS(SET, g) do { _Pragma("unroll") for (int k = 0; k < 4; ++k) { const float wk = wq[g][k]; \
        _Pragma("unroll") for (int c = 0; c < 2; ++c) _Pragma("unroll") for (int dw = 0; dw < 4; ++dw) { \
        const f32x2v lo = __builtin_amdgcn_cvt_pk_f32_fp8((int)SET[k][c][dw], false), hi2 = __builtin_amdgcn_cvt_pk_f32_fp8((int)SET[k][c][dw], true); \
        acc[c][4 * dw] += wk * lo.x; acc[c][4 * dw + 1] += wk * lo.y; acc[c][4 * dw + 2] += wk * hi2.x; acc[c][4 * dw + 3] += wk * hi2.y; } } } while (0)
#endif
#define G9_PIN() do { _Pragma("unroll") for (int c = 0; c < 2; ++c) asm volatile("" : "+v"(acc[c][0]), "+v"(acc[c][1]), "+v"(acc[c][2]), "+v"(acc[c][3]), "+v"(acc[c][4]), "+v"(acc[c][5]), "+v"(acc[c][6]), "+v"(acc[c][7]), \
        "+v"(acc[c][8]), "+v"(acc[c][9]), "+v"(acc[c][10]), "+v"(acc[c][11]), "+v"(acc[c][12]), "+v"(acc[c][13]), "+v"(acc[c][14]), "+v"(acc[c][15])); } while (0)
template <class IdF, class GtF>
__device__ __forceinline__ void g9_token(Frame& F, const Ins& I, float* out, int t, LAS float* wl, IdF idf, GtF gtf) {
    unsigned char* ws = F.ws;
    const bf16* X2B = (const bf16*)(ws + WS_X2B); const unsigned char* EU = ws + WS_EU; const unsigned char* EV = ws + WS_EV;
    const float* ssq2 = (const float*)(ws + WS_PSQ2);
    const int lane = F.lane, sl = (lane >> 2) & 15;
    const bool bit3 = (lane & 8) != 0, bit2 = (lane & 4) != 0;
    {
        G9_SETS;
        {
            float xv[2][16];
#pragma unroll
            for (int c = 0; c < 2; ++c)
#pragma unroll
                for (int q = 0; q < 2; ++q) { const u32x4 a = *(const u32x4*)(X2B + (size_t)t * 2048 + G9_XOFF(c) + 8 * q);
                    xv[c][8 * q] = bflo(a.x); xv[c][8 * q + 1] = bfhi(a.x); xv[c][8 * q + 2] = bflo(a.y); xv[c][8 * q + 3] = bfhi(a.y); xv[c][8 * q + 4] = bflo(a.z); xv[c][8 * q + 5] = bfhi(a.z); xv[c][8 * q + 6] = bflo(a.w); xv[c][8 * q + 7] = bfhi(a.w); }
            const float rstd2 = (1.0f / EU_SCALE) / sqrtf(sum32(ssq2 + (size_t)t * 32) * (1.0f / 2048.0f) + EPS);
            int idl_cur = idf(0);
            G9_LOAD(A, EU, idl_cur, 0); __builtin_amdgcn_sched_barrier(0);
#pragma unroll 1
            for (int hd = 0; hd < 8; ++hd) {
                const int idl_nxt = idf(hd < 7 ? hd + 1 : 0); const float gtl = gtf(hd);
                float dots[16];
                G9_LOAD(B, EU, idl_cur, 1); __builtin_amdgcn_sched_barrier(0);
                G9_DOTS(A, 0); __builtin_amdgcn_sched_barrier(0);
                G9_LOAD(A, EU, idl_cur, 2); __builtin_amdgcn_sched_barrier(0);
                G9_DOTS(B, 1); __builtin_amdgcn_sched_barrier(0);
                G9_LOAD(B, EU, idl_cur, 3); __builtin_amdgcn_sched_barrier(0);
                G9_DOTS(A, 2); __builtin_amdgcn_sched_barrier(0);
                if (hd < 7) { G9_LOAD(A, EU, idl_nxt, 0); } else { G9_LOAD(A, EV, idl_nxt, 0); }
                __builtin_amdgcn_sched_barrier(0);
                G9_DOTS(B, 3); __builtin_amdgcn_sched_barrier(0);
                float d8[8], d4[4], d2[2], d1;
#pragma unroll
                for (int i = 0; i < 8; ++i) { auto rr = __builtin_amdgcn_permlane32_swap(__float_as_uint(dots[i]), __float_as_uint(dots[8 + i]), false, false); const unsigned r0 = rr[0], r1 = rr[1]; d8[i] = __uint_as_float(r0) + __uint_as_float(r1); }
#pragma unroll
                for (int i = 0; i < 4; ++i) { auto rr = __builtin_amdgcn_permlane16_swap(__float_as_uint(d8[i]), __float_as_uint(d8[4 + i]), false, false); const unsigned r0 = rr[0], r1 = rr[1]; d4[i] = __uint_as_float(r0) + __uint_as_float(r1); }
#pragma unroll
                for (int i = 0; i < 2; ++i) { const float keep = bit3 ? d4[2 + i] : d4[i], send = bit3 ? d4[i] : d4[2 + i]; d2[i] = keep + __shfl_xor(send, 8); }
                { const float keep = bit2 ? d2[1] : d2[0], send = bit2 ? d2[0] : d2[1]; d1 = keep + __shfl_xor(send, 4); }
                d1 += __shfl_xor(d1, 2); d1 += __shfl_xor(d1, 1);
                const float a = d1 * rstd2;
                const float z2 = 1.5957691216057308f * (a + 0.044715f * a * a * a);
                const float w = gtl * (1.0f / EV_SCALE) * a * __builtin_amdgcn_rcpf(1.0f + __builtin_amdgcn_exp2f(-z2 * LOG2E));
                if ((lane & 3) == 0) wl[hd * 16 + sl] = w;
                idl_cur = idl_nxt;
            }
        }
        LDS_WAIT(); asm volatile("" ::: "memory");
        float acc[2][16];
#pragma unroll
        for (int c = 0; c < 2; ++c)
#pragma unroll
            for (int e = 0; e < 16; ++e) acc[c][e] = 0.f;
        {
            int idl_cur = idf(0);
#pragma unroll 1
            for (int hd = 0; hd < 8; ++hd) {
                const int idl_nxt = idf(hd < 7 ? hd + 1 : 0);
                f32x4 wq[4];
#pragma unroll
                for (int g = 0; g < 4; ++g) wq[g] = *(const LAS f32x4*)(wl + hd * 16 + 4 * g);
                G9_LOAD(B, EV, idl_cur, 1); __builtin_amdgcn_sched_barrier(0);
                G9_FMAS(A, 0); G9_PIN(); __builtin_amdgcn_sched_barrier(0);
                G9_LOAD(A, EV, idl_cur, 2); __builtin_amdgcn_sched_barrier(0);
                G9_FMAS(B, 1); G9_PIN(); __builtin_amdgcn_sched_barrier(0);
                G9_LOAD(B, EV, idl_cur, 3); __builtin_amdgcn_sched_barrier(0);
                G9_FMAS(A, 2); G9_PIN(); __builtin_amdgcn_sched_barrier(0);
                if (hd < 7) { G9_LOAD(A, EV, idl_nxt, 0); } __builtin_amdgcn_sched_barrier(0);
                G9_FMAS(B, 3); G9_PIN(); __builtin_amdgcn_sched_barrier(0);
                idl_cur = idl_nxt;
            }
        }
        LDS_WAIT(); asm volatile("" ::: "memory");
        float s = 0.f;
#pragma unroll
        for (int c = 0; c < 2; ++c)
#pragma unroll
            for (int q = 0; q < 2; ++q) { const u32x4 a = *(const u32x4*)(X2B + (size_t)t * 2048 + G9_XOFF(c) + 8 * q);
                const float xr[8] = {bflo(a.x), bfhi(a.x), bflo(a.y), bfhi(a.y), bflo(a.z), bfhi(a.z), bflo(a.w), bfhi(a.w)};
#pragma unroll
                for (int e = 0; e < 8; ++e) { acc[c][8 * q + e] += xr[e]; s += acc[c][8 * q + e] * acc[c][8 * q + e]; } }
        float rs = 1.0f / sqrtf(wave_sum(s) * (1.0f / 2048.0f) + EPS);
#ifdef ATT_CHECK
        if (((const unsigned*)F.ctl)[16] + ((const unsigned*)F.ctl)[17] > 0u) rs = __builtin_nanf("");
#endif
#pragma unroll
        for (int c = 0; c < 2; ++c)
#pragma unroll
            for (int q = 0; q < 4; ++q) { const f32x4 g = *(const f32x4*)(I.g_final + G9_XOFF(c) + 4 * q);
                *(f32x4*)(out + (size_t)t * 2048 + G9_XOFF(c) + 4 * q) = (f32x4){acc[c][4 * q] * rs * g[0], acc[c][4 * q + 1] * rs * g[1], acc[c][4 * q + 2] * rs * g[2], acc[c][4 * q + 3] * rs * g[3]}; }
    }
}
#undef G9_LOAD
#undef G9_DOTS
#undef G9_FMAS
#undef G9_PIN
#undef G9_SETS
#undef G9_XOFF
__device__ __forceinline__ void p9_gather_fp8(Frame& F, const Ins& I, float* out) {
    const int* IDX = (const int*)(F.ws + WS_IDX); const float* GT = (const float*)(F.ws + WS_GT);
    const int lane = F.lane, sl = (lane >> 2) & 15;
    LAS float* wl = (LAS float*)(F.lds + RING_OFF + F.wave * 4096);
    unsigned* tokctr = (unsigned*)F.ctl + CW_TOKCTR;
    for (;;) {
        int t = 0; if (lane == 0) t = (int)__hip_atomic_fetch_add(tokctr, 1u, __ATOMIC_RELAXED, __HIP_MEMORY_SCOPE_AGENT);
        t = __builtin_amdgcn_readfirstlane(t);
        if (t >= T) break;
        const int* idx_t = IDX + (size_t)t * 128 + sl; const float* gt_t = GT + (size_t)t * 128 + sl;
        g9_token(F, I, out, t, wl, [=](int hd) { return idx_t[hd * 16]; }, [=](int hd) { return gt_t[hd * 16]; });
    }
}

__device__ __forceinline__ void p89_route_gather(Frame& F, const Ins& I, float* out) {
    using namespace rt;
    rt_load_keys(F, I);
    LAS unsigned* lstw = (LAS unsigned*)(F.lds + RING_OFF + LIST_OFF + F.wave * LIST_WAVE);
    LAS unsigned* lst = lstw + (F.lane & 31) * 48;
    LAS float* wl = (LAS float*)(lstw + 32 * 48);
    const int gw = F.vcu * NWAVES + F.wave, NGW = F.G * NWAVES, sl = (F.lane >> 2) & 15;
    for (int task = gw; task < T * 8 / 32; task += NGW) {
        rt_task<true>(F, task, lst);
        LDS_WAIT(); asm volatile("" ::: "memory");
#pragma unroll 1
        for (int tt = 0; tt < 4; ++tt) {
            LAS unsigned* lt = lstw + (tt * 8) * 48 + sl;
            g9_token(F, I, out, 4 * task + tt, wl, [=](int hd) { return (int)lt[hd * 48]; }, [=](int hd) { return __uint_as_float(lt[hd * 48 + 16]); });
        }
        LDS_WAIT(); asm volatile("" ::: "memory");
    }
}

constexpr int NPHASE = 10;
struct Args { Ins in; float* out; unsigned char* ws; double inv_freq[32]; int ph_lo, ph_hi; };
__global__ void __launch_bounds__(NWAVES * 64, 2) mega_fwd(Args args) {
    extern __shared__ __attribute__((aligned(16))) unsigned char lds[];
    Frame F;
    F.lds = (LAS unsigned char*)lds;
    F.MISC = (volatile LAS unsigned*)(F.lds + MISC_OFF);
    F.tid = threadIdx.x; F.lane = F.tid & 63; F.wave = __builtin_amdgcn_readfirstlane(F.tid >> 6);
    F.G = gridDim.x; { const int bx = blockIdx.x; F.vcu = (F.G % 8 == 0) ? (bx % 8) * (F.G / 8) + bx / 8 : bx; }
    unsigned char* ws = args.ws; F.ws = ws;
    F.ctl = (gu32*)(ws + WS_CTL);
    const Ins& I = args.in;
    for (int u = F.tid; u < (LDS_BYTES - LDSCTL_OFF) / 4; u += NWAVES * 64) ((LAS unsigned*)(F.lds + LDSCTL_OFF))[u] = 0u;
    __syncthreads();
    XcdBarrier bar; bar.bar = (unsigned*)(F.ctl + CW_BAR); bar.x = 0; bar.st = nullptr;
#if MK_N_LAUNCHES == 1
    bar = xcd_barrier_post((unsigned*)(F.ctl + CW_BAR), F.MISC + 8);
#define GRID_BAR() xcd_barrier(bar)
#else
#define GRID_BAR() do {} while (0)
#endif
    const int lo = args.ph_lo, hi = args.ph_hi;
#ifdef PROBE_PH
    unsigned long long pstamp[NPHASE + 1];
#define PSTAMP(k) do { if (blockIdx.x == 0 && F.tid == 0) pstamp[k] = __builtin_amdgcn_s_memrealtime(); } while (0)
#else
#define PSTAMP(k) do {} while (0)
#endif
#ifndef PH_MASK
#define PH_MASK 0xFFFF
#endif
#define IN(k) (((PH_MASK >> (k)) & 1) && lo <= (k) && (k) < hi)
#define BOTH(k) (IN(k) && IN((k) + 1))
    float* ssq_q = (float*)(ws + WS_PSQ_Q); float* ssq_kv = (float*)(ws + WS_PSQ_KV); float* ssq2 = (float*)(ws + WS_PSQ2);
    const float* rope = (const float*)(ws + WS_ROPE);

    PSTAMP(0);
    if (IN(0)) { p0_prologue(F, I, args.inv_freq); if (BOTH(0)) GRID_BAR(); }

    PSTAMP(1);
    if (IN(1)) {
        { pg8::Gemm g{(const bf16_t*)(ws + WS_H), (const bf16_t*)(ws + WS_W1), T, N1, 2048, 2048}; pg8::StaticOrder S; S.init(T, N1, F.G, (int)blockIdx.x);
          EpiProj<0> E{(bf16_t*)(ws + WS_CQ), (bf16_t*)(ws + WS_CKV), (bf16_t*)(ws + WS_DQ), (bf16_t*)(ws + WS_DK), (bf16_t*)(ws + WS_DV), (bf16_t*)(ws + WS_G), (bf16_t*)(ws + WS_KR), ssq_q, ssq_kv, I.b_gate, rope};
          pg8::gemm_phase<EpiProj<0>, pg8::StaticOrder, PG8_ALIGN, PG8_SP2>(F.lds + RING_OFF, g, S, E); }
        {
          pg8::Gemm g{(const bf16_t*)(ws + WS_H8), (const bf16_t*)(ws + WS_W8), T, NG, 1024, 1024, 1.0f / W1_SCALE}; pg8::GateOrder S; S.init(T, NG, F.G, (int)blockIdx.x);
          EpiProj<1> E{(bf16_t*)(ws + WS_CQ), (bf16_t*)(ws + WS_CKV), (bf16_t*)(ws + WS_DQ), (bf16_t*)(ws + WS_DK), (bf16_t*)(ws + WS_DV), (bf16_t*)(ws + WS_G), (bf16_t*)(ws + WS_KR), ssq_q, ssq_kv, I.b_gate, rope};
          pg8::gemm_phase<EpiProj<1>, pg8::GateOrder, PG8_ALIGN, PG8_SP2, true>(F.lds + RING_OFF, g, S, E); }
        if (BOTH(1)) GRID_BAR();
    }
    PSTAMP(2);
    if (IN(2)) {
        { pg8::Gemm g{(const bf16_t*)(ws + WS_CQ), (const bf16_t*)(ws + WS_WUQ), T, 1536, 384, 384, 1.0f / W1_SCALE}; pg8::StaticOrder S; S.init(T, 1536, F.G, (int)blockIdx.x);
          EpiQup E{(bf16_t*)(ws + WS_QN), (bf16_t*)(ws + WS_QR), ssq_q, rope};
          pg8::gemm_phase<EpiQup, pg8::StaticOrder, PG8_ALIGN, PG8_SP2, true>(F.lds + RING_OFF, g, S, E); }
        { pg8::Gemm g{(const bf16_t*)(ws + WS_CKV), (const bf16_t*)(ws + WS_WUKV), T, 2048, 256, 256, 1.0f / W1_SCALE}; pg8::StaticOrder S; S.init(T, 2048, F.G, (int)blockIdx.x);
          EpiKVup E{(bf16_t*)(ws + WS_KN), (bf16_t*)(ws + WS_V), ssq_kv};
          pg8::gemm_phase<EpiKVup, pg8::StaticOrder, PG8_ALIGN, PG8_SP2, true>(F.lds + RING_OFF, g, S, E); }
        if (BOTH(2)) GRID_BAR();
    }
    PSTAMP(3);
#ifdef ATT_REF
    if (IN(3)) { p3_attention_ref(F, I); if (BOTH(3)) GRID_BAR(); }
#else
    if (IN(3)) { p3_attention(F, I); if (BOTH(3)) GRID_BAR(); }
#ifdef ATT_CHECK
    if (IN(3)) { p3_attention_ref(F, I); GRID_BAR(); }
#endif
#endif
    PSTAMP(4);
    if (IN(4)) {
        pg8::Gemm2 g{(const bf16_t*)(ws + WS_OM), (const bf16_t*)(ws + WS_OD), (const bf16_t*)(ws + WS_WOM), (const bf16_t*)(ws + WS_WOD), T, 2048, 1024, 1024};
        pg8::StaticOrder S; S.init(T, 2048, F.G, (int)blockIdx.x);
        EpiGate2 E{(const bf16_t*)(ws + WS_G), (bf16_t*)(ws + WS_MG)};
        pg8::gemm_phase2<EpiGate2, pg8::StaticOrder, PG8_ALIGN, PG8_SP2>(F.lds + RING_OFF, g, S, E);
        if (BOTH(4)) GRID_BAR();
    }
    PSTAMP(5);
    PSTAMP(6);
    if (IN(6)) {
#ifdef PEER_BF16
        convert_experts(F, I);
#else
#ifdef PEER_FP6
        convert_experts_fp6(F, I);
#else
        convert_experts_fp8(F, I);
#endif
#endif
        pg8::Gemm g{(const bf16_t*)(ws + WS_MG), (const bf16_t*)(ws + WS_WOUT), T, 2048, 2048, 2048}; pg8::StaticOrder S; S.init(T, 2048, F.G, (int)blockIdx.x);
        EpiRes E{I.x, (float*)(ws + WS_X2), (bf16_t*)(ws + WS_X2B), ssq2};
        pg8::gemm_phase<EpiRes, pg8::StaticOrder, PG8_ALIGN, PG8_SP2>(F.lds + RING_OFF, g, S, E);
        if (BOTH(6)) GRID_BAR();
    }
    PSTAMP(7);
    if (IN(7)) {
        pg8::Gemm g{(const bf16_t*)(ws + WS_X2B), (const bf16_t*)(ws + WS_WQP), T, 2048, 2048, 2048}; pg8::StaticOrder S; S.init(T, 2048, F.G, (int)blockIdx.x);
        EpiQP E{(bf16_t*)(ws + WS_QP), ssq2, (const LAS float*)(F.lds + RTAB_OFF), {-1, -1, -1, -1}};
        {
            LAS float* tab = (LAS float*)(F.lds + RTAB_OFF); pg8::Unit u;
#pragma unroll
            for (int i = 0; i < RTAB_SLOTS; ++i) {
                if (S.next(i, u)) {
                    E.pms[i] = u.pm;
                    const int r = F.tid >> 1, hf = F.tid & 1; const float* p = ssq2 + ((size_t)u.pm * 256 + r) * 32 + hf * 16;
                    const f32x4 q0 = *(const f32x4*)p, q1 = *(const f32x4*)(p + 4), q2 = *(const f32x4*)(p + 8), q3 = *(const f32x4*)(p + 12);
                    float t = (((q0[0] + q0[1]) + (q0[2] + q0[3])) + ((q1[0] + q1[1]) + (q1[2] + q1[3]))) + (((q2[0] + q2[1]) + (q2[2] + q2[3])) + ((q3[0] + q3[1]) + (q3[2] + q3[3])));
                    t += __shfl_xor(t, 1);
                    if (hf == 0) tab[i * 256 + r] = 1.0f / sqrtf(t * (1.0f / 2048.0f) + EPS);
                }
            }
            __syncthreads();
        }
        pg8::gemm_phase<EpiQP, pg8::StaticOrder, PG8_ALIGN, PG8_SP2>(F.lds + RING_OFF, g, S, E);
        if (BOTH(7)) GRID_BAR();
    }
    PSTAMP(8);
#if defined(ROUTE_REF) || defined(PEER_BF16) || defined(NO_FUSE89)
#ifdef ROUTE_REF
    if (IN(8)) { p7_routing_ref(F); if (BOTH(8)) GRID_BAR(); }
#else
    if (IN(8)) { p8_routing(F, I); if (BOTH(8)) GRID_BAR(); }
#endif
    PSTAMP(9);
#ifdef PEER_BF16
    if (IN(9)) { p8_gather(F, I, args.out); }
#else
    if (IN(9)) { p9_gather_fp8(F, I, args.out); }
#endif
#else
    if (IN(8) && IN(9)) { p89_route_gather(F, I, args.out); }
    PSTAMP(9);
#endif
    PSTAMP(10);
#ifdef PROBE_PH
    if (blockIdx.x == 0 && F.tid == 0) {
        const unsigned long long span = (pstamp[PROBE_PH + 1] - pstamp[PROBE_PH]) * PROBE_MUL, t0 = __builtin_amdgcn_s_memrealtime();
        while (__builtin_amdgcn_s_memrealtime() - t0 < span) __builtin_amdgcn_s_sleep(32);
    }
#endif
#undef IN
#undef BOTH
}

extern "C" void kernel_launch(void* const* d_in, const int* in_sizes, int n_in, void* d_out, int out_size, void* d_ws, size_t ws_size, hipStream_t stream) {
    static int grid = 0;
    if (grid == 0) {
        if (n_in != 19 || out_size != T * D_MODEL || ws_size < WS_END) { fprintf(stderr, "kernel_launch: unexpected shapes: n_in %d out %d ws %zu\n", n_in, out_size, ws_size); grid = -1; return; }
        int dev = 0, cus = 0, per_cu = 0;
        if (hipGetDevice(&dev) != hipSuccess || hipDeviceGetAttribute(&cus, hipDeviceAttributeMultiprocessorCount, dev) != hipSuccess) { grid = -1; return; }
        if (hipFuncSetAttribute((const void*)mega_fwd, hipFuncAttributeMaxDynamicSharedMemorySize, LDS_BYTES) != hipSuccess) { fprintf(stderr, "kernel_launch: hipFuncSetAttribute failed\n"); grid = -1; return; }
        if (hipOccupancyMaxActiveBlocksPerMultiprocessor(&per_cu, (const void*)mega_fwd, NWAVES * 64, LDS_BYTES) != hipSuccess || per_cu < 1)
            fprintf(stderr, "kernel_launch: occupancy query reports %d workgroups per CU\n", per_cu);
        (void)hipGetLastError();
        grid = cus;
    }
    if (grid < 0) return;
    if (hipMemsetAsync((char*)d_ws + WS_CTL, 0, CTL_ZERO_BYTES, stream) != hipSuccess) { fprintf(stderr, "kernel_launch: memset failed\n"); return; }
    Args a{};
    const float** ip = (const float**)&a.in;
    for (int i = 0; i < 19; ++i) ip[i] = (const float*)d_in[i];
    a.out = (float*)d_out; a.ws = (unsigned char*)d_ws;
    for (int i = 0; i < 32; ++i) a.inv_freq[i] = pow(10000.0, -(double)i / 32.0);
#if MK_N_LAUNCHES == 1
    a.ph_lo = 0; a.ph_hi = NPHASE;
    hipLaunchKernelGGL(mega_fwd, dim3(grid), dim3(NWAVES * 64), LDS_BYTES, stream, a);
#else
    for (int p = 0; p < NPHASE; ++p) { a.ph_lo = p; a.ph_hi = p + 1; hipLaunchKernelGGL(mega_fwd, dim3(grid), dim3(NWAVES * 64), LDS_BYTES, stream, a); }
#endif
    const hipError_t le = hipPeekAtLastError();
    if (le != hipSuccess) fprintf(stderr, "kernel_launch: launch failed: %s\n", hipGetErrorName(le));
}
```

```cpp
#include <hip/hip_runtime.h>
#include <cstdio>
#include <cstdint>
#include <cmath>

#ifndef MK_N_LAUNCHES
#define MK_N_LAUNCHES 1
#endif

constexpr int D_MODEL = 2048, BATCH = 2, SEQ = 8192, T = BATCH * SEQ;
constexpr int OFF_CQ = 0, OFF_CKV = 768, OFF_KR = 1280, OFF_DQ = 1344, OFF_DK = 2368, OFF_DV = 3392, OFF_GATE = 4416, IN_COLS = 8512;
constexpr int N1 = 3072;
constexpr int NG = 5632;
constexpr float W1_SCALE = 32.0f;
constexpr int NEXP = 16384;
constexpr float EPS = 1e-6f;
constexpr float LOG2E = 1.4426950408889634f;
constexpr float C2_MLA = 0.07216878364870322f * LOG2E;
constexpr float C2_DIFF = 0.125f * LOG2E;
constexpr float LAMBDA_INIT = 0.2f;

namespace pg8 {
#define PG8_LAS __attribute__((address_space(3)))
typedef unsigned short bf16_t;
typedef short bf16x8 __attribute__((ext_vector_type(8)));
typedef float f32x4 __attribute__((ext_vector_type(4)));
typedef unsigned u32x4 __attribute__((ext_vector_type(4)));
typedef unsigned u32x2 __attribute__((ext_vector_type(2)));
typedef int v8i32 __attribute__((ext_vector_type(8)));
constexpr int BM = 256, BK = 64, HALF = 128, HTB = HALF * BK * 2, STAGE_BYTES = 8 * HTB, NXCD = 8, WGM = 8;

__host__ __device__ __forceinline__ int lds_byte(int r, int c) { const int st = (r >> 4) * 2 + (c >> 5), rr = r & 15, cc = c & 31, ob = rr * 64 + cc * 2; return st * 1024 + (ob ^ (((ob >> 9) & 1) << 5)); }
__host__ __device__ __forceinline__ void stage_rc(int b, int& R, int& C) { const int st = b / 1024, sb = b % 1024, swz = sb ^ (((sb >> 9) & 1) << 5); R = (st >> 1) * 16 + swz / 64; C = (st & 1) * 32 + (swz % 64) / 2; }
__host__ __device__ __forceinline__ int perm32(int rho) { const int n = rho >> 4, i = rho & 15; return 8 * (i >> 2) + 4 * n + (i & 3); }

struct Unit { int pm, pn; };
struct Gemm { const bf16_t* A; const bf16_t* Bt; int M, N, K, lda; float oscale; };

struct StaticOrder {
    int nM, nN, nwg, G, c;
    __host__ __device__ __forceinline__ void init(int M, int N, int G_, int c_) { nM = M / BM; nN = N / BM; nwg = nM * nN; G = G_; c = c_; }
    __host__ __device__ __forceinline__ bool next(int i, Unit& u) const { return map((long)i * G + c, u); }
    __host__ __device__ __forceinline__ bool map(long L, Unit& u) const {
        if (L >= nwg) return false;
        int wgid = (int)L; { const int q = nwg / NXCD, r = nwg % NXCD, xcd = wgid % NXCD, off = wgid / NXCD; wgid = (xcd < r ? xcd * (q + 1) : r * (q + 1) + (xcd - r) * q) + off; }
        const int nig = WGM * nN, gid = wgid / nig, fm = gid * WGM, gsz = (nM - fm) < WGM ? (nM - fm) : WGM;
        u.pm = fm + ((wgid % nig) % gsz); u.pn = (wgid % nig) / gsz; return true;
    }
    __device__ __forceinline__ void a_ready(const Unit&) const {}
    __device__ __forceinline__ void done(const Unit&) const {}
};

struct GateOrder : StaticOrder {
    __host__ __device__ __forceinline__ bool next(int i, Unit& u) const {
        if (G != 256 || nwg != 1024) return StaticOrder::next(i, u);
        if (i < 3) return map((long)i * 256 + c, u);
        if (c >= 128 && i < 5) return map(768 + (long)(i - 3) * 128 + (c - 128), u);
        return false;
    }
};
typedef float f32x2_t __attribute__((ext_vector_type(2))); typedef __bf16 bf16x2_t __attribute__((ext_vector_type(2)));
__device__ __forceinline__ unsigned cvtpk(float lo, float hi) { f32x2_t v = {lo, hi}; bf16x2_t b = __builtin_convertvector(v, bf16x2_t); return __builtin_bit_cast(unsigned, b); }
__device__ __forceinline__ float bf2f(unsigned short h) { return __builtin_bit_cast(float, (unsigned)h << 16); }
__device__ __forceinline__ float bflo(unsigned w) { return __builtin_bit_cast(float, w << 16); }
__device__ __forceinline__ float bfhi(unsigned w) { return __builtin_bit_cast(float, w & 0xffff0000u); }

template <class Epi, class Sched, bool ALIGN_EPI = false, bool SP2 = false, bool FP8 = false>
__device__ __forceinline__ void gemm_phase(PG8_LAS unsigned char* lds, const Gemm g, const Sched& S, const Epi& E) {
    const int tid = threadIdx.x, wid = __builtin_amdgcn_readfirstlane(tid >> 6), lane = tid & 63, wr = wid >> 2, wc = wid & 3, fr = lane & 15, fq = lane >> 4;
    const int K = g.K, nt = K / BK, lda = g.lda;
    unsigned voffA[2], voffB[2];
#pragma unroll
    for (int i = 0; i < 2; ++i) { int R, C; stage_rc(tid * 16 + i * 8192, R, C); const int Rb = Epi::PERM ? ((R & ~31) + perm32(R & 31)) : R;
        voffA[i] = (unsigned)(R * lda + C) * 2u; voffB[i] = (unsigned)(Rb * K + C) * 2u; }
    const size_t kstep = (size_t)(BK * 2);
    const size_t hstepA = (size_t)HALF * lda * 2, hstepB = (size_t)HALF * K * 2;
    const size_t tstepA = 2 * hstepA, tstepB = 2 * hstepB;
    const unsigned ldsw = (unsigned)wid * 1024u;
    const int aoff = lds_byte(wr * 64 + fr, fq * 8), boff = lds_byte(wc * 32 + fr, fq * 8);
    const int aoff8 = lds_byte(wr * 64 + fr, 16 * fq) & ~31, boff8 = lds_byte(wc * 32 + fr, 16 * fq) & ~31;
#define PG8_SA(b, h) (((b) * 2 + (h)) * HTB)
#define PG8_SB(b, h) ((4 + (b) * 2 + (h)) * HTB)
#define PG8_STAGE(bufoff, gbase, voff) do { _Pragma("unroll") for (int _i = 0; _i < 2; ++_i) \
        __builtin_amdgcn_global_load_lds((const unsigned*)((const char*)(gbase) + (voff)[_i]), (PG8_LAS unsigned*)(lds + (bufoff) + ldsw + _i * 8192), 16, 0, 0); } while (0)
#define PG8_LDA(dst, b, h) do { _Pragma("unroll") for (int m = 0; m < 4; ++m) _Pragma("unroll") for (int k = 0; k < 2; ++k) { if constexpr (FP8) { if (k == 0) dst##8[m] = *(const PG8_LAS v8i32*)(lds + PG8_SA(b, h) + aoff8 + m * 2048); } else dst[m][k] = *(const PG8_LAS bf16x8*)(lds + PG8_SA(b, h) + aoff + m * 2048 + k * 1024); } } while (0)
#define PG8_LDB(dst, b, h) do { _Pragma("unroll") for (int n = 0; n < 2; ++n) _Pragma("unroll") for (int k = 0; k < 2; ++k) { if constexpr (FP8) { if (k == 0) dst##8[n] = *(const PG8_LAS v8i32*)(lds + PG8_SB(b, h) + boff8 + n * 2048); } else dst[n][k] = *(const PG8_LAS bf16x8*)(lds + PG8_SB(b, h) + boff + n * 2048 + k * 1024); } } while (0)
#define PG8_MMA(ai, bj, At, Bt) do { __builtin_amdgcn_s_setprio(1); _Pragma("unroll") for (int m = 0; m < 4; ++m) _Pragma("unroll") for (int n = 0; n < 2; ++n) { if constexpr (FP8) { \
        asm volatile("v_mfma_scale_f32_16x16x128_f8f6f4 %0, %1, %2, %0, %3, %3 op_sel_hi:[0,0,0]" : "+v"(acc[ai][bj][m][n]) : "v"(Bt##8[n]), "v"(At##8[m]), "v"(mxs));   \
        } else { _Pragma("unroll") for (int k = 0; k < 2; ++k) \
        acc[ai][bj][m][n] = __builtin_amdgcn_mfma_f32_16x16x32_bf16(Bt[n][k], At[m][k], acc[ai][bj][m][n], 0, 0, 0); } } __builtin_amdgcn_s_setprio(0); } while (0)
#define PG8_WAIT_V(n) asm volatile("s_waitcnt vmcnt(" #n ")" ::: "memory")
#define PG8_WAIT_L(n) asm volatile("s_waitcnt lgkmcnt(" #n ")" ::: "memory")
#define PG8_BAR __builtin_amdgcn_s_barrier()
#define PG8_SCHED __builtin_amdgcn_sched_barrier(0)
    Unit cur, nxt; int ui = 0;
    if (!S.next(0, cur)) return;
    f32x4 acc[2][2][4][2];
#pragma unroll
    for (int a = 0; a < 2; ++a)
#pragma unroll
        for (int b = 0; b < 2; ++b)
#pragma unroll
            for (int m = 0; m < 4; ++m)
#pragma unroll
                for (int n = 0; n < 2; ++n) acc[a][b][m][n] = (f32x4){0.f, 0.f, 0.f, 0.f};
    bf16x8 At[4][2], B0[2][2], B1[2][2];
    v8i32 At8[4], B08[2], B18[2];
    const int mxs = 0x7F7F7F7F;
    const char* cA = (const char*)g.A + (size_t)cur.pm * tstepA; const char* cB = (const char*)g.Bt + (size_t)cur.pn * tstepB;
    S.a_ready(cur);
    if constexpr (SP2) {
        PG8_STAGE(PG8_SB(0, 0), cB, voffB); PG8_STAGE(PG8_SB(0, 1), cB + hstepB, voffB); PG8_STAGE(PG8_SA(0, 0), cA, voffA); PG8_STAGE(PG8_SA(0, 1), cA + hstepA, voffA);
        if (wr == 1) PG8_BAR;
        PG8_WAIT_V(2); PG8_BAR;
        PG8_STAGE(PG8_SB(1, 0), cB + kstep, voffB); PG8_STAGE(PG8_SA(1, 0), cA + kstep, voffA); PG8_STAGE(PG8_SB(1, 1), cB + hstepB + kstep, voffB);
        PG8_WAIT_V(6); PG8_BAR;
    } else {
        PG8_STAGE(PG8_SB(0, 0), cB, voffB); PG8_STAGE(PG8_SA(0, 0), cA, voffA); PG8_STAGE(PG8_SB(0, 1), cB + hstepB, voffB); PG8_STAGE(PG8_SA(0, 1), cA + hstepA, voffA);
        if (wr == 1) PG8_BAR;
        PG8_WAIT_V(4); PG8_BAR;
        PG8_STAGE(PG8_SB(1, 0), cB + kstep, voffB); PG8_STAGE(PG8_SA(1, 0), cA + kstep, voffA); PG8_STAGE(PG8_SB(1, 1), cB + hstepB + kstep, voffB);
        PG8_WAIT_V(6); PG8_BAR;
    }
    for (;;) {
        const bool has_next = S.next(ui + 1, nxt);
        const char* nA = has_next ? (const char*)g.A + (size_t)nxt.pm * tstepA : cA; const char* nB = has_next ? (const char*)g.Bt + (size_t)nxt.pn * tstepB : cB;
        for (int t = 0; t < nt; t += 2) {
            const bool last = (t == nt - 2);
            const char* a1 = cA + (size_t)(t + 1) * kstep;
            const char* a2 = last ? nA : cA + (size_t)(t + 2) * kstep; const char* b2 = last ? nB : cB + (size_t)(t + 2) * kstep;
            const char* a3 = a2 + kstep; const char* b3 = b2 + kstep;
            if (last && has_next) S.a_ready(nxt);
            if constexpr (SP2) {
            PG8_LDB(B0, 0, 0); PG8_LDB(B1, 0, 1); PG8_SCHED; PG8_LDA(At, 0, 0); PG8_STAGE(PG8_SA(1, 1), a1 + hstepA, voffA);
            PG8_WAIT_V(8); PG8_WAIT_L(0); PG8_BAR; PG8_MMA(0, 0, At, B0); PG8_MMA(0, 1, At, B1); PG8_BAR; PG8_SCHED;
            PG8_LDA(At, 0, 1); PG8_STAGE(PG8_SB(0, 0), b2, voffB); PG8_STAGE(PG8_SB(0, 1), b2 + hstepB, voffB); PG8_STAGE(PG8_SA(0, 0), a2, voffA);
            PG8_WAIT_V(8); PG8_WAIT_L(0); PG8_BAR; PG8_MMA(1, 0, At, B0); PG8_MMA(1, 1, At, B1); PG8_BAR; PG8_SCHED;
            PG8_LDB(B0, 1, 0); PG8_LDB(B1, 1, 1); PG8_SCHED; PG8_LDA(At, 1, 0); PG8_STAGE(PG8_SA(0, 1), a2 + hstepA, voffA);
            PG8_WAIT_V(8); PG8_WAIT_L(0); PG8_BAR; PG8_MMA(0, 0, At, B0); PG8_MMA(0, 1, At, B1); PG8_BAR; PG8_SCHED;
            PG8_LDA(At, 1, 1); PG8_STAGE(PG8_SB(1, 0), b3, voffB); PG8_STAGE(PG8_SB(1, 1), b3 + hstepB, voffB); PG8_STAGE(PG8_SA(1, 0), a3, voffA);
            PG8_WAIT_V(8); PG8_WAIT_L(0); PG8_BAR; PG8_MMA(1, 0, At, B0); PG8_MMA(1, 1, At, B1); PG8_BAR; PG8_SCHED;
            } else {
            PG8_LDB(B0, 0, 0); PG8_SCHED; PG8_LDA(At, 0, 0); PG8_STAGE(PG8_SA(1, 1), a1 + hstepA, voffA);
            PG8_WAIT_L(8); PG8_BAR; PG8_WAIT_L(0); PG8_MMA(0, 0, At, B0); PG8_BAR; PG8_SCHED;
            PG8_LDB(B1, 0, 1); PG8_STAGE(PG8_SB(0, 0), b2, voffB);
            PG8_BAR; PG8_WAIT_L(0); PG8_MMA(0, 1, At, B1); PG8_BAR;
            PG8_LDA(At, 0, 1); PG8_STAGE(PG8_SA(0, 0), a2, voffA);
            PG8_BAR; PG8_WAIT_L(0); PG8_MMA(1, 0, At, B0); PG8_BAR; PG8_SCHED;
            PG8_STAGE(PG8_SB(0, 1), b2 + hstepB, voffB);
            PG8_WAIT_V(6); PG8_BAR; PG8_MMA(1, 1, At, B1); PG8_BAR;
            PG8_LDB(B0, 1, 0); PG8_SCHED; PG8_LDA(At, 1, 0); PG8_STAGE(PG8_SA(0, 1), a2 + hstepA, voffA);
            PG8_WAIT_L(8); PG8_BAR; PG8_WAIT_L(0); PG8_MMA(0, 0, At, B0); PG8_BAR; PG8_SCHED;
            PG8_LDB(B1, 1, 1); PG8_STAGE(PG8_SB(1, 0), b3, voffB);
            PG8_BAR; PG8_WAIT_L(0); PG8_MMA(0, 1, At, B1); PG8_BAR;
            PG8_LDA(At, 1, 1); PG8_STAGE(PG8_SA(1, 0), a3, voffA);
            PG8_BAR; PG8_WAIT_L(0); PG8_MMA(1, 0, At, B0); PG8_BAR; PG8_SCHED;
            PG8_STAGE(PG8_SB(1, 1), b3 + hstepB, voffB);
            PG8_WAIT_V(6); PG8_BAR; PG8_MMA(1, 1, At, B1); PG8_BAR;
            }
        }
        if constexpr (ALIGN_EPI) { if (wr == 0) PG8_BAR; }
        if constexpr (FP8) {
            asm volatile("s_nop 15\n\ts_nop 7" ::: "memory");
#pragma unroll
            for (int a = 0; a < 2; ++a)
#pragma unroll
                for (int b = 0; b < 2; ++b)
#pragma unroll
                    for (int m = 0; m < 4; ++m)
#pragma unroll
                        for (int n = 0; n < 2; ++n) acc[a][b][m][n] *= g.oscale; }
        E(acc, cur, wr, wc, fr, fq); S.done(cur);
        if (!has_next) break;
#pragma unroll
        for (int a = 0; a < 2; ++a)
#pragma unroll
            for (int b = 0; b < 2; ++b)
#pragma unroll
                for (int m = 0; m < 4; ++m)
#pragma unroll
                    for (int n = 0; n < 2; ++n) acc[a][b][m][n] = (f32x4){0.f, 0.f, 0.f, 0.f};
        cur = nxt; cA = nA; cB = nB; ++ui;
        if constexpr (ALIGN_EPI) { if (wr == 1) PG8_BAR; }
    }
    PG8_WAIT_V(0);
    if constexpr (!ALIGN_EPI) { if (wr == 0) PG8_BAR; }
    PG8_BAR;
#undef PG8_SA
#undef PG8_SB
#undef PG8_STAGE
#undef PG8_LDA
#undef PG8_LDB
#undef PG8_MMA
#undef PG8_WAIT_V
#undef PG8_WAIT_L
#undef PG8_BAR
#undef PG8_SCHED
}
struct Gemm2 { const bf16_t *A1, *A2, *B1, *B2; int M, N, K1, lda; };
template <class Epi, class Sched, bool ALIGN_EPI = false, bool SP2 = false>
__device__ __forceinline__ void gemm_phase2(PG8_LAS unsigned char* lds, const Gemm2 g, const Sched& S, const Epi& E) {
    const int tid = threadIdx.x, wid = __builtin_amdgcn_readfirstlane(tid >> 6), lane = tid & 63, wr = wid >> 2, wc = wid & 3, fr = lane & 15, fq = lane >> 4;
    const int K = g.K1, nt = K / BK, lda = g.lda;
    unsigned voffA[2], voffB[2];
#pragma unroll
    for (int i = 0; i < 2; ++i) { int R, C; stage_rc(tid * 16 + i * 8192, R, C); const int Rb = Epi::PERM ? ((R & ~31) + perm32(R & 31)) : R;
        voffA[i] = (unsigned)(R * lda + C) * 2u; voffB[i] = (unsigned)(Rb * K + C) * 2u; }
    const size_t kstep = (size_t)(BK * 2);
    const size_t hstepA = (size_t)HALF * lda * 2, hstepB = (size_t)HALF * K * 2;
    const size_t tstepA = 2 * hstepA, tstepB = 2 * hstepB;
    const unsigned ldsw = (unsigned)wid * 1024u;
    const int aoff = lds_byte(wr * 64 + fr, fq * 8), boff = lds_byte(wc * 32 + fr, fq * 8);
#define PG8_SA(b, h) (((b) * 2 + (h)) * HTB)
#define PG8_SB(b, h) ((4 + (b) * 2 + (h)) * HTB)
#define PG8_STAGE(bufoff, gbase, voff) do { _Pragma("unroll") for (int _i = 0; _i < 2; ++_i) \
        __builtin_amdgcn_global_load_lds((const unsigned*)((const char*)(gbase) + (voff)[_i]), (PG8_LAS unsigned*)(lds + (bufoff) + ldsw + _i * 8192), 16, 0, 0); } while (0)
#define PG8_LDA(dst, b, h) do { _Pragma("unroll") for (int m = 0; m < 4; ++m) _Pragma("unroll") for (int k = 0; k < 2; ++k) dst[m][k] = *(const PG8_LAS bf16x8*)(lds + PG8_SA(b, h) + aoff + m * 2048 + k * 1024); } while (0)
#define PG8_LDB(dst, b, h) do { _Pragma("unroll") for (int n = 0; n < 2; ++n) _Pragma("unroll") for (int k = 0; k < 2; ++k) dst[n][k] = *(const PG8_LAS bf16x8*)(lds + PG8_SB(b, h) + boff + n * 2048 + k * 1024); } while (0)
#define PG8_MMA(ai, bj, At, Bt) do { __builtin_amdgcn_s_setprio(1); _Pragma("unroll") for (int m = 0; m < 4; ++m) _Pragma("unroll") for (int n = 0; n < 2; ++n) _Pragma("unroll") for (int k = 0; k < 2; ++k) \
        acc[ai][bj][m][n] = __builtin_amdgcn_mfma_f32_16x16x32_bf16(Bt[n][k], At[m][k], acc[ai][bj][m][n], 0, 0, 0); __builtin_amdgcn_s_setprio(0); } while (0)
#define PG8_WAIT_V(n) asm volatile("s_waitcnt vmcnt(" #n ")" ::: "memory")
#define PG8_WAIT_L(n) asm volatile("s_waitcnt lgkmcnt(" #n ")" ::: "memory")
#define PG8_BAR __builtin_amdgcn_s_barrier()
#define PG8_SCHED __builtin_amdgcn_sched_barrier(0)
    Unit cur, nxt; int ui = 0;
    if (!S.next(0, cur)) return;
    f32x4 acc[2][2][4][2];
#pragma unroll
    for (int a = 0; a < 2; ++a)
#pragma unroll
        for (int b = 0; b < 2; ++b)
#pragma unroll
            for (int m = 0; m < 4; ++m)
#pragma unroll
                for (int n = 0; n < 2; ++n) acc[a][b][m][n] = (f32x4){0.f, 0.f, 0.f, 0.f};
    bf16x8 At[4][2], B0[2][2], B1[2][2];
    const char* cA = (const char*)g.A1 + (size_t)cur.pm * tstepA; const char* cB = (const char*)g.B1 + (size_t)cur.pn * tstepB;
    S.a_ready(cur);
    if constexpr (SP2) {
        PG8_STAGE(PG8_SB(0, 0), cB, voffB); PG8_STAGE(PG8_SB(0, 1), cB + hstepB, voffB); PG8_STAGE(PG8_SA(0, 0), cA, voffA); PG8_STAGE(PG8_SA(0, 1), cA + hstepA, voffA);
        if (wr == 1) PG8_BAR;
        PG8_WAIT_V(2); PG8_BAR;
        PG8_STAGE(PG8_SB(1, 0), cB + kstep, voffB); PG8_STAGE(PG8_SA(1, 0), cA + kstep, voffA); PG8_STAGE(PG8_SB(1, 1), cB + hstepB + kstep, voffB);
        PG8_WAIT_V(6); PG8_BAR;
    } else {
        PG8_STAGE(PG8_SB(0, 0), cB, voffB); PG8_STAGE(PG8_SA(0, 0), cA, voffA); PG8_STAGE(PG8_SB(0, 1), cB + hstepB, voffB); PG8_STAGE(PG8_SA(0, 1), cA + hstepA, voffA);
        if (wr == 1) PG8_BAR;
        PG8_WAIT_V(4); PG8_BAR;
        PG8_STAGE(PG8_SB(1, 0), cB + kstep, voffB); PG8_STAGE(PG8_SA(1, 0), cA + kstep, voffA); PG8_STAGE(PG8_SB(1, 1), cB + hstepB + kstep, voffB);
        PG8_WAIT_V(6); PG8_BAR;
    }
    for (;;) {
        const int nhalf = (ui + 1) & 1;
        const bool has_next = S.next((ui + 1) >> 1, nxt);
        const char* nA = has_next ? (const char*)(nhalf ? g.A2 : g.A1) + (size_t)nxt.pm * tstepA : cA; const char* nB = has_next ? (const char*)(nhalf ? g.B2 : g.B1) + (size_t)nxt.pn * tstepB : cB;
        for (int t = 0; t < nt; t += 2) {
            const bool last = (t == nt - 2);
            const char* a1 = cA + (size_t)(t + 1) * kstep;
            const char* a2 = last ? nA : cA + (size_t)(t + 2) * kstep; const char* b2 = last ? nB : cB + (size_t)(t + 2) * kstep;
            const char* a3 = a2 + kstep; const char* b3 = b2 + kstep;
            if (last && has_next) S.a_ready(nxt);
            if constexpr (SP2) {
            PG8_LDB(B0, 0, 0); PG8_LDB(B1, 0, 1); PG8_SCHED; PG8_LDA(At, 0, 0); PG8_STAGE(PG8_SA(1, 1), a1 + hstepA, voffA);
            PG8_WAIT_V(8); PG8_WAIT_L(0); PG8_BAR; PG8_MMA(0, 0, At, B0); PG8_MMA(0, 1, At, B1); PG8_BAR; PG8_SCHED;
            PG8_LDA(At, 0, 1); PG8_STAGE(PG8_SB(0, 0), b2, voffB); PG8_STAGE(PG8_SB(0, 1), b2 + hstepB, voffB); PG8_STAGE(PG8_SA(0, 0), a2, voffA);
            PG8_WAIT_V(8); PG8_WAIT_L(0); PG8_BAR; PG8_MMA(1, 0, At, B0); PG8_MMA(1, 1, At, B1); PG8_BAR; PG8_SCHED;
            PG8_LDB(B0, 1, 0); PG8_LDB(B1, 1, 1); PG8_SCHED; PG8_LDA(At, 1, 0); PG8_STAGE(PG8_SA(0, 1), a2 + hstepA, voffA);
            PG8_WAIT_V(8); PG8_WAIT_L(0); PG8_BAR; PG8_MMA(0, 0, At, B0); PG8_MMA(0, 1, At, B1); PG8_BAR; PG8_SCHED;
            PG8_LDA(At, 1, 1); PG8_STAGE(PG8_SB(1, 0), b3, voffB); PG8_STAGE(PG8_SB(1, 1), b3 + hstepB, voffB); PG8_STAGE(PG8_SA(1, 0), a3, voffA);
            PG8_WAIT_V(8); PG8_WAIT_L(0); PG8_BAR; PG8_MMA(1, 0, At, B0); PG8_MMA(1, 1, At, B1); PG8_BAR; PG8_SCHED;
            } else {
            PG8_LDB(B0, 0, 0); PG8_SCHED; PG8_LDA(At, 0, 0); PG8_STAGE(PG8_SA(1, 1), a1 + hstepA, voffA);
            PG8_WAIT_L(8); PG8_BAR; PG8_WAIT_L(0); PG8_MMA(0, 0, At, B0); PG8_BAR; PG8_SCHED;
            PG8_LDB(B1, 0, 1); PG8_STAGE(PG8_SB(0, 0), b2, voffB);
            PG8_BAR; PG8_WAIT_L(0); PG8_MMA(0, 1, At, B1); PG8_BAR;
            PG8_LDA(At, 0, 1); PG8_STAGE(PG8_SA(0, 0), a2, voffA);
            PG8_BAR; PG8_WAIT_L(0); PG8_MMA(1, 0, At, B0); PG8_BAR; PG8_SCHED;
            PG8_STAGE(PG8_SB(0, 1), b2 + hstepB, voffB);
            PG8_WAIT_V(6); PG8_BAR; PG8_MMA(1, 1, At, B1); PG8_BAR;
            PG8_LDB(B0, 1, 0); PG8_SCHED; PG8_LDA(At, 1, 0); PG8_STAGE(PG8_SA(0, 1), a2 + hstepA, voffA);
            PG8_WAIT_L(8); PG8_BAR; PG8_WAIT_L(0); PG8_MMA(0, 0, At, B0); PG8_BAR; PG8_SCHED;
            PG8_LDB(B1, 1, 1); PG8_STAGE(PG8_SB(1, 0), b3, voffB);
            PG8_BAR; PG8_WAIT_L(0); PG8_MMA(0, 1, At, B1); PG8_BAR;
            PG8_LDA(At, 1, 1); PG8_STAGE(PG8_SA(1, 0), a3, voffA);
            PG8_BAR; PG8_WAIT_L(0); PG8_MMA(1, 0, At, B0); PG8_BAR; PG8_SCHED;
            PG8_STAGE(PG8_SB(1, 1), b3 + hstepB, voffB);
            PG8_WAIT_V(6); PG8_BAR; PG8_MMA(1, 1, At, B1); PG8_BAR;
            }
        }
        if constexpr (ALIGN_EPI) { if (wr == 0) PG8_BAR; }
        if ((ui & 1) == 0) E.mid(acc, cur, wr, wc, fr, fq); else { E(acc, cur, wr, wc, fr, fq); S.done(cur); }
        if (!has_next) break;
        if (ui & 1)
#pragma unroll
        for (int a = 0; a < 2; ++a)
#pragma unroll
            for (int b = 0; b < 2; ++b)
#pragma unroll
                for (int m = 0; m < 4; ++m)
#pragma unroll
                    for (int n = 0; n < 2; ++n) acc[a][b][m][n] = (f32x4){0.f, 0.f, 0.f, 0.f};
        cur = nxt; cA = nA; cB = nB; ++ui;
        if constexpr (ALIGN_EPI) { if (wr == 1) PG8_BAR; }
    }
    PG8_WAIT_V(0);
    if constexpr (!ALIGN_EPI) { if (wr == 0) PG8_BAR; }
    PG8_BAR;
#undef PG8_SA
#undef PG8_SB
#undef PG8_STAGE
#undef PG8_LDA
#undef PG8_LDB
#undef PG8_MMA
#undef PG8_WAIT_V
#undef PG8_WAIT_L
#undef PG8_BAR
#undef PG8_SCHED
}
}

#ifndef PG8_SP2
#define PG8_SP2 true
#endif
#ifndef PG8_ALIGN
#define PG8_ALIGN true
#endif

using pg8::bf16_t; using pg8::f32x4; using pg8::u32x4; using pg8::u32x2; using pg8::cvtpk; using pg8::bf2f; using pg8::bflo; using pg8::bfhi;

constexpr size_t MiB = 1u << 20;
constexpr size_t WS_CTL = 0, CTL_ZERO_BYTES = 32 * 1024;
constexpr size_t WS_ROPE = 1 * MiB;
constexpr size_t WS_WUQ = 3 * MiB, WS_WUKV = 6 * MiB, WS_WOM = 8 * MiB, WS_WOD = 12 * MiB, WS_WOUT = 16 * MiB, WS_WQP = 24 * MiB;
constexpr size_t WS_SKB = 5 * MiB + 512 * 1024;
constexpr size_t WS_W1 = 32 * MiB;
constexpr size_t WS_W8 = 44 * MiB;
constexpr size_t WS_H8 = 396 * MiB;
constexpr size_t WS_H = 66 * MiB;
constexpr size_t WS_CQ = 130 * MiB, WS_CKV = 154 * MiB;
constexpr size_t WS_KR = 170 * MiB, WS_DQ = 172 * MiB, WS_DK = 204 * MiB, WS_DV = 236 * MiB;
constexpr size_t WS_G = 268 * MiB;
constexpr size_t WS_QN = 32 * MiB, WS_QR = 64 * MiB, WS_KN = 80 * MiB, WS_V = 396 * MiB;
constexpr size_t WS_OM = 112 * MiB, WS_OD = 428 * MiB;
constexpr size_t WS_TMP = 32 * MiB;
constexpr size_t WS_MG = 172 * MiB;
constexpr size_t WS_X2 = 268 * MiB;
constexpr size_t WS_X2B = 396 * MiB;
constexpr size_t WS_EU = 32 * MiB, WS_EV = 96 * MiB;
constexpr size_t WS_QP = 172 * MiB;
constexpr size_t WS_IDX = 236 * MiB, WS_GT = 244 * MiB;
constexpr size_t WS_PSQ_Q = 460 * MiB, WS_PSQ_KV = 461 * MiB, WS_PSQ2 = 462 * MiB;
constexpr size_t WS_END = 464 * MiB;
constexpr int CW_TMO = 0, CW_CODE = 1, CW_LAMBDA = 8, CW_TOKCTR = 64;
constexpr int CW_BAR = 4096;

constexpr int RING_OFF = 0, RING_BYTES = 131072;
constexpr int LDSCTL_OFF = RING_BYTES, MISC_OFF = LDSCTL_OFF + 320;
constexpr int LDS_BYTES = 147456;
constexpr int NWAVES = 8;

#define GAS __attribute__((address_space(1)))
#define LAS __attribute__((address_space(3)))
typedef unsigned short bf16;
typedef unsigned v4u __attribute__((ext_vector_type(4)));
typedef GAS unsigned gu32;
#define RLX_AGENT __ATOMIC_RELAXED, __HIP_MEMORY_SCOPE_AGENT
#define LDS_WAIT() asm volatile("s_waitcnt lgkmcnt(0)" ::: "memory")
#define VM_WAIT() asm volatile("s_waitcnt vmcnt(0)" ::: "memory")

#define XB_TMO      128
#define XB_XCNT(j)  (256  + 64 * (j))
#define XB_XSUB(j)  (1280 + 64 * (j))
#define XB_XGEN(j)  (2304 + 64 * (j))
#define XB_TOP      3328
#define XB_TOPGEN   3392
#define XCD_BAR_WORDS 3456
#define XB_SPIN_CAP (1u << 22)
__device__ __forceinline__ unsigned xb_ld(unsigned* p)              { return __hip_atomic_load(p, __ATOMIC_RELAXED, __HIP_MEMORY_SCOPE_AGENT); }
__device__ __forceinline__ unsigned xb_add(unsigned* p, unsigned v) { return __hip_atomic_fetch_add(p, v, __ATOMIC_RELAXED, __HIP_MEMORY_SCOPE_AGENT); }
__device__ __forceinline__ unsigned xb_xcc_id() { return (unsigned)__builtin_amdgcn_s_getreg((3 << 11) | 20) & 0xFu; }
#define XB_SPIN(cond, bar) do { unsigned _sp = 0; while (cond) { __builtin_amdgcn_s_sleep(1); \
    if ((++_sp & 255u) == 0u) { if (xb_ld(&(bar)[XB_TMO])) break; if (_sp > XB_SPIN_CAP) { atomicAdd(&(bar)[XB_TMO], 1u); break; } } } } while (0)
struct XcdBarrier { unsigned* bar; unsigned x; volatile LAS unsigned* st; };
__device__ __forceinline__ XcdBarrier xcd_barrier_post(unsigned* bar, volatile LAS unsigned* st) {
    XcdBarrier b; b.bar = bar; b.x = xb_xcc_id(); b.st = st;
    if (threadIdx.x == 0) (void)xb_add(&bar[XB_XCNT(b.x)], 1u);
    return b;
}
__device__ __forceinline__ void xcd_barrier_complete(unsigned* bar, unsigned x, unsigned& nloc, unsigned& nx) {
    const unsigned G = gridDim.x * gridDim.y * gridDim.z;
    unsigned sum, cnt, mine, sp = 0u;
    for (;;) {
        sum = 0u; cnt = 0u; mine = 0u;
#pragma unroll
        for (unsigned j = 0; j < 16; ++j) { const unsigned c = xb_ld(&bar[XB_XCNT(j)]); sum += c; cnt += (c > 0u) ? 1u : 0u; mine = (j == x) ? c : mine; }
        if (sum == G) break;
        __builtin_amdgcn_s_sleep(1);
        if ((++sp & 255u) == 0u) { if (xb_ld(&bar[XB_TMO])) break; if (sp > XB_SPIN_CAP) { atomicAdd(&bar[XB_TMO], 1u); break; } }
    }
    nloc = mine > 0u ? mine : 1u; nx = cnt > 0u ? cnt : 1u;
}
__device__ __forceinline__ void xcd_barrier(const XcdBarrier& b) {
    asm volatile("s_waitcnt vmcnt(0)" ::: "memory");
    __syncthreads();
    if (threadIdx.x == 0) {
        unsigned* bar = b.bar;
        __builtin_amdgcn_s_waitcnt(0);
        unsigned nloc = b.st[0], nx = b.st[1];
        if (nloc == 0u) { xcd_barrier_complete(bar, b.x, nloc, nx); b.st[0] = nloc; b.st[1] = nx; }
        const unsigned old = xb_add(&bar[XB_XSUB(b.x)], 1u);
        const unsigned gen = old / nloc;
        if (old + 1u == (gen + 1u) * nloc) {
            __builtin_amdgcn_fence(__ATOMIC_RELEASE, "agent");
            asm volatile("s_waitcnt vmcnt(0)" ::: "memory");
            const unsigned og = xb_add(&bar[XB_TOP], 1u);
            const unsigned tg = og / nx;
            if (og + 1u == (tg + 1u) * nx) xb_add(&bar[XB_TOPGEN], 1u);
            else XB_SPIN(xb_ld(&bar[XB_TOPGEN]) == tg, bar);
            __builtin_amdgcn_fence(__ATOMIC_ACQUIRE, "agent");
            xb_add(&bar[XB_XGEN(b.x)], 1u);
            asm volatile("s_waitcnt vmcnt(0)" ::: "memory");
        } else {
            XB_SPIN(xb_ld(&bar[XB_XGEN(b.x)]) == gen, bar);
            __builtin_amdgcn_fence(__ATOMIC_ACQUIRE, "agent");
            asm volatile("s_waitcnt vmcnt(0)" ::: "memory");
        }
    }
    __syncthreads();
}

struct Frame {
    LAS unsigned char* lds;
    volatile LAS unsigned* MISC;
    gu32* ctl;
    unsigned char* ws;
    int tid, lane, wave, vcu, G;
};

__device__ __forceinline__ float wave_sum(float v) {
#pragma unroll
    for (int o = 1; o < 64; o <<= 1) v += __shfl_xor(v, o);
    return v;
}
__device__ __forceinline__ float wave_max(float v) {
#pragma unroll
    for (int o = 1; o < 64; o <<= 1) v = fmaxf(v, __shfl_xor(v, o));
    return v;
}
__device__ __forceinline__ unsigned pk2(float lo, float hi) { return cvtpk(lo, hi); }

template <class Map>
__device__ __forceinline__ void tr_item(const float* W, int Nsrc, int K, const float* kscale, bf16* WT, LAS float* scr, int item, int nblk, int lane, Map map) {
    const int kb = item / nblk, nb = item % nblk, k0 = 64 * kb, n0 = 32 * nb;
    const int sc = map(n0 + (lane & 31));
    float tv[32];
    const int scc = sc >= 0 ? sc : 0;
#pragma unroll
    for (int i = 0; i < 32; ++i) { const int kk = 2 * i + (lane >> 5); tv[i] = W[(size_t)(k0 + kk) * Nsrc + scc]; }
#pragma unroll
    for (int i = 0; i < 32; ++i) { const int kk = 2 * i + (lane >> 5); float v = sc >= 0 ? tv[i] : 0.f; if (kscale) v *= kscale[k0 + kk]; scr[kk * 33 + (lane & 31)] = v; }
    LDS_WAIT(); asm volatile("" ::: "memory");
    const int c = lane & 7;
#pragma unroll
    for (int j = 0; j < 4; ++j) { const int n = (lane >> 3) + 8 * j; const LAS float* s = scr + (8 * c) * 33 + n;
        v4u o; o.x = pk2(s[0 * 33], s[1 * 33]); o.y = pk2(s[2 * 33], s[3 * 33]); o.z = pk2(s[4 * 33], s[5 * 33]); o.w = pk2(s[6 * 33], s[7 * 33]);
        *(GAS v4u*)(WT + (size_t)(n0 + n) * K + k0 + 8 * c) = o; }
    LDS_WAIT(); asm volatile("" ::: "memory");
}
template <class Map>
__device__ __forceinline__ void tr_item8(const float* W, int Nsrc, int K, const float* kscale, float wscale, unsigned char* WT8, LAS float* scr, int item, int nblk, int lane, Map map) {
    const int kb = item / nblk, nb = item % nblk, k0 = 64 * kb, n0 = 32 * nb;
    const int sc = map(n0 + (lane & 31));
    float tv[32];
    const int scc = sc >= 0 ? sc : 0;
#pragma unroll
    for (int i = 0; i < 32; ++i) { const int kk = 2 * i + (lane >> 5); tv[i] = W[(size_t)(k0 + kk) * Nsrc + scc]; }
#pragma unroll
    for (int i = 0; i < 32; ++i) { const int kk = 2 * i + (lane >> 5); float v = sc >= 0 ? tv[i] * wscale : 0.f; if (kscale) v *= kscale[k0 + kk]; scr[kk * 33 + (lane & 31)] = v; }
    LDS_WAIT(); asm volatile("" ::: "memory");
    const int c = lane & 7;
#pragma unroll
    for (int j = 0; j < 4; ++j) { const int n = (lane >> 3) + 8 * j; const LAS float* s = scr + (8 * c) * 33 + n;
        u32x2 o; o.x = (unsigned)__builtin_amdgcn_cvt_pk_fp8_f32(s[2 * 33], s[3 * 33], __builtin_amdgcn_cvt_pk_fp8_f32(s[0 * 33], s[1 * 33], 0, false), true);
        o.y = (unsigned)__builtin_amdgcn_cvt_pk_fp8_f32(s[6 * 33], s[7 * 33], __builtin_amdgcn_cvt_pk_fp8_f32(s[4 * 33], s[5 * 33], 0, false), true);
        *(GAS u32x2*)(WT8 + (size_t)(n0 + n) * K + k0 + 8 * c) = o; }
    LDS_WAIT(); asm volatile("" ::: "memory");
}
__device__ __forceinline__ int rope_src(int jj) { return (jj & 1) * 32 + (jj >> 1); }
struct MapW1 { __device__ int operator()(int n) const {
    if (n < 1024) return OFF_DQ + (n & ~63) + rope_src(n & 63);
    if (n < 2048) { const int j = n - 1024; return OFF_DK + (j & ~63) + rope_src(j & 63); }
    return OFF_DV + (n - 2048); } };
struct MapGate { __device__ int operator()(int n) const {
    if (n < 4096) return OFF_GATE + n;
    if (n < 5376) return n - 4096;
    if (n < 5440) return OFF_KR + rope_src(n - 5376);
    return -1; } };
struct MapUQ { __device__ int operator()(int n) const {
    if (n < 1024) return (n >> 7) * 192 + (n & 127);
    const int j = n - 1024; return (j >> 6) * 192 + 128 + rope_src(j & 63); } };
struct MapUKV { __device__ int operator()(int n) const {
    if (n < 1024) return (n >> 7) * 256 + (n & 127);
    const int j = n - 1024; return (j >> 7) * 256 + 128 + (j & 127); } };
struct MapId { __device__ int operator()(int n) const { return n; } };

struct Ins { const float *x, *w_in, *b_gate, *g_norm1, *g_cq, *w_uq, *g_ckv, *w_ukv, *w_o_mla, *lambda_qk, *g_subln, *w_o_diff, *w_out, *g_norm2, *w_q_peer, *sub_keys, *expert_u, *expert_v, *g_final; };

__device__ __forceinline__ void p0_prologue(Frame& F, const Ins& I, const double* inv_freq) {
    LAS float* scr = (LAS float*)(F.lds + RING_OFF + F.wave * 16384);
    const int gw = F.vcu * NWAVES + F.wave, NGW = F.G * NWAVES;
    unsigned char* ws = F.ws;
    constexpr int I_W1 = (2048 / 64) * (N1 / 32), I_W8 = (2048 / 64) * (NG / 32), I_UQ = (768 / 64) * (1536 / 32), I_UKV = (512 / 64) * (2048 / 32), I_OM = (1024 / 64) * (2048 / 32), I_OD = I_OM, I_OUT = (2048 / 64) * (2048 / 32), I_QP = I_OUT;
    constexpr int NITEMS = I_W1 + I_W8 + I_UQ + I_UKV + I_OM + I_OD + I_OUT + I_QP;
    for (int it = gw; it < NITEMS; it += NGW) {
        int r = it;
        if (r < I_W1) { tr_item(I.w_in, IN_COLS, 2048, nullptr, (bf16*)(ws + WS_W1), scr, r, N1 / 32, F.lane, MapW1()); continue; } r -= I_W1;
        if (r < I_W8) { tr_item8(I.w_in, IN_COLS, 2048, nullptr, W1_SCALE, ws + WS_W8, scr, r, NG / 32, F.lane, MapGate()); continue; } r -= I_W8;
        if (r < I_UQ) { tr_item8(I.w_uq, 1536, 768, I.g_cq, W1_SCALE, ws + WS_WUQ, scr, r, 1536 / 32, F.lane, MapUQ()); continue; } r -= I_UQ;
        if (r < I_UKV) { tr_item8(I.w_ukv, 2048, 512, I.g_ckv, W1_SCALE, ws + WS_WUKV, scr, r, 2048 / 32, F.lane, MapUKV()); continue; } r -= I_UKV;
        if (r < I_OM) { tr_item(I.w_o_mla, 2048, 1024, nullptr, (bf16*)(ws + WS_WOM), scr, r, 2048 / 32, F.lane, MapId()); continue; } r -= I_OM;
        if (r < I_OD) { tr_item(I.w_o_diff, 2048, 1024, nullptr, (bf16*)(ws + WS_WOD), scr, r, 2048 / 32, F.lane, MapId()); continue; } r -= I_OD;
        if (r < I_OUT) { tr_item(I.w_out, 2048, 2048, nullptr, (bf16*)(ws + WS_WOUT), scr, r, 2048 / 32, F.lane, MapId()); continue; } r -= I_OUT;
        tr_item(I.w_q_peer, 2048, 2048, I.g_norm2, (bf16*)(ws + WS_WQP), scr, r, 2048 / 32, F.lane, MapId());
    }
    {
        bf16* skb = (bf16*)(ws + WS_SKB);
        for (int e = gw * 64 + F.lane; e < 256 * 256; e += NGW * 64) {
            const int n = e >> 8, k = e & 255; float v = 0.f;
            if (n < 128 && k < 128) v = I.sub_keys[n * 128 + k];
            else if (n >= 128 && k >= 128) v = I.sub_keys[128 * 128 + (n - 128) * 128 + (k - 128)];
            skb[e] = (bf16)(pk2(v, 0.f) & 0xffffu);
        }
    }
    {
        float* rope = (float*)(ws + WS_ROPE);
        for (int e = gw * 64 + F.lane; e < SEQ * 32; e += NGW * 64) {
            const int pos = e >> 5, i = e & 31;
            const double rev = (double)pos * inv_freq[i] * 0.15915494309189535;
            const float fr = (float)(rev - floor(rev));
            rope[2 * e] = __builtin_amdgcn_cosf(fr); rope[2 * e + 1] = __builtin_amdgcn_sinf(fr);
        }
    }
    if (blockIdx.x == 0 && F.tid == 0) {
        float a = 0.f, b = 0.f;
        for (int d = 0; d < 64; ++d) { a += I.lambda_qk[d] * I.lambda_qk[64 + d]; b += I.lambda_qk[128 + d] * I.lambda_qk[192 + d]; }
        const float lam = __expf(a) - __expf(b) + LAMBDA_INIT;
        ((float*)F.ctl)[CW_LAMBDA] = lam;
    }
    {
        bf16* H = (bf16*)(ws + WS_H);
        f32x4 g[8];
#pragma unroll
        for (int j = 0; j < 8; ++j) g[j] = *((const f32x4*)I.g_norm1 + F.lane + 64 * j);
        for (int m = gw; m < T; m += NGW) {
            const GAS f32x4* xr = (const GAS f32x4*)(I.x + (size_t)m * D_MODEL) + F.lane;
            f32x4 v[8]; float s = 0.f;
#pragma unroll
            for (int j = 0; j < 8; ++j) { v[j] = xr[64 * j]; s += (v[j].x * v[j].x + v[j].y * v[j].y) + (v[j].z * v[j].z + v[j].w * v[j].w); }
            const float rstd = 1.0f / sqrtf(wave_sum(s) * (1.f / D_MODEL) + EPS);
            GAS u32x2* o8 = (GAS u32x2*)(H + (size_t)m * D_MODEL) + F.lane;
#pragma unroll
            for (int j = 0; j < 8; ++j) { u32x2 w; w.x = pk2(v[j].x * rstd * g[j].x, v[j].y * rstd * g[j].y); w.y = pk2(v[j].z * rstd * g[j].z, v[j].w * rstd * g[j].w); o8[64 * j] = w; }
            { GAS unsigned* h8 = (GAS unsigned*)(ws + WS_H8 + (size_t)m * D_MODEL) + F.lane;
#pragma unroll
              for (int j = 0; j < 8; ++j) h8[64 * j] = (unsigned)__builtin_amdgcn_cvt_pk_fp8_f32(v[j].z * rstd * g[j].z, v[j].w * rstd * g[j].w, __builtin_amdgcn_cvt_pk_fp8_f32(v[j].x * rstd * g[j].x, v[j].y * rstd * g[j].y, 0, false), true); }
        }
    }
}

__device__ __forceinline__ void convert_experts(Frame& F, const Ins& I) {
    const size_t gt = (size_t)(F.vcu * NWAVES * 64) + F.tid, NT = (size_t)F.G * NWAVES * 64;
    const size_t nchunk = (size_t)NEXP * D_MODEL / 8;
    bf16* EU = (bf16*)(F.ws + WS_EU); bf16* EV = (bf16*)(F.ws + WS_EV);
    for (size_t c = gt; c < nchunk; c += NT) {
        const int d = (int)((c * 8) & (D_MODEL - 1));
        const f32x4 a0 = *(const GAS f32x4*)(I.expert_u + c * 8), a1 = *(const GAS f32x4*)(I.expert_u + c * 8 + 4);
        const f32x4 g0 = *(const f32x4*)(I.g_norm2 + d), g1 = *(const f32x4*)(I.g_norm2 + d + 4);
        v4u o; o.x = pk2(a0.x * g0.x, a0.y * g0.y); o.y = pk2(a0.z * g0.z, a0.w * g0.w); o.z = pk2(a1.x * g1.x, a1.y * g1.y); o.w = pk2(a1.z * g1.z, a1.w * g1.w);
        *(GAS v4u*)(EU + c * 8) = o;
        const f32x4 b0 = *(const GAS f32x4*)(I.expert_v + c * 8), b1 = *(const GAS f32x4*)(I.expert_v + c * 8 + 4);
        v4u p; p.x = pk2(b0.x, b0.y); p.y = pk2(b0.z, b0.w); p.z = pk2(b1.x, b1.y); p.w = pk2(b1.z, b1.w);
        *(GAS v4u*)(EV + c * 8) = p;
    }
}

__device__ __forceinline__ float sigmoidf_fast(float x) { return __builtin_amdgcn_rcpf(1.0f + __builtin_amdgcn_exp2f(-x * LOG2E)); }
__device__ __forceinline__ void rope8(f32x4& v0, f32x4& v1, const f32x4 cs0, const f32x4 cs1, float sc) {
    const float a0 = v0[0] * cs0[0] - v0[1] * cs0[1], b0 = v0[1] * cs0[0] + v0[0] * cs0[1];
    const float a1 = v0[2] * cs0[2] - v0[3] * cs0[3], b1 = v0[3] * cs0[2] + v0[2] * cs0[3];
    const float a2 = v1[0] * cs1[0] - v1[1] * cs1[1], b2 = v1[1] * cs1[0] + v1[0] * cs1[1];
    const float a3 = v1[2] * cs1[2] - v1[3] * cs1[3], b3 = v1[3] * cs1[2] + v1[2] * cs1[3];
    v0 = (f32x4){a0 * sc, b0 * sc, a1 * sc, b1 * sc}; v1 = (f32x4){a2 * sc, b2 * sc, a3 * sc, b3 * sc};
}
__device__ __forceinline__ u32x4 pack8(const f32x4 v0, const f32x4 v1) { u32x4 w; w.x = cvtpk(v0[0], v0[1]); w.y = cvtpk(v0[2], v0[3]); w.z = cvtpk(v1[0], v1[1]); w.w = cvtpk(v1[2], v1[3]); return w; }

__device__ __forceinline__ size_t kt_off(size_t row, int col) { const size_t b = row >> 13; const int pos = (int)(row & 8191), tile = pos >> 6, key = pos & 63, h = col >> 7, piece = (col & 127) >> 3;
    return (((b * 8 + h) * 128 + tile) * 16 + piece) * 512 + key * 8 + (col & 7); }
__device__ __forceinline__ size_t vt_off(size_t row, int col) { const size_t b = row >> 13; const int pos = (int)(row & 8191), tile = pos >> 6, key = pos & 63, h = col >> 7, d = col & 127;
    return (((b * 8 + h) * 128 + tile) * 16 + (d >> 5) * 4 + (key >> 4)) * 512 + (key & 15) * 32 + (d & 31); }
__device__ __forceinline__ size_t krt_off(size_t row, int col) { const size_t b = row >> 13; const int pos = (int)(row & 8191), tile = pos >> 6, key = pos & 63;
    return ((b * 128 + tile) * 8 + (col >> 3)) * 512 + key * 8 + (col & 7); }
__device__ __forceinline__ size_t k8_off(size_t row, int col) { const size_t b = row >> 13; const int pos = (int)(row & 8191), tile = pos >> 6, key = pos & 63, h = col >> 7, d = col & 127;
    return (((b * 8 + h) * 128 + tile) * 4 + (d >> 5)) * 2048 + key * 32 + (d & 31); }
__device__ __forceinline__ size_t kr8_off(size_t row, int c) { const size_t b = row >> 13; const int pos = (int)(row & 8191), tile = pos >> 6, key = pos & 63;
    return ((b * 128 + tile) * 2 + (c >> 5)) * 2048 + key * 32 + (c & 31); }
constexpr float MLA_QSCALE = 8.0f;
__device__ __forceinline__ u32x2 pack8_fp8(const f32x4 v0, const f32x4 v1) { u32x2 w; w.x = (unsigned)__builtin_amdgcn_cvt_pk_fp8_f32(v0[2], v0[3], __builtin_amdgcn_cvt_pk_fp8_f32(v0[0], v0[1], 0, false), true);
    w.y = (unsigned)__builtin_amdgcn_cvt_pk_fp8_f32(v1[2], v1[3], __builtin_amdgcn_cvt_pk_fp8_f32(v1[0], v1[1], 0, false), true); return w; }
template <int kind> struct EpiProj {
    static constexpr bool PERM = true;
    bf16_t *CQ, *CKV, *DQ, *DK, *DV, *G, *KR; float *ssq_q, *ssq_kv; const float* bgate; const float* rope;
    __device__ __forceinline__ void operator()(const f32x4 (&acc)[2][2][4][2], const pg8::Unit& u, int wr, int wc, int fr, int fq) const {
        const int row0 = u.pm * 256 + wr * 64 + fr, pn = kind == 0 ? 5 + u.pn : (u.pn < 16 ? 18 + u.pn : (u.pn < 21 ? u.pn - 16 : 17)), colw = wc * 32 + 8 * fq;
        if (kind == 1 && pn < 5) {
            unsigned char* O; int ldc, ct, nsl, sl; float* ssq;
            if (pn < 3) { O = (unsigned char*)CQ; ldc = 768; ct = pn * 256; ssq = ssq_q; nsl = 12; sl = pn * 4 + wc; } else { O = (unsigned char*)CKV; ldc = 512; ct = (pn - 3) * 256; ssq = ssq_kv; nsl = 8; sl = (pn - 3) * 4 + wc; }
#pragma unroll
            for (int ai = 0; ai < 2; ++ai)
#pragma unroll
                for (int m = 0; m < 4; ++m) { const int row = row0 + ai * 128 + m * 16; float s = 0.f;
#pragma unroll
                    for (int bj = 0; bj < 2; ++bj) { const f32x4 v0 = acc[ai][bj][m][0], v1 = acc[ai][bj][m][1];
                        s += (v0[0] * v0[0] + v0[1] * v0[1]) + (v0[2] * v0[2] + v0[3] * v0[3]) + (v1[0] * v1[0] + v1[1] * v1[1]) + (v1[2] * v1[2] + v1[3] * v1[3]);
                        u32x2 w8; w8.x = (unsigned)__builtin_amdgcn_cvt_pk_fp8_f32(v0[2], v0[3], __builtin_amdgcn_cvt_pk_fp8_f32(v0[0], v0[1], 0, false), true); w8.y = (unsigned)__builtin_amdgcn_cvt_pk_fp8_f32(v1[2], v1[3], __builtin_amdgcn_cvt_pk_fp8_f32(v1[0], v1[1], 0, false), true);
                        *(u32x2*)(O + (size_t)row * ldc + ct + bj * 128 + colw) = w8; }
                    s += __shfl_xor(s, 16); s += __shfl_xor(s, 32);
                    if (fq == 0) ssq[(size_t)row * nsl + sl] = s; }
        } else if (kind == 0 && pn < 13) {
            const bool isq = pn < 9; bf16_t* O = isq ? DQ : DK; const int ct = (pn - (isq ? 5 : 9)) * 256; const float sc = isq ? C2_DIFF : 1.0f;
            const int i0 = ((wc & 1) * 32 + 8 * fq) >> 1;
#pragma unroll
            for (int ai = 0; ai < 2; ++ai) {
                f32x4 cs[4][2];
#pragma unroll
                for (int m = 0; m < 4; ++m) { const int pos = (row0 + ai * 128 + m * 16) & (SEQ - 1);
                    cs[m][0] = *(const f32x4*)(rope + (size_t)(pos * 32 + i0) * 2); cs[m][1] = *(const f32x4*)(rope + (size_t)(pos * 32 + i0 + 2) * 2); }
#pragma unroll
                for (int m = 0; m < 4; ++m) { const int row = row0 + ai * 128 + m * 16;
#pragma unroll
                    for (int bj = 0; bj < 2; ++bj) { f32x4 v0 = acc[ai][bj][m][0], v1 = acc[ai][bj][m][1]; rope8(v0, v1, cs[m][0], cs[m][1], sc);
                        const int col = ct + bj * 128 + colw;
                        *(u32x4*)(O + (isq ? (size_t)row * 1024 + col : kt_off(row, col))) = pack8(v0, v1); } } }
        } else if (kind == 0) {
            const int ct = (pn - 13) * 256;
#pragma unroll
            for (int ai = 0; ai < 2; ++ai)
#pragma unroll
                for (int m = 0; m < 4; ++m) { const int row = row0 + ai * 128 + m * 16;
#pragma unroll
                    for (int bj = 0; bj < 2; ++bj) *(u32x4*)(DV + vt_off(row, ct + bj * 128 + colw)) = pack8(acc[ai][bj][m][0], acc[ai][bj][m][1]); }
        } else if (kind == 1 && pn >= 18) {
            const int ct = (pn - 18) * 256;
            f32x4 bv[2][2];
#pragma unroll
            for (int bj = 0; bj < 2; ++bj) { bv[bj][0] = *(const f32x4*)(bgate + ct + bj * 128 + colw); bv[bj][1] = *(const f32x4*)(bgate + ct + bj * 128 + colw + 4); }
#pragma unroll
            for (int ai = 0; ai < 2; ++ai)
#pragma unroll
                for (int m = 0; m < 4; ++m) { const int row = row0 + ai * 128 + m * 16;
#pragma unroll
                    for (int bj = 0; bj < 2; ++bj) { f32x4 v0 = acc[ai][bj][m][0] + bv[bj][0], v1 = acc[ai][bj][m][1] + bv[bj][1];
#pragma unroll
                        for (int e = 0; e < 4; ++e) { v0[e] = sigmoidf_fast(v0[e]); v1[e] = sigmoidf_fast(v1[e]); }
                        *(u32x4*)(G + (size_t)row * 4096 + ct + bj * 128 + colw) = pack8(v0, v1); } }
        } else if (kind == 1) {
            if (wc < 2) {
                const int i0 = colw >> 1;
#pragma unroll
                for (int ai = 0; ai < 2; ++ai) {
                    f32x4 cs[4][2];
#pragma unroll
                    for (int m = 0; m < 4; ++m) { const int pos = (row0 + ai * 128 + m * 16) & (SEQ - 1);
                        cs[m][0] = *(const f32x4*)(rope + (size_t)(pos * 32 + i0) * 2); cs[m][1] = *(const f32x4*)(rope + (size_t)(pos * 32 + i0 + 2) * 2); }
#pragma unroll
                    for (int m = 0; m < 4; ++m) { const int row = row0 + ai * 128 + m * 16;
                        f32x4 v0 = acc[ai][0][m][0], v1 = acc[ai][0][m][1]; rope8(v0, v1, cs[m][0], cs[m][1], 1.0f);
                        *(u32x2*)((unsigned char*)KR + kr8_off(row, colw)) = pack8_fp8(v0, v1); } }
            }
        }
    }
};

struct EpiQup {
    static constexpr bool PERM = true;
    bf16_t *QN, *QR; const float* ssq; const float* rope;
    __device__ __forceinline__ void operator()(const f32x4 (&acc)[2][2][4][2], const pg8::Unit& u, int wr, int wc, int fr, int fq) const {
        const int row0 = u.pm * 256 + wr * 64 + fr, pn = u.pn, colw = wc * 32 + 8 * fq;
        const int i0 = ((wc & 1) * 32 + 8 * fq) >> 1;
#pragma unroll
        for (int ai = 0; ai < 2; ++ai) {
            float sc[4]; f32x4 cs[4][2];
#pragma unroll
            for (int m = 0; m < 4; ++m) { const int row = row0 + ai * 128 + m * 16; const int pos = row & (SEQ - 1);
                const f32x4 q0 = *(const f32x4*)(ssq + (size_t)row * 12), q1 = *(const f32x4*)(ssq + (size_t)row * 12 + 4), q2 = *(const f32x4*)(ssq + (size_t)row * 12 + 8);
                if (pn >= 4) { cs[m][0] = *(const f32x4*)(rope + (size_t)(pos * 32 + i0) * 2); cs[m][1] = *(const f32x4*)(rope + (size_t)(pos * 32 + i0 + 2) * 2); }
                const float sq = (((q0[0] + q0[1]) + (q0[2] + q0[3])) + ((q1[0] + q1[1]) + (q1[2] + q1[3]))) + ((q2[0] + q2[1]) + (q2[2] + q2[3]));
                sc[m] = (C2_MLA * MLA_QSCALE) / sqrtf(sq * (1.0f / 768.0f) + EPS); }
            if (pn < 4) {
#pragma unroll
                for (int m = 0; m < 4; ++m) { const int row = row0 + ai * 128 + m * 16;
#pragma unroll
                    for (int bj = 0; bj < 2; ++bj) *(u32x2*)((unsigned char*)QN + (size_t)row * 1024 + pn * 256 + bj * 128 + colw) = pack8_fp8(acc[ai][bj][m][0] * sc[m], acc[ai][bj][m][1] * sc[m]); }
            } else {
#pragma unroll
                for (int m = 0; m < 4; ++m) { const int row = row0 + ai * 128 + m * 16;
#pragma unroll
                    for (int bj = 0; bj < 2; ++bj) { f32x4 v0 = acc[ai][bj][m][0], v1 = acc[ai][bj][m][1]; rope8(v0, v1, cs[m][0], cs[m][1], sc[m]);
                        *(u32x2*)((unsigned char*)QR + (size_t)row * 512 + (pn - 4) * 256 + bj * 128 + colw) = pack8_fp8(v0, v1); } }
            }
        }
    }
};
struct EpiKVup {
    static constexpr bool PERM = true;
    bf16_t *KN, *V; const float* ssq;
    __device__ __forceinline__ void operator()(const f32x4 (&acc)[2][2][4][2], const pg8::Unit& u, int wr, int wc, int fr, int fq) const {
        const int row0 = u.pm * 256 + wr * 64 + fr, pn = u.pn, colw = wc * 32 + 8 * fq;
        bf16_t* O = pn < 4 ? KN : V; const int ct = (pn & 3) * 256;
#pragma unroll
        for (int ai = 0; ai < 2; ++ai) {
            float scv[4];
#pragma unroll
            for (int m = 0; m < 4; ++m) { const int row = row0 + ai * 128 + m * 16;
                const f32x4 q0 = *(const f32x4*)(ssq + (size_t)row * 8), q1 = *(const f32x4*)(ssq + (size_t)row * 8 + 4);
                const float sq = ((q0[0] + q0[1]) + (q0[2] + q0[3])) + ((q1[0] + q1[1]) + (q1[2] + q1[3]));
                scv[m] = 1.0f / sqrtf(sq * (1.0f / 512.0f) + EPS); }
#pragma unroll
            for (int m = 0; m < 4; ++m) { const int row = row0 + ai * 128 + m * 16; const float sc = scv[m];
#pragma unroll
                for (int bj = 0; bj < 2; ++bj) { const int col = ct + bj * 128 + colw;
                    if (pn < 4) *(u32x2*)((unsigned char*)KN + k8_off(row, col)) = pack8_fp8(acc[ai][bj][m][0] * sc, acc[ai][bj][m][1] * sc);
                    else *(u32x4*)(V + vt_off(row, col)) = pack8(acc[ai][bj][m][0] * sc, acc[ai][bj][m][1] * sc); } } }
    }
};
struct EpiGate {
    static constexpr bool PERM = true;
    const bf16_t* G; bf16_t* TMP; bf16_t* MG; int second;
    __device__ __forceinline__ void operator()(const f32x4 (&acc)[2][2][4][2], const pg8::Unit& u, int wr, int wc, int fr, int fq) const {
        const int row0 = u.pm * 256 + wr * 64 + fr, colw = u.pn * 256 + wc * 32 + 8 * fq;
#pragma unroll
        for (int ai = 0; ai < 2; ++ai)
#pragma unroll
            for (int m = 0; m < 4; ++m) { const int row = row0 + ai * 128 + m * 16;
#pragma unroll
                for (int bj = 0; bj < 2; ++bj) { const int col = colw + bj * 128;
                    const u32x4 gw = *(const u32x4*)(G + (size_t)row * 4096 + (second ? 2048 : 0) + col);
                    f32x4 v0 = acc[ai][bj][m][0], v1 = acc[ai][bj][m][1];
                    v0 = (f32x4){v0[0] * bflo(gw.x), v0[1] * bfhi(gw.x), v0[2] * bflo(gw.y), v0[3] * bfhi(gw.y)};
                    v1 = (f32x4){v1[0] * bflo(gw.z), v1[1] * bfhi(gw.z), v1[2] * bflo(gw.w), v1[3] * bfhi(gw.w)};
                    if (second) { const u32x4 tw = *(const u32x4*)(TMP + (size_t)row * 2048 + col);
                        v0 += (f32x4){bflo(tw.x), bfhi(tw.x), bflo(tw.y), bfhi(tw.y)}; v1 += (f32x4){bflo(tw.z), bfhi(tw.z), bflo(tw.w), bfhi(tw.w)};
                        *(u32x4*)(MG + (size_t)row * 2048 + col) = pack8(v0, v1);
                    } else *(u32x4*)(TMP + (size_t)row * 2048 + col) = pack8(v0, v1); } }
    }
};
struct EpiGate2 {
    static constexpr bool PERM = true;
    const bf16_t* G; bf16_t* MG;
    __device__ __forceinline__ void mid(f32x4 (&acc)[2][2][4][2], const pg8::Unit& u, int wr, int wc, int fr, int fq) const {
        const int row0 = u.pm * 256 + wr * 64 + fr, colw = u.pn * 256 + wc * 32 + 8 * fq;
#pragma unroll
        for (int ai = 0; ai < 2; ++ai) {
            u32x4 ga[4][2], gb[4][2];
#pragma unroll
            for (int m = 0; m < 4; ++m)
#pragma unroll
                for (int bj = 0; bj < 2; ++bj) { const size_t o = (size_t)(row0 + ai * 128 + m * 16) * 4096 + colw + bj * 128; ga[m][bj] = *(const u32x4*)(G + o); gb[m][bj] = *(const u32x4*)(G + o + 2048); }
#pragma unroll
            for (int m = 0; m < 4; ++m)
#pragma unroll
                for (int bj = 0; bj < 2; ++bj) { const u32x4 a = ga[m][bj], b = gb[m][bj];
                    f32x4 r0, r1;
                    r0[0] = bflo(a.x) * __builtin_amdgcn_rcpf(bflo(b.x)); r0[1] = bfhi(a.x) * __builtin_amdgcn_rcpf(bfhi(b.x)); r0[2] = bflo(a.y) * __builtin_amdgcn_rcpf(bflo(b.y)); r0[3] = bfhi(a.y) * __builtin_amdgcn_rcpf(bfhi(b.y));
                    r1[0] = bflo(a.z) * __builtin_amdgcn_rcpf(bflo(b.z)); r1[1] = bfhi(a.z) * __builtin_amdgcn_rcpf(bfhi(b.z)); r1[2] = bflo(a.w) * __builtin_amdgcn_rcpf(bflo(b.w)); r1[3] = bfhi(a.w) * __builtin_amdgcn_rcpf(bfhi(b.w));
                    acc[ai][bj][m][0] *= r0; acc[ai][bj][m][1] *= r1; }
            asm volatile("" ::: "memory"); }
    }
    __device__ __forceinline__ void operator()(const f32x4 (&acc)[2][2][4][2], const pg8::Unit& u, int wr, int wc, int fr, int fq) const {
        const int row0 = u.pm * 256 + wr * 64 + fr, colw = u.pn * 256 + wc * 32 + 8 * fq;
        u32x4 gbv[2][4][2];
#pragma unroll
        for (int ai = 0; ai < 2; ++ai)
#pragma unroll
            for (int m = 0; m < 4; ++m)
#pragma unroll
                for (int bj = 0; bj < 2; ++bj) gbv[ai][m][bj] = *(const u32x4*)(G + (size_t)(row0 + ai * 128 + m * 16) * 4096 + 2048 + colw + bj * 128);
#pragma unroll
        for (int ai = 0; ai < 2; ++ai)
#pragma unroll
            for (int m = 0; m < 4; ++m) { const int row = row0 + ai * 128 + m * 16;
#pragma unroll
                for (int bj = 0; bj < 2; ++bj) { const int col = colw + bj * 128;
                    const u32x4 gb = gbv[ai][m][bj];
                    f32x4 v0 = acc[ai][bj][m][0], v1 = acc[ai][bj][m][1];
                    v0 = (f32x4){v0[0] * bflo(gb.x), v0[1] * bfhi(gb.x), v0[2] * bflo(gb.y), v0[3] * bfhi(gb.y)};
                    v1 = (f32x4){v1[0] * bflo(gb.z), v1[1] * bfhi(gb.z), v1[2] * bflo(gb.w), v1[3] * bfhi(gb.w)};
                    *(u32x4*)(MG + (size_t)row * 2048 + col) = pack8(v0, v1); } }
    }
};
struct EpiRes {
    static constexpr bool PERM = false;
    const float* x; float* X2; bf16_t* X2B; float* ssq;
    __device__ __forceinline__ void operator()(const f32x4 (&acc)[2][2][4][2], const pg8::Unit& u, int wr, int wc, int fr, int fq) const {
        const int row0 = u.pm * 256 + wr * 64 + fr, col0 = u.pn * 256 + wc * 32 + 4 * fq;
#pragma unroll
        for (int ai = 0; ai < 2; ++ai) {
            f32x4 xv[4][2][2];
#pragma unroll
            for (int m = 0; m < 4; ++m)
#pragma unroll
                for (int bj = 0; bj < 2; ++bj)
#pragma unroll
                    for (int n = 0; n < 2; ++n) xv[m][bj][n] = *(const f32x4*)(x + (size_t)(row0 + ai * 128 + m * 16) * 2048 + col0 + bj * 128 + n * 16);
#pragma unroll
            for (int m = 0; m < 4; ++m) { const int row = row0 + ai * 128 + m * 16; float s = 0.f;
#pragma unroll
                for (int bj = 0; bj < 2; ++bj)
#pragma unroll
                    for (int n = 0; n < 2; ++n) { const size_t off = (size_t)row * 2048 + col0 + bj * 128 + n * 16;
                        const f32x4 v = acc[ai][bj][m][n] + xv[m][bj][n];
                        s += (v[0] * v[0] + v[1] * v[1]) + (v[2] * v[2] + v[3] * v[3]);
#ifdef PEER_BF16
                        *(f32x4*)(X2 + off) = v;
#endif
                        u32x2 w; w.x = cvtpk(v[0], v[1]); w.y = cvtpk(v[2], v[3]); *(u32x2*)(X2B + off) = w; }
                s += __shfl_xor(s, 16); s += __shfl_xor(s, 32);
                if (fq == 0) ssq[(size_t)row * 32 + u.pn * 4 + wc] = s; } }
    }
};
__device__ __forceinline__ float sum32(const float* p) { float t = 0.f;
#pragma unroll
    for (int i = 0; i < 8; ++i) { const f32x4 q = *(const f32x4*)(p + 4 * i); t += (q[0] + q[1]) + (q[2] + q[3]); } return t; }
constexpr int RTAB_OFF = 132096, RTAB_SLOTS = 4;
struct EpiQP {
    static constexpr bool PERM = true;
    bf16_t* QP; const float* ssq; const LAS float* tab; int pms[RTAB_SLOTS];
    __device__ __forceinline__ void operator()(const f32x4 (&acc)[2][2][4][2], const pg8::Unit& u, int wr, int wc, int fr, int fq) const {
        const int row0 = u.pm * 256 + wr * 64 + fr, colw = u.pn * 256 + wc * 32 + 8 * fq;
        int slot = -1;
#pragma unroll
        for (int i = RTAB_SLOTS - 1; i >= 0; --i) if (pms[i] == u.pm) slot = i;
        const bool have = __builtin_amdgcn_readfirstlane(slot) >= 0;
#pragma unroll
        for (int ai = 0; ai < 2; ++ai) {
            float scv[4];
            if (have) {
#pragma unroll
                for (int m = 0; m < 4; ++m) scv[m] = tab[slot * 256 + wr * 64 + fr + ai * 128 + m * 16];
            } else {
#pragma unroll
                for (int m = 0; m < 4; ++m) { scv[m] = 1.0f / sqrtf(sum32(ssq + (size_t)(row0 + ai * 128 + m * 16) * 32) * (1.0f / 2048.0f) + EPS); asm volatile("" ::: "memory"); }
            }
#pragma unroll
            for (int m = 0; m < 4; ++m) { const int row = row0 + ai * 128 + m * 16; const float sc = scv[m];
#pragma unroll
                for (int bj = 0; bj < 2; ++bj) *(u32x4*)(QP + (size_t)row * 2048 + colw + bj * 128) = pack8(acc[ai][bj][m][0] * sc, acc[ai][bj][m][1] * sc); }
        }
    }
};

template <class QF, class KF, class VF>
__device__ __forceinline__ void naive_attn(LAS float* qs, QF q_f, int dt, KF k_f, VF v_f, float sscale,
                                           size_t rowbase, int p0, int lane, float (&o)[4][2], float (&linv)[4]) {
    for (int idx = lane; idx < 4 * dt; idx += 64) { const int r = idx / dt, d = idx - r * dt; qs[r * 192 + d] = q_f(rowbase + p0 + r, d); }
    LDS_WAIT(); asm volatile("" ::: "memory");
    float m[4], l[4];
#pragma unroll
    for (int r = 0; r < 4; ++r) { m[r] = -INFINITY; l[r] = 0.f; o[r][0] = 0.f; o[r][1] = 0.f; }
    const int pmax = p0 + 3, ntile = pmax / 64 + 1;
#pragma unroll 1
    for (int kt = 0; kt < ntile; ++kt) {
        const int key = kt * 64 + lane, kc = key < pmax ? key : pmax;
        float s[4] = {0.f, 0.f, 0.f, 0.f};
#pragma unroll 2
        for (int d = 0; d < dt; d += 8) { float k[8]; k_f(rowbase + kc, d, k);
#pragma unroll
            for (int r = 0; r < 4; ++r) { const f32x4 qa4 = *(const LAS f32x4*)(qs + r * 192 + d), qb4 = *(const LAS f32x4*)(qs + r * 192 + d + 4);
                s[r] += (qa4[0] * k[0] + qa4[1] * k[1]) + (qa4[2] * k[2] + qa4[3] * k[3]) + (qb4[0] * k[4] + qb4[1] * k[5]) + (qb4[2] * k[6] + qb4[3] * k[7]); } }
        float p[4];
#pragma unroll
        for (int r = 0; r < 4; ++r) {
            const float sv = key > p0 + r ? -INFINITY : s[r] * sscale;
            const float mn = fmaxf(m[r], wave_max(sv));
            const float al = __builtin_amdgcn_exp2f(m[r] - mn);
            p[r] = __builtin_amdgcn_exp2f(sv - mn);
            l[r] = l[r] * al + wave_sum(p[r]); o[r][0] *= al; o[r][1] *= al; m[r] = mn;
        }
        const int jn = (pmax - kt * 64) < 63 ? (pmax - kt * 64) : 63;
#pragma unroll 4
        for (int j = 0; j <= jn; ++j) {
            const float v0 = bf2f(v_f(rowbase + kt * 64 + j, lane)), v1 = bf2f(v_f(rowbase + kt * 64 + j, 64 + lane));
#pragma unroll
            for (int r = 0; r < 4; ++r) { const float pj = __builtin_bit_cast(float, __builtin_amdgcn_readlane(__builtin_bit_cast(int, p[r]), j)); o[r][0] += pj * v0; o[r][1] += pj * v1; }
        }
    }
#pragma unroll
    for (int r = 0; r < 4; ++r) linv[r] = 1.0f / l[r];
    LDS_WAIT(); asm volatile("" ::: "memory");
}
__device__ __forceinline__ float fp8_at(const unsigned char* p) { typedef float f2 __attribute__((ext_vector_type(2))); const f2 v = __builtin_amdgcn_cvt_pk_f32_fp8((int)*p, false); return v.x; }
__device__ __forceinline__ void fp8x8(const unsigned char* p, float (&k)[8]) { typedef float f2 __attribute__((ext_vector_type(2))); const u32x2 w = *(const u32x2*)p;
    const f2 a = __builtin_amdgcn_cvt_pk_f32_fp8((int)w.x, false), b = __builtin_amdgcn_cvt_pk_f32_fp8((int)w.x, true), c = __builtin_amdgcn_cvt_pk_f32_fp8((int)w.y, false), d = __builtin_amdgcn_cvt_pk_f32_fp8((int)w.y, true);
    k[0] = a.x; k[1] = a.y; k[2] = b.x; k[3] = b.y; k[4] = c.x; k[5] = c.y; k[6] = d.x; k[7] = d.y; }
__device__ __forceinline__ void bf16x8f(const bf16* p, float (&k)[8]) { const u32x4 kw = *(const u32x4*)p; k[0] = bflo(kw.x); k[1] = bfhi(kw.x); k[2] = bflo(kw.y); k[3] = bfhi(kw.y); k[4] = bflo(kw.z); k[5] = bfhi(kw.z); k[6] = bflo(kw.w); k[7] = bfhi(kw.w); }
__device__ __forceinline__ void p3_attention_ref(Frame& F, const Ins& I) {
    unsigned char* ws = F.ws;
    const bf16 *QN = (const bf16*)(ws + WS_QN), *QR = (const bf16*)(ws + WS_QR), *KN = (const bf16*)(ws + WS_KN), *KR = (const bf16*)(ws + WS_KR), *V = (const bf16*)(ws + WS_V);
    const bf16 *DQ = (const bf16*)(ws + WS_DQ), *DK = (const bf16*)(ws + WS_DK), *DV = (const bf16*)(ws + WS_DV);
    bf16 *OM = (bf16*)(ws + WS_OM), *OD = (bf16*)(ws + WS_OD);
    LAS float* qs = (LAS float*)(F.lds + RING_OFF + F.wave * 4096);
    const int gw = F.vcu * NWAVES + F.wave, NGW = F.G * NWAVES, lane = F.lane;
    const float lam = ((const float*)F.ctl)[CW_LAMBDA];
    const float gs0 = I.g_subln[lane] * (1.0f - LAMBDA_INIT), gs1 = I.g_subln[64 + lane] * (1.0f - LAMBDA_INIT);
    for (int it = gw; it < 2 * 16 * (SEQ / 4); it += NGW) {
        const int type = it & 1, rest = it >> 1, bh = rest & 15, g = rest >> 4, b = bh >> 3, h = bh & 7, p0 = 4 * g;
        const size_t rowbase = (size_t)b * SEQ;
        float o[4][2], li[4];
        if (type == 0) {
            {
                const unsigned char *QN8 = (const unsigned char*)QN, *QR8 = (const unsigned char*)QR, *KN8 = (const unsigned char*)KN, *KR8 = (const unsigned char*)KR;
                naive_attn(qs, [=](size_t row, int d) { return d < 128 ? fp8_at(QN8 + row * 1024 + h * 128 + d) : fp8_at(QR8 + row * 512 + h * 64 + (d - 128)); }, 192,
                           [=](size_t row, int d, float (&k)[8]) { if (d < 128) fp8x8(KN8 + k8_off(row, h * 128 + d), k); else fp8x8(KR8 + kr8_off(row, d - 128), k); },
                           [=](size_t row, int c) { return V[vt_off(row, h * 128 + c)]; }, 1.0f / MLA_QSCALE, rowbase, p0, lane, o, li); }
#pragma unroll
            for (int r = 0; r < 4; ++r) { bf16* orow = OM + (rowbase + p0 + r) * 1024 + h * 128;
#ifdef ATT_CHECK
                { const float a0 = bf2f(orow[lane]), a1 = bf2f(orow[64 + lane]), b0 = o[r][0] * li[r], b1 = o[r][1] * li[r];
                  if (fabsf(a0 - b0) > ATT_TOL_A + ATT_TOL_R * fabsf(b0) || fabsf(a1 - b1) > ATT_TOL_A + ATT_TOL_R * fabsf(b1) || !(a0 == a0) || !(a1 == a1)) atomicAdd((unsigned*)F.ctl + 16, 1u); }
#else
                orow[lane] = (bf16)(pk2(o[r][0] * li[r], 0.f) & 0xffffu); orow[64 + lane] = (bf16)(pk2(o[r][1] * li[r], 0.f) & 0xffffu);
#endif
            }
        } else {
            float o2[4][2], li2[4];
            naive_attn(qs, [=](size_t row, int d) { return bf2f(DQ[row * 1024 + (h * 2) * 64 + d]); }, 64, [=](size_t row, int d, float (&k)[8]) { bf16x8f(DK + kt_off(row, h * 128 + d), k); },
                       [=](size_t row, int c) { return DV[vt_off(row, h * 128 + c)]; }, 1.0f, rowbase, p0, lane, o, li);
            naive_attn(qs, [=](size_t row, int d) { return bf2f(DQ[row * 1024 + (h * 2 + 1) * 64 + d]); }, 64, [=](size_t row, int d, float (&k)[8]) { bf16x8f(DK + kt_off(row, h * 128 + 64 + d), k); },
                       [=](size_t row, int c) { return DV[vt_off(row, h * 128 + c)]; }, 1.0f, rowbase, p0, lane, o2, li2);
#pragma unroll
            for (int r = 0; r < 4; ++r) {
                const float d0 = o[r][0] * li[r] - lam * o2[r][0] * li2[r], d1 = o[r][1] * li[r] - lam * o2[r][1] * li2[r];
                const float rs = 1.0f / sqrtf(wave_sum(d0 * d0 + d1 * d1) * (1.0f / 128.0f) + EPS);
                bf16* orow = OD + (rowbase + p0 + r) * 1024 + h * 128;
#ifdef ATT_CHECK
                { const float a0 = bf2f(orow[lane]), a1 = bf2f(orow[64 + lane]), b0 = d0 * rs * gs0, b1 = d1 * rs * gs1;
                  if (fabsf(a0 - b0) > ATT_TOL_A + ATT_TOL_R * fabsf(b0) || fabsf(a1 - b1) > ATT_TOL_A + ATT_TOL_R * fabsf(b1) || !(a0 == a0) || !(a1 == a1)) atomicAdd((unsigned*)F.ctl + 17, 1u); }
#else
                orow[lane] = (bf16)(pk2(d0 * rs * gs0, 0.f) & 0xffffu); orow[64 + lane] = (bf16)(pk2(d1 * rs * gs1, 0.f) & 0xffffu);
#endif
            }
        }
    }
}

namespace att {
typedef short bf16x8 __attribute__((ext_vector_type(8)));
typedef short s16x4 __attribute__((ext_vector_type(4)));
typedef float f32x16 __attribute__((ext_vector_type(16)));
typedef short v4i16_t __attribute__((ext_vector_type(4)));
#ifndef ATT_PF2
#define ATT_PF2 1
#endif
constexpr int BUFB = 40960, WSF_OFF = (ATT_PF2 ? 3 : 2) * BUFB;
#ifndef ATT_KD
#define ATT_KD 2
#endif
#ifndef ATT_THR
#define ATT_THR 8.0f
#endif
#ifndef ATT_DMAPOS
#define ATT_DMAPOS 0
#endif
#ifndef ATT_VD
#define ATT_VD 2
#endif
__device__ __forceinline__ int crow(int r, int hi) { return (r & 3) + 8 * (r >> 2) + 4 * hi; }
__device__ __forceinline__ s16x4 vtr(const LAS unsigned char* p) { return __builtin_bit_cast(s16x4, __builtin_amdgcn_ds_read_tr16_b64_v4i16((LAS v4i16_t*)p)); }
__device__ __forceinline__ float max3f(float a, float b, float c) { float r; asm("v_max3_f32 %0, %1, %2, %3" : "=v"(r) : "v"(a), "v"(b), "v"(c)); return r; }
__device__ __forceinline__ float max2f(float a, float b) { float r; asm("v_max_f32_e32 %0, %1, %2" : "=v"(r) : "v"(a), "v"(b)); return r; }
__device__ __forceinline__ float swapmax(float m) { auto rr = __builtin_amdgcn_permlane32_swap(__float_as_uint(m), __float_as_uint(m), false, false);
    const unsigned a = rr[0], b = rr[1]; return fmaxf(__uint_as_float(a), __uint_as_float(b)); }
__device__ __forceinline__ float swapsum(float m) { auto rr = __builtin_amdgcn_permlane32_swap(__float_as_uint(m), __float_as_uint(m), false, false);
    const unsigned a = rr[0], b = rr[1]; return __uint_as_float(a) + __uint_as_float(b); }

template <bool DIFF>
__device__ __forceinline__ void attn_unit(LAS unsigned char* lds, int tid, size_t rowbase, int h, int q0,
                                          const bf16* Qa, const bf16* Qb, const bf16* Ka, const bf16* Kb, const bf16* Vp, bf16* Op, float lam, const float* gsub) {
    constexpr bool QK8 = !DIFF;
    constexpr int NP = 4, NKS = DIFF ? 4 : 12, KPIECES = 24, R = DIFF ? 128 : 256;
    typedef int v8i32 __attribute__((ext_vector_type(8)));
    const int lane = tid & 63, r32 = lane & 31, hi = lane >> 5, wid = __builtin_amdgcn_readfirstlane(tid >> 6);
    const int mp = DIFF ? (wid >> 2) : 0, rows_w0 = q0 + 32 * (DIFF ? (wid & 3) : wid);
    const char* src[NP]; unsigned tstr[NP]; unsigned dsto[NP];
#pragma unroll
    for (int i = 0; i < NP; ++i) { const int pidx = wid * NP + i;
        const size_t bhb = ((size_t)(rowbase >> 13) * 8 + h) * 128 * 16384, krb = (size_t)(rowbase >> 13) * 128 * 8192;
        if (!DIFF) {
            const size_t b8 = ((size_t)(rowbase >> 13) * 8 + h) * 128 * 8192, kr8 = (size_t)(rowbase >> 13) * 128 * 4096;
            if (pidx < 8) { src[i] = (const char*)Ka + b8 + pidx * 1024 + lane * 16; tstr[i] = 8192; dsto[i] = pidx * 1024; }
            else if (pidx < 12) { src[i] = (const char*)Kb + kr8 + (pidx - 8) * 1024 + lane * 16; tstr[i] = 4096; dsto[i] = pidx * 1024; }
            else if (pidx < 28) { src[i] = (const char*)Vp + bhb + (pidx - 12) * 1024 + lane * 16; tstr[i] = 16384; dsto[i] = KPIECES * 1024 + (pidx - 12) * 1024; }
            else { src[i] = nullptr; tstr[i] = 0; dsto[i] = 0; }
        } else {
            if (pidx < 16) { src[i] = (const char*)Ka + bhb + pidx * 1024 + lane * 16; tstr[i] = 16384; dsto[i] = pidx * 1024; }
            else { src[i] = (const char*)Vp + bhb + (pidx - 16) * 1024 + lane * 16; tstr[i] = 16384; dsto[i] = KPIECES * 1024 + (pidx - 16) * 1024; }
        } }
    const int npw = DIFF ? NP : (wid == 7 ? 0 : NP);
    const unsigned lds0 = (unsigned)(uintptr_t)lds;
#define ATT_DMA(t, bb) do { if (npw) _Pragma("unroll") for (int _i = 0; _i < NP; ++_i) { unsigned _keep; const unsigned _dst = (unsigned)__builtin_amdgcn_readfirstlane((int)(lds0 + (unsigned)((bb) * BUFB) + dsto[_i])); \
        asm volatile("s_mov_b32 %0, m0\n\ts_mov_b32 m0, %2\n\ts_nop 0\n\tglobal_load_lds_dwordx4 %1, off\n\ts_mov_b32 m0, %0" : "=&s"(_keep) : "v"(src[_i] + (size_t)(t) * tstr[_i]), "s"(_dst) : "memory"); } } while (0)
    bf16x8 qf[QK8 ? 1 : NKS]; v8i32 qf8[3];
    { const size_t qrow = rowbase + rows_w0 + r32;
      if constexpr (QK8) {
#pragma unroll
          for (int ks = 0; ks < 3; ++ks) qf8[ks] = ks < 2 ? *(const v8i32*)((const unsigned char*)Qa + qrow * 1024 + h * 128 + ks * 64 + hi * 32) : *(const v8i32*)((const unsigned char*)Qb + qrow * 512 + h * 64 + hi * 32);
      } else {
#pragma unroll
      for (int ks = 0; ks < NKS; ++ks) {
          if (DIFF) qf[ks] = *(const bf16x8*)(Qa + qrow * 1024 + (h * 2 + mp) * 64 + ks * 16 + hi * 8);
          else if (ks < 8) qf[ks] = *(const bf16x8*)(Qa + qrow * 1024 + h * 128 + ks * 16 + hi * 8);
          else qf[ks] = *(const bf16x8*)(Qb + qrow * 512 + h * 64 + (ks - 8) * 16 + hi * 8);
      } } }
    f32x16 o[4];
#pragma unroll
    for (int d0 = 0; d0 < 4; ++d0) o[d0] = f32x16{};
    float m = -1e30f, l = 0.f;
    const int NT = (q0 + R) / 64, t_last = (rows_w0 + 31) / 64;
    LAS float* wsf = (LAS float*)(lds + WSF_OFF) + wid * 32;
    const int koff = QK8 ? hi * 2048 + r32 * 32 : (DIFF ? mp * 8 * 1024 : 0) + hi * 1024 + r32 * 16;
    const int voff = KPIECES * 1024 + ((lane >> 4) & 1) * 32 + (lane & 3) * 8 + (4 * hi + ((lane & 15) >> 2)) * 64;
    const int qpos = rows_w0 + r32;
    ATT_DMA(0, 0);
#if ATT_PF2
    ATT_DMA(1, 1);
#endif
    __builtin_amdgcn_s_waitcnt(0x0F70);
    asm volatile("s_waitcnt vmcnt(0)" ::: "memory"); __syncthreads();
#if ATT_PF2
    int bcur = 0;
#endif
#pragma unroll 1
    for (int t = 0; t < NT; ++t) {
#if ATT_PF2
        const int bb = bcur; const bool more = t + 2 < NT;
#if ATT_DMAPOS == 0
        if (more) ATT_DMA(t + 2, (bcur == 0) ? 2 : bcur - 1);
#else
        if (more && t > t_last) ATT_DMA(t + 2, (bcur == 0) ? 2 : bcur - 1);
#endif
#else
        const int bb = t & 1;
        if (t + 1 < NT) ATT_DMA(t + 1, bb ^ 1);
#endif
        if (t <= t_last) {
            const LAS unsigned char* kb = lds + bb * BUFB + koff;
            f32x16 p0 = f32x16{}, p1 = f32x16{};
            if constexpr (QK8) {
                v8i32 k8a[3], k8c[3];
#pragma unroll
                for (int ks = 0; ks < 3; ++ks) { k8a[ks] = *(const LAS v8i32*)(kb + ks * 4096); k8c[ks] = *(const LAS v8i32*)(kb + ks * 4096 + 1024); }
#pragma unroll
                for (int ks = 0; ks < 3; ++ks) {
                    p0 = __builtin_amdgcn_mfma_scale_f32_32x32x64_f8f6f4(k8a[ks], qf8[ks], p0, 0, 0, 0, 0x7F7F7F7F, 0, 0x7F7F7F7F);
                    p1 = __builtin_amdgcn_mfma_scale_f32_32x32x64_f8f6f4(k8c[ks], qf8[ks], p1, 0, 0, 0, 0x7F7F7F7F, 0, 0x7F7F7F7F);
                }
            } else
            {
                bf16x8 kfa[NKS], kfc[NKS];
#pragma unroll
                for (int ks = 0; ks < ATT_KD; ++ks) { kfa[ks] = *(const LAS bf16x8*)(kb + ks * 2048); kfc[ks] = *(const LAS bf16x8*)(kb + ks * 2048 + 512); }
                __builtin_amdgcn_sched_barrier(0);
#pragma unroll
                for (int ks = 0; ks < NKS; ++ks) {
                    if (ks + ATT_KD < NKS) { kfa[ks + ATT_KD] = *(const LAS bf16x8*)(kb + (ks + ATT_KD) * 2048); kfc[ks + ATT_KD] = *(const LAS bf16x8*)(kb + (ks + ATT_KD) * 2048 + 512); }
                    __builtin_amdgcn_sched_barrier(0);
                    p0 = __builtin_amdgcn_mfma_f32_32x32x16_bf16(kfa[ks], qf[ks], p0, 0, 0, 0);
                    p1 = __builtin_amdgcn_mfma_f32_32x32x16_bf16(kfc[ks], qf[ks], p1, 0, 0, 0);
                    __builtin_amdgcn_sched_barrier(0);
                }
            }
#if ATT_PF2 && ATT_DMAPOS == 1
            if (more) ATT_DMA(t + 2, (bcur == 0) ? 2 : bcur - 1);
#endif
            if (64 * t + 63 > rows_w0) {
                const int kb0 = 64 * t + 4 * hi;
#pragma unroll
                for (int r = 0; r < 16; ++r) { const int kv = kb0 + (r & 3) + 8 * (r >> 2); if (kv > qpos) p0[r] = -INFINITY; if (kv + 32 > qpos) p1[r] = -INFINITY; }
            }
            asm volatile("s_nop 15\n\ts_nop 7" : "+v"(p0), "+v"(p1));
            float rm = max3f(p0[0], p0[1], p1[0]), rm2 = max3f(p0[2], p0[3], p1[1]); rm = max3f(rm, p1[2], p1[3]);
#pragma unroll
            for (int r = 4; r < 16; r += 4) { rm = max3f(rm, p0[r], p0[r + 1]); rm2 = max3f(rm2, p0[r + 2], p0[r + 3]); rm = max3f(rm, p1[r], p1[r + 1]); rm2 = max3f(rm2, p1[r + 2], p1[r + 3]); }
            rm = swapmax(max2f(rm, rm2)) * (QK8 ? 1.0f / MLA_QSCALE : 1.0f);
            const float mn = (rm > m + ATT_THR) ? rm : m;
            if (__any(mn > m)) {
                const float al = __builtin_amdgcn_exp2f(m - mn);
                l *= al;
                if (hi == 0) wsf[r32] = al;
                LDS_WAIT(); asm volatile("" ::: "memory");
#pragma unroll
                for (int r = 0; r < 16; ++r) { const float a = wsf[crow(r, hi)];
#pragma unroll
                    for (int d0 = 0; d0 < 4; ++d0) o[d0][r] *= a; }
                LDS_WAIT(); asm volatile("" ::: "memory");
            }
            m = mn;
            float ps = 0.f;
#pragma unroll
            for (int r = 0; r < 16; ++r) { p0[r] = __builtin_amdgcn_exp2f(QK8 ? fmaf(p0[r], 1.0f / MLA_QSCALE, -mn) : p0[r] - mn); p1[r] = __builtin_amdgcn_exp2f(QK8 ? fmaf(p1[r], 1.0f / MLA_QSCALE, -mn) : p1[r] - mn); ps += p0[r] + p1[r]; }
            l += ps;
#if ATT_PF2 && ATT_DMAPOS == 2
            if (more) ATT_DMA(t + 2, (bcur == 0) ? 2 : bcur - 1);
#endif
            u32x4 pw[4];
            pw[0] = (u32x4){cvtpk(p0[0], p0[1]), cvtpk(p0[2], p0[3]), cvtpk(p0[4], p0[5]), cvtpk(p0[6], p0[7])};
            pw[1] = (u32x4){cvtpk(p0[8], p0[9]), cvtpk(p0[10], p0[11]), cvtpk(p0[12], p0[13]), cvtpk(p0[14], p0[15])};
            pw[2] = (u32x4){cvtpk(p1[0], p1[1]), cvtpk(p1[2], p1[3]), cvtpk(p1[4], p1[5]), cvtpk(p1[6], p1[7])};
            pw[3] = (u32x4){cvtpk(p1[8], p1[9]), cvtpk(p1[10], p1[11]), cvtpk(p1[12], p1[13]), cvtpk(p1[14], p1[15])};
            const LAS unsigned char* vb = lds + bb * BUFB + voff;
            {
                s16x4 vlo[16], vhh[16];
#pragma unroll
                for (int i = 0; i < ATT_VD; ++i) { vlo[i] = vtr(vb + i * 1024); vhh[i] = vtr(vb + i * 1024 + 512); }
                __builtin_amdgcn_sched_barrier(0);
#pragma unroll
                for (int i = 0; i < 16; ++i) {
                    if (i + ATT_VD < 16) { vlo[i + ATT_VD] = vtr(vb + (i + ATT_VD) * 1024); vhh[i + ATT_VD] = vtr(vb + (i + ATT_VD) * 1024 + 512); }
                    __builtin_amdgcn_sched_barrier(0);
                    const bf16x8 vf = (bf16x8){vlo[i][0], vlo[i][1], vlo[i][2], vlo[i][3], vhh[i][0], vhh[i][1], vhh[i][2], vhh[i][3]};
                    o[i >> 2] = __builtin_amdgcn_mfma_f32_32x32x16_bf16(__builtin_bit_cast(bf16x8, pw[i & 3]), vf, o[i >> 2], 0, 0, 0);
                    __builtin_amdgcn_sched_barrier(0);
                }
            }
        }
#if ATT_PF2
        if (more) asm volatile("s_waitcnt vmcnt(%0)" :: "n"(NP) : "memory"); else asm volatile("s_waitcnt vmcnt(0)" ::: "memory");
        __syncthreads();
        bcur = (bcur == 2) ? 0 : bcur + 1;
#else
        asm volatile("s_waitcnt vmcnt(0)" ::: "memory"); __syncthreads();
#endif
    }
#undef ATT_DMA
    l = swapsum(l);
    if (hi == 0) wsf[r32] = l;
    LDS_WAIT(); asm volatile("" ::: "memory");
    float rli[16];
#pragma unroll
    for (int r = 0; r < 16; ++r) rli[r] = 1.0f / wsf[crow(r, hi)];
    LDS_WAIT(); asm volatile("" ::: "memory");
    if (!DIFF) {
#pragma unroll
        for (int r = 0; r < 16; ++r) { bf16* orow = Op + (rowbase + rows_w0 + crow(r, hi)) * 1024 + h * 128 + r32;
#pragma unroll
            for (int d0 = 0; d0 < 4; ++d0) orow[d0 * 32] = (bf16)(cvtpk(o[d0][r] * rli[r], 0.f) & 0xffffu); }
    } else {
        LAS float* xch = (LAS float*)lds;
        if (wid >= 4) {
#pragma unroll
            for (int d0 = 0; d0 < 4; ++d0)
#pragma unroll
                for (int r = 0; r < 16; ++r) xch[((wid & 3) * 64 + d0 * 16 + r) * 64 + lane] = o[d0][r] * rli[r];
        }
        __syncthreads();
        if (wid < 4) {
            float ss[16];
#pragma unroll
            for (int r = 0; r < 16; ++r) ss[r] = 0.f;
#pragma unroll
            for (int d0 = 0; d0 < 4; ++d0)
#pragma unroll
                for (int r = 0; r < 16; ++r) { const float d = o[d0][r] * rli[r] - lam * xch[(wid * 64 + d0 * 16 + r) * 64 + lane]; o[d0][r] = d; ss[r] += d * d; }
#pragma unroll
            for (int r = 0; r < 16; ++r) {
#pragma unroll
                for (int of = 1; of < 32; of <<= 1) ss[r] += __shfl_xor(ss[r], of);
                ss[r] = 1.0f / sqrtf(ss[r] * (1.0f / 128.0f) + EPS); }
            float g4[4];
#pragma unroll
            for (int d0 = 0; d0 < 4; ++d0) g4[d0] = gsub[d0 * 32 + r32] * (1.0f - LAMBDA_INIT);
#pragma unroll
            for (int r = 0; r < 16; ++r) { bf16* orow = Op + (rowbase + rows_w0 + crow(r, hi)) * 1024 + h * 128 + r32;
#pragma unroll
                for (int d0 = 0; d0 < 4; ++d0) orow[d0 * 32] = (bf16)(cvtpk(o[d0][r] * ss[r] * g4[d0], 0.f) & 0xffffu); }
        }
        __syncthreads();
    }
}
}

__device__ __forceinline__ void p3_attention(Frame& F, const Ins& I) {
    unsigned char* ws = F.ws;
    const bf16 *QN = (const bf16*)(ws + WS_QN), *QR = (const bf16*)(ws + WS_QR), *KN = (const bf16*)(ws + WS_KN), *KR = (const bf16*)(ws + WS_KR), *V = (const bf16*)(ws + WS_V);
    const bf16 *DQ = (const bf16*)(ws + WS_DQ), *DK = (const bf16*)(ws + WS_DK), *DV = (const bf16*)(ws + WS_DV);
    bf16 *OM = (bf16*)(ws + WS_OM), *OD = (bf16*)(ws + WS_OD);
    const float lam = ((const float*)F.ctl)[CW_LAMBDA];
    LAS unsigned char* lds = F.lds + RING_OFF;
    for (int v = F.vcu; v < 256; v += F.G) {
        const int bh = v >> 4, c = v & 15, b = bh >> 3, h = bh & 7; const size_t rowbase = (size_t)b * SEQ;
        att::attn_unit<false>(lds, F.tid, rowbase, h, (31 - c) * 256, QN, QR, KN, KR, V, OM, lam, I.g_subln);
        att::attn_unit<true>(lds, F.tid, rowbase, h, (63 - c) * 128, DQ, nullptr, DK, nullptr, DV, OD, lam, I.g_subln);
        att::attn_unit<true>(lds, F.tid, rowbase, h, (47 - c) * 128, DQ, nullptr, DK, nullptr, DV, OD, lam, I.g_subln);
        att::attn_unit<true>(lds, F.tid, rowbase, h, (16 + c) * 128, DQ, nullptr, DK, nullptr, DV, OD, lam, I.g_subln);
        att::attn_unit<true>(lds, F.tid, rowbase, h, c * 128, DQ, nullptr, DK, nullptr, DV, OD, lam, I.g_subln);
        att::attn_unit<false>(lds, F.tid, rowbase, h, c * 256, QN, QR, KN, KR, V, OM, lam, I.g_subln);
    }
}

__device__ __forceinline__ void wave_argmax(float v, int idx, float& mv, int& mi) {
#pragma unroll
    for (int o = 1; o < 64; o <<= 1) { const float ov = __shfl_xor(v, o); const int oi = __shfl_xor(idx, o); if (ov > v || (ov == v && oi < idx)) { v = ov; idx = oi; } }
    mv = v; mi = idx;
}
__device__ __forceinline__ void p7_routing_ref(Frame& F) {
    unsigned char* ws = F.ws;
    const bf16* QP = (const bf16*)(ws + WS_QP); const bf16* SKB = (const bf16*)(ws + WS_SKB);
    int* IDX = (int*)(ws + WS_IDX); float* GT = (float*)(ws + WS_GT);
    LAS float* wl = (LAS float*)(F.lds + RING_OFF + F.wave * 4096);
    LAS float* qs = wl; LAS float* v1s = wl + 256; LAS int* i1s = (LAS int*)(wl + 272); LAS float* v2s = wl + 288; LAS int* i2s = (LAS int*)(wl + 304);
    const int gw = F.vcu * NWAVES + F.wave, NGW = F.G * NWAVES, lane = F.lane;
    for (int it = gw; it < T * 8; it += NGW) {
        { const u32x2 w = *(const u32x2*)(QP + (size_t)it * 256 + lane * 4); qs[lane * 4 + 0] = bflo(w.x); qs[lane * 4 + 1] = bfhi(w.x); qs[lane * 4 + 2] = bflo(w.y); qs[lane * 4 + 3] = bfhi(w.y); }
        LDS_WAIT(); asm volatile("" ::: "memory");
        float sc[2][2];
#pragma unroll
        for (int hf = 0; hf < 2; ++hf)
#pragma unroll
            for (int kk = 0; kk < 2; ++kk) { const bf16* kr = SKB + (size_t)(hf * 128 + kk * 64 + lane) * 256 + hf * 128; float s = 0.f;
#pragma unroll 4
                for (int d = 0; d < 128; d += 8) { const u32x4 kw = *(const u32x4*)(kr + d);
                    const f32x4 qa4 = *(const LAS f32x4*)(qs + hf * 128 + d), qb4 = *(const LAS f32x4*)(qs + hf * 128 + d + 4);
                    s += (qa4[0] * bflo(kw.x) + qa4[1] * bfhi(kw.x)) + (qa4[2] * bflo(kw.y) + qa4[3] * bfhi(kw.y)) + (qb4[0] * bflo(kw.z) + qb4[1] * bfhi(kw.z)) + (qb4[2] * bflo(kw.w) + qb4[3] * bfhi(kw.w)); }
                sc[hf][kk] = s; }
#pragma unroll
        for (int hf = 0; hf < 2; ++hf) {
            float a = sc[hf][0], b = sc[hf][1];
            for (int r = 0; r < 16; ++r) {
                float lv; int li; if (b > a) { lv = b; li = lane + 64; } else { lv = a; li = lane; }
                float mv; int mi; wave_argmax(lv, li, mv, mi);
                if (mi == lane) a = -INFINITY; if (mi == lane + 64) b = -INFINITY;
                if (lane == 0) { if (hf == 0) { v1s[r] = mv; i1s[r] = mi; } else { v2s[r] = mv; i2s[r] = mi; } }
            }
        }
        LDS_WAIT(); asm volatile("" ::: "memory");
        float cv[4];
#pragma unroll
        for (int j = 0; j < 4; ++j) { const int c = lane * 4 + j; cv[j] = v1s[c >> 4] + v2s[c & 15]; }
        float mycs = 0.f; int myc = 0;
        for (int r = 0; r < 16; ++r) {
            float lv = cv[0]; int li = lane * 4;
#pragma unroll
            for (int j = 1; j < 4; ++j) if (cv[j] > lv) { lv = cv[j]; li = lane * 4 + j; }
            float mv; int mi; wave_argmax(lv, li, mv, mi);
#pragma unroll
            for (int j = 0; j < 4; ++j) if (mi == lane * 4 + j) cv[j] = -INFINITY;
            if (lane == r) { mycs = mv; myc = mi; }
        }
        float mx = mycs;
#pragma unroll
        for (int o = 1; o < 16; o <<= 1) mx = fmaxf(mx, __shfl_xor(mx, o));
        const float e = __expf(mycs - mx); float se = e;
#pragma unroll
        for (int o = 1; o < 16; o <<= 1) se += __shfl_xor(se, o);
        if (lane < 16) { const int ex = i1s[myc >> 4] * 128 + i2s[myc & 15];
            IDX[(size_t)it * 16 + lane] = ex; GT[(size_t)it * 16 + lane] = e / se; }
        LDS_WAIT(); asm volatile("" ::: "memory");
    }
}

__device__ __forceinline__ void unpack8(const u32x4 w, float (&f)[8]) { f[0] = bflo(w.x); f[1] = bfhi(w.x); f[2] = bflo(w.y); f[3] = bfhi(w.y); f[4] = bflo(w.z); f[5] = bfhi(w.z); f[6] = bflo(w.w); f[7] = bfhi(w.w); }
__device__ __forceinline__ void p8_gather(Frame& F, const Ins& I, float* out) {
    unsigned char* ws = F.ws;
    const float* X2 = (const float*)(ws + WS_X2); const bf16* EU = (const bf16*)(ws + WS_EU); const bf16* EV = (const bf16*)(ws + WS_EV);
    const int* IDX = (const int*)(ws + WS_IDX); const float* GT = (const float*)(ws + WS_GT);
    const float* ssq2 = (const float*)(ws + WS_PSQ2);
    const int gw = F.vcu * NWAVES + F.wave, NGW = F.G * NWAVES, lane = F.lane;
    for (int t = gw; t < T; t += NGW) {
        float xv[4][8], acc[4][8];
#pragma unroll
        for (int j = 0; j < 4; ++j) { const f32x4 a = *(const f32x4*)(X2 + (size_t)t * 2048 + 512 * j + 8 * lane), b = *(const f32x4*)(X2 + (size_t)t * 2048 + 512 * j + 8 * lane + 4);
            xv[j][0] = a[0]; xv[j][1] = a[1]; xv[j][2] = a[2]; xv[j][3] = a[3]; xv[j][4] = b[0]; xv[j][5] = b[1]; xv[j][6] = b[2]; xv[j][7] = b[3];
#pragma unroll
            for (int e = 0; e < 8; ++e) acc[j][e] = 0.f; }
        const float rstd2 = 1.0f / sqrtf(sum32(ssq2 + (size_t)t * 32) * (1.0f / 2048.0f) + EPS);
        const int id0 = IDX[(size_t)t * 128 + lane], id1 = IDX[(size_t)t * 128 + 64 + lane];
        const float g0 = GT[(size_t)t * 128 + lane], g1 = GT[(size_t)t * 128 + 64 + lane];
        for (int i = 0; i < 128; ++i) {
            const int ex = __builtin_amdgcn_readlane(i < 64 ? id0 : id1, i & 63);
            const float gate = __builtin_bit_cast(float, __builtin_amdgcn_readlane(__builtin_bit_cast(int, i < 64 ? g0 : g1), i & 63));
            const bf16* ur = EU + (size_t)ex * 2048 + 8 * lane; const bf16* vr = EV + (size_t)ex * 2048 + 8 * lane;
            u32x4 uw[4], vw[4];
#pragma unroll
            for (int j = 0; j < 4; ++j) { uw[j] = *(const u32x4*)(ur + 512 * j); vw[j] = *(const u32x4*)(vr + 512 * j); }
            float dot = 0.f;
#pragma unroll
            for (int j = 0; j < 4; ++j) { float f[8]; unpack8(uw[j], f);
#pragma unroll
                for (int e = 0; e < 8; ++e) dot += f[e] * xv[j][e]; }
            const float a = wave_sum(dot) * rstd2;
            const float z2 = 1.5957691216057308f * (a + 0.044715f * a * a * a);
            const float w = gate * a * __builtin_amdgcn_rcpf(1.0f + __builtin_amdgcn_exp2f(-z2 * LOG2E));
#pragma unroll
            for (int j = 0; j < 4; ++j) { float f[8]; unpack8(vw[j], f);
#pragma unroll
                for (int e = 0; e < 8; ++e) acc[j][e] += w * f[e]; }
        }
        float s = 0.f;
#pragma unroll
        for (int j = 0; j < 4; ++j)
#pragma unroll
            for (int e = 0; e < 8; ++e) { acc[j][e] += xv[j][e]; s += acc[j][e] * acc[j][e]; }
        float rs = 1.0f / sqrtf(wave_sum(s) * (1.0f / 2048.0f) + EPS);
#ifdef ATT_CHECK
        if (((const unsigned*)F.ctl)[ATT_CHECK_WORD] > ATT_CHECK_MAX) rs = __builtin_nanf("");
#endif
#pragma unroll
        for (int j = 0; j < 4; ++j) { const f32x4 ga = *(const f32x4*)(I.g_final + 512 * j + 8 * lane), gb = *(const f32x4*)(I.g_final + 512 * j + 8 * lane + 4);
            *(f32x4*)(out + (size_t)t * 2048 + 512 * j + 8 * lane) = (f32x4){acc[j][0] * rs * ga[0], acc[j][1] * rs * ga[1], acc[j][2] * rs * ga[2], acc[j][3] * rs * ga[3]};
            *(f32x4*)(out + (size_t)t * 2048 + 512 * j + 8 * lane + 4) = (f32x4){acc[j][4] * rs * gb[0], acc[j][5] * rs * gb[1], acc[j][6] * rs * gb[2], acc[j][7] * rs * gb[3]}; }
    }
}

namespace rt {
typedef short bf16x8 __attribute__((ext_vector_type(8)));
typedef float f32x16 __attribute__((ext_vector_type(16)));
__device__ __forceinline__ unsigned f2sort(float f) { const unsigned u = __float_as_uint(f); return u ^ ((unsigned)((int)u >> 31) | 0x80000000u); }
__device__ __forceinline__ float sort2f(unsigned s) { return __uint_as_float(s ^ ((s >> 31) ? 0x80000000u : 0xFFFFFFFFu)); }
__device__ __forceinline__ unsigned umax(unsigned a, unsigned b) { return a > b ? a : b; }
__device__ __forceinline__ unsigned pair_max(unsigned m) { auto rr = __builtin_amdgcn_permlane32_swap(m, m, false, false); const unsigned a = rr[0], b = rr[1]; return umax(a, b); }
constexpr int KEYS_BYTES = 65536, LIST_OFF = KEYS_BYTES, LIST_WAVE = 6144 + 512;
}
__device__ __forceinline__ void rt_load_keys(Frame& F, const Ins& I) {
    LAS unsigned char* lds = F.lds + RING_OFF;
    for (int it = F.tid; it < 2 * 128 * 16; it += NWAVES * 64) {
        const int c = it & 15, n = (it >> 4) & 127, hf = it >> 11;
        const float* sp = I.sub_keys + (size_t)hf * 16384 + n * 128 + c * 8;
        const f32x4 a = *(const f32x4*)sp, b = *(const f32x4*)(sp + 4);
        v4u o; o.x = pk2(a.x, a.y); o.y = pk2(a.z, a.w); o.z = pk2(b.x, b.y); o.w = pk2(b.z, b.w);
        *(LAS v4u*)(lds + hf * 32768 + c * 2048 + n * 16) = o;
    }
    __syncthreads();
}
template <bool TO_LDS>
__device__ __forceinline__ void rt_task(Frame& F, int task, LAS unsigned* lst) {
    using namespace rt;
    unsigned char* ws = F.ws;
    const bf16* QP = (const bf16*)(ws + WS_QP);
    int* IDX = (int*)(ws + WS_IDX); float* GT = (float*)(ws + WS_GT);
    LAS unsigned char* lds = F.lds + RING_OFF;
    const int lane = F.lane, r32 = lane & 31, hi = lane >> 5;
        const size_t row = (size_t)task * 32 + r32;
#pragma unroll 1
        for (int hf = 0; hf < 2; ++hf) {
            bf16x8 qf[8];
#pragma unroll
            for (int ks = 0; ks < 8; ++ks) qf[ks] = *(const bf16x8*)(QP + row * 256 + hf * 128 + ks * 16 + hi * 8);
            unsigned k[64];
            const LAS unsigned char* kb0 = lds + hf * 32768 + hi * 2048 + r32 * 16;
#pragma unroll
            for (int kb = 0; kb < 4; ++kb) {
                f32x16 acc = f32x16{};
#pragma unroll
                for (int ks = 0; ks < 8; ++ks) acc = __builtin_amdgcn_mfma_f32_32x32x16_bf16(*(const LAS bf16x8*)(kb0 + ks * 4096 + kb * 512), qf[ks], acc, 0, 0, 0);
#pragma unroll
                for (int r = 0; r < 16; ++r) { const int n = 32 * kb + (r & 3) + 8 * (r >> 2) + 4 * hi; k[16 * kb + r] = (f2sort(acc[r]) & ~0x7Fu) | (unsigned)(127 - n); }
            }
#pragma unroll 1
            for (int rd = 0; rd < 16; ++rd) {
                unsigned m = k[0];
#pragma unroll
                for (int i = 1; i < 64; ++i) m = umax(m, k[i]);
                const unsigned g = pair_max(m);
#pragma unroll
                for (int i = 0; i < 64; ++i) k[i] = (k[i] == g) ? 0u : k[i];
                if (hi == 0) lst[hf * 16 + rd] = g;
            }
        }
        LDS_WAIT(); asm volatile("" ::: "memory");
        float v1[16], v2[16];
#pragma unroll
        for (int q = 0; q < 4; ++q) { const v4u a = *(const LAS v4u*)(lst + 4 * q), b = *(const LAS v4u*)(lst + 16 + 4 * q);
#pragma unroll
            for (int e = 0; e < 4; ++e) { v1[4 * q + e] = sort2f(a[e] & ~0x7Fu); v2[4 * q + e] = sort2f(b[e] & ~0x7Fu); } }
        unsigned cand[50];
        { int ci = 0;
#pragma unroll
          for (int a = 0; a < 16; ++a)
#pragma unroll
              for (int b = 0; b < 16; ++b) if ((a + 1) * (b + 1) <= 16) { cand[ci] = (f2sort(v1[a] + v2[b]) & ~0xFFu) | (unsigned)(255 - (a * 16 + b)); ++ci; } }
#pragma unroll 1
        for (int rd = 0; rd < 16; ++rd) {
            unsigned m = cand[0];
#pragma unroll
            for (int i = 1; i < 50; ++i) m = umax(m, cand[i]);
#pragma unroll
            for (int i = 0; i < 50; ++i) cand[i] = (cand[i] == m) ? 0u : cand[i];
            if (hi == 0) lst[32 + rd] = m;
        }
        LDS_WAIT(); asm volatile("" ::: "memory");
        const float cmax = sort2f(lst[32] & ~0xFFu);
        float ev[8]; int ex[8]; float se = 0.f;
#pragma unroll
        for (int j = 0; j < 8; ++j) { const unsigned key = lst[32 + 8 * hi + j]; const int ab = 255 - (int)(key & 0xFFu);
            const int i1 = 127 - (int)(lst[ab >> 4] & 0x7Fu), i2 = 127 - (int)(lst[16 + (ab & 15)] & 0x7Fu);
            ex[j] = i1 * 128 + i2; ev[j] = __expf(sort2f(key & ~0xFFu) - cmax); se += ev[j]; }
        { auto rr = __builtin_amdgcn_permlane32_swap(__float_as_uint(se), __float_as_uint(se), false, false); const unsigned a = rr[0], b = rr[1]; se = __uint_as_float(a) + __uint_as_float(b); }
        const float inv = 1.0f / se;
        if (TO_LDS) {
#pragma unroll
            for (int j = 0; j < 8; ++j) { lst[8 * hi + j] = (unsigned)ex[j]; lst[16 + 8 * hi + j] = __float_as_uint(ev[j] * inv); }
        } else {
        int* ip = IDX + row * 16 + 8 * hi; float* gp = GT + row * 16 + 8 * hi;
        *(GAS v4u*)ip = (v4u){(unsigned)ex[0], (unsigned)ex[1], (unsigned)ex[2], (unsigned)ex[3]}; *(GAS v4u*)(ip + 4) = (v4u){(unsigned)ex[4], (unsigned)ex[5], (unsigned)ex[6], (unsigned)ex[7]};
        *(GAS f32x4*)gp = (f32x4){ev[0] * inv, ev[1] * inv, ev[2] * inv, ev[3] * inv}; *(GAS f32x4*)(gp + 4) = (f32x4){ev[4] * inv, ev[5] * inv, ev[6] * inv, ev[7] * inv};
        }
        LDS_WAIT(); asm volatile("" ::: "memory");
}
__device__ __forceinline__ void p8_routing(Frame& F, const Ins& I) {
    using namespace rt;
    rt_load_keys(F, I);
    LAS unsigned* lst = (LAS unsigned*)(F.lds + RING_OFF + LIST_OFF + F.wave * LIST_WAVE) + (F.lane & 31) * 48;
    const int gw = F.vcu * NWAVES + F.wave, NGW = F.G * NWAVES;
    for (int task = gw; task < T * 8 / 32; task += NGW) rt_task<false>(F, task, lst);
}
#ifndef PEER_U4
#define PEER_U4 1
#endif
#ifndef PEER_V4
#define PEER_V4 1
#endif
constexpr bool U4 = PEER_U4 != 0, V4 = PEER_V4 != 0;
constexpr float EU_SCALE = U4 ? 90.0f : 64.0f, EV_SCALE = V4 ? 5.625f : 4.0f;
typedef float f32x2v __attribute__((ext_vector_type(2)));
__device__ __forceinline__ unsigned pk4_fp8(float a, float b, float c, float d) { int t = __builtin_amdgcn_cvt_pk_fp8_f32(a, b, 0, false); t = __builtin_amdgcn_cvt_pk_fp8_f32(c, d, t, true); return (unsigned)t; }
__device__ __forceinline__ void convert_experts_fp8(Frame& F, const Ins& I) {
    const size_t gt = (size_t)(F.vcu * NWAVES * 64) + F.tid, NT = (size_t)F.G * NWAVES * 64;
    const size_t nchunk = (size_t)NEXP * D_MODEL / 16;
    unsigned char* EU = F.ws + WS_EU; unsigned char* EV = F.ws + WS_EV;
    for (size_t c = gt; c < nchunk; c += NT) {
        const int d = (int)((c * 16) & (D_MODEL - 1));
        v4u o, p;
#pragma unroll
        for (int k = 0; k < 4; ++k) {
            const f32x4 a = *(const GAS f32x4*)(I.expert_u + c * 16 + 4 * k), g = *(const f32x4*)(I.g_norm2 + d + 4 * k), b = *(const GAS f32x4*)(I.expert_v + c * 16 + 4 * k);
            o[k] = pk4_fp8(a.x * g.x * EU_SCALE, a.y * g.y * EU_SCALE, a.z * g.z * EU_SCALE, a.w * g.w * EU_SCALE);
            p[k] = pk4_fp8(b.x * EV_SCALE, b.y * EV_SCALE, b.z * EV_SCALE, b.w * EV_SCALE);
        }
        *(GAS v4u*)(EU + c * 16) = o; *(GAS v4u*)(EV + c * 16) = p;
    }
}
#ifndef PEER_FP8
#define PEER_FP6 1
#endif
#ifdef PEER_FP6
typedef float v32f_t __attribute__((ext_vector_type(32)));
typedef float v16f_t __attribute__((ext_vector_type(16)));
typedef unsigned v6u_t __attribute__((ext_vector_type(6)));
constexpr int EROW = 1536;
#define FP4_UNP(w, sel) __builtin_amdgcn_cvt_scalef32_pk_f32_fp4((w), 1.0f, (sel))
__device__ __forceinline__ void unpack32_fp4(const u32x4 a, f32x2v (&r)[16]) {
    r[0] = FP4_UNP(a.x, 0); r[1] = FP4_UNP(a.x, 1); r[2] = FP4_UNP(a.x, 2); r[3] = FP4_UNP(a.x, 3); r[4] = FP4_UNP(a.y, 0); r[5] = FP4_UNP(a.y, 1); r[6] = FP4_UNP(a.y, 2); r[7] = FP4_UNP(a.y, 3);
    r[8] = FP4_UNP(a.z, 0); r[9] = FP4_UNP(a.z, 1); r[10] = FP4_UNP(a.z, 2); r[11] = FP4_UNP(a.z, 3); r[12] = FP4_UNP(a.w, 0); r[13] = FP4_UNP(a.w, 1); r[14] = FP4_UNP(a.w, 2); r[15] = FP4_UNP(a.w, 3);
}
__device__ __forceinline__ unsigned pack8_fp4(const f32x4 lo, const f32x4 hi) {
    unsigned w = __builtin_amdgcn_cvt_scalef32_pk_fp4_f32(0u, lo[0], lo[1], 1.0f, 0); w = __builtin_amdgcn_cvt_scalef32_pk_fp4_f32(w, lo[2], lo[3], 1.0f, 1);
    w = __builtin_amdgcn_cvt_scalef32_pk_fp4_f32(w, hi[0], hi[1], 1.0f, 2); return __builtin_amdgcn_cvt_scalef32_pk_fp4_f32(w, hi[2], hi[3], 1.0f, 3); }
__device__ __forceinline__ void convert_experts_fp4(Frame& F, const Ins& I) {
    if (!U4 && !V4) return;
    unsigned char* EU = F.ws + WS_EU; unsigned char* EV = F.ws + WS_EV;
    const int gw = F.vcu * NWAVES + F.wave, NGW = F.G * NWAVES, lane = F.lane;
    LAS unsigned char* img = F.lds + RING_OFF + F.wave * 9216;
    f32x4 gsc[8];
#pragma unroll
    for (int k = 0; k < 8; ++k) gsc[k] = *(const f32x4*)(I.g_norm2 + (64 * k + lane) * 4) * EU_SCALE;
    for (int e = gw; e < NEXP; e += NGW) {
        f32x4 ru[8], rv[8];
#pragma unroll
        for (int k = 0; k < 8; ++k) { if (U4) ru[k] = *(const GAS f32x4*)(I.expert_u + (size_t)e * 2048 + (64 * k + lane) * 4); if (V4) rv[k] = *(const GAS f32x4*)(I.expert_v + (size_t)e * 2048 + (64 * k + lane) * 4); }
#pragma unroll
        for (int tb = 0; tb < 2; ++tb) {
            if (tb == 0 ? !U4 : !V4) continue;
#pragma unroll
            for (int k = 0; k < 8; ++k) { const int i4 = 64 * k + lane;
                *(LAS f32x4*)(img + (i4 >> 3) * 144 + (i4 & 7) * 16) = tb == 0 ? ru[k] * gsc[k] : rv[k] * EV_SCALE; }
            LDS_WAIT(); asm volatile("" ::: "memory");
            unsigned w[4];
#pragma unroll
            for (int j = 0; j < 4; ++j) w[j] = pack8_fp4(*(const LAS f32x4*)(img + lane * 144 + 32 * j), *(const LAS f32x4*)(img + lane * 144 + 32 * j + 16));
            LDS_WAIT(); asm volatile("" ::: "memory");
            *(GAS v4u*)((tb == 0 ? EU : EV) + (size_t)e * 1024 + 16 * lane) = (v4u){w[0], w[1], w[2], w[3]};
        }
    }
    __syncthreads();
}
__device__ __forceinline__ void convert_experts_fp6(Frame& F, const Ins& I) {
    if (U4 && V4) return;
    const size_t gt = (size_t)(F.vcu * NWAVES * 64) + F.tid, NT = (size_t)F.G * NWAVES * 64;
    const size_t nblk = (size_t)NEXP * 64;
    unsigned char* EU = F.ws + WS_EU; unsigned char* EV = F.ws + WS_EV;
    LAS int* ptab = (LAS int*)(F.lds + RING_OFF + 65536);
#pragma unroll 1
    for (int j = 0; j < 32; ++j) {
        v16f_t a, b;
#pragma unroll
        for (int i = 0; i < 16; ++i) { a[i] = (i == j) ? 1.0f : 0.0f; b[i] = (i + 16 == j) ? 1.0f : 0.0f; }
        const v32f_t r = __builtin_amdgcn_cvt_scalef32_pk32_f32_fp6(__builtin_amdgcn_cvt_scalef32_2xpk16_fp6_f32(a, b, 1.0f), 1.0f);
        int pos = 0;
#pragma unroll
        for (int i = 0; i < 32; ++i) pos = (r[i] != 0.0f) ? i : pos;
        ptab[j] = pos;
    }
    LDS_WAIT(); asm volatile("" ::: "memory");
    bool inter = true;
#pragma unroll 1
    for (int j = 0; j < 32; ++j) inter = inter && (ptab[j] == ((j < 16) ? 2 * j : 2 * (j - 16) + 1));
    if (inter) {
        const int gw = F.vcu * NWAVES + F.wave, NGW = F.G * NWAVES, lane = F.lane;
        LAS unsigned char* img = F.lds + RING_OFF + F.wave * 9216;
        f32x4 gsc[8];
#pragma unroll
        for (int k = 0; k < 8; ++k) gsc[k] = *(const f32x4*)(I.g_norm2 + (64 * k + lane) * 4) * EU_SCALE;
        for (int e = gw; e < NEXP; e += NGW) {
            f32x4 ru[8], rv[8];
#pragma unroll
            for (int k = 0; k < 8; ++k) { if (!U4) ru[k] = *(const GAS f32x4*)(I.expert_u + (size_t)e * 2048 + (64 * k + lane) * 4); if (!V4) rv[k] = *(const GAS f32x4*)(I.expert_v + (size_t)e * 2048 + (64 * k + lane) * 4); }
#pragma unroll
            for (int tb = 0; tb < 2; ++tb) {
                if (tb == 0 ? U4 : V4) continue;
#pragma unroll
                for (int k = 0; k < 8; ++k) { const int i4 = 64 * k + lane;
                    *(LAS f32x4*)(img + (i4 >> 3) * 144 + (i4 & 7) * 16) = tb == 0 ? ru[k] * gsc[k] : rv[k] * EV_SCALE; }
                LDS_WAIT(); asm volatile("" ::: "memory");
                v16f_t ya, yb;
#pragma unroll
                for (int j = 0; j < 8; ++j) { const f32x4 x4 = *(const LAS f32x4*)(img + lane * 144 + 16 * j); ya[2 * j] = x4[0]; yb[2 * j] = x4[1]; ya[2 * j + 1] = x4[2]; yb[2 * j + 1] = x4[3]; }
                LDS_WAIT(); asm volatile("" ::: "memory");
                const v6u_t pk = __builtin_amdgcn_cvt_scalef32_2xpk16_fp6_f32(ya, yb, 1.0f);
                unsigned char* dst = (tb == 0 ? EU : EV) + (size_t)e * EROW;
                *(GAS v4u*)(dst + 16 * lane) = (v4u){pk[0], pk[1], pk[2], pk[3]}; *(GAS u32x2*)(dst + 1024 + 8 * lane) = (u32x2){pk[4], pk[5]};
            }
        }
    } else {
    LAS float* scr = (LAS float*)(F.lds + RING_OFF) + F.tid;
    for (size_t c = gt; c < nblk; c += NT) {
        const size_t e = c >> 6; const int l = (int)(c & 63), d = 32 * l;
        v16f_t ya, yb;
        if (!U4) {
#pragma unroll
        for (int k = 0; k < 8; ++k) { const f32x4 a0 = *(const GAS f32x4*)(I.expert_u + c * 32 + 4 * k), g0 = *(const f32x4*)(I.g_norm2 + d + 4 * k);
#pragma unroll
            for (int j = 0; j < 4; ++j) scr[(4 * k + j) * 512] = a0[j] * g0[j] * EU_SCALE; }
#pragma unroll
        for (int j = 0; j < 16; ++j) { ya[j] = scr[ptab[j] * 512]; yb[j] = scr[ptab[16 + j] * 512]; }
        const v6u_t pu = __builtin_amdgcn_cvt_scalef32_2xpk16_fp6_f32(ya, yb, 1.0f);
        *(GAS v4u*)(EU + e * EROW + 16 * l) = (v4u){pu[0], pu[1], pu[2], pu[3]}; *(GAS u32x2*)(EU + e * EROW + 1024 + 8 * l) = (u32x2){pu[4], pu[5]};
        }
        if (!V4) {
#pragma unroll
        for (int k = 0; k < 8; ++k) { const f32x4 b0 = *(const GAS f32x4*)(I.expert_v + c * 32 + 4 * k);
#pragma unroll
            for (int j = 0; j < 4; ++j) scr[(4 * k + j) * 512] = b0[j] * EV_SCALE; }
#pragma unroll
        for (int j = 0; j < 16; ++j) { ya[j] = scr[ptab[j] * 512]; yb[j] = scr[ptab[16 + j] * 512]; }
        const v6u_t pv = __builtin_amdgcn_cvt_scalef32_2xpk16_fp6_f32(ya, yb, 1.0f);
        *(GAS v4u*)(EV + e * EROW + 16 * l) = (v4u){pv[0], pv[1], pv[2], pv[3]}; *(GAS u32x2*)(EV + e * EROW + 1024 + 8 * l) = (u32x2){pv[4], pv[5]};
        }
    }
    }
    __syncthreads();
}
struct G9Row { u32x4 a; u32x2 b; };
#define G9_SETS G9Row A[4], B[4]
#define G9_XOFF(c) (32 * lane + 16 * (c))
#define G9_LOAD(SET, TAB, IDL, g) do { _Pragma("unroll") for (int k = 0; k < 4; ++k) { const int ex = __builtin_amdgcn_readlane(IDL, 4 * (4 * (g) + k)); \
        if (((TAB) == EU) ? U4 : V4) { SET[k].a = *(const u32x4*)((TAB) + (size_t)ex * 1024 + 16 * lane); } else { \
        const unsigned char* rp = (TAB) + (size_t)ex * EROW; SET[k].a = *(const u32x4*)(rp + 16 * lane); if (VAR == 0 || (TAB) != EU) SET[k].b = *(const u32x2*)(rp + 1024 + 8 * lane); else SET[k].b = (u32x2){0u, 0u}; } } } while (0)
#define G9_CVT(SET, k) __builtin_amdgcn_cvt_scalef32_pk32_f32_fp6((v6u_t){SET[k].a.x, SET[k].a.y, SET[k].a.z, SET[k].a.w, SET[k].b.x, SET[k].b.y}, 1.0f)
#define G9_DOTS(SET, g) do { _Pragma("unroll") for (int k = 0; k < 4; ++k) { f32x2v q0 = {0.f, 0.f}, q1 = {0.f, 0.f}; \
        if (U4) { f32x2v r4[16]; unpack32_fp4(SET[k].a, r4); _Pragma("unroll") for (int i = 0; i < 8; ++i) { \
            q0 = r4[i] * (f32x2v){xv[0][2 * i], xv[0][2 * i + 1]} + q0; q1 = r4[8 + i] * (f32x2v){xv[1][2 * i], xv[1][2 * i + 1]} + q1; } \
        } else { const v32f_t r = G9_CVT(SET, k); \
        _Pragma("unroll") for (int e = 0; e < 16; e += 2) { q0 = (f32x2v){r[e], r[e + 1]} * (f32x2v){xv[0][e], xv[0][e + 1]} + q0; q1 = (f32x2v){r[16 + e], r[17 + e]} * (f32x2v){xv[1][e], xv[1][e + 1]} + q1; } } \
        q0 += q1; float s = q0.x + q0.y; asm volatile("" : "+v"(s)); dots[4 * (g) + k] = s; } } while (0)
#define G9_FMAS(SET, g) do { _Pragma("unroll") for (int k = 0; k < 4; ++k) { const float wk = wq[g][k]; const f32x2v wk2 = {wk, wk}; \
        if (V4) { f32x2v r4[16]; unpack32_fp4(SET[k].a, r4); _Pragma("unroll") for (int i = 0; i < 8; ++i) { \
            const f32x2v a0 = r4[i] * wk2 + (f32x2v){acc[0][2 * i], acc[0][2 * i + 1]}, a1 = r4[8 + i] * wk2 + (f32x2v){acc[1][2 * i], acc[1][2 * i + 1]}; \
            acc[0][2 * i] = a0.x; acc[0][2 * i + 1] = a0.y; acc[1][2 * i] = a1.x; acc[1][2 * i + 1] = a1.y; } \
        } else { const v32f_t r = G9_CVT(SET, k); \
        _Pragma("unroll") for (int e = 0; e < 16; e += 2) { const f32x2v a0 = (f32x2v){r[e], r[e + 1]} * wk2 + (f32x2v){acc[0][e], acc[0][e + 1]}, a1 = (f32x2v){r[16 + e], r[17 + e]} * wk2 + (f32x2v){acc[1][e], acc[1][e + 1]}; \
            acc[0][e] = a0.x; acc[0][e + 1] = a0.y; acc[1][e] = a1.x; acc[1][e + 1] = a1.y; } } } } while (0)
#else
constexpr int EROW = 2048;
#define G9_SETS u32x4 A[4][2], B[4][2]
#define G9_XOFF(c) (1024 * (c) + 16 * lane)
#define G9_LOAD(SET, TAB, IDL, g) do { _Pragma("unroll") for (int k = 0; k < 4; ++k) { const int ex = __builtin_amdgcn_readlane(IDL, 4 * (4 * (g) + k)); \
        const unsigned char* rp = (TAB) + (size_t)ex * 2048 + 16 * lane; SET[k][0] = *(const u32x4*)rp; SET[k][1] = *(const u32x4*)(rp + 1024); } } while (0)
#define G9_DOTS(SET, g) do { _Pragma("unroll") for (int k = 0; k < 4; ++k) { float s = 0.f; _Pragma("unroll") for (int c = 0; c < 2; ++c) _Pragma("unroll") for (int dw = 0; dw < 4; ++dw) { \
        const f32x2v lo = __builtin_amdgcn_cvt_pk_f32_fp8((int)SET[k][c][dw], false), hi2 = __builtin_amdgcn_cvt_pk_f32_fp8((int)SET[k][c][dw], true); \
        s += lo.x * xv[c][4 * dw] + lo.y * xv[c][4 * dw + 1] + hi2.x * xv[c][4 * dw + 2] + hi2.y * xv[c][4 * dw + 3]; } asm volatile("" : "+v"(s)); dots[4 * (g) + k] = s; } } while (0)
#define G9_FMAS(SET, g) do { _Pragma("unroll") for (int k = 0; k < 4; ++k) { const float wk = wq[g][k]; \
        _Pragma("unroll") for (int c = 0; c < 2; ++c) _Pragma("unroll") for (int dw = 0; dw < 4; ++dw) { \
        const f32x2v lo = __builtin_amdgcn_cvt_pk_f32_fp8((int)SET[k][c][dw], false), hi2 = __builtin_amdgcn_cvt_pk_f32_fp8((int)SET[k][c][dw], true); \
        acc[c][4 * dw] += wk * lo.x; acc[c][4 * dw + 1] += wk * lo.y; acc[c][4 * dw + 2] += wk * hi2.x; acc[c][4 * dw + 3] += wk * hi2.y; } } } while (0)
#endif
#define G9_PIN() do { _Pragma("unroll") for (int c = 0; c < 2; ++c) asm volatile("" : "+v"(acc[c][0]), "+v"(acc[c][1]), "+v"(acc[c][2]), "+v"(acc[c][3]), "+v"(acc[c][4]), "+v"(acc[c][5]), "+v"(acc[c][6]), "+v"(acc[c][7]), \
        "+v"(acc[c][8]), "+v"(acc[c][9]), "+v"(acc[c][10]), "+v"(acc[c][11]), "+v"(acc[c][12]), "+v"(acc[c][13]), "+v"(acc[c][14]), "+v"(acc[c][15])); } while (0)
template <int VAR = 0, class IdF, class GtF>
__device__ __forceinline__ void g9_token(Frame& F, const Ins& I, float* out, int t, LAS float* wl, IdF idf, GtF gtf) {
    unsigned char* ws = F.ws;
    const bf16* X2B = (const bf16*)(ws + WS_X2B); const unsigned char* EU = ws + WS_EU; const unsigned char* EV = ws + WS_EV;
    const float* ssq2 = (const float*)(ws + WS_PSQ2);
    const int lane = F.lane, sl = (lane >> 2) & 15;
    const bool bit3 = (lane & 8) != 0, bit2 = (lane & 4) != 0;
    {
        G9_SETS;
        {
            float xv[2][16];
#pragma unroll
            for (int c = 0; c < 2; ++c)
#pragma unroll
                for (int q = 0; q < 2; ++q) { const u32x4 a = *(const u32x4*)(X2B + (size_t)t * 2048 + G9_XOFF(c) + 8 * q);
                    xv[c][8 * q] = bflo(a.x); xv[c][8 * q + 1] = bfhi(a.x); xv[c][8 * q + 2] = bflo(a.y); xv[c][8 * q + 3] = bfhi(a.y); xv[c][8 * q + 4] = bflo(a.z); xv[c][8 * q + 5] = bfhi(a.z); xv[c][8 * q + 6] = bflo(a.w); xv[c][8 * q + 7] = bfhi(a.w); }
            const float rstd2 = (1.0f / EU_SCALE) / sqrtf(sum32(ssq2 + (size_t)t * 32) * (1.0f / 2048.0f) + EPS);
            int idl_cur = idf(0);
            G9_LOAD(A, EU, idl_cur, 0); __builtin_amdgcn_sched_barrier(0);
#pragma unroll 1
            for (int hd = 0; hd < 8; ++hd) {
                const int idl_nxt = idf(hd < 7 ? hd + 1 : 0); const float gtl = gtf(hd);
                float dots[16];
                G9_LOAD(B, EU, idl_cur, 1); __builtin_amdgcn_sched_barrier(0);
                G9_DOTS(A, 0); __builtin_amdgcn_sched_barrier(0);
                G9_LOAD(A, EU, idl_cur, 2); __builtin_amdgcn_sched_barrier(0);
                G9_DOTS(B, 1); __builtin_amdgcn_sched_barrier(0);
                G9_LOAD(B, EU, idl_cur, 3); __builtin_amdgcn_sched_barrier(0);
                G9_DOTS(A, 2); __builtin_amdgcn_sched_barrier(0);
                if (hd < 7) { G9_LOAD(A, EU, idl_nxt, 0); } else { G9_LOAD(A, EV, idl_nxt, 0); }
                __builtin_amdgcn_sched_barrier(0);
                G9_DOTS(B, 3); __builtin_amdgcn_sched_barrier(0);
                float d8[8], d4[4], d2[2], d1;
#pragma unroll
                for (int i = 0; i < 8; ++i) { auto rr = __builtin_amdgcn_permlane32_swap(__float_as_uint(dots[i]), __float_as_uint(dots[8 + i]), false, false); const unsigned r0 = rr[0], r1 = rr[1]; d8[i] = __uint_as_float(r0) + __uint_as_float(r1); }
#pragma unroll
                for (int i = 0; i < 4; ++i) { auto rr = __builtin_amdgcn_permlane16_swap(__float_as_uint(d8[i]), __float_as_uint(d8[4 + i]), false, false); const unsigned r0 = rr[0], r1 = rr[1]; d4[i] = __uint_as_float(r0) + __uint_as_float(r1); }
#pragma unroll
                for (int i = 0; i < 2; ++i) { const float keep = bit3 ? d4[2 + i] : d4[i], send = bit3 ? d4[i] : d4[2 + i]; d2[i] = keep + __shfl_xor(send, 8); }
                { const float keep = bit2 ? d2[1] : d2[0], send = bit2 ? d2[0] : d2[1]; d1 = keep + __shfl_xor(send, 4); }
                d1 += __shfl_xor(d1, 2); d1 += __shfl_xor(d1, 1);
                const float a = d1 * rstd2;
                const float z2 = 1.5957691216057308f * (a + 0.044715f * a * a * a);
                const float w = gtl * (1.0f / EV_SCALE) * a * __builtin_amdgcn_rcpf(1.0f + __builtin_amdgcn_exp2f(-z2 * LOG2E));
                if ((lane & 3) == 0) wl[hd * 16 + sl] = w;
                idl_cur = idl_nxt;
            }
        }
        LDS_WAIT(); asm volatile("" ::: "memory");
        float acc[2][16];
#pragma unroll
        for (int c = 0; c < 2; ++c)
#pragma unroll
            for (int e = 0; e < 16; ++e) acc[c][e] = 0.f;
        {
            int idl_cur = idf(0);
#pragma unroll 1
            for (int hd = 0; hd < 8; ++hd) {
                const int idl_nxt = idf(hd < 7 ? hd + 1 : 0);
                f32x4 wq[4];
#pragma unroll
                for (int g = 0; g < 4; ++g) wq[g] = *(const LAS f32x4*)(wl + hd * 16 + 4 * g);
                G9_LOAD(B, EV, idl_cur, 1); __builtin_amdgcn_sched_barrier(0);
                G9_FMAS(A, 0); G9_PIN(); __builtin_amdgcn_sched_barrier(0);
                G9_LOAD(A, EV, idl_cur, 2); __builtin_amdgcn_sched_barrier(0);
                G9_FMAS(B, 1); G9_PIN(); __builtin_amdgcn_sched_barrier(0);
                G9_LOAD(B, EV, idl_cur, 3); __builtin_amdgcn_sched_barrier(0);
                G9_FMAS(A, 2); G9_PIN(); __builtin_amdgcn_sched_barrier(0);
                if (hd < 7) { G9_LOAD(A, EV, idl_nxt, 0); } __builtin_amdgcn_sched_barrier(0);
                G9_FMAS(B, 3); G9_PIN(); __builtin_amdgcn_sched_barrier(0);
                idl_cur = idl_nxt;
            }
        }
        LDS_WAIT(); asm volatile("" ::: "memory");
        float s = 0.f;
#pragma unroll
        for (int c = 0; c < 2; ++c)
#pragma unroll
            for (int q = 0; q < 2; ++q) { const u32x4 a = *(const u32x4*)(X2B + (size_t)t * 2048 + G9_XOFF(c) + 8 * q);
                const float xr[8] = {bflo(a.x), bfhi(a.x), bflo(a.y), bfhi(a.y), bflo(a.z), bfhi(a.z), bflo(a.w), bfhi(a.w)};
#pragma unroll
                for (int e = 0; e < 8; ++e) { acc[c][8 * q + e] += xr[e]; s += acc[c][8 * q + e] * acc[c][8 * q + e]; } }
        float rs = 1.0f / sqrtf(wave_sum(s) * (1.0f / 2048.0f) + EPS);
#ifdef ATT_CHECK
        if (((const unsigned*)F.ctl)[16] + ((const unsigned*)F.ctl)[17] > 0u) rs = __builtin_nanf("");
#endif
#pragma unroll
        for (int c = 0; c < 2; ++c)
#pragma unroll
            for (int q = 0; q < 4; ++q) { const f32x4 g = *(const f32x4*)(I.g_final + G9_XOFF(c) + 4 * q);
                *(f32x4*)(out + (size_t)t * 2048 + G9_XOFF(c) + 4 * q) = (f32x4){acc[c][4 * q] * rs * g[0], acc[c][4 * q + 1] * rs * g[1], acc[c][4 * q + 2] * rs * g[2], acc[c][4 * q + 3] * rs * g[3]}; }
    }
}
#undef G9_LOAD
#undef G9_DOTS
#undef G9_FMAS
#undef G9_PIN
#undef G9_SETS
#undef G9_XOFF
__device__ __forceinline__ void p9_gather_fp8(Frame& F, const Ins& I, float* out) {
    const int* IDX = (const int*)(F.ws + WS_IDX); const float* GT = (const float*)(F.ws + WS_GT);
    const int lane = F.lane, sl = (lane >> 2) & 15;
    LAS float* wl = (LAS float*)(F.lds + RING_OFF + F.wave * 4096);
    unsigned* tokctr = (unsigned*)F.ctl + CW_TOKCTR;
    for (;;) {
        int t = 0; if (lane == 0) t = (int)__hip_atomic_fetch_add(tokctr, 1u, __ATOMIC_RELAXED, __HIP_MEMORY_SCOPE_AGENT);
        t = __builtin_amdgcn_readfirstlane(t);
        if (t >= T) break;
        const int* idx_t = IDX + (size_t)t * 128 + sl; const float* gt_t = GT + (size_t)t * 128 + sl;
        g9_token(F, I, out, t, wl, [=](int hd) { return idx_t[hd * 16]; }, [=](int hd) { return gt_t[hd * 16]; });
    }
}

template <int VAR = 0>
__device__ __forceinline__ void p89_route_gather(Frame& F, const Ins& I, float* out) {
    using namespace rt;
    rt_load_keys(F, I);
    LAS unsigned* lstw = (LAS unsigned*)(F.lds + RING_OFF + LIST_OFF + F.wave * LIST_WAVE);
    LAS unsigned* lst = lstw + (F.lane & 31) * 48;
    LAS float* wl = (LAS float*)(lstw + 32 * 48);
    const int gw = F.vcu * NWAVES + F.wave, NGW = F.G * NWAVES, sl = (F.lane >> 2) & 15;
    for (int task = gw; task < T * 8 / 32; task += NGW) {
        rt_task<true>(F, task, lst);
        LDS_WAIT(); asm volatile("" ::: "memory");
#pragma unroll 1
        for (int tt = 0; tt < 4; ++tt) {
            LAS unsigned* lt = lstw + (tt * 8) * 48 + sl;
            g9_token<VAR>(F, I, out, 4 * task + tt, wl, [=](int hd) { return (int)lt[hd * 48]; }, [=](int hd) { return __uint_as_float(lt[hd * 48 + 16]); });
        }
        LDS_WAIT(); asm volatile("" ::: "memory");
    }
}

constexpr int NPHASE = 10;
struct Args { Ins in; float* out; unsigned char* ws; double inv_freq[32]; int ph_lo, ph_hi; };
__global__ void __launch_bounds__(NWAVES * 64, 2) mega_fwd(Args args) {
    extern __shared__ __attribute__((aligned(16))) unsigned char lds[];
    Frame F;
    F.lds = (LAS unsigned char*)lds;
    F.MISC = (volatile LAS unsigned*)(F.lds + MISC_OFF);
    F.tid = threadIdx.x; F.lane = F.tid & 63; F.wave = __builtin_amdgcn_readfirstlane(F.tid >> 6);
    F.G = gridDim.x; { const int bx = blockIdx.x; F.vcu = (F.G % 8 == 0) ? (bx % 8) * (F.G / 8) + bx / 8 : bx; }
    unsigned char* ws = args.ws; F.ws = ws;
    F.ctl = (gu32*)(ws + WS_CTL);
    const Ins& I = args.in;
    for (int u = F.tid; u < (LDS_BYTES - LDSCTL_OFF) / 4; u += NWAVES * 64) ((LAS unsigned*)(F.lds + LDSCTL_OFF))[u] = 0u;
    __syncthreads();
    XcdBarrier bar; bar.bar = (unsigned*)(F.ctl + CW_BAR); bar.x = 0; bar.st = nullptr;
#if MK_N_LAUNCHES == 1
    bar = xcd_barrier_post((unsigned*)(F.ctl + CW_BAR), F.MISC + 8);
#define GRID_BAR() xcd_barrier(bar)
#else
#define GRID_BAR() do {} while (0)
#endif
    const int lo = args.ph_lo, hi = args.ph_hi;
#ifdef PROBE_PH
    unsigned long long pstamp[NPHASE + 1];
#define PSTAMP(k) do { if (blockIdx.x == 0 && F.tid == 0) pstamp[k] = __builtin_amdgcn_s_memrealtime(); } while (0)
#else
#define PSTAMP(k) do {} while (0)
#endif
#ifndef PH_MASK
#define PH_MASK 0xFFFF
#endif
#define IN(k) (((PH_MASK >> (k)) & 1) && lo <= (k) && (k) < hi)
#define BOTH(k) (IN(k) && IN((k) + 1))
    float* ssq_q = (float*)(ws + WS_PSQ_Q); float* ssq_kv = (float*)(ws + WS_PSQ_KV); float* ssq2 = (float*)(ws + WS_PSQ2);
    const float* rope = (const float*)(ws + WS_ROPE);

    PSTAMP(0);
    if (IN(0)) { p0_prologue(F, I, args.inv_freq); if (BOTH(0)) GRID_BAR(); }

    PSTAMP(1);
    if (IN(1)) {
        { pg8::Gemm g{(const bf16_t*)(ws + WS_H), (const bf16_t*)(ws + WS_W1), T, N1, 2048, 2048}; pg8::StaticOrder S; S.init(T, N1, F.G, (int)blockIdx.x);
          EpiProj<0> E{(bf16_t*)(ws + WS_CQ), (bf16_t*)(ws + WS_CKV), (bf16_t*)(ws + WS_DQ), (bf16_t*)(ws + WS_DK), (bf16_t*)(ws + WS_DV), (bf16_t*)(ws + WS_G), (bf16_t*)(ws + WS_KR), ssq_q, ssq_kv, I.b_gate, rope};
          pg8::gemm_phase<EpiProj<0>, pg8::StaticOrder, PG8_ALIGN, PG8_SP2>(F.lds + RING_OFF, g, S, E); }
        {
          pg8::Gemm g{(const bf16_t*)(ws + WS_H8), (const bf16_t*)(ws + WS_W8), T, NG, 1024, 1024, 1.0f / W1_SCALE}; pg8::GateOrder S; S.init(T, NG, F.G, (int)blockIdx.x);
          EpiProj<1> E{(bf16_t*)(ws + WS_CQ), (bf16_t*)(ws + WS_CKV), (bf16_t*)(ws + WS_DQ), (bf16_t*)(ws + WS_DK), (bf16_t*)(ws + WS_DV), (bf16_t*)(ws + WS_G), (bf16_t*)(ws + WS_KR), ssq_q, ssq_kv, I.b_gate, rope};
          pg8::gemm_phase<EpiProj<1>, pg8::GateOrder, PG8_ALIGN, PG8_SP2, true>(F.lds + RING_OFF, g, S, E); }
        if (BOTH(1)) GRID_BAR();
    }
    PSTAMP(2);
    if (IN(2)) {
        { pg8::Gemm g{(const bf16_t*)(ws + WS_CQ), (const bf16_t*)(ws + WS_WUQ), T, 1536, 384, 384, 1.0f / W1_SCALE}; pg8::StaticOrder S; S.init(T, 1536, F.G, (int)blockIdx.x);
          EpiQup E{(bf16_t*)(ws + WS_QN), (bf16_t*)(ws + WS_QR), ssq_q, rope};
          pg8::gemm_phase<EpiQup, pg8::StaticOrder, PG8_ALIGN, PG8_SP2, true>(F.lds + RING_OFF, g, S, E); }
        { pg8::Gemm g{(const bf16_t*)(ws + WS_CKV), (const bf16_t*)(ws + WS_WUKV), T, 2048, 256, 256, 1.0f / W1_SCALE}; pg8::StaticOrder S; S.init(T, 2048, F.G, (int)blockIdx.x);
          EpiKVup E{(bf16_t*)(ws + WS_KN), (bf16_t*)(ws + WS_V), ssq_kv};
          pg8::gemm_phase<EpiKVup, pg8::StaticOrder, PG8_ALIGN, PG8_SP2, true>(F.lds + RING_OFF, g, S, E); }
        if (BOTH(2)) GRID_BAR();
    }
    PSTAMP(3);
#ifdef ATT_REF
    if (IN(3)) { p3_attention_ref(F, I); if (BOTH(3)) GRID_BAR(); }
#else
    if (IN(3)) { p3_attention(F, I); if (BOTH(3)) GRID_BAR(); }
#ifdef ATT_CHECK
    if (IN(3)) { p3_attention_ref(F, I); GRID_BAR(); }
#endif
#endif
    PSTAMP(4);
    if (IN(4)) {
        pg8::Gemm2 g{(const bf16_t*)(ws + WS_OM), (const bf16_t*)(ws + WS_OD), (const bf16_t*)(ws + WS_WOM), (const bf16_t*)(ws + WS_WOD), T, 2048, 1024, 1024};
        pg8::StaticOrder S; S.init(T, 2048, F.G, (int)blockIdx.x);
        EpiGate2 E{(const bf16_t*)(ws + WS_G), (bf16_t*)(ws + WS_MG)};
        pg8::gemm_phase2<EpiGate2, pg8::StaticOrder, PG8_ALIGN, PG8_SP2>(F.lds + RING_OFF, g, S, E);
        if (BOTH(4)) GRID_BAR();
    }
    PSTAMP(5);
    PSTAMP(6);
    if (IN(6)) {
#ifdef PEER_BF16
        convert_experts(F, I);
#else
#ifdef PEER_FP6
        convert_experts_fp4(F, I); convert_experts_fp6(F, I);
#else
        convert_experts_fp8(F, I);
#endif
#endif
        pg8::Gemm g{(const bf16_t*)(ws + WS_MG), (const bf16_t*)(ws + WS_WOUT), T, 2048, 2048, 2048}; pg8::StaticOrder S; S.init(T, 2048, F.G, (int)blockIdx.x);
        EpiRes E{I.x, (float*)(ws + WS_X2), (bf16_t*)(ws + WS_X2B), ssq2};
        pg8::gemm_phase<EpiRes, pg8::StaticOrder, PG8_ALIGN, PG8_SP2>(F.lds + RING_OFF, g, S, E);
        if (BOTH(6)) GRID_BAR();
    }
    PSTAMP(7);
    if (IN(7)) {
        pg8::Gemm g{(const bf16_t*)(ws + WS_X2B), (const bf16_t*)(ws + WS_WQP), T, 2048, 2048, 2048}; pg8::StaticOrder S; S.init(T, 2048, F.G, (int)blockIdx.x);
        EpiQP E{(bf16_t*)(ws + WS_QP), ssq2, (const LAS float*)(F.lds + RTAB_OFF), {-1, -1, -1, -1}};
        {
            LAS float* tab = (LAS float*)(F.lds + RTAB_OFF); pg8::Unit u;
#pragma unroll
            for (int i = 0; i < RTAB_SLOTS; ++i) {
                if (S.next(i, u)) {
                    E.pms[i] = u.pm;
                    const int r = F.tid >> 1, hf = F.tid & 1; const float* p = ssq2 + ((size_t)u.pm * 256 + r) * 32 + hf * 16;
                    const f32x4 q0 = *(const f32x4*)p, q1 = *(const f32x4*)(p + 4), q2 = *(const f32x4*)(p + 8), q3 = *(const f32x4*)(p + 12);
                    float t = (((q0[0] + q0[1]) + (q0[2] + q0[3])) + ((q1[0] + q1[1]) + (q1[2] + q1[3]))) + (((q2[0] + q2[1]) + (q2[2] + q2[3])) + ((q3[0] + q3[1]) + (q3[2] + q3[3])));
                    t += __shfl_xor(t, 1);
                    if (hf == 0) tab[i * 256 + r] = 1.0f / sqrtf(t * (1.0f / 2048.0f) + EPS);
                }
            }
            __syncthreads();
        }
        pg8::gemm_phase<EpiQP, pg8::StaticOrder, PG8_ALIGN, PG8_SP2>(F.lds + RING_OFF, g, S, E);
        if (BOTH(7)) GRID_BAR();
    }
    PSTAMP(8);
#if defined(ROUTE_REF) || defined(PEER_BF16) || defined(NO_FUSE89)
#ifdef ROUTE_REF
    if (IN(8)) { p7_routing_ref(F); if (BOTH(8)) GRID_BAR(); }
#else
    if (IN(8)) { p8_routing(F, I); if (BOTH(8)) GRID_BAR(); }
#endif
    PSTAMP(9);
#ifdef PEER_BF16
    if (IN(9)) { p8_gather(F, I, args.out); }
#else
    if (IN(9)) { p9_gather_fp8(F, I, args.out); }
#endif
#else
    if (IN(8) && IN(9)) { p89_route_gather(F, I, args.out); }
#ifdef PROBE_G9
    if (IN(8) && IN(9)) { __syncthreads(); p89_route_gather<PROBE_G9>(F, I, (float*)(ws + WS_G)); }
#endif
    PSTAMP(9);
#endif
    PSTAMP(10);
#ifdef PROBE_PH
    if (blockIdx.x == 0 && F.tid == 0) {
        const unsigned long long span = (pstamp[PROBE_PH + 1] - pstamp[PROBE_PH]) * PROBE_MUL, t0 = __builtin_amdgcn_s_memrealtime();
        while (__builtin_amdgcn_s_memrealtime() - t0 < span) __builtin_amdgcn_s_sleep(32);
    }
#endif
#undef IN
#undef BOTH
}

extern "C" void kernel_launch(void* const* d_in, const int* in_sizes, int n_in, void* d_out, int out_size, void* d_ws, size_t ws_size, hipStream_t stream) {
    static int grid = 0;
    if (grid == 0) {
        if (n_in != 19 || out_size != T * D_MODEL || ws_size < WS_END) { fprintf(stderr, "kernel_launch: unexpected shapes: n_in %d out %d ws %zu\n", n_in, out_size, ws_size); grid = -1; return; }
        int dev = 0, cus = 0, per_cu = 0;
        if (hipGetDevice(&dev) != hipSuccess || hipDeviceGetAttribute(&cus, hipDeviceAttributeMultiprocessorCount, dev) != hipSuccess) { grid = -1; return; }
        if (hipFuncSetAttribute((const void*)mega_fwd, hipFuncAttributeMaxDynamicSharedMemorySize, LDS_BYTES) != hipSuccess) { fprintf(stderr, "kernel_launch: hipFuncSetAttribute failed\n"); grid = -1; return; }
        if (hipOccupancyMaxActiveBlocksPerMultiprocessor(&per_cu, (const void*)mega_fwd, NWAVES * 64, LDS_BYTES) != hipSuccess || per_cu < 1)
            fprintf(stderr, "kernel_launch: occupancy query reports %d workgroups per CU\n", per_cu);
        (void)hipGetLastError();
        grid = cus;
    }
    if (grid < 0) return;
    if (hipMemsetAsync((char*)d_ws + WS_CTL, 0, CTL_ZERO_BYTES, stream) != hipSuccess) { fprintf(stderr, "kernel_launch: memset failed\n"); return; }
    Args a{};
    const float** ip = (const float**)&a.in;
    for (int i = 0; i < 19; ++i) ip[i] = (const float*)d_in[i];
    a.out = (float*)d_out; a.ws = (unsigned char*)d_ws;
    for (int i = 0; i < 32; ++i) a.inv_freq[i] = pow(10000.0, -(double)i / 32.0);
#if MK_N_LAUNCHES == 1
    a.ph_lo = 0; a.ph_hi = NPHASE;
    hipLaunchKernelGGL(mega_fwd, dim3(grid), dim3(NWAVES * 64), LDS_BYTES, stream, a);
#else
    for (int p = 0; p < NPHASE; ++p) { a.ph_lo = p; a.ph_hi = p + 1; hipLaunchKernelGGL(mega_fwd, dim3(grid), dim3(NWAVES * 64), LDS_BYTES, stream, a); }
#endif
    const hipError_t le = hipPeekAtLastError();
    if (le != hipSuccess) fprintf(stderr, "kernel_launch: launch failed: %s\n", hipGetErrorName(le));
}
```

```cpp
#include <hip/hip_runtime.h>
#include <cstdio>
#include <cstdint>
#include <cmath>

#ifndef MK_N_LAUNCHES
#define MK_N_LAUNCHES 1
#endif

constexpr int D_MODEL = 2048, BATCH = 2, SEQ = 8192, T = BATCH * SEQ;
constexpr int OFF_CQ = 0, OFF_CKV = 768, OFF_KR = 1280, OFF_DQ = 1344, OFF_DK = 2368, OFF_DV = 3392, OFF_GATE = 4416, IN_COLS = 8512;
constexpr int N1 = 3072;
constexpr int NG = 5632;
constexpr float W1_SCALE = 32.0f;
constexpr int NEXP = 16384;
constexpr float EPS = 1e-6f;
constexpr float LOG2E = 1.4426950408889634f;
constexpr float C2_MLA = 0.07216878364870322f * LOG2E;
constexpr float C2_DIFF = 0.125f * LOG2E;
constexpr float LAMBDA_INIT = 0.2f;

namespace pg8 {
#define PG8_LAS __attribute__((address_space(3)))
typedef unsigned short bf16_t;
typedef short bf16x8 __attribute__((ext_vector_type(8)));
typedef float f32x4 __attribute__((ext_vector_type(4)));
typedef unsigned u32x4 __attribute__((ext_vector_type(4)));
typedef unsigned u32x2 __attribute__((ext_vector_type(2)));
typedef int v8i32 __attribute__((ext_vector_type(8)));
constexpr int BM = 256, BK = 64, HALF = 128, HTB = HALF * BK * 2, STAGE_BYTES = 8 * HTB, NXCD = 8, WGM = 2;

__host__ __device__ __forceinline__ int lds_byte(int r, int c) { const int st = (r >> 4) * 2 + (c >> 5), rr = r & 15, cc = c & 31, ob = rr * 64 + cc * 2; return st * 1024 + (ob ^ (((ob >> 9) & 1) << 5)); }
__host__ __device__ __forceinline__ void stage_rc(int b, int& R, int& C) { const int st = b / 1024, sb = b % 1024, swz = sb ^ (((sb >> 9) & 1) << 5); R = (st >> 1) * 16 + swz / 64; C = (st & 1) * 32 + (swz % 64) / 2; }
__host__ __device__ __forceinline__ int perm32(int rho) { const int n = rho >> 4, i = rho & 15; return 8 * (i >> 2) + 4 * n + (i & 3); }

struct Unit { int pm, pn; };
struct Gemm { const bf16_t* A; const bf16_t* Bt; int M, N, K, lda; float oscale; };

struct StaticOrder {
    int nM, nN, nwg, G, c;
    __host__ __device__ __forceinline__ void init(int M, int N, int G_, int c_) { nM = M / BM; nN = N / BM; nwg = nM * nN; G = G_; c = c_; }
    __host__ __device__ __forceinline__ bool next(int i, Unit& u) const { return map((long)i * G + c, u); }
    __host__ __device__ __forceinline__ bool map(long L, Unit& u) const {
        if (L >= nwg) return false;
        int wgid = (int)L; { const int q = nwg / NXCD, r = nwg % NXCD, xcd = wgid % NXCD, off = wgid / NXCD; wgid = (xcd < r ? xcd * (q + 1) : r * (q + 1) + (xcd - r) * q) + off; }
        const int nig = WGM * nN, gid = wgid / nig, fm = gid * WGM, gsz = (nM - fm) < WGM ? (nM - fm) : WGM;
        u.pm = fm + ((wgid % nig) % gsz); u.pn = (wgid % nig) / gsz; return true;
    }
    __device__ __forceinline__ void a_ready(const Unit&) const {}
    __device__ __forceinline__ void done(const Unit&) const {}
};

struct GateOrder : StaticOrder {
    __host__ __device__ __forceinline__ bool next(int i, Unit& u) const {
        if (G != 256 || nwg != 1024) return StaticOrder::next(i, u);
        if (i < 3) return map((long)i * 256 + c, u);
        if (c >= 128 && i < 5) return map(768 + (long)(i - 3) * 128 + (c - 128), u);
        return false;
    }
};
typedef float f32x2_t __attribute__((ext_vector_type(2))); typedef __bf16 bf16x2_t __attribute__((ext_vector_type(2)));
__device__ __forceinline__ unsigned cvtpk(float lo, float hi) { f32x2_t v = {lo, hi}; bf16x2_t b = __builtin_convertvector(v, bf16x2_t); return __builtin_bit_cast(unsigned, b); }
__device__ __forceinline__ float bf2f(unsigned short h) { return __builtin_bit_cast(float, (unsigned)h << 16); }
__device__ __forceinline__ float bflo(unsigned w) { return __builtin_bit_cast(float, w << 16); }
__device__ __forceinline__ float bfhi(unsigned w) { return __builtin_bit_cast(float, w & 0xffff0000u); }

template <class Epi, class Sched, bool ALIGN_EPI = false, bool SP2 = false, bool FP8 = false>
__device__ __forceinline__ void gemm_phase(PG8_LAS unsigned char* lds, const Gemm g, const Sched& S, const Epi& E) {
    const int tid = threadIdx.x, wid = __builtin_amdgcn_readfirstlane(tid >> 6), lane = tid & 63, wr = wid >> 2, wc = wid & 3, fr = lane & 15, fq = lane >> 4;
    const int K = g.K, nt = K / BK, lda = g.lda;
    unsigned voffA[2], voffB[2];
#pragma unroll
    for (int i = 0; i < 2; ++i) { int R, C; stage_rc(tid * 16 + i * 8192, R, C); const int Rb = Epi::PERM ? ((R & ~31) + perm32(R & 31)) : R;
        voffA[i] = (unsigned)(R * lda + C) * 2u; voffB[i] = (unsigned)(Rb * K + C) * 2u; }
    const size_t kstep = (size_t)(BK * 2);
    const size_t hstepA = (size_t)HALF * lda * 2, hstepB = (size_t)HALF * K * 2;
    const size_t tstepA = 2 * hstepA, tstepB = 2 * hstepB;
    const unsigned ldsw = (unsigned)wid * 1024u;
    const int aoff = lds_byte(wr * 64 + fr, fq * 8), boff = lds_byte(wc * 32 + fr, fq * 8);
    const int aoff8 = lds_byte(wr * 64 + fr, 16 * fq) & ~31, boff8 = lds_byte(wc * 32 + fr, 16 * fq) & ~31;
#define PG8_SA(b, h) (((b) * 2 + (h)) * HTB)
#define PG8_SB(b, h) ((4 + (b) * 2 + (h)) * HTB)
#define PG8_STAGE(bufoff, gbase, voff) do { _Pragma("unroll") for (int _i = 0; _i < 2; ++_i) \
        __builtin_amdgcn_global_load_lds((const unsigned*)((const char*)(gbase) + (voff)[_i]), (PG8_LAS unsigned*)(lds + (bufoff) + ldsw + _i * 8192), 16, 0, 0); } while (0)
#define PG8_LDA(dst, b, h) do { _Pragma("unroll") for (int m = 0; m < 4; ++m) _Pragma("unroll") for (int k = 0; k < 2; ++k) { if constexpr (FP8) { if (k == 0) dst##8[m] = *(const PG8_LAS v8i32*)(lds + PG8_SA(b, h) + aoff8 + m * 2048); } else dst[m][k] = *(const PG8_LAS bf16x8*)(lds + PG8_SA(b, h) + aoff + m * 2048 + k * 1024); } } while (0)
#define PG8_LDB(dst, b, h) do { _Pragma("unroll") for (int n = 0; n < 2; ++n) _Pragma("unroll") for (int k = 0; k < 2; ++k) { if constexpr (FP8) { if (k == 0) dst##8[n] = *(const PG8_LAS v8i32*)(lds + PG8_SB(b, h) + boff8 + n * 2048); } else dst[n][k] = *(const PG8_LAS bf16x8*)(lds + PG8_SB(b, h) + boff + n * 2048 + k * 1024); } } while (0)
#define PG8_MMA(ai, bj, At, Bt) do { __builtin_amdgcn_s_setprio(1); _Pragma("unroll") for (int m = 0; m < 4; ++m) _Pragma("unroll") for (int n = 0; n < 2; ++n) { if constexpr (FP8) { \
        asm volatile("v_mfma_scale_f32_16x16x128_f8f6f4 %0, %1, %2, %0, %3, %3 op_sel_hi:[0,0,0]" : "+v"(acc[ai][bj][m][n]) : "v"(Bt##8[n]), "v"(At##8[m]), "v"(mxs));   \
        } else { _Pragma("unroll") for (int k = 0; k < 2; ++k) \
        acc[ai][bj][m][n] = __builtin_amdgcn_mfma_f32_16x16x32_bf16(Bt[n][k], At[m][k], acc[ai][bj][m][n], 0, 0, 0); } } __builtin_amdgcn_s_setprio(0); } while (0)
#define PG8_WAIT_V(n) asm volatile("s_waitcnt vmcnt(" #n ")" ::: "memory")
#define PG8_WAIT_L(n) asm volatile("s_waitcnt lgkmcnt(" #n ")" ::: "memory")
#define PG8_BAR __builtin_amdgcn_s_barrier()
#define PG8_SCHED __builtin_amdgcn_sched_barrier(0)
    Unit cur, nxt; int ui = 0;
    if (!S.next(0, cur)) return;
    f32x4 acc[2][2][4][2];
#pragma unroll
    for (int a = 0; a < 2; ++a)
#pragma unroll
        for (int b = 0; b < 2; ++b)
#pragma unroll
            for (int m = 0; m < 4; ++m)
#pragma unroll
                for (int n = 0; n < 2; ++n) acc[a][b][m][n] = (f32x4){0.f, 0.f, 0.f, 0.f};
    bf16x8 At[4][2], B0[2][2], B1[2][2];
    v8i32 At8[4], B08[2], B18[2];
    const int mxs = 0x7F7F7F7F;
    const char* cA = (const char*)g.A + (size_t)cur.pm * tstepA; const char* cB = (const char*)g.Bt + (size_t)cur.pn * tstepB;
    S.a_ready(cur);
    if constexpr (SP2) {
        PG8_STAGE(PG8_SB(0, 0), cB, voffB); PG8_STAGE(PG8_SB(0, 1), cB + hstepB, voffB); PG8_STAGE(PG8_SA(0, 0), cA, voffA); PG8_STAGE(PG8_SA(0, 1), cA + hstepA, voffA);
        if (wr == 1) PG8_BAR;
        PG8_WAIT_V(2); PG8_BAR;
        PG8_STAGE(PG8_SB(1, 0), cB + kstep, voffB); PG8_STAGE(PG8_SA(1, 0), cA + kstep, voffA); PG8_STAGE(PG8_SB(1, 1), cB + hstepB + kstep, voffB);
        PG8_WAIT_V(6); PG8_BAR;
    } else {
        PG8_STAGE(PG8_SB(0, 0), cB, voffB); PG8_STAGE(PG8_SA(0, 0), cA, voffA); PG8_STAGE(PG8_SB(0, 1), cB + hstepB, voffB); PG8_STAGE(PG8_SA(0, 1), cA + hstepA, voffA);
        if (wr == 1) PG8_BAR;
        PG8_WAIT_V(4); PG8_BAR;
        PG8_STAGE(PG8_SB(1, 0), cB + kstep, voffB); PG8_STAGE(PG8_SA(1, 0), cA + kstep, voffA); PG8_STAGE(PG8_SB(1, 1), cB + hstepB + kstep, voffB);
        PG8_WAIT_V(6); PG8_BAR;
    }
    for (;;) {
        const bool has_next = S.next(ui + 1, nxt);
        const char* nA = has_next ? (const char*)g.A + (size_t)nxt.pm * tstepA : cA; const char* nB = has_next ? (const char*)g.Bt + (size_t)nxt.pn * tstepB : cB;
        for (int t = 0; t < nt; t += 2) {
            const bool last = (t == nt - 2);
            const char* a1 = cA + (size_t)(t + 1) * kstep;
            const char* a2 = last ? nA : cA + (size_t)(t + 2) * kstep; const char* b2 = last ? nB : cB + (size_t)(t + 2) * kstep;
            const char* a3 = a2 + kstep; const char* b3 = b2 + kstep;
            if (last && has_next) S.a_ready(nxt);
            if constexpr (SP2) {
            PG8_LDB(B0, 0, 0); PG8_LDB(B1, 0, 1); PG8_SCHED; PG8_LDA(At, 0, 0); PG8_STAGE(PG8_SA(1, 1), a1 + hstepA, voffA);
            PG8_WAIT_V(8); PG8_WAIT_L(0); PG8_BAR; PG8_MMA(0, 0, At, B0); PG8_MMA(0, 1, At, B1); PG8_BAR; PG8_SCHED;
            PG8_LDA(At, 0, 1); PG8_STAGE(PG8_SB(0, 0), b2, voffB); PG8_STAGE(PG8_SB(0, 1), b2 + hstepB, voffB); PG8_STAGE(PG8_SA(0, 0), a2, voffA);
            PG8_WAIT_V(8); PG8_WAIT_L(0); PG8_BAR; PG8_MMA(1, 0, At, B0); PG8_MMA(1, 1, At, B1); PG8_BAR; PG8_SCHED;
            PG8_LDB(B0, 1, 0); PG8_LDB(B1, 1, 1); PG8_SCHED; PG8_LDA(At, 1, 0); PG8_STAGE(PG8_SA(0, 1), a2 + hstepA, voffA);
            PG8_WAIT_V(8); PG8_WAIT_L(0); PG8_BAR; PG8_MMA(0, 0, At, B0); PG8_MMA(0, 1, At, B1); PG8_BAR; PG8_SCHED;
            PG8_LDA(At, 1, 1); PG8_STAGE(PG8_SB(1, 0), b3, voffB); PG8_STAGE(PG8_SB(1, 1), b3 + hstepB, voffB); PG8_STAGE(PG8_SA(1, 0), a3, voffA);
            PG8_WAIT_V(8); PG8_WAIT_L(0); PG8_BAR; PG8_MMA(1, 0, At, B0); PG8_MMA(1, 1, At, B1); PG8_BAR; PG8_SCHED;
            } else {
            PG8_LDB(B0, 0, 0); PG8_SCHED; PG8_LDA(At, 0, 0); PG8_STAGE(PG8_SA(1, 1), a1 + hstepA, voffA);
            PG8_WAIT_L(8); PG8_BAR; PG8_WAIT_L(0); PG8_MMA(0, 0, At, B0); PG8_BAR; PG8_SCHED;
            PG8_LDB(B1, 0, 1); PG8_STAGE(PG8_SB(0, 0), b2, voffB);
            PG8_BAR; PG8_WAIT_L(0); PG8_MMA(0, 1, At, B1); PG8_BAR;
            PG8_LDA(At, 0, 1); PG8_STAGE(PG8_SA(0, 0), a2, voffA);
            PG8_BAR; PG8_WAIT_L(0); PG8_MMA(1, 0, At, B0); PG8_BAR; PG8_SCHED;
            PG8_STAGE(PG8_SB(0, 1), b2 + hstepB, voffB);
            PG8_WAIT_V(6); PG8_BAR; PG8_MMA(1, 1, At, B1); PG8_BAR;
            PG8_LDB(B0, 1, 0); PG8_SCHED; PG8_LDA(At, 1, 0); PG8_STAGE(PG8_SA(0, 1), a2 + hstepA, voffA);
            PG8_WAIT_L(8); PG8_BAR; PG8_WAIT_L(0); PG8_MMA(0, 0, At, B0); PG8_BAR; PG8_SCHED;
            PG8_LDB(B1, 1, 1); PG8_STAGE(PG8_SB(1, 0), b3, voffB);
            PG8_BAR; PG8_WAIT_L(0); PG8_MMA(0, 1, At, B1); PG8_BAR;
            PG8_LDA(At, 1, 1); PG8_STAGE(PG8_SA(1, 0), a3, voffA);
            PG8_BAR; PG8_WAIT_L(0); PG8_MMA(1, 0, At, B0); PG8_BAR; PG8_SCHED;
            PG8_STAGE(PG8_SB(1, 1), b3 + hstepB, voffB);
            PG8_WAIT_V(6); PG8_BAR; PG8_MMA(1, 1, At, B1); PG8_BAR;
            }
        }
        if constexpr (ALIGN_EPI) { if (wr == 0) PG8_BAR; }
        if constexpr (FP8) {
            asm volatile("s_nop 15\n\ts_nop 7" ::: "memory");
#pragma unroll
            for (int a = 0; a < 2; ++a)
#pragma unroll
                for (int b = 0; b < 2; ++b)
#pragma unroll
                    for (int m = 0; m < 4; ++m)
#pragma unroll
                        for (int n = 0; n < 2; ++n) acc[a][b][m][n] *= g.oscale; }
        E(acc, cur, wr, wc, fr, fq); S.done(cur);
        if (!has_next) break;
#pragma unroll
        for (int a = 0; a < 2; ++a)
#pragma unroll
            for (int b = 0; b < 2; ++b)
#pragma unroll
                for (int m = 0; m < 4; ++m)
#pragma unroll
                    for (int n = 0; n < 2; ++n) acc[a][b][m][n] = (f32x4){0.f, 0.f, 0.f, 0.f};
        cur = nxt; cA = nA; cB = nB; ++ui;
        if constexpr (ALIGN_EPI) { if (wr == 1) PG8_BAR; }
    }
    PG8_WAIT_V(0);
    if constexpr (!ALIGN_EPI) { if (wr == 0) PG8_BAR; }
    PG8_BAR;
#undef PG8_SA
#undef PG8_SB
#undef PG8_STAGE
#undef PG8_LDA
#undef PG8_LDB
#undef PG8_MMA
#undef PG8_WAIT_V
#undef PG8_WAIT_L
#undef PG8_BAR
#undef PG8_SCHED
}
struct Gemm2 { const bf16_t *A1, *A2, *B1, *B2; int M, N, K1, lda; };
template <class Epi, class Sched, bool ALIGN_EPI = false, bool SP2 = false>
__device__ __forceinline__ void gemm_phase2(PG8_LAS unsigned char* lds, const Gemm2 g, const Sched& S, const Epi& E) {
    const int tid = threadIdx.x, wid = __builtin_amdgcn_readfirstlane(tid >> 6), lane = tid & 63, wr = wid >> 2, wc = wid & 3, fr = lane & 15, fq = lane >> 4;
    const int K = g.K1, nt = K / BK, lda = g.lda;
    unsigned voffA[2], voffB[2];
#pragma unroll
    for (int i = 0; i < 2; ++i) { int R, C; stage_rc(tid * 16 + i * 8192, R, C); const int Rb = Epi::PERM ? ((R & ~31) + perm32(R & 31)) : R;
        voffA[i] = (unsigned)(R * lda + C) * 2u; voffB[i] = (unsigned)(Rb * K + C) * 2u; }
    const size_t kstep = (size_t)(BK * 2);
    const size_t hstepA = (size_t)HALF * lda * 2, hstepB = (size_t)HALF * K * 2;
    const size_t tstepA = 2 * hstepA, tstepB = 2 * hstepB;
    const unsigned ldsw = (unsigned)wid * 1024u;
    const int aoff = lds_byte(wr * 64 + fr, fq * 8), boff = lds_byte(wc * 32 + fr, fq * 8);
#define PG8_SA(b, h) (((b) * 2 + (h)) * HTB)
#define PG8_SB(b, h) ((4 + (b) * 2 + (h)) * HTB)
#define PG8_STAGE(bufoff, gbase, voff) do { _Pragma("unroll") for (int _i = 0; _i < 2; ++_i) \
        __builtin_amdgcn_global_load_lds((const unsigned*)((const char*)(gbase) + (voff)[_i]), (PG8_LAS unsigned*)(lds + (bufoff) + ldsw + _i * 8192), 16, 0, 0); } while (0)
#define PG8_LDA(dst, b, h) do { _Pragma("unroll") for (int m = 0; m < 4; ++m) _Pragma("unroll") for (int k = 0; k < 2; ++k) dst[m][k] = *(const PG8_LAS bf16x8*)(lds + PG8_SA(b, h) + aoff + m * 2048 + k * 1024); } while (0)
#define PG8_LDB(dst, b, h) do { _Pragma("unroll") for (int n = 0; n < 2; ++n) _Pragma("unroll") for (int k = 0; k < 2; ++k) dst[n][k] = *(const PG8_LAS bf16x8*)(lds + PG8_SB(b, h) + boff + n * 2048 + k * 1024); } while (0)
#define PG8_MMA(ai, bj, At, Bt) do { __builtin_amdgcn_s_setprio(1); _Pragma("unroll") for (int m = 0; m < 4; ++m) _Pragma("unroll") for (int n = 0; n < 2; ++n) _Pragma("unroll") for (int k = 0; k < 2; ++k) \
        acc[ai][bj][m][n] = __builtin_amdgcn_mfma_f32_16x16x32_bf16(Bt[n][k], At[m][k], acc[ai][bj][m][n], 0, 0, 0); __builtin_amdgcn_s_setprio(0); } while (0)
#define PG8_WAIT_V(n) asm volatile("s_waitcnt vmcnt(" #n ")" ::: "memory")
#define PG8_WAIT_L(n) asm volatile("s_waitcnt lgkmcnt(" #n ")" ::: "memory")
#define PG8_BAR __builtin_amdgcn_s_barrier()
#define PG8_SCHED __builtin_amdgcn_sched_barrier(0)
    Unit cur, nxt; int ui = 0;
    if (!S.next(0, cur)) return;
    f32x4 acc[2][2][4][2];
#pragma unroll
    for (int a = 0; a < 2; ++a)
#pragma unroll
        for (int b = 0; b < 2; ++b)
#pragma unroll
            for (int m = 0; m < 4; ++m)
#pragma unroll
                for (int n = 0; n < 2; ++n) acc[a][b][m][n] = (f32x4){0.f, 0.f, 0.f, 0.f};
    bf16x8 At[4][2], B0[2][2], B1[2][2];
    const char* cA = (const char*)g.A1 + (size_t)cur.pm * tstepA; const char* cB = (const char*)g.B1 + (size_t)cur.pn * tstepB;
    S.a_ready(cur);
    if constexpr (SP2) {
        PG8_STAGE(PG8_SB(0, 0), cB, voffB); PG8_STAGE(PG8_SB(0, 1), cB + hstepB, voffB); PG8_STAGE(PG8_SA(0, 0), cA, voffA); PG8_STAGE(PG8_SA(0, 1), cA + hstepA, voffA);
        if (wr == 1) PG8_BAR;
        PG8_WAIT_V(2); PG8_BAR;
        PG8_STAGE(PG8_SB(1, 0), cB + kstep, voffB); PG8_STAGE(PG8_SA(1, 0), cA + kstep, voffA); PG8_STAGE(PG8_SB(1, 1), cB + hstepB + kstep, voffB);
        PG8_WAIT_V(6); PG8_BAR;
    } else {
        PG8_STAGE(PG8_SB(0, 0), cB, voffB); PG8_STAGE(PG8_SA(0, 0), cA, voffA); PG8_STAGE(PG8_SB(0, 1), cB + hstepB, voffB); PG8_STAGE(PG8_SA(0, 1), cA + hstepA, voffA);
        if (wr == 1) PG8_BAR;
        PG8_WAIT_V(4); PG8_BAR;
        PG8_STAGE(PG8_SB(1, 0), cB + kstep, voffB); PG8_STAGE(PG8_SA(1, 0), cA + kstep, voffA); PG8_STAGE(PG8_SB(1, 1), cB + hstepB + kstep, voffB);
        PG8_WAIT_V(6); PG8_BAR;
    }
    for (;;) {
        const int nhalf = (ui + 1) & 1;
        const bool has_next = S.next((ui + 1) >> 1, nxt);
        const char* nA = has_next ? (const char*)(nhalf ? g.A2 : g.A1) + (size_t)nxt.pm * tstepA : cA; const char* nB = has_next ? (const char*)(nhalf ? g.B2 : g.B1) + (size_t)nxt.pn * tstepB : cB;
        for (int t = 0; t < nt; t += 2) {
            const bool last = (t == nt - 2);
            const char* a1 = cA + (size_t)(t + 1) * kstep;
            const char* a2 = last ? nA : cA + (size_t)(t + 2) * kstep; const char* b2 = last ? nB : cB + (size_t)(t + 2) * kstep;
            const char* a3 = a2 + kstep; const char* b3 = b2 + kstep;
            if (last && has_next) S.a_ready(nxt);
            if constexpr (SP2) {
            PG8_LDB(B0, 0, 0); PG8_LDB(B1, 0, 1); PG8_SCHED; PG8_LDA(At, 0, 0); PG8_STAGE(PG8_SA(1, 1), a1 + hstepA, voffA);
            PG8_WAIT_V(8); PG8_WAIT_L(0); PG8_BAR; PG8_MMA(0, 0, At, B0); PG8_MMA(0, 1, At, B1); PG8_BAR; PG8_SCHED;
            PG8_LDA(At, 0, 1); PG8_STAGE(PG8_SB(0, 0), b2, voffB); PG8_STAGE(PG8_SB(0, 1), b2 + hstepB, voffB); PG8_STAGE(PG8_SA(0, 0), a2, voffA);
            PG8_WAIT_V(8); PG8_WAIT_L(0); PG8_BAR; PG8_MMA(1, 0, At, B0); PG8_MMA(1, 1, At, B1); PG8_BAR; PG8_SCHED;
            PG8_LDB(B0, 1, 0); PG8_LDB(B1, 1, 1); PG8_SCHED; PG8_LDA(At, 1, 0); PG8_STAGE(PG8_SA(0, 1), a2 + hstepA, voffA);
            PG8_WAIT_V(8); PG8_WAIT_L(0); PG8_BAR; PG8_MMA(0, 0, At, B0); PG8_MMA(0, 1, At, B1); PG8_BAR; PG8_SCHED;
            PG8_LDA(At, 1, 1); PG8_STAGE(PG8_SB(1, 0), b3, voffB); PG8_STAGE(PG8_SB(1, 1), b3 + hstepB, voffB); PG8_STAGE(PG8_SA(1, 0), a3, voffA);
            PG8_WAIT_V(8); PG8_WAIT_L(0); PG8_BAR; PG8_MMA(1, 0, At, B0); PG8_MMA(1, 1, At, B1); PG8_BAR; PG8_SCHED;
            } else {
            PG8_LDB(B0, 0, 0); PG8_SCHED; PG8_LDA(At, 0, 0); PG8_STAGE(PG8_SA(1, 1), a1 + hstepA, voffA);
            PG8_WAIT_L(8); PG8_BAR; PG8_WAIT_L(0); PG8_MMA(0, 0, At, B0); PG8_BAR; PG8_SCHED;
            PG8_LDB(B1, 0, 1); PG8_STAGE(PG8_SB(0, 0), b2, voffB);
            PG8_BAR; PG8_WAIT_L(0); PG8_MMA(0, 1, At, B1); PG8_BAR;
            PG8_LDA(At, 0, 1); PG8_STAGE(PG8_SA(0, 0), a2, voffA);
            PG8_BAR; PG8_WAIT_L(0); PG8_MMA(1, 0, At, B0); PG8_BAR; PG8_SCHED;
            PG8_STAGE(PG8_SB(0, 1), b2 + hstepB, voffB);
            PG8_WAIT_V(6); PG8_BAR; PG8_MMA(1, 1, At, B1); PG8_BAR;
            PG8_LDB(B0, 1, 0); PG8_SCHED; PG8_LDA(At, 1, 0); PG8_STAGE(PG8_SA(0, 1), a2 + hstepA, voffA);
            PG8_WAIT_L(8); PG8_BAR; PG8_WAIT_L(0); PG8_MMA(0, 0, At, B0); PG8_BAR; PG8_SCHED;
            PG8_LDB(B1, 1, 1); PG8_STAGE(PG8_SB(1, 0), b3, voffB);
            PG8_BAR; PG8_WAIT_L(0); PG8_MMA(0, 1, At, B1); PG8_BAR;
            PG8_LDA(At, 1, 1); PG8_STAGE(PG8_SA(1, 0), a3, voffA);
            PG8_BAR; PG8_WAIT_L(0); PG8_MMA(1, 0, At, B0); PG8_BAR; PG8_SCHED;
            PG8_STAGE(PG8_SB(1, 1), b3 + hstepB, voffB);
            PG8_WAIT_V(6); PG8_BAR; PG8_MMA(1, 1, At, B1); PG8_BAR;
            }
        }
        if constexpr (ALIGN_EPI) { if (wr == 0) PG8_BAR; }
        if ((ui & 1) == 0) E.mid(acc, cur, wr, wc, fr, fq); else { E(acc, cur, wr, wc, fr, fq); S.done(cur); }
        if (!has_next) break;
        if (ui & 1)
#pragma unroll
        for (int a = 0; a < 2; ++a)
#pragma unroll
            for (int b = 0; b < 2; ++b)
#pragma unroll
                for (int m = 0; m < 4; ++m)
#pragma unroll
                    for (int n = 0; n < 2; ++n) acc[a][b][m][n] = (f32x4){0.f, 0.f, 0.f, 0.f};
        cur = nxt; cA = nA; cB = nB; ++ui;
        if constexpr (ALIGN_EPI) { if (wr == 1) PG8_BAR; }
    }
    PG8_WAIT_V(0);
    if constexpr (!ALIGN_EPI) { if (wr == 0) PG8_BAR; }
    PG8_BAR;
#undef PG8_SA
#undef PG8_SB
#undef PG8_STAGE
#undef PG8_LDA
#undef PG8_LDB
#undef PG8_MMA
#undef PG8_WAIT_V
#undef PG8_WAIT_L
#undef PG8_BAR
#undef PG8_SCHED
}
}

#ifndef PG8_SP2
#define PG8_SP2 true
#endif
#ifndef PG8_ALIGN
#define PG8_ALIGN true
#endif

using pg8::bf16_t; using pg8::f32x4; using pg8::u32x4; using pg8::u32x2; using pg8::cvtpk; using pg8::bf2f; using pg8::bflo; using pg8::bfhi;

constexpr size_t MiB = 1u << 20;
constexpr size_t WS_CTL = 0, CTL_ZERO_BYTES = 32 * 1024;
constexpr size_t WS_ROPE = 1 * MiB;
constexpr size_t WS_WUQ = 3 * MiB, WS_WUKV = 6 * MiB, WS_WOM = 8 * MiB, WS_WOD = 12 * MiB, WS_WOUT = 16 * MiB, WS_WQP = 24 * MiB;
constexpr size_t WS_SKB = 5 * MiB + 512 * 1024;
constexpr size_t WS_W1 = 32 * MiB;
constexpr size_t WS_W8 = 44 * MiB;
constexpr size_t WS_H8 = 396 * MiB;
constexpr size_t WS_H = 66 * MiB;
constexpr size_t WS_CQ = 130 * MiB, WS_CKV = 154 * MiB;
constexpr size_t WS_KR = 170 * MiB, WS_DQ = 172 * MiB, WS_DK = 204 * MiB, WS_DV = 236 * MiB;
constexpr size_t WS_G = 268 * MiB;
constexpr size_t WS_QN = 32 * MiB, WS_QR = 64 * MiB, WS_KN = 80 * MiB, WS_V = 396 * MiB;
constexpr size_t WS_OM = 112 * MiB, WS_OD = 428 * MiB;
constexpr size_t WS_TMP = 32 * MiB;
constexpr size_t WS_MG = 172 * MiB;
constexpr size_t WS_X2 = 268 * MiB;
constexpr size_t WS_X2B = 396 * MiB;
#ifndef PEER_U4
#define PEER_U4 1
#endif
#ifndef PEER_V4
#define PEER_V4 1
#endif
#ifndef ATT_BGCONV
#define ATT_BGCONV (PEER_U4 && PEER_V4)
#endif
constexpr size_t WS_EU = (ATT_BGCONV ? 48 : 32) * MiB, WS_EV = 96 * MiB;
constexpr size_t WS_QP = 172 * MiB;
constexpr size_t WS_IDX = 236 * MiB, WS_GT = 244 * MiB;
constexpr size_t WS_PSQ_Q = 460 * MiB, WS_PSQ_KV = 461 * MiB, WS_PSQ2 = 462 * MiB;
constexpr size_t WS_END = 464 * MiB;
constexpr int CW_TMO = 0, CW_CODE = 1, CW_LAMBDA = 8, CW_TOKCTR = 64;
constexpr int CW_BAR = 4096;

constexpr int RING_OFF = 0, RING_BYTES = 131072;
constexpr int LDSCTL_OFF = RING_BYTES, MISC_OFF = LDSCTL_OFF + 320;
constexpr int LDS_BYTES = 147456;
constexpr int NWAVES = 8;

#define GAS __attribute__((address_space(1)))
#define LAS __attribute__((address_space(3)))
typedef unsigned short bf16;
typedef unsigned v4u __attribute__((ext_vector_type(4)));
typedef GAS unsigned gu32;
#define RLX_AGENT __ATOMIC_RELAXED, __HIP_MEMORY_SCOPE_AGENT
#define LDS_WAIT() asm volatile("s_waitcnt lgkmcnt(0)" ::: "memory")
#define VM_WAIT() asm volatile("s_waitcnt vmcnt(0)" ::: "memory")

#define XB_TMO      128
#define XB_XCNT(j)  (256  + 64 * (j))
#define XB_XSUB(j)  (1280 + 64 * (j))
#define XB_XGEN(j)  (2304 + 64 * (j))
#define XB_TOP      3328
#define XB_TOPGEN   3392
#define XCD_BAR_WORDS 3456
#define XB_SPIN_CAP (1u << 22)
__device__ __forceinline__ unsigned xb_ld(unsigned* p)              { return __hip_atomic_load(p, __ATOMIC_RELAXED, __HIP_MEMORY_SCOPE_AGENT); }
__device__ __forceinline__ unsigned xb_add(unsigned* p, unsigned v) { return __hip_atomic_fetch_add(p, v, __ATOMIC_RELAXED, __HIP_MEMORY_SCOPE_AGENT); }
__device__ __forceinline__ unsigned xb_xcc_id() { return (unsigned)__builtin_amdgcn_s_getreg((3 << 11) | 20) & 0xFu; }
#define XB_SPIN(cond, bar) do { unsigned _sp = 0; while (cond) { __builtin_amdgcn_s_sleep(1); \
    if ((++_sp & 255u) == 0u) { if (xb_ld(&(bar)[XB_TMO])) break; if (_sp > XB_SPIN_CAP) { atomicAdd(&(bar)[XB_TMO], 1u); break; } } } } while (0)
struct XcdBarrier { unsigned* bar; unsigned x; volatile LAS unsigned* st; };
__device__ __forceinline__ XcdBarrier xcd_barrier_post(unsigned* bar, volatile LAS unsigned* st) {
    XcdBarrier b; b.bar = bar; b.x = xb_xcc_id(); b.st = st;
    if (threadIdx.x == 0) (void)xb_add(&bar[XB_XCNT(b.x)], 1u);
    return b;
}
__device__ __forceinline__ void xcd_barrier_complete(unsigned* bar, unsigned x, unsigned& nloc, unsigned& nx) {
    const unsigned G = gridDim.x * gridDim.y * gridDim.z;
    unsigned sum, cnt, mine, sp = 0u;
    for (;;) {
        sum = 0u; cnt = 0u; mine = 0u;
#pragma unroll
        for (unsigned j = 0; j < 16; ++j) { const unsigned c = xb_ld(&bar[XB_XCNT(j)]); sum += c; cnt += (c > 0u) ? 1u : 0u; mine = (j == x) ? c : mine; }
        if (sum == G) break;
        __builtin_amdgcn_s_sleep(1);
        if ((++sp & 255u) == 0u) { if (xb_ld(&bar[XB_TMO])) break; if (sp > XB_SPIN_CAP) { atomicAdd(&bar[XB_TMO], 1u); break; } }
    }
    nloc = mine > 0u ? mine : 1u; nx = cnt > 0u ? cnt : 1u;
}
__device__ __forceinline__ void xcd_barrier(const XcdBarrier& b) {
    asm volatile("s_waitcnt vmcnt(0)" ::: "memory");
    __syncthreads();
    if (threadIdx.x == 0) {
        unsigned* bar = b.bar;
        __builtin_amdgcn_s_waitcnt(0);
        unsigned nloc = b.st[0], nx = b.st[1];
        if (nloc == 0u) { xcd_barrier_complete(bar, b.x, nloc, nx); b.st[0] = nloc; b.st[1] = nx; }
        const unsigned old = xb_add(&bar[XB_XSUB(b.x)], 1u);
        const unsigned gen = old / nloc;
        if (old + 1u == (gen + 1u) * nloc) {
            __builtin_amdgcn_fence(__ATOMIC_RELEASE, "agent");
            asm volatile("s_waitcnt vmcnt(0)" ::: "memory");
            const unsigned og = xb_add(&bar[XB_TOP], 1u);
            const unsigned tg = og / nx;
            if (og + 1u == (tg + 1u) * nx) xb_add(&bar[XB_TOPGEN], 1u);
            else XB_SPIN(xb_ld(&bar[XB_TOPGEN]) == tg, bar);
            __builtin_amdgcn_fence(__ATOMIC_ACQUIRE, "agent");
            xb_add(&bar[XB_XGEN(b.x)], 1u);
            asm volatile("s_waitcnt vmcnt(0)" ::: "memory");
        } else {
            XB_SPIN(xb_ld(&bar[XB_XGEN(b.x)]) == gen, bar);
            __builtin_amdgcn_fence(__ATOMIC_ACQUIRE, "agent");
            asm volatile("s_waitcnt vmcnt(0)" ::: "memory");
        }
    }
    __syncthreads();
}

struct Frame {
    LAS unsigned char* lds;
    volatile LAS unsigned* MISC;
    gu32* ctl;
    unsigned char* ws;
    int tid, lane, wave, vcu, G;
};

__device__ __forceinline__ float wave_sum(float v) {
#pragma unroll
    for (int o = 1; o < 64; o <<= 1) v += __shfl_xor(v, o);
    return v;
}
__device__ __forceinline__ float wave_max(float v) {
#pragma unroll
    for (int o = 1; o < 64; o <<= 1) v = fmaxf(v, __shfl_xor(v, o));
    return v;
}
__device__ __forceinline__ unsigned pk2(float lo, float hi) { return cvtpk(lo, hi); }

template <class Map>
__device__ __forceinline__ void tr_item(const float* W, int Nsrc, int K, const float* kscale, bf16* WT, LAS float* scr, int item, int nblk, int lane, Map map) {
    const int kb = item / nblk, nb = item % nblk, k0 = 64 * kb, n0 = 32 * nb;
    const int sc = map(n0 + (lane & 31));
    float tv[32];
    const int scc = sc >= 0 ? sc : 0;
#pragma unroll
    for (int i = 0; i < 32; ++i) { const int kk = 2 * i + (lane >> 5); tv[i] = W[(size_t)(k0 + kk) * Nsrc + scc]; }
#pragma unroll
    for (int i = 0; i < 32; ++i) { const int kk = 2 * i + (lane >> 5); float v = sc >= 0 ? tv[i] : 0.f; if (kscale) v *= kscale[k0 + kk]; scr[kk * 33 + (lane & 31)] = v; }
    LDS_WAIT(); asm volatile("" ::: "memory");
    const int c = lane & 7;
#pragma unroll
    for (int j = 0; j < 4; ++j) { const int n = (lane >> 3) + 8 * j; const LAS float* s = scr + (8 * c) * 33 + n;
        v4u o; o.x = pk2(s[0 * 33], s[1 * 33]); o.y = pk2(s[2 * 33], s[3 * 33]); o.z = pk2(s[4 * 33], s[5 * 33]); o.w = pk2(s[6 * 33], s[7 * 33]);
        *(GAS v4u*)(WT + (size_t)(n0 + n) * K + k0 + 8 * c) = o; }
    LDS_WAIT(); asm volatile("" ::: "memory");
}
template <class Map>
__device__ __forceinline__ void tr_item8(const float* W, int Nsrc, int K, const float* kscale, float wscale, unsigned char* WT8, LAS float* scr, int item, int nblk, int lane, Map map) {
    const int kb = item / nblk, nb = item % nblk, k0 = 64 * kb, n0 = 32 * nb;
    const int sc = map(n0 + (lane & 31));
    float tv[32];
    const int scc = sc >= 0 ? sc : 0;
#pragma unroll
    for (int i = 0; i < 32; ++i) { const int kk = 2 * i + (lane >> 5); tv[i] = W[(size_t)(k0 + kk) * Nsrc + scc]; }
#pragma unroll
    for (int i = 0; i < 32; ++i) { const int kk = 2 * i + (lane >> 5); float v = sc >= 0 ? tv[i] * wscale : 0.f; if (kscale) v *= kscale[k0 + kk]; scr[kk * 33 + (lane & 31)] = v; }
    LDS_WAIT(); asm volatile("" ::: "memory");
    const int c = lane & 7;
#pragma unroll
    for (int j = 0; j < 4; ++j) { const int n = (lane >> 3) + 8 * j; const LAS float* s = scr + (8 * c) * 33 + n;
        u32x2 o; o.x = (unsigned)__builtin_amdgcn_cvt_pk_fp8_f32(s[2 * 33], s[3 * 33], __builtin_amdgcn_cvt_pk_fp8_f32(s[0 * 33], s[1 * 33], 0, false), true);
        o.y = (unsigned)__builtin_amdgcn_cvt_pk_fp8_f32(s[6 * 33], s[7 * 33], __builtin_amdgcn_cvt_pk_fp8_f32(s[4 * 33], s[5 * 33], 0, false), true);
        *(GAS u32x2*)(WT8 + (size_t)(n0 + n) * K + k0 + 8 * c) = o; }
    LDS_WAIT(); asm volatile("" ::: "memory");
}
__device__ __forceinline__ int rope_src(int jj) { return (jj & 1) * 32 + (jj >> 1); }
struct MapW1 { __device__ int operator()(int n) const {
    if (n < 1024) return OFF_DQ + (n & ~63) + rope_src(n & 63);
    if (n < 2048) { const int j = n - 1024; return OFF_DK + (j & ~63) + rope_src(j & 63); }
    return OFF_DV + (n - 2048); } };
struct MapGate { __device__ int operator()(int n) const {
    if (n < 4096) return OFF_GATE + ((n >> 7) & 1) * 2048 + (n >> 8) * 128 + (n & 127);
    if (n < 5376) return n - 4096;
    if (n < 5440) return OFF_KR + rope_src(n - 5376);
    return -1; } };
struct MapUQ { __device__ int operator()(int n) const {
    if (n < 1024) return (n >> 7) * 192 + (n & 127);
    const int j = n - 1024; return (j >> 6) * 192 + 128 + rope_src(j & 63); } };
struct MapUKV { __device__ int operator()(int n) const {
    if (n < 1024) return (n >> 7) * 256 + (n & 127);
    const int j = n - 1024; return (j >> 7) * 256 + 128 + (j & 127); } };
struct MapId { __device__ int operator()(int n) const { return n; } };

struct Ins { const float *x, *w_in, *b_gate, *g_norm1, *g_cq, *w_uq, *g_ckv, *w_ukv, *w_o_mla, *lambda_qk, *g_subln, *w_o_diff, *w_out, *g_norm2, *w_q_peer, *sub_keys, *expert_u, *expert_v, *g_final; };

__device__ __forceinline__ void p0_prologue(Frame& F, const Ins& I, const double* inv_freq) {
    LAS float* scr = (LAS float*)(F.lds + RING_OFF + F.wave * 16384);
    const int gw = F.vcu * NWAVES + F.wave, NGW = F.G * NWAVES;
    unsigned char* ws = F.ws;
    constexpr int I_W1 = (2048 / 64) * (N1 / 32), I_W8 = (2048 / 64) * (NG / 32), I_UQ = (768 / 64) * (1536 / 32), I_UKV = (512 / 64) * (2048 / 32), I_OM = (1024 / 64) * (2048 / 32), I_OD = I_OM, I_OUT = (2048 / 64) * (2048 / 32), I_QP = I_OUT;
    constexpr int NITEMS = I_W1 + I_W8 + I_UQ + I_UKV + I_OM + I_OD + I_OUT + I_QP;
    for (int it = gw; it < NITEMS; it += NGW) {
        int r = it;
        if (r < I_W1) { tr_item(I.w_in, IN_COLS, 2048, nullptr, (bf16*)(ws + WS_W1), scr, r, N1 / 32, F.lane, MapW1()); continue; } r -= I_W1;
        if (r < I_W8) { tr_item8(I.w_in, IN_COLS, 2048, nullptr, W1_SCALE, ws + WS_W8, scr, r, NG / 32, F.lane, MapGate()); continue; } r -= I_W8;
        if (r < I_UQ) { tr_item8(I.w_uq, 1536, 768, I.g_cq, W1_SCALE, ws + WS_WUQ, scr, r, 1536 / 32, F.lane, MapUQ()); continue; } r -= I_UQ;
        if (r < I_UKV) { tr_item8(I.w_ukv, 2048, 512, I.g_ckv, W1_SCALE, ws + WS_WUKV, scr, r, 2048 / 32, F.lane, MapUKV()); continue; } r -= I_UKV;
        if (r < I_OM) { tr_item(I.w_o_mla, 2048, 1024, nullptr, (bf16*)(ws + WS_WOM), scr, r, 2048 / 32, F.lane, MapId()); continue; } r -= I_OM;
        if (r < I_OD) { tr_item(I.w_o_diff, 2048, 1024, nullptr, (bf16*)(ws + WS_WOD), scr, r, 2048 / 32, F.lane, MapId()); continue; } r -= I_OD;
        if (r < I_OUT) { tr_item(I.w_out, 2048, 2048, nullptr, (bf16*)(ws + WS_WOUT), scr, r, 2048 / 32, F.lane, MapId()); continue; } r -= I_OUT;
        tr_item(I.w_q_peer, 2048, 2048, I.g_norm2, (bf16*)(ws + WS_WQP), scr, r, 2048 / 32, F.lane, MapId());
    }
    {
        bf16* skb = (bf16*)(ws + WS_SKB);
        for (int e = gw * 64 + F.lane; e < 256 * 256; e += NGW * 64) {
            const int n = e >> 8, k = e & 255; float v = 0.f;
            if (n < 128 && k < 128) v = I.sub_keys[n * 128 + k];
            else if (n >= 128 && k >= 128) v = I.sub_keys[128 * 128 + (n - 128) * 128 + (k - 128)];
            skb[e] = (bf16)(pk2(v, 0.f) & 0xffffu);
        }
    }
    {
        float* rope = (float*)(ws + WS_ROPE);
        for (int e = gw * 64 + F.lane; e < SEQ * 32; e += NGW * 64) {
            const int pos = e >> 5, i = e & 31;
            const double rev = (double)pos * inv_freq[i] * 0.15915494309189535;
            const float fr = (float)(rev - floor(rev));
            rope[2 * e] = __builtin_amdgcn_cosf(fr); rope[2 * e + 1] = __builtin_amdgcn_sinf(fr);
        }
    }
    if (blockIdx.x == 0 && F.tid == 0) {
        float a = 0.f, b = 0.f;
        for (int d = 0; d < 64; ++d) { a += I.lambda_qk[d] * I.lambda_qk[64 + d]; b += I.lambda_qk[128 + d] * I.lambda_qk[192 + d]; }
        const float lam = __expf(a) - __expf(b) + LAMBDA_INIT;
        ((float*)F.ctl)[CW_LAMBDA] = lam;
    }
    {
        bf16* H = (bf16*)(ws + WS_H);
        f32x4 g[8];
#pragma unroll
        for (int j = 0; j < 8; ++j) g[j] = *((const f32x4*)I.g_norm1 + F.lane + 64 * j);
        for (int m = gw; m < T; m += NGW) {
            const GAS f32x4* xr = (const GAS f32x4*)(I.x + (size_t)m * D_MODEL) + F.lane;
            f32x4 v[8]; float s = 0.f;
#pragma unroll
            for (int j = 0; j < 8; ++j) { v[j] = xr[64 * j]; s += (v[j].x * v[j].x + v[j].y * v[j].y) + (v[j].z * v[j].z + v[j].w * v[j].w); }
            const float rstd = 1.0f / sqrtf(wave_sum(s) * (1.f / D_MODEL) + EPS);
            GAS u32x2* o8 = (GAS u32x2*)(H + (size_t)m * D_MODEL) + F.lane;
#pragma unroll
            for (int j = 0; j < 8; ++j) { u32x2 w; w.x = pk2(v[j].x * rstd * g[j].x, v[j].y * rstd * g[j].y); w.y = pk2(v[j].z * rstd * g[j].z, v[j].w * rstd * g[j].w); o8[64 * j] = w; }
            { GAS unsigned* h8 = (GAS unsigned*)(ws + WS_H8 + (size_t)m * D_MODEL) + F.lane;
#pragma unroll
              for (int j = 0; j < 8; ++j) h8[64 * j] = (unsigned)__builtin_amdgcn_cvt_pk_fp8_f32(v[j].z * rstd * g[j].z, v[j].w * rstd * g[j].w, __builtin_amdgcn_cvt_pk_fp8_f32(v[j].x * rstd * g[j].x, v[j].y * rstd * g[j].y, 0, false), true); }
        }
    }
}

__device__ __forceinline__ void convert_experts(Frame& F, const Ins& I) {
    const size_t gt = (size_t)(F.vcu * NWAVES * 64) + F.tid, NT = (size_t)F.G * NWAVES * 64;
    const size_t nchunk = (size_t)NEXP * D_MODEL / 8;
    bf16* EU = (bf16*)(F.ws + WS_EU); bf16* EV = (bf16*)(F.ws + WS_EV);
    for (size_t c = gt; c < nchunk; c += NT) {
        const int d = (int)((c * 8) & (D_MODEL - 1));
        const f32x4 a0 = *(const GAS f32x4*)(I.expert_u + c * 8), a1 = *(const GAS f32x4*)(I.expert_u + c * 8 + 4);
        const f32x4 g0 = *(const f32x4*)(I.g_norm2 + d), g1 = *(const f32x4*)(I.g_norm2 + d + 4);
        v4u o; o.x = pk2(a0.x * g0.x, a0.y * g0.y); o.y = pk2(a0.z * g0.z, a0.w * g0.w); o.z = pk2(a1.x * g1.x, a1.y * g1.y); o.w = pk2(a1.z * g1.z, a1.w * g1.w);
        *(GAS v4u*)(EU + c * 8) = o;
        const f32x4 b0 = *(const GAS f32x4*)(I.expert_v + c * 8), b1 = *(const GAS f32x4*)(I.expert_v + c * 8 + 4);
        v4u p; p.x = pk2(b0.x, b0.y); p.y = pk2(b0.z, b0.w); p.z = pk2(b1.x, b1.y); p.w = pk2(b1.z, b1.w);
        *(GAS v4u*)(EV + c * 8) = p;
    }
}

__device__ __forceinline__ float sigmoidf_fast(float x) { return __builtin_amdgcn_rcpf(1.0f + __builtin_amdgcn_exp2f(-x * LOG2E)); }
__device__ __forceinline__ void rope8(f32x4& v0, f32x4& v1, const f32x4 cs0, const f32x4 cs1, float sc) {
    const float a0 = v0[0] * cs0[0] - v0[1] * cs0[1], b0 = v0[1] * cs0[0] + v0[0] * cs0[1];
    const float a1 = v0[2] * cs0[2] - v0[3] * cs0[3], b1 = v0[3] * cs0[2] + v0[2] * cs0[3];
    const float a2 = v1[0] * cs1[0] - v1[1] * cs1[1], b2 = v1[1] * cs1[0] + v1[0] * cs1[1];
    const float a3 = v1[2] * cs1[2] - v1[3] * cs1[3], b3 = v1[3] * cs1[2] + v1[2] * cs1[3];
    v0 = (f32x4){a0 * sc, b0 * sc, a1 * sc, b1 * sc}; v1 = (f32x4){a2 * sc, b2 * sc, a3 * sc, b3 * sc};
}
__device__ __forceinline__ u32x4 pack8(const f32x4 v0, const f32x4 v1) { u32x4 w; w.x = cvtpk(v0[0], v0[1]); w.y = cvtpk(v0[2], v0[3]); w.z = cvtpk(v1[0], v1[1]); w.w = cvtpk(v1[2], v1[3]); return w; }

__device__ __forceinline__ size_t kt_off(size_t row, int col) { const size_t b = row >> 13; const int pos = (int)(row & 8191), tile = pos >> 6, key = pos & 63, h = col >> 7, piece = (col & 127) >> 3;
    return (((b * 8 + h) * 128 + tile) * 16 + piece) * 512 + key * 8 + (col & 7); }
__device__ __forceinline__ size_t vt_off(size_t row, int col) { const size_t b = row >> 13; const int pos = (int)(row & 8191), tile = pos >> 6, key = pos & 63, h = col >> 7, d = col & 127;
    return (((b * 8 + h) * 128 + tile) * 16 + (d >> 5) * 4 + (key >> 4)) * 512 + (key & 15) * 32 + (d & 31); }
__device__ __forceinline__ size_t krt_off(size_t row, int col) { const size_t b = row >> 13; const int pos = (int)(row & 8191), tile = pos >> 6, key = pos & 63;
    return ((b * 128 + tile) * 8 + (col >> 3)) * 512 + key * 8 + (col & 7); }
__device__ __forceinline__ size_t k8_off(size_t row, int col) { const size_t b = row >> 13; const int pos = (int)(row & 8191), tile = pos >> 6, key = pos & 63, h = col >> 7, d = col & 127;
    return (((b * 8 + h) * 128 + tile) * 4 + (d >> 5)) * 2048 + key * 32 + (d & 31); }
__device__ __forceinline__ size_t kr8_off(size_t row, int c) { const size_t b = row >> 13; const int pos = (int)(row & 8191), tile = pos >> 6, key = pos & 63;
    return ((b * 128 + tile) * 2 + (c >> 5)) * 2048 + key * 32 + (c & 31); }
__device__ __forceinline__ size_t v8_off(size_t row, int col) { const size_t b = row >> 13; const int pos = (int)(row & 8191), tile = pos >> 6, key = pos & 63, h = col >> 7, d = col & 127;
    const int kk = key & 31, hi = (kk >> 2) & 1, j = (kk & 3) + 4 * (kk >> 3) + 16 * (key >> 5);
    return ((b * 8 + h) * 128 + tile) * 8192 + hi * 4096 + d * 32 + j; }
constexpr float MLA_QSCALE = 8.0f;
__device__ __forceinline__ u32x2 pack8_fp8(const f32x4 v0, const f32x4 v1) { u32x2 w; w.x = (unsigned)__builtin_amdgcn_cvt_pk_fp8_f32(v0[2], v0[3], __builtin_amdgcn_cvt_pk_fp8_f32(v0[0], v0[1], 0, false), true);
    w.y = (unsigned)__builtin_amdgcn_cvt_pk_fp8_f32(v1[2], v1[3], __builtin_amdgcn_cvt_pk_fp8_f32(v1[0], v1[1], 0, false), true); return w; }
template <int kind> struct EpiProj {
    static constexpr bool PERM = true;
    bf16_t *CQ, *CKV, *DQ, *DK, *DV, *G, *KR; float *ssq_q, *ssq_kv; const float* bgate; const float* rope;
    __device__ __forceinline__ void operator()(const f32x4 (&acc)[2][2][4][2], const pg8::Unit& u, int wr, int wc, int fr, int fq) const {
        const int row0 = u.pm * 256 + wr * 64 + fr, pn = kind == 0 ? 5 + u.pn : (u.pn < 16 ? 18 + u.pn : (u.pn < 21 ? u.pn - 16 : 17)), colw = wc * 32 + 8 * fq;
        if (kind == 1 && pn < 5) {
            unsigned char* O; int ldc, ct, nsl, sl; float* ssq;
            if (pn < 3) { O = (unsigned char*)CQ; ldc = 768; ct = pn * 256; ssq = ssq_q; nsl = 12; sl = pn * 4 + wc; } else { O = (unsigned char*)CKV; ldc = 512; ct = (pn - 3) * 256; ssq = ssq_kv; nsl = 8; sl = (pn - 3) * 4 + wc; }
#pragma unroll
            for (int ai = 0; ai < 2; ++ai)
#pragma unroll
                for (int m = 0; m < 4; ++m) { const int row = row0 + ai * 128 + m * 16; float s = 0.f;
#pragma unroll
                    for (int bj = 0; bj < 2; ++bj) { const f32x4 v0 = acc[ai][bj][m][0], v1 = acc[ai][bj][m][1];
                        s += (v0[0] * v0[0] + v0[1] * v0[1]) + (v0[2] * v0[2] + v0[3] * v0[3]) + (v1[0] * v1[0] + v1[1] * v1[1]) + (v1[2] * v1[2] + v1[3] * v1[3]);
                        u32x2 w8; w8.x = (unsigned)__builtin_amdgcn_cvt_pk_fp8_f32(v0[2], v0[3], __builtin_amdgcn_cvt_pk_fp8_f32(v0[0], v0[1], 0, false), true); w8.y = (unsigned)__builtin_amdgcn_cvt_pk_fp8_f32(v1[2], v1[3], __builtin_amdgcn_cvt_pk_fp8_f32(v1[0], v1[1], 0, false), true);
                        *(u32x2*)(O + (size_t)row * ldc + ct + bj * 128 + colw) = w8; }
                    s += __shfl_xor(s, 16); s += __shfl_xor(s, 32);
                    if (fq == 0) ssq[(size_t)row * nsl + sl] = s; }
        } else if (kind == 0 && pn < 13) {
            const bool isq = pn < 9; bf16_t* O = isq ? DQ : DK; const int ct = (pn - (isq ? 5 : 9)) * 256; const float sc = isq ? C2_DIFF : 1.0f;
            const int i0 = ((wc & 1) * 32 + 8 * fq) >> 1;
#pragma unroll
            for (int ai = 0; ai < 2; ++ai) {
                f32x4 cs[4][2];
#pragma unroll
                for (int m = 0; m < 4; ++m) { const int pos = (row0 + ai * 128 + m * 16) & (SEQ - 1);
                    cs[m][0] = *(const f32x4*)(rope + (size_t)(pos * 32 + i0) * 2); cs[m][1] = *(const f32x4*)(rope + (size_t)(pos * 32 + i0 + 2) * 2); }
#pragma unroll
                for (int m = 0; m < 4; ++m) { const int row = row0 + ai * 128 + m * 16;
#pragma unroll
                    for (int bj = 0; bj < 2; ++bj) { f32x4 v0 = acc[ai][bj][m][0], v1 = acc[ai][bj][m][1]; rope8(v0, v1, cs[m][0], cs[m][1], sc);
                        const int col = ct + bj * 128 + colw;
                        *(u32x4*)(O + (isq ? (size_t)row * 1024 + col : kt_off(row, col))) = pack8(v0, v1); } } }
        } else if (kind == 0) {
            const int ct = (pn - 13) * 256;
#pragma unroll
            for (int ai = 0; ai < 2; ++ai)
#pragma unroll
                for (int m = 0; m < 4; ++m) { const int row = row0 + ai * 128 + m * 16;
#pragma unroll
                    for (int bj = 0; bj < 2; ++bj) *(u32x4*)(DV + vt_off(row, ct + bj * 128 + colw)) = pack8(acc[ai][bj][m][0], acc[ai][bj][m][1]); }
        } else if (kind == 1 && pn >= 18) {
            const int cg = (pn - 18) * 128 + colw;
            f32x4 bv[2][2];
#pragma unroll
            for (int bj = 0; bj < 2; ++bj) { bv[bj][0] = *(const f32x4*)(bgate + bj * 2048 + cg); bv[bj][1] = *(const f32x4*)(bgate + bj * 2048 + cg + 4); }
#pragma unroll
            for (int ai = 0; ai < 2; ++ai)
#pragma unroll
                for (int m = 0; m < 4; ++m) { const int row = row0 + ai * 128 + m * 16;
                    f32x4 r0, r1, g0, g1;
#pragma unroll
                    for (int e = 0; e < 4; ++e) {
                        const float ea0 = __builtin_amdgcn_exp2f(-(acc[ai][0][m][0][e] + bv[0][0][e]) * LOG2E), eb0 = __builtin_amdgcn_exp2f(-(acc[ai][1][m][0][e] + bv[1][0][e]) * LOG2E);
                        const float ea1 = __builtin_amdgcn_exp2f(-(acc[ai][0][m][1][e] + bv[0][1][e]) * LOG2E), eb1 = __builtin_amdgcn_exp2f(-(acc[ai][1][m][1][e] + bv[1][1][e]) * LOG2E);
                        g0[e] = __builtin_amdgcn_rcpf(1.0f + eb0); r0[e] = (1.0f + eb0) * __builtin_amdgcn_rcpf(1.0f + ea0);
                        g1[e] = __builtin_amdgcn_rcpf(1.0f + eb1); r1[e] = (1.0f + eb1) * __builtin_amdgcn_rcpf(1.0f + ea1); }
                    *(u32x4*)(G + (size_t)row * 4096 + cg) = pack8(r0, r1); *(u32x4*)(G + (size_t)row * 4096 + 2048 + cg) = pack8(g0, g1); }
        } else if (kind == 1) {
            if (wc < 2) {
                const int i0 = colw >> 1;
#pragma unroll
                for (int ai = 0; ai < 2; ++ai) {
                    f32x4 cs[4][2];
#pragma unroll
                    for (int m = 0; m < 4; ++m) { const int pos = (row0 + ai * 128 + m * 16) & (SEQ - 1);
                        cs[m][0] = *(const f32x4*)(rope + (size_t)(pos * 32 + i0) * 2); cs[m][1] = *(const f32x4*)(rope + (size_t)(pos * 32 + i0 + 2) * 2); }
#pragma unroll
                    for (int m = 0; m < 4; ++m) { const int row = row0 + ai * 128 + m * 16;
                        f32x4 v0 = acc[ai][0][m][0], v1 = acc[ai][0][m][1]; rope8(v0, v1, cs[m][0], cs[m][1], 1.0f);
                        *(u32x2*)((unsigned char*)KR + kr8_off(row, colw)) = pack8_fp8(v0, v1); } }
            }
        }
    }
};

struct EpiQup {
    static constexpr bool PERM = true;
    bf16_t *QN, *QR; const float* ssq; const float* rope;
    __device__ __forceinline__ void operator()(const f32x4 (&acc)[2][2][4][2], const pg8::Unit& u, int wr, int wc, int fr, int fq) const {
        const int row0 = u.pm * 256 + wr * 64 + fr, pn = u.pn, colw = wc * 32 + 8 * fq;
        const int i0 = ((wc & 1) * 32 + 8 * fq) >> 1;
#pragma unroll
        for (int ai = 0; ai < 2; ++ai) {
            float sc[4]; f32x4 cs[4][2];
#pragma unroll
            for (int m = 0; m < 4; ++m) { const int row = row0 + ai * 128 + m * 16; const int pos = row & (SEQ - 1);
                const f32x4 q0 = *(const f32x4*)(ssq + (size_t)row * 12), q1 = *(const f32x4*)(ssq + (size_t)row * 12 + 4), q2 = *(const f32x4*)(ssq + (size_t)row * 12 + 8);
                if (pn >= 4) { cs[m][0] = *(const f32x4*)(rope + (size_t)(pos * 32 + i0) * 2); cs[m][1] = *(const f32x4*)(rope + (size_t)(pos * 32 + i0 + 2) * 2); }
                const float sq = (((q0[0] + q0[1]) + (q0[2] + q0[3])) + ((q1[0] + q1[1]) + (q1[2] + q1[3]))) + ((q2[0] + q2[1]) + (q2[2] + q2[3]));
                sc[m] = (C2_MLA * MLA_QSCALE) / sqrtf(sq * (1.0f / 768.0f) + EPS); }
            if (pn < 4) {
#pragma unroll
                for (int m = 0; m < 4; ++m) { const int row = row0 + ai * 128 + m * 16;
#pragma unroll
                    for (int bj = 0; bj < 2; ++bj) *(u32x2*)((unsigned char*)QN + (size_t)row * 1024 + pn * 256 + bj * 128 + colw) = pack8_fp8(acc[ai][bj][m][0] * sc[m], acc[ai][bj][m][1] * sc[m]); }
            } else {
#pragma unroll
                for (int m = 0; m < 4; ++m) { const int row = row0 + ai * 128 + m * 16;
#pragma unroll
                    for (int bj = 0; bj < 2; ++bj) { f32x4 v0 = acc[ai][bj][m][0], v1 = acc[ai][bj][m][1]; rope8(v0, v1, cs[m][0], cs[m][1], sc[m]);
                        *(u32x2*)((unsigned char*)QR + (size_t)row * 512 + (pn - 4) * 256 + bj * 128 + colw) = pack8_fp8(v0, v1); } }
            }
        }
    }
};
struct EpiKVup {
    static constexpr bool PERM = true;
    bf16_t *KN, *V; const float* ssq;
    __device__ __forceinline__ void operator()(const f32x4 (&acc)[2][2][4][2], const pg8::Unit& u, int wr, int wc, int fr, int fq) const {
        const int row0 = u.pm * 256 + wr * 64 + fr, pn = u.pn, colw = wc * 32 + 8 * fq;
        bf16_t* O = pn < 4 ? KN : V; const int ct = (pn & 3) * 256;
#pragma unroll
        for (int ai = 0; ai < 2; ++ai) {
            float scv[4];
#pragma unroll
            for (int m = 0; m < 4; ++m) { const int row = row0 + ai * 128 + m * 16;
                const f32x4 q0 = *(const f32x4*)(ssq + (size_t)row * 8), q1 = *(const f32x4*)(ssq + (size_t)row * 8 + 4);
                const float sq = ((q0[0] + q0[1]) + (q0[2] + q0[3])) + ((q1[0] + q1[1]) + (q1[2] + q1[3]));
                scv[m] = 1.0f / sqrtf(sq * (1.0f / 512.0f) + EPS); }
#pragma unroll
            for (int m = 0; m < 4; ++m) { const int row = row0 + ai * 128 + m * 16; const float sc = scv[m];
#pragma unroll
                for (int bj = 0; bj < 2; ++bj) { const int col = ct + bj * 128 + colw;
                    if (pn < 4) *(u32x2*)((unsigned char*)KN + k8_off(row, col)) = pack8_fp8(acc[ai][bj][m][0] * sc, acc[ai][bj][m][1] * sc);
                    else { const u32x2 w8 = pack8_fp8(acc[ai][bj][m][0] * sc, acc[ai][bj][m][1] * sc); unsigned char* vp = (unsigned char*)V + v8_off(row, col);
                        vp[0] = (unsigned char)w8.x; vp[32] = (unsigned char)(w8.x >> 8); vp[64] = (unsigned char)(w8.x >> 16); vp[96] = (unsigned char)(w8.x >> 24);
                        vp[128] = (unsigned char)w8.y; vp[160] = (unsigned char)(w8.y >> 8); vp[192] = (unsigned char)(w8.y >> 16); vp[224] = (unsigned char)(w8.y >> 24); } } } }
    }
};
struct EpiGate {
    static constexpr bool PERM = true;
    const bf16_t* G; bf16_t* TMP; bf16_t* MG; int second;
    __device__ __forceinline__ void operator()(const f32x4 (&acc)[2][2][4][2], const pg8::Unit& u, int wr, int wc, int fr, int fq) const {
        const int row0 = u.pm * 256 + wr * 64 + fr, colw = u.pn * 256 + wc * 32 + 8 * fq;
#pragma unroll
        for (int ai = 0; ai < 2; ++ai)
#pragma unroll
            for (int m = 0; m < 4; ++m) { const int row = row0 + ai * 128 + m * 16;
#pragma unroll
                for (int bj = 0; bj < 2; ++bj) { const int col = colw + bj * 128;
                    const u32x4 gw = *(const u32x4*)(G + (size_t)row * 4096 + (second ? 2048 : 0) + col);
                    f32x4 v0 = acc[ai][bj][m][0], v1 = acc[ai][bj][m][1];
                    v0 = (f32x4){v0[0] * bflo(gw.x), v0[1] * bfhi(gw.x), v0[2] * bflo(gw.y), v0[3] * bfhi(gw.y)};
                    v1 = (f32x4){v1[0] * bflo(gw.z), v1[1] * bfhi(gw.z), v1[2] * bflo(gw.w), v1[3] * bfhi(gw.w)};
                    if (second) { const u32x4 tw = *(const u32x4*)(TMP + (size_t)row * 2048 + col);
                        v0 += (f32x4){bflo(tw.x), bfhi(tw.x), bflo(tw.y), bfhi(tw.y)}; v1 += (f32x4){bflo(tw.z), bfhi(tw.z), bflo(tw.w), bfhi(tw.w)};
                        *(u32x4*)(MG + (size_t)row * 2048 + col) = pack8(v0, v1);
                    } else *(u32x4*)(TMP + (size_t)row * 2048 + col) = pack8(v0, v1); } }
    }
};
struct EpiGate2 {
    static constexpr bool PERM = true;
    const bf16_t* G; bf16_t* MG; int pv;
    __device__ __forceinline__ void mid(f32x4 (&acc)[2][2][4][2], const pg8::Unit& u, int wr, int wc, int fr, int fq) const {
        const int row0 = u.pm * 256 + wr * 64 + fr, colw = u.pn * 256 + wc * 32 + 8 * fq;
        if (pv >= 2) return;
        u32x4 rv[2][4][2];
#pragma unroll
        for (int ai = 0; ai < 2; ++ai)
#pragma unroll
            for (int m = 0; m < 4; ++m)
#pragma unroll
                for (int bj = 0; bj < 2; ++bj) rv[ai][m][bj] = *(const u32x4*)(G + (size_t)(row0 + ai * 128 + m * 16) * 4096 + colw + bj * 128);
#pragma unroll
        for (int ai = 0; ai < 2; ++ai)
#pragma unroll
            for (int m = 0; m < 4; ++m)
#pragma unroll
                for (int bj = 0; bj < 2; ++bj) { const u32x4 a = rv[ai][m][bj];
                    acc[ai][bj][m][0] *= (f32x4){bflo(a.x), bfhi(a.x), bflo(a.y), bfhi(a.y)}; acc[ai][bj][m][1] *= (f32x4){bflo(a.z), bfhi(a.z), bflo(a.w), bfhi(a.w)}; }
    }
    __device__ __forceinline__ void operator()(const f32x4 (&acc)[2][2][4][2], const pg8::Unit& u, int wr, int wc, int fr, int fq) const {
        const int row0 = u.pm * 256 + wr * 64 + fr, colw = u.pn * 256 + wc * 32 + 8 * fq;
        u32x4 gbv[2][4][2];
#pragma unroll
        for (int ai = 0; ai < 2; ++ai)
#pragma unroll
            for (int m = 0; m < 4; ++m)
#pragma unroll
                for (int bj = 0; bj < 2; ++bj) gbv[ai][m][bj] = pv >= 3 ? (u32x4){0x3f803f80u, 0x3f803f80u, 0x3f803f80u, 0x3f803f80u} : *(const u32x4*)(G + (size_t)(row0 + ai * 128 + m * 16) * 4096 + 2048 + colw + bj * 128);
#pragma unroll
        for (int ai = 0; ai < 2; ++ai)
#pragma unroll
            for (int m = 0; m < 4; ++m) { const int row = row0 + ai * 128 + m * 16;
#pragma unroll
                for (int bj = 0; bj < 2; ++bj) { const int col = colw + bj * 128;
                    const u32x4 gb = gbv[ai][m][bj];
                    f32x4 v0 = acc[ai][bj][m][0], v1 = acc[ai][bj][m][1];
                    v0 = (f32x4){v0[0] * bflo(gb.x), v0[1] * bfhi(gb.x), v0[2] * bflo(gb.y), v0[3] * bfhi(gb.y)};
                    v1 = (f32x4){v1[0] * bflo(gb.z), v1[1] * bfhi(gb.z), v1[2] * bflo(gb.w), v1[3] * bfhi(gb.w)};
                    if (pv == 0) *(u32x4*)(MG + (size_t)row * 2048 + col) = pack8(v0, v1); } }
    }
};
struct EpiRes {
    static constexpr bool PERM = false;
    const float* x; float* X2; bf16_t* X2B; float* ssq;
    __device__ __forceinline__ void operator()(const f32x4 (&acc)[2][2][4][2], const pg8::Unit& u, int wr, int wc, int fr, int fq) const {
        const int row0 = u.pm * 256 + wr * 64 + fr, col0 = u.pn * 256 + wc * 32 + 4 * fq;
#pragma unroll
        for (int ai = 0; ai < 2; ++ai) {
            f32x4 xv[4][2][2];
#pragma unroll
            for (int m = 0; m < 4; ++m)
#pragma unroll
                for (int bj = 0; bj < 2; ++bj)
#pragma unroll
                    for (int n = 0; n < 2; ++n) xv[m][bj][n] = *(const f32x4*)(x + (size_t)(row0 + ai * 128 + m * 16) * 2048 + col0 + bj * 128 + n * 16);
#pragma unroll
            for (int m = 0; m < 4; ++m) { const int row = row0 + ai * 128 + m * 16; float s = 0.f;
#pragma unroll
                for (int bj = 0; bj < 2; ++bj)
#pragma unroll
                    for (int n = 0; n < 2; ++n) { const size_t off = (size_t)row * 2048 + col0 + bj * 128 + n * 16;
                        const f32x4 v = acc[ai][bj][m][n] + xv[m][bj][n];
                        s += (v[0] * v[0] + v[1] * v[1]) + (v[2] * v[2] + v[3] * v[3]);
#ifdef PEER_BF16
                        *(f32x4*)(X2 + off) = v;
#endif
                        u32x2 w; w.x = cvtpk(v[0], v[1]); w.y = cvtpk(v[2], v[3]); *(u32x2*)(X2B + off) = w; }
                s += __shfl_xor(s, 16); s += __shfl_xor(s, 32);
                if (fq == 0) ssq[(size_t)row * 32 + u.pn * 4 + wc] = s; } }
    }
};
__device__ __forceinline__ float sum32(const float* p) { float t = 0.f;
#pragma unroll
    for (int i = 0; i < 8; ++i) { const f32x4 q = *(const f32x4*)(p + 4 * i); t += (q[0] + q[1]) + (q[2] + q[3]); } return t; }
constexpr int RTAB_OFF = 132096, RTAB_SLOTS = 4;
struct EpiQP {
    static constexpr bool PERM = true;
    bf16_t* QP; const float* ssq; const LAS float* tab; int pms[RTAB_SLOTS];
    __device__ __forceinline__ void operator()(const f32x4 (&acc)[2][2][4][2], const pg8::Unit& u, int wr, int wc, int fr, int fq) const {
        const int row0 = u.pm * 256 + wr * 64 + fr, colw = u.pn * 256 + wc * 32 + 8 * fq;
        int slot = -1;
#pragma unroll
        for (int i = RTAB_SLOTS - 1; i >= 0; --i) if (pms[i] == u.pm) slot = i;
        const bool have = __builtin_amdgcn_readfirstlane(slot) >= 0;
#pragma unroll
        for (int ai = 0; ai < 2; ++ai) {
            float scv[4];
            if (have) {
#pragma unroll
                for (int m = 0; m < 4; ++m) scv[m] = tab[slot * 256 + wr * 64 + fr + ai * 128 + m * 16];
            } else {
#pragma unroll
                for (int m = 0; m < 4; ++m) { scv[m] = 1.0f / sqrtf(sum32(ssq + (size_t)(row0 + ai * 128 + m * 16) * 32) * (1.0f / 2048.0f) + EPS); asm volatile("" ::: "memory"); }
            }
#pragma unroll
            for (int m = 0; m < 4; ++m) { const int row = row0 + ai * 128 + m * 16; const float sc = scv[m];
#pragma unroll
                for (int bj = 0; bj < 2; ++bj) *(u32x4*)(QP + (size_t)row * 2048 + colw + bj * 128) = pack8(acc[ai][bj][m][0] * sc, acc[ai][bj][m][1] * sc); }
        }
    }
};

template <class QF, class KF, class VF>
__device__ __forceinline__ void naive_attn(LAS float* qs, QF q_f, int dt, KF k_f, VF v_f, float sscale,
                                           size_t rowbase, int p0, int lane, float (&o)[4][2], float (&linv)[4]) {
    for (int idx = lane; idx < 4 * dt; idx += 64) { const int r = idx / dt, d = idx - r * dt; qs[r * 192 + d] = q_f(rowbase + p0 + r, d); }
    LDS_WAIT(); asm volatile("" ::: "memory");
    float m[4], l[4];
#pragma unroll
    for (int r = 0; r < 4; ++r) { m[r] = -INFINITY; l[r] = 0.f; o[r][0] = 0.f; o[r][1] = 0.f; }
    const int pmax = p0 + 3, ntile = pmax / 64 + 1;
#pragma unroll 1
    for (int kt = 0; kt < ntile; ++kt) {
        const int key = kt * 64 + lane, kc = key < pmax ? key : pmax;
        float s[4] = {0.f, 0.f, 0.f, 0.f};
#pragma unroll 2
        for (int d = 0; d < dt; d += 8) { float k[8]; k_f(rowbase + kc, d, k);
#pragma unroll
            for (int r = 0; r < 4; ++r) { const f32x4 qa4 = *(const LAS f32x4*)(qs + r * 192 + d), qb4 = *(const LAS f32x4*)(qs + r * 192 + d + 4);
                s[r] += (qa4[0] * k[0] + qa4[1] * k[1]) + (qa4[2] * k[2] + qa4[3] * k[3]) + (qb4[0] * k[4] + qb4[1] * k[5]) + (qb4[2] * k[6] + qb4[3] * k[7]); } }
        float p[4];
#pragma unroll
        for (int r = 0; r < 4; ++r) {
            const float sv = key > p0 + r ? -INFINITY : s[r] * sscale;
            const float mn = fmaxf(m[r], wave_max(sv));
            const float al = __builtin_amdgcn_exp2f(m[r] - mn);
            p[r] = __builtin_amdgcn_exp2f(sv - mn);
            l[r] = l[r] * al + wave_sum(p[r]); o[r][0] *= al; o[r][1] *= al; m[r] = mn;
        }
        const int jn = (pmax - kt * 64) < 63 ? (pmax - kt * 64) : 63;
#pragma unroll 4
        for (int j = 0; j <= jn; ++j) {
            const float v0 = v_f(rowbase + kt * 64 + j, lane), v1 = v_f(rowbase + kt * 64 + j, 64 + lane);
#pragma unroll
            for (int r = 0; r < 4; ++r) { const float pj = __builtin_bit_cast(float, __builtin_amdgcn_readlane(__builtin_bit_cast(int, p[r]), j)); o[r][0] += pj * v0; o[r][1] += pj * v1; }
        }
    }
#pragma unroll
    for (int r = 0; r < 4; ++r) linv[r] = 1.0f / l[r];
    LDS_WAIT(); asm volatile("" ::: "memory");
}
__device__ __forceinline__ float fp8_at(const unsigned char* p) { typedef float f2 __attribute__((ext_vector_type(2))); const f2 v = __builtin_amdgcn_cvt_pk_f32_fp8((int)*p, false); return v.x; }
__device__ __forceinline__ void fp8x8(const unsigned char* p, float (&k)[8]) { typedef float f2 __attribute__((ext_vector_type(2))); const u32x2 w = *(const u32x2*)p;
    const f2 a = __builtin_amdgcn_cvt_pk_f32_fp8((int)w.x, false), b = __builtin_amdgcn_cvt_pk_f32_fp8((int)w.x, true), c = __builtin_amdgcn_cvt_pk_f32_fp8((int)w.y, false), d = __builtin_amdgcn_cvt_pk_f32_fp8((int)w.y, true);
    k[0] = a.x; k[1] = a.y; k[2] = b.x; k[3] = b.y; k[4] = c.x; k[5] = c.y; k[6] = d.x; k[7] = d.y; }
__device__ __forceinline__ void bf16x8f(const bf16* p, float (&k)[8]) { const u32x4 kw = *(const u32x4*)p; k[0] = bflo(kw.x); k[1] = bfhi(kw.x); k[2] = bflo(kw.y); k[3] = bfhi(kw.y); k[4] = bflo(kw.z); k[5] = bfhi(kw.z); k[6] = bflo(kw.w); k[7] = bfhi(kw.w); }
__device__ __forceinline__ void p3_attention_ref(Frame& F, const Ins& I) {
    unsigned char* ws = F.ws;
    const bf16 *QN = (const bf16*)(ws + WS_QN), *QR = (const bf16*)(ws + WS_QR), *KN = (const bf16*)(ws + WS_KN), *KR = (const bf16*)(ws + WS_KR), *V = (const bf16*)(ws + WS_V);
    const bf16 *DQ = (const bf16*)(ws + WS_DQ), *DK = (const bf16*)(ws + WS_DK), *DV = (const bf16*)(ws + WS_DV);
    bf16 *OM = (bf16*)(ws + WS_OM), *OD = (bf16*)(ws + WS_OD);
    LAS float* qs = (LAS float*)(F.lds + RING_OFF + F.wave * 4096);
    const int gw = F.vcu * NWAVES + F.wave, NGW = F.G * NWAVES, lane = F.lane;
    const float lam = ((const float*)F.ctl)[CW_LAMBDA];
    const float gs0 = I.g_subln[lane] * (1.0f - LAMBDA_INIT), gs1 = I.g_subln[64 + lane] * (1.0f - LAMBDA_INIT);
    for (int it = gw; it < 2 * 16 * (SEQ / 4); it += NGW) {
        const int type = it & 1, rest = it >> 1, bh = rest & 15, g = rest >> 4, b = bh >> 3, h = bh & 7, p0 = 4 * g;
        const size_t rowbase = (size_t)b * SEQ;
        float o[4][2], li[4];
        if (type == 0) {
            {
                const unsigned char *QN8 = (const unsigned char*)QN, *QR8 = (const unsigned char*)QR, *KN8 = (const unsigned char*)KN, *KR8 = (const unsigned char*)KR;
                naive_attn(qs, [=](size_t row, int d) { return d < 128 ? fp8_at(QN8 + row * 1024 + h * 128 + d) : fp8_at(QR8 + row * 512 + h * 64 + (d - 128)); }, 192,
                           [=](size_t row, int d, float (&k)[8]) { if (d < 128) fp8x8(KN8 + k8_off(row, h * 128 + d), k); else fp8x8(KR8 + kr8_off(row, d - 128), k); },
                           [=](size_t row, int c) { return fp8_at((const unsigned char*)V + v8_off(row, h * 128 + c)); }, 1.0f / MLA_QSCALE, rowbase, p0, lane, o, li); }
#pragma unroll
            for (int r = 0; r < 4; ++r) { bf16* orow = OM + (rowbase + p0 + r) * 1024 + h * 128;
#ifdef ATT_CHECK
                { const float a0 = bf2f(orow[lane]), a1 = bf2f(orow[64 + lane]), b0 = o[r][0] * li[r], b1 = o[r][1] * li[r];
                  if (fabsf(a0 - b0) > ATT_TOL_A + ATT_TOL_R * fabsf(b0) || fabsf(a1 - b1) > ATT_TOL_A + ATT_TOL_R * fabsf(b1) || !(a0 == a0) || !(a1 == a1)) atomicAdd((unsigned*)F.ctl + 16, 1u); }
#else
                orow[lane] = (bf16)(pk2(o[r][0] * li[r], 0.f) & 0xffffu); orow[64 + lane] = (bf16)(pk2(o[r][1] * li[r], 0.f) & 0xffffu);
#endif
            }
        } else {
            float o2[4][2], li2[4];
            naive_attn(qs, [=](size_t row, int d) { return bf2f(DQ[row * 1024 + (h * 2) * 64 + d]); }, 64, [=](size_t row, int d, float (&k)[8]) { bf16x8f(DK + kt_off(row, h * 128 + d), k); },
                       [=](size_t row, int c) { return bf2f(DV[vt_off(row, h * 128 + c)]); }, 1.0f, rowbase, p0, lane, o, li);
            naive_attn(qs, [=](size_t row, int d) { return bf2f(DQ[row * 1024 + (h * 2 + 1) * 64 + d]); }, 64, [=](size_t row, int d, float (&k)[8]) { bf16x8f(DK + kt_off(row, h * 128 + 64 + d), k); },
                       [=](size_t row, int c) { return bf2f(DV[vt_off(row, h * 128 + c)]); }, 1.0f, rowbase, p0, lane, o2, li2);
#pragma unroll
            for (int r = 0; r < 4; ++r) {
                const float d0 = o[r][0] * li[r] - lam * o2[r][0] * li2[r], d1 = o[r][1] * li[r] - lam * o2[r][1] * li2[r];
                const float rs = 1.0f / sqrtf(wave_sum(d0 * d0 + d1 * d1) * (1.0f / 128.0f) + EPS);
                bf16* orow = OD + (rowbase + p0 + r) * 1024 + h * 128;
#ifdef ATT_CHECK
                { const float a0 = bf2f(orow[lane]), a1 = bf2f(orow[64 + lane]), b0 = d0 * rs * gs0, b1 = d1 * rs * gs1;
                  if (fabsf(a0 - b0) > ATT_TOL_A + ATT_TOL_R * fabsf(b0) || fabsf(a1 - b1) > ATT_TOL_A + ATT_TOL_R * fabsf(b1) || !(a0 == a0) || !(a1 == a1)) atomicAdd((unsigned*)F.ctl + 17, 1u); }
#else
                orow[lane] = (bf16)(pk2(d0 * rs * gs0, 0.f) & 0xffffu); orow[64 + lane] = (bf16)(pk2(d1 * rs * gs1, 0.f) & 0xffffu);
#endif
            }
        }
    }
}

constexpr float EU_SCALE4 = 90.0f, EV_SCALE4 = 5.625f;
namespace att {
typedef short bf16x8 __attribute__((ext_vector_type(8)));
typedef short s16x4 __attribute__((ext_vector_type(4)));
typedef float f32x16 __attribute__((ext_vector_type(16)));
typedef short v4i16_t __attribute__((ext_vector_type(4)));
#ifndef ATT_PF2
#define ATT_PF2 1
#endif
constexpr int BUFB = 40960, WSF_OFF = (ATT_PF2 ? 3 : 2) * BUFB;
#ifndef ATT_KD
#define ATT_KD 2
#endif
#ifndef ATT_THR
#define ATT_THR 8.0f
#endif
#ifndef ATT_PIPE
#define ATT_PIPE 0
#endif
#ifndef ATT_THR8
#define ATT_THR8 4.0f
#endif
#define ATT_PSH 4.0f
#ifndef ATT_DMAPOS
#define ATT_DMAPOS 0
#endif
#ifndef ATT_VD
#define ATT_VD 2
#endif
__device__ __forceinline__ int crow(int r, int hi) { return (r & 3) + 8 * (r >> 2) + 4 * hi; }
__device__ __forceinline__ s16x4 vtr(const LAS unsigned char* p) { return __builtin_bit_cast(s16x4, __builtin_amdgcn_ds_read_tr16_b64_v4i16((LAS v4i16_t*)p)); }
__device__ __forceinline__ float max3f(float a, float b, float c) { float r; asm("v_max3_f32 %0, %1, %2, %3" : "=v"(r) : "v"(a), "v"(b), "v"(c)); return r; }
__device__ __forceinline__ float max2f(float a, float b) { float r; asm("v_max_f32_e32 %0, %1, %2" : "=v"(r) : "v"(a), "v"(b)); return r; }
__device__ __forceinline__ float swapmax(float m) { auto rr = __builtin_amdgcn_permlane32_swap(__float_as_uint(m), __float_as_uint(m), false, false);
    const unsigned a = rr[0], b = rr[1]; return fmaxf(__uint_as_float(a), __uint_as_float(b)); }
__device__ __forceinline__ float swapsum(float m) { auto rr = __builtin_amdgcn_permlane32_swap(__float_as_uint(m), __float_as_uint(m), false, false);
    const unsigned a = rr[0], b = rr[1]; return __uint_as_float(a) + __uint_as_float(b); }

struct BgConv { const float* src; unsigned char* dst; const float* g; float scale; int row0; };
__device__ __forceinline__ unsigned bg_pack8_fp4(const f32x4 lo, const f32x4 hi) {
    unsigned w = __builtin_amdgcn_cvt_scalef32_pk_fp4_f32(0u, lo[0], lo[1], 1.0f, 0); w = __builtin_amdgcn_cvt_scalef32_pk_fp4_f32(w, lo[2], lo[3], 1.0f, 1);
    w = __builtin_amdgcn_cvt_scalef32_pk_fp4_f32(w, hi[0], hi[1], 1.0f, 2); return __builtin_amdgcn_cvt_scalef32_pk_fp4_f32(w, hi[2], hi[3], 1.0f, 3); }
template <bool DIFF, int PV = 0>
__device__ __forceinline__ void attn_unit(LAS unsigned char* lds, int tid, size_t rowbase, int h, int q0,
                                          const bf16* Qa, const bf16* Qb, const bf16* Ka, const bf16* Kb, const bf16* Vp, bf16* Op, float lam, const float* gsub, const BgConv cv = BgConv{nullptr, nullptr, nullptr, 0.f, 0}) {
    constexpr bool QK8 = !DIFF;
    constexpr int NP = DIFF ? 4 : 3, NKS = DIFF ? 4 : 12, KPIECES = 24, R = DIFF ? 128 : 256;
    typedef int v8i32 __attribute__((ext_vector_type(8)));
    const int lane = tid & 63, r32 = lane & 31, hi = lane >> 5, wid = __builtin_amdgcn_readfirstlane(tid >> 6);
    const int mp = DIFF ? (wid >> 2) : 0, rows_w0 = q0 + 32 * (DIFF ? (wid & 3) : wid);
    const char* src[NP]; unsigned tstr[NP]; unsigned dsto[NP];
#pragma unroll
    for (int i = 0; i < NP; ++i) { const int pidx = wid * NP + i;
        const size_t bhb = ((size_t)(rowbase >> 13) * 8 + h) * 128 * 16384, krb = (size_t)(rowbase >> 13) * 128 * 8192;
        if (!DIFF) {
            const size_t b8 = ((size_t)(rowbase >> 13) * 8 + h) * 128 * 8192, kr8 = (size_t)(rowbase >> 13) * 128 * 4096;
            const int pq = wid < 4 ? wid * 3 + i : 12 + (wid - 4) * 2 + i;
            if (wid >= 4 && i == 2) { src[i] = nullptr; tstr[i] = 0; dsto[i] = 0; }
            else if (pq < 8) { src[i] = (const char*)Ka + b8 + pq * 1024 + lane * 16; tstr[i] = 8192; dsto[i] = pq * 1024; }
            else if (pq < 12) { src[i] = (const char*)Kb + kr8 + (pq - 8) * 1024 + lane * 16; tstr[i] = 4096; dsto[i] = pq * 1024; }
            else { src[i] = (const char*)Vp + b8 + (pq - 12) * 1024 + lane * 16; tstr[i] = 8192; dsto[i] = KPIECES * 1024 + (pq - 12) * 1024; }
        } else {
            if (pidx < 16) { src[i] = (const char*)Ka + bhb + pidx * 1024 + lane * 16; tstr[i] = 16384; dsto[i] = pidx * 1024; }
            else { src[i] = (const char*)Vp + bhb + (pidx - 16) * 1024 + lane * 16; tstr[i] = 16384; dsto[i] = KPIECES * 1024 + (pidx - 16) * 1024; }
        } }
    const int npw = DIFF ? NP : (wid >= 4 ? 2 : 3);
    const unsigned lds0 = (unsigned)(uintptr_t)lds;
#define ATT_DMA(t, bb) do { if (PV != 3) _Pragma("unroll") for (int _i = 0; _i < NP; ++_i) if (_i < npw) { unsigned _keep; const unsigned _dst = (unsigned)__builtin_amdgcn_readfirstlane((int)(lds0 + (unsigned)((bb) * BUFB) + dsto[_i])); \
        asm volatile("s_mov_b32 %0, m0\n\ts_mov_b32 m0, %2\n\ts_nop 0\n\tglobal_load_lds_dwordx4 %1, off\n\ts_mov_b32 m0, %0" : "=&s"(_keep) : "v"(src[_i] + (size_t)(t) * tstr[_i]), "s"(_dst) : "memory"); } } while (0)
    bf16x8 qf[QK8 ? 1 : NKS]; v8i32 qf8[3];
    { const size_t qrow = rowbase + rows_w0 + r32;
      if constexpr (QK8) {
#pragma unroll
          for (int ks = 0; ks < 3; ++ks) qf8[ks] = ks < 2 ? *(const v8i32*)((const unsigned char*)Qa + qrow * 1024 + h * 128 + ks * 64 + hi * 32) : *(const v8i32*)((const unsigned char*)Qb + qrow * 512 + h * 64 + hi * 32);
      } else {
#pragma unroll
      for (int ks = 0; ks < NKS; ++ks) {
          if (DIFF) qf[ks] = *(const bf16x8*)(Qa + qrow * 1024 + (h * 2 + mp) * 64 + ks * 16 + hi * 8);
          else if (ks < 8) qf[ks] = *(const bf16x8*)(Qa + qrow * 1024 + h * 128 + ks * 16 + hi * 8);
          else qf[ks] = *(const bf16x8*)(Qb + qrow * 512 + h * 64 + (ks - 8) * 16 + hi * 8);
      } } }
    f32x16 o[4];
#pragma unroll
    for (int d0 = 0; d0 < 4; ++d0) o[d0] = f32x16{};
    float m = -1e30f, l = 0.f;
    const int NT = (q0 + R) / 64, t_last = (rows_w0 + 31) / 64;
    LAS float* wsf = (LAS float*)(lds + WSF_OFF) + wid * 32;
    const int koff = QK8 ? hi * 2048 + r32 * 32 : (DIFF ? mp * 8 * 1024 : 0) + hi * 1024 + r32 * 16;
    const int voff = KPIECES * 1024 + ((lane >> 4) & 1) * 32 + (lane & 3) * 8 + (4 * hi + ((lane & 15) >> 2)) * 64;
    const int qpos = rows_w0 + r32;
    ATT_DMA(0, 0);
#if ATT_PF2
    ATT_DMA(1, 1);
#endif
    f32x4 cvr[3][8], cvg[8];
    const int cve = cv.row0 + 3 * wid;
    if (cv.src != nullptr) {
#pragma unroll
        for (int k = 0; k < 3; ++k) if (cve + k < NEXP)
#pragma unroll
            for (int i = 0; i < 8; ++i) cvr[k][i] = *(const GAS f32x4*)(cv.src + (size_t)(cve + k) * 2048 + 256 * i + 4 * lane);
#pragma unroll
        for (int i = 0; i < 8; ++i) cvg[i] = cv.g != nullptr ? *(const f32x4*)(cv.g + 256 * i + 4 * lane) * cv.scale : (f32x4){cv.scale, cv.scale, cv.scale, cv.scale};
    }
    __builtin_amdgcn_s_waitcnt(0x0F70);
    asm volatile("s_waitcnt vmcnt(0)" ::: "memory"); __syncthreads();
    if (cv.src != nullptr) {
#pragma unroll
        for (int k = 0; k < 3; ++k) if (cve + k < NEXP) { unsigned w[4];
#pragma unroll
            for (int j = 0; j < 4; ++j) w[j] = bg_pack8_fp4(cvr[k][2 * j] * cvg[2 * j], cvr[k][2 * j + 1] * cvg[2 * j + 1]);
            *(GAS u32x4*)(cv.dst + (size_t)(cve + k) * 1024 + 16 * lane) = (u32x4){w[0], w[1], w[2], w[3]}; }
    }
#if ATT_PF2
    int bcur = 0;
#endif
#pragma unroll 1
    for (int t = 0; t < NT; ++t) {
#if ATT_PF2
        const int bb = bcur; const bool more = t + 2 < NT;
#if ATT_DMAPOS == 0
        if (more) ATT_DMA(t + 2, (bcur == 0) ? 2 : bcur - 1);
#else
        if (more && t > t_last) ATT_DMA(t + 2, (bcur == 0) ? 2 : bcur - 1);
#endif
#else
        const int bb = t & 1;
        if (t + 1 < NT) ATT_DMA(t + 1, bb ^ 1);
#endif
        if (t <= t_last) {
            const LAS unsigned char* kb = lds + bb * BUFB + koff;
            f32x16 p0 = f32x16{}, p1 = f32x16{};
            if constexpr (QK8) {
                v8i32 k8a[3], k8c[3];
#pragma unroll
                for (int ks = 0; ks < 3; ++ks) { k8a[ks] = *(const LAS v8i32*)(kb + ks * 4096); k8c[ks] = *(const LAS v8i32*)(kb + ks * 4096 + 1024); }
#pragma unroll
                for (int ks = 0; ks < 3; ++ks) {
                    p0 = __builtin_amdgcn_mfma_scale_f32_32x32x64_f8f6f4(k8a[ks], qf8[ks], p0, 0, 0, 0, 0x7F7F7F7F, 0, 0x7F7F7F7F);
                    p1 = __builtin_amdgcn_mfma_scale_f32_32x32x64_f8f6f4(k8c[ks], qf8[ks], p1, 0, 0, 0, 0x7F7F7F7F, 0, 0x7F7F7F7F);
                }
            } else
            {
                bf16x8 kfa[NKS], kfc[NKS];
#pragma unroll
                for (int ks = 0; ks < ATT_KD; ++ks) { kfa[ks] = *(const LAS bf16x8*)(kb + ks * 2048); kfc[ks] = *(const LAS bf16x8*)(kb + ks * 2048 + 512); }
                __builtin_amdgcn_sched_barrier(0);
#pragma unroll
                for (int ks = 0; ks < NKS; ++ks) {
                    if (ks + ATT_KD < NKS) { kfa[ks + ATT_KD] = *(const LAS bf16x8*)(kb + (ks + ATT_KD) * 2048); kfc[ks + ATT_KD] = *(const LAS bf16x8*)(kb + (ks + ATT_KD) * 2048 + 512); }
                    __builtin_amdgcn_sched_barrier(0);
                    p0 = __builtin_amdgcn_mfma_f32_32x32x16_bf16(kfa[ks], qf[ks], p0, 0, 0, 0);
                    p1 = __builtin_amdgcn_mfma_f32_32x32x16_bf16(kfc[ks], qf[ks], p1, 0, 0, 0);
                    __builtin_amdgcn_sched_barrier(0);
                }
            }
#if ATT_PF2 && ATT_DMAPOS == 1
            if (more) ATT_DMA(t + 2, (bcur == 0) ? 2 : bcur - 1);
#endif
            if (64 * t + 63 > rows_w0) {
                const int kb0 = 64 * t + 4 * hi;
#pragma unroll
                for (int r = 0; r < 16; ++r) { const int kv = kb0 + (r & 3) + 8 * (r >> 2); if (kv > qpos) p0[r] = -INFINITY; if (kv + 32 > qpos) p1[r] = -INFINITY; }
            }
            asm volatile("s_nop 15\n\ts_nop 7" : "+v"(p0), "+v"(p1));
            float rm = max3f(p0[0], p0[1], p1[0]), rm2 = max3f(p0[2], p0[3], p1[1]); rm = max3f(rm, p1[2], p1[3]);
#pragma unroll
            for (int r = 4; r < 16; r += 4) { rm = max3f(rm, p0[r], p0[r + 1]); rm2 = max3f(rm2, p0[r + 2], p0[r + 3]); rm = max3f(rm, p1[r], p1[r + 1]); rm2 = max3f(rm2, p1[r + 2], p1[r + 3]); }
            rm = swapmax(max2f(rm, rm2)) * (QK8 ? 1.0f / MLA_QSCALE : 1.0f);
            const float mn = (rm > m + (QK8 ? ATT_THR8 : ATT_THR)) ? rm : m;
            if (__any(mn > m)) {
                const float al = __builtin_amdgcn_exp2f(m - mn);
                l *= al;
                if (hi == 0) wsf[r32] = al;
                LDS_WAIT(); asm volatile("" ::: "memory");
#pragma unroll
                for (int r = 0; r < 16; ++r) { const float a = wsf[crow(r, hi)];
#pragma unroll
                    for (int d0 = 0; d0 < 4; ++d0) o[d0][r] *= a; }
                LDS_WAIT(); asm volatile("" ::: "memory");
            }
            m = mn;
            float ps = 0.f;
#pragma unroll
            for (int r = 0; r < 16; ++r) { if (PV == 2) { p0[r] = QK8 ? fmaf(p0[r], 1.0f / MLA_QSCALE, ATT_PSH - mn) : p0[r] - mn; p1[r] = QK8 ? fmaf(p1[r], 1.0f / MLA_QSCALE, ATT_PSH - mn) : p1[r] - mn; } else {
                p0[r] = __builtin_amdgcn_exp2f(QK8 ? fmaf(p0[r], 1.0f / MLA_QSCALE, ATT_PSH - mn) : p0[r] - mn); p1[r] = __builtin_amdgcn_exp2f(QK8 ? fmaf(p1[r], 1.0f / MLA_QSCALE, ATT_PSH - mn) : p1[r] - mn); } ps += p0[r] + p1[r]; }
            l += ps;
#if ATT_PF2 && ATT_DMAPOS == 2
            if (more) ATT_DMA(t + 2, (bcur == 0) ? 2 : bcur - 1);
#endif
            if constexpr (QK8) {
                v8i32 p8;
#pragma unroll
                for (int w = 0; w < 4; ++w) { p8[w] = __builtin_amdgcn_cvt_pk_fp8_f32(p0[4 * w + 2], p0[4 * w + 3], __builtin_amdgcn_cvt_pk_fp8_f32(p0[4 * w], p0[4 * w + 1], 0, false), true);
                    p8[4 + w] = __builtin_amdgcn_cvt_pk_fp8_f32(p1[4 * w + 2], p1[4 * w + 3], __builtin_amdgcn_cvt_pk_fp8_f32(p1[4 * w], p1[4 * w + 1], 0, false), true); }
                const LAS unsigned char* vb8 = lds + bb * BUFB + KPIECES * 1024 + hi * 4096 + r32 * 32;
                v8i32 v8f[4];
#pragma unroll
                for (int d0 = 0; d0 < 4; ++d0) v8f[d0] = *(const LAS v8i32*)(vb8 + d0 * 1024);
#pragma unroll
                for (int d0 = 0; d0 < 4; ++d0) o[d0] = __builtin_amdgcn_mfma_scale_f32_32x32x64_f8f6f4(p8, v8f[d0], o[d0], 0, 0, 0, 0x7F7F7F7F, 0, 0x7F7F7F7F);
            } else {
            u32x4 pw[4];
            pw[0] = (u32x4){cvtpk(p0[0], p0[1]), cvtpk(p0[2], p0[3]), cvtpk(p0[4], p0[5]), cvtpk(p0[6], p0[7])};
            pw[1] = (u32x4){cvtpk(p0[8], p0[9]), cvtpk(p0[10], p0[11]), cvtpk(p0[12], p0[13]), cvtpk(p0[14], p0[15])};
            pw[2] = (u32x4){cvtpk(p1[0], p1[1]), cvtpk(p1[2], p1[3]), cvtpk(p1[4], p1[5]), cvtpk(p1[6], p1[7])};
            pw[3] = (u32x4){cvtpk(p1[8], p1[9]), cvtpk(p1[10], p1[11]), cvtpk(p1[12], p1[13]), cvtpk(p1[14], p1[15])};
            const LAS unsigned char* vb = lds + bb * BUFB + voff;
            {
                s16x4 vlo[16], vhh[16];
#pragma unroll
                for (int i = 0; i < ATT_VD; ++i) { vlo[i] = vtr(vb + i * 1024); vhh[i] = vtr(vb + i * 1024 + 512); }
                __builtin_amdgcn_sched_barrier(0);
#pragma unroll
                for (int i = 0; i < 16; ++i) {
                    if (i + ATT_VD < 16) { vlo[i + ATT_VD] = vtr(vb + (i + ATT_VD) * 1024); vhh[i + ATT_VD] = vtr(vb + (i + ATT_VD) * 1024 + 512); }
                    __builtin_amdgcn_sched_barrier(0);
                    const bf16x8 vf = (bf16x8){vlo[i][0], vlo[i][1], vlo[i][2], vlo[i][3], vhh[i][0], vhh[i][1], vhh[i][2], vhh[i][3]};
                    o[i >> 2] = __builtin_amdgcn_mfma_f32_32x32x16_bf16(__builtin_bit_cast(bf16x8, pw[i & 3]), vf, o[i >> 2], 0, 0, 0);
                    __builtin_amdgcn_sched_barrier(0);
                }
            }
            }
        }
#if ATT_PF2
        if (!more) asm volatile("s_waitcnt vmcnt(0)" ::: "memory");
        else if (DIFF || npw == NP) asm volatile("s_waitcnt vmcnt(%0)" :: "n"(NP) : "memory");
        else asm volatile("s_waitcnt vmcnt(%0)" :: "n"(NP - 1) : "memory");
        __syncthreads();
        bcur = (bcur == 2) ? 0 : bcur + 1;
#else
        asm volatile("s_waitcnt vmcnt(0)" ::: "memory"); __syncthreads();
#endif
    }
#undef ATT_DMA
    l = swapsum(l);
    if (hi == 0) wsf[r32] = l;
    LDS_WAIT(); asm volatile("" ::: "memory");
    float rli[16];
#pragma unroll
    for (int r = 0; r < 16; ++r) rli[r] = 1.0f / wsf[crow(r, hi)];
    LDS_WAIT(); asm volatile("" ::: "memory");
    const bool dost = (PV == 0) || (lam > 1e30f);
    if (!DIFF) {
        if (dost)
#pragma unroll
        for (int r = 0; r < 16; ++r) { bf16* orow = Op + (rowbase + rows_w0 + crow(r, hi)) * 1024 + h * 128 + r32;
#pragma unroll
            for (int d0 = 0; d0 < 4; ++d0) orow[d0 * 32] = (bf16)(cvtpk(o[d0][r] * rli[r], 0.f) & 0xffffu); }
    } else {
        LAS float* xch = (LAS float*)lds;
        if (wid >= 4) {
#pragma unroll
            for (int d0 = 0; d0 < 4; ++d0)
#pragma unroll
                for (int r = 0; r < 16; ++r) xch[((wid & 3) * 64 + d0 * 16 + r) * 64 + lane] = o[d0][r] * rli[r];
        }
        __syncthreads();
        if (wid < 4) {
            float ss[16];
#pragma unroll
            for (int r = 0; r < 16; ++r) ss[r] = 0.f;
#pragma unroll
            for (int d0 = 0; d0 < 4; ++d0)
#pragma unroll
                for (int r = 0; r < 16; ++r) { const float d = o[d0][r] * rli[r] - lam * xch[(wid * 64 + d0 * 16 + r) * 64 + lane]; o[d0][r] = d; ss[r] += d * d; }
#pragma unroll
            for (int r = 0; r < 16; ++r) {
#pragma unroll
                for (int of = 1; of < 32; of <<= 1) ss[r] += __shfl_xor(ss[r], of);
                ss[r] = 1.0f / sqrtf(ss[r] * (1.0f / 128.0f) + EPS); }
            float g4[4];
#pragma unroll
            for (int d0 = 0; d0 < 4; ++d0) g4[d0] = gsub[d0 * 32 + r32] * (1.0f - LAMBDA_INIT);
            if (dost)
#pragma unroll
            for (int r = 0; r < 16; ++r) { bf16* orow = Op + (rowbase + rows_w0 + crow(r, hi)) * 1024 + h * 128 + r32;
#pragma unroll
                for (int d0 = 0; d0 < 4; ++d0) orow[d0 * 32] = (bf16)(cvtpk(o[d0][r] * ss[r] * g4[d0], 0.f) & 0xffffu); }
        }
        __syncthreads();
    }
}

template <bool DIFF>
__device__ __forceinline__ void attn_unit_p(LAS unsigned char* lds, int tid, size_t rowbase, int h, int q0,
                                            const bf16* Qa, const bf16* Qb, const bf16* Ka, const bf16* Kb, const bf16* Vp, bf16* Op, float lam, const float* gsub) {
    constexpr bool QK8 = !DIFF;
    constexpr int NP = DIFF ? 4 : 3, KPIECES = 24, R = DIFF ? 128 : 256;
    typedef int v8i32 __attribute__((ext_vector_type(8)));
    const int lane = tid & 63, r32 = lane & 31, hi = lane >> 5, wid = __builtin_amdgcn_readfirstlane(tid >> 6);
    const int mp = DIFF ? (wid >> 2) : 0, rows_w0 = q0 + 32 * (DIFF ? (wid & 3) : wid);
    const bool isK = wid < 4;
    const char* src[NP]; unsigned tstr[NP]; unsigned dsto[NP];
#pragma unroll
    for (int i = 0; i < NP; ++i) { const int pidx = wid * NP + i;
        const size_t bhb = ((size_t)(rowbase >> 13) * 8 + h) * 128 * 16384;
        if (!DIFF) {
            const size_t b8 = ((size_t)(rowbase >> 13) * 8 + h) * 128 * 8192, kr8 = (size_t)(rowbase >> 13) * 128 * 4096;
            const int pq = wid < 4 ? wid * 3 + i : 12 + (wid - 4) * 2 + i;
            if (wid >= 4 && i == 2) { src[i] = nullptr; tstr[i] = 0; dsto[i] = 0; }
            else if (pq < 8) { src[i] = (const char*)Ka + b8 + pq * 1024 + lane * 16; tstr[i] = 8192; dsto[i] = pq * 1024; }
            else if (pq < 12) { src[i] = (const char*)Kb + kr8 + (pq - 8) * 1024 + lane * 16; tstr[i] = 4096; dsto[i] = pq * 1024; }
            else { src[i] = (const char*)Vp + b8 + (pq - 12) * 1024 + lane * 16; tstr[i] = 8192; dsto[i] = KPIECES * 1024 + (pq - 12) * 1024; }
        } else {
            if (pidx < 16) { src[i] = (const char*)Ka + bhb + pidx * 1024 + lane * 16; tstr[i] = 16384; dsto[i] = pidx * 1024; }
            else { src[i] = (const char*)Vp + bhb + (pidx - 16) * 1024 + lane * 16; tstr[i] = 16384; dsto[i] = KPIECES * 1024 + (pidx - 16) * 1024; }
        } }
    const int npw = DIFF ? NP : (wid >= 4 ? 2 : 3);
    const unsigned lds0 = (unsigned)(uintptr_t)lds;
    const int NT = (q0 + R) / 64, t_last = (rows_w0 + 31) / 64;
#define ATT_MOD3(x) ((x) - 3 * (((x) * 43) >> 7))
#define ATT_DMAT(tile) do { const int _tl = (tile) < NT - 1 ? (tile) : NT - 1; const unsigned _sb = (unsigned)(ATT_MOD3(_tl) * BUFB); _Pragma("unroll") for (int _i = 0; _i < NP; ++_i) if (_i < npw) { unsigned _keep; \
        const unsigned _dst = (unsigned)__builtin_amdgcn_readfirstlane((int)(lds0 + _sb + dsto[_i])); \
        asm volatile("s_mov_b32 %0, m0\n\ts_mov_b32 m0, %2\n\ts_nop 0\n\tglobal_load_lds_dwordx4 %1, off\n\ts_mov_b32 m0, %0" : "=&s"(_keep) : "v"(src[_i] + (size_t)_tl * tstr[_i]), "s"(_dst) : "memory"); } } while (0)
    bf16x8 qf[QK8 ? 1 : 4]; v8i32 qf8[3];
    { const size_t qrow = rowbase + rows_w0 + r32;
      if constexpr (QK8) {
#pragma unroll
          for (int ks = 0; ks < 3; ++ks) qf8[ks] = ks < 2 ? *(const v8i32*)((const unsigned char*)Qa + qrow * 1024 + h * 128 + ks * 64 + hi * 32) : *(const v8i32*)((const unsigned char*)Qb + qrow * 512 + h * 64 + hi * 32);
      } else {
#pragma unroll
          for (int ks = 0; ks < 4; ++ks) qf[ks] = *(const bf16x8*)(Qa + qrow * 1024 + (h * 2 + mp) * 64 + ks * 16 + hi * 8);
      } }
    f32x16 o[4];
#pragma unroll
    for (int d0 = 0; d0 < 4; ++d0) o[d0] = f32x16{};
    float m = -1e30f, l = 0.f;
    LAS float* wsf = (LAS float*)(lds + WSF_OFF) + wid * 32;
    const int koff = QK8 ? hi * 2048 + r32 * 32 : mp * 8 * 1024 + hi * 1024 + r32 * 16;
    const int voff = QK8 ? KPIECES * 1024 + hi * 4096 + r32 * 32 : KPIECES * 1024 + ((lane >> 4) & 1) * 32 + (lane & 3) * 8 + (4 * hi + ((lane & 15) >> 2)) * 64;
    const int qpos = rows_w0 + r32;
    if (isK) { ATT_DMAT(0); ATT_DMAT(1); ATT_DMAT(2); } else { ATT_DMAT(0); ATT_DMAT(1); }
    __builtin_amdgcn_s_waitcnt(0x0F70);
    asm volatile("s_waitcnt vmcnt(0)" ::: "memory"); __syncthreads();
    f32x16 pc0 = f32x16{}, pc1 = f32x16{};
    { const LAS unsigned char* kb = lds + koff;
      if constexpr (QK8) {
#pragma unroll
          for (int ks = 0; ks < 3; ++ks) { const v8i32 ka = *(const LAS v8i32*)(kb + ks * 4096), kc = *(const LAS v8i32*)(kb + ks * 4096 + 1024);
              pc0 = __builtin_amdgcn_mfma_scale_f32_32x32x64_f8f6f4(ka, qf8[ks], pc0, 0, 0, 0, 0x7F7F7F7F, 0, 0x7F7F7F7F);
              pc1 = __builtin_amdgcn_mfma_scale_f32_32x32x64_f8f6f4(kc, qf8[ks], pc1, 0, 0, 0, 0x7F7F7F7F, 0, 0x7F7F7F7F); }
      } else {
#pragma unroll
          for (int ks = 0; ks < 4; ++ks) { const bf16x8 ka = *(const LAS bf16x8*)(kb + ks * 2048), kc = *(const LAS bf16x8*)(kb + ks * 2048 + 512);
              pc0 = __builtin_amdgcn_mfma_f32_32x32x16_bf16(ka, qf[ks], pc0, 0, 0, 0); pc1 = __builtin_amdgcn_mfma_f32_32x32x16_bf16(kc, qf[ks], pc1, 0, 0, 0); }
      } }
    constexpr float ESC = QK8 ? 1.0f / MLA_QSCALE : 1.0f, PSH = QK8 ? ATT_PSH : 0.0f, THRV = QK8 ? ATT_THR8 : ATT_THR;
#define ATT_EXP1(v, mnv) __builtin_amdgcn_exp2f(QK8 ? fmaf((v), ESC, PSH - (mnv)) : (v) - (mnv))
#pragma unroll 1
    for (int t = 0; t < NT; ++t) {
        if (isK) ATT_DMAT(t + 3); else ATT_DMAT(t + 2);
        const int sk = ATT_MOD3(t + 1), sv = ATT_MOD3(t);
        unsigned kbu = lds0 + (unsigned)(sk * BUFB + koff), vbu = lds0 + (unsigned)(sv * BUFB + voff);
        asm volatile("" : "+v"(kbu), "+v"(vbu));
        const LAS unsigned char* kb = (const LAS unsigned char*)(uintptr_t)kbu;
        const LAS unsigned char* vb = (const LAS unsigned char*)(uintptr_t)vbu;
        if (t <= t_last) {
            if (64 * t + 63 > rows_w0) {
                const int kb0 = 64 * t + 4 * hi;
#pragma unroll
                for (int r = 0; r < 16; ++r) { const int kv = kb0 + (r & 3) + 8 * (r >> 2); if (kv > qpos) pc0[r] = -INFINITY; if (kv + 32 > qpos) pc1[r] = -INFINITY; }
            }
            asm volatile("s_nop 15\n\ts_nop 7" : "+v"(pc0), "+v"(pc1));
            float rm = max3f(pc0[0], pc0[1], pc1[0]), rm2 = max3f(pc0[2], pc0[3], pc1[1]); rm = max3f(rm, pc1[2], pc1[3]);
#pragma unroll
            for (int r = 4; r < 16; r += 4) { rm = max3f(rm, pc0[r], pc0[r + 1]); rm2 = max3f(rm2, pc0[r + 2], pc0[r + 3]); rm = max3f(rm, pc1[r], pc1[r + 1]); rm2 = max3f(rm2, pc1[r + 2], pc1[r + 3]); }
            rm = swapmax(max2f(rm, rm2)) * ESC;
            const float mn = (rm > m + THRV) ? rm : m;
            if (__any(mn > m)) {
                const float al = __builtin_amdgcn_exp2f(m - mn);
                l *= al;
                if (hi == 0) wsf[r32] = al;
                LDS_WAIT(); asm volatile("" ::: "memory");
#pragma unroll
                for (int r = 0; r < 16; ++r) { const float a = wsf[crow(r, hi)];
#pragma unroll
                    for (int d0 = 0; d0 < 4; ++d0) o[d0][r] *= a; }
                LDS_WAIT(); asm volatile("" ::: "memory");
            }
            m = mn;
            f32x16 pn0 = f32x16{}, pn1 = f32x16{};
            float ps = 0.f;
            if constexpr (QK8) {
                v8i32 p8;
                v8i32 ka[3], kc[3];
                ka[0] = *(const LAS v8i32*)(kb); kc[0] = *(const LAS v8i32*)(kb + 1024);
                __builtin_amdgcn_sched_barrier(0);
#define ATT_CH8(w) do { float a0, a1, a2, a3; if ((w) < 4) { a0 = pc0[4 * (w)]; a1 = pc0[4 * (w) + 1]; a2 = pc0[4 * (w) + 2]; a3 = pc0[4 * (w) + 3]; } \
                    else { a0 = pc1[(4 * (w)) & 15]; a1 = pc1[(4 * (w) + 1) & 15]; a2 = pc1[(4 * (w) + 2) & 15]; a3 = pc1[(4 * (w) + 3) & 15]; } \
                    asm volatile("" : "+v"(a0), "+v"(a1), "+v"(a2), "+v"(a3)); const float e0 = ATT_EXP1(a0, mn), e1 = ATT_EXP1(a1, mn), e2 = ATT_EXP1(a2, mn), e3 = ATT_EXP1(a3, mn); \
                    ps += (e0 + e1) + (e2 + e3); int w8 = __builtin_amdgcn_cvt_pk_fp8_f32(e2, e3, __builtin_amdgcn_cvt_pk_fp8_f32(e0, e1, 0, false), true); asm volatile("" : "+v"(w8), "+v"(ps)); p8[w] = w8; } while (0)
#pragma unroll
                for (int ks = 0; ks < 3; ++ks) {
                    if (ks < 2) { ka[ks + 1] = *(const LAS v8i32*)(kb + (ks + 1) * 4096); kc[ks + 1] = *(const LAS v8i32*)(kb + (ks + 1) * 4096 + 1024); }
                    __builtin_amdgcn_sched_barrier(0);
                    asm volatile("" : "+v"(ka[ks]));
                    pn0 = __builtin_amdgcn_mfma_scale_f32_32x32x64_f8f6f4(ka[ks], qf8[ks], pn0, 0, 0, 0, 0x7F7F7F7F, 0, 0x7F7F7F7F);
                    if (ks == 0) ATT_CH8(0); else if (ks == 1) ATT_CH8(2); else { ATT_CH8(4); ATT_CH8(5); }
                    __builtin_amdgcn_sched_barrier(0);
                    asm volatile("" : "+v"(kc[ks]));
                    pn1 = __builtin_amdgcn_mfma_scale_f32_32x32x64_f8f6f4(kc[ks], qf8[ks], pn1, 0, 0, 0, 0x7F7F7F7F, 0, 0x7F7F7F7F);
                    if (ks == 0) ATT_CH8(1); else if (ks == 1) ATT_CH8(3); else { ATT_CH8(6); ATT_CH8(7); }
                    __builtin_amdgcn_sched_barrier(0);
                }
#undef ATT_CH8
                l += ps;
                v8i32 vf[4];
#pragma unroll
                for (int d0 = 0; d0 < 4; ++d0) vf[d0] = *(const LAS v8i32*)(vb + d0 * 1024);
#pragma unroll
                for (int d0 = 0; d0 < 4; ++d0) o[d0] = __builtin_amdgcn_mfma_scale_f32_32x32x64_f8f6f4(p8, vf[d0], o[d0], 0, 0, 0, 0x7F7F7F7F, 0, 0x7F7F7F7F);
            } else {
                u32x4 pw[4];
                bf16x8 kfa[4], kfc[4];
#pragma unroll
                for (int ks = 0; ks < 2; ++ks) { kfa[ks] = *(const LAS bf16x8*)(kb + ks * 2048); kfc[ks] = *(const LAS bf16x8*)(kb + ks * 2048 + 512); }
                __builtin_amdgcn_sched_barrier(0);
#pragma unroll
                for (int ks = 0; ks < 4; ++ks) {
                    if (ks + 2 < 4) { kfa[ks + 2] = *(const LAS bf16x8*)(kb + (ks + 2) * 2048); kfc[ks + 2] = *(const LAS bf16x8*)(kb + (ks + 2) * 2048 + 512); }
                    __builtin_amdgcn_sched_barrier(0);
                    asm volatile("" : "+v"(kfa[ks]));
                    pn0 = __builtin_amdgcn_mfma_f32_32x32x16_bf16(kfa[ks], qf[ks], pn0, 0, 0, 0);
                    { float a0 = pc0[4 * ks], a1 = pc0[4 * ks + 1], a2 = pc0[4 * ks + 2], a3 = pc0[4 * ks + 3]; asm volatile("" : "+v"(a0), "+v"(a1), "+v"(a2), "+v"(a3));
                      const float e0 = ATT_EXP1(a0, mn), e1 = ATT_EXP1(a1, mn), e2 = ATT_EXP1(a2, mn), e3 = ATT_EXP1(a3, mn);
                      ps += (e0 + e1) + (e2 + e3); unsigned w0 = cvtpk(e0, e1), w1 = cvtpk(e2, e3); asm volatile("" : "+v"(w0), "+v"(w1), "+v"(ps)); pw[ks >> 1][(ks & 1) * 2] = w0; pw[ks >> 1][(ks & 1) * 2 + 1] = w1; }
                    __builtin_amdgcn_sched_barrier(0);
                    asm volatile("" : "+v"(kfc[ks]));
                    pn1 = __builtin_amdgcn_mfma_f32_32x32x16_bf16(kfc[ks], qf[ks], pn1, 0, 0, 0);
                    { float a0 = pc1[4 * ks], a1 = pc1[4 * ks + 1], a2 = pc1[4 * ks + 2], a3 = pc1[4 * ks + 3]; asm volatile("" : "+v"(a0), "+v"(a1), "+v"(a2), "+v"(a3));
                      const float e0 = ATT_EXP1(a0, mn), e1 = ATT_EXP1(a1, mn), e2 = ATT_EXP1(a2, mn), e3 = ATT_EXP1(a3, mn);
                      ps += (e0 + e1) + (e2 + e3); unsigned w0 = cvtpk(e0, e1), w1 = cvtpk(e2, e3); asm volatile("" : "+v"(w0), "+v"(w1), "+v"(ps)); pw[2 + (ks >> 1)][(ks & 1) * 2] = w0; pw[2 + (ks >> 1)][(ks & 1) * 2 + 1] = w1; }
                    __builtin_amdgcn_sched_barrier(0);
                }
                l += ps;
                {
                    s16x4 vlo[16], vhh[16];
#pragma unroll
                    for (int i = 0; i < ATT_VD; ++i) { vlo[i] = vtr(vb + i * 1024); vhh[i] = vtr(vb + i * 1024 + 512); }
                    __builtin_amdgcn_sched_barrier(0);
#pragma unroll
                    for (int i = 0; i < 16; ++i) {
                        if (i + ATT_VD < 16) { vlo[i + ATT_VD] = vtr(vb + (i + ATT_VD) * 1024); vhh[i + ATT_VD] = vtr(vb + (i + ATT_VD) * 1024 + 512); }
                        __builtin_amdgcn_sched_barrier(0);
                        const bf16x8 vfr = (bf16x8){vlo[i][0], vlo[i][1], vlo[i][2], vlo[i][3], vhh[i][0], vhh[i][1], vhh[i][2], vhh[i][3]};
                        o[i >> 2] = __builtin_amdgcn_mfma_f32_32x32x16_bf16(__builtin_bit_cast(bf16x8, pw[i & 3]), vfr, o[i >> 2], 0, 0, 0);
                        __builtin_amdgcn_sched_barrier(0);
                    }
                }
            }
            pc0 = pn0; pc1 = pn1;
        }
        if (npw == 4) asm volatile("s_waitcnt vmcnt(4)" ::: "memory"); else if (npw == 3) asm volatile("s_waitcnt vmcnt(3)" ::: "memory"); else asm volatile("s_waitcnt vmcnt(2)" ::: "memory");
        __syncthreads();
    }
    asm volatile("s_waitcnt vmcnt(0)" ::: "memory"); __syncthreads();
#undef ATT_DMAT
#undef ATT_MOD3
#undef ATT_EXP1
    l = swapsum(l);
    if (hi == 0) wsf[r32] = l;
    LDS_WAIT(); asm volatile("" ::: "memory");
    float rli[16];
#pragma unroll
    for (int r = 0; r < 16; ++r) rli[r] = 1.0f / wsf[crow(r, hi)];
    LDS_WAIT(); asm volatile("" ::: "memory");
    if (!DIFF) {
#pragma unroll
        for (int r = 0; r < 16; ++r) { bf16* orow = Op + (rowbase + rows_w0 + crow(r, hi)) * 1024 + h * 128 + r32;
#pragma unroll
            for (int d0 = 0; d0 < 4; ++d0) orow[d0 * 32] = (bf16)(cvtpk(o[d0][r] * rli[r], 0.f) & 0xffffu); }
    } else {
        LAS float* xch = (LAS float*)lds;
        if (wid >= 4) {
#pragma unroll
            for (int d0 = 0; d0 < 4; ++d0)
#pragma unroll
                for (int r = 0; r < 16; ++r) xch[((wid & 3) * 64 + d0 * 16 + r) * 64 + lane] = o[d0][r] * rli[r];
        }
        __syncthreads();
        if (wid < 4) {
            float ss[16];
#pragma unroll
            for (int r = 0; r < 16; ++r) ss[r] = 0.f;
#pragma unroll
            for (int d0 = 0; d0 < 4; ++d0)
#pragma unroll
                for (int r = 0; r < 16; ++r) { const float d = o[d0][r] * rli[r] - lam * xch[(wid * 64 + d0 * 16 + r) * 64 + lane]; o[d0][r] = d; ss[r] += d * d; }
#pragma unroll
            for (int r = 0; r < 16; ++r) {
#pragma unroll
                for (int of = 1; of < 32; of <<= 1) ss[r] += __shfl_xor(ss[r], of);
                ss[r] = 1.0f / sqrtf(ss[r] * (1.0f / 128.0f) + EPS); }
            float g4[4];
#pragma unroll
            for (int d0 = 0; d0 < 4; ++d0) g4[d0] = gsub[d0 * 32 + r32] * (1.0f - LAMBDA_INIT);
#pragma unroll
            for (int r = 0; r < 16; ++r) { bf16* orow = Op + (rowbase + rows_w0 + crow(r, hi)) * 1024 + h * 128 + r32;
#pragma unroll
                for (int d0 = 0; d0 < 4; ++d0) orow[d0 * 32] = (bf16)(cvtpk(o[d0][r] * ss[r] * g4[d0], 0.f) & 0xffffu); }
        }
        __syncthreads();
    }
}
}

__device__ __forceinline__ void p3_attention(Frame& F, const Ins& I) {
    unsigned char* ws = F.ws;
    const bf16 *QN = (const bf16*)(ws + WS_QN), *QR = (const bf16*)(ws + WS_QR), *KN = (const bf16*)(ws + WS_KN), *KR = (const bf16*)(ws + WS_KR), *V = (const bf16*)(ws + WS_V);
    const bf16 *DQ = (const bf16*)(ws + WS_DQ), *DK = (const bf16*)(ws + WS_DK), *DV = (const bf16*)(ws + WS_DV);
    bf16 *OM = (bf16*)(ws + WS_OM), *OD = (bf16*)(ws + WS_OD);
    const float lam = ((const float*)F.ctl)[CW_LAMBDA];
    LAS unsigned char* lds = F.lds + RING_OFF;
    for (int v = F.vcu; v < 256; v += F.G) {
        const int bh = v >> 4, c = v & 15, b = bh >> 3, h = bh & 7; const size_t rowbase = (size_t)b * SEQ;
#ifndef ATT_PIPE_M
#define ATT_PIPE_M ATT_PIPE
#endif
#ifndef ATT_PIPE_D
#define ATT_PIPE_D ATT_PIPE
#endif
#ifdef PROBE_ATT
#undef ATT_PIPE_M
#undef ATT_PIPE_D
#define ATT_PIPE_M 0
#define ATT_PIPE_D 0
#endif
#if ATT_PIPE_M
#define ATT_UNIT_M att::attn_unit_p<false>
#else
#define ATT_UNIT_M att::attn_unit<false>
#endif
#if ATT_PIPE_D
#define ATT_UNIT_D att::attn_unit_p<true>
#else
#define ATT_UNIT_D att::attn_unit<true>
#endif
#if ATT_BGCONV && !ATT_PIPE_M && !ATT_PIPE_D
#define ATT_CV(j) att::BgConv{(j) < 3 ? I.expert_u : I.expert_v, ws + ((j) < 3 ? WS_EU : WS_EV), (j) < 3 ? I.g_norm2 : nullptr, (j) < 3 ? EU_SCALE4 : EV_SCALE4, (v * 3 + (j) % 3) * 24}
#else
#define ATT_CV(j) att::BgConv{nullptr, nullptr, nullptr, 0.f, 0}
#endif
        ATT_UNIT_M(lds, F.tid, rowbase, h, (31 - c) * 256, QN, QR, KN, KR, V, OM, lam, I.g_subln, ATT_CV(0));
        ATT_UNIT_D(lds, F.tid, rowbase, h, (63 - c) * 128, DQ, nullptr, DK, nullptr, DV, OD, lam, I.g_subln, ATT_CV(1));
        ATT_UNIT_D(lds, F.tid, rowbase, h, (47 - c) * 128, DQ, nullptr, DK, nullptr, DV, OD, lam, I.g_subln, ATT_CV(2));
        ATT_UNIT_D(lds, F.tid, rowbase, h, (16 + c) * 128, DQ, nullptr, DK, nullptr, DV, OD, lam, I.g_subln, ATT_CV(3));
        ATT_UNIT_D(lds, F.tid, rowbase, h, c * 128, DQ, nullptr, DK, nullptr, DV, OD, lam, I.g_subln, ATT_CV(4));
        ATT_UNIT_M(lds, F.tid, rowbase, h, c * 256, QN, QR, KN, KR, V, OM, lam, I.g_subln, ATT_CV(5));
#undef ATT_CV
#ifdef PROBE_ATT
        {
            bf16* OX = (bf16*)(ws + WS_CQ);
            att::attn_unit<false, PROBE_ATT>(lds, F.tid, rowbase, h, (31 - c) * 256, QN, QR, KN, KR, V, OX, lam, I.g_subln);
            att::attn_unit<true, PROBE_ATT>(lds, F.tid, rowbase, h, (63 - c) * 128, DQ, nullptr, DK, nullptr, DV, OX, lam, I.g_subln);
            att::attn_unit<true, PROBE_ATT>(lds, F.tid, rowbase, h, (47 - c) * 128, DQ, nullptr, DK, nullptr, DV, OX, lam, I.g_subln);
            att::attn_unit<true, PROBE_ATT>(lds, F.tid, rowbase, h, (16 + c) * 128, DQ, nullptr, DK, nullptr, DV, OX, lam, I.g_subln);
            att::attn_unit<true, PROBE_ATT>(lds, F.tid, rowbase, h, c * 128, DQ, nullptr, DK, nullptr, DV, OX, lam, I.g_subln);
            att::attn_unit<false, PROBE_ATT>(lds, F.tid, rowbase, h, c * 256, QN, QR, KN, KR, V, OX, lam, I.g_subln);
        }
#endif
    }
}

__device__ __forceinline__ void wave_argmax(float v, int idx, float& mv, int& mi) {
#pragma unroll
    for (int o = 1; o < 64; o <<= 1) { const float ov = __shfl_xor(v, o); const int oi = __shfl_xor(idx, o); if (ov > v || (ov == v && oi < idx)) { v = ov; idx = oi; } }
    mv = v; mi = idx;
}
__device__ __forceinline__ void p7_routing_ref(Frame& F) {
    unsigned char* ws = F.ws;
    const bf16* QP = (const bf16*)(ws + WS_QP); const bf16* SKB = (const bf16*)(ws + WS_SKB);
    int* IDX = (int*)(ws + WS_IDX); float* GT = (float*)(ws + WS_GT);
    LAS float* wl = (LAS float*)(F.lds + RING_OFF + F.wave * 4096);
    LAS float* qs = wl; LAS float* v1s = wl + 256; LAS int* i1s = (LAS int*)(wl + 272); LAS float* v2s = wl + 288; LAS int* i2s = (LAS int*)(wl + 304);
    const int gw = F.vcu * NWAVES + F.wave, NGW = F.G * NWAVES, lane = F.lane;
    for (int it = gw; it < T * 8; it += NGW) {
        { const u32x2 w = *(const u32x2*)(QP + (size_t)it * 256 + lane * 4); qs[lane * 4 + 0] = bflo(w.x); qs[lane * 4 + 1] = bfhi(w.x); qs[lane * 4 + 2] = bflo(w.y); qs[lane * 4 + 3] = bfhi(w.y); }
        LDS_WAIT(); asm volatile("" ::: "memory");
        float sc[2][2];
#pragma unroll
        for (int hf = 0; hf < 2; ++hf)
#pragma unroll
            for (int kk = 0; kk < 2; ++kk) { const bf16* kr = SKB + (size_t)(hf * 128 + kk * 64 + lane) * 256 + hf * 128; float s = 0.f;
#pragma unroll 4
                for (int d = 0; d < 128; d += 8) { const u32x4 kw = *(const u32x4*)(kr + d);
                    const f32x4 qa4 = *(const LAS f32x4*)(qs + hf * 128 + d), qb4 = *(const LAS f32x4*)(qs + hf * 128 + d + 4);
                    s += (qa4[0] * bflo(kw.x) + qa4[1] * bfhi(kw.x)) + (qa4[2] * bflo(kw.y) + qa4[3] * bfhi(kw.y)) + (qb4[0] * bflo(kw.z) + qb4[1] * bfhi(kw.z)) + (qb4[2] * bflo(kw.w) + qb4[3] * bfhi(kw.w)); }
                sc[hf][kk] = s; }
#pragma unroll
        for (int hf = 0; hf < 2; ++hf) {
            float a = sc[hf][0], b = sc[hf][1];
            for (int r = 0; r < 16; ++r) {
                float lv; int li; if (b > a) { lv = b; li = lane + 64; } else { lv = a; li = lane; }
                float mv; int mi; wave_argmax(lv, li, mv, mi);
                if (mi == lane) a = -INFINITY; if (mi == lane + 64) b = -INFINITY;
                if (lane == 0) { if (hf == 0) { v1s[r] = mv; i1s[r] = mi; } else { v2s[r] = mv; i2s[r] = mi; } }
            }
        }
        LDS_WAIT(); asm volatile("" ::: "memory");
        float cv[4];
#pragma unroll
        for (int j = 0; j < 4; ++j) { const int c = lane * 4 + j; cv[j] = v1s[c >> 4] + v2s[c & 15]; }
        float mycs = 0.f; int myc = 0;
        for (int r = 0; r < 16; ++r) {
            float lv = cv[0]; int li = lane * 4;
#pragma unroll
            for (int j = 1; j < 4; ++j) if (cv[j] > lv) { lv = cv[j]; li = lane * 4 + j; }
            float mv; int mi; wave_argmax(lv, li, mv, mi);
#pragma unroll
            for (int j = 0; j < 4; ++j) if (mi == lane * 4 + j) cv[j] = -INFINITY;
            if (lane == r) { mycs = mv; myc = mi; }
        }
        float mx = mycs;
#pragma unroll
        for (int o = 1; o < 16; o <<= 1) mx = fmaxf(mx, __shfl_xor(mx, o));
        const float e = __expf(mycs - mx); float se = e;
#pragma unroll
        for (int o = 1; o < 16; o <<= 1) se += __shfl_xor(se, o);
        if (lane < 16) { const int ex = i1s[myc >> 4] * 128 + i2s[myc & 15];
            IDX[(size_t)it * 16 + lane] = ex; GT[(size_t)it * 16 + lane] = e / se; }
        LDS_WAIT(); asm volatile("" ::: "memory");
    }
}

__device__ __forceinline__ void unpack8(const u32x4 w, float (&f)[8]) { f[0] = bflo(w.x); f[1] = bfhi(w.x); f[2] = bflo(w.y); f[3] = bfhi(w.y); f[4] = bflo(w.z); f[5] = bfhi(w.z); f[6] = bflo(w.w); f[7] = bfhi(w.w); }
__device__ __forceinline__ void p8_gather(Frame& F, const Ins& I, float* out) {
    unsigned char* ws = F.ws;
    const float* X2 = (const float*)(ws + WS_X2); const bf16* EU = (const bf16*)(ws + WS_EU); const bf16* EV = (const bf16*)(ws + WS_EV);
    const int* IDX = (const int*)(ws + WS_IDX); const float* GT = (const float*)(ws + WS_GT);
    const float* ssq2 = (const float*)(ws + WS_PSQ2);
    const int gw = F.vcu * NWAVES + F.wave, NGW = F.G * NWAVES, lane = F.lane;
    for (int t = gw; t < T; t += NGW) {
        float xv[4][8], acc[4][8];
#pragma unroll
        for (int j = 0; j < 4; ++j) { const f32x4 a = *(const f32x4*)(X2 + (size_t)t * 2048 + 512 * j + 8 * lane), b = *(const f32x4*)(X2 + (size_t)t * 2048 + 512 * j + 8 * lane + 4);
            xv[j][0] = a[0]; xv[j][1] = a[1]; xv[j][2] = a[2]; xv[j][3] = a[3]; xv[j][4] = b[0]; xv[j][5] = b[1]; xv[j][6] = b[2]; xv[j][7] = b[3];
#pragma unroll
            for (int e = 0; e < 8; ++e) acc[j][e] = 0.f; }
        const float rstd2 = 1.0f / sqrtf(sum32(ssq2 + (size_t)t * 32) * (1.0f / 2048.0f) + EPS);
        const int id0 = IDX[(size_t)t * 128 + lane], id1 = IDX[(size_t)t * 128 + 64 + lane];
        const float g0 = GT[(size_t)t * 128 + lane], g1 = GT[(size_t)t * 128 + 64 + lane];
        for (int i = 0; i < 128; ++i) {
            const int ex = __builtin_amdgcn_readlane(i < 64 ? id0 : id1, i & 63);
            const float gate = __builtin_bit_cast(float, __builtin_amdgcn_readlane(__builtin_bit_cast(int, i < 64 ? g0 : g1), i & 63));
            const bf16* ur = EU + (size_t)ex * 2048 + 8 * lane; const bf16* vr = EV + (size_t)ex * 2048 + 8 * lane;
            u32x4 uw[4], vw[4];
#pragma unroll
            for (int j = 0; j < 4; ++j) { uw[j] = *(const u32x4*)(ur + 512 * j); vw[j] = *(const u32x4*)(vr + 512 * j); }
            float dot = 0.f;
#pragma unroll
            for (int j = 0; j < 4; ++j) { float f[8]; unpack8(uw[j], f);
#pragma unroll
                for (int e = 0; e < 8; ++e) dot += f[e] * xv[j][e]; }
            const float a = wave_sum(dot) * rstd2;
            const float z2 = 1.5957691216057308f * (a + 0.044715f * a * a * a);
            const float w = gate * a * __builtin_amdgcn_rcpf(1.0f + __builtin_amdgcn_exp2f(-z2 * LOG2E));
#pragma unroll
            for (int j = 0; j < 4; ++j) { float f[8]; unpack8(vw[j], f);
#pragma unroll
                for (int e = 0; e < 8; ++e) acc[j][e] += w * f[e]; }
        }
        float s = 0.f;
#pragma unroll
        for (int j = 0; j < 4; ++j)
#pragma unroll
            for (int e = 0; e < 8; ++e) { acc[j][e] += xv[j][e]; s += acc[j][e] * acc[j][e]; }
        float rs = 1.0f / sqrtf(wave_sum(s) * (1.0f / 2048.0f) + EPS);
#ifdef ATT_CHECK
        if (((const unsigned*)F.ctl)[ATT_CHECK_WORD] > ATT_CHECK_MAX) rs = __builtin_nanf("");
#endif
#pragma unroll
        for (int j = 0; j < 4; ++j) { const f32x4 ga = *(const f32x4*)(I.g_final + 512 * j + 8 * lane), gb = *(const f32x4*)(I.g_final + 512 * j + 8 * lane + 4);
            *(f32x4*)(out + (size_t)t * 2048 + 512 * j + 8 * lane) = (f32x4){acc[j][0] * rs * ga[0], acc[j][1] * rs * ga[1], acc[j][2] * rs * ga[2], acc[j][3] * rs * ga[3]};
            *(f32x4*)(out + (size_t)t * 2048 + 512 * j + 8 * lane + 4) = (f32x4){acc[j][4] * rs * gb[0], acc[j][5] * rs * gb[1], acc[j][6] * rs * gb[2], acc[j][7] * rs * gb[3]}; }
    }
}

namespace rt {
typedef short bf16x8 __attribute__((ext_vector_type(8)));
typedef float f32x16 __attribute__((ext_vector_type(16)));
__device__ __forceinline__ unsigned f2sort(float f) { const unsigned u = __float_as_uint(f); return u ^ ((unsigned)((int)u >> 31) | 0x80000000u); }
__device__ __forceinline__ float sort2f(unsigned s) { return __uint_as_float(s ^ ((s >> 31) ? 0x80000000u : 0xFFFFFFFFu)); }
__device__ __forceinline__ unsigned umax(unsigned a, unsigned b) { return a > b ? a : b; }
__device__ __forceinline__ unsigned pair_max(unsigned m) { auto rr = __builtin_amdgcn_permlane32_swap(m, m, false, false); const unsigned a = rr[0], b = rr[1]; return umax(a, b); }
constexpr int KEYS_BYTES = 65536, LIST_OFF = KEYS_BYTES, LIST_WAVE = 6144 + 512;
}
__device__ __forceinline__ void rt_load_keys(Frame& F, const Ins& I) {
    LAS unsigned char* lds = F.lds + RING_OFF;
    for (int it = F.tid; it < 2 * 128 * 16; it += NWAVES * 64) {
        const int c = it & 15, n = (it >> 4) & 127, hf = it >> 11;
        const float* sp = I.sub_keys + (size_t)hf * 16384 + n * 128 + c * 8;
        const f32x4 a = *(const f32x4*)sp, b = *(const f32x4*)(sp + 4);
        v4u o; o.x = pk2(a.x, a.y); o.y = pk2(a.z, a.w); o.z = pk2(b.x, b.y); o.w = pk2(b.z, b.w);
        *(LAS v4u*)(lds + hf * 32768 + c * 2048 + n * 16) = o;
    }
    __syncthreads();
}
template <bool TO_LDS>
__device__ __forceinline__ void rt_task(Frame& F, int task, LAS unsigned* lst) {
    using namespace rt;
    unsigned char* ws = F.ws;
    const bf16* QP = (const bf16*)(ws + WS_QP);
    int* IDX = (int*)(ws + WS_IDX); float* GT = (float*)(ws + WS_GT);
    LAS unsigned char* lds = F.lds + RING_OFF;
    const int lane = F.lane, r32 = lane & 31, hi = lane >> 5;
        const size_t row = (size_t)task * 32 + r32;
#pragma unroll 1
        for (int hf = 0; hf < 2; ++hf) {
            bf16x8 qf[8];
#pragma unroll
            for (int ks = 0; ks < 8; ++ks) qf[ks] = *(const bf16x8*)(QP + row * 256 + hf * 128 + ks * 16 + hi * 8);
            unsigned k[64];
            const LAS unsigned char* kb0 = lds + hf * 32768 + hi * 2048 + r32 * 16;
#pragma unroll
            for (int kb = 0; kb < 4; ++kb) {
                f32x16 acc = f32x16{};
#pragma unroll
                for (int ks = 0; ks < 8; ++ks) acc = __builtin_amdgcn_mfma_f32_32x32x16_bf16(*(const LAS bf16x8*)(kb0 + ks * 4096 + kb * 512), qf[ks], acc, 0, 0, 0);
#pragma unroll
                for (int r = 0; r < 16; ++r) { const int n = 32 * kb + (r & 3) + 8 * (r >> 2) + 4 * hi; k[16 * kb + r] = (f2sort(acc[r]) & ~0x7Fu) | (unsigned)(127 - n); }
            }
#pragma unroll 1
            for (int rd = 0; rd < 16; ++rd) {
                unsigned m = k[0];
#pragma unroll
                for (int i = 1; i < 64; ++i) m = umax(m, k[i]);
                const unsigned g = pair_max(m);
#pragma unroll
                for (int i = 0; i < 64; ++i) k[i] = (k[i] == g) ? 0u : k[i];
                if (hi == 0) lst[hf * 16 + rd] = g;
            }
        }
        LDS_WAIT(); asm volatile("" ::: "memory");
        float v1[16], v2[16];
#pragma unroll
        for (int q = 0; q < 4; ++q) { const v4u a = *(const LAS v4u*)(lst + 4 * q), b = *(const LAS v4u*)(lst + 16 + 4 * q);
#pragma unroll
            for (int e = 0; e < 4; ++e) { v1[4 * q + e] = sort2f(a[e] & ~0x7Fu); v2[4 * q + e] = sort2f(b[e] & ~0x7Fu); } }
        unsigned cand[50];
        { int ci = 0;
#pragma unroll
          for (int a = 0; a < 16; ++a)
#pragma unroll
              for (int b = 0; b < 16; ++b) if ((a + 1) * (b + 1) <= 16) { cand[ci] = (f2sort(v1[a] + v2[b]) & ~0xFFu) | (unsigned)(255 - (a * 16 + b)); ++ci; } }
#pragma unroll 1
        for (int rd = 0; rd < 16; ++rd) {
            unsigned m = cand[0];
#pragma unroll
            for (int i = 1; i < 50; ++i) m = umax(m, cand[i]);
#pragma unroll
            for (int i = 0; i < 50; ++i) cand[i] = (cand[i] == m) ? 0u : cand[i];
            if (hi == 0) lst[32 + rd] = m;
        }
        LDS_WAIT(); asm volatile("" ::: "memory");
        const float cmax = sort2f(lst[32] & ~0xFFu);
        float ev[8]; int ex[8]; float se = 0.f;
#pragma unroll
        for (int j = 0; j < 8; ++j) { const unsigned key = lst[32 + 8 * hi + j]; const int ab = 255 - (int)(key & 0xFFu);
            const int i1 = 127 - (int)(lst[ab >> 4] & 0x7Fu), i2 = 127 - (int)(lst[16 + (ab & 15)] & 0x7Fu);
            ex[j] = i1 * 128 + i2; ev[j] = __expf(sort2f(key & ~0xFFu) - cmax); se += ev[j]; }
        { auto rr = __builtin_amdgcn_permlane32_swap(__float_as_uint(se), __float_as_uint(se), false, false); const unsigned a = rr[0], b = rr[1]; se = __uint_as_float(a) + __uint_as_float(b); }
        const float inv = 1.0f / se;
        if (TO_LDS) {
#pragma unroll
            for (int j = 0; j < 8; ++j) { lst[8 * hi + j] = (unsigned)ex[j]; lst[16 + 8 * hi + j] = __float_as_uint(ev[j] * inv); }
        } else {
        int* ip = IDX + row * 16 + 8 * hi; float* gp = GT + row * 16 + 8 * hi;
        *(GAS v4u*)ip = (v4u){(unsigned)ex[0], (unsigned)ex[1], (unsigned)ex[2], (unsigned)ex[3]}; *(GAS v4u*)(ip + 4) = (v4u){(unsigned)ex[4], (unsigned)ex[5], (unsigned)ex[6], (unsigned)ex[7]};
        *(GAS f32x4*)gp = (f32x4){ev[0] * inv, ev[1] * inv, ev[2] * inv, ev[3] * inv}; *(GAS f32x4*)(gp + 4) = (f32x4){ev[4] * inv, ev[5] * inv, ev[6] * inv, ev[7] * inv};
        }
        LDS_WAIT(); asm volatile("" ::: "memory");
}
__device__ __forceinline__ void p8_routing(Frame& F, const Ins& I) {
    using namespace rt;
    rt_load_keys(F, I);
    LAS unsigned* lst = (LAS unsigned*)(F.lds + RING_OFF + LIST_OFF + F.wave * LIST_WAVE) + (F.lane & 31) * 48;
    const int gw = F.vcu * NWAVES + F.wave, NGW = F.G * NWAVES;
    for (int task = gw; task < T * 8 / 32; task += NGW) rt_task<false>(F, task, lst);
}
#ifndef PEER_U4
#define PEER_U4 1
#endif
#ifndef PEER_V4
#define PEER_V4 1
#endif
constexpr bool U4 = PEER_U4 != 0, V4 = PEER_V4 != 0;
constexpr bool PERMX = U4 && V4;
constexpr float EU_SCALE = U4 ? EU_SCALE4 : 64.0f, EV_SCALE = V4 ? EV_SCALE4 : 4.0f;
typedef float f32x2v __attribute__((ext_vector_type(2)));
__device__ __forceinline__ unsigned pk4_fp8(float a, float b, float c, float d) { int t = __builtin_amdgcn_cvt_pk_fp8_f32(a, b, 0, false); t = __builtin_amdgcn_cvt_pk_fp8_f32(c, d, t, true); return (unsigned)t; }
__device__ __forceinline__ void convert_experts_fp8(Frame& F, const Ins& I) {
    const size_t gt = (size_t)(F.vcu * NWAVES * 64) + F.tid, NT = (size_t)F.G * NWAVES * 64;
    const size_t nchunk = (size_t)NEXP * D_MODEL / 16;
    unsigned char* EU = F.ws + WS_EU; unsigned char* EV = F.ws + WS_EV;
    for (size_t c = gt; c < nchunk; c += NT) {
        const int d = (int)((c * 16) & (D_MODEL - 1));
        v4u o, p;
#pragma unroll
        for (int k = 0; k < 4; ++k) {
            const f32x4 a = *(const GAS f32x4*)(I.expert_u + c * 16 + 4 * k), g = *(const f32x4*)(I.g_norm2 + d + 4 * k), b = *(const GAS f32x4*)(I.expert_v + c * 16 + 4 * k);
            o[k] = pk4_fp8(a.x * g.x * EU_SCALE, a.y * g.y * EU_SCALE, a.z * g.z * EU_SCALE, a.w * g.w * EU_SCALE);
            p[k] = pk4_fp8(b.x * EV_SCALE, b.y * EV_SCALE, b.z * EV_SCALE, b.w * EV_SCALE);
        }
        *(GAS v4u*)(EU + c * 16) = o; *(GAS v4u*)(EV + c * 16) = p;
    }
}
#ifndef PEER_FP8
#define PEER_FP6 1
#endif
#ifdef PEER_FP6
typedef float v32f_t __attribute__((ext_vector_type(32)));
typedef float v16f_t __attribute__((ext_vector_type(16)));
typedef unsigned v6u_t __attribute__((ext_vector_type(6)));
constexpr int EROW = 1536;
#define FP4_UNP(w, sel) __builtin_amdgcn_cvt_scalef32_pk_f32_fp4((w), 1.0f, (sel))
__device__ __forceinline__ void unpack32_fp4(const u32x4 a, f32x2v (&r)[16]) {
    r[0] = FP4_UNP(a.x, 0); r[1] = FP4_UNP(a.x, 1); r[2] = FP4_UNP(a.x, 2); r[3] = FP4_UNP(a.x, 3); r[4] = FP4_UNP(a.y, 0); r[5] = FP4_UNP(a.y, 1); r[6] = FP4_UNP(a.y, 2); r[7] = FP4_UNP(a.y, 3);
    r[8] = FP4_UNP(a.z, 0); r[9] = FP4_UNP(a.z, 1); r[10] = FP4_UNP(a.z, 2); r[11] = FP4_UNP(a.z, 3); r[12] = FP4_UNP(a.w, 0); r[13] = FP4_UNP(a.w, 1); r[14] = FP4_UNP(a.w, 2); r[15] = FP4_UNP(a.w, 3);
}
__device__ __forceinline__ unsigned pack8_fp4(const f32x4 lo, const f32x4 hi) {
    unsigned w = __builtin_amdgcn_cvt_scalef32_pk_fp4_f32(0u, lo[0], lo[1], 1.0f, 0); w = __builtin_amdgcn_cvt_scalef32_pk_fp4_f32(w, lo[2], lo[3], 1.0f, 1);
    w = __builtin_amdgcn_cvt_scalef32_pk_fp4_f32(w, hi[0], hi[1], 1.0f, 2); return __builtin_amdgcn_cvt_scalef32_pk_fp4_f32(w, hi[2], hi[3], 1.0f, 3); }
__device__ __forceinline__ void convert_experts_fp4(Frame& F, const Ins& I) {
    if (!U4 && !V4) return;
    unsigned char* EU = F.ws + WS_EU; unsigned char* EV = F.ws + WS_EV;
    const int gw = F.vcu * NWAVES + F.wave, NGW = F.G * NWAVES, lane = F.lane;
    LAS unsigned char* img = F.lds + RING_OFF + F.wave * 9216;
    f32x4 gsc[8];
#pragma unroll
    for (int k = 0; k < 8; ++k) gsc[k] = *(const f32x4*)(I.g_norm2 + (64 * k + lane) * 4) * EU_SCALE;
    for (int e = gw; e < NEXP; e += NGW) {
        f32x4 ru[8], rv[8];
#pragma unroll
        for (int k = 0; k < 8; ++k) { if (U4) ru[k] = *(const GAS f32x4*)(I.expert_u + (size_t)e * 2048 + (64 * k + lane) * 4); if (V4) rv[k] = *(const GAS f32x4*)(I.expert_v + (size_t)e * 2048 + (64 * k + lane) * 4); }
        if (PERMX) {
            unsigned wu[4], wv[4];
#pragma unroll
            for (int j = 0; j < 4; ++j) { wu[j] = pack8_fp4(ru[2 * j] * gsc[2 * j], ru[2 * j + 1] * gsc[2 * j + 1]); wv[j] = pack8_fp4(rv[2 * j] * EV_SCALE, rv[2 * j + 1] * EV_SCALE); }
            *(GAS v4u*)(EU + (size_t)e * 1024 + 16 * lane) = (v4u){wu[0], wu[1], wu[2], wu[3]}; *(GAS v4u*)(EV + (size_t)e * 1024 + 16 * lane) = (v4u){wv[0], wv[1], wv[2], wv[3]};
            continue;
        }
#pragma unroll
        for (int tb = 0; tb < 2; ++tb) {
            if (tb == 0 ? !U4 : !V4) continue;
#pragma unroll
            for (int k = 0; k < 8; ++k) { const int i4 = 64 * k + lane;
                *(LAS f32x4*)(img + (i4 >> 3) * 144 + (i4 & 7) * 16) = tb == 0 ? ru[k] * gsc[k] : rv[k] * EV_SCALE; }
            LDS_WAIT(); asm volatile("" ::: "memory");
            unsigned w[4];
#pragma unroll
            for (int j = 0; j < 4; ++j) w[j] = pack8_fp4(*(const LAS f32x4*)(img + lane * 144 + 32 * j), *(const LAS f32x4*)(img + lane * 144 + 32 * j + 16));
            LDS_WAIT(); asm volatile("" ::: "memory");
            *(GAS v4u*)((tb == 0 ? EU : EV) + (size_t)e * 1024 + 16 * lane) = (v4u){w[0], w[1], w[2], w[3]};
        }
    }
    __syncthreads();
}
__device__ __forceinline__ void convert_experts_fp6(Frame& F, const Ins& I) {
    if (U4 && V4) return;
    const size_t gt = (size_t)(F.vcu * NWAVES * 64) + F.tid, NT = (size_t)F.G * NWAVES * 64;
    const size_t nblk = (size_t)NEXP * 64;
    unsigned char* EU = F.ws + WS_EU; unsigned char* EV = F.ws + WS_EV;
    LAS int* ptab = (LAS int*)(F.lds + RING_OFF + 65536);
#pragma unroll 1
    for (int j = 0; j < 32; ++j) {
        v16f_t a, b;
#pragma unroll
        for (int i = 0; i < 16; ++i) { a[i] = (i == j) ? 1.0f : 0.0f; b[i] = (i + 16 == j) ? 1.0f : 0.0f; }
        const v32f_t r = __builtin_amdgcn_cvt_scalef32_pk32_f32_fp6(__builtin_amdgcn_cvt_scalef32_2xpk16_fp6_f32(a, b, 1.0f), 1.0f);
        int pos = 0;
#pragma unroll
        for (int i = 0; i < 32; ++i) pos = (r[i] != 0.0f) ? i : pos;
        ptab[j] = pos;
    }
    LDS_WAIT(); asm volatile("" ::: "memory");
    bool inter = true;
#pragma unroll 1
    for (int j = 0; j < 32; ++j) inter = inter && (ptab[j] == ((j < 16) ? 2 * j : 2 * (j - 16) + 1));
    if (inter) {
        const int gw = F.vcu * NWAVES + F.wave, NGW = F.G * NWAVES, lane = F.lane;
        LAS unsigned char* img = F.lds + RING_OFF + F.wave * 9216;
        f32x4 gsc[8];
#pragma unroll
        for (int k = 0; k < 8; ++k) gsc[k] = *(const f32x4*)(I.g_norm2 + (64 * k + lane) * 4) * EU_SCALE;
        for (int e = gw; e < NEXP; e += NGW) {
            f32x4 ru[8], rv[8];
#pragma unroll
            for (int k = 0; k < 8; ++k) { if (!U4) ru[k] = *(const GAS f32x4*)(I.expert_u + (size_t)e * 2048 + (64 * k + lane) * 4); if (!V4) rv[k] = *(const GAS f32x4*)(I.expert_v + (size_t)e * 2048 + (64 * k + lane) * 4); }
#pragma unroll
            for (int tb = 0; tb < 2; ++tb) {
                if (tb == 0 ? U4 : V4) continue;
#pragma unroll
                for (int k = 0; k < 8; ++k) { const int i4 = 64 * k + lane;
                    *(LAS f32x4*)(img + (i4 >> 3) * 144 + (i4 & 7) * 16) = tb == 0 ? ru[k] * gsc[k] : rv[k] * EV_SCALE; }
                LDS_WAIT(); asm volatile("" ::: "memory");
                v16f_t ya, yb;
#pragma unroll
                for (int j = 0; j < 8; ++j) { const f32x4 x4 = *(const LAS f32x4*)(img + lane * 144 + 16 * j); ya[2 * j] = x4[0]; yb[2 * j] = x4[1]; ya[2 * j + 1] = x4[2]; yb[2 * j + 1] = x4[3]; }
                LDS_WAIT(); asm volatile("" ::: "memory");
                const v6u_t pk = __builtin_amdgcn_cvt_scalef32_2xpk16_fp6_f32(ya, yb, 1.0f);
                unsigned char* dst = (tb == 0 ? EU : EV) + (size_t)e * EROW;
                *(GAS v4u*)(dst + 16 * lane) = (v4u){pk[0], pk[1], pk[2], pk[3]}; *(GAS u32x2*)(dst + 1024 + 8 * lane) = (u32x2){pk[4], pk[5]};
            }
        }
    } else {
    LAS float* scr = (LAS float*)(F.lds + RING_OFF) + F.tid;
    for (size_t c = gt; c < nblk; c += NT) {
        const size_t e = c >> 6; const int l = (int)(c & 63), d = 32 * l;
        v16f_t ya, yb;
        if (!U4) {
#pragma unroll
        for (int k = 0; k < 8; ++k) { const f32x4 a0 = *(const GAS f32x4*)(I.expert_u + c * 32 + 4 * k), g0 = *(const f32x4*)(I.g_norm2 + d + 4 * k);
#pragma unroll
            for (int j = 0; j < 4; ++j) scr[(4 * k + j) * 512] = a0[j] * g0[j] * EU_SCALE; }
#pragma unroll
        for (int j = 0; j < 16; ++j) { ya[j] = scr[ptab[j] * 512]; yb[j] = scr[ptab[16 + j] * 512]; }
        const v6u_t pu = __builtin_amdgcn_cvt_scalef32_2xpk16_fp6_f32(ya, yb, 1.0f);
        *(GAS v4u*)(EU + e * EROW + 16 * l) = (v4u){pu[0], pu[1], pu[2], pu[3]}; *(GAS u32x2*)(EU + e * EROW + 1024 + 8 * l) = (u32x2){pu[4], pu[5]};
        }
        if (!V4) {
#pragma unroll
        for (int k = 0; k < 8; ++k) { const f32x4 b0 = *(const GAS f32x4*)(I.expert_v + c * 32 + 4 * k);
#pragma unroll
            for (int j = 0; j < 4; ++j) scr[(4 * k + j) * 512] = b0[j] * EV_SCALE; }
#pragma unroll
        for (int j = 0; j < 16; ++j) { ya[j] = scr[ptab[j] * 512]; yb[j] = scr[ptab[16 + j] * 512]; }
        const v6u_t pv = __builtin_amdgcn_cvt_scalef32_2xpk16_fp6_f32(ya, yb, 1.0f);
        *(GAS v4u*)(EV + e * EROW + 16 * l) = (v4u){pv[0], pv[1], pv[2], pv[3]}; *(GAS u32x2*)(EV + e * EROW + 1024 + 8 * l) = (u32x2){pv[4], pv[5]};
        }
    }
    }
    __syncthreads();
}
struct G9Row { u32x4 a; u32x2 b; };
#define G9_SETS G9Row A[4], B[4]
#define G9_XOFF(c) (32 * lane + 16 * (c))
#define G9_LOAD(SET, TAB, IDL, g) do { _Pragma("unroll") for (int k = 0; k < 4; ++k) { const int ex = __builtin_amdgcn_readlane(IDL, 4 * (4 * (g) + k)); \
        if (((TAB) == EU) ? U4 : V4) { SET[k].a = *(const u32x4*)((TAB) + (size_t)ex * 1024 + 16 * lane); } else { \
        const unsigned char* rp = (TAB) + (size_t)ex * EROW; SET[k].a = *(const u32x4*)(rp + 16 * lane); if (VAR == 0 || (TAB) != EU) SET[k].b = *(const u32x2*)(rp + 1024 + 8 * lane); else SET[k].b = (u32x2){0u, 0u}; } } } while (0)
#define G9_CVT(SET, k) __builtin_amdgcn_cvt_scalef32_pk32_f32_fp6((v6u_t){SET[k].a.x, SET[k].a.y, SET[k].a.z, SET[k].a.w, SET[k].b.x, SET[k].b.y}, 1.0f)
#define G9_DOTS(SET, g) do { _Pragma("unroll") for (int k = 0; k < 4; ++k) { f32x2v q0 = {0.f, 0.f}, q1 = {0.f, 0.f}; \
        if (U4) { f32x2v r4[16]; unpack32_fp4(SET[k].a, r4); _Pragma("unroll") for (int i = 0; i < 8; ++i) { \
            q0 = r4[i] * (f32x2v){xv[0][2 * i], xv[0][2 * i + 1]} + q0; q1 = r4[8 + i] * (f32x2v){xv[1][2 * i], xv[1][2 * i + 1]} + q1; } \
        } else { const v32f_t r = G9_CVT(SET, k); \
        _Pragma("unroll") for (int e = 0; e < 16; e += 2) { q0 = (f32x2v){r[e], r[e + 1]} * (f32x2v){xv[0][e], xv[0][e + 1]} + q0; q1 = (f32x2v){r[16 + e], r[17 + e]} * (f32x2v){xv[1][e], xv[1][e + 1]} + q1; } } \
        q0 += q1; float s = q0.x + q0.y; asm volatile("" : "+v"(s)); dots[4 * (g) + k] = s; } } while (0)
#define G9_FMAS(SET, g) do { _Pragma("unroll") for (int k = 0; k < 4; ++k) { const float wk = wq[g][k]; const f32x2v wk2 = {wk, wk}; \
        if (V4) { f32x2v r4[16]; unpack32_fp4(SET[k].a, r4); _Pragma("unroll") for (int i = 0; i < 8; ++i) { \
            const f32x2v a0 = r4[i] * wk2 + (f32x2v){acc[0][2 * i], acc[0][2 * i + 1]}, a1 = r4[8 + i] * wk2 + (f32x2v){acc[1][2 * i], acc[1][2 * i + 1]}; \
            acc[0][2 * i] = a0.x; acc[0][2 * i + 1] = a0.y; acc[1][2 * i] = a1.x; acc[1][2 * i + 1] = a1.y; } \
        } else { const v32f_t r = G9_CVT(SET, k); \
        _Pragma("unroll") for (int e = 0; e < 16; e += 2) { const f32x2v a0 = (f32x2v){r[e], r[e + 1]} * wk2 + (f32x2v){acc[0][e], acc[0][e + 1]}, a1 = (f32x2v){r[16 + e], r[17 + e]} * wk2 + (f32x2v){acc[1][e], acc[1][e + 1]}; \
            acc[0][e] = a0.x; acc[0][e + 1] = a0.y; acc[1][e] = a1.x; acc[1][e + 1] = a1.y; } } } } while (0)
#else
constexpr int EROW = 2048;
#define G9_SETS u32x4 A[4][2], B[4][2]
#define G9_XOFF(c) (1024 * (c) + 16 * lane)
#define G9_LOAD(SET, TAB, IDL, g) do { _Pragma("unroll") for (int k = 0; k < 4; ++k) { const int ex = __builtin_amdgcn_readlane(IDL, 4 * (4 * (g) + k)); \
        const unsigned char* rp = (TAB) + (size_t)ex * 2048 + 16 * lane; SET[k][0] = *(const u32x4*)rp; SET[k][1] = *(const u32x4*)(rp + 1024); } } while (0)
#define G9_DOTS(SET, g) do { _Pragma("unroll") for (int k = 0; k < 4; ++k) { float s = 0.f; _Pragma("unroll") for (int c = 0; c < 2; ++c) _Pragma("unroll") for (int dw = 0; dw < 4; ++dw) { \
        const f32x2v lo = __builtin_amdgcn_cvt_pk_f32_fp8((int)SET[k][c][dw], false), hi2 = __builtin_amdgcn_cvt_pk_f32_fp8((int)SET[k][c][dw], true); \
        s += lo.x * xv[c][4 * dw] + lo.y * xv[c][4 * dw + 1] + hi2.x * xv[c][4 * dw + 2] + hi2.y * xv[c][4 * dw + 3]; } asm volatile("" : "+v"(s)); dots[4 * (g) + k] = s; } } while (0)
#define G9_FMAS(SET, g) do { _Pragma("unroll") for (int k = 0; k < 4; ++k) { const float wk = wq[g][k]; \
        _Pragma("unroll") for (int c = 0; c < 2; ++c) _Pragma("unroll") for (int dw = 0; dw < 4; ++dw) { \
        const f32x2v lo = __builtin_amdgcn_cvt_pk_f32_fp8((int)SET[k][c][dw], false), hi2 = __builtin_amdgcn_cvt_pk_f32_fp8((int)SET[k][c][dw], true); \
        acc[c][4 * dw] += wk * lo.x; acc[c][4 * dw + 1] += wk * lo.y; acc[c][4 * dw + 2] += wk * hi2.x; acc[c][4 * dw + 3] += wk * hi2.y; } } } while (0)
#endif
#define G9_PIN() do { _Pragma("unroll") for (int c = 0; c < 2; ++c) asm volatile("" : "+v"(acc[c][0]), "+v"(acc[c][1]), "+v"(acc[c][2]), "+v"(acc[c][3]), "+v"(acc[c][4]), "+v"(acc[c][5]), "+v"(acc[c][6]), "+v"(acc[c][7]), \
        "+v"(acc[c][8]), "+v"(acc[c][9]), "+v"(acc[c][10]), "+v"(acc[c][11]), "+v"(acc[c][12]), "+v"(acc[c][13]), "+v"(acc[c][14]), "+v"(acc[c][15])); } while (0)
template <int VAR = 0, class IdF, class GtF>
__device__ __forceinline__ void g9_token(Frame& F, const Ins& I, float* out, int t, LAS float* wl, IdF idf, GtF gtf) {
    unsigned char* ws = F.ws;
    const bf16* X2B = (const bf16*)(ws + WS_X2B); const unsigned char* EU = ws + WS_EU; const unsigned char* EV = ws + WS_EV;
    const float* ssq2 = (const float*)(ws + WS_PSQ2);
    const int lane = F.lane, sl = (lane >> 2) & 15;
    const bool bit3 = (lane & 8) != 0, bit2 = (lane & 4) != 0;
    {
        G9_SETS;
        {
            float xv[2][16];
            if (PERMX) {
#pragma unroll
                for (int k = 0; k < 8; ++k) { const u32x2 a = *(const u32x2*)(X2B + (size_t)t * 2048 + 256 * k + 4 * lane);
                    xv[k >> 2][(4 * k) & 15] = bflo(a.x); xv[k >> 2][((4 * k) & 15) + 1] = bfhi(a.x); xv[k >> 2][((4 * k) & 15) + 2] = bflo(a.y); xv[k >> 2][((4 * k) & 15) + 3] = bfhi(a.y); }
            } else
#pragma unroll
            for (int c = 0; c < 2; ++c)
#pragma unroll
                for (int q = 0; q < 2; ++q) { const u32x4 a = *(const u32x4*)(X2B + (size_t)t * 2048 + G9_XOFF(c) + 8 * q);
                    xv[c][8 * q] = bflo(a.x); xv[c][8 * q + 1] = bfhi(a.x); xv[c][8 * q + 2] = bflo(a.y); xv[c][8 * q + 3] = bfhi(a.y); xv[c][8 * q + 4] = bflo(a.z); xv[c][8 * q + 5] = bfhi(a.z); xv[c][8 * q + 6] = bflo(a.w); xv[c][8 * q + 7] = bfhi(a.w); }
            const float rstd2 = (1.0f / EU_SCALE) / sqrtf(sum32(ssq2 + (size_t)t * 32) * (1.0f / 2048.0f) + EPS);
            int idl_cur = idf(0);
            G9_LOAD(A, EU, idl_cur, 0); __builtin_amdgcn_sched_barrier(0);
#pragma unroll 1
            for (int hd = 0; hd < 8; ++hd) {
                const int idl_nxt = idf(hd < 7 ? hd + 1 : 0); const float gtl = gtf(hd);
                float dots[16];
                G9_LOAD(B, EU, idl_cur, 1); __builtin_amdgcn_sched_barrier(0);
                G9_DOTS(A, 0); __builtin_amdgcn_sched_barrier(0);
                G9_LOAD(A, EU, idl_cur, 2); __builtin_amdgcn_sched_barrier(0);
                G9_DOTS(B, 1); __builtin_amdgcn_sched_barrier(0);
                G9_LOAD(B, EU, idl_cur, 3); __builtin_amdgcn_sched_barrier(0);
                G9_DOTS(A, 2); __builtin_amdgcn_sched_barrier(0);
                if (hd < 7) { G9_LOAD(A, EU, idl_nxt, 0); } else { G9_LOAD(A, EV, idl_nxt, 0); }
                __builtin_amdgcn_sched_barrier(0);
                G9_DOTS(B, 3); __builtin_amdgcn_sched_barrier(0);
                float d8[8], d4[4], d2[2], d1;
#pragma unroll
                for (int i = 0; i < 8; ++i) { auto rr = __builtin_amdgcn_permlane32_swap(__float_as_uint(dots[i]), __float_as_uint(dots[8 + i]), false, false); const unsigned r0 = rr[0], r1 = rr[1]; d8[i] = __uint_as_float(r0) + __uint_as_float(r1); }
#pragma unroll
                for (int i = 0; i < 4; ++i) { auto rr = __builtin_amdgcn_permlane16_swap(__float_as_uint(d8[i]), __float_as_uint(d8[4 + i]), false, false); const unsigned r0 = rr[0], r1 = rr[1]; d4[i] = __uint_as_float(r0) + __uint_as_float(r1); }
#pragma unroll
                for (int i = 0; i < 2; ++i) { const float keep = bit3 ? d4[2 + i] : d4[i], send = bit3 ? d4[i] : d4[2 + i]; d2[i] = keep + __shfl_xor(send, 8); }
                { const float keep = bit2 ? d2[1] : d2[0], send = bit2 ? d2[0] : d2[1]; d1 = keep + __shfl_xor(send, 4); }
                d1 += __shfl_xor(d1, 2); d1 += __shfl_xor(d1, 1);
                const float a = d1 * rstd2;
                const float z2 = 1.5957691216057308f * (a + 0.044715f * a * a * a);
                const float w = gtl * (1.0f / EV_SCALE) * a * __builtin_amdgcn_rcpf(1.0f + __builtin_amdgcn_exp2f(-z2 * LOG2E));
                if ((lane & 3) == 0) wl[hd * 16 + sl] = w;
                idl_cur = idl_nxt;
            }
        }
        LDS_WAIT(); asm volatile("" ::: "memory");
        float acc[2][16];
#pragma unroll
        for (int c = 0; c < 2; ++c)
#pragma unroll
            for (int e = 0; e < 16; ++e) acc[c][e] = 0.f;
        {
            int idl_cur = idf(0);
#pragma unroll 1
            for (int hd = 0; hd < 8; ++hd) {
                const int idl_nxt = idf(hd < 7 ? hd + 1 : 0);
                f32x4 wq[4];
#pragma unroll
                for (int g = 0; g < 4; ++g) wq[g] = *(const LAS f32x4*)(wl + hd * 16 + 4 * g);
                G9_LOAD(B, EV, idl_cur, 1); __builtin_amdgcn_sched_barrier(0);
                G9_FMAS(A, 0); G9_PIN(); __builtin_amdgcn_sched_barrier(0);
                G9_LOAD(A, EV, idl_cur, 2); __builtin_amdgcn_sched_barrier(0);
                G9_FMAS(B, 1); G9_PIN(); __builtin_amdgcn_sched_barrier(0);
                G9_LOAD(B, EV, idl_cur, 3); __builtin_amdgcn_sched_barrier(0);
                G9_FMAS(A, 2); G9_PIN(); __builtin_amdgcn_sched_barrier(0);
                if (hd < 7) { G9_LOAD(A, EV, idl_nxt, 0); } __builtin_amdgcn_sched_barrier(0);
                G9_FMAS(B, 3); G9_PIN(); __builtin_amdgcn_sched_barrier(0);
                idl_cur = idl_nxt;
            }
        }
        LDS_WAIT(); asm volatile("" ::: "memory");
        float s = 0.f;
        if (PERMX) {
#pragma unroll
            for (int k = 0; k < 8; ++k) { const u32x2 a = *(const u32x2*)(X2B + (size_t)t * 2048 + 256 * k + 4 * lane);
                const float xr[4] = {bflo(a.x), bfhi(a.x), bflo(a.y), bfhi(a.y)};
#pragma unroll
                for (int e = 0; e < 4; ++e) { float& ac = acc[k >> 2][((4 * k) & 15) + e]; ac += xr[e]; s += ac * ac; } }
        } else
#pragma unroll
        for (int c = 0; c < 2; ++c)
#pragma unroll
            for (int q = 0; q < 2; ++q) { const u32x4 a = *(const u32x4*)(X2B + (size_t)t * 2048 + G9_XOFF(c) + 8 * q);
                const float xr[8] = {bflo(a.x), bfhi(a.x), bflo(a.y), bfhi(a.y), bflo(a.z), bfhi(a.z), bflo(a.w), bfhi(a.w)};
#pragma unroll
                for (int e = 0; e < 8; ++e) { acc[c][8 * q + e] += xr[e]; s += acc[c][8 * q + e] * acc[c][8 * q + e]; } }
        float rs = 1.0f / sqrtf(wave_sum(s) * (1.0f / 2048.0f) + EPS);
#ifdef ATT_CHECK
        if (((const unsigned*)F.ctl)[16] + ((const unsigned*)F.ctl)[17] > 0u) rs = __builtin_nanf("");
#endif
        if (PERMX) {
#pragma unroll
            for (int k = 0; k < 8; ++k) { const f32x4 g = *(const f32x4*)(I.g_final + 256 * k + 4 * lane); const int c = k >> 2, e = (4 * k) & 15;
                *(f32x4*)(out + (size_t)t * 2048 + 256 * k + 4 * lane) = (f32x4){acc[c][e] * rs * g[0], acc[c][e + 1] * rs * g[1], acc[c][e + 2] * rs * g[2], acc[c][e + 3] * rs * g[3]}; }
        } else
#pragma unroll
        for (int c = 0; c < 2; ++c)
#pragma unroll
            for (int q = 0; q < 4; ++q) { const f32x4 g = *(const f32x4*)(I.g_final + G9_XOFF(c) + 4 * q);
                *(f32x4*)(out + (size_t)t * 2048 + G9_XOFF(c) + 4 * q) = (f32x4){acc[c][4 * q] * rs * g[0], acc[c][4 * q + 1] * rs * g[1], acc[c][4 * q + 2] * rs * g[2], acc[c][4 * q + 3] * rs * g[3]}; }
    }
}
#undef G9_LOAD
#undef G9_DOTS
#undef G9_FMAS
#undef G9_PIN
#undef G9_SETS
#undef G9_XOFF
__device__ __forceinline__ void p9_gather_fp8(Frame& F, const Ins& I, float* out) {
    const int* IDX = (const int*)(F.ws + WS_IDX); const float* GT = (const float*)(F.ws + WS_GT);
    const int lane = F.lane, sl = (lane >> 2) & 15;
    LAS float* wl = (LAS float*)(F.lds + RING_OFF + F.wave * 4096);
    unsigned* tokctr = (unsigned*)F.ctl + CW_TOKCTR;
    for (;;) {
        int t = 0; if (lane == 0) t = (int)__hip_atomic_fetch_add(tokctr, 1u, __ATOMIC_RELAXED, __HIP_MEMORY_SCOPE_AGENT);
        t = __builtin_amdgcn_readfirstlane(t);
        if (t >= T) break;
        const int* idx_t = IDX + (size_t)t * 128 + sl; const float* gt_t = GT + (size_t)t * 128 + sl;
        g9_token(F, I, out, t, wl, [=](int hd) { return idx_t[hd * 16]; }, [=](int hd) { return gt_t[hd * 16]; });
    }
}

template <int VAR = 0>
__device__ __forceinline__ void p89_route_gather(Frame& F, const Ins& I, float* out) {
    using namespace rt;
    rt_load_keys(F, I);
    LAS unsigned* lstw = (LAS unsigned*)(F.lds + RING_OFF + LIST_OFF + F.wave * LIST_WAVE);
    LAS unsigned* lst = lstw + (F.lane & 31) * 48;
    LAS float* wl = (LAS float*)(lstw + 32 * 48);
    const int gw = F.vcu * NWAVES + F.wave, NGW = F.G * NWAVES, sl = (F.lane >> 2) & 15;
    for (int task = gw; task < T * 8 / 32; task += NGW) {
        rt_task<true>(F, task, lst);
        LDS_WAIT(); asm volatile("" ::: "memory");
#pragma unroll 1
        for (int tt = 0; tt < 4; ++tt) {
            LAS unsigned* lt = lstw + (tt * 8) * 48 + sl;
            g9_token<VAR>(F, I, out, 4 * task + tt, wl, [=](int hd) { return (int)lt[hd * 48]; }, [=](int hd) { return __uint_as_float(lt[hd * 48 + 16]); });
        }
        LDS_WAIT(); asm volatile("" ::: "memory");
    }
}

constexpr int NPHASE = 10;
struct Args { Ins in; float* out; unsigned char* ws; double inv_freq[32]; int ph_lo, ph_hi; };
__global__ void __launch_bounds__(NWAVES * 64, 2) mega_fwd(Args args) {
    extern __shared__ __attribute__((aligned(16))) unsigned char lds[];
    Frame F;
    F.lds = (LAS unsigned char*)lds;
    F.MISC = (volatile LAS unsigned*)(F.lds + MISC_OFF);
    F.tid = threadIdx.x; F.lane = F.tid & 63; F.wave = __builtin_amdgcn_readfirstlane(F.tid >> 6);
    F.G = gridDim.x; { const int bx = blockIdx.x; F.vcu = (F.G % 8 == 0) ? (bx % 8) * (F.G / 8) + bx / 8 : bx; }
    unsigned char* ws = args.ws; F.ws = ws;
    F.ctl = (gu32*)(ws + WS_CTL);
    const Ins& I = args.in;
    for (int u = F.tid; u < (LDS_BYTES - LDSCTL_OFF) / 4; u += NWAVES * 64) ((LAS unsigned*)(F.lds + LDSCTL_OFF))[u] = 0u;
    __syncthreads();
    XcdBarrier bar; bar.bar = (unsigned*)(F.ctl + CW_BAR); bar.x = 0; bar.st = nullptr;
#if MK_N_LAUNCHES == 1
    bar = xcd_barrier_post((unsigned*)(F.ctl + CW_BAR), F.MISC + 8);
#define GRID_BAR() xcd_barrier(bar)
#else
#define GRID_BAR() do {} while (0)
#endif
    const int lo = args.ph_lo, hi = args.ph_hi;
#ifdef PROBE_PH
    unsigned long long pstamp[NPHASE + 1];
#define PSTAMP(k) do { if (blockIdx.x == 0 && F.tid == 0) pstamp[k] = __builtin_amdgcn_s_memrealtime(); } while (0)
#else
#define PSTAMP(k) do {} while (0)
#endif
#ifndef PH_MASK
#define PH_MASK 0xFFFF
#endif
#define IN(k) (((PH_MASK >> (k)) & 1) && lo <= (k) && (k) < hi)
#define BOTH(k) (IN(k) && IN((k) + 1))
    float* ssq_q = (float*)(ws + WS_PSQ_Q); float* ssq_kv = (float*)(ws + WS_PSQ_KV); float* ssq2 = (float*)(ws + WS_PSQ2);
    const float* rope = (const float*)(ws + WS_ROPE);

    PSTAMP(0);
    if (IN(0)) { p0_prologue(F, I, args.inv_freq); if (BOTH(0)) GRID_BAR(); }

    PSTAMP(1);
    if (IN(1)) {
        { pg8::Gemm g{(const bf16_t*)(ws + WS_H), (const bf16_t*)(ws + WS_W1), T, N1, 2048, 2048}; pg8::StaticOrder S; S.init(T, N1, F.G, (int)blockIdx.x);
          EpiProj<0> E{(bf16_t*)(ws + WS_CQ), (bf16_t*)(ws + WS_CKV), (bf16_t*)(ws + WS_DQ), (bf16_t*)(ws + WS_DK), (bf16_t*)(ws + WS_DV), (bf16_t*)(ws + WS_G), (bf16_t*)(ws + WS_KR), ssq_q, ssq_kv, I.b_gate, rope};
          pg8::gemm_phase<EpiProj<0>, pg8::StaticOrder, PG8_ALIGN, PG8_SP2>(F.lds + RING_OFF, g, S, E); }
        {
          pg8::Gemm g{(const bf16_t*)(ws + WS_H8), (const bf16_t*)(ws + WS_W8), T, NG, 1024, 1024, 1.0f / W1_SCALE}; pg8::GateOrder S; S.init(T, NG, F.G, (int)blockIdx.x);
          EpiProj<1> E{(bf16_t*)(ws + WS_CQ), (bf16_t*)(ws + WS_CKV), (bf16_t*)(ws + WS_DQ), (bf16_t*)(ws + WS_DK), (bf16_t*)(ws + WS_DV), (bf16_t*)(ws + WS_G), (bf16_t*)(ws + WS_KR), ssq_q, ssq_kv, I.b_gate, rope};
          pg8::gemm_phase<EpiProj<1>, pg8::GateOrder, PG8_ALIGN, PG8_SP2, true>(F.lds + RING_OFF, g, S, E); }
        if (BOTH(1)) GRID_BAR();
    }
    PSTAMP(2);
    if (IN(2)) {
        { pg8::Gemm g{(const bf16_t*)(ws + WS_CQ), (const bf16_t*)(ws + WS_WUQ), T, 1536, 384, 384, 1.0f / W1_SCALE}; pg8::StaticOrder S; S.init(T, 1536, F.G, (int)blockIdx.x);
          EpiQup E{(bf16_t*)(ws + WS_QN), (bf16_t*)(ws + WS_QR), ssq_q, rope};
          pg8::gemm_phase<EpiQup, pg8::StaticOrder, PG8_ALIGN, PG8_SP2, true>(F.lds + RING_OFF, g, S, E); }
        { pg8::Gemm g{(const bf16_t*)(ws + WS_CKV), (const bf16_t*)(ws + WS_WUKV), T, 2048, 256, 256, 1.0f / W1_SCALE}; pg8::StaticOrder S; S.init(T, 2048, F.G, (int)blockIdx.x);
          EpiKVup E{(bf16_t*)(ws + WS_KN), (bf16_t*)(ws + WS_V), ssq_kv};
          pg8::gemm_phase<EpiKVup, pg8::StaticOrder, PG8_ALIGN, PG8_SP2, true>(F.lds + RING_OFF, g, S, E); }
        if (BOTH(2)) GRID_BAR();
    }
    PSTAMP(3);
#ifdef ATT_REF
    if (IN(3)) { p3_attention_ref(F, I); if (BOTH(3)) GRID_BAR(); }
#else
    if (IN(3)) { p3_attention(F, I); if (BOTH(3)) GRID_BAR(); }
#ifdef ATT_CHECK
    if (IN(3)) { p3_attention_ref(F, I); GRID_BAR(); }
#endif
#endif
    PSTAMP(4);
    if (IN(4)) {
        pg8::Gemm2 g{(const bf16_t*)(ws + WS_OM), (const bf16_t*)(ws + WS_OD), (const bf16_t*)(ws + WS_WOM), (const bf16_t*)(ws + WS_WOD), T, 2048, 1024, 1024};
        pg8::StaticOrder S; S.init(T, 2048, F.G, (int)blockIdx.x);
        EpiGate2 E{(const bf16_t*)(ws + WS_G), (bf16_t*)(ws + WS_MG), 0};
        pg8::gemm_phase2<EpiGate2, pg8::StaticOrder, PG8_ALIGN, PG8_SP2>(F.lds + RING_OFF, g, S, E);
#ifdef PROBE_P4
        { __syncthreads(); EpiGate2 E2{(const bf16_t*)(ws + WS_G), (bf16_t*)(ws + WS_MG), args.ph_hi > 1000 ? 0 : PROBE_P4};
          pg8::gemm_phase2<EpiGate2, pg8::StaticOrder, PG8_ALIGN, PG8_SP2>(F.lds + RING_OFF, g, S, E2); }
#endif
        if (BOTH(4)) GRID_BAR();
    }
    PSTAMP(5);
    PSTAMP(6);
    if (IN(6)) {
#ifdef PEER_BF16
        convert_experts(F, I);
#else
#ifdef PEER_FP6
#if !(ATT_BGCONV && !ATT_PIPE_M && !ATT_PIPE_D)
        convert_experts_fp4(F, I); convert_experts_fp6(F, I);
#endif
#else
        convert_experts_fp8(F, I);
#endif
#endif
        pg8::Gemm g{(const bf16_t*)(ws + WS_MG), (const bf16_t*)(ws + WS_WOUT), T, 2048, 2048, 2048}; pg8::StaticOrder S; S.init(T, 2048, F.G, (int)blockIdx.x);
        EpiRes E{I.x, (float*)(ws + WS_X2), (bf16_t*)(ws + WS_X2B), ssq2};
        pg8::gemm_phase<EpiRes, pg8::StaticOrder, PG8_ALIGN, PG8_SP2>(F.lds + RING_OFF, g, S, E);
        if (BOTH(6)) GRID_BAR();
    }
    PSTAMP(7);
    if (IN(7)) {
        pg8::Gemm g{(const bf16_t*)(ws + WS_X2B), (const bf16_t*)(ws + WS_WQP), T, 2048, 2048, 2048}; pg8::StaticOrder S; S.init(T, 2048, F.G, (int)blockIdx.x);
        EpiQP E{(bf16_t*)(ws + WS_QP), ssq2, (const LAS float*)(F.lds + RTAB_OFF), {-1, -1, -1, -1}};
        {
            LAS float* tab = (LAS float*)(F.lds + RTAB_OFF); pg8::Unit u;
#pragma unroll
            for (int i = 0; i < RTAB_SLOTS; ++i) {
                if (S.next(i, u)) {
                    E.pms[i] = u.pm;
                    const int r = F.tid >> 1, hf = F.tid & 1; const float* p = ssq2 + ((size_t)u.pm * 256 + r) * 32 + hf * 16;
                    const f32x4 q0 = *(const f32x4*)p, q1 = *(const f32x4*)(p + 4), q2 = *(const f32x4*)(p + 8), q3 = *(const f32x4*)(p + 12);
                    float t = (((q0[0] + q0[1]) + (q0[2] + q0[3])) + ((q1[0] + q1[1]) + (q1[2] + q1[3]))) + (((q2[0] + q2[1]) + (q2[2] + q2[3])) + ((q3[0] + q3[1]) + (q3[2] + q3[3])));
                    t += __shfl_xor(t, 1);
                    if (hf == 0) tab[i * 256 + r] = 1.0f / sqrtf(t * (1.0f / 2048.0f) + EPS);
                }
            }
            __syncthreads();
        }
        pg8::gemm_phase<EpiQP, pg8::StaticOrder, PG8_ALIGN, PG8_SP2>(F.lds + RING_OFF, g, S, E);
        if (BOTH(7)) GRID_BAR();
    }
    PSTAMP(8);
#if defined(ROUTE_REF) || defined(PEER_BF16) || defined(NO_FUSE89)
#ifdef ROUTE_REF
    if (IN(8)) { p7_routing_ref(F); if (BOTH(8)) GRID_BAR(); }
#else
    if (IN(8)) { p8_routing(F, I); if (BOTH(8)) GRID_BAR(); }
#endif
    PSTAMP(9);
#ifdef PEER_BF16
    if (IN(9)) { p8_gather(F, I, args.out); }
#else
    if (IN(9)) { p9_gather_fp8(F, I, args.out); }
#endif
#else
    if (IN(8) && IN(9)) { p89_route_gather(F, I, args.out); }
#ifdef PROBE_G9
    if (IN(8) && IN(9)) { __syncthreads(); p89_route_gather<PROBE_G9>(F, I, (float*)(ws + WS_G)); }
#endif
    PSTAMP(9);
#endif
    PSTAMP(10);
#ifdef PROBE_PH
    if (blockIdx.x == 0 && F.tid == 0) {
#ifndef PROBE_HI
#define PROBE_HI (PROBE_PH + 1)
#endif
#ifndef PROBE_MUL
#define PROBE_MUL 1
#endif
        const unsigned long long span = (pstamp[PROBE_HI] - pstamp[PROBE_PH]) * PROBE_MUL, t0 = __builtin_amdgcn_s_memrealtime();
        while (__builtin_amdgcn_s_memrealtime() - t0 < span) __builtin_amdgcn_s_sleep(32);
    }
#endif
#undef IN
#undef BOTH
}

extern "C" void kernel_launch(void* const* d_in, const int* in_sizes, int n_in, void* d_out, int out_size, void* d_ws, size_t ws_size, hipStream_t stream) {
    static int grid = 0;
    if (grid == 0) {
        if (n_in != 19 || out_size != T * D_MODEL || ws_size < WS_END) { fprintf(stderr, "kernel_launch: unexpected shapes: n_in %d out %d ws %zu\n", n_in, out_size, ws_size); grid = -1; return; }
        int dev = 0, cus = 0, per_cu = 0;
        if (hipGetDevice(&dev) != hipSuccess || hipDeviceGetAttribute(&cus, hipDeviceAttributeMultiprocessorCount, dev) != hipSuccess) { grid = -1; return; }
        if (hipFuncSetAttribute((const void*)mega_fwd, hipFuncAttributeMaxDynamicSharedMemorySize, LDS_BYTES) != hipSuccess) { fprintf(stderr, "kernel_launch: hipFuncSetAttribute failed\n"); grid = -1; return; }
        if (hipOccupancyMaxActiveBlocksPerMultiprocessor(&per_cu, (const void*)mega_fwd, NWAVES * 64, LDS_BYTES) != hipSuccess || per_cu < 1)
            fprintf(stderr, "kernel_launch: occupancy query reports %d workgroups per CU\n", per_cu);
        (void)hipGetLastError();
        grid = cus;
    }
    if (grid < 0) return;
    if (hipMemsetAsync((char*)d_ws + WS_CTL, 0, CTL_ZERO_BYTES, stream) != hipSuccess) { fprintf(stderr, "kernel_launch: memset failed\n"); return; }
    Args a{};
    const float** ip = (const float**)&a.in;
    for (int i = 0; i < 19; ++i) ip[i] = (const float*)d_in[i];
    a.out = (float*)d_out; a.ws = (unsigned char*)d_ws;
    for (int i = 0; i < 32; ++i) a.inv_freq[i] = pow(10000.0, -(double)i / 32.0);
#if MK_N_LAUNCHES == 1
    a.ph_lo = 0; a.ph_hi = NPHASE;
    hipLaunchKernelGGL(mega_fwd, dim3(grid), dim3(NWAVES * 64), LDS_BYTES, stream, a);
#else
    for (int p = 0; p < NPHASE; ++p) { a.ph_lo = p; a.ph_hi = p + 1; hipLaunchKernelGGL(mega_fwd, dim3(grid), dim3(NWAVES * 64), LDS_BYTES, stream, a); }
#endif
    const hipError_t le = hipPeekAtLastError();
    if (le != hipSuccess) fprintf(stderr, "kernel_launch: launch failed: %s\n", hipGetErrorName(le));
}
```
